# Optimizing an MI355X kernel written in HIP

```python
import math
import jax, jax.numpy as jnp
from jax import lax
import numpy as np

D_MODEL = 1024
BATCH = 4
SEQ = 8192
DEPTH = 2
DEC_BATCH = 1
DEC_SEQ = 16384
PAST_LEN = 128

GRID_W = 64
Q_BLOCK = 128
NORM_EPS = 1e-6
D_FF = 2816
D_HY = 512
HY_IN = 3 * D_HY
SHORT_CONV = 3
POS_BANDS = 16
POS_EMB = 1 + 2 * POS_BANDS
FILT_HID = 64
DECAY_TARGET = 1e-2
FAST_DECAY_PCT = 0.3
SLOW_DECAY_PCT = 1.5
HEAD_DIM = 64
N_Q_HEADS = 8
N_KV_HEADS = 2
GQA_GROUP = N_Q_HEADS // N_KV_HEADS
D_GQA = N_Q_HEADS * HEAD_DIM
D_GQA_KV = N_KV_HEADS * HEAD_DIM
ROPE_THETA = 10000.0
N_DIFF_HEADS = 4
D_DIFF = N_DIFF_HEADS * 2 * HEAD_DIM
DIFF_SUBLN_EPS = 1e-5
N_BUCKETS = 32
MAX_DISTANCE = 128
N_BRANCHES = 3
D_BRANCH = 512
OFF_HY = 0
OFF_GQ = OFF_HY + HY_IN
OFF_GK = OFF_GQ + D_GQA
OFF_GV = OFF_GK + D_GQA_KV
OFF_DQ = OFF_GV + D_GQA_KV
OFF_DK = OFF_DQ + D_DIFF
OFF_DV = OFF_DK + D_DIFF
OFF_GATE = OFF_DV + D_DIFF
IN_COLS = OFF_GATE + N_BRANCHES * D_MODEL

kernel_name = "hybrid_hyena_gqa_diffattn_encoder"

F32 = jnp.float32


def rms_norm(x, g, eps=NORM_EPS):
    xf = x.astype(F32)
    y = xf * lax.rsqrt(jnp.mean(xf * xf, axis=-1, keepdims=True) + eps)
    return (y * g.astype(F32)).astype(x.dtype)


def swiglu_ffn(x, norm_g, w_in, w_out):
    h = rms_norm(x, norm_g)
    gate, up = jnp.split(h @ w_in, 2, axis=-1)
    return (jax.nn.silu(gate) * up) @ w_out


def short_conv(u, w, b):
    up = jnp.pad(u, ((0, 0), (1, 1), (0, 0)))
    return up[:, :-2] * w[0] + up[:, 1:-1] * w[1] + up[:, 2:] * w[2] + b


def hyena_kernel(L, w1, b1, w2, b2, w3, freq):
    t = jnp.linspace(0.0, 1.0, L, dtype=F32)[:, None]
    band = jnp.linspace(1e-4, POS_BANDS - 1, POS_BANDS, dtype=F32)
    ang = (2.0 * math.pi / L) * jnp.arange(L, dtype=F32)[:, None] * band[None, :]
    feats = jnp.concatenate([t, jnp.cos(ang), -jnp.sin(ang)], axis=-1)
    fr = freq.astype(F32)
    h = jnp.sin(fr * (feats @ w1.astype(F32) + b1.astype(F32)))
    h = jnp.sin(fr * (h @ w2.astype(F32) + b2.astype(F32)))
    h = h @ w3.astype(F32)
    max_decay = math.log(DECAY_TARGET) / FAST_DECAY_PCT
    min_decay = math.log(DECAY_TARGET) / SLOW_DECAY_PCT
    deltas = jnp.linspace(min_decay, max_decay, D_HY, dtype=F32)
    decay = jnp.exp(-t * jnp.abs(deltas)[None, :])
    h_fwd = h[:, :D_HY] * decay
    h_bwd = h[:, D_HY:] * decay
    return jnp.concatenate([h_fwd, jnp.zeros((1, D_HY), F32), h_bwd[:0:-1]], axis=0)


def hyena_mixer(u, conv_w, conv_b, kernel, skip):
    L = u.shape[1]
    u = short_conv(u, conv_w, conv_b)
    x0, x1, v = jnp.split(u, 3, axis=-1)
    z = (v * x1).astype(F32)
    n = 2 * L
    zf = jnp.fft.rfft(z, n=n, axis=1)
    kf = jnp.fft.rfft(kernel, n=n, axis=0)
    y = jnp.fft.irfft(zf * kf[None], n=n, axis=1)[:, :L]
    y = y + z * skip.astype(F32)
    return x0 * y.astype(u.dtype)


def axial_rope_tables(L):
    rows = L // GRID_W
    row = jnp.repeat(jnp.arange(rows, dtype=F32), GRID_W)
    col = jnp.tile(jnp.arange(GRID_W, dtype=F32), rows)
    half = HEAD_DIM // 2
    inv = ROPE_THETA ** (-jnp.arange(0, half, 2, dtype=F32) / half)
    ang = jnp.concatenate([row[:, None] * inv, col[:, None] * inv], axis=-1)
    return jnp.cos(ang), jnp.sin(ang)


def apply_rope(x, cos, sin):
    shp = x.shape
    xr = x.astype(F32).reshape(shp[:-1] + (shp[-1] // 2, 2))
    c = cos[None, :, None, :]
    s = sin[None, :, None, :]
    a, b = xr[..., 0], xr[..., 1]
    out = jnp.stack([a * c - b * s, a * s + b * c], axis=-1).reshape(shp)
    return out.astype(x.dtype)


def t5_bucket(rel):
    nb = N_BUCKETS // 2
    max_exact = nb // 2
    ret = jnp.where(rel > 0, nb, 0)
    n = jnp.abs(rel)
    nf = jnp.maximum(n, 1).astype(F32)
    large = max_exact + (jnp.log(nf / max_exact) / math.log(MAX_DISTANCE / max_exact)
                         * (nb - max_exact)).astype(jnp.int32)
    large = jnp.minimum(large, nb - 1)
    return ret + jnp.where(n < max_exact, n, large)


def sweep_query_blocks(block_fn, qs):
    B, L = qs[0].shape[:2]
    nb = L // Q_BLOCK
    blocks = tuple(jnp.moveaxis(q.reshape((B, nb, Q_BLOCK) + q.shape[2:]), 1, 0) for q in qs)
    starts = jnp.arange(nb, dtype=jnp.int32) * Q_BLOCK
    out = lax.map(lambda a: block_fn(a[0], *a[1]), (starts, blocks))
    return jnp.moveaxis(out, 0, 1).reshape((B, L) + out.shape[3:])


def gqa_mixer(q, k, v, q_norm, k_norm, cos, sin):
    B, L = q.shape[:2]
    q = q.reshape(B, L, N_Q_HEADS, HEAD_DIM)
    k = k.reshape(B, L, N_KV_HEADS, HEAD_DIM)
    v = v.reshape(B, L, N_KV_HEADS, HEAD_DIM)
    q = apply_rope(rms_norm(q, q_norm), cos, sin) * (HEAD_DIM ** -0.5)
    k = apply_rope(rms_norm(k, k_norm), cos, sin)
    q = q.reshape(B, L, N_KV_HEADS, GQA_GROUP, HEAD_DIM)

    def block(start, qb):
        s = jnp.einsum('bqhgd,bkhd->bhgqk', qb, k).astype(F32)
        p = jax.nn.softmax(s, axis=-1).astype(v.dtype)
        return jnp.einsum('bhgqk,bkhd->bqhgd', p, v)

    o = sweep_query_blocks(block, (q,))
    return o.reshape(B, L, D_GQA)


def diff_mixer(q, k, v, lam_params, subln_g, rel_bias, lam_init):
    B, L = q.shape[:2]
    q = q.reshape(B, L, N_DIFF_HEADS, 2, HEAD_DIM) * (HEAD_DIM ** -0.5)
    k = k.reshape(B, L, N_DIFF_HEADS, 2, HEAD_DIM)
    v = v.reshape(B, L, N_DIFF_HEADS, 2 * HEAD_DIM)
    lp = lam_params.astype(F32)
    lam = jnp.exp(jnp.sum(lp[0] * lp[1])) - jnp.exp(jnp.sum(lp[2] * lp[3])) + lam_init
    kpos = jnp.arange(L, dtype=jnp.int32)
    table = rel_bias.astype(F32)

    def block(start, qb):
        qpos = start + jnp.arange(Q_BLOCK, dtype=jnp.int32)
        bucket = t5_bucket(kpos[None, :] - qpos[:, None])
        bias = jnp.moveaxis(table[bucket], -1, 0)
        s = jnp.einsum('bqhcd,bkhcd->bchqk', qb, k).astype(F32) + bias
        p = jax.nn.softmax(s, axis=-1)
        a = (p[:, 0] - lam * p[:, 1]).astype(v.dtype)
        return jnp.einsum('bhqk,bkhe->bqhe', a, v)

    o = sweep_query_blocks(block, (q,))
    o = rms_norm(o, subln_g, DIFF_SUBLN_EPS) * (1.0 - lam_init)
    return o.reshape(B, L, D_DIFF)


def encoder_trunk(x, P):
    L = x.shape[1]
    cos, sin = axial_rope_tables(L)
    for l in range(DEPTH):
        x = x + 0.5 * swiglu_ffn(x, P["ffn1_norm"][l], P["ffn1_w_in"][l], P["ffn1_w_out"][l])
        h = rms_norm(x, P["mix_norm"][l])
        p = h @ P["w_in"][l]
        kernel = hyena_kernel(L, P["hy_filt_w1"][l], P["hy_filt_b1"][l], P["hy_filt_w2"][l],
                              P["hy_filt_b2"][l], P["hy_filt_w3"][l], P["hy_filt_freq"][l])
        y_hy = hyena_mixer(p[..., OFF_HY:OFF_GQ], P["hy_conv_w"][l], P["hy_conv_b"][l],
                           kernel, P["hy_skip"][l])
        y_gqa = gqa_mixer(p[..., OFF_GQ:OFF_GK], p[..., OFF_GK:OFF_GV], p[..., OFF_GV:OFF_DQ],
                          P["gqa_q_norm"][l], P["gqa_k_norm"][l], cos, sin)
        lam_init = 0.8 - 0.6 * math.exp(-0.3 * l)
        y_diff = diff_mixer(p[..., OFF_DQ:OFF_DK], p[..., OFF_DK:OFF_DV], p[..., OFF_DV:OFF_GATE],
                            P["diff_lambda"][l], P["diff_subln"][l], P["rel_bias"], lam_init)
        gates = jax.nn.sigmoid(p[..., OFF_GATE:].astype(F32)).astype(x.dtype)
        wb = P["w_branch"][l]
        merged = (gates[..., 0:D_MODEL] * (y_hy @ wb[0])
                  + gates[..., D_MODEL:2 * D_MODEL] * (y_gqa @ wb[1])
                  + gates[..., 2 * D_MODEL:3 * D_MODEL] * (y_diff @ wb[2]))
        x = x + merged @ P["w_out"][l]
        x = x + 0.5 * swiglu_ffn(x, P["ffn2_norm"][l], P["ffn2_w_in"][l], P["ffn2_w_out"][l])
    return rms_norm(x, P["final_norm"])


def setup_inputs(seed: int = 0) -> dict:
    key = jax.random.key(seed)
    ks = jax.random.split(key, 32)

    def nrm(k, shape, scale):
        return jax.random.normal(k, shape, F32) * scale

    def gain(k, shape):
        return 1.0 + 0.02 * jax.random.normal(k, shape, F32)

    return {
        "x_prompt": nrm(ks[0], (BATCH, SEQ, D_MODEL), 1.0),
        "x_sample": nrm(ks[1], (DEC_BATCH, DEC_SEQ, D_MODEL), 1.0),
        "ffn1_norm": gain(ks[2], (DEPTH, D_MODEL)),
        "ffn1_w_in": nrm(ks[3], (DEPTH, D_MODEL, 2 * D_FF), D_MODEL ** -0.5),
        "ffn1_w_out": nrm(ks[4], (DEPTH, D_FF, D_MODEL), D_FF ** -0.5),
        "mix_norm": gain(ks[5], (DEPTH, D_MODEL)),
        "w_in": nrm(ks[6], (DEPTH, D_MODEL, IN_COLS), D_MODEL ** -0.5),
        "hy_conv_w": nrm(ks[7], (DEPTH, SHORT_CONV, HY_IN), SHORT_CONV ** -0.5),
        "hy_conv_b": nrm(ks[8], (DEPTH, HY_IN), 0.02),
        "hy_filt_w1": nrm(ks[9], (DEPTH, POS_EMB, FILT_HID), POS_EMB ** -0.5),
        "hy_filt_b1": nrm(ks[10], (DEPTH, FILT_HID), 0.02),
        "hy_filt_w2": nrm(ks[11], (DEPTH, FILT_HID, FILT_HID), FILT_HID ** -0.5),
        "hy_filt_b2": nrm(ks[12], (DEPTH, FILT_HID), 0.02),
        "hy_filt_w3": nrm(ks[13], (DEPTH, FILT_HID, 2 * D_HY), 0.05 * FILT_HID ** -0.5),
        "hy_filt_freq": gain(ks[14], (DEPTH, FILT_HID)),
        "hy_skip": nrm(ks[15], (DEPTH, D_HY), 1.0),
        "gqa_q_norm": gain(ks[16], (DEPTH, HEAD_DIM)),
        "gqa_k_norm": gain(ks[17], (DEPTH, HEAD_DIM)),
        "diff_lambda": nrm(ks[18], (DEPTH, 4, HEAD_DIM), 0.1),
        "diff_subln": gain(ks[19], (DEPTH, 2 * HEAD_DIM)),
        "rel_bias": nrm(ks[20], (N_BUCKETS, N_DIFF_HEADS), 0.5),
        "w_branch": nrm(ks[21], (DEPTH, N_BRANCHES, D_BRANCH, D_MODEL), D_BRANCH ** -0.5),
        "w_out": nrm(ks[22], (DEPTH, D_MODEL, D_MODEL), D_MODEL ** -0.5),
        "ffn2_norm": gain(ks[23], (DEPTH, D_MODEL)),
        "ffn2_w_in": nrm(ks[24], (DEPTH, D_MODEL, 2 * D_FF), D_MODEL ** -0.5),
        "ffn2_w_out": nrm(ks[25], (DEPTH, D_FF, D_MODEL), D_FF ** -0.5),
        "final_norm": gain(ks[26], (D_MODEL,)),
    }


def reference(x_prompt, x_sample, ffn1_norm, ffn1_w_in, ffn1_w_out, mix_norm, w_in,
              hy_conv_w, hy_conv_b, hy_filt_w1, hy_filt_b1, hy_filt_w2, hy_filt_b2,
              hy_filt_w3, hy_filt_freq, hy_skip, gqa_q_norm, gqa_k_norm, diff_lambda,
              diff_subln, rel_bias, w_branch, w_out, ffn2_norm, ffn2_w_in, ffn2_w_out,
              final_norm):
    params = {
        "ffn1_norm": ffn1_norm, "ffn1_w_in": ffn1_w_in, "ffn1_w_out": ffn1_w_out,
        "mix_norm": mix_norm, "w_in": w_in,
        "hy_conv_w": hy_conv_w, "hy_conv_b": hy_conv_b,
        "hy_filt_w1": hy_filt_w1, "hy_filt_b1": hy_filt_b1, "hy_filt_w2": hy_filt_w2,
        "hy_filt_b2": hy_filt_b2, "hy_filt_w3": hy_filt_w3, "hy_filt_freq": hy_filt_freq,
        "hy_skip": hy_skip, "gqa_q_norm": gqa_q_norm, "gqa_k_norm": gqa_k_norm,
        "diff_lambda": diff_lambda, "diff_subln": diff_subln, "rel_bias": rel_bias,
        "w_branch": w_branch, "w_out": w_out,
        "ffn2_norm": ffn2_norm, "ffn2_w_in": ffn2_w_in, "ffn2_w_out": ffn2_w_out,
        "final_norm": final_norm,
    }
    y_prompt = encoder_trunk(x_prompt, params)
    y_sample = encoder_trunk(x_sample, params)
    return (y_prompt, y_sample)
```

```cpp
#include <hip/hip_runtime.h>
#include <hip/hip_cooperative_groups.h>
#include <stdint.h>
#include <cstdio>
namespace cg = cooperative_groups;

typedef unsigned short u16;
typedef __attribute__((ext_vector_type(8))) short bf16x8;
typedef __attribute__((ext_vector_type(16))) float f32x16;
typedef __attribute__((ext_vector_type(4))) float f32x4;
typedef __attribute__((ext_vector_type(4))) unsigned u32x4;
typedef __attribute__((ext_vector_type(2))) unsigned u32x2;
typedef __attribute__((ext_vector_type(2))) __bf16 bf2_t;
typedef __attribute__((ext_vector_type(2))) float f2_t;
#define DI __device__ __forceinline__
#define MFMA(a, b, c) __builtin_amdgcn_mfma_f32_32x32x16_bf16((a), (b), (c), 0, 0, 0)

constexpr int DM = 1024, DFF = 2816, INC = 6912, TCH = 16384, NTOK = 49152;
constexpr int OFF_GQ = 1536, OFF_GK = 2048, OFF_GV = 2176, OFF_DQ = 2304, OFF_DK = 2816, OFF_DV = 3328, OFF_GATE = 3840;
constexpr float LOG2E = 1.4426950408889634f;

constexpr size_t SZ_F1IN = (size_t)5632 * 1024 * 2, SZ_F1OUT = (size_t)1024 * 2816 * 2, SZ_WIN = (size_t)6912 * 1024 * 2,
                 SZ_WBR = (size_t)3 * 1024 * 512 * 2, SZ_WOUT = (size_t)1024 * 1024 * 2;
constexpr size_t O_F1IN = 0, O_F1OUT = O_F1IN + SZ_F1IN, O_WIN = O_F1OUT + SZ_F1OUT, O_WBR = O_WIN + SZ_WIN, O_WOUT = O_WBR + SZ_WBR,
                 O_F2IN = O_WOUT + SZ_WOUT, O_F2OUT = O_F2IN + SZ_F1IN, O_FILT8 = O_F2OUT + SZ_F1OUT,
                 O_FILT16 = O_FILT8 + (size_t)512 * 16384 * 2, O_MISC = O_FILT16 + (size_t)512 * 32768 * 2,
                 O_P = O_MISC + 65536, O_HN = O_P + (size_t)TCH * INC * 2, O_ZT = O_HN + (size_t)TCH * 1024 * 2,
                 O_YT = O_ZT + (size_t)TCH * 512 * 2, O_DIFFO = O_YT + (size_t)TCH * 512 * 2, O_VTG = O_DIFFO + (size_t)TCH * 1024 * 2,
                 O_VTD = O_VTG + (size_t)TCH * 128 * 2, O_YHY = O_VTD + (size_t)TCH * 512 * 2, O_YGQ = O_YHY + (size_t)TCH * 512 * 2,
                 O_YDF = O_YGQ + (size_t)TCH * 512 * 2, O_END = O_YDF + (size_t)TCH * 512 * 2;
static_assert(O_END <= (size_t)536870912, "workspace overflow");
constexpr int SMEM_BYTES = 61440;

struct Params {
  const float* x_prompt; const float* x_sample;
  const float* ffn1_norm; const float* ffn1_w_in; const float* ffn1_w_out; const float* mix_norm; const float* w_in;
  const float* hy_conv_w; const float* hy_conv_b; const float* hy_w1; const float* hy_b1; const float* hy_w2; const float* hy_b2;
  const float* hy_w3; const float* hy_freq; const float* hy_skip;
  const float* gqa_q_norm; const float* gqa_k_norm; const float* diff_lambda; const float* diff_subln; const float* rel_bias;
  const float* w_branch; const float* w_out; const float* ffn2_norm; const float* ffn2_w_in; const float* ffn2_w_out; const float* final_norm;
  float* out; char* ws;
};

DI unsigned pack2(float a, float b) { f2_t v = {a, b}; bf2_t r = __builtin_convertvector(v, bf2_t); return __builtin_bit_cast(unsigned, r); }
DI u16 f2bf(float a) { return (u16)(pack2(a, 0.f) & 0xffffu); }
DI float bf2f(u16 v) { return __uint_as_float(((unsigned)v) << 16); }
DI float bflo(unsigned v) { return __uint_as_float(v << 16); }
DI float bfhi(unsigned v) { return __uint_as_float(v & 0xffff0000u); }
DI int otid() { int t = threadIdx.x; asm volatile("" : "+v"(t)); return t; }
DI int crow(int reg, int h) { return (reg & 3) + 8 * (reg >> 2) + 4 * h; }
DI float wave_sum(float v) {
  v += __shfl_xor(v, 32); v += __shfl_xor(v, 16); v += __shfl_xor(v, 8); v += __shfl_xor(v, 4); v += __shfl_xor(v, 2); v += __shfl_xor(v, 1);
  return v;
}
DI float half_sum(float v) {
  v += __shfl_xor(v, 16); v += __shfl_xor(v, 8); v += __shfl_xor(v, 4); v += __shfl_xor(v, 2); v += __shfl_xor(v, 1);
  return v;
}

DI void convT_tile(const float* __restrict__ src, int K, int N, u16* __restrict__ dst, int kt, int nt, int perm_half, char* smem) {
  float* t = (float*)smem;
  const int tid = otid();
  __syncthreads();
  {
    const int col = tid & 63, r0 = tid >> 6;
#pragma unroll
    for (int i = 0; i < 16; ++i) { int row = r0 + 4 * i; t[row * 65 + col] = src[(size_t)(kt * 64 + row) * N + nt * 64 + col]; }
  }
  __syncthreads();
  {
    const int nl = tid >> 2, kq = tid & 3;
    int n = nt * 64 + nl;
    if (perm_half > 0) { if (n < perm_half) n = (n >> 5) * 64 + (n & 31); else { int j = n - perm_half; n = (j >> 5) * 64 + 32 + (j & 31); } }
    u32x4 o0, o1;
#pragma unroll
    for (int i = 0; i < 4; ++i) {
      o0[i] = pack2(t[(kq * 16 + 2 * i) * 65 + nl], t[(kq * 16 + 2 * i + 1) * 65 + nl]);
      o1[i] = pack2(t[(kq * 16 + 8 + 2 * i) * 65 + nl], t[(kq * 16 + 8 + 2 * i + 1) * 65 + nl]);
    }
    u16* d = dst + (size_t)n * K + kt * 64 + kq * 16;
    *(u32x4*)d = o0; *(u32x4*)(d + 8) = o1;
  }
}

DI void filter_item(const Params& P, int layer, int L, int tb, u16* __restrict__ G, char* smem) {
  float* h1 = (float*)smem;
  float* h2 = h1 + 64 * 65;
  const int tid = otid(), lane = tid & 63, w = tid >> 6;
  const float* w1 = P.hy_w1 + layer * 33 * 64; const float* b1 = P.hy_b1 + layer * 64;
  const float* w2 = P.hy_w2 + layer * 64 * 64; const float* b2 = P.hy_b2 + layer * 64;
  const float* w3 = P.hy_w3 + layer * 64 * 1024; const float* fr = P.hy_freq + layer * 64;
  const int t = tb * 64 + lane;
  const float tl = (float)t / (float)(L - 1);
  __syncthreads();
  {
    float a[16];
#pragma unroll
    for (int u = 0; u < 16; ++u) a[u] = b1[w * 16 + u] + tl * w1[w * 16 + u];
    const float base = (float)(2.0 * 3.14159265358979323846 / (double)L) * (float)t;
    for (int b = 0; b < 16; ++b) {
      const float band = 1e-4f + (float)b * ((15.0f - 1e-4f) / 15.0f);
      const float ang = base * band;
      const float cs = cosf(ang), sn = -sinf(ang);
#pragma unroll
      for (int u = 0; u < 16; ++u) a[u] += cs * w1[(1 + b) * 64 + w * 16 + u] + sn * w1[(17 + b) * 64 + w * 16 + u];
    }
#pragma unroll
    for (int u = 0; u < 16; ++u) h1[lane * 65 + w * 16 + u] = sinf(fr[w * 16 + u] * a[u]);
  }
  __syncthreads();
  {
    float a[16];
#pragma unroll
    for (int u = 0; u < 16; ++u) a[u] = b2[w * 16 + u];
    for (int k = 0; k < 64; ++k) {
      const float hv = h1[lane * 65 + k];
#pragma unroll
      for (int u = 0; u < 16; ++u) a[u] += hv * w2[k * 64 + w * 16 + u];
    }
#pragma unroll
    for (int u = 0; u < 16; ++u) h2[lane * 65 + w * 16 + u] = sinf(fr[w * 16 + u] * a[u]);
  }
  __syncthreads();
  const float min_decay = -3.0701134573253946f, max_decay = -15.350567286626973f;
  for (int og = 0; og < 64; ++og) {
    const int o = w * 256 + og * 4;
    float a0 = 0.f, a1 = 0.f, a2 = 0.f, a3 = 0.f;
#pragma unroll 4
    for (int k = 0; k < 64; ++k) {
      const float hv = h2[lane * 65 + k];
      const f32x4 wv = *(const f32x4*)(w3 + k * 1024 + o);
      a0 += hv * wv[0]; a1 += hv * wv[1]; a2 += hv * wv[2]; a3 += hv * wv[3];
    }
    float av[4] = {a0, a1, a2, a3};
#pragma unroll
    for (int q = 0; q < 4; ++q) {
      const int oo = o + q; const int ch = oo & 511;
      const float delta = min_decay + (float)ch * ((max_decay - min_decay) / 511.0f);
      const float val = av[q] * expf(-tl * fabsf(delta));
      u16* Gc = G + (size_t)ch * (2 * L);
      if (oo < 512) Gc[L - t] = f2bf(val);
      else { if (t >= 1) Gc[L + t] = f2bf(val); else Gc[0] = 0; }
    }
  }
}

DI void norm_row_bf16(const float* __restrict__ x, const float* __restrict__ g, u16* __restrict__ out, int lane) {
  f32x4 v[4]; float ss = 0.f;
#pragma unroll
  for (int i = 0; i < 4; ++i) { v[i] = *(const f32x4*)(x + lane * 4 + 256 * i); ss += v[i][0] * v[i][0] + v[i][1] * v[i][1] + v[i][2] * v[i][2] + v[i][3] * v[i][3]; }
  ss = wave_sum(ss);
  const float rs = rsqrtf(ss * (1.0f / 1024.0f) + 1e-6f);
#pragma unroll
  for (int i = 0; i < 4; ++i) {
    const f32x4 gg = *(const f32x4*)(g + lane * 4 + 256 * i);
    u32x2 o; o[0] = pack2(v[i][0] * rs * gg[0], v[i][1] * rs * gg[1]); o[1] = pack2(v[i][2] * rs * gg[2], v[i][3] * rs * gg[3]);
    *(u32x2*)(out + lane * 4 + 256 * i) = o;
  }
}
DI void norm_row_f32_inplace(float* __restrict__ x, const float* __restrict__ g, int lane) {
  f32x4 v[4]; float ss = 0.f;
#pragma unroll
  for (int i = 0; i < 4; ++i) { v[i] = *(const f32x4*)(x + lane * 4 + 256 * i); ss += v[i][0] * v[i][0] + v[i][1] * v[i][1] + v[i][2] * v[i][2] + v[i][3] * v[i][3]; }
  ss = wave_sum(ss);
  const float rs = rsqrtf(ss * (1.0f / 1024.0f) + 1e-6f);
#pragma unroll
  for (int i = 0; i < 4; ++i) {
    const f32x4 gg = *(const f32x4*)(g + lane * 4 + 256 * i);
    f32x4 o; o[0] = v[i][0] * rs * gg[0]; o[1] = v[i][1] * rs * gg[1]; o[2] = v[i][2] * rs * gg[2]; o[3] = v[i][3] * rs * gg[3];
    *(f32x4*)(x + lane * 4 + 256 * i) = o;
  }
}

struct GemmArgs {
  const u16* A; int lda; const u16* Bt; int ldb; int K;
  u16* outb; int ldo; const float* xin; float* xout; float scale; const u16* gate; float* macc; int br;
};
enum { EPI_SWIGLU = 0, EPI_RESID = 1, EPI_PROJ = 2, EPI_MERGE = 3 };

template <int MODE>
DI void gemm_tile(const GemmArgs& g, int mt, int nt, char* smem) {
  const int tid = otid(), lane = tid & 63, w = tid >> 6, wm = w >> 1, wn = w & 1, r = lane & 31, h = lane >> 5;
  u16* As = (u16*)smem;
  u16* Bs = As + 2 * 256 * 40;
  const int m0 = mt * 256, n0 = nt * 128;
  f32x16 acc[4][2];
#pragma unroll
  for (int i = 0; i < 4; ++i)
#pragma unroll
    for (int j = 0; j < 2; ++j)
#pragma unroll
      for (int q = 0; q < 16; ++q) acc[i][j][q] = 0.f;
  const int lrow = tid >> 2, lcc = tid & 3;
  const u16* Ag = g.A + (size_t)(m0 + lrow) * g.lda + lcc * 8;
  const u16* Bg = g.Bt + (size_t)(n0 + lrow) * g.ldb + lcc * 8;
  u32x4 ra[4], rb[2];
  __syncthreads();
#pragma unroll
  for (int i = 0; i < 4; ++i) ra[i] = *(const u32x4*)(Ag + (size_t)(64 * i) * g.lda);
#pragma unroll
  for (int i = 0; i < 2; ++i) rb[i] = *(const u32x4*)(Bg + (size_t)(64 * i) * g.ldb);
#pragma unroll
  for (int i = 0; i < 4; ++i) *(u32x4*)(As + (lrow + 64 * i) * 40 + lcc * 8) = ra[i];
#pragma unroll
  for (int i = 0; i < 2; ++i) *(u32x4*)(Bs + (lrow + 64 * i) * 40 + lcc * 8) = rb[i];
  __syncthreads();
  const int nk = g.K >> 5;
  for (int kt = 0; kt < nk; ++kt) {
    const int buf = kt & 1;
    if (kt + 1 < nk) {
      const int k0 = (kt + 1) * 32;
#pragma unroll
      for (int i = 0; i < 4; ++i) ra[i] = *(const u32x4*)(Ag + (size_t)(64 * i) * g.lda + k0);
#pragma unroll
      for (int i = 0; i < 2; ++i) rb[i] = *(const u32x4*)(Bg + (size_t)(64 * i) * g.ldb + k0);
    }
    const u16* Ab = As + buf * (256 * 40); const u16* Bb = Bs + buf * (128 * 40);
#pragma unroll
    for (int s = 0; s < 2; ++s) {
      bf16x8 af[4], bfr[2];
#pragma unroll
      for (int i = 0; i < 4; ++i) af[i] = *(const bf16x8*)(Ab + (wm * 128 + 32 * i + r) * 40 + 16 * s + 8 * h);
#pragma unroll
      for (int j = 0; j < 2; ++j) bfr[j] = *(const bf16x8*)(Bb + (wn * 64 + 32 * j + r) * 40 + 16 * s + 8 * h);
#pragma unroll
      for (int i = 0; i < 4; ++i)
#pragma unroll
        for (int j = 0; j < 2; ++j) acc[i][j] = MFMA(af[i], bfr[j], acc[i][j]);
    }
    if (kt + 1 < nk) {
      u16* Aw = As + (buf ^ 1) * (256 * 40); u16* Bw = Bs + (buf ^ 1) * (128 * 40);
#pragma unroll
      for (int i = 0; i < 4; ++i) *(u32x4*)(Aw + (lrow + 64 * i) * 40 + lcc * 8) = ra[i];
#pragma unroll
      for (int i = 0; i < 2; ++i) *(u32x4*)(Bw + (lrow + 64 * i) * 40 + lcc * 8) = rb[i];
    }
    __syncthreads();
  }
  const int rb0 = m0 + wm * 128, cb0 = n0 + wn * 64;
  if (MODE == EPI_SWIGLU) {
    const int hc = (cb0 >> 1) + r;
#pragma unroll
    for (int i = 0; i < 4; ++i)
#pragma unroll
      for (int q = 0; q < 16; ++q) {
        const int row = rb0 + 32 * i + crow(q, h);
        const float gv = acc[i][0][q], uv = acc[i][1][q];
        g.outb[(size_t)row * g.ldo + hc] = f2bf(gv / (1.0f + __expf(-gv)) * uv);
      }
  } else if (MODE == EPI_RESID) {
#pragma unroll
    for (int i = 0; i < 4; ++i)
#pragma unroll
      for (int j = 0; j < 2; ++j)
#pragma unroll
        for (int q = 0; q < 16; ++q) {
          const size_t idx = (size_t)(rb0 + 32 * i + crow(q, h)) * DM + cb0 + 32 * j + r;
          g.xout[idx] = g.xin[idx] + g.scale * acc[i][j][q];
        }
  } else if (MODE == EPI_PROJ) {
    const bool sg = (n0 >= OFF_GATE);
#pragma unroll
    for (int i = 0; i < 4; ++i)
#pragma unroll
      for (int j = 0; j < 2; ++j)
#pragma unroll
        for (int q = 0; q < 16; ++q) {
          const size_t idx = (size_t)(rb0 + 32 * i + crow(q, h)) * g.ldo + cb0 + 32 * j + r;
          float v = acc[i][j][q];
          if (sg) v = 1.0f / (1.0f + __expf(-v));
          g.outb[idx] = f2bf(v);
        }
  } else {
#pragma unroll
    for (int i = 0; i < 4; ++i)
#pragma unroll
      for (int j = 0; j < 2; ++j)
#pragma unroll
        for (int q = 0; q < 16; ++q) {
          const int row = rb0 + 32 * i + crow(q, h), col = cb0 + 32 * j + r;
          const float gt = bf2f(g.gate[(size_t)row * INC + OFF_GATE + g.br * DM + col]);
          float v = gt * acc[i][j][q];
          const size_t idx = (size_t)row * DM + col;
          if (g.br > 0) v += g.macc[idx];
          if (g.br < 2) g.macc[idx] = v; else g.outb[idx] = f2bf(v);
        }
  }
}

DI void qk_prep_item(const Params& P, int layer, u16* __restrict__ p, int L, int it) {
  const int tid = otid(), lane = tid & 63, w = tid >> 6;
  const int u = it * 8 + w * 2 + (lane >> 5);
  const int tok = u / 10, hd = u - tok * 10;
  const int i = lane & 31;
  const int col0 = (hd < 8) ? (OFF_GQ + hd * 64) : (OFF_GK + (hd - 8) * 64);
  const float* gn = (hd < 8) ? (P.gqa_q_norm + layer * 64) : (P.gqa_k_norm + layer * 64);
  unsigned* ptr = (unsigned*)(p + (size_t)tok * INC + col0) + i;
  const unsigned v = *ptr;
  float a = bflo(v), b = bfhi(v);
  const float ss = half_sum(a * a + b * b);
  const float rs = rsqrtf(ss * (1.0f / 64.0f) + 1e-6f);
  a = a * rs * gn[2 * i]; b = b * rs * gn[2 * i + 1];
  const int tl = tok % L;
  const float pos = (i < 16) ? (float)(tl >> 6) : (float)(tl & 63);
  const int jj = i & 15;
  const float inv = powf(10000.0f, -(float)(2 * jj) / 32.0f);
  const float ang = pos * inv;
  const float c = cosf(ang), s = sinf(ang);
  *ptr = pack2(a * c - b * s, a * s + b * c);
}

DI void transpose_item(const Params& P, int layer, const u16* __restrict__ p, int L, int kind, int ct, int tt, u16* __restrict__ dst, char* smem) {
  u16* tile = (u16*)smem;
  const int tid = otid();
  const int t0 = tt * 64;
  const int seq = t0 / L, tl0 = t0 - seq * L;
  const int C = (kind == 0) ? 128 : 512;
  __syncthreads();
  {
    const int col = tid & 63, r0 = tid >> 6;
    const int cidx = ct * 64 + col;
    if (kind < 2) {
      const int off = (kind == 0 ? OFF_GV : OFF_DV) + cidx;
#pragma unroll
      for (int i = 0; i < 16; ++i) { const int row = r0 + 4 * i; tile[col * 72 + row] = p[(size_t)(t0 + row) * INC + off]; }
    } else {
      const float* cw = P.hy_conv_w + layer * 3 * 1536; const float* cb = P.hy_conv_b + layer * 1536;
      const int c1 = 512 + cidx, c2 = 1024 + cidx;
      const float w10 = cw[c1], w11 = cw[1536 + c1], w12 = cw[3072 + c1], b1 = cb[c1];
      const float w20 = cw[c2], w21 = cw[1536 + c2], w22 = cw[3072 + c2], b2 = cb[c2];
#pragma unroll
      for (int i = 0; i < 16; ++i) {
        const int row = r0 + 4 * i; const int tl = tl0 + row;
        const u16* pr = p + (size_t)(t0 + row) * INC;
        const float xm1 = (tl > 0) ? bf2f(pr[c1 - INC]) : 0.f, x0 = bf2f(pr[c1]), xp1 = (tl < L - 1) ? bf2f(pr[c1 + INC]) : 0.f;
        const float vm1 = (tl > 0) ? bf2f(pr[c2 - INC]) : 0.f, v0 = bf2f(pr[c2]), vp1 = (tl < L - 1) ? bf2f(pr[c2 + INC]) : 0.f;
        const float x1c = xm1 * w10 + x0 * w11 + xp1 * w12 + b1;
        const float vc = vm1 * w20 + v0 * w21 + vp1 * w22 + b2;
        tile[col * 72 + row] = f2bf(vc * x1c);
      }
    }
  }
  __syncthreads();
  {
    const int c = tid >> 2, q = tid & 3;
    const u32x4 a = *(const u32x4*)(tile + c * 72 + q * 16), b = *(const u32x4*)(tile + c * 72 + q * 16 + 8);
    u16* d = dst + ((size_t)seq * C + ct * 64 + c) * L + tl0 + q * 16;
    *(u32x4*)d = a; *(u32x4*)(d + 8) = b;
  }
}

template <int DV, bool BIAS>
DI void attn_tile(const u16* __restrict__ Qp, const u16* __restrict__ Kp, const u16* __restrict__ VTp, int L,
                  u16* __restrict__ Op, int ldo, int q0, const float* __restrict__ btab, char* smem) {
  constexpr int NDT = DV / 32;
  constexpr int VCH = DV / 32;
  constexpr int KS_SZ = 64 * 72, VS_SZ = DV * 68;
  u16* Ks = (u16*)smem;
  u16* Vs = Ks + 2 * KS_SZ;
  float* bt = (float*)(Vs + 2 * VS_SZ);
  const int tid = otid(), lane = tid & 63, w = tid >> 6, r = lane & 31, h = lane >> 5;
  const float sc = 0.125f * LOG2E;
  __syncthreads();
  if (BIAS) { for (int i = tid; i < 257; i += 256) bt[i] = btab[i]; }
  bf16x8 qf[4];
  {
    const u16* qrow = Qp + (size_t)(q0 + 32 * w + r) * INC + 8 * h;
#pragma unroll
    for (int s = 0; s < 4; ++s) qf[s] = *(const bf16x8*)(qrow + 16 * s);
  }
  const int qpos = q0 + 32 * w + r;
  f32x16 O[NDT];
#pragma unroll
  for (int d = 0; d < NDT; ++d)
#pragma unroll
    for (int q = 0; q < 16; ++q) O[d][q] = 0.f;
  float m = -INFINITY, l = 0.f;
  const int lrow = tid >> 3, lcc = tid & 7;
  u32x4 rk[2], rv[VCH];
  const u16* Kg = Kp + (size_t)lrow * INC + lcc * 8;
  const u16* Vg = VTp + (size_t)lrow * L + lcc * 8;
#pragma unroll
  for (int i = 0; i < 2; ++i) rk[i] = *(const u32x4*)(Kg + (size_t)(32 * i) * INC);
#pragma unroll
  for (int i = 0; i < VCH; ++i) rv[i] = *(const u32x4*)(Vg + (size_t)(32 * i) * L);
#pragma unroll
  for (int i = 0; i < 2; ++i) *(u32x4*)(Ks + (lrow + 32 * i) * 72 + lcc * 8) = rk[i];
#pragma unroll
  for (int i = 0; i < VCH; ++i) {
    u16* d = Vs + (lrow + 32 * i) * 68 + lcc * 8;
    u32x2 lo, hi; lo[0] = rv[i][0]; lo[1] = rv[i][1]; hi[0] = rv[i][2]; hi[1] = rv[i][3];
    *(u32x2*)d = lo; *(u32x2*)(d + 4) = hi;
  }
  __syncthreads();
  const int nkb = L >> 6;
  for (int kb = 0; kb < nkb; ++kb) {
    const int buf = kb & 1;
    if (kb + 1 < nkb) {
      const size_t ko = (size_t)(kb + 1) * 64;
#pragma unroll
      for (int i = 0; i < 2; ++i) rk[i] = *(const u32x4*)(Kg + (ko + 32 * i) * INC);
#pragma unroll
      for (int i = 0; i < VCH; ++i) rv[i] = *(const u32x4*)(Vg + (size_t)(32 * i) * L + ko);
    }
    const u16* Kb = Ks + buf * KS_SZ; const u16* Vb = Vs + buf * VS_SZ;
    f32x16 S[2];
#pragma unroll
    for (int kt = 0; kt < 2; ++kt) {
#pragma unroll
      for (int q = 0; q < 16; ++q) S[kt][q] = 0.f;
#pragma unroll
      for (int s = 0; s < 4; ++s) {
        const bf16x8 a = *(const bf16x8*)(Kb + (32 * kt + r) * 72 + 16 * s + 8 * h);
        S[kt] = MFMA(a, qf[s], S[kt]);
      }
    }
    if (BIAS) {
      const int kmin = kb * 64;
      if (kmin - (q0 + 127) >= 128) {
        const float cb = bt[256];
#pragma unroll
        for (int kt = 0; kt < 2; ++kt)
#pragma unroll
          for (int q = 0; q < 16; ++q) S[kt][q] = S[kt][q] * sc + cb;
      } else if (q0 - (kmin + 63) >= 128) {
        const float cb = bt[0];
#pragma unroll
        for (int kt = 0; kt < 2; ++kt)
#pragma unroll
          for (int q = 0; q < 16; ++q) S[kt][q] = S[kt][q] * sc + cb;
      } else {
#pragma unroll
        for (int kt = 0; kt < 2; ++kt)
#pragma unroll
          for (int q = 0; q < 16; ++q) {
            int rel = kmin + 32 * kt + crow(q, h) - qpos;
            rel = rel < -128 ? -128 : (rel > 128 ? 128 : rel);
            S[kt][q] = S[kt][q] * sc + bt[rel + 128];
          }
      }
    } else {
#pragma unroll
      for (int kt = 0; kt < 2; ++kt)
#pragma unroll
        for (int q = 0; q < 16; ++q) S[kt][q] *= sc;
    }
    float mx = S[0][0];
#pragma unroll
    for (int kt = 0; kt < 2; ++kt)
#pragma unroll
      for (int q = 0; q < 16; ++q) mx = fmaxf(mx, S[kt][q]);
    mx = fmaxf(mx, __shfl_xor(mx, 32));
    const float mn = fmaxf(m, mx);
    const float alpha = __builtin_amdgcn_exp2f(m - mn);
    m = mn;
    l *= alpha;
#pragma unroll
    for (int d = 0; d < NDT; ++d)
#pragma unroll
      for (int q = 0; q < 16; ++q) O[d][q] *= alpha;
    bf16x8 pf[2][2];
#pragma unroll
    for (int kt = 0; kt < 2; ++kt) {
#pragma unroll
      for (int q = 0; q < 16; ++q) { const float pv = __builtin_amdgcn_exp2f(S[kt][q] - mn); S[kt][q] = pv; l += pv; }
#pragma unroll
      for (int s = 0; s < 2; ++s) {
        u32x4 pk;
#pragma unroll
        for (int q = 0; q < 4; ++q) pk[q] = pack2(S[kt][8 * s + 2 * q], S[kt][8 * s + 2 * q + 1]);
        pf[kt][s] = __builtin_bit_cast(bf16x8, pk);
      }
    }
#pragma unroll
    for (int kt = 0; kt < 2; ++kt)
#pragma unroll
      for (int s = 0; s < 2; ++s)
#pragma unroll
        for (int d = 0; d < NDT; ++d) {
          const u16* vp = Vb + (32 * d + r) * 68 + 32 * kt + 16 * s + 4 * h;
          const u32x2 lo = *(const u32x2*)vp, hi = *(const u32x2*)(vp + 8);
          u32x4 av; av[0] = lo[0]; av[1] = lo[1]; av[2] = hi[0]; av[3] = hi[1];
          O[d] = MFMA(__builtin_bit_cast(bf16x8, av), pf[kt][s], O[d]);
        }
    if (kb + 1 < nkb) {
      u16* Kw = Ks + (buf ^ 1) * KS_SZ; u16* Vw = Vs + (buf ^ 1) * VS_SZ;
#pragma unroll
      for (int i = 0; i < 2; ++i) *(u32x4*)(Kw + (lrow + 32 * i) * 72 + lcc * 8) = rk[i];
#pragma unroll
      for (int i = 0; i < VCH; ++i) {
        u16* d = Vw + (lrow + 32 * i) * 68 + lcc * 8;
        u32x2 lo, hi; lo[0] = rv[i][0]; lo[1] = rv[i][1]; hi[0] = rv[i][2]; hi[1] = rv[i][3];
        *(u32x2*)d = lo; *(u32x2*)(d + 4) = hi;
      }
    }
    __syncthreads();
  }
  l += __shfl_xor(l, 32);
  const float inv = 1.0f / l;
  u16* orow = Op + (size_t)qpos * ldo;
#pragma unroll
  for (int d = 0; d < NDT; ++d)
#pragma unroll
    for (int g4 = 0; g4 < 4; ++g4) {
      u32x2 o; o[0] = pack2(O[d][4 * g4] * inv, O[d][4 * g4 + 1] * inv); o[1] = pack2(O[d][4 * g4 + 2] * inv, O[d][4 * g4 + 3] * inv);
      *(u32x2*)(orow + 32 * d + 8 * g4 + 4 * h) = o;
    }
}

DI void hyena_item(int c, const u16* __restrict__ G, const u16* __restrict__ zT, u16* __restrict__ yT, int nseq, int L, char* smem) {
  u16* zs = (u16*)smem;
  u16* fw = zs + 20480;
  const int tid = otid(), lane = tid & 63, w = tid >> 6, r = lane & 31, h = lane >> 5;
  const int ZL = L + 2048;
  __syncthreads();
  for (int q = 0; q < nseq; ++q) {
    const u16* src = zT + ((size_t)q * 512 + c) * L;
    u16* dst = zs + q * ZL;
    const u32x4 zero = {0u, 0u, 0u, 0u};
    for (int i = tid; i < 128; i += 256) { *(u32x4*)(dst + i * 8) = zero; *(u32x4*)(dst + 1024 + L + i * 8) = zero; }
    for (int i = tid; i < (L >> 3); i += 256) *(u32x4*)(dst + 1024 + i * 8) = *(const u32x4*)(src + i * 8);
  }
  int tq[4], tJ[4];
#pragma unroll
  for (int i = 0; i < 4; ++i) { if (nseq == 2) { tq[i] = i & 1; tJ[i] = 2 * w + (i >> 1); } else { tq[i] = 0; tJ[i] = 4 * w + i; } }
  f32x16 acc[4];
#pragma unroll
  for (int i = 0; i < 4; ++i)
#pragma unroll
    for (int q = 0; q < 16; ++q) acc[i][q] = 0.f;
  const int E0 = -L + 16, ELAST = L - 32;
  const int npass = (2 * L - 32 + 8191) / 8192;
  const u16* Gc = G + (size_t)c * (2 * L);
  for (int ps = 0; ps < npass; ++ps) {
    const int ea = E0 + 8192 * ps, eb = ea + 8192;
    const int wb = L - eb - 16;
    __syncthreads();
    for (int i = tid; i < 1032; i += 256) {
      const int gi = wb + i * 8;
      u32x4 v = {0u, 0u, 0u, 0u};
      if (gi >= 0 && gi < 2 * L) v = *(const u32x4*)(Gc + gi);
      *(u32x4*)(fw + i * 8) = v;
    }
    __syncthreads();
    const int eend = (eb - 16 < ELAST) ? (eb - 16) : ELAST;
    for (int e = ea; e <= eend; e += 16) {
      bool in[4]; bool any = false;
#pragma unroll
      for (int i = 0; i < 4; ++i) { in[i] = (e >= 1024 * tJ[i] - L + 16) && (e <= 1024 * tJ[i] + 992); any = any || in[i]; }
      if (!any) continue;
      const int idx0 = L - e - r + 8 * h - wb;
      bf16x8 a;
#pragma unroll
      for (int j = 0; j < 8; ++j) a[j] = (short)fw[idx0 + j];
#pragma unroll
      for (int i = 0; i < 4; ++i) {
        if (in[i]) {
          const bf16x8 b = *(const bf16x8*)(zs + tq[i] * ZL + 1024 + 1024 * tJ[i] + 32 * r - e + 8 * h);
          acc[i] = MFMA(a, b, acc[i]);
        }
      }
    }
  }
#pragma unroll
  for (int i = 0; i < 4; ++i) {
    u16* dst = yT + ((size_t)tq[i] * 512 + c) * L + 1024 * tJ[i] + 32 * r + 4 * h;
#pragma unroll
    for (int g4 = 0; g4 < 4; ++g4) {
      u32x2 o; o[0] = pack2(acc[i][4 * g4], acc[i][4 * g4 + 1]); o[1] = pack2(acc[i][4 * g4 + 2], acc[i][4 * g4 + 3]);
      *(u32x2*)(dst + 8 * g4) = o;
    }
  }
}

DI void diff_post_item(const Params& P, int layer, float lam, float lam_init, const u16* __restrict__ dO, u16* __restrict__ ydf, int it) {
  const int tid = otid(), lane = tid & 63, w = tid >> 6;
  const int u = it * 8 + w * 2 + (lane >> 5);
  const int i = lane & 31;
  const u32x2 a = *(const u32x2*)(dO + (size_t)u * 256 + 4 * i);
  const u32x2 b = *(const u32x2*)(dO + (size_t)u * 256 + 128 + 4 * i);
  float o[4];
  o[0] = bflo(a[0]) - lam * bflo(b[0]); o[1] = bfhi(a[0]) - lam * bfhi(b[0]);
  o[2] = bflo(a[1]) - lam * bflo(b[1]); o[3] = bfhi(a[1]) - lam * bfhi(b[1]);
  const float ss = half_sum(o[0] * o[0] + o[1] * o[1] + o[2] * o[2] + o[3] * o[3]);
  const float rs = rsqrtf(ss * (1.0f / 128.0f) + 1e-5f) * (1.0f - lam_init);
  const float* g = P.diff_subln + layer * 128 + 4 * i;
  u32x2 ov; ov[0] = pack2(o[0] * rs * g[0], o[1] * rs * g[1]); ov[1] = pack2(o[2] * rs * g[2], o[3] * rs * g[3]);
  *(u32x2*)(ydf + (size_t)u * 128 + 4 * i) = ov;
}
DI void hyena_post_item(const Params& P, int layer, const u16* __restrict__ p, int L, const u16* __restrict__ yT, const u16* __restrict__ zT,
                        int ct, int tt, u16* __restrict__ yhy, char* smem) {
  float* tile = (float*)smem;
  const int tid = otid();
  const int t0 = tt * 64; const int seq = t0 / L, tl0 = t0 - seq * L;
  __syncthreads();
  {
    const int tcol = tid & 63, c0 = tid >> 6;
#pragma unroll
    for (int i = 0; i < 16; ++i) {
      const int cc = c0 + 4 * i; const int c = ct * 64 + cc;
      const size_t gi = ((size_t)seq * 512 + c) * L + tl0 + tcol;
      tile[cc * 65 + tcol] = bf2f(yT[gi]) + bf2f(zT[gi]) * P.hy_skip[layer * 512 + c];
    }
  }
  __syncthreads();
  {
    const int col = tid & 63, r0 = tid >> 6; const int c = ct * 64 + col;
    const float* cw = P.hy_conv_w + layer * 3 * 1536; const float* cb = P.hy_conv_b + layer * 1536;
    const float w0 = cw[c], w1 = cw[1536 + c], w2 = cw[3072 + c], b0 = cb[c];
#pragma unroll
    for (int i = 0; i < 16; ++i) {
      const int row = r0 + 4 * i; const int tl = tl0 + row;
      const u16* pr = p + (size_t)(t0 + row) * INC + c;
      const float xm1 = (tl > 0) ? bf2f(pr[-INC]) : 0.f, x0 = bf2f(pr[0]), xp1 = (tl < L - 1) ? bf2f(pr[INC]) : 0.f;
      const float x0c = xm1 * w0 + x0 * w1 + xp1 * w2 + b0;
      yhy[(size_t)(t0 + row) * 512 + c] = f2bf(x0c * tile[col * 65 + row]);
    }
  }
}

__global__ void __launch_bounds__(256, 2) fwd_megakernel(Params P) {
  cg::grid_group grid = cg::this_grid();
  __shared__ __attribute__((aligned(16))) char smem[SMEM_BYTES];
  const int tid = threadIdx.x, lane = tid & 63, w = tid >> 6;
  const int nb = gridDim.x, bid = blockIdx.x;
  char* ws = P.ws;
  u16* Wf1in = (u16*)(ws + O_F1IN); u16* Wf1out = (u16*)(ws + O_F1OUT); u16* Win = (u16*)(ws + O_WIN); u16* Wbr = (u16*)(ws + O_WBR);
  u16* Wout = (u16*)(ws + O_WOUT); u16* Wf2in = (u16*)(ws + O_F2IN); u16* Wf2out = (u16*)(ws + O_F2OUT);
  u16* filt8 = (u16*)(ws + O_FILT8); u16* filt16 = (u16*)(ws + O_FILT16);
  float* misc = (float*)(ws + O_MISC);
  u16* pbuf = (u16*)(ws + O_P); u16* hid = pbuf; u16* hn = (u16*)(ws + O_HN); u16* merged = hn;
  u16* zT = (u16*)(ws + O_ZT); u16* yT = (u16*)(ws + O_YT); u16* dO = (u16*)(ws + O_DIFFO); float* macc = (float*)(ws + O_ZT);
  u16* vtg = (u16*)(ws + O_VTG); u16* vtd = (u16*)(ws + O_VTD);
  u16* yhy = (u16*)(ws + O_YHY); u16* ygq = (u16*)(ws + O_YGQ); u16* ydf = (u16*)(ws + O_YDF);

  for (int layer = 0; layer < 2; ++layer) {
    {
      const int n1 = 16 * 88, n2 = 44 * 16, n3 = 16 * 108, n4 = 3 * 8 * 16, n5 = 16 * 16;
      const int nconv = n1 + n2 + n3 + n4 + n5 + n1 + n2;
      const int nfilt = 128 + 256;
      const int total = nconv + nfilt + 1;
      for (int it = bid; it < total; it += nb) {
        int t = it;
        if (t < nfilt) {
          const bool big = t < 256;
          filter_item(P, layer, big ? 16384 : 8192, big ? t : t - 256, big ? filt16 : filt8, smem);
          continue;
        }
        t -= nfilt;
        if (t < n1) { convT_tile(P.ffn1_w_in + (size_t)layer * 1024 * 5632, 1024, 5632, Wf1in, t / 88, t % 88, 2816, smem); continue; } t -= n1;
        if (t < n2) { convT_tile(P.ffn1_w_out + (size_t)layer * 2816 * 1024, 2816, 1024, Wf1out, t / 16, t % 16, 0, smem); continue; } t -= n2;
        if (t < n3) { convT_tile(P.w_in + (size_t)layer * 1024 * 6912, 1024, 6912, Win, t / 108, t % 108, 0, smem); continue; } t -= n3;
        if (t < n4) { const int br = t / 128, tt = t % 128;
          convT_tile(P.w_branch + ((size_t)layer * 3 + br) * 512 * 1024, 512, 1024, Wbr + (size_t)br * 1024 * 512, tt / 16, tt % 16, 0, smem); continue; } t -= n4;
        if (t < n5) { convT_tile(P.w_out + (size_t)layer * 1024 * 1024, 1024, 1024, Wout, t / 16, t % 16, 0, smem); continue; } t -= n5;
        if (t < n1) { convT_tile(P.ffn2_w_in + (size_t)layer * 1024 * 5632, 1024, 5632, Wf2in, t / 88, t % 88, 2816, smem); continue; } t -= n1;
        if (t < n2) { convT_tile(P.ffn2_w_out + (size_t)layer * 2816 * 1024, 2816, 1024, Wf2out, t / 16, t % 16, 0, smem); continue; } t -= n2;
        if (tid < 2) {
          const float* lp = P.diff_lambda + tid * 256;
          float s1 = 0.f, s2 = 0.f;
          for (int i = 0; i < 64; ++i) { s1 += lp[i] * lp[64 + i]; s2 += lp[128 + i] * lp[192 + i]; }
          const float lam_init = 0.8f - 0.6f * expf(-0.3f * (float)tid);
          misc[tid] = expf(s1) - expf(s2) + lam_init;
        }
        for (int i = tid; i < 4 * 257; i += 256) {
          const int hh = i / 257, idx = i % 257; const int rel = idx - 128; const int n = rel < 0 ? -rel : rel;
          int b;
          if (n < 8) b = n; else { int lg = 8 + (int)(logf((float)n / 8.0f) / 2.772588722239781f * 8.0f); b = lg < 15 ? lg : 15; }
          if (rel > 0) b += 16;
          misc[64 + i] = P.rel_bias[b * 4 + hh] * LOG2E;
        }
      }
    }
    grid.sync();
    const float lam = misc[layer];
    const float lam_init = 0.8f - 0.6f * expf(-0.3f * (float)layer);

    for (int ch = 0; ch < 3; ++ch) {
      const int nseq = (ch < 2) ? 2 : 1, L = (ch < 2) ? 8192 : 16384;
      const float* xin0 = (ch < 2) ? (P.x_prompt + (size_t)ch * TCH * DM) : P.x_sample;
      float* xres = P.out + (size_t)ch * TCH * DM;
      const float* xcur = (layer == 0) ? xin0 : xres;
      const u16* filt = (ch < 2) ? filt8 : filt16;

      for (int it = bid; it < TCH / 4; it += nb) { const int row = it * 4 + w; norm_row_bf16(xcur + (size_t)row * DM, P.ffn1_norm + layer * DM, hn + (size_t)row * DM, lane); }
      grid.sync();
      { GemmArgs g{}; g.A = hn; g.lda = DM; g.Bt = Wf1in; g.ldb = DM; g.K = DM; g.outb = hid; g.ldo = DFF;
        for (int it = bid; it < 64 * 44; it += nb) gemm_tile<EPI_SWIGLU>(g, it / 44, it % 44, smem); }
      grid.sync();
      { GemmArgs g{}; g.A = hid; g.lda = DFF; g.Bt = Wf1out; g.ldb = DFF; g.K = DFF; g.xin = xcur; g.xout = xres; g.scale = 0.5f;
        for (int it = bid; it < 64 * 8; it += nb) gemm_tile<EPI_RESID>(g, it / 8, it % 8, smem); }
      grid.sync();
      for (int it = bid; it < TCH / 4; it += nb) { const int row = it * 4 + w; norm_row_bf16(xres + (size_t)row * DM, P.mix_norm + layer * DM, hn + (size_t)row * DM, lane); }
      grid.sync();
      { GemmArgs g{}; g.A = hn; g.lda = DM; g.Bt = Win; g.ldb = DM; g.K = DM; g.outb = pbuf; g.ldo = INC;
        for (int it = bid; it < 64 * 54; it += nb) gemm_tile<EPI_PROJ>(g, it / 54, it % 54, smem); }
      grid.sync();
      {
        const int nqk = TCH * 10 / 8, ntr = 256 * 18;
        for (int it = bid; it < nqk + ntr; it += nb) {
          if (it < nqk) { qk_prep_item(P, layer, pbuf, L, it); continue; }
          const int t = it - nqk; const int tt = t / 18, cc = t % 18;
          if (cc < 2) transpose_item(P, layer, pbuf, L, 0, cc, tt, vtg, smem);
          else if (cc < 10) transpose_item(P, layer, pbuf, L, 1, cc - 2, tt, vtd, smem);
          else transpose_item(P, layer, pbuf, L, 2, cc - 10, tt, zT, smem);
        }
      }
      grid.sync();
      {
        const int nqt = L / 128;
        const int ndiff = nseq * 8 * nqt, ngqa = nseq * 8 * nqt, nhy = 512;
        for (int it = bid; it < ndiff + ngqa + nhy; it += nb) {
          if (it < ndiff) {
            const int qt = it % nqt; const int hc = (it / nqt) & 7; const int seq = it / (nqt * 8);
            const int hh = hc >> 1, cc = hc & 1;
            const size_t tb = (size_t)seq * L;
            attn_tile<128, true>(pbuf + tb * INC + OFF_DQ + hc * 64, pbuf + tb * INC + OFF_DK + hc * 64,
                                 vtd + ((size_t)seq * 512 + hh * 128) * L, L,
                                 dO + tb * 1024 + (hh * 2 + cc) * 128, 1024, qt * 128, misc + 64 + hh * 257, smem);
          } else if (it < ndiff + ngqa) {
            const int t = it - ndiff;
            const int qt = t % nqt; const int hd = (t / nqt) & 7; const int seq = t / (nqt * 8);
            const int kvh = hd >> 2;
            const size_t tb = (size_t)seq * L;
            attn_tile<64, false>(pbuf + tb * INC + OFF_GQ + hd * 64, pbuf + tb * INC + OFF_GK + kvh * 64,
                                 vtg + ((size_t)seq * 128 + kvh * 64) * L, L,
                                 ygq + tb * 512 + hd * 64, 512, qt * 128, nullptr, smem);
          } else {
            hyena_item(it - ndiff - ngqa, filt, zT, yT, nseq, L, smem);
          }
        }
      }
      grid.sync();
      {
        const int ndp = TCH * 4 / 8, nhp = 256 * 8;
        for (int it = bid; it < ndp + nhp; it += nb) {
          if (it < ndp) diff_post_item(P, layer, lam, lam_init, dO, ydf, it);
          else { const int t = it - ndp; hyena_post_item(P, layer, pbuf, L, yT, zT, t % 8, t / 8, yhy, smem); }
        }
      }
      grid.sync();
      {
        for (int it = bid; it < 64 * 8; it += nb) {
          for (int br = 0; br < 3; ++br) {
            GemmArgs g{}; g.A = (br == 0) ? yhy : (br == 1 ? ygq : ydf); g.lda = 512; g.Bt = Wbr + (size_t)br * 1024 * 512; g.ldb = 512; g.K = 512;
            g.gate = pbuf; g.macc = macc; g.outb = merged; g.br = br;
            gemm_tile<EPI_MERGE>(g, it / 8, it % 8, smem);
          }
        }
      }
      grid.sync();
      { GemmArgs g{}; g.A = merged; g.lda = DM; g.Bt = Wout; g.ldb = DM; g.K = DM; g.xin = xres; g.xout = xres; g.scale = 1.0f;
        for (int it = bid; it < 64 * 8; it += nb) gemm_tile<EPI_RESID>(g, it / 8, it % 8, smem); }
      grid.sync();
      for (int it = bid; it < TCH / 4; it += nb) { const int row = it * 4 + w; norm_row_bf16(xres + (size_t)row * DM, P.ffn2_norm + layer * DM, hn + (size_t)row * DM, lane); }
      grid.sync();
      { GemmArgs g{}; g.A = hn; g.lda = DM; g.Bt = Wf2in; g.ldb = DM; g.K = DM; g.outb = hid; g.ldo = DFF;
        for (int it = bid; it < 64 * 44; it += nb) gemm_tile<EPI_SWIGLU>(g, it / 44, it % 44, smem); }
      grid.sync();
      { GemmArgs g{}; g.A = hid; g.lda = DFF; g.Bt = Wf2out; g.ldb = DFF; g.K = DFF; g.xin = xres; g.xout = xres; g.scale = 0.5f;
        for (int it = bid; it < 64 * 8; it += nb) gemm_tile<EPI_RESID>(g, it / 8, it % 8, smem); }
      grid.sync();
    }
  }
  for (int it = bid; it < NTOK / 4; it += nb) { const int row = it * 4 + w; norm_row_f32_inplace(P.out + (size_t)row * DM, P.final_norm, lane); }
}

extern "C" void kernel_launch(void* const* d_in, const int* in_sizes, int n_in, void* d_out, int out_size, void* d_ws, size_t ws_size,
                              hipStream_t stream) {
  static int grid_blocks = 0;
  if (!grid_blocks) {
    int dev = 0, cus = 0, per_cu = 0;
    hipGetDevice(&dev);
    hipDeviceGetAttribute(&cus, hipDeviceAttributeMultiprocessorCount, dev);
    hipOccupancyMaxActiveBlocksPerMultiprocessor(&per_cu, fwd_megakernel, 256, 0);
    if (per_cu < 1) per_cu = 1;
    if (per_cu > 2) per_cu = 2;
    grid_blocks = cus * per_cu;
  }
  Params p{};
  const float* const* in = (const float* const*)d_in;
  p.x_prompt = in[0]; p.x_sample = in[1]; p.ffn1_norm = in[2]; p.ffn1_w_in = in[3]; p.ffn1_w_out = in[4]; p.mix_norm = in[5]; p.w_in = in[6];
  p.hy_conv_w = in[7]; p.hy_conv_b = in[8]; p.hy_w1 = in[9]; p.hy_b1 = in[10]; p.hy_w2 = in[11]; p.hy_b2 = in[12]; p.hy_w3 = in[13];
  p.hy_freq = in[14]; p.hy_skip = in[15]; p.gqa_q_norm = in[16]; p.gqa_k_norm = in[17]; p.diff_lambda = in[18]; p.diff_subln = in[19];
  p.rel_bias = in[20]; p.w_branch = in[21]; p.w_out = in[22]; p.ffn2_norm = in[23]; p.ffn2_w_in = in[24]; p.ffn2_w_out = in[25]; p.final_norm = in[26];
  p.out = (float*)d_out; p.ws = (char*)d_ws;
  void* args[] = {&p};
  hipError_t e = hipLaunchCooperativeKernel((void*)fwd_megakernel, dim3(grid_blocks), dim3(256), args, 0, stream);
  if (e != hipSuccess) fprintf(stderr, "cooperative launch failed: %s (grid %d)\n", hipGetErrorString(e), grid_blocks);
}
```

```cpp
#include <hip/hip_runtime.h>
#include <hip/hip_cooperative_groups.h>
#include <stdint.h>
#include <cstdio>
namespace cg = cooperative_groups;

typedef unsigned short u16;
typedef __attribute__((ext_vector_type(8))) short bf16x8;
typedef __attribute__((ext_vector_type(16))) float f32x16;
typedef __attribute__((ext_vector_type(4))) float f32x4;
typedef __attribute__((ext_vector_type(4))) unsigned u32x4;
typedef __attribute__((ext_vector_type(2))) unsigned u32x2;
typedef __attribute__((ext_vector_type(2))) __bf16 bf2_t;
typedef __attribute__((ext_vector_type(2))) float f2_t;
#define DI __device__ __forceinline__
#define MFMA(a, b, c) __builtin_amdgcn_mfma_f32_32x32x16_bf16((a), (b), (c), 0, 0, 0)

constexpr int DM = 1024, DFF = 2816, INC = 6912, TCH = 16384, NTOK = 49152;
constexpr int OFF_GQ = 1536, OFF_GK = 2048, OFF_GV = 2176, OFF_DQ = 2304, OFF_DK = 2816, OFF_DV = 3328, OFF_GATE = 3840;
constexpr float LOG2E = 1.4426950408889634f;

constexpr size_t SZ_F1IN = (size_t)5632 * 1024 * 2, SZ_F1OUT = (size_t)1024 * 2816 * 2, SZ_WIN = (size_t)6912 * 1024 * 2,
                 SZ_WBR = (size_t)3 * 1024 * 512 * 2, SZ_WOUT = (size_t)1024 * 1024 * 2;
constexpr size_t O_F1IN = 0, O_F1OUT = O_F1IN + SZ_F1IN, O_WIN = O_F1OUT + SZ_F1OUT, O_WBR = O_WIN + SZ_WIN, O_WOUT = O_WBR + SZ_WBR,
                 O_F2IN = O_WOUT + SZ_WOUT, O_F2OUT = O_F2IN + SZ_F1IN, O_FILT8 = O_F2OUT + SZ_F1OUT,
                 O_FILT16 = O_FILT8 + (size_t)512 * 16384 * 2, O_MISC = O_FILT16 + (size_t)512 * 32768 * 2,
                 O_P = O_MISC + 65536, O_HN = O_P + (size_t)TCH * INC * 2, O_ZT = O_HN + (size_t)TCH * 1024 * 2,
                 O_YT = O_ZT + (size_t)TCH * 512 * 2, O_DIFFO = O_YT + (size_t)TCH * 512 * 2, O_VTG = O_DIFFO + (size_t)TCH * 1024 * 2,
                 O_VTD = O_VTG + (size_t)TCH * 128 * 2, O_YHY = O_VTD + (size_t)TCH * 512 * 2, O_YGQ = O_YHY + (size_t)TCH * 512 * 2,
                 O_YDF = O_YGQ + (size_t)TCH * 512 * 2, O_END = O_YDF + (size_t)TCH * 512 * 2;
static_assert(O_END <= (size_t)536870912, "workspace overflow");
constexpr int SMEM_BYTES = 61440;
#define REP_GEMM 1
#define REP_ATTN 1
#define REP_HY 1
#define REP_SMALL 1
#define REP_SYNC 1
#define GSYNC() do { for (int rs_ = 0; rs_ < REP_SYNC; ++rs_) xcd_barrier(xb); } while (0)


#define XB_TMO      128
#define XB_XCNT(j)  (256  + 64 * (j))
#define XB_XSUB(j)  (1280 + 64 * (j))
#define XB_XGEN(j)  (2304 + 64 * (j))
#define XB_TOP      3328
#define XB_TOPGEN   3392
#define XCD_BAR_WORDS 3456
#define XB_SPIN_CAP (1u << 21)
#define LAS __attribute__((address_space(3)))
DI unsigned xb_ld(unsigned* p)              { return __hip_atomic_load(p, __ATOMIC_RELAXED, __HIP_MEMORY_SCOPE_AGENT); }
DI unsigned xb_add(unsigned* p, unsigned v) { return __hip_atomic_fetch_add(p, v, __ATOMIC_RELAXED, __HIP_MEMORY_SCOPE_AGENT); }
DI unsigned xb_xcc_id() { return (unsigned)__builtin_amdgcn_s_getreg((3 << 11) | 20) & 0xFu; }
#define XB_SPIN(cond, bar) do { unsigned _sp = 0; while (cond) { __builtin_amdgcn_s_sleep(1); \
    if ((++_sp & 255u) == 0u) { if (xb_ld(&(bar)[XB_TMO])) break; if (_sp > XB_SPIN_CAP) { atomicAdd(&(bar)[XB_TMO], 1u); break; } } } } while (0)
struct XcdBarrier { unsigned* bar; unsigned x; volatile LAS unsigned* st; };
DI XcdBarrier xcd_barrier_post(unsigned* bar, volatile LAS unsigned* st) {
  XcdBarrier b; b.bar = bar; b.x = xb_xcc_id(); b.st = st;
  if (threadIdx.x == 0) (void)xb_add(&bar[XB_XCNT(b.x)], 1u);
  return b;
}
DI void xcd_barrier_complete(unsigned* bar, unsigned x, unsigned& nloc, unsigned& nx) {
  const unsigned G = gridDim.x * gridDim.y * gridDim.z;
  unsigned sum, cnt, mine, sp = 0u;
  for (;;) {
    sum = 0u; cnt = 0u; mine = 0u;
#pragma unroll
    for (unsigned j = 0; j < 16; ++j) { const unsigned c = xb_ld(&bar[XB_XCNT(j)]); sum += c; cnt += (c > 0u) ? 1u : 0u; mine = (j == x) ? c : mine; }
    if (sum == G) break;
    __builtin_amdgcn_s_sleep(1);
    if ((++sp & 255u) == 0u) { if (xb_ld(&bar[XB_TMO])) break; if (sp > XB_SPIN_CAP) { atomicAdd(&bar[XB_TMO], 1u); break; } }
  }
  nloc = mine > 0u ? mine : 1u; nx = cnt > 0u ? cnt : 1u;
}
DI void xcd_barrier(const XcdBarrier& b) {
  asm volatile("s_waitcnt vmcnt(0)" ::: "memory");
  __syncthreads();
  if (threadIdx.x == 0) {
    unsigned* bar = b.bar;
    __builtin_amdgcn_s_waitcnt(0);
    unsigned nloc = b.st[0], nx = b.st[1];
    if (nloc == 0u) { xcd_barrier_complete(bar, b.x, nloc, nx); b.st[0] = nloc; b.st[1] = nx; }
    const unsigned old = xb_add(&bar[XB_XSUB(b.x)], 1u);
    const unsigned gen = old / nloc;
    if (old + 1u == (gen + 1u) * nloc) {
      __builtin_amdgcn_fence(__ATOMIC_RELEASE, "agent");
      asm volatile("s_waitcnt vmcnt(0)" ::: "memory");
      const unsigned og = xb_add(&bar[XB_TOP], 1u);
      const unsigned tg = og / nx;
      if (og + 1u == (tg + 1u) * nx) xb_add(&bar[XB_TOPGEN], 1u);
      else XB_SPIN(xb_ld(&bar[XB_TOPGEN]) == tg, bar);
      __builtin_amdgcn_fence(__ATOMIC_ACQUIRE, "agent");
      xb_add(&bar[XB_XGEN(b.x)], 1u);
      asm volatile("s_waitcnt vmcnt(0)" ::: "memory");
    } else {
      XB_SPIN(xb_ld(&bar[XB_XGEN(b.x)]) == gen, bar);
      __builtin_amdgcn_fence(__ATOMIC_ACQUIRE, "agent");
      asm volatile("s_waitcnt vmcnt(0)" ::: "memory");
    }
  }
  __syncthreads();
}
constexpr size_t O_BAR = O_MISC + 16384;

struct Params {
  const float* x_prompt; const float* x_sample;
  const float* ffn1_norm; const float* ffn1_w_in; const float* ffn1_w_out; const float* mix_norm; const float* w_in;
  const float* hy_conv_w; const float* hy_conv_b; const float* hy_w1; const float* hy_b1; const float* hy_w2; const float* hy_b2;
  const float* hy_w3; const float* hy_freq; const float* hy_skip;
  const float* gqa_q_norm; const float* gqa_k_norm; const float* diff_lambda; const float* diff_subln; const float* rel_bias;
  const float* w_branch; const float* w_out; const float* ffn2_norm; const float* ffn2_w_in; const float* ffn2_w_out; const float* final_norm;
  float* out; char* ws;
};

DI unsigned pack2(float a, float b) { f2_t v = {a, b}; bf2_t r = __builtin_convertvector(v, bf2_t); return __builtin_bit_cast(unsigned, r); }
DI u16 f2bf(float a) { return (u16)(pack2(a, 0.f) & 0xffffu); }
DI float bf2f(u16 v) { return __uint_as_float(((unsigned)v) << 16); }
DI float bflo(unsigned v) { return __uint_as_float(v << 16); }
DI float bfhi(unsigned v) { return __uint_as_float(v & 0xffff0000u); }
DI int otid() { int t = threadIdx.x; asm volatile("" : "+v"(t)); return t; }
DI int crow(int reg, int h) { return (reg & 3) + 8 * (reg >> 2) + 4 * h; }
DI float wave_sum(float v) {
  v += __shfl_xor(v, 32); v += __shfl_xor(v, 16); v += __shfl_xor(v, 8); v += __shfl_xor(v, 4); v += __shfl_xor(v, 2); v += __shfl_xor(v, 1);
  return v;
}
DI float half_sum(float v) {
  v += __shfl_xor(v, 16); v += __shfl_xor(v, 8); v += __shfl_xor(v, 4); v += __shfl_xor(v, 2); v += __shfl_xor(v, 1);
  return v;
}

DI void convT_tile(const float* __restrict__ src, int K, int N, u16* __restrict__ dst, int kt, int nt, int perm_half, char* smem) {
  float* t = (float*)smem;
  const int tid = otid();
  __syncthreads();
  {
    const int col = tid & 63, r0 = tid >> 6;
#pragma unroll
    for (int i = 0; i < 16; ++i) { int row = r0 + 4 * i; t[row * 65 + col] = src[(size_t)(kt * 64 + row) * N + nt * 64 + col]; }
  }
  __syncthreads();
  {
    const int nl = tid >> 2, kq = tid & 3;
    int n = nt * 64 + nl;
    if (perm_half > 0) { if (n < perm_half) n = (n >> 5) * 64 + (n & 31); else { int j = n - perm_half; n = (j >> 5) * 64 + 32 + (j & 31); } }
    u32x4 o0, o1;
#pragma unroll
    for (int i = 0; i < 4; ++i) {
      o0[i] = pack2(t[(kq * 16 + 2 * i) * 65 + nl], t[(kq * 16 + 2 * i + 1) * 65 + nl]);
      o1[i] = pack2(t[(kq * 16 + 8 + 2 * i) * 65 + nl], t[(kq * 16 + 8 + 2 * i + 1) * 65 + nl]);
    }
    u16* d = dst + (size_t)n * K + kt * 64 + kq * 16;
    *(u32x4*)d = o0; *(u32x4*)(d + 8) = o1;
  }
}

DI void filter_item(const Params& P, int layer, int L, int tb, u16* __restrict__ G, char* smem) {
  float* h1 = (float*)smem;
  float* h2 = h1 + 64 * 65;
  const int tid = otid(), lane = tid & 63, w = tid >> 6;
  const float* w1 = P.hy_w1 + layer * 33 * 64; const float* b1 = P.hy_b1 + layer * 64;
  const float* w2 = P.hy_w2 + layer * 64 * 64; const float* b2 = P.hy_b2 + layer * 64;
  const float* w3 = P.hy_w3 + layer * 64 * 1024; const float* fr = P.hy_freq + layer * 64;
  const int t = tb * 64 + lane;
  const float tl = (float)t / (float)(L - 1);
  __syncthreads();
  {
    float a[16];
#pragma unroll
    for (int u = 0; u < 16; ++u) a[u] = b1[w * 16 + u] + tl * w1[w * 16 + u];
    const float base = (float)(2.0 * 3.14159265358979323846 / (double)L) * (float)t;
    for (int b = 0; b < 16; ++b) {
      const float band = 1e-4f + (float)b * ((15.0f - 1e-4f) / 15.0f);
      const float ang = base * band;
      const float cs = cosf(ang), sn = -sinf(ang);
#pragma unroll
      for (int u = 0; u < 16; ++u) a[u] += cs * w1[(1 + b) * 64 + w * 16 + u] + sn * w1[(17 + b) * 64 + w * 16 + u];
    }
#pragma unroll
    for (int u = 0; u < 16; ++u) h1[lane * 65 + w * 16 + u] = sinf(fr[w * 16 + u] * a[u]);
  }
  __syncthreads();
  {
    float a[16];
#pragma unroll
    for (int u = 0; u < 16; ++u) a[u] = b2[w * 16 + u];
    for (int k = 0; k < 64; ++k) {
      const float hv = h1[lane * 65 + k];
#pragma unroll
      for (int u = 0; u < 16; ++u) a[u] += hv * w2[k * 64 + w * 16 + u];
    }
#pragma unroll
    for (int u = 0; u < 16; ++u) h2[lane * 65 + w * 16 + u] = sinf(fr[w * 16 + u] * a[u]);
  }
  __syncthreads();
  const float min_decay = -3.0701134573253946f, max_decay = -15.350567286626973f;
  for (int og = 0; og < 64; ++og) {
    const int o = w * 256 + og * 4;
    float a0 = 0.f, a1 = 0.f, a2 = 0.f, a3 = 0.f;
#pragma unroll 4
    for (int k = 0; k < 64; ++k) {
      const float hv = h2[lane * 65 + k];
      const f32x4 wv = *(const f32x4*)(w3 + k * 1024 + o);
      a0 += hv * wv[0]; a1 += hv * wv[1]; a2 += hv * wv[2]; a3 += hv * wv[3];
    }
    float av[4] = {a0, a1, a2, a3};
#pragma unroll
    for (int q = 0; q < 4; ++q) {
      const int oo = o + q; const int ch = oo & 511;
      const float delta = min_decay + (float)ch * ((max_decay - min_decay) / 511.0f);
      const float val = av[q] * expf(-tl * fabsf(delta));
      u16* Gc = G + (size_t)ch * (2 * L);
      if (oo < 512) Gc[L - t] = f2bf(val);
      else { if (t >= 1) Gc[L + t] = f2bf(val); else Gc[0] = 0; }
    }
  }
}

DI void norm_row_bf16(const float* __restrict__ x, const float* __restrict__ g, u16* __restrict__ out, int lane) {
  f32x4 v[4]; float ss = 0.f;
#pragma unroll
  for (int i = 0; i < 4; ++i) { v[i] = *(const f32x4*)(x + lane * 4 + 256 * i); ss += v[i][0] * v[i][0] + v[i][1] * v[i][1] + v[i][2] * v[i][2] + v[i][3] * v[i][3]; }
  ss = wave_sum(ss);
  const float rs = rsqrtf(ss * (1.0f / 1024.0f) + 1e-6f);
#pragma unroll
  for (int i = 0; i < 4; ++i) {
    const f32x4 gg = *(const f32x4*)(g + lane * 4 + 256 * i);
    u32x2 o; o[0] = pack2(v[i][0] * rs * gg[0], v[i][1] * rs * gg[1]); o[1] = pack2(v[i][2] * rs * gg[2], v[i][3] * rs * gg[3]);
    *(u32x2*)(out + lane * 4 + 256 * i) = o;
  }
}
DI void norm_row_f32_inplace(float* __restrict__ x, const float* __restrict__ g, int lane) {
  f32x4 v[4]; float ss = 0.f;
#pragma unroll
  for (int i = 0; i < 4; ++i) { v[i] = *(const f32x4*)(x + lane * 4 + 256 * i); ss += v[i][0] * v[i][0] + v[i][1] * v[i][1] + v[i][2] * v[i][2] + v[i][3] * v[i][3]; }
  ss = wave_sum(ss);
  const float rs = rsqrtf(ss * (1.0f / 1024.0f) + 1e-6f);
#pragma unroll
  for (int i = 0; i < 4; ++i) {
    const f32x4 gg = *(const f32x4*)(g + lane * 4 + 256 * i);
    f32x4 o; o[0] = v[i][0] * rs * gg[0]; o[1] = v[i][1] * rs * gg[1]; o[2] = v[i][2] * rs * gg[2]; o[3] = v[i][3] * rs * gg[3];
    *(f32x4*)(x + lane * 4 + 256 * i) = o;
  }
}

struct GemmArgs {
  const u16* A; int lda; const u16* Bt; int ldb; int K;
  u16* outb; int ldo; const float* xin; float* xout; float scale; const u16* gate; float* macc; int br;
};
enum { EPI_SWIGLU = 0, EPI_RESID = 1, EPI_PROJ = 2, EPI_MERGE = 3 };

template <int MODE>
DI void gemm_tile(const GemmArgs& g, int mt, int nt, char* smem) {
  const int tid = otid(), lane = tid & 63, w = tid >> 6, wm = w >> 1, wn = w & 1, r = lane & 31, h = lane >> 5;
  u16* As = (u16*)smem;
  u16* Bs = As + 2 * 256 * 40;
  const int m0 = mt * 256, n0 = nt * 128;
  f32x16 acc[4][2];
#pragma unroll
  for (int i = 0; i < 4; ++i)
#pragma unroll
    for (int j = 0; j < 2; ++j)
#pragma unroll
      for (int q = 0; q < 16; ++q) acc[i][j][q] = 0.f;
  const int lrow = tid >> 2, lcc = tid & 3;
  const u16* Ag = g.A + (size_t)(m0 + lrow) * g.lda + lcc * 8;
  const u16* Bg = g.Bt + (size_t)(n0 + lrow) * g.ldb + lcc * 8;
  u32x4 ra[4], rb[2];
  __syncthreads();
#pragma unroll
  for (int i = 0; i < 4; ++i) ra[i] = *(const u32x4*)(Ag + (size_t)(64 * i) * g.lda);
#pragma unroll
  for (int i = 0; i < 2; ++i) rb[i] = *(const u32x4*)(Bg + (size_t)(64 * i) * g.ldb);
#pragma unroll
  for (int i = 0; i < 4; ++i) *(u32x4*)(As + (lrow + 64 * i) * 40 + lcc * 8) = ra[i];
#pragma unroll
  for (int i = 0; i < 2; ++i) *(u32x4*)(Bs + (lrow + 64 * i) * 40 + lcc * 8) = rb[i];
  __syncthreads();
  const int nk = g.K >> 5;
  for (int kt = 0; kt < nk; ++kt) {
    const int buf = kt & 1;
    if (kt + 1 < nk) {
      const int k0 = (kt + 1) * 32;
#pragma unroll
      for (int i = 0; i < 4; ++i) ra[i] = *(const u32x4*)(Ag + (size_t)(64 * i) * g.lda + k0);
#pragma unroll
      for (int i = 0; i < 2; ++i) rb[i] = *(const u32x4*)(Bg + (size_t)(64 * i) * g.ldb + k0);
    }
    const u16* Ab = As + buf * (256 * 40); const u16* Bb = Bs + buf * (128 * 40);
#pragma unroll
    for (int s = 0; s < 2; ++s) {
      bf16x8 af[4], bfr[2];
#pragma unroll
      for (int i = 0; i < 4; ++i) af[i] = *(const bf16x8*)(Ab + (wm * 128 + 32 * i + r) * 40 + 16 * s + 8 * h);
#pragma unroll
      for (int j = 0; j < 2; ++j) bfr[j] = *(const bf16x8*)(Bb + (wn * 64 + 32 * j + r) * 40 + 16 * s + 8 * h);
#pragma unroll
      for (int i = 0; i < 4; ++i)
#pragma unroll
        for (int j = 0; j < 2; ++j) acc[i][j] = MFMA(af[i], bfr[j], acc[i][j]);
    }
    if (kt + 1 < nk) {
      u16* Aw = As + (buf ^ 1) * (256 * 40); u16* Bw = Bs + (buf ^ 1) * (128 * 40);
#pragma unroll
      for (int i = 0; i < 4; ++i) *(u32x4*)(Aw + (lrow + 64 * i) * 40 + lcc * 8) = ra[i];
#pragma unroll
      for (int i = 0; i < 2; ++i) *(u32x4*)(Bw + (lrow + 64 * i) * 40 + lcc * 8) = rb[i];
    }
    __syncthreads();
  }
  const int rb0 = m0 + wm * 128, cb0 = n0 + wn * 64;
  if (MODE == EPI_SWIGLU) {
    const int hc = (cb0 >> 1) + r;
#pragma unroll
    for (int i = 0; i < 4; ++i)
#pragma unroll
      for (int q = 0; q < 16; ++q) {
        const int row = rb0 + 32 * i + crow(q, h);
        const float gv = acc[i][0][q], uv = acc[i][1][q];
        g.outb[(size_t)row * g.ldo + hc] = f2bf(gv / (1.0f + __expf(-gv)) * uv);
      }
  } else if (MODE == EPI_RESID) {
#pragma unroll
    for (int i = 0; i < 4; ++i)
#pragma unroll
      for (int j = 0; j < 2; ++j)
#pragma unroll
        for (int q = 0; q < 16; ++q) {
          const size_t idx = (size_t)(rb0 + 32 * i + crow(q, h)) * DM + cb0 + 32 * j + r;
          g.xout[idx] = g.xin[idx] + g.scale * acc[i][j][q];
        }
  } else if (MODE == EPI_PROJ) {
    const bool sg = (n0 >= OFF_GATE);
#pragma unroll
    for (int i = 0; i < 4; ++i)
#pragma unroll
      for (int j = 0; j < 2; ++j)
#pragma unroll
        for (int q = 0; q < 16; ++q) {
          const size_t idx = (size_t)(rb0 + 32 * i + crow(q, h)) * g.ldo + cb0 + 32 * j + r;
          float v = acc[i][j][q];
          if (sg) v = 1.0f / (1.0f + __expf(-v));
          g.outb[idx] = f2bf(v);
        }
  } else {
#pragma unroll
    for (int i = 0; i < 4; ++i)
#pragma unroll
      for (int j = 0; j < 2; ++j)
#pragma unroll
        for (int q = 0; q < 16; ++q) {
          const int row = rb0 + 32 * i + crow(q, h), col = cb0 + 32 * j + r;
          const float gt = bf2f(g.gate[(size_t)row * INC + OFF_GATE + g.br * DM + col]);
          float v = gt * acc[i][j][q];
          const size_t idx = (size_t)row * DM + col;
          if (g.br > 0) v += g.macc[idx];
          if (g.br < 2) g.macc[idx] = v; else g.outb[idx] = f2bf(v);
        }
  }
}

DI void qk_prep_item(const Params& P, int layer, u16* __restrict__ p, int L, int it) {
  const int tid = otid(), lane = tid & 63, w = tid >> 6;
  const int u = it * 8 + w * 2 + (lane >> 5);
  const int tok = u / 10, hd = u - tok * 10;
  const int i = lane & 31;
  const int col0 = (hd < 8) ? (OFF_GQ + hd * 64) : (OFF_GK + (hd - 8) * 64);
  const float* gn = (hd < 8) ? (P.gqa_q_norm + layer * 64) : (P.gqa_k_norm + layer * 64);
  unsigned* ptr = (unsigned*)(p + (size_t)tok * INC + col0) + i;
  const unsigned v = *ptr;
  float a = bflo(v), b = bfhi(v);
  const float ss = half_sum(a * a + b * b);
  const float rs = rsqrtf(ss * (1.0f / 64.0f) + 1e-6f);
  a = a * rs * gn[2 * i]; b = b * rs * gn[2 * i + 1];
  const int tl = tok % L;
  const float pos = (i < 16) ? (float)(tl >> 6) : (float)(tl & 63);
  const int jj = i & 15;
  const float inv = powf(10000.0f, -(float)(2 * jj) / 32.0f);
  const float ang = pos * inv;
  const float c = cosf(ang), s = sinf(ang);
  *ptr = pack2(a * c - b * s, a * s + b * c);
}

DI void transpose_item(const Params& P, int layer, const u16* __restrict__ p, int L, int kind, int ct, int tt, u16* __restrict__ dst, char* smem) {
  u16* tile = (u16*)smem;
  const int tid = otid();
  const int t0 = tt * 64;
  const int seq = t0 / L, tl0 = t0 - seq * L;
  const int C = (kind == 0) ? 128 : 512;
  __syncthreads();
  {
    const int col = tid & 63, r0 = tid >> 6;
    const int cidx = ct * 64 + col;
    if (kind < 2) {
      const int off = (kind == 0 ? OFF_GV : OFF_DV) + cidx;
#pragma unroll
      for (int i = 0; i < 16; ++i) { const int row = r0 + 4 * i; tile[col * 72 + row] = p[(size_t)(t0 + row) * INC + off]; }
    } else {
      const float* cw = P.hy_conv_w + layer * 3 * 1536; const float* cb = P.hy_conv_b + layer * 1536;
      const int c1 = 512 + cidx, c2 = 1024 + cidx;
      const float w10 = cw[c1], w11 = cw[1536 + c1], w12 = cw[3072 + c1], b1 = cb[c1];
      const float w20 = cw[c2], w21 = cw[1536 + c2], w22 = cw[3072 + c2], b2 = cb[c2];
#pragma unroll
      for (int i = 0; i < 16; ++i) {
        const int row = r0 + 4 * i; const int tl = tl0 + row;
        const u16* pr = p + (size_t)(t0 + row) * INC;
        const float xm1 = (tl > 0) ? bf2f(pr[c1 - INC]) : 0.f, x0 = bf2f(pr[c1]), xp1 = (tl < L - 1) ? bf2f(pr[c1 + INC]) : 0.f;
        const float vm1 = (tl > 0) ? bf2f(pr[c2 - INC]) : 0.f, v0 = bf2f(pr[c2]), vp1 = (tl < L - 1) ? bf2f(pr[c2 + INC]) : 0.f;
        const float x1c = xm1 * w10 + x0 * w11 + xp1 * w12 + b1;
        const float vc = vm1 * w20 + v0 * w21 + vp1 * w22 + b2;
        tile[col * 72 + row] = f2bf(vc * x1c);
      }
    }
  }
  __syncthreads();
  {
    const int c = tid >> 2, q = tid & 3;
    const u32x4 a = *(const u32x4*)(tile + c * 72 + q * 16), b = *(const u32x4*)(tile + c * 72 + q * 16 + 8);
    u16* d = dst + ((size_t)seq * C + ct * 64 + c) * L + tl0 + q * 16;
    *(u32x4*)d = a; *(u32x4*)(d + 8) = b;
  }
}

template <int DV, bool BIAS>
DI void attn_tile(const u16* __restrict__ Qp, const u16* __restrict__ Kp, const u16* __restrict__ VTp, int L,
                  u16* __restrict__ Op, int ldo, int q0, const float* __restrict__ btab, char* smem) {
  constexpr int NDT = DV / 32;
  constexpr int VCH = DV / 32;
  constexpr int KS_SZ = 64 * 72, VS_SZ = DV * 68;
  u16* Ks = (u16*)smem;
  u16* Vs = Ks + 2 * KS_SZ;
  float* bt = (float*)(Vs + 2 * VS_SZ);
  const int tid = otid(), lane = tid & 63, w = tid >> 6, r = lane & 31, h = lane >> 5;
  const float sc = 0.125f * LOG2E;
  __syncthreads();
  if (BIAS) { for (int i = tid; i < 257; i += 256) bt[i] = btab[i]; }
  bf16x8 qf[4];
  {
    const u16* qrow = Qp + (size_t)(q0 + 32 * w + r) * INC + 8 * h;
#pragma unroll
    for (int s = 0; s < 4; ++s) qf[s] = *(const bf16x8*)(qrow + 16 * s);
  }
  const int qpos = q0 + 32 * w + r;
  f32x16 O[NDT];
#pragma unroll
  for (int d = 0; d < NDT; ++d)
#pragma unroll
    for (int q = 0; q < 16; ++q) O[d][q] = 0.f;
  float m = -INFINITY, l = 0.f;
  const int lrow = tid >> 3, lcc = tid & 7;
  u32x4 rk[2], rv[VCH];
  const u16* Kg = Kp + (size_t)lrow * INC + lcc * 8;
  const u16* Vg = VTp + (size_t)lrow * L + lcc * 8;
#pragma unroll
  for (int i = 0; i < 2; ++i) rk[i] = *(const u32x4*)(Kg + (size_t)(32 * i) * INC);
#pragma unroll
  for (int i = 0; i < VCH; ++i) rv[i] = *(const u32x4*)(Vg + (size_t)(32 * i) * L);
#pragma unroll
  for (int i = 0; i < 2; ++i) *(u32x4*)(Ks + (lrow + 32 * i) * 72 + lcc * 8) = rk[i];
#pragma unroll
  for (int i = 0; i < VCH; ++i) {
    u16* d = Vs + (lrow + 32 * i) * 68 + lcc * 8;
    u32x2 lo, hi; lo[0] = rv[i][0]; lo[1] = rv[i][1]; hi[0] = rv[i][2]; hi[1] = rv[i][3];
    *(u32x2*)d = lo; *(u32x2*)(d + 4) = hi;
  }
  __syncthreads();
  const int nkb = L >> 6;
  for (int kb = 0; kb < nkb; ++kb) {
    const int buf = kb & 1;
    if (kb + 1 < nkb) {
      const size_t ko = (size_t)(kb + 1) * 64;
#pragma unroll
      for (int i = 0; i < 2; ++i) rk[i] = *(const u32x4*)(Kg + (ko + 32 * i) * INC);
#pragma unroll
      for (int i = 0; i < VCH; ++i) rv[i] = *(const u32x4*)(Vg + (size_t)(32 * i) * L + ko);
    }
    const u16* Kb = Ks + buf * KS_SZ; const u16* Vb = Vs + buf * VS_SZ;
    f32x16 S[2];
#pragma unroll
    for (int kt = 0; kt < 2; ++kt) {
#pragma unroll
      for (int q = 0; q < 16; ++q) S[kt][q] = 0.f;
#pragma unroll
      for (int s = 0; s < 4; ++s) {
        const bf16x8 a = *(const bf16x8*)(Kb + (32 * kt + r) * 72 + 16 * s + 8 * h);
        S[kt] = MFMA(a, qf[s], S[kt]);
      }
    }
    if (BIAS) {
      const int kmin = kb * 64;
      if (kmin - (q0 + 127) >= 128) {
        const float cb = bt[256];
#pragma unroll
        for (int kt = 0; kt < 2; ++kt)
#pragma unroll
          for (int q = 0; q < 16; ++q) S[kt][q] = S[kt][q] * sc + cb;
      } else if (q0 - (kmin + 63) >= 128) {
        const float cb = bt[0];
#pragma unroll
        for (int kt = 0; kt < 2; ++kt)
#pragma unroll
          for (int q = 0; q < 16; ++q) S[kt][q] = S[kt][q] * sc + cb;
      } else {
#pragma unroll
        for (int kt = 0; kt < 2; ++kt)
#pragma unroll
          for (int q = 0; q < 16; ++q) {
            int rel = kmin + 32 * kt + crow(q, h) - qpos;
            rel = rel < -128 ? -128 : (rel > 128 ? 128 : rel);
            S[kt][q] = S[kt][q] * sc + bt[rel + 128];
          }
      }
    } else {
#pragma unroll
      for (int kt = 0; kt < 2; ++kt)
#pragma unroll
        for (int q = 0; q < 16; ++q) S[kt][q] *= sc;
    }
    float mx = S[0][0];
#pragma unroll
    for (int kt = 0; kt < 2; ++kt)
#pragma unroll
      for (int q = 0; q < 16; ++q) mx = fmaxf(mx, S[kt][q]);
    mx = fmaxf(mx, __shfl_xor(mx, 32));
    const float mn = fmaxf(m, mx);
    const float alpha = __builtin_amdgcn_exp2f(m - mn);
    m = mn;
    l *= alpha;
#pragma unroll
    for (int d = 0; d < NDT; ++d)
#pragma unroll
      for (int q = 0; q < 16; ++q) O[d][q] *= alpha;
    bf16x8 pf[2][2];
#pragma unroll
    for (int kt = 0; kt < 2; ++kt) {
#pragma unroll
      for (int q = 0; q < 16; ++q) { const float pv = __builtin_amdgcn_exp2f(S[kt][q] - mn); S[kt][q] = pv; l += pv; }
#pragma unroll
      for (int s = 0; s < 2; ++s) {
        u32x4 pk;
#pragma unroll
        for (int q = 0; q < 4; ++q) pk[q] = pack2(S[kt][8 * s + 2 * q], S[kt][8 * s + 2 * q + 1]);
        pf[kt][s] = __builtin_bit_cast(bf16x8, pk);
      }
    }
#pragma unroll
    for (int kt = 0; kt < 2; ++kt)
#pragma unroll
      for (int s = 0; s < 2; ++s)
#pragma unroll
        for (int d = 0; d < NDT; ++d) {
          const u16* vp = Vb + (32 * d + r) * 68 + 32 * kt + 16 * s + 4 * h;
          const u32x2 lo = *(const u32x2*)vp, hi = *(const u32x2*)(vp + 8);
          u32x4 av; av[0] = lo[0]; av[1] = lo[1]; av[2] = hi[0]; av[3] = hi[1];
          O[d] = MFMA(__builtin_bit_cast(bf16x8, av), pf[kt][s], O[d]);
        }
    if (kb + 1 < nkb) {
      u16* Kw = Ks + (buf ^ 1) * KS_SZ; u16* Vw = Vs + (buf ^ 1) * VS_SZ;
#pragma unroll
      for (int i = 0; i < 2; ++i) *(u32x4*)(Kw + (lrow + 32 * i) * 72 + lcc * 8) = rk[i];
#pragma unroll
      for (int i = 0; i < VCH; ++i) {
        u16* d = Vw + (lrow + 32 * i) * 68 + lcc * 8;
        u32x2 lo, hi; lo[0] = rv[i][0]; lo[1] = rv[i][1]; hi[0] = rv[i][2]; hi[1] = rv[i][3];
        *(u32x2*)d = lo; *(u32x2*)(d + 4) = hi;
      }
    }
    __syncthreads();
  }
  l += __shfl_xor(l, 32);
  const float inv = 1.0f / l;
  u16* orow = Op + (size_t)qpos * ldo;
#pragma unroll
  for (int d = 0; d < NDT; ++d)
#pragma unroll
    for (int g4 = 0; g4 < 4; ++g4) {
      u32x2 o; o[0] = pack2(O[d][4 * g4] * inv, O[d][4 * g4 + 1] * inv); o[1] = pack2(O[d][4 * g4 + 2] * inv, O[d][4 * g4 + 3] * inv);
      *(u32x2*)(orow + 32 * d + 8 * g4 + 4 * h) = o;
    }
}

DI void hyena_item(int c, const u16* __restrict__ G, const u16* __restrict__ zT, u16* __restrict__ yT, int nseq, int L, char* smem) {
  u16* zs = (u16*)smem;
  u16* fw = zs + 20480;
  const int tid = otid(), lane = tid & 63, w = tid >> 6, r = lane & 31, h = lane >> 5;
  const int ZL = L + 2048;
  __syncthreads();
  for (int q = 0; q < nseq; ++q) {
    const u16* src = zT + ((size_t)q * 512 + c) * L;
    u16* dst = zs + q * ZL;
    const u32x4 zero = {0u, 0u, 0u, 0u};
    for (int i = tid; i < 128; i += 256) { *(u32x4*)(dst + i * 8) = zero; *(u32x4*)(dst + 1024 + L + i * 8) = zero; }
    for (int i = tid; i < (L >> 3); i += 256) *(u32x4*)(dst + 1024 + i * 8) = *(const u32x4*)(src + i * 8);
  }
  int tq[4], tJ[4];
#pragma unroll
  for (int i = 0; i < 4; ++i) { if (nseq == 2) { tq[i] = i & 1; tJ[i] = 2 * w + (i >> 1); } else { tq[i] = 0; tJ[i] = 4 * w + i; } }
  f32x16 acc[4];
#pragma unroll
  for (int i = 0; i < 4; ++i)
#pragma unroll
    for (int q = 0; q < 16; ++q) acc[i][q] = 0.f;
  const int E0 = -L + 16, ELAST = L - 32;
  const int npass = (2 * L - 32 + 8191) / 8192;
  const u16* Gc = G + (size_t)c * (2 * L);
  for (int ps = 0; ps < npass; ++ps) {
    const int ea = E0 + 8192 * ps, eb = ea + 8192;
    const int wb = L - eb - 16;
    __syncthreads();
    for (int i = tid; i < 1032; i += 256) {
      const int gi = wb + i * 8;
      u32x4 v = {0u, 0u, 0u, 0u};
      if (gi >= 0 && gi < 2 * L) v = *(const u32x4*)(Gc + gi);
      *(u32x4*)(fw + i * 8) = v;
    }
    __syncthreads();
    const int eend = (eb - 16 < ELAST) ? (eb - 16) : ELAST;
    for (int e = ea; e <= eend; e += 16) {
      bool in[4]; bool any = false;
#pragma unroll
      for (int i = 0; i < 4; ++i) { in[i] = (e >= 1024 * tJ[i] - L + 16) && (e <= 1024 * tJ[i] + 992); any = any || in[i]; }
      if (!any) continue;
      const int idx0 = L - e - r + 8 * h - wb;
      bf16x8 a;
#pragma unroll
      for (int j = 0; j < 8; ++j) a[j] = (short)fw[idx0 + j];
#pragma unroll
      for (int i = 0; i < 4; ++i) {
        if (in[i]) {
          const bf16x8 b = *(const bf16x8*)(zs + tq[i] * ZL + 1024 + 1024 * tJ[i] + 32 * r - e + 8 * h);
          acc[i] = MFMA(a, b, acc[i]);
        }
      }
    }
  }
#pragma unroll
  for (int i = 0; i < 4; ++i) {
    u16* dst = yT + ((size_t)tq[i] * 512 + c) * L + 1024 * tJ[i] + 32 * r + 4 * h;
#pragma unroll
    for (int g4 = 0; g4 < 4; ++g4) {
      u32x2 o; o[0] = pack2(acc[i][4 * g4], acc[i][4 * g4 + 1]); o[1] = pack2(acc[i][4 * g4 + 2], acc[i][4 * g4 + 3]);
      *(u32x2*)(dst + 8 * g4) = o;
    }
  }
}

DI void diff_post_item(const Params& P, int layer, float lam, float lam_init, const u16* __restrict__ dO, u16* __restrict__ ydf, int it) {
  const int tid = otid(), lane = tid & 63, w = tid >> 6;
  const int u = it * 8 + w * 2 + (lane >> 5);
  const int i = lane & 31;
  const u32x2 a = *(const u32x2*)(dO + (size_t)u * 256 + 4 * i);
  const u32x2 b = *(const u32x2*)(dO + (size_t)u * 256 + 128 + 4 * i);
  float o[4];
  o[0] = bflo(a[0]) - lam * bflo(b[0]); o[1] = bfhi(a[0]) - lam * bfhi(b[0]);
  o[2] = bflo(a[1]) - lam * bflo(b[1]); o[3] = bfhi(a[1]) - lam * bfhi(b[1]);
  const float ss = half_sum(o[0] * o[0] + o[1] * o[1] + o[2] * o[2] + o[3] * o[3]);
  const float rs = rsqrtf(ss * (1.0f / 128.0f) + 1e-5f) * (1.0f - lam_init);
  const float* g = P.diff_subln + layer * 128 + 4 * i;
  u32x2 ov; ov[0] = pack2(o[0] * rs * g[0], o[1] * rs * g[1]); ov[1] = pack2(o[2] * rs * g[2], o[3] * rs * g[3]);
  *(u32x2*)(ydf + (size_t)u * 128 + 4 * i) = ov;
}
DI void hyena_post_item(const Params& P, int layer, const u16* __restrict__ p, int L, const u16* __restrict__ yT, const u16* __restrict__ zT,
                        int ct, int tt, u16* __restrict__ yhy, char* smem) {
  float* tile = (float*)smem;
  const int tid = otid();
  const int t0 = tt * 64; const int seq = t0 / L, tl0 = t0 - seq * L;
  __syncthreads();
  {
    const int tcol = tid & 63, c0 = tid >> 6;
#pragma unroll
    for (int i = 0; i < 16; ++i) {
      const int cc = c0 + 4 * i; const int c = ct * 64 + cc;
      const size_t gi = ((size_t)seq * 512 + c) * L + tl0 + tcol;
      tile[cc * 65 + tcol] = bf2f(yT[gi]) + bf2f(zT[gi]) * P.hy_skip[layer * 512 + c];
    }
  }
  __syncthreads();
  {
    const int col = tid & 63, r0 = tid >> 6; const int c = ct * 64 + col;
    const float* cw = P.hy_conv_w + layer * 3 * 1536; const float* cb = P.hy_conv_b + layer * 1536;
    const float w0 = cw[c], w1 = cw[1536 + c], w2 = cw[3072 + c], b0 = cb[c];
#pragma unroll
    for (int i = 0; i < 16; ++i) {
      const int row = r0 + 4 * i; const int tl = tl0 + row;
      const u16* pr = p + (size_t)(t0 + row) * INC + c;
      const float xm1 = (tl > 0) ? bf2f(pr[-INC]) : 0.f, x0 = bf2f(pr[0]), xp1 = (tl < L - 1) ? bf2f(pr[INC]) : 0.f;
      const float x0c = xm1 * w0 + x0 * w1 + xp1 * w2 + b0;
      yhy[(size_t)(t0 + row) * 512 + c] = f2bf(x0c * tile[col * 65 + row]);
    }
  }
}

__global__ void __launch_bounds__(256, 2) fwd_megakernel(Params P) {
  cg::grid_group grid = cg::this_grid();
  __shared__ __attribute__((aligned(16))) char smem[SMEM_BYTES];
  __shared__ uint4 xb_words;
  const int tid = threadIdx.x, lane = tid & 63, w = tid >> 6;
  const int nb = gridDim.x, bid = blockIdx.x;
  char* ws = P.ws;
  if (tid == 0) xb_words = make_uint4(0u, 0u, 0u, 0u);
  __syncthreads();
  XcdBarrier xb = xcd_barrier_post((unsigned*)(ws + O_BAR), (volatile LAS unsigned*)&xb_words);
  u16* Wf1in = (u16*)(ws + O_F1IN); u16* Wf1out = (u16*)(ws + O_F1OUT); u16* Win = (u16*)(ws + O_WIN); u16* Wbr = (u16*)(ws + O_WBR);
  u16* Wout = (u16*)(ws + O_WOUT); u16* Wf2in = (u16*)(ws + O_F2IN); u16* Wf2out = (u16*)(ws + O_F2OUT);
  u16* filt8 = (u16*)(ws + O_FILT8); u16* filt16 = (u16*)(ws + O_FILT16);
  float* misc = (float*)(ws + O_MISC);
  u16* pbuf = (u16*)(ws + O_P); u16* hid = pbuf; u16* hn = (u16*)(ws + O_HN); u16* merged = hn;
  u16* zT = (u16*)(ws + O_ZT); u16* yT = (u16*)(ws + O_YT); u16* dO = (u16*)(ws + O_DIFFO); float* macc = (float*)(ws + O_ZT);
  u16* vtg = (u16*)(ws + O_VTG); u16* vtd = (u16*)(ws + O_VTD);
  u16* yhy = (u16*)(ws + O_YHY); u16* ygq = (u16*)(ws + O_YGQ); u16* ydf = (u16*)(ws + O_YDF);

  for (int layer = 0; layer < 2; ++layer) {
    {
      const int n1 = 16 * 88, n2 = 44 * 16, n3 = 16 * 108, n4 = 3 * 8 * 16, n5 = 16 * 16;
      const int nconv = n1 + n2 + n3 + n4 + n5 + n1 + n2;
      const int nfilt = 128 + 256;
      const int total = nconv + nfilt + 1;
      for (int it = bid; it < total; it += nb) {
        int t = it;
        if (t < nfilt) {
          const bool big = t < 256;
          filter_item(P, layer, big ? 16384 : 8192, big ? t : t - 256, big ? filt16 : filt8, smem);
          continue;
        }
        t -= nfilt;
        if (t < n1) { convT_tile(P.ffn1_w_in + (size_t)layer * 1024 * 5632, 1024, 5632, Wf1in, t / 88, t % 88, 2816, smem); continue; } t -= n1;
        if (t < n2) { convT_tile(P.ffn1_w_out + (size_t)layer * 2816 * 1024, 2816, 1024, Wf1out, t / 16, t % 16, 0, smem); continue; } t -= n2;
        if (t < n3) { convT_tile(P.w_in + (size_t)layer * 1024 * 6912, 1024, 6912, Win, t / 108, t % 108, 0, smem); continue; } t -= n3;
        if (t < n4) { const int br = t / 128, tt = t % 128;
          convT_tile(P.w_branch + ((size_t)layer * 3 + br) * 512 * 1024, 512, 1024, Wbr + (size_t)br * 1024 * 512, tt / 16, tt % 16, 0, smem); continue; } t -= n4;
        if (t < n5) { convT_tile(P.w_out + (size_t)layer * 1024 * 1024, 1024, 1024, Wout, t / 16, t % 16, 0, smem); continue; } t -= n5;
        if (t < n1) { convT_tile(P.ffn2_w_in + (size_t)layer * 1024 * 5632, 1024, 5632, Wf2in, t / 88, t % 88, 2816, smem); continue; } t -= n1;
        if (t < n2) { convT_tile(P.ffn2_w_out + (size_t)layer * 2816 * 1024, 2816, 1024, Wf2out, t / 16, t % 16, 0, smem); continue; } t -= n2;
        if (tid < 2) {
          const float* lp = P.diff_lambda + tid * 256;
          float s1 = 0.f, s2 = 0.f;
          for (int i = 0; i < 64; ++i) { s1 += lp[i] * lp[64 + i]; s2 += lp[128 + i] * lp[192 + i]; }
          const float lam_init = 0.8f - 0.6f * expf(-0.3f * (float)tid);
          misc[tid] = expf(s1) - expf(s2) + lam_init;
        }
        for (int i = tid; i < 4 * 257; i += 256) {
          const int hh = i / 257, idx = i % 257; const int rel = idx - 128; const int n = rel < 0 ? -rel : rel;
          int b;
          if (n < 8) b = n; else { int lg = 8 + (int)(logf((float)n / 8.0f) / 2.772588722239781f * 8.0f); b = lg < 15 ? lg : 15; }
          if (rel > 0) b += 16;
          misc[64 + i] = P.rel_bias[b * 4 + hh] * LOG2E;
        }
      }
    }
    if (layer == 0) grid.sync(); else GSYNC();
    const float lam = misc[layer];
    const float lam_init = 0.8f - 0.6f * expf(-0.3f * (float)layer);

    for (int ch = 0; ch < 3; ++ch) {
      const int nseq = (ch < 2) ? 2 : 1, L = (ch < 2) ? 8192 : 16384;
      const float* xin0 = (ch < 2) ? (P.x_prompt + (size_t)ch * TCH * DM) : P.x_sample;
      float* xres = P.out + (size_t)ch * TCH * DM;
      const float* xcur = (layer == 0) ? xin0 : xres;
      const u16* filt = (ch < 2) ? filt8 : filt16;

      for (int rp = 0; rp < REP_SMALL; ++rp) for (int it = bid; it < TCH / 4; it += nb) { const int row = it * 4 + w; norm_row_bf16(xcur + (size_t)row * DM, P.ffn1_norm + layer * DM, hn + (size_t)row * DM, lane); }
      GSYNC();
      { GemmArgs g{}; g.A = hn; g.lda = DM; g.Bt = Wf1in; g.ldb = DM; g.K = DM; g.outb = hid; g.ldo = DFF;
        for (int rp = 0; rp < REP_GEMM; ++rp) for (int it = bid; it < 64 * 44; it += nb) gemm_tile<EPI_SWIGLU>(g, it / 44, it % 44, smem); }
      GSYNC();
      { GemmArgs g{}; g.A = hid; g.lda = DFF; g.Bt = Wf1out; g.ldb = DFF; g.K = DFF; g.xin = xcur; g.xout = xres; g.scale = 0.5f;
        for (int rp = 0; rp < REP_GEMM; ++rp) { if (rp > 0) { g.xin = xres; g.scale = 0.f; } for (int it = bid; it < 64 * 8; it += nb) gemm_tile<EPI_RESID>(g, it / 8, it % 8, smem); } }
      GSYNC();
      for (int rp = 0; rp < REP_SMALL; ++rp) for (int it = bid; it < TCH / 4; it += nb) { const int row = it * 4 + w; norm_row_bf16(xres + (size_t)row * DM, P.mix_norm + layer * DM, hn + (size_t)row * DM, lane); }
      GSYNC();
      { GemmArgs g{}; g.A = hn; g.lda = DM; g.Bt = Win; g.ldb = DM; g.K = DM; g.outb = pbuf; g.ldo = INC;
        for (int rp = 0; rp < REP_GEMM; ++rp) for (int it = bid; it < 64 * 54; it += nb) gemm_tile<EPI_PROJ>(g, it / 54, it % 54, smem); }
      GSYNC();
      {
        const int nqk = TCH * 10 / 8, ntr = 256 * 18;
        for (int it = bid; it < nqk + ntr; it += nb) {
          if (it < nqk) { qk_prep_item(P, layer, pbuf, L, it); continue; }
          const int t = it - nqk; const int tt = t / 18, cc = t % 18;
          if (cc < 2) transpose_item(P, layer, pbuf, L, 0, cc, tt, vtg, smem);
          else if (cc < 10) transpose_item(P, layer, pbuf, L, 1, cc - 2, tt, vtd, smem);
          else transpose_item(P, layer, pbuf, L, 2, cc - 10, tt, zT, smem);
        }
      }
      GSYNC();
      {
        const int nqt = L / 128;
        const int ndiff = nseq * 8 * nqt, ngqa = nseq * 8 * nqt, nhy = 512;
        const int nrep = (REP_ATTN > REP_HY) ? REP_ATTN : REP_HY;
        for (int rp = 0; rp < nrep; ++rp) for (int it = bid; it < ndiff + ngqa + nhy; it += nb) {
          if (it < ndiff + ngqa ? (rp >= REP_ATTN) : (rp >= REP_HY)) continue;
          if (it < ndiff) {
            const int qt = it % nqt; const int hc = (it / nqt) & 7; const int seq = it / (nqt * 8);
            const int hh = hc >> 1, cc = hc & 1;
            const size_t tb = (size_t)seq * L;
            attn_tile<128, true>(pbuf + tb * INC + OFF_DQ + hc * 64, pbuf + tb * INC + OFF_DK + hc * 64,
                                 vtd + ((size_t)seq * 512 + hh * 128) * L, L,
                                 dO + tb * 1024 + (hh * 2 + cc) * 128, 1024, qt * 128, misc + 64 + hh * 257, smem);
          } else if (it < ndiff + ngqa) {
            const int t = it - ndiff;
            const int qt = t % nqt; const int hd = (t / nqt) & 7; const int seq = t / (nqt * 8);
            const int kvh = hd >> 2;
            const size_t tb = (size_t)seq * L;
            attn_tile<64, false>(pbuf + tb * INC + OFF_GQ + hd * 64, pbuf + tb * INC + OFF_GK + kvh * 64,
                                 vtg + ((size_t)seq * 128 + kvh * 64) * L, L,
                                 ygq + tb * 512 + hd * 64, 512, qt * 128, nullptr, smem);
          } else {
            hyena_item(it - ndiff - ngqa, filt, zT, yT, nseq, L, smem);
          }
        }
      }
      GSYNC();
      {
        const int ndp = TCH * 4 / 8, nhp = 256 * 8;
        for (int rp = 0; rp < REP_SMALL; ++rp) for (int it = bid; it < ndp + nhp; it += nb) {
          if (it < ndp) diff_post_item(P, layer, lam, lam_init, dO, ydf, it);
          else { const int t = it - ndp; hyena_post_item(P, layer, pbuf, L, yT, zT, t % 8, t / 8, yhy, smem); }
        }
      }
      GSYNC();
      {
        for (int rp = 0; rp < REP_GEMM; ++rp) for (int it = bid; it < 64 * 8; it += nb) {
          for (int br = 0; br < 3; ++br) {
            GemmArgs g{}; g.A = (br == 0) ? yhy : (br == 1 ? ygq : ydf); g.lda = 512; g.Bt = Wbr + (size_t)br * 1024 * 512; g.ldb = 512; g.K = 512;
            g.gate = pbuf; g.macc = macc; g.outb = merged; g.br = br;
            gemm_tile<EPI_MERGE>(g, it / 8, it % 8, smem);
          }
        }
      }
      GSYNC();
      { GemmArgs g{}; g.A = merged; g.lda = DM; g.Bt = Wout; g.ldb = DM; g.K = DM; g.xin = xres; g.xout = xres; g.scale = 1.0f;
        for (int rp = 0; rp < REP_GEMM; ++rp) { if (rp > 0) { g.xin = xres; g.scale = 0.f; } for (int it = bid; it < 64 * 8; it += nb) gemm_tile<EPI_RESID>(g, it / 8, it % 8, smem); } }
      GSYNC();
      for (int rp = 0; rp < REP_SMALL; ++rp) for (int it = bid; it < TCH / 4; it += nb) { const int row = it * 4 + w; norm_row_bf16(xres + (size_t)row * DM, P.ffn2_norm + layer * DM, hn + (size_t)row * DM, lane); }
      GSYNC();
      { GemmArgs g{}; g.A = hn; g.lda = DM; g.Bt = Wf2in; g.ldb = DM; g.K = DM; g.outb = hid; g.ldo = DFF;
        for (int rp = 0; rp < REP_GEMM; ++rp) for (int it = bid; it < 64 * 44; it += nb) gemm_tile<EPI_SWIGLU>(g, it / 44, it % 44, smem); }
      GSYNC();
      { GemmArgs g{}; g.A = hid; g.lda = DFF; g.Bt = Wf2out; g.ldb = DFF; g.K = DFF; g.xin = xres; g.xout = xres; g.scale = 0.5f;
        for (int rp = 0; rp < REP_GEMM; ++rp) { if (rp > 0) { g.xin = xres; g.scale = 0.f; } for (int it = bid; it < 64 * 8; it += nb) gemm_tile<EPI_RESID>(g, it / 8, it % 8, smem); } }
      GSYNC();
    }
  }
  for (int it = bid; it < NTOK / 4; it += nb) { const int row = it * 4 + w; norm_row_f32_inplace(P.out + (size_t)row * DM, P.final_norm, lane); }
}

extern "C" void kernel_launch(void* const* d_in, const int* in_sizes, int n_in, void* d_out, int out_size, void* d_ws, size_t ws_size,
                              hipStream_t stream) {
  static int grid_blocks = 0;
  if (!grid_blocks) {
    int dev = 0, cus = 0, per_cu = 0;
    (void)hipGetDevice(&dev);
    (void)hipDeviceGetAttribute(&cus, hipDeviceAttributeMultiprocessorCount, dev);
    (void)hipOccupancyMaxActiveBlocksPerMultiprocessor(&per_cu, fwd_megakernel, 256, 0);
    if (per_cu < 1) per_cu = 1;
    if (per_cu > 2) per_cu = 2;
    grid_blocks = cus * per_cu;
  }
  Params p{};
  const float* const* in = (const float* const*)d_in;
  p.x_prompt = in[0]; p.x_sample = in[1]; p.ffn1_norm = in[2]; p.ffn1_w_in = in[3]; p.ffn1_w_out = in[4]; p.mix_norm = in[5]; p.w_in = in[6];
  p.hy_conv_w = in[7]; p.hy_conv_b = in[8]; p.hy_w1 = in[9]; p.hy_b1 = in[10]; p.hy_w2 = in[11]; p.hy_b2 = in[12]; p.hy_w3 = in[13];
  p.hy_freq = in[14]; p.hy_skip = in[15]; p.gqa_q_norm = in[16]; p.gqa_k_norm = in[17]; p.diff_lambda = in[18]; p.diff_subln = in[19];
  p.rel_bias = in[20]; p.w_branch = in[21]; p.w_out = in[22]; p.ffn2_norm = in[23]; p.ffn2_w_in = in[24]; p.ffn2_w_out = in[25]; p.final_norm = in[26];
  p.out = (float*)d_out; p.ws = (char*)d_ws;
  void* args[] = {&p};
  (void)hipMemsetAsync((char*)d_ws + O_BAR, 0, XCD_BAR_WORDS * 4, stream);
  hipError_t e = hipLaunchCooperativeKernel((void*)fwd_megakernel, dim3(grid_blocks), dim3(256), args, 0, stream);
  if (e != hipSuccess) fprintf(stderr, "cooperative launch failed: %s (grid %d)\n", hipGetErrorString(e), grid_blocks);
}
```

```cpp
#include <hip/hip_runtime.h>
#include <hip/hip_cooperative_groups.h>
#include <stdint.h>
#include <cstdio>
namespace cg = cooperative_groups;

typedef unsigned short u16;
typedef __attribute__((ext_vector_type(8))) short bf16x8;
typedef __attribute__((ext_vector_type(16))) float f32x16;
typedef __attribute__((ext_vector_type(4))) float f32x4;
typedef __attribute__((ext_vector_type(4))) unsigned u32x4;
typedef __attribute__((ext_vector_type(2))) unsigned u32x2;
typedef __attribute__((ext_vector_type(2))) __bf16 bf2_t;
typedef __attribute__((ext_vector_type(2))) float f2_t;
#define DI __device__ __forceinline__
#define MFMA(a, b, c) __builtin_amdgcn_mfma_f32_32x32x16_bf16((a), (b), (c), 0, 0, 0)

constexpr int DM = 1024, DFF = 2816, INC = 6912, TCH = 16384, NTOK = 49152;
constexpr int OFF_GQ = 1536, OFF_GK = 2048, OFF_GV = 2176, OFF_DQ = 2304, OFF_DK = 2816, OFF_DV = 3328, OFF_GATE = 3840;
constexpr float LOG2E = 1.4426950408889634f;

constexpr size_t SZ_F1IN = (size_t)5632 * 1024 * 2, SZ_F1OUT = (size_t)1024 * 2816 * 2, SZ_WIN = (size_t)6912 * 1024 * 2,
                 SZ_WBR = (size_t)3 * 1024 * 512 * 2, SZ_WOUT = (size_t)1024 * 1024 * 2;
constexpr size_t O_F1IN = 0, O_F1OUT = O_F1IN + SZ_F1IN, O_WIN = O_F1OUT + SZ_F1OUT, O_WBR = O_WIN + SZ_WIN, O_WOUT = O_WBR + SZ_WBR,
                 O_F2IN = O_WOUT + SZ_WOUT, O_F2OUT = O_F2IN + SZ_F1IN, O_FILT8 = O_F2OUT + SZ_F1OUT,
                 O_FILT16 = O_FILT8 + (size_t)512 * 16384 * 2, O_MISC = O_FILT16 + (size_t)512 * 32768 * 2,
                 O_P = O_MISC + 65536, O_HN = O_P + (size_t)TCH * INC * 2, O_ZT = O_HN + (size_t)TCH * 1024 * 2,
                 O_YT = O_ZT + (size_t)TCH * 512 * 2, O_DIFFO = O_YT + (size_t)TCH * 512 * 2, O_VTG = O_DIFFO + (size_t)TCH * 1024 * 2,
                 O_VTD = O_VTG + (size_t)TCH * 128 * 2, O_YHY = O_VTD + (size_t)TCH * 512 * 2, O_YGQ = O_YHY + (size_t)TCH * 512 * 2,
                 O_YDF = O_YGQ + (size_t)TCH * 512 * 2, O_END = O_YDF + (size_t)TCH * 512 * 2;
static_assert(O_END <= (size_t)536870912, "workspace overflow");
constexpr int SMEM_BYTES = 131072;
#define REP_GEMM 1
#define REP_ATTN 1
#define REP_HY 1
#define REP_SMALL 1
#define REP_SYNC 1
#define PHASE_IDS() const int t_ = otid(); const int lane = t_ & 63; const int grp = __builtin_amdgcn_readfirstlane(t_ >> 8); \
  const int w = __builtin_amdgcn_readfirstlane((t_ >> 6) & 3); const int bid2 = bid * 2 + grp; char* smg = smem + grp * 61440; \
  const int vb = (bid & 7) * (nb >> 3) + (bid >> 3); (void)lane; (void)w; (void)bid2; (void)smg; (void)vb
#define GSYNC() do { for (int rs_ = 0; rs_ < REP_SYNC; ++rs_) xcd_barrier(xb); } while (0)


#define XB_TMO      128
#define XB_XCNT(j)  (256  + 64 * (j))
#define XB_XSUB(j)  (1280 + 64 * (j))
#define XB_XGEN(j)  (2304 + 64 * (j))
#define XB_TOP      3328
#define XB_TOPGEN   3392
#define XCD_BAR_WORDS 3456
#define XB_SPIN_CAP (1u << 21)
#define LAS __attribute__((address_space(3)))
DI unsigned xb_ld(unsigned* p)              { return __hip_atomic_load(p, __ATOMIC_RELAXED, __HIP_MEMORY_SCOPE_AGENT); }
DI unsigned xb_add(unsigned* p, unsigned v) { return __hip_atomic_fetch_add(p, v, __ATOMIC_RELAXED, __HIP_MEMORY_SCOPE_AGENT); }
DI unsigned xb_xcc_id() { return (unsigned)__builtin_amdgcn_s_getreg((3 << 11) | 20) & 0xFu; }
#define XB_SPIN(cond, bar) do { unsigned _sp = 0; while (cond) { __builtin_amdgcn_s_sleep(1); \
    if ((++_sp & 255u) == 0u) { if (xb_ld(&(bar)[XB_TMO])) break; if (_sp > XB_SPIN_CAP) { atomicAdd(&(bar)[XB_TMO], 1u); break; } } } } while (0)
struct XcdBarrier { unsigned* bar; unsigned x; volatile LAS unsigned* st; };
DI XcdBarrier xcd_barrier_post(unsigned* bar, volatile LAS unsigned* st) {
  XcdBarrier b; b.bar = bar; b.x = xb_xcc_id(); b.st = st;
  if (threadIdx.x == 0) (void)xb_add(&bar[XB_XCNT(b.x)], 1u);
  return b;
}
DI void xcd_barrier_complete(unsigned* bar, unsigned x, unsigned& nloc, unsigned& nx) {
  const unsigned G = gridDim.x * gridDim.y * gridDim.z;
  unsigned sum, cnt, mine, sp = 0u;
  for (;;) {
    sum = 0u; cnt = 0u; mine = 0u;
#pragma unroll
    for (unsigned j = 0; j < 16; ++j) { const unsigned c = xb_ld(&bar[XB_XCNT(j)]); sum += c; cnt += (c > 0u) ? 1u : 0u; mine = (j == x) ? c : mine; }
    if (sum == G) break;
    __builtin_amdgcn_s_sleep(1);
    if ((++sp & 255u) == 0u) { if (xb_ld(&bar[XB_TMO])) break; if (sp > XB_SPIN_CAP) { atomicAdd(&bar[XB_TMO], 1u); break; } }
  }
  nloc = mine > 0u ? mine : 1u; nx = cnt > 0u ? cnt : 1u;
}
DI void xcd_barrier(const XcdBarrier& b) {
  asm volatile("s_waitcnt vmcnt(0)" ::: "memory");
  __syncthreads();
  if (threadIdx.x == 0) {
    unsigned* bar = b.bar;
    __builtin_amdgcn_s_waitcnt(0);
    unsigned nloc = b.st[0], nx = b.st[1];
    if (nloc == 0u) { xcd_barrier_complete(bar, b.x, nloc, nx); b.st[0] = nloc; b.st[1] = nx; }
    const unsigned old = xb_add(&bar[XB_XSUB(b.x)], 1u);
    const unsigned gen = old / nloc;
    if (old + 1u == (gen + 1u) * nloc) {
      __builtin_amdgcn_fence(__ATOMIC_RELEASE, "agent");
      asm volatile("s_waitcnt vmcnt(0)" ::: "memory");
      const unsigned og = xb_add(&bar[XB_TOP], 1u);
      const unsigned tg = og / nx;
      if (og + 1u == (tg + 1u) * nx) xb_add(&bar[XB_TOPGEN], 1u);
      else XB_SPIN(xb_ld(&bar[XB_TOPGEN]) == tg, bar);
      __builtin_amdgcn_fence(__ATOMIC_ACQUIRE, "agent");
      xb_add(&bar[XB_XGEN(b.x)], 1u);
      asm volatile("s_waitcnt vmcnt(0)" ::: "memory");
    } else {
      XB_SPIN(xb_ld(&bar[XB_XGEN(b.x)]) == gen, bar);
      __builtin_amdgcn_fence(__ATOMIC_ACQUIRE, "agent");
      asm volatile("s_waitcnt vmcnt(0)" ::: "memory");
    }
  }
  __syncthreads();
}
constexpr size_t O_BAR = O_MISC + 16384;

struct Params {
  const float* x_prompt; const float* x_sample;
  const float* ffn1_norm; const float* ffn1_w_in; const float* ffn1_w_out; const float* mix_norm; const float* w_in;
  const float* hy_conv_w; const float* hy_conv_b; const float* hy_w1; const float* hy_b1; const float* hy_w2; const float* hy_b2;
  const float* hy_w3; const float* hy_freq; const float* hy_skip;
  const float* gqa_q_norm; const float* gqa_k_norm; const float* diff_lambda; const float* diff_subln; const float* rel_bias;
  const float* w_branch; const float* w_out; const float* ffn2_norm; const float* ffn2_w_in; const float* ffn2_w_out; const float* final_norm;
  float* out; char* ws;
};

DI unsigned pack2(float a, float b) { f2_t v = {a, b}; bf2_t r = __builtin_convertvector(v, bf2_t); return __builtin_bit_cast(unsigned, r); }
DI u16 f2bf(float a) { return (u16)(pack2(a, 0.f) & 0xffffu); }
DI float bf2f(u16 v) { return __uint_as_float(((unsigned)v) << 16); }
DI float bflo(unsigned v) { return __uint_as_float(v << 16); }
DI float bfhi(unsigned v) { return __uint_as_float(v & 0xffff0000u); }
DI int otid() { int t = threadIdx.x; asm volatile("" : "+v"(t)); return t; }
DI int crow(int reg, int h) { return (reg & 3) + 8 * (reg >> 2) + 4 * h; }
DI float wave_sum(float v) {
  v += __shfl_xor(v, 32); v += __shfl_xor(v, 16); v += __shfl_xor(v, 8); v += __shfl_xor(v, 4); v += __shfl_xor(v, 2); v += __shfl_xor(v, 1);
  return v;
}
DI float half_sum(float v) {
  v += __shfl_xor(v, 16); v += __shfl_xor(v, 8); v += __shfl_xor(v, 4); v += __shfl_xor(v, 2); v += __shfl_xor(v, 1);
  return v;
}

DI void convT_tile(const float* __restrict__ src, int K, int N, u16* __restrict__ dst, int kt, int nt, int perm_half, char* smem) {
  float* t = (float*)smem;
  const int tid = otid() & 255;
  __syncthreads();
  {
    const int col = tid & 63, r0 = tid >> 6;
#pragma unroll
    for (int i = 0; i < 16; ++i) { int row = r0 + 4 * i; t[row * 65 + col] = src[(size_t)(kt * 64 + row) * N + nt * 64 + col]; }
  }
  __syncthreads();
  {
    const int nl = tid >> 2, kq = tid & 3;
    int n = nt * 64 + nl;
    if (perm_half > 0) { if (n < perm_half) n = (n >> 5) * 64 + (n & 31); else { int j = n - perm_half; n = (j >> 5) * 64 + 32 + (j & 31); } }
    u32x4 o0, o1;
#pragma unroll
    for (int i = 0; i < 4; ++i) {
      o0[i] = pack2(t[(kq * 16 + 2 * i) * 65 + nl], t[(kq * 16 + 2 * i + 1) * 65 + nl]);
      o1[i] = pack2(t[(kq * 16 + 8 + 2 * i) * 65 + nl], t[(kq * 16 + 8 + 2 * i + 1) * 65 + nl]);
    }
    u16* d = dst + (size_t)n * K + kt * 64 + kq * 16;
    *(u32x4*)d = o0; *(u32x4*)(d + 8) = o1;
  }
}

DI void filter_item(const Params& P, int layer, int L, int tb, u16* __restrict__ G, char* smem) {
  float* h1 = (float*)smem;
  float* h2 = h1 + 64 * 65;
  const int tid = otid() & 255, lane = tid & 63, w = __builtin_amdgcn_readfirstlane(tid >> 6);
  const float* w1 = P.hy_w1 + layer * 33 * 64; const float* b1 = P.hy_b1 + layer * 64;
  const float* w2 = P.hy_w2 + layer * 64 * 64; const float* b2 = P.hy_b2 + layer * 64;
  const float* w3 = P.hy_w3 + layer * 64 * 1024; const float* fr = P.hy_freq + layer * 64;
  const int t = tb * 64 + lane;
  const float tl = (float)t / (float)(L - 1);
  __syncthreads();
  {
    float a[16];
#pragma unroll
    for (int u = 0; u < 16; ++u) a[u] = b1[w * 16 + u] + tl * w1[w * 16 + u];
    const float base = (float)(2.0 * 3.14159265358979323846 / (double)L) * (float)t;
    for (int b = 0; b < 16; ++b) {
      const float band = 1e-4f + (float)b * ((15.0f - 1e-4f) / 15.0f);
      const float ang = base * band;
      const float cs = cosf(ang), sn = -sinf(ang);
#pragma unroll
      for (int u = 0; u < 16; ++u) a[u] += cs * w1[(1 + b) * 64 + w * 16 + u] + sn * w1[(17 + b) * 64 + w * 16 + u];
    }
#pragma unroll
    for (int u = 0; u < 16; ++u) h1[lane * 65 + w * 16 + u] = sinf(fr[w * 16 + u] * a[u]);
  }
  __syncthreads();
  {
    float a[16];
#pragma unroll
    for (int u = 0; u < 16; ++u) a[u] = b2[w * 16 + u];
    for (int k = 0; k < 64; ++k) {
      const float hv = h1[lane * 65 + k];
#pragma unroll
      for (int u = 0; u < 16; ++u) a[u] += hv * w2[k * 64 + w * 16 + u];
    }
#pragma unroll
    for (int u = 0; u < 16; ++u) h2[lane * 65 + w * 16 + u] = sinf(fr[w * 16 + u] * a[u]);
  }
  __syncthreads();
  const float min_decay = -3.0701134573253946f, max_decay = -15.350567286626973f;
  for (int og = 0; og < 64; ++og) {
    const int o = w * 256 + og * 4;
    float a0 = 0.f, a1 = 0.f, a2 = 0.f, a3 = 0.f;
#pragma unroll 4
    for (int k = 0; k < 64; ++k) {
      const float hv = h2[lane * 65 + k];
      const f32x4 wv = *(const f32x4*)(w3 + k * 1024 + o);
      a0 += hv * wv[0]; a1 += hv * wv[1]; a2 += hv * wv[2]; a3 += hv * wv[3];
    }
    float av[4] = {a0, a1, a2, a3};
#pragma unroll
    for (int q = 0; q < 4; ++q) {
      const int oo = o + q; const int ch = oo & 511;
      const float delta = min_decay + (float)ch * ((max_decay - min_decay) / 511.0f);
      const float val = av[q] * expf(-tl * fabsf(delta));
      u16* Gc = G + (size_t)ch * (2 * L);
      if (oo < 512) Gc[L - t] = f2bf(val);
      else { if (t >= 1) Gc[L + t] = f2bf(val); else Gc[0] = 0; }
    }
  }
}

DI void norm_row_bf16(const float* __restrict__ x, const float* __restrict__ g, u16* __restrict__ out, int lane) {
  f32x4 v[4]; float ss = 0.f;
#pragma unroll
  for (int i = 0; i < 4; ++i) { v[i] = *(const f32x4*)(x + lane * 4 + 256 * i); ss += v[i][0] * v[i][0] + v[i][1] * v[i][1] + v[i][2] * v[i][2] + v[i][3] * v[i][3]; }
  ss = wave_sum(ss);
  const float rs = rsqrtf(ss * (1.0f / 1024.0f) + 1e-6f);
#pragma unroll
  for (int i = 0; i < 4; ++i) {
    const f32x4 gg = *(const f32x4*)(g + lane * 4 + 256 * i);
    u32x2 o; o[0] = pack2(v[i][0] * rs * gg[0], v[i][1] * rs * gg[1]); o[1] = pack2(v[i][2] * rs * gg[2], v[i][3] * rs * gg[3]);
    *(u32x2*)(out + lane * 4 + 256 * i) = o;
  }
}
DI void norm_row_f32_inplace(float* __restrict__ x, const float* __restrict__ g, int lane) {
  f32x4 v[4]; float ss = 0.f;
#pragma unroll
  for (int i = 0; i < 4; ++i) { v[i] = *(const f32x4*)(x + lane * 4 + 256 * i); ss += v[i][0] * v[i][0] + v[i][1] * v[i][1] + v[i][2] * v[i][2] + v[i][3] * v[i][3]; }
  ss = wave_sum(ss);
  const float rs = rsqrtf(ss * (1.0f / 1024.0f) + 1e-6f);
#pragma unroll
  for (int i = 0; i < 4; ++i) {
    const f32x4 gg = *(const f32x4*)(g + lane * 4 + 256 * i);
    f32x4 o; o[0] = v[i][0] * rs * gg[0]; o[1] = v[i][1] * rs * gg[1]; o[2] = v[i][2] * rs * gg[2]; o[3] = v[i][3] * rs * gg[3];
    *(f32x4*)(x + lane * 4 + 256 * i) = o;
  }
}

struct GemmArgs {
  const u16* A; int lda; const u16* Bt; int ldb; int K;
  u16* outb; int ldo; const float* xin; float* xout; float scale; const u16* gate; float* macc; int br;
};
enum { EPI_SWIGLU = 0, EPI_RESID = 1, EPI_PROJ = 2, EPI_MERGE = 3 };

DI void st_pair(u16* base, size_t ld, int row0, int col, int lane, float v0, float v1) {
  const float send = (lane & 1) ? v0 : v1;
  const float recv = __shfl_xor(send, 1);
  if (lane & 1) *(unsigned*)(base + (size_t)(row0 + 1) * ld + col - 1) = pack2(recv, v1);
  else          *(unsigned*)(base + (size_t)row0 * ld + col) = pack2(v0, recv);
}

template <int MODE>
DI void gemm_tile(const GemmArgs& g, int mt, int nt, char* smem) {
  const int tid = otid(), lane = tid & 63, w = __builtin_amdgcn_readfirstlane(tid >> 6), wm = w >> 2, wn = w & 3, r = lane & 31, h = lane >> 5;
  char* As = smem;
  char* Bs = smem + 65536;
  const int m0 = mt * 256, n0 = nt * 256;
  f32x16 acc[4][2];
#pragma unroll
  for (int i = 0; i < 4; ++i)
#pragma unroll
    for (int j = 0; j < 2; ++j)
#pragma unroll
      for (int q = 0; q < 16; ++q) acc[i][j][q] = 0.f;
  const int srow = tid >> 3, scc = (tid & 7) ^ ((tid >> 4) & 7);
  const u16* Ag = g.A + (size_t)(m0 + srow) * g.lda + scc * 8;
  const u16* Bg = g.Bt + (size_t)(n0 + srow) * g.ldb + scc * 8;
#define GSTAGE(buf, k0)                                                                                                    \
  do {                                                                                                                     \
    _Pragma("unroll") for (int i_ = 0; i_ < 4; ++i_)                                                                       \
      __builtin_amdgcn_global_load_lds((const unsigned*)(Ag + (size_t)(64 * i_) * g.lda + (k0)),                           \
                                       (unsigned*)(As + (buf) * 32768 + tid * 16 + i_ * 8192), 16, 0, 0);                  \
    _Pragma("unroll") for (int i_ = 0; i_ < 4; ++i_)                                                                       \
      __builtin_amdgcn_global_load_lds((const unsigned*)(Bg + (size_t)(64 * i_) * g.ldb + (k0)),                           \
                                       (unsigned*)(Bs + (buf) * 32768 + tid * 16 + i_ * 8192), 16, 0, 0);                  \
  } while (0)
  __syncthreads();
  GSTAGE(0, 0);
  asm volatile("s_waitcnt vmcnt(0)" ::: "memory");
  __syncthreads();
  const int nk = g.K >> 6;
  const int arow = wm * 128 + r, brow = wn * 64 + r;
  const int sw = (r >> 1) & 7;
  for (int kt = 0; kt < nk; ++kt) {
    const int buf = kt & 1;
    if (kt + 1 < nk) GSTAGE(buf ^ 1, (kt + 1) * 64);
    const char* Ab = As + buf * 32768; const char* Bb = Bs + buf * 32768;
#pragma unroll
    for (int s = 0; s < 4; ++s) {
      bf16x8 af[4], bfr[2];
      const int co = ((2 * s + h) ^ sw) << 4;
#pragma unroll
      for (int i = 0; i < 4; ++i) af[i] = *(const bf16x8*)(Ab + (arow + 32 * i) * 128 + co);
#pragma unroll
      for (int j = 0; j < 2; ++j) bfr[j] = *(const bf16x8*)(Bb + (brow + 32 * j) * 128 + co);
#pragma unroll
      for (int i = 0; i < 4; ++i)
#pragma unroll
        for (int j = 0; j < 2; ++j) acc[i][j] = MFMA(af[i], bfr[j], acc[i][j]);
    }
    asm volatile("s_waitcnt vmcnt(0)" ::: "memory");
    __syncthreads();
  }
#undef GSTAGE
  const int rb0 = m0 + wm * 128, cb0 = n0 + wn * 64;
  if (MODE == EPI_SWIGLU) {
    const int hc = (cb0 >> 1) + r;
#pragma unroll
    for (int i = 0; i < 4; ++i)
#pragma unroll
      for (int q = 0; q < 16; q += 2) {
        const int row = rb0 + 32 * i + crow(q, h);
        const float g0 = acc[i][0][q], u0 = acc[i][1][q], g1 = acc[i][0][q + 1], u1 = acc[i][1][q + 1];
        st_pair(g.outb, g.ldo, row, hc, lane, g0 / (1.0f + __expf(-g0)) * u0, g1 / (1.0f + __expf(-g1)) * u1);
      }
  } else if (MODE == EPI_RESID) {
#pragma unroll
    for (int i = 0; i < 4; ++i)
#pragma unroll
      for (int j = 0; j < 2; ++j)
#pragma unroll
        for (int q = 0; q < 16; ++q) {
          const size_t idx = (size_t)(rb0 + 32 * i + crow(q, h)) * DM + cb0 + 32 * j + r;
          g.xout[idx] = g.xin[idx] + g.scale * acc[i][j][q];
        }
  } else if (MODE == EPI_PROJ) {
    const bool sg = (n0 >= OFF_GATE);
#pragma unroll
    for (int i = 0; i < 4; ++i)
#pragma unroll
      for (int j = 0; j < 2; ++j)
#pragma unroll
        for (int q = 0; q < 16; q += 2) {
          float v0 = acc[i][j][q], v1 = acc[i][j][q + 1];
          if (sg) { v0 = 1.0f / (1.0f + __expf(-v0)); v1 = 1.0f / (1.0f + __expf(-v1)); }
          st_pair(g.outb, g.ldo, rb0 + 32 * i + crow(q, h), cb0 + 32 * j + r, lane, v0, v1);
        }
  } else {
#pragma unroll
    for (int i = 0; i < 4; ++i)
#pragma unroll
      for (int j = 0; j < 2; ++j)
#pragma unroll
        for (int q = 0; q < 16; ++q) {
          const int row = rb0 + 32 * i + crow(q, h), col = cb0 + 32 * j + r;
          const float gt = bf2f(g.gate[(size_t)row * INC + OFF_GATE + g.br * DM + col]);
          float v = gt * acc[i][j][q];
          const size_t idx = (size_t)row * DM + col;
          if (g.br > 0) v += g.macc[idx];
          if (g.br < 2) g.macc[idx] = v; else g.outb[idx] = f2bf(v);
        }
  }
}

DI void tile_map(int t, int NT, int& mt, int& nt) { const int gs = 8 * NT; const int gm = t / gs, rem = t - gm * gs; mt = gm * 8 + (rem & 7); nt = rem >> 3; }

DI void qk_prep_item(const Params& P, int layer, u16* __restrict__ p, int L, int it) {
  const int tid = otid() & 255, lane = tid & 63, w = __builtin_amdgcn_readfirstlane(tid >> 6);
  const int u = it * 8 + w * 2 + (lane >> 5);
  const int tok = u / 10, hd = u - tok * 10;
  const int i = lane & 31;
  const int col0 = (hd < 8) ? (OFF_GQ + hd * 64) : (OFF_GK + (hd - 8) * 64);
  const float* gn = (hd < 8) ? (P.gqa_q_norm + layer * 64) : (P.gqa_k_norm + layer * 64);
  unsigned* ptr = (unsigned*)(p + (size_t)tok * INC + col0) + i;
  const unsigned v = *ptr;
  float a = bflo(v), b = bfhi(v);
  const float ss = half_sum(a * a + b * b);
  const float rs = rsqrtf(ss * (1.0f / 64.0f) + 1e-6f);
  a = a * rs * gn[2 * i]; b = b * rs * gn[2 * i + 1];
  const int tl = tok % L;
  const float pos = (i < 16) ? (float)(tl >> 6) : (float)(tl & 63);
  const int jj = i & 15;
  const float inv = powf(10000.0f, -(float)(2 * jj) / 32.0f);
  const float ang = pos * inv;
  const float c = cosf(ang), s = sinf(ang);
  *ptr = pack2(a * c - b * s, a * s + b * c);
}

DI void transpose_item(const Params& P, int layer, const u16* __restrict__ p, int L, int kind, int ct, int tt, u16* __restrict__ dst, char* smem) {
  u16* tile = (u16*)smem;
  const int tid = otid() & 255;
  const int t0 = tt * 64;
  const int seq = t0 / L, tl0 = t0 - seq * L;
  const int C = (kind == 0) ? 128 : 512;
  __syncthreads();
  {
    const int col = tid & 63, r0 = tid >> 6;
    const int cidx = ct * 64 + col;
    if (kind < 2) {
      const int off = (kind == 0 ? OFF_GV : OFF_DV) + cidx;
#pragma unroll
      for (int i = 0; i < 16; ++i) { const int row = r0 + 4 * i; tile[col * 72 + row] = p[(size_t)(t0 + row) * INC + off]; }
    } else {
      const float* cw = P.hy_conv_w + layer * 3 * 1536; const float* cb = P.hy_conv_b + layer * 1536;
      const int c1 = 512 + cidx, c2 = 1024 + cidx;
      const float w10 = cw[c1], w11 = cw[1536 + c1], w12 = cw[3072 + c1], b1 = cb[c1];
      const float w20 = cw[c2], w21 = cw[1536 + c2], w22 = cw[3072 + c2], b2 = cb[c2];
#pragma unroll
      for (int i = 0; i < 16; ++i) {
        const int row = r0 + 4 * i; const int tl = tl0 + row;
        const u16* pr = p + (size_t)(t0 + row) * INC;
        const float xm1 = (tl > 0) ? bf2f(pr[c1 - INC]) : 0.f, x0 = bf2f(pr[c1]), xp1 = (tl < L - 1) ? bf2f(pr[c1 + INC]) : 0.f;
        const float vm1 = (tl > 0) ? bf2f(pr[c2 - INC]) : 0.f, v0 = bf2f(pr[c2]), vp1 = (tl < L - 1) ? bf2f(pr[c2 + INC]) : 0.f;
        const float x1c = xm1 * w10 + x0 * w11 + xp1 * w12 + b1;
        const float vc = vm1 * w20 + v0 * w21 + vp1 * w22 + b2;
        tile[col * 72 + row] = f2bf(vc * x1c);
      }
    }
  }
  __syncthreads();
  {
    const int c = tid >> 2, q = tid & 3;
    const u32x4 a = *(const u32x4*)(tile + c * 72 + q * 16), b = *(const u32x4*)(tile + c * 72 + q * 16 + 8);
    u16* d = dst + ((size_t)seq * C + ct * 64 + c) * L + tl0 + q * 16;
    *(u32x4*)d = a; *(u32x4*)(d + 8) = b;
  }
}

template <int DV, bool BIAS>
DI void attn_tile(const u16* __restrict__ Qp, const u16* __restrict__ Kp, const u16* __restrict__ VTp, int L,
                  u16* __restrict__ Op, int ldo, int q0, const float* __restrict__ btab, char* smem) {
  constexpr int NDT = DV / 32;
  constexpr int VCH = DV / 32;
  constexpr int KS_SZ = 64 * 72, VS_SZ = DV * 68;
  u16* Ks = (u16*)smem;
  u16* Vs = Ks + 2 * KS_SZ;
  float* bt = (float*)(Vs + 2 * VS_SZ);
  const int tid = otid() & 255, lane = tid & 63, w = __builtin_amdgcn_readfirstlane(tid >> 6), r = lane & 31, h = lane >> 5;
  const float sc = 0.125f * LOG2E;
  __syncthreads();
  if (BIAS) { for (int i = tid; i < 257; i += 256) bt[i] = btab[i]; }
  bf16x8 qf[4];
  {
    const u16* qrow = Qp + (size_t)(q0 + 32 * w + r) * INC + 8 * h;
#pragma unroll
    for (int s = 0; s < 4; ++s) qf[s] = *(const bf16x8*)(qrow + 16 * s);
  }
  const int qpos = q0 + 32 * w + r;
  f32x16 O[NDT];
#pragma unroll
  for (int d = 0; d < NDT; ++d)
#pragma unroll
    for (int q = 0; q < 16; ++q) O[d][q] = 0.f;
  float m = -INFINITY, l = 0.f;
  const int lrow = tid >> 3, lcc = tid & 7;
  u32x4 rk[2], rv[VCH];
  const u16* Kg = Kp + (size_t)lrow * INC + lcc * 8;
  const u16* Vg = VTp + (size_t)lrow * L + lcc * 8;
#pragma unroll
  for (int i = 0; i < 2; ++i) rk[i] = *(const u32x4*)(Kg + (size_t)(32 * i) * INC);
#pragma unroll
  for (int i = 0; i < VCH; ++i) rv[i] = *(const u32x4*)(Vg + (size_t)(32 * i) * L);
#pragma unroll
  for (int i = 0; i < 2; ++i) *(u32x4*)(Ks + (lrow + 32 * i) * 72 + lcc * 8) = rk[i];
#pragma unroll
  for (int i = 0; i < VCH; ++i) {
    u16* d = Vs + (lrow + 32 * i) * 68 + lcc * 8;
    u32x2 lo, hi; lo[0] = rv[i][0]; lo[1] = rv[i][1]; hi[0] = rv[i][2]; hi[1] = rv[i][3];
    *(u32x2*)d = lo; *(u32x2*)(d + 4) = hi;
  }
  __syncthreads();
  const int nkb = L >> 6;
  for (int kb = 0; kb < nkb; ++kb) {
    const int buf = kb & 1;
    if (kb + 1 < nkb) {
      const size_t ko = (size_t)(kb + 1) * 64;
#pragma unroll
      for (int i = 0; i < 2; ++i) rk[i] = *(const u32x4*)(Kg + (ko + 32 * i) * INC);
#pragma unroll
      for (int i = 0; i < VCH; ++i) rv[i] = *(const u32x4*)(Vg + (size_t)(32 * i) * L + ko);
    }
    const u16* Kb = Ks + buf * KS_SZ; const u16* Vb = Vs + buf * VS_SZ;
    f32x16 S[2];
#pragma unroll
    for (int kt = 0; kt < 2; ++kt) {
#pragma unroll
      for (int q = 0; q < 16; ++q) S[kt][q] = 0.f;
#pragma unroll
      for (int s = 0; s < 4; ++s) {
        const bf16x8 a = *(const bf16x8*)(Kb + (32 * kt + r) * 72 + 16 * s + 8 * h);
        S[kt] = MFMA(a, qf[s], S[kt]);
      }
    }
    if (BIAS) {
      const int kmin = kb * 64;
      if (kmin - (q0 + 127) >= 128) {
        const float cb = bt[256];
#pragma unroll
        for (int kt = 0; kt < 2; ++kt)
#pragma unroll
          for (int q = 0; q < 16; ++q) S[kt][q] = S[kt][q] * sc + cb;
      } else if (q0 - (kmin + 63) >= 128) {
        const float cb = bt[0];
#pragma unroll
        for (int kt = 0; kt < 2; ++kt)
#pragma unroll
          for (int q = 0; q < 16; ++q) S[kt][q] = S[kt][q] * sc + cb;
      } else {
#pragma unroll
        for (int kt = 0; kt < 2; ++kt)
#pragma unroll
          for (int q = 0; q < 16; ++q) {
            int rel = kmin + 32 * kt + crow(q, h) - qpos;
            rel = rel < -128 ? -128 : (rel > 128 ? 128 : rel);
            S[kt][q] = S[kt][q] * sc + bt[rel + 128];
          }
      }
    } else {
#pragma unroll
      for (int kt = 0; kt < 2; ++kt)
#pragma unroll
        for (int q = 0; q < 16; ++q) S[kt][q] *= sc;
    }
    float mx = S[0][0];
#pragma unroll
    for (int kt = 0; kt < 2; ++kt)
#pragma unroll
      for (int q = 0; q < 16; ++q) mx = fmaxf(mx, S[kt][q]);
    mx = fmaxf(mx, __shfl_xor(mx, 32));
    const float mn = fmaxf(m, mx);
    const float alpha = __builtin_amdgcn_exp2f(m - mn);
    m = mn;
    l *= alpha;
#pragma unroll
    for (int d = 0; d < NDT; ++d)
#pragma unroll
      for (int q = 0; q < 16; ++q) O[d][q] *= alpha;
    bf16x8 pf[2][2];
#pragma unroll
    for (int kt = 0; kt < 2; ++kt) {
#pragma unroll
      for (int q = 0; q < 16; ++q) { const float pv = __builtin_amdgcn_exp2f(S[kt][q] - mn); S[kt][q] = pv; l += pv; }
#pragma unroll
      for (int s = 0; s < 2; ++s) {
        u32x4 pk;
#pragma unroll
        for (int q = 0; q < 4; ++q) pk[q] = pack2(S[kt][8 * s + 2 * q], S[kt][8 * s + 2 * q + 1]);
        pf[kt][s] = __builtin_bit_cast(bf16x8, pk);
      }
    }
#pragma unroll
    for (int kt = 0; kt < 2; ++kt)
#pragma unroll
      for (int s = 0; s < 2; ++s)
#pragma unroll
        for (int d = 0; d < NDT; ++d) {
          const u16* vp = Vb + (32 * d + r) * 68 + 32 * kt + 16 * s + 4 * h;
          const u32x2 lo = *(const u32x2*)vp, hi = *(const u32x2*)(vp + 8);
          u32x4 av; av[0] = lo[0]; av[1] = lo[1]; av[2] = hi[0]; av[3] = hi[1];
          O[d] = MFMA(__builtin_bit_cast(bf16x8, av), pf[kt][s], O[d]);
        }
    if (kb + 1 < nkb) {
      u16* Kw = Ks + (buf ^ 1) * KS_SZ; u16* Vw = Vs + (buf ^ 1) * VS_SZ;
#pragma unroll
      for (int i = 0; i < 2; ++i) *(u32x4*)(Kw + (lrow + 32 * i) * 72 + lcc * 8) = rk[i];
#pragma unroll
      for (int i = 0; i < VCH; ++i) {
        u16* d = Vw + (lrow + 32 * i) * 68 + lcc * 8;
        u32x2 lo, hi; lo[0] = rv[i][0]; lo[1] = rv[i][1]; hi[0] = rv[i][2]; hi[1] = rv[i][3];
        *(u32x2*)d = lo; *(u32x2*)(d + 4) = hi;
      }
    }
    __syncthreads();
  }
  l += __shfl_xor(l, 32);
  const float inv = 1.0f / l;
  u16* orow = Op + (size_t)qpos * ldo;
#pragma unroll
  for (int d = 0; d < NDT; ++d)
#pragma unroll
    for (int g4 = 0; g4 < 4; ++g4) {
      u32x2 o; o[0] = pack2(O[d][4 * g4] * inv, O[d][4 * g4 + 1] * inv); o[1] = pack2(O[d][4 * g4 + 2] * inv, O[d][4 * g4 + 3] * inv);
      *(u32x2*)(orow + 32 * d + 8 * g4 + 4 * h) = o;
    }
}

DI void hyena_item(int c, const u16* __restrict__ G, const u16* __restrict__ zT, u16* __restrict__ yT, int nseq, int L, char* smem) {
  u16* zs = (u16*)smem;
  u16* fw = zs + 20480;
  const int tid = otid() & 255, lane = tid & 63, w = __builtin_amdgcn_readfirstlane(tid >> 6), r = lane & 31, h = lane >> 5;
  const int ZL = L + 2048;
  __syncthreads();
  for (int q = 0; q < nseq; ++q) {
    const u16* src = zT + ((size_t)q * 512 + c) * L;
    u16* dst = zs + q * ZL;
    const u32x4 zero = {0u, 0u, 0u, 0u};
    for (int i = tid; i < 128; i += 256) { *(u32x4*)(dst + i * 8) = zero; *(u32x4*)(dst + 1024 + L + i * 8) = zero; }
    for (int i = tid; i < (L >> 3); i += 256) *(u32x4*)(dst + 1024 + i * 8) = *(const u32x4*)(src + i * 8);
  }
  int tq[4], tJ[4];
#pragma unroll
  for (int i = 0; i < 4; ++i) { if (nseq == 2) { tq[i] = i & 1; tJ[i] = 2 * w + (i >> 1); } else { tq[i] = 0; tJ[i] = 4 * w + i; } }
  f32x16 acc[4];
#pragma unroll
  for (int i = 0; i < 4; ++i)
#pragma unroll
    for (int q = 0; q < 16; ++q) acc[i][q] = 0.f;
  const int E0 = -L + 16, ELAST = L - 32;
  const int npass = (2 * L - 32 + 8191) / 8192;
  const u16* Gc = G + (size_t)c * (2 * L);
  for (int ps = 0; ps < npass; ++ps) {
    const int ea = E0 + 8192 * ps, eb = ea + 8192;
    const int wb = L - eb - 16;
    __syncthreads();
    for (int i = tid; i < 1032; i += 256) {
      const int gi = wb + i * 8;
      u32x4 v = {0u, 0u, 0u, 0u};
      if (gi >= 0 && gi < 2 * L) v = *(const u32x4*)(Gc + gi);
      *(u32x4*)(fw + i * 8) = v;
    }
    __syncthreads();
    const int eend = (eb - 16 < ELAST) ? (eb - 16) : ELAST;
    for (int e = ea; e <= eend; e += 16) {
      bool in[4]; bool any = false;
#pragma unroll
      for (int i = 0; i < 4; ++i) { in[i] = (e >= 1024 * tJ[i] - L + 16) && (e <= 1024 * tJ[i] + 992); any = any || in[i]; }
      if (!any) continue;
      const int idx0 = L - e - r + 8 * h - wb;
      bf16x8 a;
#pragma unroll
      for (int j = 0; j < 8; ++j) a[j] = (short)fw[idx0 + j];
#pragma unroll
      for (int i = 0; i < 4; ++i) {
        if (in[i]) {
          const bf16x8 b = *(const bf16x8*)(zs + tq[i] * ZL + 1024 + 1024 * tJ[i] + 32 * r - e + 8 * h);
          acc[i] = MFMA(a, b, acc[i]);
        }
      }
    }
  }
#pragma unroll
  for (int i = 0; i < 4; ++i) {
    u16* dst = yT + ((size_t)tq[i] * 512 + c) * L + 1024 * tJ[i] + 32 * r + 4 * h;
#pragma unroll
    for (int g4 = 0; g4 < 4; ++g4) {
      u32x2 o; o[0] = pack2(acc[i][4 * g4], acc[i][4 * g4 + 1]); o[1] = pack2(acc[i][4 * g4 + 2], acc[i][4 * g4 + 3]);
      *(u32x2*)(dst + 8 * g4) = o;
    }
  }
}

DI void diff_post_item(const Params& P, int layer, float lam, float lam_init, const u16* __restrict__ dO, u16* __restrict__ ydf, int it) {
  const int tid = otid() & 255, lane = tid & 63, w = __builtin_amdgcn_readfirstlane(tid >> 6);
  const int u = it * 8 + w * 2 + (lane >> 5);
  const int i = lane & 31;
  const u32x2 a = *(const u32x2*)(dO + (size_t)u * 256 + 4 * i);
  const u32x2 b = *(const u32x2*)(dO + (size_t)u * 256 + 128 + 4 * i);
  float o[4];
  o[0] = bflo(a[0]) - lam * bflo(b[0]); o[1] = bfhi(a[0]) - lam * bfhi(b[0]);
  o[2] = bflo(a[1]) - lam * bflo(b[1]); o[3] = bfhi(a[1]) - lam * bfhi(b[1]);
  const float ss = half_sum(o[0] * o[0] + o[1] * o[1] + o[2] * o[2] + o[3] * o[3]);
  const float rs = rsqrtf(ss * (1.0f / 128.0f) + 1e-5f) * (1.0f - lam_init);
  const float* g = P.diff_subln + layer * 128 + 4 * i;
  u32x2 ov; ov[0] = pack2(o[0] * rs * g[0], o[1] * rs * g[1]); ov[1] = pack2(o[2] * rs * g[2], o[3] * rs * g[3]);
  *(u32x2*)(ydf + (size_t)u * 128 + 4 * i) = ov;
}
DI void hyena_post_item(const Params& P, int layer, const u16* __restrict__ p, int L, const u16* __restrict__ yT, const u16* __restrict__ zT,
                        int ct, int tt, u16* __restrict__ yhy, char* smem) {
  float* tile = (float*)smem;
  const int tid = otid() & 255;
  const int t0 = tt * 64; const int seq = t0 / L, tl0 = t0 - seq * L;
  __syncthreads();
  {
    const int tcol = tid & 63, c0 = tid >> 6;
#pragma unroll
    for (int i = 0; i < 16; ++i) {
      const int cc = c0 + 4 * i; const int c = ct * 64 + cc;
      const size_t gi = ((size_t)seq * 512 + c) * L + tl0 + tcol;
      tile[cc * 65 + tcol] = bf2f(yT[gi]) + bf2f(zT[gi]) * P.hy_skip[layer * 512 + c];
    }
  }
  __syncthreads();
  {
    const int col = tid & 63, r0 = tid >> 6; const int c = ct * 64 + col;
    const float* cw = P.hy_conv_w + layer * 3 * 1536; const float* cb = P.hy_conv_b + layer * 1536;
    const float w0 = cw[c], w1 = cw[1536 + c], w2 = cw[3072 + c], b0 = cb[c];
#pragma unroll
    for (int i = 0; i < 16; ++i) {
      const int row = r0 + 4 * i; const int tl = tl0 + row;
      const u16* pr = p + (size_t)(t0 + row) * INC + c;
      const float xm1 = (tl > 0) ? bf2f(pr[-INC]) : 0.f, x0 = bf2f(pr[0]), xp1 = (tl < L - 1) ? bf2f(pr[INC]) : 0.f;
      const float x0c = xm1 * w0 + x0 * w1 + xp1 * w2 + b0;
      yhy[(size_t)(t0 + row) * 512 + c] = f2bf(x0c * tile[col * 65 + row]);
    }
  }
}

__global__ void __launch_bounds__(512) fwd_megakernel(Params P) {
  cg::grid_group grid = cg::this_grid();
  __shared__ __attribute__((aligned(16))) char smem[SMEM_BYTES];
  __shared__ uint4 xb_words;
  const int nb = gridDim.x, bid = blockIdx.x, nb2 = nb * 2;
  char* ws = P.ws;
  if (threadIdx.x == 0) xb_words = make_uint4(0u, 0u, 0u, 0u);
  __syncthreads();
  XcdBarrier xb = xcd_barrier_post((unsigned*)(ws + O_BAR), (volatile LAS unsigned*)&xb_words);
  u16* Wf1in = (u16*)(ws + O_F1IN); u16* Wf1out = (u16*)(ws + O_F1OUT); u16* Win = (u16*)(ws + O_WIN); u16* Wbr = (u16*)(ws + O_WBR);
  u16* Wout = (u16*)(ws + O_WOUT); u16* Wf2in = (u16*)(ws + O_F2IN); u16* Wf2out = (u16*)(ws + O_F2OUT);
  u16* filt8 = (u16*)(ws + O_FILT8); u16* filt16 = (u16*)(ws + O_FILT16);
  float* misc = (float*)(ws + O_MISC);
  u16* pbuf = (u16*)(ws + O_P); u16* hid = pbuf; u16* hn = (u16*)(ws + O_HN); u16* merged = hn;
  u16* zT = (u16*)(ws + O_ZT); u16* yT = (u16*)(ws + O_YT); u16* dO = (u16*)(ws + O_DIFFO); float* macc = (float*)(ws + O_ZT);
  u16* vtg = (u16*)(ws + O_VTG); u16* vtd = (u16*)(ws + O_VTD);
  u16* yhy = (u16*)(ws + O_YHY); u16* ygq = (u16*)(ws + O_YGQ); u16* ydf = (u16*)(ws + O_YDF);

  for (int layer = 0; layer < 2; ++layer) {
    { PHASE_IDS();
    {
      const int n1 = 16 * 88, n2 = 44 * 16, n3 = 16 * 108, n4 = 3 * 8 * 16, n5 = 16 * 16;
      const int nconv = n1 + n2 + n3 + n4 + n5 + n1 + n2;
      const int nfilt = 128 + 256;
      const int total = nconv + nfilt;
      for (int it = bid2; it < total; it += nb2) {
        int t = it;
        if (t < nfilt) {
          const bool big = t < 256;
          filter_item(P, layer, big ? 16384 : 8192, big ? t : t - 256, big ? filt16 : filt8, smg);
          continue;
        }
        t -= nfilt;
        if (t < n1) { convT_tile(P.ffn1_w_in + (size_t)layer * 1024 * 5632, 1024, 5632, Wf1in, t / 88, t % 88, 2816, smg); continue; } t -= n1;
        if (t < n2) { convT_tile(P.ffn1_w_out + (size_t)layer * 2816 * 1024, 2816, 1024, Wf1out, t / 16, t % 16, 0, smg); continue; } t -= n2;
        if (t < n3) { convT_tile(P.w_in + (size_t)layer * 1024 * 6912, 1024, 6912, Win, t / 108, t % 108, 0, smg); continue; } t -= n3;
        if (t < n4) { const int br = t / 128, tt = t % 128;
          convT_tile(P.w_branch + ((size_t)layer * 3 + br) * 512 * 1024, 512, 1024, Wbr + (size_t)br * 1024 * 512, tt / 16, tt % 16, 0, smg); continue; } t -= n4;
        if (t < n5) { convT_tile(P.w_out + (size_t)layer * 1024 * 1024, 1024, 1024, Wout, t / 16, t % 16, 0, smg); continue; } t -= n5;
        if (t < n1) { convT_tile(P.ffn2_w_in + (size_t)layer * 1024 * 5632, 1024, 5632, Wf2in, t / 88, t % 88, 2816, smg); continue; } t -= n1;
        if (t < n2) { convT_tile(P.ffn2_w_out + (size_t)layer * 2816 * 1024, 2816, 1024, Wf2out, t / 16, t % 16, 0, smg); continue; } t -= n2;
      }
      if (bid == 0 && grp == 0) {
        const int tid = t_;
        if (tid < 2) {
          const float* lp = P.diff_lambda + tid * 256;
          float s1 = 0.f, s2 = 0.f;
          for (int i = 0; i < 64; ++i) { s1 += lp[i] * lp[64 + i]; s2 += lp[128 + i] * lp[192 + i]; }
          const float lam_init = 0.8f - 0.6f * expf(-0.3f * (float)tid);
          misc[tid] = expf(s1) - expf(s2) + lam_init;
        }
        for (int i = tid; i < 4 * 257; i += 256) {
          const int hh = i / 257, idx = i % 257; const int rel = idx - 128; const int n = rel < 0 ? -rel : rel;
          int b;
          if (n < 8) b = n; else { int lg = 8 + (int)(logf((float)n / 8.0f) / 2.772588722239781f * 8.0f); b = lg < 15 ? lg : 15; }
          if (rel > 0) b += 16;
          misc[64 + i] = P.rel_bias[b * 4 + hh] * LOG2E;
        }
      }
    }
    }
    if (layer == 0) grid.sync(); else GSYNC();
    const float lam = misc[layer];
    const float lam_init = 0.8f - 0.6f * expf(-0.3f * (float)layer);

    for (int ch = 0; ch < 3; ++ch) {
      const int nseq = (ch < 2) ? 2 : 1, L = (ch < 2) ? 8192 : 16384;
      const float* xin0 = (ch < 2) ? (P.x_prompt + (size_t)ch * TCH * DM) : P.x_sample;
      float* xres = P.out + (size_t)ch * TCH * DM;
      const float* xcur = (layer == 0) ? xin0 : xres;
      const u16* filt = (ch < 2) ? filt8 : filt16;

      { PHASE_IDS();
      for (int rp = 0; rp < REP_SMALL; ++rp) for (int it = bid2; it < TCH / 4; it += nb2) { const int row = it * 4 + w; norm_row_bf16(xcur + (size_t)row * DM, P.ffn1_norm + layer * DM, hn + (size_t)row * DM, lane); }
      }
      GSYNC();
      { PHASE_IDS();
      { GemmArgs g{}; g.A = hn; g.lda = DM; g.Bt = Wf1in; g.ldb = DM; g.K = DM; g.outb = hid; g.ldo = DFF;
        for (int rp = 0; rp < REP_GEMM; ++rp) for (int it = vb; it < 64 * 22; it += nb) { int mt_, nt_; tile_map(it, 22, mt_, nt_); gemm_tile<EPI_SWIGLU>(g, mt_, nt_, smem); } }
      }
      GSYNC();
      { PHASE_IDS();
      { GemmArgs g{}; g.A = hid; g.lda = DFF; g.Bt = Wf1out; g.ldb = DFF; g.K = DFF; g.xin = xcur; g.xout = xres; g.scale = 0.5f;
        for (int rp = 0; rp < REP_GEMM; ++rp) { if (rp > 0) { g.xin = xres; g.scale = 0.f; } for (int it = vb; it < 64 * 4; it += nb) { int mt_, nt_; tile_map(it, 4, mt_, nt_); gemm_tile<EPI_RESID>(g, mt_, nt_, smem); } } }
      }
      GSYNC();
      { PHASE_IDS();
      for (int rp = 0; rp < REP_SMALL; ++rp) for (int it = bid2; it < TCH / 4; it += nb2) { const int row = it * 4 + w; norm_row_bf16(xres + (size_t)row * DM, P.mix_norm + layer * DM, hn + (size_t)row * DM, lane); }
      }
      GSYNC();
      { PHASE_IDS();
      { GemmArgs g{}; g.A = hn; g.lda = DM; g.Bt = Win; g.ldb = DM; g.K = DM; g.outb = pbuf; g.ldo = INC;
        for (int rp = 0; rp < REP_GEMM; ++rp) for (int it = vb; it < 64 * 27; it += nb) { int mt_, nt_; tile_map(it, 27, mt_, nt_); gemm_tile<EPI_PROJ>(g, mt_, nt_, smem); } }
      }
      GSYNC();
      { PHASE_IDS();
      {
        const int nqk = TCH * 10 / 8, ntr = 256 * 18;
        for (int it = bid2; it < nqk + ntr; it += nb2) {
          if (it < nqk) { qk_prep_item(P, layer, pbuf, L, it); continue; }
          const int t = it - nqk; const int tt = t / 18, cc = t % 18;
          if (cc < 2) transpose_item(P, layer, pbuf, L, 0, cc, tt, vtg, smg);
          else if (cc < 10) transpose_item(P, layer, pbuf, L, 1, cc - 2, tt, vtd, smg);
          else transpose_item(P, layer, pbuf, L, 2, cc - 10, tt, zT, smg);
        }
      }
      }
      GSYNC();
      { PHASE_IDS();
      {
        const int nqt = L / 128;
        const int ndiff = nseq * 8 * nqt, ngqa = nseq * 8 * nqt, nhy = 512;
        const int nrep = (REP_ATTN > REP_HY) ? REP_ATTN : REP_HY;
        for (int rp = 0; rp < nrep; ++rp) for (int it = bid2; it < ndiff + ngqa + nhy; it += nb2) {
          if (it < ndiff + ngqa ? (rp >= REP_ATTN) : (rp >= REP_HY)) continue;
          if (it < ndiff) {
            const int qt = it % nqt; const int hc = (it / nqt) & 7; const int seq = it / (nqt * 8);
            const int hh = hc >> 1, cc = hc & 1;
            const size_t tb = (size_t)seq * L;
            attn_tile<128, true>(pbuf + tb * INC + OFF_DQ + hc * 64, pbuf + tb * INC + OFF_DK + hc * 64,
                                 vtd + ((size_t)seq * 512 + hh * 128) * L, L,
                                 dO + tb * 1024 + (hh * 2 + cc) * 128, 1024, qt * 128, misc + 64 + hh * 257, smg);
          } else if (it < ndiff + ngqa) {
            const int t = it - ndiff;
            const int qt = t % nqt; const int hd = (t / nqt) & 7; const int seq = t / (nqt * 8);
            const int kvh = hd >> 2;
            const size_t tb = (size_t)seq * L;
            attn_tile<64, false>(pbuf + tb * INC + OFF_GQ + hd * 64, pbuf + tb * INC + OFF_GK + kvh * 64,
                                 vtg + ((size_t)seq * 128 + kvh * 64) * L, L,
                                 ygq + tb * 512 + hd * 64, 512, qt * 128, nullptr, smg);
          } else {
            hyena_item(it - ndiff - ngqa, filt, zT, yT, nseq, L, smg);
          }
        }
      }
      }
      GSYNC();
      { PHASE_IDS();
      {
        const int ndp = TCH * 4 / 8, nhp = 256 * 8;
        for (int rp = 0; rp < REP_SMALL; ++rp) for (int it = bid2; it < ndp + nhp; it += nb2) {
          if (it < ndp) diff_post_item(P, layer, lam, lam_init, dO, ydf, it);
          else { const int t = it - ndp; hyena_post_item(P, layer, pbuf, L, yT, zT, t % 8, t / 8, yhy, smg); }
        }
      }
      }
      GSYNC();
      { PHASE_IDS();
      {
        for (int rp = 0; rp < REP_GEMM; ++rp) for (int it = vb; it < 64 * 4; it += nb) {
          int mt_, nt_; tile_map(it, 4, mt_, nt_);
          for (int br = 0; br < 3; ++br) {
            GemmArgs g{}; g.A = (br == 0) ? yhy : (br == 1 ? ygq : ydf); g.lda = 512; g.Bt = Wbr + (size_t)br * 1024 * 512; g.ldb = 512; g.K = 512;
            g.gate = pbuf; g.macc = macc; g.outb = merged; g.br = br;
            gemm_tile<EPI_MERGE>(g, mt_, nt_, smem);
          }
        }
      }
      }
      GSYNC();
      { PHASE_IDS();
      { GemmArgs g{}; g.A = merged; g.lda = DM; g.Bt = Wout; g.ldb = DM; g.K = DM; g.xin = xres; g.xout = xres; g.scale = 1.0f;
        for (int rp = 0; rp < REP_GEMM; ++rp) { if (rp > 0) { g.xin = xres; g.scale = 0.f; } for (int it = vb; it < 64 * 4; it += nb) { int mt_, nt_; tile_map(it, 4, mt_, nt_); gemm_tile<EPI_RESID>(g, mt_, nt_, smem); } } }
      }
      GSYNC();
      { PHASE_IDS();
      for (int rp = 0; rp < REP_SMALL; ++rp) for (int it = bid2; it < TCH / 4; it += nb2) { const int row = it * 4 + w; norm_row_bf16(xres + (size_t)row * DM, P.ffn2_norm + layer * DM, hn + (size_t)row * DM, lane); }
      }
      GSYNC();
      { PHASE_IDS();
      { GemmArgs g{}; g.A = hn; g.lda = DM; g.Bt = Wf2in; g.ldb = DM; g.K = DM; g.outb = hid; g.ldo = DFF;
        for (int rp = 0; rp < REP_GEMM; ++rp) for (int it = vb; it < 64 * 22; it += nb) { int mt_, nt_; tile_map(it, 22, mt_, nt_); gemm_tile<EPI_SWIGLU>(g, mt_, nt_, smem); } }
      }
      GSYNC();
      { PHASE_IDS();
      { GemmArgs g{}; g.A = hid; g.lda = DFF; g.Bt = Wf2out; g.ldb = DFF; g.K = DFF; g.xin = xres; g.xout = xres; g.scale = 0.5f;
        for (int rp = 0; rp < REP_GEMM; ++rp) { if (rp > 0) { g.xin = xres; g.scale = 0.f; } for (int it = vb; it < 64 * 4; it += nb) { int mt_, nt_; tile_map(it, 4, mt_, nt_); gemm_tile<EPI_RESID>(g, mt_, nt_, smem); } } }
      }
      GSYNC();
    }
  }
  { PHASE_IDS();
  for (int it = bid2; it < NTOK / 4; it += nb2) { const int row = it * 4 + w; norm_row_f32_inplace(P.out + (size_t)row * DM, P.final_norm, lane); }
  }
}

extern "C" void kernel_launch(void* const* d_in, const int* in_sizes, int n_in, void* d_out, int out_size, void* d_ws, size_t ws_size,
                              hipStream_t stream) {
  static int grid_blocks = 0;
  if (!grid_blocks) {
    int dev = 0, cus = 0, per_cu = 0;
    (void)hipGetDevice(&dev);
    (void)hipDeviceGetAttribute(&cus, hipDeviceAttributeMultiprocessorCount, dev);
    (void)hipOccupancyMaxActiveBlocksPerMultiprocessor(&per_cu, fwd_megakernel, 512, 0);
    if (per_cu < 1) per_cu = 1;
    if (per_cu > 1) per_cu = 1;
    grid_blocks = cus * per_cu;
  }
  Params p{};
  const float* const* in = (const float* const*)d_in;
  p.x_prompt = in[0]; p.x_sample = in[1]; p.ffn1_norm = in[2]; p.ffn1_w_in = in[3]; p.ffn1_w_out = in[4]; p.mix_norm = in[5]; p.w_in = in[6];
  p.hy_conv_w = in[7]; p.hy_conv_b = in[8]; p.hy_w1 = in[9]; p.hy_b1 = in[10]; p.hy_w2 = in[11]; p.hy_b2 = in[12]; p.hy_w3 = in[13];
  p.hy_freq = in[14]; p.hy_skip = in[15]; p.gqa_q_norm = in[16]; p.gqa_k_norm = in[17]; p.diff_lambda = in[18]; p.diff_subln = in[19];
  p.rel_bias = in[20]; p.w_branch = in[21]; p.w_out = in[22]; p.ffn2_norm = in[23]; p.ffn2_w_in = in[24]; p.ffn2_w_out = in[25]; p.final_norm = in[26];
  p.out = (float*)d_out; p.ws = (char*)d_ws;
  void* args[] = {&p};
  (void)hipMemsetAsync((char*)d_ws + O_BAR, 0, XCD_BAR_WORDS * 4, stream);
  hipError_t e = hipLaunchCooperativeKernel((void*)fwd_megakernel, dim3(grid_blocks), dim3(512), args, 0, stream);
  if (e != hipSuccess) fprintf(stderr, "cooperative launch failed: %s (grid %d)\n", hipGetErrorString(e), grid_blocks);
}
```

```cpp
#include <hip/hip_runtime.h>
#include <hip/hip_cooperative_groups.h>
#include <stdint.h>
#include <cstdio>
namespace cg = cooperative_groups;

typedef unsigned short u16;
typedef __attribute__((ext_vector_type(8))) short bf16x8;
typedef __attribute__((ext_vector_type(16))) float f32x16;
typedef __attribute__((ext_vector_type(4))) float f32x4;
typedef __attribute__((ext_vector_type(4))) unsigned u32x4;
typedef __attribute__((ext_vector_type(2))) unsigned u32x2;
typedef __attribute__((ext_vector_type(2))) __bf16 bf2_t;
typedef __attribute__((ext_vector_type(2))) float f2_t;
#define DI __device__ __forceinline__
#define MFMA(a, b, c) __builtin_amdgcn_mfma_f32_32x32x16_bf16((a), (b), (c), 0, 0, 0)

constexpr int DM = 1024, DFF = 2816, INC = 6912, TCH = 16384, NTOK = 49152;
constexpr int OFF_GQ = 1536, OFF_GK = 2048, OFF_GV = 2176, OFF_DQ = 2304, OFF_DK = 2816, OFF_DV = 3328, OFF_GATE = 3840;
constexpr float LOG2E = 1.4426950408889634f;

constexpr size_t SZ_F1IN = (size_t)5632 * 1024 * 2, SZ_F1OUT = (size_t)1024 * 2816 * 2, SZ_WIN = (size_t)6912 * 1024 * 2,
                 SZ_WBR = (size_t)3 * 1024 * 512 * 2, SZ_WOUT = (size_t)1024 * 1024 * 2;
constexpr size_t O_F1IN = 0, O_F1OUT = O_F1IN + SZ_F1IN, O_WIN = O_F1OUT + SZ_F1OUT, O_WBR = O_WIN + SZ_WIN, O_WOUT = O_WBR + SZ_WBR,
                 O_F2IN = O_WOUT + SZ_WOUT, O_F2OUT = O_F2IN + SZ_F1IN, O_FILT8 = O_F2OUT + SZ_F1OUT,
                 O_FILT16 = O_FILT8 + (size_t)512 * 16384 * 2, O_MISC = O_FILT16 + (size_t)512 * 32768 * 2,
                 O_P = O_MISC + 65536, O_HN = O_P + (size_t)TCH * INC * 2, O_ZT = O_HN + (size_t)TCH * 1024 * 2,
                 O_YT = O_ZT + (size_t)TCH * 512 * 2, O_DIFFO = O_YT + (size_t)TCH * 512 * 2, O_VTG = O_DIFFO + (size_t)TCH * 1024 * 2,
                 O_VTD = O_VTG + (size_t)TCH * 128 * 2, O_YHY = O_VTD + (size_t)TCH * 512 * 2, O_YGQ = O_YHY + (size_t)TCH * 512 * 2,
                 O_YDF = O_YGQ + (size_t)TCH * 512 * 2, O_END = O_YDF + (size_t)TCH * 512 * 2;
static_assert(O_END <= (size_t)536870912, "workspace overflow");
constexpr int SMEM_BYTES = 131072;
#define REPMASK 0
#define REP_SYNC 1
#define PHASE_IDS() const int t_ = otid(); const int lane = t_ & 63; const int grp = __builtin_amdgcn_readfirstlane(t_ >> 8); \
  const int w = __builtin_amdgcn_readfirstlane((t_ >> 6) & 3); const int bid2 = bid * 2 + grp; char* smg = smem + grp * 61440; \
  const int vb = (bid & 7) * (nb >> 3) + (bid >> 3); (void)lane; (void)w; (void)bid2; (void)smg; (void)vb
#define GSYNC() do { for (int rs_ = 0; rs_ < REP_SYNC; ++rs_) xcd_barrier(xb); } while (0)


#define XB_TMO      128
#define XB_XCNT(j)  (256  + 64 * (j))
#define XB_XSUB(j)  (1280 + 64 * (j))
#define XB_XGEN(j)  (2304 + 64 * (j))
#define XB_TOP      3328
#define XB_TOPGEN   3392
#define XCD_BAR_WORDS 3456
#define XB_SPIN_CAP (1u << 21)
#define LAS __attribute__((address_space(3)))
DI unsigned xb_ld(unsigned* p)              { return __hip_atomic_load(p, __ATOMIC_RELAXED, __HIP_MEMORY_SCOPE_AGENT); }
DI unsigned xb_add(unsigned* p, unsigned v) { return __hip_atomic_fetch_add(p, v, __ATOMIC_RELAXED, __HIP_MEMORY_SCOPE_AGENT); }
DI unsigned xb_xcc_id() { return (unsigned)__builtin_amdgcn_s_getreg((3 << 11) | 20) & 0xFu; }
#define XB_SPIN(cond, bar) do { unsigned _sp = 0; while (cond) { __builtin_amdgcn_s_sleep(1); \
    if ((++_sp & 255u) == 0u) { if (xb_ld(&(bar)[XB_TMO])) break; if (_sp > XB_SPIN_CAP) { atomicAdd(&(bar)[XB_TMO], 1u); break; } } } } while (0)
struct XcdBarrier { unsigned* bar; unsigned x; volatile LAS unsigned* st; };
DI XcdBarrier xcd_barrier_post(unsigned* bar, volatile LAS unsigned* st) {
  XcdBarrier b; b.bar = bar; b.x = xb_xcc_id(); b.st = st;
  if (threadIdx.x == 0) (void)xb_add(&bar[XB_XCNT(b.x)], 1u);
  return b;
}
DI void xcd_barrier_complete(unsigned* bar, unsigned x, unsigned& nloc, unsigned& nx) {
  const unsigned G = gridDim.x * gridDim.y * gridDim.z;
  unsigned sum, cnt, mine, sp = 0u;
  for (;;) {
    sum = 0u; cnt = 0u; mine = 0u;
#pragma unroll
    for (unsigned j = 0; j < 16; ++j) { const unsigned c = xb_ld(&bar[XB_XCNT(j)]); sum += c; cnt += (c > 0u) ? 1u : 0u; mine = (j == x) ? c : mine; }
    if (sum == G) break;
    __builtin_amdgcn_s_sleep(1);
    if ((++sp & 255u) == 0u) { if (xb_ld(&bar[XB_TMO])) break; if (sp > XB_SPIN_CAP) { atomicAdd(&bar[XB_TMO], 1u); break; } }
  }
  nloc = mine > 0u ? mine : 1u; nx = cnt > 0u ? cnt : 1u;
}
DI void xcd_barrier(const XcdBarrier& b) {
  asm volatile("s_waitcnt vmcnt(0)" ::: "memory");
  __syncthreads();
  if (threadIdx.x == 0) {
    unsigned* bar = b.bar;
    __builtin_amdgcn_s_waitcnt(0);
    unsigned nloc = b.st[0], nx = b.st[1];
    if (nloc == 0u) { xcd_barrier_complete(bar, b.x, nloc, nx); b.st[0] = nloc; b.st[1] = nx; }
    const unsigned old = xb_add(&bar[XB_XSUB(b.x)], 1u);
    const unsigned gen = old / nloc;
    if (old + 1u == (gen + 1u) * nloc) {
      __builtin_amdgcn_fence(__ATOMIC_RELEASE, "agent");
      asm volatile("s_waitcnt vmcnt(0)" ::: "memory");
      const unsigned og = xb_add(&bar[XB_TOP], 1u);
      const unsigned tg = og / nx;
      if (og + 1u == (tg + 1u) * nx) xb_add(&bar[XB_TOPGEN], 1u);
      else XB_SPIN(xb_ld(&bar[XB_TOPGEN]) == tg, bar);
      __builtin_amdgcn_fence(__ATOMIC_ACQUIRE, "agent");
      xb_add(&bar[XB_XGEN(b.x)], 1u);
      asm volatile("s_waitcnt vmcnt(0)" ::: "memory");
    } else {
      XB_SPIN(xb_ld(&bar[XB_XGEN(b.x)]) == gen, bar);
      __builtin_amdgcn_fence(__ATOMIC_ACQUIRE, "agent");
      asm volatile("s_waitcnt vmcnt(0)" ::: "memory");
    }
  }
  __syncthreads();
}
constexpr size_t O_BAR = O_MISC + 16384;

struct Params {
  const float* x_prompt; const float* x_sample;
  const float* ffn1_norm; const float* ffn1_w_in; const float* ffn1_w_out; const float* mix_norm; const float* w_in;
  const float* hy_conv_w; const float* hy_conv_b; const float* hy_w1; const float* hy_b1; const float* hy_w2; const float* hy_b2;
  const float* hy_w3; const float* hy_freq; const float* hy_skip;
  const float* gqa_q_norm; const float* gqa_k_norm; const float* diff_lambda; const float* diff_subln; const float* rel_bias;
  const float* w_branch; const float* w_out; const float* ffn2_norm; const float* ffn2_w_in; const float* ffn2_w_out; const float* final_norm;
  float* out; char* ws;
};

DI unsigned pack2(float a, float b) { f2_t v = {a, b}; bf2_t r = __builtin_convertvector(v, bf2_t); return __builtin_bit_cast(unsigned, r); }
DI u16 f2bf(float a) { return (u16)(pack2(a, 0.f) & 0xffffu); }
DI float bf2f(u16 v) { return __uint_as_float(((unsigned)v) << 16); }
DI float bflo(unsigned v) { return __uint_as_float(v << 16); }
DI float bfhi(unsigned v) { return __uint_as_float(v & 0xffff0000u); }
DI int otid() { int t = threadIdx.x; asm volatile("" : "+v"(t)); return t; }
DI int crow(int reg, int h) { return (reg & 3) + 8 * (reg >> 2) + 4 * h; }
DI float wave_sum(float v) {
  v += __shfl_xor(v, 32); v += __shfl_xor(v, 16); v += __shfl_xor(v, 8); v += __shfl_xor(v, 4); v += __shfl_xor(v, 2); v += __shfl_xor(v, 1);
  return v;
}
DI float half_sum(float v) {
  v += __shfl_xor(v, 16); v += __shfl_xor(v, 8); v += __shfl_xor(v, 4); v += __shfl_xor(v, 2); v += __shfl_xor(v, 1);
  return v;
}

DI void convT_tile(const float* __restrict__ src, int K, int N, u16* __restrict__ dst, int kt, int nt, int perm_half, char* smem) {
  float* t = (float*)smem;
  const int tid = otid() & 255;
  __syncthreads();
  {
    const int col = tid & 63, r0 = tid >> 6;
#pragma unroll
    for (int i = 0; i < 16; ++i) { int row = r0 + 4 * i; t[row * 65 + col] = src[(size_t)(kt * 64 + row) * N + nt * 64 + col]; }
  }
  __syncthreads();
  {
    const int nl = tid >> 2, kq = tid & 3;
    int n = nt * 64 + nl;
    if (perm_half > 0) { if (n < perm_half) n = (n >> 7) * 256 + (n & 127); else { int j = n - perm_half; n = (j >> 7) * 256 + 128 + (j & 127); } }
    u32x4 o0, o1;
#pragma unroll
    for (int i = 0; i < 4; ++i) {
      o0[i] = pack2(t[(kq * 16 + 2 * i) * 65 + nl], t[(kq * 16 + 2 * i + 1) * 65 + nl]);
      o1[i] = pack2(t[(kq * 16 + 8 + 2 * i) * 65 + nl], t[(kq * 16 + 8 + 2 * i + 1) * 65 + nl]);
    }
    u16* d = dst + (size_t)n * K + kt * 64 + kq * 16;
    *(u32x4*)d = o0; *(u32x4*)(d + 8) = o1;
  }
}

DI void filter_item(const Params& P, int layer, int L, int tb, u16* __restrict__ G, char* smem) {
  float* h1 = (float*)smem;
  float* h2 = h1 + 64 * 65;
  const int tid = otid() & 255, lane = tid & 63, w = __builtin_amdgcn_readfirstlane(tid >> 6);
  const float* w1 = P.hy_w1 + layer * 33 * 64; const float* b1 = P.hy_b1 + layer * 64;
  const float* w2 = P.hy_w2 + layer * 64 * 64; const float* b2 = P.hy_b2 + layer * 64;
  const float* w3 = P.hy_w3 + layer * 64 * 1024; const float* fr = P.hy_freq + layer * 64;
  const int t = tb * 64 + lane;
  const float tl = (float)t / (float)(L - 1);
  __syncthreads();
  {
    float a[16];
#pragma unroll
    for (int u = 0; u < 16; ++u) a[u] = b1[w * 16 + u] + tl * w1[w * 16 + u];
    const float base = (float)(2.0 * 3.14159265358979323846 / (double)L) * (float)t;
    for (int b = 0; b < 16; ++b) {
      const float band = 1e-4f + (float)b * ((15.0f - 1e-4f) / 15.0f);
      const float ang = base * band;
      const float cs = cosf(ang), sn = -sinf(ang);
#pragma unroll
      for (int u = 0; u < 16; ++u) a[u] += cs * w1[(1 + b) * 64 + w * 16 + u] + sn * w1[(17 + b) * 64 + w * 16 + u];
    }
#pragma unroll
    for (int u = 0; u < 16; ++u) h1[lane * 65 + w * 16 + u] = sinf(fr[w * 16 + u] * a[u]);
  }
  __syncthreads();
  {
    float a[16];
#pragma unroll
    for (int u = 0; u < 16; ++u) a[u] = b2[w * 16 + u];
    for (int k = 0; k < 64; ++k) {
      const float hv = h1[lane * 65 + k];
#pragma unroll
      for (int u = 0; u < 16; ++u) a[u] += hv * w2[k * 64 + w * 16 + u];
    }
#pragma unroll
    for (int u = 0; u < 16; ++u) h2[lane * 65 + w * 16 + u] = sinf(fr[w * 16 + u] * a[u]);
  }
  __syncthreads();
  const float min_decay = -3.0701134573253946f, max_decay = -15.350567286626973f;
  for (int og = 0; og < 64; ++og) {
    const int o = w * 256 + og * 4;
    float a0 = 0.f, a1 = 0.f, a2 = 0.f, a3 = 0.f;
#pragma unroll 4
    for (int k = 0; k < 64; ++k) {
      const float hv = h2[lane * 65 + k];
      const f32x4 wv = *(const f32x4*)(w3 + k * 1024 + o);
      a0 += hv * wv[0]; a1 += hv * wv[1]; a2 += hv * wv[2]; a3 += hv * wv[3];
    }
    float av[4] = {a0, a1, a2, a3};
#pragma unroll
    for (int q = 0; q < 4; ++q) {
      const int oo = o + q; const int ch = oo & 511;
      const float delta = min_decay + (float)ch * ((max_decay - min_decay) / 511.0f);
      const float val = av[q] * expf(-tl * fabsf(delta));
      u16* Gc = G + (size_t)ch * (2 * L);
      if (oo < 512) Gc[L - t] = f2bf(val);
      else { if (t >= 1) Gc[L + t] = f2bf(val); else Gc[0] = 0; }
    }
  }
}

DI void norm_row_bf16(const float* __restrict__ x, const float* __restrict__ g, u16* __restrict__ out, int lane) {
  f32x4 v[4]; float ss = 0.f;
#pragma unroll
  for (int i = 0; i < 4; ++i) { v[i] = *(const f32x4*)(x + lane * 4 + 256 * i); ss += v[i][0] * v[i][0] + v[i][1] * v[i][1] + v[i][2] * v[i][2] + v[i][3] * v[i][3]; }
  ss = wave_sum(ss);
  const float rs = rsqrtf(ss * (1.0f / 1024.0f) + 1e-6f);
#pragma unroll
  for (int i = 0; i < 4; ++i) {
    const f32x4 gg = *(const f32x4*)(g + lane * 4 + 256 * i);
    u32x2 o; o[0] = pack2(v[i][0] * rs * gg[0], v[i][1] * rs * gg[1]); o[1] = pack2(v[i][2] * rs * gg[2], v[i][3] * rs * gg[3]);
    *(u32x2*)(out + lane * 4 + 256 * i) = o;
  }
}
DI void norm_row_f32_inplace(float* __restrict__ x, const float* __restrict__ g, int lane) {
  f32x4 v[4]; float ss = 0.f;
#pragma unroll
  for (int i = 0; i < 4; ++i) { v[i] = *(const f32x4*)(x + lane * 4 + 256 * i); ss += v[i][0] * v[i][0] + v[i][1] * v[i][1] + v[i][2] * v[i][2] + v[i][3] * v[i][3]; }
  ss = wave_sum(ss);
  const float rs = rsqrtf(ss * (1.0f / 1024.0f) + 1e-6f);
#pragma unroll
  for (int i = 0; i < 4; ++i) {
    const f32x4 gg = *(const f32x4*)(g + lane * 4 + 256 * i);
    f32x4 o; o[0] = v[i][0] * rs * gg[0]; o[1] = v[i][1] * rs * gg[1]; o[2] = v[i][2] * rs * gg[2]; o[3] = v[i][3] * rs * gg[3];
    *(f32x4*)(x + lane * 4 + 256 * i) = o;
  }
}

namespace pg8 {
#define PG8_LAS __attribute__((address_space(3)))
typedef unsigned short bf16_t;
typedef short bf16x8 __attribute__((ext_vector_type(8)));
typedef float f32x4 __attribute__((ext_vector_type(4)));
typedef unsigned u32x4 __attribute__((ext_vector_type(4)));
constexpr int BM = 256, BK = 64, HALF = 128, HTB = HALF * BK * 2  , STAGE_BYTES = 8 * HTB, NXCD = 8, WGM = 8;

__host__ __device__ __forceinline__ int lds_byte(int r, int c) { const int st = (r >> 4) * 2 + (c >> 5), rr = r & 15, cc = c & 31, ob = rr * 64 + cc * 2; return st * 1024 + (ob ^ (((ob >> 9) & 1) << 5)); }
__host__ __device__ __forceinline__ void stage_rc(int b, int& R, int& C) { const int st = b / 1024, sb = b % 1024, swz = sb ^ (((sb >> 9) & 1) << 5); R = (st >> 1) * 16 + swz / 64; C = (st & 1) * 32 + (swz % 64) / 2; }
__host__ __device__ __forceinline__ int perm32(int rho) { const int n = rho >> 4, i = rho & 15; return 8 * (i >> 2) + 4 * n + (i & 3); }

struct Unit { int pm, pn; };
struct Gemm { const bf16_t* A; const bf16_t* Bt; int M, N, K; };

struct StaticOrder {
    int nM, nN, nwg, G, c;
    __host__ __device__ void init(int M, int N, int G_, int c_) { nM = M / BM; nN = N / BM; nwg = nM * nN; G = G_; c = c_; }
    __host__ __device__ bool next(int i, Unit& u) const {
        const long L = (long)i * G + c; if (L >= nwg) return false;
        int wgid = (int)L; { const int q = nwg / NXCD, r = nwg % NXCD, xcd = wgid % NXCD, off = wgid / NXCD; wgid = (xcd < r ? xcd * (q + 1) : r * (q + 1) + (xcd - r) * q) + off; }
        const int nig = WGM * nN, gid = wgid / nig, fm = gid * WGM, gsz = (nM - fm) < WGM ? (nM - fm) : WGM;
        u.pm = fm + ((wgid % nig) % gsz); u.pn = (wgid % nig) / gsz; return true;
    }
    __device__ __forceinline__ void a_ready(const Unit&) const {}
    __device__ __forceinline__ void done(const Unit&) const {}
};

template <class Epi, class Sched, bool STAMP = false>
__device__ __forceinline__ void gemm_phase(PG8_LAS unsigned char* lds, const Gemm g, const Sched& S, const Epi& E, unsigned long long* stamps) {
    const int tid = otid(), wid = __builtin_amdgcn_readfirstlane(tid >> 6), lane = tid & 63, wr = wid >> 2, wc = wid & 3, fr = lane & 15, fq = lane >> 4;
    const int K = g.K, nt = K / BK;
    int ts_lo = 0, ts_hi = 0, nts = 0; const unsigned long long rt_entry = STAMP ? (unsigned long long)wall_clock64() : 0ull;
#define PG8_STAMP() do { if (STAMP && wid == 0 && nts < 64) { const unsigned long long _c = (unsigned long long)clock64(); \
        ts_lo = (lane == nts) ? (int)(unsigned)_c : ts_lo; ts_hi = (lane == nts) ? (int)(unsigned)(_c >> 32) : ts_hi; ++nts; } } while (0)
    PG8_STAMP();
    unsigned voffA[2], voffB[2];
#pragma unroll
    for (int i = 0; i < 2; ++i) { int R, C; stage_rc(tid * 16 + i * 8192, R, C); const int Rb = E.perm ? ((R & ~31) + perm32(R & 31)) : R;
        voffA[i] = (unsigned)(R * K + C) * 2u; voffB[i] = (unsigned)(Rb * K + C) * 2u; }
    const size_t kstep = (size_t)(BK * 2);
    const size_t hstep = (size_t)HALF * K * 2;
    const size_t tstep = 2 * hstep;
    const unsigned ldsw = (unsigned)wid * 1024u;
    const int aoff = lds_byte(wr * 64 + fr, fq * 8), boff = lds_byte(wc * 32 + fr, fq * 8);
#define PG8_SA(b, h) (((b) * 2 + (h)) * HTB)
#define PG8_SB(b, h) ((4 + (b) * 2 + (h)) * HTB)
#define PG8_STAGE(bufoff, gbase, voff) do { _Pragma("unroll") for (int _i = 0; _i < 2; ++_i) \
        __builtin_amdgcn_global_load_lds((const unsigned*)((const char*)(gbase) + (voff)[_i]), (PG8_LAS unsigned*)(lds + (bufoff) + ldsw + _i * 8192), 16, 0, 0); } while (0)
#define PG8_LDA(dst, b, h) do { _Pragma("unroll") for (int m = 0; m < 4; ++m) _Pragma("unroll") for (int k = 0; k < 2; ++k) dst[m][k] = *(const PG8_LAS bf16x8*)(lds + PG8_SA(b, h) + aoff + m * 2048 + k * 1024); } while (0)
#define PG8_LDB(dst, b, h) do { _Pragma("unroll") for (int n = 0; n < 2; ++n) _Pragma("unroll") for (int k = 0; k < 2; ++k) dst[n][k] = *(const PG8_LAS bf16x8*)(lds + PG8_SB(b, h) + boff + n * 2048 + k * 1024); } while (0)
#define PG8_MMA(ai, bj, At, Bt) do { __builtin_amdgcn_s_setprio(1); _Pragma("unroll") for (int m = 0; m < 4; ++m) _Pragma("unroll") for (int n = 0; n < 2; ++n) _Pragma("unroll") for (int k = 0; k < 2; ++k) \
        acc[ai][bj][m][n] = __builtin_amdgcn_mfma_f32_16x16x32_bf16(Bt[n][k], At[m][k], acc[ai][bj][m][n], 0, 0, 0); __builtin_amdgcn_s_setprio(0); } while (0)
#define PG8_WAIT_V(n) asm volatile("s_waitcnt vmcnt(" #n ")" ::: "memory")
#define PG8_WAIT_L(n) asm volatile("s_waitcnt lgkmcnt(" #n ")" ::: "memory")
#define PG8_BAR __builtin_amdgcn_s_barrier()
#define PG8_SCHED __builtin_amdgcn_sched_barrier(0)
    Unit cur, nxt; int ui = 0;
    if (!S.next(0, cur)) return;
    f32x4 acc[2][2][4][2];
#pragma unroll
    for (int a = 0; a < 2; ++a)
#pragma unroll
        for (int b = 0; b < 2; ++b)
#pragma unroll
            for (int m = 0; m < 4; ++m)
#pragma unroll
                for (int n = 0; n < 2; ++n) acc[a][b][m][n] = (f32x4){0.f, 0.f, 0.f, 0.f};
    bf16x8 At[4][2], B0[2][2], B1[2][2];
    const char* cA = (const char*)g.A + (size_t)cur.pm * tstep; const char* cB = (const char*)g.Bt + (size_t)cur.pn * tstep;
    S.a_ready(cur);
    PG8_STAGE(PG8_SB(0, 0), cB, voffB); PG8_STAGE(PG8_SA(0, 0), cA, voffA); PG8_STAGE(PG8_SB(0, 1), cB + hstep, voffB); PG8_STAGE(PG8_SA(0, 1), cA + hstep, voffA);
    if (wr == 1) PG8_BAR;
    PG8_WAIT_V(4); PG8_BAR;
    PG8_STAGE(PG8_SB(1, 0), cB + kstep, voffB); PG8_STAGE(PG8_SA(1, 0), cA + kstep, voffA); PG8_STAGE(PG8_SB(1, 1), cB + hstep + kstep, voffB);
    PG8_WAIT_V(6); PG8_BAR;
    PG8_STAMP();
    for (;;) {
        const bool has_next = S.next(ui + 1, nxt);
        const char* nA = has_next ? (const char*)g.A + (size_t)nxt.pm * tstep : cA; const char* nB = has_next ? (const char*)g.Bt + (size_t)nxt.pn * tstep : cB;
        for (int t = 0; t < nt; t += 2) {
            const bool last = (t == nt - 2);
            const char* a1 = cA + (size_t)(t + 1) * kstep;
            const char* a2 = last ? nA : cA + (size_t)(t + 2) * kstep; const char* b2 = last ? nB : cB + (size_t)(t + 2) * kstep;
            const char* a3 = a2 + kstep; const char* b3 = b2 + kstep;
            if (last && has_next) S.a_ready(nxt);
            PG8_LDB(B0, 0, 0); PG8_SCHED; PG8_LDA(At, 0, 0); PG8_STAGE(PG8_SA(1, 1), a1 + hstep, voffA);
            PG8_WAIT_L(8); PG8_BAR; PG8_WAIT_L(0); PG8_MMA(0, 0, At, B0); PG8_BAR; PG8_SCHED;
            PG8_LDB(B1, 0, 1); PG8_STAGE(PG8_SB(0, 0), b2, voffB);
            PG8_BAR; PG8_WAIT_L(0); PG8_MMA(0, 1, At, B1); PG8_BAR;
            PG8_LDA(At, 0, 1); PG8_STAGE(PG8_SA(0, 0), a2, voffA);
            PG8_BAR; PG8_WAIT_L(0); PG8_MMA(1, 0, At, B0); PG8_BAR; PG8_SCHED;
            PG8_STAGE(PG8_SB(0, 1), b2 + hstep, voffB);
            PG8_WAIT_V(6); PG8_BAR; PG8_MMA(1, 1, At, B1); PG8_BAR;
            PG8_LDB(B0, 1, 0); PG8_SCHED; PG8_LDA(At, 1, 0); PG8_STAGE(PG8_SA(0, 1), a2 + hstep, voffA);
            PG8_WAIT_L(8); PG8_BAR; PG8_WAIT_L(0); PG8_MMA(0, 0, At, B0); PG8_BAR; PG8_SCHED;
            PG8_LDB(B1, 1, 1); PG8_STAGE(PG8_SB(1, 0), b3, voffB);
            PG8_BAR; PG8_WAIT_L(0); PG8_MMA(0, 1, At, B1); PG8_BAR;
            PG8_LDA(At, 1, 1); PG8_STAGE(PG8_SA(1, 0), a3, voffA);
            PG8_BAR; PG8_WAIT_L(0); PG8_MMA(1, 0, At, B0); PG8_BAR; PG8_SCHED;
            PG8_STAGE(PG8_SB(1, 1), b3 + hstep, voffB);
            PG8_WAIT_V(6); PG8_BAR; PG8_MMA(1, 1, At, B1); PG8_BAR;
        }
        PG8_STAMP();
        if constexpr (!Epi::AFTER_DRAIN) { E(acc, cur, wr, wc, fr, fq); S.done(cur); }
        PG8_STAMP();
        if (!has_next) break;
#pragma unroll
        for (int a = 0; a < 2; ++a)
#pragma unroll
            for (int b = 0; b < 2; ++b)
#pragma unroll
                for (int m = 0; m < 4; ++m)
#pragma unroll
                    for (int n = 0; n < 2; ++n) acc[a][b][m][n] = (f32x4){0.f, 0.f, 0.f, 0.f};
        cur = nxt; cA = nA; cB = nB; ++ui;
    }
    PG8_WAIT_V(0);
    if (wr == 0) PG8_BAR;
    PG8_BAR;
    if constexpr (Epi::AFTER_DRAIN) { E.fused(acc, cur, wr, wc, fr, fq, lds, wid, lane); S.done(cur); }
    PG8_STAMP();
    if (STAMP && wid == 0) { stamps[lane] = lane < nts ? (((unsigned long long)(unsigned)ts_hi << 32) | (unsigned)ts_lo) : 0ull;
        if (lane == 62) stamps[62] = rt_entry; if (lane == 63) stamps[63] = (unsigned long long)wall_clock64(); }
#undef PG8_STAMP
#undef PG8_SA
#undef PG8_SB
#undef PG8_STAGE
#undef PG8_LDA
#undef PG8_LDB
#undef PG8_MMA
#undef PG8_WAIT_V
#undef PG8_WAIT_L
#undef PG8_BAR
#undef PG8_SCHED
}
}

enum { EPI_SWIGLU = 0, EPI_RESID = 1, EPI_PROJ = 2, EPI_MERGE = 3 };
struct EpiAny {
  static constexpr bool AFTER_DRAIN = false;
  int mode; bool perm;
  u16* O; int ldo; const float* xin; float* xout; float scale; const u16* gate; float* macc; int br;
  DI void operator()(const pg8::f32x4 (&acc)[2][2][4][2], const pg8::Unit& u, int wr, int wc, int fr, int fq) const {
    const int row0 = u.pm * 256 + wr * 64 + fr;
    if (mode == EPI_SWIGLU) {
      const int col0 = u.pn * 128 + wc * 32 + 8 * fq;
#pragma unroll
      for (int ai = 0; ai < 2; ++ai)
#pragma unroll
        for (int m = 0; m < 4; ++m) {
          float v[8];
#pragma unroll
          for (int n = 0; n < 2; ++n)
#pragma unroll
            for (int e = 0; e < 4; ++e) { const float gv = acc[ai][0][m][n][e], uv = acc[ai][1][m][n][e]; v[4 * n + e] = gv / (1.0f + __expf(-gv)) * uv; }
          u32x4 o; o[0] = pack2(v[0], v[1]); o[1] = pack2(v[2], v[3]); o[2] = pack2(v[4], v[5]); o[3] = pack2(v[6], v[7]);
          *(u32x4*)(O + (size_t)(row0 + ai * 128 + m * 16) * ldo + col0) = o;
        }
    } else if (mode == EPI_PROJ) {
      const int col0 = u.pn * 256 + wc * 32 + 8 * fq;
      const bool sg = (u.pn * 256 >= OFF_GATE);
#pragma unroll
      for (int ai = 0; ai < 2; ++ai)
#pragma unroll
        for (int m = 0; m < 4; ++m)
#pragma unroll
          for (int bj = 0; bj < 2; ++bj) {
            float v[8];
#pragma unroll
            for (int n = 0; n < 2; ++n)
#pragma unroll
              for (int e = 0; e < 4; ++e) { float t = acc[ai][bj][m][n][e]; if (sg) t = 1.0f / (1.0f + __expf(-t)); v[4 * n + e] = t; }
            u32x4 o; o[0] = pack2(v[0], v[1]); o[1] = pack2(v[2], v[3]); o[2] = pack2(v[4], v[5]); o[3] = pack2(v[6], v[7]);
            *(u32x4*)(O + (size_t)(row0 + ai * 128 + m * 16) * INC + col0 + bj * 128) = o;
          }
    } else if (mode == EPI_RESID) {
      const int col0 = u.pn * 256 + wc * 32 + 4 * fq;
#pragma unroll
      for (int ai = 0; ai < 2; ++ai)
#pragma unroll
        for (int m = 0; m < 4; ++m)
#pragma unroll
          for (int bj = 0; bj < 2; ++bj)
#pragma unroll
            for (int n = 0; n < 2; ++n) {
              const size_t idx = (size_t)(row0 + ai * 128 + m * 16) * DM + col0 + bj * 128 + n * 16;
              f32x4 xv = *(const f32x4*)(xin + idx);
#pragma unroll
              for (int e = 0; e < 4; ++e) xv[e] += scale * acc[ai][bj][m][n][e];
              *(f32x4*)(xout + idx) = xv;
            }
    } else {
      const int col0 = u.pn * 256 + wc * 32 + 4 * fq;
#pragma unroll
      for (int ai = 0; ai < 2; ++ai)
#pragma unroll
        for (int m = 0; m < 4; ++m)
#pragma unroll
          for (int bj = 0; bj < 2; ++bj)
#pragma unroll
            for (int n = 0; n < 2; ++n) {
              const int row = row0 + ai * 128 + m * 16, col = col0 + bj * 128 + n * 16;
              const u32x2 gt = *(const u32x2*)(gate + (size_t)row * INC + OFF_GATE + br * DM + col);
              f32x4 v;
              v[0] = bflo(gt[0]) * acc[ai][bj][m][n][0]; v[1] = bfhi(gt[0]) * acc[ai][bj][m][n][1];
              v[2] = bflo(gt[1]) * acc[ai][bj][m][n][2]; v[3] = bfhi(gt[1]) * acc[ai][bj][m][n][3];
              const size_t idx = (size_t)row * DM + col;
              if (br > 0) { const f32x4 pv = *(const f32x4*)(macc + idx); v[0] += pv[0]; v[1] += pv[1]; v[2] += pv[2]; v[3] += pv[3]; }
              if (br < 2) *(f32x4*)(macc + idx) = v;
              else { u32x2 o; o[0] = pack2(v[0], v[1]); o[1] = pack2(v[2], v[3]); *(u32x2*)(outb_() + idx) = o; }
            }
    }
  }
  DI u16* outb_() const { return O; }
};

DI void qk_prep_item(const Params& P, int layer, u16* __restrict__ p, int L, int it) {
  const int tid = otid() & 255, lane = tid & 63, w = __builtin_amdgcn_readfirstlane(tid >> 6);
  const int u = it * 8 + w * 2 + (lane >> 5);
  const int tok = u / 10, hd = u - tok * 10;
  const int i = lane & 31;
  const int col0 = (hd < 8) ? (OFF_GQ + hd * 64) : (OFF_GK + (hd - 8) * 64);
  const float* gn = (hd < 8) ? (P.gqa_q_norm + layer * 64) : (P.gqa_k_norm + layer * 64);
  unsigned* ptr = (unsigned*)(p + (size_t)tok * INC + col0) + i;
  const unsigned v = *ptr;
  float a = bflo(v), b = bfhi(v);
  const float ss = half_sum(a * a + b * b);
  const float rs = rsqrtf(ss * (1.0f / 64.0f) + 1e-6f);
  a = a * rs * gn[2 * i]; b = b * rs * gn[2 * i + 1];
  const int tl = tok % L;
  const float pos = (i < 16) ? (float)(tl >> 6) : (float)(tl & 63);
  const int jj = i & 15;
  const float inv = powf(10000.0f, -(float)(2 * jj) / 32.0f);
  const float ang = pos * inv;
  const float c = cosf(ang), s = sinf(ang);
  *ptr = pack2(a * c - b * s, a * s + b * c);
}

DI void transpose_item(const Params& P, int layer, const u16* __restrict__ p, int L, int kind, int ct, int tt, u16* __restrict__ dst, char* smem) {
  u16* tile = (u16*)smem;
  const int tid = otid() & 255;
  const int t0 = tt * 64;
  const int seq = t0 / L, tl0 = t0 - seq * L;
  const int C = (kind == 0) ? 128 : 512;
  __syncthreads();
  {
    const int col = tid & 63, r0 = tid >> 6;
    const int cidx = ct * 64 + col;
    if (kind < 2) {
      const int off = (kind == 0 ? OFF_GV : OFF_DV) + cidx;
#pragma unroll
      for (int i = 0; i < 16; ++i) { const int row = r0 + 4 * i; tile[col * 72 + row] = p[(size_t)(t0 + row) * INC + off]; }
    } else {
      const float* cw = P.hy_conv_w + layer * 3 * 1536; const float* cb = P.hy_conv_b + layer * 1536;
      const int c1 = 512 + cidx, c2 = 1024 + cidx;
      const float w10 = cw[c1], w11 = cw[1536 + c1], w12 = cw[3072 + c1], b1 = cb[c1];
      const float w20 = cw[c2], w21 = cw[1536 + c2], w22 = cw[3072 + c2], b2 = cb[c2];
#pragma unroll
      for (int i = 0; i < 16; ++i) {
        const int row = r0 + 4 * i; const int tl = tl0 + row;
        const u16* pr = p + (size_t)(t0 + row) * INC;
        const float xm1 = (tl > 0) ? bf2f(pr[c1 - INC]) : 0.f, x0 = bf2f(pr[c1]), xp1 = (tl < L - 1) ? bf2f(pr[c1 + INC]) : 0.f;
        const float vm1 = (tl > 0) ? bf2f(pr[c2 - INC]) : 0.f, v0 = bf2f(pr[c2]), vp1 = (tl < L - 1) ? bf2f(pr[c2 + INC]) : 0.f;
        const float x1c = xm1 * w10 + x0 * w11 + xp1 * w12 + b1;
        const float vc = vm1 * w20 + v0 * w21 + vp1 * w22 + b2;
        tile[col * 72 + row] = f2bf(vc * x1c);
      }
    }
  }
  __syncthreads();
  {
    const int c = tid >> 2, q = tid & 3;
    const u32x4 a = *(const u32x4*)(tile + c * 72 + q * 16), b = *(const u32x4*)(tile + c * 72 + q * 16 + 8);
    u16* d = dst + ((size_t)seq * C + ct * 64 + c) * L + tl0 + q * 16;
    *(u32x4*)d = a; *(u32x4*)(d + 8) = b;
  }
}

template <int DV, bool BIAS>
DI void attn_tile(const u16* __restrict__ Qp, const u16* __restrict__ Kp, const u16* __restrict__ VTp, int L,
                  u16* __restrict__ Op, int ldo, int q0, const float* __restrict__ btab, char* smem) {
  constexpr int NDT = DV / 32;
  constexpr int VCH = DV / 32;
  constexpr int KS_SZ = 64 * 72, VS_SZ = DV * 68;
  u16* Ks = (u16*)smem;
  u16* Vs = Ks + 2 * KS_SZ;
  float* bt = (float*)(Vs + 2 * VS_SZ);
  const int tid = otid() & 255, lane = tid & 63, w = __builtin_amdgcn_readfirstlane(tid >> 6), r = lane & 31, h = lane >> 5;
  const float sc = 0.125f * LOG2E;
  __syncthreads();
  if (BIAS) { for (int i = tid; i < 257; i += 256) bt[i] = btab[i]; }
  bf16x8 qf[4];
  {
    const u16* qrow = Qp + (size_t)(q0 + 32 * w + r) * INC + 8 * h;
#pragma unroll
    for (int s = 0; s < 4; ++s) qf[s] = *(const bf16x8*)(qrow + 16 * s);
  }
  const int qpos = q0 + 32 * w + r;
  f32x16 O[NDT];
#pragma unroll
  for (int d = 0; d < NDT; ++d)
#pragma unroll
    for (int q = 0; q < 16; ++q) O[d][q] = 0.f;
  float m = -INFINITY, l = 0.f;
  const int lrow = tid >> 3, lcc = tid & 7;
  u32x4 rk[2], rv[VCH];
  const u16* Kg = Kp + (size_t)lrow * INC + lcc * 8;
  const u16* Vg = VTp + (size_t)lrow * L + lcc * 8;
#pragma unroll
  for (int i = 0; i < 2; ++i) rk[i] = *(const u32x4*)(Kg + (size_t)(32 * i) * INC);
#pragma unroll
  for (int i = 0; i < VCH; ++i) rv[i] = *(const u32x4*)(Vg + (size_t)(32 * i) * L);
#pragma unroll
  for (int i = 0; i < 2; ++i) *(u32x4*)(Ks + (lrow + 32 * i) * 72 + lcc * 8) = rk[i];
#pragma unroll
  for (int i = 0; i < VCH; ++i) {
    u16* d = Vs + (lrow + 32 * i) * 68 + lcc * 8;
    u32x2 lo, hi; lo[0] = rv[i][0]; lo[1] = rv[i][1]; hi[0] = rv[i][2]; hi[1] = rv[i][3];
    *(u32x2*)d = lo; *(u32x2*)(d + 4) = hi;
  }
  __syncthreads();
  const int nkb = L >> 6;
  for (int kb = 0; kb < nkb; ++kb) {
    const int buf = kb & 1;
    if (kb + 1 < nkb) {
      const size_t ko = (size_t)(kb + 1) * 64;
#pragma unroll
      for (int i = 0; i < 2; ++i) rk[i] = *(const u32x4*)(Kg + (ko + 32 * i) * INC);
#pragma unroll
      for (int i = 0; i < VCH; ++i) rv[i] = *(const u32x4*)(Vg + (size_t)(32 * i) * L + ko);
    }
    const u16* Kb = Ks + buf * KS_SZ; const u16* Vb = Vs + buf * VS_SZ;
    f32x16 S[2];
#pragma unroll
    for (int kt = 0; kt < 2; ++kt) {
#pragma unroll
      for (int q = 0; q < 16; ++q) S[kt][q] = 0.f;
#pragma unroll
      for (int s = 0; s < 4; ++s) {
        const bf16x8 a = *(const bf16x8*)(Kb + (32 * kt + r) * 72 + 16 * s + 8 * h);
        S[kt] = MFMA(a, qf[s], S[kt]);
      }
    }
    if (BIAS) {
      const int kmin = kb * 64;
      if (kmin - (q0 + 127) >= 128) {
        const float cb = bt[256];
#pragma unroll
        for (int kt = 0; kt < 2; ++kt)
#pragma unroll
          for (int q = 0; q < 16; ++q) S[kt][q] = S[kt][q] * sc + cb;
      } else if (q0 - (kmin + 63) >= 128) {
        const float cb = bt[0];
#pragma unroll
        for (int kt = 0; kt < 2; ++kt)
#pragma unroll
          for (int q = 0; q < 16; ++q) S[kt][q] = S[kt][q] * sc + cb;
      } else {
#pragma unroll
        for (int kt = 0; kt < 2; ++kt)
#pragma unroll
          for (int q = 0; q < 16; ++q) {
            int rel = kmin + 32 * kt + crow(q, h) - qpos;
            rel = rel < -128 ? -128 : (rel > 128 ? 128 : rel);
            S[kt][q] = S[kt][q] * sc + bt[rel + 128];
          }
      }
    } else {
#pragma unroll
      for (int kt = 0; kt < 2; ++kt)
#pragma unroll
        for (int q = 0; q < 16; ++q) S[kt][q] *= sc;
    }
    float mx = S[0][0];
#pragma unroll
    for (int kt = 0; kt < 2; ++kt)
#pragma unroll
      for (int q = 0; q < 16; ++q) mx = fmaxf(mx, S[kt][q]);
    mx = fmaxf(mx, __shfl_xor(mx, 32));
    const float mn = fmaxf(m, mx);
    const float alpha = __builtin_amdgcn_exp2f(m - mn);
    m = mn;
    l *= alpha;
#pragma unroll
    for (int d = 0; d < NDT; ++d)
#pragma unroll
      for (int q = 0; q < 16; ++q) O[d][q] *= alpha;
    bf16x8 pf[2][2];
#pragma unroll
    for (int kt = 0; kt < 2; ++kt) {
#pragma unroll
      for (int q = 0; q < 16; ++q) { const float pv = __builtin_amdgcn_exp2f(S[kt][q] - mn); S[kt][q] = pv; l += pv; }
#pragma unroll
      for (int s = 0; s < 2; ++s) {
        u32x4 pk;
#pragma unroll
        for (int q = 0; q < 4; ++q) pk[q] = pack2(S[kt][8 * s + 2 * q], S[kt][8 * s + 2 * q + 1]);
        pf[kt][s] = __builtin_bit_cast(bf16x8, pk);
      }
    }
#pragma unroll
    for (int kt = 0; kt < 2; ++kt)
#pragma unroll
      for (int s = 0; s < 2; ++s)
#pragma unroll
        for (int d = 0; d < NDT; ++d) {
          const u16* vp = Vb + (32 * d + r) * 68 + 32 * kt + 16 * s + 4 * h;
          const u32x2 lo = *(const u32x2*)vp, hi = *(const u32x2*)(vp + 8);
          u32x4 av; av[0] = lo[0]; av[1] = lo[1]; av[2] = hi[0]; av[3] = hi[1];
          O[d] = MFMA(__builtin_bit_cast(bf16x8, av), pf[kt][s], O[d]);
        }
    if (kb + 1 < nkb) {
      u16* Kw = Ks + (buf ^ 1) * KS_SZ; u16* Vw = Vs + (buf ^ 1) * VS_SZ;
#pragma unroll
      for (int i = 0; i < 2; ++i) *(u32x4*)(Kw + (lrow + 32 * i) * 72 + lcc * 8) = rk[i];
#pragma unroll
      for (int i = 0; i < VCH; ++i) {
        u16* d = Vw + (lrow + 32 * i) * 68 + lcc * 8;
        u32x2 lo, hi; lo[0] = rv[i][0]; lo[1] = rv[i][1]; hi[0] = rv[i][2]; hi[1] = rv[i][3];
        *(u32x2*)d = lo; *(u32x2*)(d + 4) = hi;
      }
    }
    __syncthreads();
  }
  l += __shfl_xor(l, 32);
  const float inv = 1.0f / l;
  u16* orow = Op + (size_t)qpos * ldo;
#pragma unroll
  for (int d = 0; d < NDT; ++d)
#pragma unroll
    for (int g4 = 0; g4 < 4; ++g4) {
      u32x2 o; o[0] = pack2(O[d][4 * g4] * inv, O[d][4 * g4 + 1] * inv); o[1] = pack2(O[d][4 * g4 + 2] * inv, O[d][4 * g4 + 3] * inv);
      *(u32x2*)(orow + 32 * d + 8 * g4 + 4 * h) = o;
    }
}

DI void hyena_item(int c, const u16* __restrict__ G, const u16* __restrict__ zT, u16* __restrict__ yT, int nseq, int L, char* smem) {
  u16* zs = (u16*)smem;
  u16* fw = zs + 20480;
  const int tid = otid() & 255, lane = tid & 63, w = __builtin_amdgcn_readfirstlane(tid >> 6), r = lane & 31, h = lane >> 5;
  const int ZL = L + 2048;
  __syncthreads();
  for (int q = 0; q < nseq; ++q) {
    const u16* src = zT + ((size_t)q * 512 + c) * L;
    u16* dst = zs + q * ZL;
    const u32x4 zero = {0u, 0u, 0u, 0u};
    for (int i = tid; i < 128; i += 256) { *(u32x4*)(dst + i * 8) = zero; *(u32x4*)(dst + 1024 + L + i * 8) = zero; }
    for (int i = tid; i < (L >> 3); i += 256) *(u32x4*)(dst + 1024 + i * 8) = *(const u32x4*)(src + i * 8);
  }
  int tq[4], tJ[4];
#pragma unroll
  for (int i = 0; i < 4; ++i) { if (nseq == 2) { tq[i] = i & 1; tJ[i] = 2 * w + (i >> 1); } else { tq[i] = 0; tJ[i] = 4 * w + i; } }
  f32x16 acc[4];
#pragma unroll
  for (int i = 0; i < 4; ++i)
#pragma unroll
    for (int q = 0; q < 16; ++q) acc[i][q] = 0.f;
  const int E0 = -L + 16, ELAST = L - 32;
  const int npass = (2 * L - 32 + 8191) / 8192;
  const u16* Gc = G + (size_t)c * (2 * L);
  for (int ps = 0; ps < npass; ++ps) {
    const int ea = E0 + 8192 * ps, eb = ea + 8192;
    const int wb = L - eb - 16;
    __syncthreads();
    for (int i = tid; i < 1032; i += 256) {
      const int gi = wb + i * 8;
      u32x4 v = {0u, 0u, 0u, 0u};
      if (gi >= 0 && gi < 2 * L) v = *(const u32x4*)(Gc + gi);
      *(u32x4*)(fw + i * 8) = v;
    }
    __syncthreads();
    const int eend = (eb - 16 < ELAST) ? (eb - 16) : ELAST;
    for (int e = ea; e <= eend; e += 16) {
      bool in[4]; bool any = false;
#pragma unroll
      for (int i = 0; i < 4; ++i) { in[i] = (e >= 1024 * tJ[i] - L + 16) && (e <= 1024 * tJ[i] + 992); any = any || in[i]; }
      if (!any) continue;
      const int idx0 = L - e - r + 8 * h - wb;
      bf16x8 a;
#pragma unroll
      for (int j = 0; j < 8; ++j) a[j] = (short)fw[idx0 + j];
#pragma unroll
      for (int i = 0; i < 4; ++i) {
        if (in[i]) {
          const bf16x8 b = *(const bf16x8*)(zs + tq[i] * ZL + 1024 + 1024 * tJ[i] + 32 * r - e + 8 * h);
          acc[i] = MFMA(a, b, acc[i]);
        }
      }
    }
  }
#pragma unroll
  for (int i = 0; i < 4; ++i) {
    u16* dst = yT + ((size_t)tq[i] * 512 + c) * L + 1024 * tJ[i] + 32 * r + 4 * h;
#pragma unroll
    for (int g4 = 0; g4 < 4; ++g4) {
      u32x2 o; o[0] = pack2(acc[i][4 * g4], acc[i][4 * g4 + 1]); o[1] = pack2(acc[i][4 * g4 + 2], acc[i][4 * g4 + 3]);
      *(u32x2*)(dst + 8 * g4) = o;
    }
  }
}

DI void diff_post_item(const Params& P, int layer, float lam, float lam_init, const u16* __restrict__ dO, u16* __restrict__ ydf, int it) {
  const int tid = otid() & 255, lane = tid & 63, w = __builtin_amdgcn_readfirstlane(tid >> 6);
  const int u = it * 8 + w * 2 + (lane >> 5);
  const int i = lane & 31;
  const u32x2 a = *(const u32x2*)(dO + (size_t)u * 256 + 4 * i);
  const u32x2 b = *(const u32x2*)(dO + (size_t)u * 256 + 128 + 4 * i);
  float o[4];
  o[0] = bflo(a[0]) - lam * bflo(b[0]); o[1] = bfhi(a[0]) - lam * bfhi(b[0]);
  o[2] = bflo(a[1]) - lam * bflo(b[1]); o[3] = bfhi(a[1]) - lam * bfhi(b[1]);
  const float ss = half_sum(o[0] * o[0] + o[1] * o[1] + o[2] * o[2] + o[3] * o[3]);
  const float rs = rsqrtf(ss * (1.0f / 128.0f) + 1e-5f) * (1.0f - lam_init);
  const float* g = P.diff_subln + layer * 128 + 4 * i;
  u32x2 ov; ov[0] = pack2(o[0] * rs * g[0], o[1] * rs * g[1]); ov[1] = pack2(o[2] * rs * g[2], o[3] * rs * g[3]);
  *(u32x2*)(ydf + (size_t)u * 128 + 4 * i) = ov;
}
DI void hyena_post_item(const Params& P, int layer, const u16* __restrict__ p, int L, const u16* __restrict__ yT, const u16* __restrict__ zT,
                        int ct, int tt, u16* __restrict__ yhy, char* smem) {
  float* tile = (float*)smem;
  const int tid = otid() & 255;
  const int t0 = tt * 64; const int seq = t0 / L, tl0 = t0 - seq * L;
  __syncthreads();
  {
    const int tcol = tid & 63, c0 = tid >> 6;
#pragma unroll
    for (int i = 0; i < 16; ++i) {
      const int cc = c0 + 4 * i; const int c = ct * 64 + cc;
      const size_t gi = ((size_t)seq * 512 + c) * L + tl0 + tcol;
      tile[cc * 65 + tcol] = bf2f(yT[gi]) + bf2f(zT[gi]) * P.hy_skip[layer * 512 + c];
    }
  }
  __syncthreads();
  {
    const int col = tid & 63, r0 = tid >> 6; const int c = ct * 64 + col;
    const float* cw = P.hy_conv_w + layer * 3 * 1536; const float* cb = P.hy_conv_b + layer * 1536;
    const float w0 = cw[c], w1 = cw[1536 + c], w2 = cw[3072 + c], b0 = cb[c];
#pragma unroll
    for (int i = 0; i < 16; ++i) {
      const int row = r0 + 4 * i; const int tl = tl0 + row;
      const u16* pr = p + (size_t)(t0 + row) * INC + c;
      const float xm1 = (tl > 0) ? bf2f(pr[-INC]) : 0.f, x0 = bf2f(pr[0]), xp1 = (tl < L - 1) ? bf2f(pr[INC]) : 0.f;
      const float x0c = xm1 * w0 + x0 * w1 + xp1 * w2 + b0;
      yhy[(size_t)(t0 + row) * 512 + c] = f2bf(x0c * tile[col * 65 + row]);
    }
  }
}

__global__ void __launch_bounds__(512) fwd_megakernel(Params Parg) {
  cg::grid_group grid = cg::this_grid();
  __shared__ __attribute__((aligned(16))) char smem[SMEM_BYTES];
  __shared__ uint4 xb_words;
  const int nb = gridDim.x, bid = blockIdx.x, nb2 = nb * 2;
#define KPARAMS() const Params __attribute__((address_space(4)))* pp_ = (const Params __attribute__((address_space(4)))*)__builtin_amdgcn_kernarg_segment_ptr(); \
  asm volatile("" : "+s"(pp_)); const Params& P = *(const Params*)pp_; char* ws = P.ws
  if (threadIdx.x == 0) xb_words = make_uint4(0u, 0u, 0u, 0u);
  __syncthreads();
  XcdBarrier xb;
  { KPARAMS(); xb = xcd_barrier_post((unsigned*)(ws + O_BAR), (volatile LAS unsigned*)&xb_words); }

  for (int step = 0; step < 80; ++step) {
    const int layer = step / 40, ls = step - layer * 40;
    PHASE_IDS();
    KPARAMS();
    float* misc = (float*)(ws + O_MISC);
    u16* pbuf = (u16*)(ws + O_P); u16* hid = pbuf; u16* hn = (u16*)(ws + O_HN); u16* merged = hn;
    if (ls == 0) {
      u16* filt8 = (u16*)(ws + O_FILT8); u16* filt16 = (u16*)(ws + O_FILT16);
      const int n1 = 16 * 88, n2 = 44 * 16, n3 = 16 * 108, n4 = 3 * 8 * 16, n5 = 16 * 16;
      const int nfilt = 128 + 256;
      const int total = n1 + n2 + n3 + n4 + n5 + n1 + n2 + nfilt;
      for (int it = bid2; it < total; it += nb2) {
        int t = it;
        if (t < nfilt) {
          const bool big = t < 256;
          filter_item(P, layer, big ? 16384 : 8192, big ? t : t - 256, big ? filt16 : filt8, smg);
          continue;
        }
        t -= nfilt;
        const float* src; int K, N, kt, nt, ph = 0; u16* dst;
        if (t < n1) { src = P.ffn1_w_in + (size_t)layer * 1024 * 5632; K = 1024; N = 5632; dst = (u16*)(ws + O_F1IN); kt = t / 88; nt = t % 88; ph = 2816; }
        else if ((t -= n1) < n2) { src = P.ffn1_w_out + (size_t)layer * 2816 * 1024; K = 2816; N = 1024; dst = (u16*)(ws + O_F1OUT); kt = t / 16; nt = t % 16; }
        else if ((t -= n2) < n3) { src = P.w_in + (size_t)layer * 1024 * 6912; K = 1024; N = 6912; dst = (u16*)(ws + O_WIN); kt = t / 108; nt = t % 108; }
        else if ((t -= n3) < n4) { const int br = t / 128, tt = t % 128; src = P.w_branch + ((size_t)layer * 3 + br) * 512 * 1024; K = 512; N = 1024;
                                   dst = (u16*)(ws + O_WBR) + (size_t)br * 1024 * 512; kt = tt / 16; nt = tt % 16; }
        else if ((t -= n4) < n5) { src = P.w_out + (size_t)layer * 1024 * 1024; K = 1024; N = 1024; dst = (u16*)(ws + O_WOUT); kt = t / 16; nt = t % 16; }
        else if ((t -= n5) < n1) { src = P.ffn2_w_in + (size_t)layer * 1024 * 5632; K = 1024; N = 5632; dst = (u16*)(ws + O_F2IN); kt = t / 88; nt = t % 88; ph = 2816; }
        else { t -= n1; src = P.ffn2_w_out + (size_t)layer * 2816 * 1024; K = 2816; N = 1024; dst = (u16*)(ws + O_F2OUT); kt = t / 16; nt = t % 16; }
        convT_tile(src, K, N, dst, kt, nt, ph, smg);
      }
      if (bid == 0 && grp == 0) {
        const int tid = t_;
        if (tid < 2) {
          const float* lp = P.diff_lambda + tid * 256;
          float s1 = 0.f, s2 = 0.f;
          for (int i = 0; i < 64; ++i) { s1 += lp[i] * lp[64 + i]; s2 += lp[128 + i] * lp[192 + i]; }
          const float lam_init = 0.8f - 0.6f * expf(-0.3f * (float)tid);
          misc[tid] = expf(s1) - expf(s2) + lam_init;
        }
        for (int i = tid; i < 4 * 257; i += 256) {
          const int hh = i / 257, idx = i % 257; const int rel = idx - 128; const int n = rel < 0 ? -rel : rel;
          int b;
          if (n < 8) b = n; else { int lg = 8 + (int)(logf((float)n / 8.0f) / 2.772588722239781f * 8.0f); b = lg < 15 ? lg : 15; }
          if (rel > 0) b += 16;
          misc[64 + i] = P.rel_bias[b * 4 + hh] * LOG2E;
        }
      }
      if (step == 0) grid.sync(); else GSYNC();
      continue;
    }
    const int cs = ls - 1; const int ch = cs / 13, st = cs - ch * 13;
    const int nseq = (ch < 2) ? 2 : 1, L = (ch < 2) ? 8192 : 16384;
    const float* xin0 = (ch < 2) ? (P.x_prompt + (size_t)ch * TCH * DM) : P.x_sample;
    float* xres = P.out + (size_t)ch * TCH * DM;
    const float* xcur = (layer == 0) ? xin0 : xres;
    for (int rp_ = 0; rp_ <= ((REPMASK >> st) & 1); ++rp_) {
    if (st == 0 || st == 3 || st == 10) {
      const float* src = (st == 0) ? xcur : xres;
      const float* gn = ((st == 0) ? P.ffn1_norm : (st == 3 ? P.mix_norm : P.ffn2_norm)) + layer * DM;
      for (int it = bid2; it < TCH / 4; it += nb2) { const int row = it * 4 + w; norm_row_bf16(src + (size_t)row * DM, gn, hn + (size_t)row * DM, lane); }
    } else if (st == 1 || st == 2 || st == 4 || st == 8 || st == 9 || st == 11 || st == 12) {
      EpiAny E{}; const u16* A; const u16* Bt; int N, K; int nrep = 1;
      if (st == 1 || st == 11) { A = hn; Bt = (u16*)(ws + (st == 1 ? O_F1IN : O_F2IN)); N = 5632; K = DM; E.mode = EPI_SWIGLU; E.perm = true; E.O = hid; E.ldo = DFF; }
      else if (st == 2 || st == 12) { A = hid; Bt = (u16*)(ws + (st == 2 ? O_F1OUT : O_F2OUT)); N = DM; K = DFF; E.mode = EPI_RESID; E.perm = false;
                                      E.xin = (st == 2) ? xcur : xres; E.xout = xres; E.scale = 0.5f; }
      else if (st == 4) { A = hn; Bt = (u16*)(ws + O_WIN); N = INC; K = DM; E.mode = EPI_PROJ; E.perm = true; E.O = pbuf; }
      else if (st == 8) { A = (u16*)(ws + O_YHY); Bt = (u16*)(ws + O_WBR); N = DM; K = 512; E.mode = EPI_MERGE; E.perm = false; E.gate = pbuf; E.macc = (float*)(ws + O_ZT); E.O = merged; nrep = 3; }
      else { A = merged; Bt = (u16*)(ws + O_WOUT); N = DM; K = DM; E.mode = EPI_RESID; E.perm = false; E.xin = xres; E.xout = xres; E.scale = 1.0f; }
      for (int rp = 0; rp < nrep; ++rp) {
        E.br = rp;
        pg8::Gemm gg{A + (size_t)rp * TCH * 512, Bt + (size_t)rp * 1024 * 512, TCH, N, K};
        pg8::StaticOrder S; S.init(TCH, N, nb, bid);
        pg8::gemm_phase<EpiAny, pg8::StaticOrder, false>((PG8_LAS unsigned char*)smem, gg, S, E, nullptr);
      }
    } else if (st == 5) {
      const int nqk = TCH * 10 / 8, ntr = 256 * 18;
      for (int it = bid2; it < nqk + ntr; it += nb2) {
        if (it < nqk) { qk_prep_item(P, layer, pbuf, L, it); continue; }
        const int t = it - nqk; const int tt = t / 18, cc = t % 18;
        const int kind = (cc < 2) ? 0 : (cc < 10 ? 1 : 2);
        const int ct = (cc < 2) ? cc : (cc < 10 ? cc - 2 : cc - 10);
        u16* dst = (u16*)(ws + (kind == 0 ? O_VTG : (kind == 1 ? O_VTD : O_ZT)));
        transpose_item(P, layer, pbuf, L, kind, ct, tt, dst, smg);
      }
    } else if (st == 6) {
      u16* zT = (u16*)(ws + O_ZT); u16* yT = (u16*)(ws + O_YT); u16* dO = (u16*)(ws + O_DIFFO);
      u16* vtg = (u16*)(ws + O_VTG); u16* vtd = (u16*)(ws + O_VTD); u16* ygq = (u16*)(ws + O_YGQ);
      const u16* filt = (u16*)(ws + ((ch < 2) ? O_FILT8 : O_FILT16));
      const int nqt = L / 128;
      const int ndiff = nseq * 8 * nqt, ngqa = nseq * 8 * nqt, nhy = 512;
      for (int it = bid2; it < ndiff + ngqa + nhy; it += nb2) {
        if (it < ndiff) {
          const int qt = it % nqt; const int hc = (it / nqt) & 7; const int seq = it / (nqt * 8);
          const int hh = hc >> 1, cc = hc & 1;
          const size_t tb = (size_t)seq * L;
          attn_tile<128, true>(pbuf + tb * INC + OFF_DQ + hc * 64, pbuf + tb * INC + OFF_DK + hc * 64,
                               vtd + ((size_t)seq * 512 + hh * 128) * L, L,
                               dO + tb * 1024 + (hh * 2 + cc) * 128, 1024, qt * 128, misc + 64 + hh * 257, smg);
        } else if (it < ndiff + ngqa) {
          const int t = it - ndiff;
          const int qt = t % nqt; const int hd = (t / nqt) & 7; const int seq = t / (nqt * 8);
          const int kvh = hd >> 2;
          const size_t tb = (size_t)seq * L;
          attn_tile<64, false>(pbuf + tb * INC + OFF_GQ + hd * 64, pbuf + tb * INC + OFF_GK + kvh * 64,
                               vtg + ((size_t)seq * 128 + kvh * 64) * L, L,
                               ygq + tb * 512 + hd * 64, 512, qt * 128, nullptr, smg);
        } else {
          hyena_item(it - ndiff - ngqa, filt, zT, yT, nseq, L, smg);
        }
      }
    } else {
      u16* zT = (u16*)(ws + O_ZT); u16* yT = (u16*)(ws + O_YT); u16* dO = (u16*)(ws + O_DIFFO);
      u16* yhy = (u16*)(ws + O_YHY); u16* ydf = (u16*)(ws + O_YDF);
      const float lam = misc[layer];
      const float lam_init = 0.8f - 0.6f * expf(-0.3f * (float)layer);
      const int ndp = TCH * 4 / 8, nhp = 256 * 8;
      for (int it = bid2; it < ndp + nhp; it += nb2) {
        if (it < ndp) diff_post_item(P, layer, lam, lam_init, dO, ydf, it);
        else { const int t = it - ndp; hyena_post_item(P, layer, pbuf, L, yT, zT, t % 8, t / 8, yhy, smg); }
      }
    }
    }
    GSYNC();
  }
  { PHASE_IDS(); KPARAMS(); (void)ws;
    for (int it = bid2; it < NTOK / 4; it += nb2) { const int row = it * 4 + w; norm_row_f32_inplace(P.out + (size_t)row * DM, P.final_norm, lane); }
  }
}

extern "C" void kernel_launch(void* const* d_in, const int* in_sizes, int n_in, void* d_out, int out_size, void* d_ws, size_t ws_size,
                              hipStream_t stream) {
  static int grid_blocks = 0;
  if (!grid_blocks) {
    int dev = 0, cus = 0, per_cu = 0;
    (void)hipGetDevice(&dev);
    (void)hipDeviceGetAttribute(&cus, hipDeviceAttributeMultiprocessorCount, dev);
    (void)hipOccupancyMaxActiveBlocksPerMultiprocessor(&per_cu, fwd_megakernel, 512, 0);
    if (per_cu < 1) per_cu = 1;
    if (per_cu > 1) per_cu = 1;
    grid_blocks = cus * per_cu;
  }
  Params p{};
  const float* const* in = (const float* const*)d_in;
  p.x_prompt = in[0]; p.x_sample = in[1]; p.ffn1_norm = in[2]; p.ffn1_w_in = in[3]; p.ffn1_w_out = in[4]; p.mix_norm = in[5]; p.w_in = in[6];
  p.hy_conv_w = in[7]; p.hy_conv_b = in[8]; p.hy_w1 = in[9]; p.hy_b1 = in[10]; p.hy_w2 = in[11]; p.hy_b2 = in[12]; p.hy_w3 = in[13];
  p.hy_freq = in[14]; p.hy_skip = in[15]; p.gqa_q_norm = in[16]; p.gqa_k_norm = in[17]; p.diff_lambda = in[18]; p.diff_subln = in[19];
  p.rel_bias = in[20]; p.w_branch = in[21]; p.w_out = in[22]; p.ffn2_norm = in[23]; p.ffn2_w_in = in[24]; p.ffn2_w_out = in[25]; p.final_norm = in[26];
  p.out = (float*)d_out; p.ws = (char*)d_ws;
  void* args[] = {&p};
  (void)hipMemsetAsync((char*)d_ws + O_BAR, 0, XCD_BAR_WORDS * 4, stream);
  hipError_t e = hipLaunchCooperativeKernel((void*)fwd_megakernel, dim3(grid_blocks), dim3(512), args, 0, stream);
  if (e != hipSuccess) fprintf(stderr, "cooperative launch failed: %s (grid %d)\n", hipGetErrorString(e), grid_blocks);
}
```

```cpp
#include <hip/hip_runtime.h>
#include <hip/hip_cooperative_groups.h>
#include <stdint.h>
#include <cstdio>
namespace cg = cooperative_groups;

typedef unsigned short u16;
typedef __attribute__((ext_vector_type(8))) short bf16x8;
typedef __attribute__((ext_vector_type(16))) float f32x16;
typedef __attribute__((ext_vector_type(4))) float f32x4;
typedef __attribute__((ext_vector_type(4))) unsigned u32x4;
typedef __attribute__((ext_vector_type(2))) unsigned u32x2;
typedef __attribute__((ext_vector_type(2))) __bf16 bf2_t;
typedef __attribute__((ext_vector_type(2))) float f2_t;
#define DI __device__ __forceinline__
#define MFMA(a, b, c) __builtin_amdgcn_mfma_f32_32x32x16_bf16((a), (b), (c), 0, 0, 0)

constexpr int DM = 1024, DFF = 2816, INC = 6912, TCH = 16384, NTOK = 49152;
constexpr int OFF_GQ = 1536, OFF_GK = 2048, OFF_GV = 2176, OFF_DQ = 2304, OFF_DK = 2816, OFF_DV = 3328, OFF_GATE = 3840;
constexpr float LOG2E = 1.4426950408889634f;

constexpr size_t SZ_F1IN = (size_t)5632 * 1024 * 2, SZ_F1OUT = (size_t)1024 * 2816 * 2, SZ_WIN = (size_t)6912 * 1024 * 2,
                 SZ_WBR = (size_t)3 * 1024 * 512 * 2, SZ_WOUT = (size_t)1024 * 1024 * 2;
constexpr size_t O_F1IN = 0, O_F1OUT = O_F1IN + SZ_F1IN, O_WIN = O_F1OUT + SZ_F1OUT, O_WBR = O_WIN + SZ_WIN, O_WOUT = O_WBR + SZ_WBR,
                 O_F2IN = O_WOUT + SZ_WOUT, O_F2OUT = O_F2IN + SZ_F1IN, O_FILT8 = O_F2OUT + SZ_F1OUT,
                 O_FILT16 = O_FILT8 + (size_t)512 * 16384 * 2, O_MISC = O_FILT16 + (size_t)512 * 32768 * 2,
                 O_P = O_MISC + 65536, O_HN = O_P + (size_t)TCH * INC * 2, O_ZT = O_HN + (size_t)TCH * 1024 * 2,
                 O_YT = O_ZT + (size_t)TCH * 512 * 2, O_DIFFO = O_YT + (size_t)TCH * 512 * 2, O_VTG = O_DIFFO + (size_t)TCH * 1024 * 2,
                 O_VTD = O_VTG + (size_t)TCH * 128 * 2, O_YHY = O_VTD + (size_t)TCH * 512 * 2, O_YGQ = O_YHY + (size_t)TCH * 512 * 2,
                 O_YDF = O_YGQ + (size_t)TCH * 512 * 2, O_END = O_YDF + (size_t)TCH * 512 * 2;
static_assert(O_END <= (size_t)536870912, "workspace overflow");
constexpr int SMEM_BYTES = 131072;
#define REPMASK 0
#define REP_SYNC 1
#define PHASE_IDS() const int t_ = otid(); const int lane = t_ & 63; const int grp = __builtin_amdgcn_readfirstlane(t_ >> 8); \
  const int w = __builtin_amdgcn_readfirstlane((t_ >> 6) & 3); const int bid2 = bid * 2 + grp; char* smg = smem + grp * 61440; \
  const int vb = (bid & 7) * (nb >> 3) + (bid >> 3); (void)lane; (void)w; (void)bid2; (void)smg; (void)vb
#define GSYNC() do { for (int rs_ = 0; rs_ < REP_SYNC; ++rs_) xcd_barrier(xb); } while (0)


#define XB_TMO      128
#define XB_XCNT(j)  (256  + 64 * (j))
#define XB_XSUB(j)  (1280 + 64 * (j))
#define XB_XGEN(j)  (2304 + 64 * (j))
#define XB_TOP      3328
#define XB_TOPGEN   3392
#define XCD_BAR_WORDS 3456
#define XB_SPIN_CAP (1u << 21)
#define LAS __attribute__((address_space(3)))
DI unsigned xb_ld(unsigned* p)              { return __hip_atomic_load(p, __ATOMIC_RELAXED, __HIP_MEMORY_SCOPE_AGENT); }
DI unsigned xb_add(unsigned* p, unsigned v) { return __hip_atomic_fetch_add(p, v, __ATOMIC_RELAXED, __HIP_MEMORY_SCOPE_AGENT); }
DI unsigned xb_xcc_id() { return (unsigned)__builtin_amdgcn_s_getreg((3 << 11) | 20) & 0xFu; }
#define XB_SPIN(cond, bar) do { unsigned _sp = 0; while (cond) { __builtin_amdgcn_s_sleep(1); \
    if ((++_sp & 255u) == 0u) { if (xb_ld(&(bar)[XB_TMO])) break; if (_sp > XB_SPIN_CAP) { atomicAdd(&(bar)[XB_TMO], 1u); break; } } } } while (0)
struct XcdBarrier { unsigned* bar; unsigned x; volatile LAS unsigned* st; };
DI XcdBarrier xcd_barrier_post(unsigned* bar, volatile LAS unsigned* st) {
  XcdBarrier b; b.bar = bar; b.x = xb_xcc_id(); b.st = st;
  if (threadIdx.x == 0) (void)xb_add(&bar[XB_XCNT(b.x)], 1u);
  return b;
}
DI void xcd_barrier_complete(unsigned* bar, unsigned x, unsigned& nloc, unsigned& nx) {
  const unsigned G = gridDim.x * gridDim.y * gridDim.z;
  unsigned sum, cnt, mine, sp = 0u;
  for (;;) {
    sum = 0u; cnt = 0u; mine = 0u;
#pragma unroll
    for (unsigned j = 0; j < 16; ++j) { const unsigned c = xb_ld(&bar[XB_XCNT(j)]); sum += c; cnt += (c > 0u) ? 1u : 0u; mine = (j == x) ? c : mine; }
    if (sum == G) break;
    __builtin_amdgcn_s_sleep(1);
    if ((++sp & 255u) == 0u) { if (xb_ld(&bar[XB_TMO])) break; if (sp > XB_SPIN_CAP) { atomicAdd(&bar[XB_TMO], 1u); break; } }
  }
  nloc = mine > 0u ? mine : 1u; nx = cnt > 0u ? cnt : 1u;
}
DI void xcd_barrier(const XcdBarrier& b) {
  asm volatile("s_waitcnt vmcnt(0)" ::: "memory");
  __syncthreads();
  if (threadIdx.x == 0) {
    unsigned* bar = b.bar;
    __builtin_amdgcn_s_waitcnt(0);
    unsigned nloc = b.st[0], nx = b.st[1];
    if (nloc == 0u) { xcd_barrier_complete(bar, b.x, nloc, nx); b.st[0] = nloc; b.st[1] = nx; }
    const unsigned old = xb_add(&bar[XB_XSUB(b.x)], 1u);
    const unsigned gen = old / nloc;
    if (old + 1u == (gen + 1u) * nloc) {
      __builtin_amdgcn_fence(__ATOMIC_RELEASE, "agent");
      asm volatile("s_waitcnt vmcnt(0)" ::: "memory");
      const unsigned og = xb_add(&bar[XB_TOP], 1u);
      const unsigned tg = og / nx;
      if (og + 1u == (tg + 1u) * nx) xb_add(&bar[XB_TOPGEN], 1u);
      else XB_SPIN(xb_ld(&bar[XB_TOPGEN]) == tg, bar);
      __builtin_amdgcn_fence(__ATOMIC_ACQUIRE, "agent");
      xb_add(&bar[XB_XGEN(b.x)], 1u);
      asm volatile("s_waitcnt vmcnt(0)" ::: "memory");
    } else {
      XB_SPIN(xb_ld(&bar[XB_XGEN(b.x)]) == gen, bar);
      __builtin_amdgcn_fence(__ATOMIC_ACQUIRE, "agent");
      asm volatile("s_waitcnt vmcnt(0)" ::: "memory");
    }
  }
  __syncthreads();
}
constexpr size_t O_BAR = O_MISC + 16384;

struct Params {
  const float* x_prompt; const float* x_sample;
  const float* ffn1_norm; const float* ffn1_w_in; const float* ffn1_w_out; const float* mix_norm; const float* w_in;
  const float* hy_conv_w; const float* hy_conv_b; const float* hy_w1; const float* hy_b1; const float* hy_w2; const float* hy_b2;
  const float* hy_w3; const float* hy_freq; const float* hy_skip;
  const float* gqa_q_norm; const float* gqa_k_norm; const float* diff_lambda; const float* diff_subln; const float* rel_bias;
  const float* w_branch; const float* w_out; const float* ffn2_norm; const float* ffn2_w_in; const float* ffn2_w_out; const float* final_norm;
  float* out; char* ws;
};

DI unsigned pack2(float a, float b) { f2_t v = {a, b}; bf2_t r = __builtin_convertvector(v, bf2_t); return __builtin_bit_cast(unsigned, r); }
DI u16 f2bf(float a) { return (u16)(pack2(a, 0.f) & 0xffffu); }
DI float bf2f(u16 v) { return __uint_as_float(((unsigned)v) << 16); }
DI float bflo(unsigned v) { return __uint_as_float(v << 16); }
DI float bfhi(unsigned v) { return __uint_as_float(v & 0xffff0000u); }
DI int otid() { int t = threadIdx.x; asm volatile("" : "+v"(t)); return t; }
DI int crow(int reg, int h) { return (reg & 3) + 8 * (reg >> 2) + 4 * h; }
DI float wave_sum(float v) {
  v += __shfl_xor(v, 32); v += __shfl_xor(v, 16); v += __shfl_xor(v, 8); v += __shfl_xor(v, 4); v += __shfl_xor(v, 2); v += __shfl_xor(v, 1);
  return v;
}
DI float half_sum(float v) {
  v += __shfl_xor(v, 16); v += __shfl_xor(v, 8); v += __shfl_xor(v, 4); v += __shfl_xor(v, 2); v += __shfl_xor(v, 1);
  return v;
}

DI void convT_tile(const float* __restrict__ src, int K, int N, u16* __restrict__ dst, int kt, int nt, int perm_half, char* smem) {
  float* t = (float*)smem;
  const int tid = otid() & 255;
  __syncthreads();
  {
    const int col = tid & 63, r0 = tid >> 6;
#pragma unroll
    for (int i = 0; i < 16; ++i) { int row = r0 + 4 * i; t[row * 65 + col] = src[(size_t)(kt * 64 + row) * N + nt * 64 + col]; }
  }
  __syncthreads();
  {
    const int nl = tid >> 2, kq = tid & 3;
    int n = nt * 64 + nl;
    if (perm_half > 0) { if (n < perm_half) n = (n >> 7) * 256 + (n & 127); else { int j = n - perm_half; n = (j >> 7) * 256 + 128 + (j & 127); } }
    u32x4 o0, o1;
#pragma unroll
    for (int i = 0; i < 4; ++i) {
      o0[i] = pack2(t[(kq * 16 + 2 * i) * 65 + nl], t[(kq * 16 + 2 * i + 1) * 65 + nl]);
      o1[i] = pack2(t[(kq * 16 + 8 + 2 * i) * 65 + nl], t[(kq * 16 + 8 + 2 * i + 1) * 65 + nl]);
    }
    u16* d = dst + (size_t)n * K + kt * 64 + kq * 16;
    *(u32x4*)d = o0; *(u32x4*)(d + 8) = o1;
  }
}

DI void filter_item(const Params& P, int layer, int L, int tb, u16* __restrict__ G, char* smem) {
  float* h1 = (float*)smem;
  float* h2 = h1 + 64 * 65;
  const int tid = otid() & 255, lane = tid & 63, w = __builtin_amdgcn_readfirstlane(tid >> 6);
  const float* w1 = P.hy_w1 + layer * 33 * 64; const float* b1 = P.hy_b1 + layer * 64;
  const float* w2 = P.hy_w2 + layer * 64 * 64; const float* b2 = P.hy_b2 + layer * 64;
  const float* w3 = P.hy_w3 + layer * 64 * 1024; const float* fr = P.hy_freq + layer * 64;
  const int t = tb * 64 + lane;
  const float tl = (float)t / (float)(L - 1);
  __syncthreads();
  {
    float a[16];
#pragma unroll
    for (int u = 0; u < 16; ++u) a[u] = b1[w * 16 + u] + tl * w1[w * 16 + u];
    const float base = (float)(2.0 * 3.14159265358979323846 / (double)L) * (float)t;
    for (int b = 0; b < 16; ++b) {
      const float band = 1e-4f + (float)b * ((15.0f - 1e-4f) / 15.0f);
      const float ang = base * band;
      const float cs = cosf(ang), sn = -sinf(ang);
#pragma unroll
      for (int u = 0; u < 16; ++u) a[u] += cs * w1[(1 + b) * 64 + w * 16 + u] + sn * w1[(17 + b) * 64 + w * 16 + u];
    }
#pragma unroll
    for (int u = 0; u < 16; ++u) h1[lane * 65 + w * 16 + u] = sinf(fr[w * 16 + u] * a[u]);
  }
  __syncthreads();
  {
    float a[16];
#pragma unroll
    for (int u = 0; u < 16; ++u) a[u] = b2[w * 16 + u];
    for (int k = 0; k < 64; ++k) {
      const float hv = h1[lane * 65 + k];
#pragma unroll
      for (int u = 0; u < 16; ++u) a[u] += hv * w2[k * 64 + w * 16 + u];
    }
#pragma unroll
    for (int u = 0; u < 16; ++u) h2[lane * 65 + w * 16 + u] = sinf(fr[w * 16 + u] * a[u]);
  }
  __syncthreads();
  const float min_decay = -3.0701134573253946f, max_decay = -15.350567286626973f;
  for (int og = 0; og < 64; ++og) {
    const int o = w * 256 + og * 4;
    float a0 = 0.f, a1 = 0.f, a2 = 0.f, a3 = 0.f;
#pragma unroll 4
    for (int k = 0; k < 64; ++k) {
      const float hv = h2[lane * 65 + k];
      const f32x4 wv = *(const f32x4*)(w3 + k * 1024 + o);
      a0 += hv * wv[0]; a1 += hv * wv[1]; a2 += hv * wv[2]; a3 += hv * wv[3];
    }
    float av[4] = {a0, a1, a2, a3};
#pragma unroll
    for (int q = 0; q < 4; ++q) {
      const int oo = o + q; const int ch = oo & 511;
      const float delta = min_decay + (float)ch * ((max_decay - min_decay) / 511.0f);
      const float val = av[q] * expf(-tl * fabsf(delta));
      u16* Gc = G + (size_t)ch * (2 * L);
      if (oo < 512) Gc[L - t] = f2bf(val);
      else { if (t >= 1) Gc[L + t] = f2bf(val); else Gc[0] = 0; }
    }
  }
}

DI void norm_row_bf16(const float* __restrict__ x, const float* __restrict__ g, u16* __restrict__ out, int lane) {
  f32x4 v[4]; float ss = 0.f;
#pragma unroll
  for (int i = 0; i < 4; ++i) { v[i] = *(const f32x4*)(x + lane * 4 + 256 * i); ss += v[i][0] * v[i][0] + v[i][1] * v[i][1] + v[i][2] * v[i][2] + v[i][3] * v[i][3]; }
  ss = wave_sum(ss);
  const float rs = rsqrtf(ss * (1.0f / 1024.0f) + 1e-6f);
#pragma unroll
  for (int i = 0; i < 4; ++i) {
    const f32x4 gg = *(const f32x4*)(g + lane * 4 + 256 * i);
    u32x2 o; o[0] = pack2(v[i][0] * rs * gg[0], v[i][1] * rs * gg[1]); o[1] = pack2(v[i][2] * rs * gg[2], v[i][3] * rs * gg[3]);
    *(u32x2*)(out + lane * 4 + 256 * i) = o;
  }
}
DI void norm_row_f32_inplace(float* __restrict__ x, const float* __restrict__ g, int lane) {
  f32x4 v[4]; float ss = 0.f;
#pragma unroll
  for (int i = 0; i < 4; ++i) { v[i] = *(const f32x4*)(x + lane * 4 + 256 * i); ss += v[i][0] * v[i][0] + v[i][1] * v[i][1] + v[i][2] * v[i][2] + v[i][3] * v[i][3]; }
  ss = wave_sum(ss);
  const float rs = rsqrtf(ss * (1.0f / 1024.0f) + 1e-6f);
#pragma unroll
  for (int i = 0; i < 4; ++i) {
    const f32x4 gg = *(const f32x4*)(g + lane * 4 + 256 * i);
    f32x4 o; o[0] = v[i][0] * rs * gg[0]; o[1] = v[i][1] * rs * gg[1]; o[2] = v[i][2] * rs * gg[2]; o[3] = v[i][3] * rs * gg[3];
    *(f32x4*)(x + lane * 4 + 256 * i) = o;
  }
}

namespace pg8 {
#define PG8_LAS __attribute__((address_space(3)))
typedef unsigned short bf16_t;
typedef short bf16x8 __attribute__((ext_vector_type(8)));
typedef float f32x4 __attribute__((ext_vector_type(4)));
typedef unsigned u32x4 __attribute__((ext_vector_type(4)));
constexpr int BM = 256, BK = 64, HALF = 128, HTB = HALF * BK * 2  , STAGE_BYTES = 8 * HTB, NXCD = 8, WGM = 8;

__host__ __device__ __forceinline__ int lds_byte(int r, int c) { const int st = (r >> 4) * 2 + (c >> 5), rr = r & 15, cc = c & 31, ob = rr * 64 + cc * 2; return st * 1024 + (ob ^ (((ob >> 9) & 1) << 5)); }
__host__ __device__ __forceinline__ void stage_rc(int b, int& R, int& C) { const int st = b / 1024, sb = b % 1024, swz = sb ^ (((sb >> 9) & 1) << 5); R = (st >> 1) * 16 + swz / 64; C = (st & 1) * 32 + (swz % 64) / 2; }
__host__ __device__ __forceinline__ int perm32(int rho) { const int n = rho >> 4, i = rho & 15; return 8 * (i >> 2) + 4 * n + (i & 3); }

struct Unit { int pm, pn; };
struct Gemm { const bf16_t* A; const bf16_t* Bt; int M, N, K; };

struct StaticOrder {
    int nM, nN, nwg, G, c;
    __host__ __device__ void init(int M, int N, int G_, int c_) { nM = M / BM; nN = N / BM; nwg = nM * nN; G = G_; c = c_; }
    __host__ __device__ bool next(int i, Unit& u) const {
        const long L = (long)i * G + c; if (L >= nwg) return false;
        int wgid = (int)L; { const int q = nwg / NXCD, r = nwg % NXCD, xcd = wgid % NXCD, off = wgid / NXCD; wgid = (xcd < r ? xcd * (q + 1) : r * (q + 1) + (xcd - r) * q) + off; }
        const int nig = WGM * nN, gid = wgid / nig, fm = gid * WGM, gsz = (nM - fm) < WGM ? (nM - fm) : WGM;
        u.pm = fm + ((wgid % nig) % gsz); u.pn = (wgid % nig) / gsz; return true;
    }
    __device__ __forceinline__ void a_ready(const Unit&) const {}
    __device__ __forceinline__ void done(const Unit&) const {}
};

template <class Epi, class Sched, bool STAMP = false>
__device__ __forceinline__ void gemm_phase(PG8_LAS unsigned char* lds, const Gemm g, const Sched& S, const Epi& E, unsigned long long* stamps) {
    const int tid = otid(), wid = __builtin_amdgcn_readfirstlane(tid >> 6), lane = tid & 63, wr = wid >> 2, wc = wid & 3, fr = lane & 15, fq = lane >> 4;
    const int K = g.K, nt = K / BK;
    int ts_lo = 0, ts_hi = 0, nts = 0; const unsigned long long rt_entry = STAMP ? (unsigned long long)wall_clock64() : 0ull;
#define PG8_STAMP() do { if (STAMP && wid == 0 && nts < 64) { const unsigned long long _c = (unsigned long long)clock64(); \
        ts_lo = (lane == nts) ? (int)(unsigned)_c : ts_lo; ts_hi = (lane == nts) ? (int)(unsigned)(_c >> 32) : ts_hi; ++nts; } } while (0)
    PG8_STAMP();
    unsigned voffA[2], voffB[2];
#pragma unroll
    for (int i = 0; i < 2; ++i) { int R, C; stage_rc(tid * 16 + i * 8192, R, C); const int Rb = E.perm ? ((R & ~31) + perm32(R & 31)) : R;
        voffA[i] = (unsigned)(R * K + C) * 2u; voffB[i] = (unsigned)(Rb * K + C) * 2u; }
    const size_t kstep = (size_t)(BK * 2);
    const size_t hstep = (size_t)HALF * K * 2;
    const size_t tstep = 2 * hstep;
    const unsigned ldsw = (unsigned)wid * 1024u;
    const int aoff = lds_byte(wr * 64 + fr, fq * 8), boff = lds_byte(wc * 32 + fr, fq * 8);
#define PG8_SA(b, h) (((b) * 2 + (h)) * HTB)
#define PG8_SB(b, h) ((4 + (b) * 2 + (h)) * HTB)
#define PG8_STAGE(bufoff, gbase, voff) do { _Pragma("unroll") for (int _i = 0; _i < 2; ++_i) \
        __builtin_amdgcn_global_load_lds((const unsigned*)((const char*)(gbase) + (voff)[_i]), (PG8_LAS unsigned*)(lds + (bufoff) + ldsw + _i * 8192), 16, 0, 0); } while (0)
#define PG8_LDA(dst, b, h) do { _Pragma("unroll") for (int m = 0; m < 4; ++m) _Pragma("unroll") for (int k = 0; k < 2; ++k) dst[m][k] = *(const PG8_LAS bf16x8*)(lds + PG8_SA(b, h) + aoff + m * 2048 + k * 1024); } while (0)
#define PG8_LDB(dst, b, h) do { _Pragma("unroll") for (int n = 0; n < 2; ++n) _Pragma("unroll") for (int k = 0; k < 2; ++k) dst[n][k] = *(const PG8_LAS bf16x8*)(lds + PG8_SB(b, h) + boff + n * 2048 + k * 1024); } while (0)
#define PG8_MMA(ai, bj, At, Bt) do { __builtin_amdgcn_s_setprio(1); _Pragma("unroll") for (int m = 0; m < 4; ++m) _Pragma("unroll") for (int n = 0; n < 2; ++n) _Pragma("unroll") for (int k = 0; k < 2; ++k) \
        acc[ai][bj][m][n] = __builtin_amdgcn_mfma_f32_16x16x32_bf16(Bt[n][k], At[m][k], acc[ai][bj][m][n], 0, 0, 0); __builtin_amdgcn_s_setprio(0); } while (0)
#define PG8_WAIT_V(n) asm volatile("s_waitcnt vmcnt(" #n ")" ::: "memory")
#define PG8_WAIT_L(n) asm volatile("s_waitcnt lgkmcnt(" #n ")" ::: "memory")
#define PG8_BAR __builtin_amdgcn_s_barrier()
#define PG8_SCHED __builtin_amdgcn_sched_barrier(0)
    Unit cur, nxt; int ui = 0;
    if (!S.next(0, cur)) return;
    f32x4 acc[2][2][4][2];
#pragma unroll
    for (int a = 0; a < 2; ++a)
#pragma unroll
        for (int b = 0; b < 2; ++b)
#pragma unroll
            for (int m = 0; m < 4; ++m)
#pragma unroll
                for (int n = 0; n < 2; ++n) acc[a][b][m][n] = (f32x4){0.f, 0.f, 0.f, 0.f};
    bf16x8 At[4][2], B0[2][2], B1[2][2];
    const char* cA = (const char*)g.A + (size_t)cur.pm * tstep; const char* cB = (const char*)g.Bt + (size_t)cur.pn * tstep;
    S.a_ready(cur);
    PG8_STAGE(PG8_SB(0, 0), cB, voffB); PG8_STAGE(PG8_SA(0, 0), cA, voffA); PG8_STAGE(PG8_SB(0, 1), cB + hstep, voffB); PG8_STAGE(PG8_SA(0, 1), cA + hstep, voffA);
    if (wr == 1) PG8_BAR;
    PG8_WAIT_V(4); PG8_BAR;
    PG8_STAGE(PG8_SB(1, 0), cB + kstep, voffB); PG8_STAGE(PG8_SA(1, 0), cA + kstep, voffA); PG8_STAGE(PG8_SB(1, 1), cB + hstep + kstep, voffB);
    PG8_WAIT_V(6); PG8_BAR;
    PG8_STAMP();
    for (;;) {
        const bool has_next = S.next(ui + 1, nxt);
        const char* nA = has_next ? (const char*)g.A + (size_t)nxt.pm * tstep : cA; const char* nB = has_next ? (const char*)g.Bt + (size_t)nxt.pn * tstep : cB;
        for (int t = 0; t < nt; t += 2) {
            const bool last = (t == nt - 2);
            const char* a1 = cA + (size_t)(t + 1) * kstep;
            const char* a2 = last ? nA : cA + (size_t)(t + 2) * kstep; const char* b2 = last ? nB : cB + (size_t)(t + 2) * kstep;
            const char* a3 = a2 + kstep; const char* b3 = b2 + kstep;
            if (last && has_next) S.a_ready(nxt);
            PG8_LDB(B0, 0, 0); PG8_SCHED; PG8_LDA(At, 0, 0); PG8_STAGE(PG8_SA(1, 1), a1 + hstep, voffA);
            PG8_WAIT_L(8); PG8_BAR; PG8_WAIT_L(0); PG8_MMA(0, 0, At, B0); PG8_BAR; PG8_SCHED;
            PG8_LDB(B1, 0, 1); PG8_STAGE(PG8_SB(0, 0), b2, voffB);
            PG8_BAR; PG8_WAIT_L(0); PG8_MMA(0, 1, At, B1); PG8_BAR;
            PG8_LDA(At, 0, 1); PG8_STAGE(PG8_SA(0, 0), a2, voffA);
            PG8_BAR; PG8_WAIT_L(0); PG8_MMA(1, 0, At, B0); PG8_BAR; PG8_SCHED;
            PG8_STAGE(PG8_SB(0, 1), b2 + hstep, voffB);
            PG8_WAIT_V(6); PG8_BAR; PG8_MMA(1, 1, At, B1); PG8_BAR;
            PG8_LDB(B0, 1, 0); PG8_SCHED; PG8_LDA(At, 1, 0); PG8_STAGE(PG8_SA(0, 1), a2 + hstep, voffA);
            PG8_WAIT_L(8); PG8_BAR; PG8_WAIT_L(0); PG8_MMA(0, 0, At, B0); PG8_BAR; PG8_SCHED;
            PG8_LDB(B1, 1, 1); PG8_STAGE(PG8_SB(1, 0), b3, voffB);
            PG8_BAR; PG8_WAIT_L(0); PG8_MMA(0, 1, At, B1); PG8_BAR;
            PG8_LDA(At, 1, 1); PG8_STAGE(PG8_SA(1, 0), a3, voffA);
            PG8_BAR; PG8_WAIT_L(0); PG8_MMA(1, 0, At, B0); PG8_BAR; PG8_SCHED;
            PG8_STAGE(PG8_SB(1, 1), b3 + hstep, voffB);
            PG8_WAIT_V(6); PG8_BAR; PG8_MMA(1, 1, At, B1); PG8_BAR;
        }
        PG8_STAMP();
        if constexpr (!Epi::AFTER_DRAIN) { E(acc, cur, wr, wc, fr, fq); S.done(cur); }
        PG8_STAMP();
        if (!has_next) break;
#pragma unroll
        for (int a = 0; a < 2; ++a)
#pragma unroll
            for (int b = 0; b < 2; ++b)
#pragma unroll
                for (int m = 0; m < 4; ++m)
#pragma unroll
                    for (int n = 0; n < 2; ++n) acc[a][b][m][n] = (f32x4){0.f, 0.f, 0.f, 0.f};
        cur = nxt; cA = nA; cB = nB; ++ui;
    }
    PG8_WAIT_V(0);
    if (wr == 0) PG8_BAR;
    PG8_BAR;
    if constexpr (Epi::AFTER_DRAIN) { E.fused(acc, cur, wr, wc, fr, fq, lds, wid, lane); S.done(cur); }
    PG8_STAMP();
    if (STAMP && wid == 0) { stamps[lane] = lane < nts ? (((unsigned long long)(unsigned)ts_hi << 32) | (unsigned)ts_lo) : 0ull;
        if (lane == 62) stamps[62] = rt_entry; if (lane == 63) stamps[63] = (unsigned long long)wall_clock64(); }
#undef PG8_STAMP
#undef PG8_SA
#undef PG8_SB
#undef PG8_STAGE
#undef PG8_LDA
#undef PG8_LDB
#undef PG8_MMA
#undef PG8_WAIT_V
#undef PG8_WAIT_L
#undef PG8_BAR
#undef PG8_SCHED
}
}

enum { EPI_SWIGLU = 0, EPI_RESID = 1, EPI_PROJ = 2, EPI_MERGE = 3 };
struct EpiAny {
  static constexpr bool AFTER_DRAIN = false;
  int mode; bool perm;
  u16* O; int ldo; const float* xin; float* xout; float scale; const u16* gate; float* macc; int br;
  DI void operator()(const pg8::f32x4 (&acc)[2][2][4][2], const pg8::Unit& u, int wr, int wc, int fr, int fq) const {
    const int row0 = u.pm * 256 + wr * 64 + fr;
    if (mode == EPI_SWIGLU) {
      const int col0 = u.pn * 128 + wc * 32 + 8 * fq;
#pragma unroll
      for (int ai = 0; ai < 2; ++ai)
#pragma unroll
        for (int m = 0; m < 4; ++m) {
          float v[8];
#pragma unroll
          for (int n = 0; n < 2; ++n)
#pragma unroll
            for (int e = 0; e < 4; ++e) { const float gv = acc[ai][0][m][n][e], uv = acc[ai][1][m][n][e]; v[4 * n + e] = gv * __builtin_amdgcn_rcpf(1.0f + __builtin_amdgcn_exp2f(-LOG2E * gv)) * uv; }
          u32x4 o; o[0] = pack2(v[0], v[1]); o[1] = pack2(v[2], v[3]); o[2] = pack2(v[4], v[5]); o[3] = pack2(v[6], v[7]);
          *(u32x4*)(O + (size_t)(row0 + ai * 128 + m * 16) * ldo + col0) = o;
        }
    } else if (mode == EPI_PROJ) {
      const int col0 = u.pn * 256 + wc * 32 + 8 * fq;
      const bool sg = (u.pn * 256 >= OFF_GATE);
#pragma unroll
      for (int ai = 0; ai < 2; ++ai)
#pragma unroll
        for (int m = 0; m < 4; ++m)
#pragma unroll
          for (int bj = 0; bj < 2; ++bj) {
            float v[8];
#pragma unroll
            for (int n = 0; n < 2; ++n)
#pragma unroll
              for (int e = 0; e < 4; ++e) { float t = acc[ai][bj][m][n][e]; if (sg) t = __builtin_amdgcn_rcpf(1.0f + __builtin_amdgcn_exp2f(-LOG2E * t)); v[4 * n + e] = t; }
            u32x4 o; o[0] = pack2(v[0], v[1]); o[1] = pack2(v[2], v[3]); o[2] = pack2(v[4], v[5]); o[3] = pack2(v[6], v[7]);
            *(u32x4*)(O + (size_t)(row0 + ai * 128 + m * 16) * INC + col0 + bj * 128) = o;
          }
    } else if (mode == EPI_RESID) {
      const int col0 = u.pn * 256 + wc * 32 + 4 * fq;
#pragma unroll
      for (int ai = 0; ai < 2; ++ai)
#pragma unroll
        for (int m = 0; m < 4; ++m)
#pragma unroll
          for (int bj = 0; bj < 2; ++bj)
#pragma unroll
            for (int n = 0; n < 2; ++n) {
              const size_t idx = (size_t)(row0 + ai * 128 + m * 16) * DM + col0 + bj * 128 + n * 16;
              f32x4 xv = *(const f32x4*)(xin + idx);
#pragma unroll
              for (int e = 0; e < 4; ++e) xv[e] += scale * acc[ai][bj][m][n][e];
              *(f32x4*)(xout + idx) = xv;
            }
    } else {
      const int col0 = u.pn * 256 + wc * 32 + 4 * fq;
#pragma unroll
      for (int ai = 0; ai < 2; ++ai)
#pragma unroll
        for (int m = 0; m < 4; ++m)
#pragma unroll
          for (int bj = 0; bj < 2; ++bj)
#pragma unroll
            for (int n = 0; n < 2; ++n) {
              const int row = row0 + ai * 128 + m * 16, col = col0 + bj * 128 + n * 16;
              const u32x2 gt = *(const u32x2*)(gate + (size_t)row * INC + OFF_GATE + br * DM + col);
              f32x4 v;
              v[0] = bflo(gt[0]) * acc[ai][bj][m][n][0]; v[1] = bfhi(gt[0]) * acc[ai][bj][m][n][1];
              v[2] = bflo(gt[1]) * acc[ai][bj][m][n][2]; v[3] = bfhi(gt[1]) * acc[ai][bj][m][n][3];
              const size_t idx = (size_t)row * DM + col;
              if (br > 0) { const f32x4 pv = *(const f32x4*)(macc + idx); v[0] += pv[0]; v[1] += pv[1]; v[2] += pv[2]; v[3] += pv[3]; }
              if (br < 2) *(f32x4*)(macc + idx) = v;
              else { u32x2 o; o[0] = pack2(v[0], v[1]); o[1] = pack2(v[2], v[3]); *(u32x2*)(outb_() + idx) = o; }
            }
    }
  }
  DI u16* outb_() const { return O; }
};

DI void qk_prep_item(const Params& P, int layer, u16* __restrict__ p, int L, int it) {
  const int tid = otid() & 255, lane = tid & 63, w = __builtin_amdgcn_readfirstlane(tid >> 6);
  const int u = it * 8 + w * 2 + (lane >> 5);
  const int tok = u / 10, hd = u - tok * 10;
  const int i = lane & 31;
  const int col0 = (hd < 8) ? (OFF_GQ + hd * 64) : (OFF_GK + (hd - 8) * 64);
  const float* gn = (hd < 8) ? (P.gqa_q_norm + layer * 64) : (P.gqa_k_norm + layer * 64);
  unsigned* ptr = (unsigned*)(p + (size_t)tok * INC + col0) + i;
  const unsigned v = *ptr;
  float a = bflo(v), b = bfhi(v);
  const float ss = half_sum(a * a + b * b);
  const float rs = rsqrtf(ss * (1.0f / 64.0f) + 1e-6f);
  a = a * rs * gn[2 * i]; b = b * rs * gn[2 * i + 1];
  const int tl = tok % L;
  const float pos = (i < 16) ? (float)(tl >> 6) : (float)(tl & 63);
  const int jj = i & 15;
  const float inv = powf(10000.0f, -(float)(2 * jj) / 32.0f);
  const float ang = pos * inv;
  const float c = cosf(ang), s = sinf(ang);
  *ptr = pack2(a * c - b * s, a * s + b * c);
}

DI void transpose_item(const Params& P, int layer, const u16* __restrict__ p, int L, int kind, int ct, int tt, u16* __restrict__ dst, char* smem) {
  u16* tile = (u16*)smem;
  const int tid = otid() & 255;
  const int t0 = tt * 64;
  const int seq = t0 / L, tl0 = t0 - seq * L;
  const int C = (kind == 0) ? 128 : 512;
  __syncthreads();
  {
    const int col = tid & 63, r0 = tid >> 6;
    const int cidx = ct * 64 + col;
    if (kind < 2) {
      const int off = (kind == 0 ? OFF_GV : OFF_DV) + cidx;
#pragma unroll
      for (int i = 0; i < 16; ++i) { const int row = r0 + 4 * i; tile[col * 72 + row] = p[(size_t)(t0 + row) * INC + off]; }
    } else {
      const float* cw = P.hy_conv_w + layer * 3 * 1536; const float* cb = P.hy_conv_b + layer * 1536;
      const int c1 = 512 + cidx, c2 = 1024 + cidx;
      const float w10 = cw[c1], w11 = cw[1536 + c1], w12 = cw[3072 + c1], b1 = cb[c1];
      const float w20 = cw[c2], w21 = cw[1536 + c2], w22 = cw[3072 + c2], b2 = cb[c2];
#pragma unroll
      for (int i = 0; i < 16; ++i) {
        const int row = r0 + 4 * i; const int tl = tl0 + row;
        const u16* pr = p + (size_t)(t0 + row) * INC;
        const float xm1 = (tl > 0) ? bf2f(pr[c1 - INC]) : 0.f, x0 = bf2f(pr[c1]), xp1 = (tl < L - 1) ? bf2f(pr[c1 + INC]) : 0.f;
        const float vm1 = (tl > 0) ? bf2f(pr[c2 - INC]) : 0.f, v0 = bf2f(pr[c2]), vp1 = (tl < L - 1) ? bf2f(pr[c2 + INC]) : 0.f;
        const float x1c = xm1 * w10 + x0 * w11 + xp1 * w12 + b1;
        const float vc = vm1 * w20 + v0 * w21 + vp1 * w22 + b2;
        tile[col * 72 + row] = f2bf(vc * x1c);
      }
    }
  }
  __syncthreads();
  {
    const int c = tid >> 2, q = tid & 3;
    const u32x4 a = *(const u32x4*)(tile + c * 72 + q * 16), b = *(const u32x4*)(tile + c * 72 + q * 16 + 8);
    u16* d = dst + ((size_t)seq * C + ct * 64 + c) * L + tl0 + q * 16;
    *(u32x4*)d = a; *(u32x4*)(d + 8) = b;
  }
}

DI int kperm(int rho) { return (rho & ~0xC) | ((rho & 4) << 1) | ((rho & 8) >> 1); }
template <int DV, bool BIAS, bool SWAP>
DI void attn_tile(const u16* __restrict__ Qp, const u16* __restrict__ Kp, const u16* __restrict__ VTp, int L,
                  u16* __restrict__ Op, int ldo, int q0, const float* __restrict__ btab, char* smem) {
  constexpr int NDT = DV / 32;
  constexpr int VCH = DV / 32;
  constexpr int KS_SZ = 64 * 64, VS_SZ = DV * 64;
  u16* Ks = (u16*)smem;
  u16* Vs = Ks + 2 * KS_SZ;
  float* bt = (float*)(Vs + 2 * VS_SZ);
  const int tid = otid() & 255, lane = tid & 63, w = __builtin_amdgcn_readfirstlane(tid >> 6), r = lane & 31, h = lane >> 5;
  const float sc = 0.125f * LOG2E;
  __syncthreads();
  if (BIAS) { for (int i = tid; i < 257; i += 256) bt[i] = btab[i]; }
  bf16x8 qf[4];
  {
    const u16* qrow = Qp + (size_t)(q0 + 32 * w + r) * INC + 8 * h;
#pragma unroll
    for (int s = 0; s < 4; ++s) qf[s] = *(const bf16x8*)(qrow + 16 * s);
  }
  const int qpos = q0 + 32 * w + r;
  f32x16 O[NDT];
#pragma unroll
  for (int d = 0; d < NDT; ++d)
#pragma unroll
    for (int q = 0; q < 16; ++q) O[d][q] = 0.f;
  float m = -INFINITY, l = 0.f;
  const int lrow = tid >> 3, lsw = (tid & 7) ^ ((tid >> 4) & 7);
  const u16* Kg0 = Kp + (size_t)kperm(lrow) * INC + lsw * 8;
  const u16* Vg = VTp + (size_t)lrow * L + lsw * 8;
  const int ksw = (r >> 1) & 7;
#define ATT_LOADK(tile, bufp) do { _Pragma("unroll") for (int i_ = 0; i_ < 2; ++i_) \
    __builtin_amdgcn_global_load_lds((const unsigned*)(Kg0 + ((size_t)(tile) * 64 + 32 * i_) * INC), (unsigned*)((char*)(bufp) + tid * 16 + i_ * 4096), 16, 0, 0); } while (0)
#define ATT_LOADV(tile, bufp) do { _Pragma("unroll") for (int i_ = 0; i_ < VCH; ++i_) \
    __builtin_amdgcn_global_load_lds((const unsigned*)(Vg + (size_t)(32 * i_) * L + (size_t)(tile) * 64), (unsigned*)((char*)(bufp) + tid * 16 + i_ * 4096), 16, 0, 0); } while (0)
  ATT_LOADK(0, Ks); ATT_LOADK(1, Ks + KS_SZ);
  for (int i = tid; i < VS_SZ / 8; i += 256) { u32x4 z = {0u, 0u, 0u, 0u}; *(u32x4*)(Vs + VS_SZ + i * 8) = z; }
  asm volatile("s_waitcnt vmcnt(0)" ::: "memory");
  __syncthreads();
  f32x16 Sc[2];
#pragma unroll
  for (int kt = 0; kt < 2; ++kt) {
#pragma unroll
    for (int q = 0; q < 16; ++q) Sc[kt][q] = 0.f;
#pragma unroll
    for (int s = 0; s < 4; ++s) {
      const bf16x8 a = *(const bf16x8*)(Ks + (32 * kt + r) * 64 + (((2 * s + h) ^ ksw) << 3));
      Sc[kt] = MFMA(a, qf[s], Sc[kt]);
    }
  }
  bf16x8 pf[2][2];
#pragma unroll
  for (int kt = 0; kt < 2; ++kt)
#pragma unroll
    for (int s = 0; s < 2; ++s)
#pragma unroll
      for (int j = 0; j < 8; ++j) pf[kt][s][j] = 0;
  const int nkb = L >> 6;
  for (int kb = 0; kb < nkb; ++kb) {
    { const int kt2 = (kb + 2 < nkb) ? kb + 2 : nkb - 1; ATT_LOADK(kt2, Ks + (kb & 1) * KS_SZ); }
    ATT_LOADV(kb, Vs + (kb & 1) * VS_SZ);
    f32x16 Sn[2];
    bf16x8 pn[2][2];
    float alpha = 1.0f; bool resc = false;
    auto partA = [&]() __attribute__((always_inline)) {
      const u16* Kb = Ks + ((kb + 1) & 1) * KS_SZ;
#pragma unroll
      for (int kt = 0; kt < 2; ++kt) {
#pragma unroll
        for (int q = 0; q < 16; ++q) Sn[kt][q] = 0.f;
#pragma unroll
        for (int s = 0; s < 4; ++s) {
          const bf16x8 a = *(const bf16x8*)(Kb + (32 * kt + r) * 64 + (((2 * s + h) ^ ksw) << 3));
          Sn[kt] = MFMA(a, qf[s], Sn[kt]);
        }
      }
      const u16* Vb = Vs + ((kb + 1) & 1) * VS_SZ;
#pragma unroll
      for (int kt = 0; kt < 2; ++kt)
#pragma unroll
        for (int s = 0; s < 2; ++s)
#pragma unroll
          for (int d = 0; d < NDT; ++d) {
            const bf16x8 av = *(const bf16x8*)(Vb + (32 * d + r) * 64 + (((4 * kt + 2 * s + h) ^ ksw) << 3));
            O[d] = MFMA(av, pf[kt][s], O[d]);
          }
    };
    auto partB = [&]() __attribute__((always_inline)) {
      if (BIAS) {
        const int kmin = kb * 64;
        if (kmin - (q0 + 127) >= 128 || q0 - (kmin + 63) >= 128) {
          const float cb = (kmin > q0) ? bt[256] : bt[0];
#pragma unroll
          for (int kt = 0; kt < 2; ++kt)
#pragma unroll
            for (int q = 0; q < 16; ++q) Sc[kt][q] = Sc[kt][q] * sc + cb;
        } else {
#pragma unroll
          for (int kt = 0; kt < 2; ++kt)
#pragma unroll
            for (int q = 0; q < 16; ++q) {
              int rel = kmin + 32 * kt + kperm(crow(q, h)) - qpos;
              rel = rel < -128 ? -128 : (rel > 128 ? 128 : rel);
              Sc[kt][q] = Sc[kt][q] * sc + bt[rel + 128];
            }
        }
      }
      float mx = Sc[0][0];
#pragma unroll
      for (int kt = 0; kt < 2; ++kt)
#pragma unroll
        for (int q = 0; q < 16; ++q) mx = fmaxf(mx, Sc[kt][q]);
      mx = fmaxf(mx, __shfl_xor(mx, 32));
      if (!BIAS) mx *= sc;
      if (__any(mx > m + 6.0f)) {
        const float mn = fmaxf(m, mx);
        alpha = __builtin_amdgcn_exp2f(m - mn);
        m = mn; l *= alpha; resc = true;
      }
      const float nm = -m;
#pragma unroll
      for (int kt = 0; kt < 2; ++kt) {
#pragma unroll
        for (int q = 0; q < 16; ++q) {
          const float pv = BIAS ? __builtin_amdgcn_exp2f(Sc[kt][q] + nm) : __builtin_amdgcn_exp2f(__builtin_fmaf(Sc[kt][q], sc, nm));
          Sc[kt][q] = pv; l += pv;
        }
#pragma unroll
        for (int s = 0; s < 2; ++s) {
          u32x4 pk;
#pragma unroll
          for (int q = 0; q < 4; ++q) pk[q] = pack2(Sc[kt][8 * s + 2 * q], Sc[kt][8 * s + 2 * q + 1]);
          pn[kt][s] = __builtin_bit_cast(bf16x8, pk);
        }
      }
    };
    if (SWAP) { partB(); partA(); } else { partA(); partB(); }
    if (resc) {
#pragma unroll
      for (int d = 0; d < NDT; ++d)
#pragma unroll
        for (int q = 0; q < 16; ++q) O[d][q] *= alpha;
    }
    asm volatile("s_waitcnt vmcnt(0)" ::: "memory");
    __syncthreads();
#pragma unroll
    for (int kt = 0; kt < 2; ++kt) {
      Sc[kt] = Sn[kt];
#pragma unroll
      for (int s = 0; s < 2; ++s) pf[kt][s] = pn[kt][s];
    }
  }
  {
    const u16* Vb = Vs + ((nkb - 1) & 1) * VS_SZ;
#pragma unroll
    for (int kt = 0; kt < 2; ++kt)
#pragma unroll
      for (int s = 0; s < 2; ++s)
#pragma unroll
        for (int d = 0; d < NDT; ++d) {
          const bf16x8 av = *(const bf16x8*)(Vb + (32 * d + r) * 64 + (((4 * kt + 2 * s + h) ^ ksw) << 3));
          O[d] = MFMA(av, pf[kt][s], O[d]);
        }
  }
#undef ATT_LOADK
#undef ATT_LOADV
  l += __shfl_xor(l, 32);
  const float inv = __builtin_amdgcn_rcpf(l);
  int ldo2 = ldo; asm volatile("" : "+s"(ldo2));
  u16* orow = Op + (size_t)qpos * ldo2;
#pragma unroll
  for (int d = 0; d < NDT; ++d)
#pragma unroll
    for (int g4 = 0; g4 < 4; ++g4) {
      u32x2 o; o[0] = pack2(O[d][4 * g4] * inv, O[d][4 * g4 + 1] * inv); o[1] = pack2(O[d][4 * g4 + 2] * inv, O[d][4 * g4 + 3] * inv);
      *(u32x2*)(orow + 32 * d + 8 * g4 + 4 * h) = o;
    }
}

DI void hyena_item(int c, const u16* __restrict__ G, const u16* __restrict__ zT, u16* __restrict__ yT, int nseq, int L, char* smem) {
  u16* zs = (u16*)smem;
  u16* fw = zs + 20480;
  const int tid = otid() & 255, lane = tid & 63, w = __builtin_amdgcn_readfirstlane(tid >> 6), r = lane & 31, h = lane >> 5;
  const int ZL = L + 2048;
  __syncthreads();
  for (int q = 0; q < nseq; ++q) {
    const u16* src = zT + ((size_t)q * 512 + c) * L;
    u16* dst = zs + q * ZL;
    const u32x4 zero = {0u, 0u, 0u, 0u};
    for (int i = tid; i < 128; i += 256) { *(u32x4*)(dst + i * 8) = zero; *(u32x4*)(dst + 1024 + L + i * 8) = zero; }
    for (int i = tid; i < (L >> 3); i += 256) *(u32x4*)(dst + 1024 + i * 8) = *(const u32x4*)(src + i * 8);
  }
  int tq[4], tJ[4];
#pragma unroll
  for (int i = 0; i < 4; ++i) { if (nseq == 2) { tq[i] = i & 1; tJ[i] = 2 * w + (i >> 1); } else { tq[i] = 0; tJ[i] = 4 * w + i; } }
  f32x16 acc[4];
#pragma unroll
  for (int i = 0; i < 4; ++i)
#pragma unroll
    for (int q = 0; q < 16; ++q) acc[i][q] = 0.f;
  const int E0 = -L + 16, ELAST = L - 32;
  const int npass = (2 * L - 32 + 8191) / 8192;
  const u16* Gc = G + (size_t)c * (2 * L);
  for (int ps = 0; ps < npass; ++ps) {
    const int ea = E0 + 8192 * ps, eb = ea + 8192;
    const int wb = L - eb - 16;
    __syncthreads();
    for (int i = tid; i < 1032; i += 256) {
      const int gi = wb + i * 8;
      u32x4 v = {0u, 0u, 0u, 0u};
      if (gi >= 0 && gi < 2 * L) v = *(const u32x4*)(Gc + gi);
      *(u32x4*)(fw + i * 8) = v;
    }
    __syncthreads();
    const int eend = (eb - 16 < ELAST) ? (eb - 16) : ELAST;
    for (int e = ea; e <= eend; e += 16) {
      bool in[4]; bool any = false;
#pragma unroll
      for (int i = 0; i < 4; ++i) { in[i] = (e >= 1024 * tJ[i] - L + 16) && (e <= 1024 * tJ[i] + 992); any = any || in[i]; }
      if (!any) continue;
      const int idx0 = L - e - r + 8 * h - wb;
      bf16x8 a;
#pragma unroll
      for (int j = 0; j < 8; ++j) a[j] = (short)fw[idx0 + j];
#pragma unroll
      for (int i = 0; i < 4; ++i) {
        if (in[i]) {
          const bf16x8 b = *(const bf16x8*)(zs + tq[i] * ZL + 1024 + 1024 * tJ[i] + 32 * r - e + 8 * h);
          acc[i] = MFMA(a, b, acc[i]);
        }
      }
    }
  }
#pragma unroll
  for (int i = 0; i < 4; ++i) {
    u16* dst = yT + ((size_t)tq[i] * 512 + c) * L + 1024 * tJ[i] + 32 * r + 4 * h;
#pragma unroll
    for (int g4 = 0; g4 < 4; ++g4) {
      u32x2 o; o[0] = pack2(acc[i][4 * g4], acc[i][4 * g4 + 1]); o[1] = pack2(acc[i][4 * g4 + 2], acc[i][4 * g4 + 3]);
      *(u32x2*)(dst + 8 * g4) = o;
    }
  }
}

DI void diff_post_item(const Params& P, int layer, float lam, float lam_init, const u16* __restrict__ dO, u16* __restrict__ ydf, int it) {
  const int tid = otid() & 255, lane = tid & 63, w = __builtin_amdgcn_readfirstlane(tid >> 6);
  const int u = it * 8 + w * 2 + (lane >> 5);
  const int i = lane & 31;
  const u32x2 a = *(const u32x2*)(dO + (size_t)u * 256 + 4 * i);
  const u32x2 b = *(const u32x2*)(dO + (size_t)u * 256 + 128 + 4 * i);
  float o[4];
  o[0] = bflo(a[0]) - lam * bflo(b[0]); o[1] = bfhi(a[0]) - lam * bfhi(b[0]);
  o[2] = bflo(a[1]) - lam * bflo(b[1]); o[3] = bfhi(a[1]) - lam * bfhi(b[1]);
  const float ss = half_sum(o[0] * o[0] + o[1] * o[1] + o[2] * o[2] + o[3] * o[3]);
  const float rs = rsqrtf(ss * (1.0f / 128.0f) + 1e-5f) * (1.0f - lam_init);
  const float* g = P.diff_subln + layer * 128 + 4 * i;
  u32x2 ov; ov[0] = pack2(o[0] * rs * g[0], o[1] * rs * g[1]); ov[1] = pack2(o[2] * rs * g[2], o[3] * rs * g[3]);
  *(u32x2*)(ydf + (size_t)u * 128 + 4 * i) = ov;
}
DI void hyena_post_item(const Params& P, int layer, const u16* __restrict__ p, int L, const u16* __restrict__ yT, const u16* __restrict__ zT,
                        int ct, int tt, u16* __restrict__ yhy, char* smem) {
  float* tile = (float*)smem;
  const int tid = otid() & 255;
  const int t0 = tt * 64; const int seq = t0 / L, tl0 = t0 - seq * L;
  __syncthreads();
  {
    const int tcol = tid & 63, c0 = tid >> 6;
#pragma unroll
    for (int i = 0; i < 16; ++i) {
      const int cc = c0 + 4 * i; const int c = ct * 64 + cc;
      const size_t gi = ((size_t)seq * 512 + c) * L + tl0 + tcol;
      tile[cc * 65 + tcol] = bf2f(yT[gi]) + bf2f(zT[gi]) * P.hy_skip[layer * 512 + c];
    }
  }
  __syncthreads();
  {
    const int col = tid & 63, r0 = tid >> 6; const int c = ct * 64 + col;
    const float* cw = P.hy_conv_w + layer * 3 * 1536; const float* cb = P.hy_conv_b + layer * 1536;
    const float w0 = cw[c], w1 = cw[1536 + c], w2 = cw[3072 + c], b0 = cb[c];
#pragma unroll
    for (int i = 0; i < 16; ++i) {
      const int row = r0 + 4 * i; const int tl = tl0 + row;
      const u16* pr = p + (size_t)(t0 + row) * INC + c;
      const float xm1 = (tl > 0) ? bf2f(pr[-INC]) : 0.f, x0 = bf2f(pr[0]), xp1 = (tl < L - 1) ? bf2f(pr[INC]) : 0.f;
      const float x0c = xm1 * w0 + x0 * w1 + xp1 * w2 + b0;
      yhy[(size_t)(t0 + row) * 512 + c] = f2bf(x0c * tile[col * 65 + row]);
    }
  }
}

__global__ void __launch_bounds__(512) fwd_megakernel(Params Parg) {
  cg::grid_group grid = cg::this_grid();
  __shared__ __attribute__((aligned(16))) char smem[SMEM_BYTES];
  __shared__ uint4 xb_words;
  const int nb = gridDim.x, bid = blockIdx.x, nb2 = nb * 2;
#define KPARAMS() const Params __attribute__((address_space(4)))* pp_ = (const Params __attribute__((address_space(4)))*)__builtin_amdgcn_kernarg_segment_ptr(); \
  asm volatile("" : "+s"(pp_)); const Params& P = *(const Params*)pp_; char* ws = P.ws
  if (threadIdx.x == 0) xb_words = make_uint4(0u, 0u, 0u, 0u);
  __syncthreads();
  XcdBarrier xb;
  { KPARAMS(); xb = xcd_barrier_post((unsigned*)(ws + O_BAR), (volatile LAS unsigned*)&xb_words); }

  for (int step = 0; step < 80; ++step) {
    const int layer = step / 40, ls = step - layer * 40;
    PHASE_IDS();
    KPARAMS();
    float* misc = (float*)(ws + O_MISC);
    u16* pbuf = (u16*)(ws + O_P); u16* hid = pbuf; u16* hn = (u16*)(ws + O_HN); u16* merged = hn;
    if (ls == 0) {
      u16* filt8 = (u16*)(ws + O_FILT8); u16* filt16 = (u16*)(ws + O_FILT16);
      const int n1 = 16 * 88, n2 = 44 * 16, n3 = 16 * 108, n4 = 3 * 8 * 16, n5 = 16 * 16;
      const int nfilt = 128 + 256;
      const int total = n1 + n2 + n3 + n4 + n5 + n1 + n2 + nfilt;
      for (int it = bid2; it < total; it += nb2) {
        int t = it;
        if (t < nfilt) {
          const bool big = t < 256;
          filter_item(P, layer, big ? 16384 : 8192, big ? t : t - 256, big ? filt16 : filt8, smg);
          continue;
        }
        t -= nfilt;
        const float* src; int K, N, kt, nt, ph = 0; u16* dst;
        if (t < n1) { src = P.ffn1_w_in + (size_t)layer * 1024 * 5632; K = 1024; N = 5632; dst = (u16*)(ws + O_F1IN); kt = t / 88; nt = t % 88; ph = 2816; }
        else if ((t -= n1) < n2) { src = P.ffn1_w_out + (size_t)layer * 2816 * 1024; K = 2816; N = 1024; dst = (u16*)(ws + O_F1OUT); kt = t / 16; nt = t % 16; }
        else if ((t -= n2) < n3) { src = P.w_in + (size_t)layer * 1024 * 6912; K = 1024; N = 6912; dst = (u16*)(ws + O_WIN); kt = t / 108; nt = t % 108; }
        else if ((t -= n3) < n4) { const int br = t / 128, tt = t % 128; src = P.w_branch + ((size_t)layer * 3 + br) * 512 * 1024; K = 512; N = 1024;
                                   dst = (u16*)(ws + O_WBR) + (size_t)br * 1024 * 512; kt = tt / 16; nt = tt % 16; }
        else if ((t -= n4) < n5) { src = P.w_out + (size_t)layer * 1024 * 1024; K = 1024; N = 1024; dst = (u16*)(ws + O_WOUT); kt = t / 16; nt = t % 16; }
        else if ((t -= n5) < n1) { src = P.ffn2_w_in + (size_t)layer * 1024 * 5632; K = 1024; N = 5632; dst = (u16*)(ws + O_F2IN); kt = t / 88; nt = t % 88; ph = 2816; }
        else { t -= n1; src = P.ffn2_w_out + (size_t)layer * 2816 * 1024; K = 2816; N = 1024; dst = (u16*)(ws + O_F2OUT); kt = t / 16; nt = t % 16; }
        convT_tile(src, K, N, dst, kt, nt, ph, smg);
      }
      if (bid == 0 && grp == 0) {
        const int tid = t_;
        if (tid < 2) {
          const float* lp = P.diff_lambda + tid * 256;
          float s1 = 0.f, s2 = 0.f;
          for (int i = 0; i < 64; ++i) { s1 += lp[i] * lp[64 + i]; s2 += lp[128 + i] * lp[192 + i]; }
          const float lam_init = 0.8f - 0.6f * expf(-0.3f * (float)tid);
          misc[tid] = expf(s1) - expf(s2) + lam_init;
        }
        for (int i = tid; i < 4 * 257; i += 256) {
          const int hh = i / 257, idx = i % 257; const int rel = idx - 128; const int n = rel < 0 ? -rel : rel;
          int b;
          if (n < 8) b = n; else { int lg = 8 + (int)(logf((float)n / 8.0f) / 2.772588722239781f * 8.0f); b = lg < 15 ? lg : 15; }
          if (rel > 0) b += 16;
          misc[64 + i] = P.rel_bias[b * 4 + hh] * LOG2E;
        }
      }
      if (step == 0) grid.sync(); else GSYNC();
      continue;
    }
    const int cs = ls - 1; const int ch = cs / 13, st = cs - ch * 13;
    const int nseq = (ch < 2) ? 2 : 1, L = (ch < 2) ? 8192 : 16384;
    const float* xin0 = (ch < 2) ? (P.x_prompt + (size_t)ch * TCH * DM) : P.x_sample;
    float* xres = P.out + (size_t)ch * TCH * DM;
    const float* xcur = (layer == 0) ? xin0 : xres;
    for (int rp_ = 0; rp_ <= ((REPMASK >> st) & 1); ++rp_) {
    if (st == 0 || st == 3 || st == 10) {
      const float* src = (st == 0) ? xcur : xres;
      const float* gn = ((st == 0) ? P.ffn1_norm : (st == 3 ? P.mix_norm : P.ffn2_norm)) + layer * DM;
      for (int it = bid2; it < TCH / 4; it += nb2) { const int row = it * 4 + w; norm_row_bf16(src + (size_t)row * DM, gn, hn + (size_t)row * DM, lane); }
    } else if (st == 1 || st == 2 || st == 4 || st == 8 || st == 9 || st == 11 || st == 12) {
      EpiAny E{}; const u16* A; const u16* Bt; int N, K; int nrep = 1;
      if (st == 1 || st == 11) { A = hn; Bt = (u16*)(ws + (st == 1 ? O_F1IN : O_F2IN)); N = 5632; K = DM; E.mode = EPI_SWIGLU; E.perm = true; E.O = hid; E.ldo = DFF; }
      else if (st == 2 || st == 12) { A = hid; Bt = (u16*)(ws + (st == 2 ? O_F1OUT : O_F2OUT)); N = DM; K = DFF; E.mode = EPI_RESID; E.perm = false;
                                      E.xin = (st == 2) ? xcur : xres; E.xout = xres; E.scale = 0.5f; }
      else if (st == 4) { A = hn; Bt = (u16*)(ws + O_WIN); N = INC; K = DM; E.mode = EPI_PROJ; E.perm = true; E.O = pbuf; }
      else if (st == 8) { A = (u16*)(ws + O_YHY); Bt = (u16*)(ws + O_WBR); N = DM; K = 512; E.mode = EPI_MERGE; E.perm = false; E.gate = pbuf; E.macc = (float*)(ws + O_ZT); E.O = merged; nrep = 3; }
      else { A = merged; Bt = (u16*)(ws + O_WOUT); N = DM; K = DM; E.mode = EPI_RESID; E.perm = false; E.xin = xres; E.xout = xres; E.scale = 1.0f; }
      for (int rp = 0; rp < nrep; ++rp) {
        E.br = rp;
        pg8::Gemm gg{A + (size_t)rp * TCH * 512, Bt + (size_t)rp * 1024 * 512, TCH, N, K};
        pg8::StaticOrder S; S.init(TCH, N, nb, bid);
        pg8::gemm_phase<EpiAny, pg8::StaticOrder, false>((PG8_LAS unsigned char*)smem, gg, S, E, nullptr);
      }
    } else if (st == 5) {
      const int nqk = TCH * 10 / 8, ntr = 256 * 18;
      for (int it = bid2; it < nqk + ntr; it += nb2) {
        if (it < nqk) { qk_prep_item(P, layer, pbuf, L, it); continue; }
        const int t = it - nqk; const int tt = t / 18, cc = t % 18;
        const int kind = (cc < 2) ? 0 : (cc < 10 ? 1 : 2);
        const int ct = (cc < 2) ? cc : (cc < 10 ? cc - 2 : cc - 10);
        u16* dst = (u16*)(ws + (kind == 0 ? O_VTG : (kind == 1 ? O_VTD : O_ZT)));
        transpose_item(P, layer, pbuf, L, kind, ct, tt, dst, smg);
      }
    } else if (st == 6) {
      u16* zT = (u16*)(ws + O_ZT); u16* yT = (u16*)(ws + O_YT); u16* dO = (u16*)(ws + O_DIFFO);
      u16* vtg = (u16*)(ws + O_VTG); u16* vtd = (u16*)(ws + O_VTD); u16* ygq = (u16*)(ws + O_YGQ);
      const u16* filt = (u16*)(ws + ((ch < 2) ? O_FILT8 : O_FILT16));
      const int nqt = L / 128;
      const int xcd = bid & 7, nxu = (nb >> 3) * 2, u0 = (bid >> 3) * 2, nitem = nseq * nqt;
      for (int e0 = u0; e0 < nitem; e0 += nxu) {
        const int e = e0 + grp;
        const int seq = e / nqt, qt = e - seq * nqt;
        const int hh = xcd >> 1, cc = xcd & 1;
        const size_t tb = (size_t)seq * L;
        const u16* Qd = pbuf + tb * INC + OFF_DQ + xcd * 64; const u16* Kd = pbuf + tb * INC + OFF_DK + xcd * 64;
        const u16* Vd = vtd + ((size_t)seq * 512 + hh * 128) * L; u16* Od = dO + tb * 1024 + (hh * 2 + cc) * 128;
        if (grp) attn_tile<128, true, true>(Qd, Kd, Vd, L, Od, 1024, qt * 128, misc + 64 + hh * 257, smg);
        else attn_tile<128, true, false>(Qd, Kd, Vd, L, Od, 1024, qt * 128, misc + 64 + hh * 257, smg);
      }
      for (int e0 = u0; e0 < nitem; e0 += nxu) {
        const int e = e0 + grp;
        const int seq = e / nqt, qt = e - seq * nqt;
        const int kvh = xcd >> 2;
        const size_t tb = (size_t)seq * L;
        const u16* Qd = pbuf + tb * INC + OFF_GQ + xcd * 64; const u16* Kd = pbuf + tb * INC + OFF_GK + kvh * 64;
        const u16* Vd = vtg + ((size_t)seq * 128 + kvh * 64) * L; u16* Od = ygq + tb * 512 + xcd * 64;
        if (grp) attn_tile<64, false, true>(Qd, Kd, Vd, L, Od, 512, qt * 128, nullptr, smg);
        else attn_tile<64, false, false>(Qd, Kd, Vd, L, Od, 512, qt * 128, nullptr, smg);
      }
      for (int c = bid2; c < 512; c += nb2) hyena_item(c, filt, zT, yT, nseq, L, smg);
    } else {
      u16* zT = (u16*)(ws + O_ZT); u16* yT = (u16*)(ws + O_YT); u16* dO = (u16*)(ws + O_DIFFO);
      u16* yhy = (u16*)(ws + O_YHY); u16* ydf = (u16*)(ws + O_YDF);
      const float lam = misc[layer];
      const float lam_init = 0.8f - 0.6f * expf(-0.3f * (float)layer);
      const int ndp = TCH * 4 / 8, nhp = 256 * 8;
      for (int it = bid2; it < ndp + nhp; it += nb2) {
        if (it < ndp) diff_post_item(P, layer, lam, lam_init, dO, ydf, it);
        else { const int t = it - ndp; hyena_post_item(P, layer, pbuf, L, yT, zT, t % 8, t / 8, yhy, smg); }
      }
    }
    }
    GSYNC();
  }
  { PHASE_IDS(); KPARAMS(); (void)ws;
    for (int it = bid2; it < NTOK / 4; it += nb2) { const int row = it * 4 + w; norm_row_f32_inplace(P.out + (size_t)row * DM, P.final_norm, lane); }
  }
}

extern "C" void kernel_launch(void* const* d_in, const int* in_sizes, int n_in, void* d_out, int out_size, void* d_ws, size_t ws_size,
                              hipStream_t stream) {
  static int grid_blocks = 0;
  if (!grid_blocks) {
    int dev = 0, cus = 0, per_cu = 0;
    (void)hipGetDevice(&dev);
    (void)hipDeviceGetAttribute(&cus, hipDeviceAttributeMultiprocessorCount, dev);
    (void)hipOccupancyMaxActiveBlocksPerMultiprocessor(&per_cu, fwd_megakernel, 512, 0);
    if (per_cu < 1) per_cu = 1;
    if (per_cu > 1) per_cu = 1;
    grid_blocks = cus * per_cu;
  }
  Params p{};
  const float* const* in = (const float* const*)d_in;
  p.x_prompt = in[0]; p.x_sample = in[1]; p.ffn1_norm = in[2]; p.ffn1_w_in = in[3]; p.ffn1_w_out = in[4]; p.mix_norm = in[5]; p.w_in = in[6];
  p.hy_conv_w = in[7]; p.hy_conv_b = in[8]; p.hy_w1 = in[9]; p.hy_b1 = in[10]; p.hy_w2 = in[11]; p.hy_b2 = in[12]; p.hy_w3 = in[13];
  p.hy_freq = in[14]; p.hy_skip = in[15]; p.gqa_q_norm = in[16]; p.gqa_k_norm = in[17]; p.diff_lambda = in[18]; p.diff_subln = in[19];
  p.rel_bias = in[20]; p.w_branch = in[21]; p.w_out = in[22]; p.ffn2_norm = in[23]; p.ffn2_w_in = in[24]; p.ffn2_w_out = in[25]; p.final_norm = in[26];
  p.out = (float*)d_out; p.ws = (char*)d_ws;
  void* args[] = {&p};
  (void)hipMemsetAsync((char*)d_ws + O_BAR, 0, XCD_BAR_WORDS * 4, stream);
  hipError_t e = hipLaunchCooperativeKernel((void*)fwd_megakernel, dim3(grid_blocks), dim3(512), args, 0, stream);
  if (e != hipSuccess) fprintf(stderr, "cooperative launch failed: %s (grid %d)\n", hipGetErrorString(e), grid_blocks);
}
```

```cpp
#include <hip/hip_runtime.h>
#include <hip/hip_cooperative_groups.h>
#include <stdint.h>
#include <cstdio>
namespace cg = cooperative_groups;

typedef unsigned short u16;
typedef __attribute__((ext_vector_type(8))) short bf16x8;
typedef __attribute__((ext_vector_type(16))) float f32x16;
typedef __attribute__((ext_vector_type(4))) float f32x4;
typedef __attribute__((ext_vector_type(4))) unsigned u32x4;
typedef __attribute__((ext_vector_type(2))) unsigned u32x2;
typedef __attribute__((ext_vector_type(2))) __bf16 bf2_t;
typedef __attribute__((ext_vector_type(2))) float f2_t;
#define DI __device__ __forceinline__
#define MFMA(a, b, c) __builtin_amdgcn_mfma_f32_32x32x16_bf16((a), (b), (c), 0, 0, 0)

constexpr int DM = 1024, DFF = 2816, INC = 6912, TCH = 16384, NTOK = 49152;
constexpr int OFF_GQ = 1536, OFF_GK = 2048, OFF_GV = 2176, OFF_DQ = 2304, OFF_DK = 2816, OFF_DV = 3328, OFF_GATE = 3840;
constexpr float LOG2E = 1.4426950408889634f;

constexpr size_t SZ_F1IN = (size_t)5632 * 1024 * 2, SZ_F1OUT = (size_t)1024 * 2816 * 2, SZ_WIN = (size_t)6912 * 1024 * 2,
                 SZ_WBR = (size_t)3 * 1024 * 512 * 2, SZ_WOUT = (size_t)1024 * 1024 * 2;
constexpr size_t O_F1IN = 0, O_F1OUT = O_F1IN + SZ_F1IN, O_WIN = O_F1OUT + SZ_F1OUT, O_WBR = O_WIN + SZ_WIN, O_WOUT = O_WBR + SZ_WBR,
                 O_F2IN = O_WOUT + SZ_WOUT, O_F2OUT = O_F2IN + SZ_F1IN, O_FILT8 = O_F2OUT + SZ_F1OUT,
                 O_FILT16 = O_FILT8 + (size_t)512 * 16384 * 2, O_MISC = O_FILT16 + (size_t)512 * 32768 * 2,
                 O_P = O_MISC + 65536, O_HN = O_P + (size_t)TCH * INC * 2, O_ZT = O_HN + (size_t)TCH * 1024 * 2,
                 O_YT = O_ZT + (size_t)TCH * 512 * 2, O_DIFFO = O_YT + (size_t)TCH * 512 * 2, O_VTG = O_DIFFO + (size_t)TCH * 1024 * 2,
                 O_VTD = O_VTG + (size_t)TCH * 128 * 2, O_YHY = O_VTD + (size_t)TCH * 512 * 2, O_YGQ = O_YHY + (size_t)TCH * 512 * 2,
                 O_YDF = O_YGQ + (size_t)TCH * 512 * 2, O_END = O_YDF + (size_t)TCH * 512 * 2;
static_assert(O_END <= (size_t)536870912, "workspace overflow");
constexpr int SMEM_BYTES = 151552;
constexpr int GRP_LDS = 75776;
#define REPMASK 0
#define REP_SYNC 1
#define PHASE_IDS() const int t_ = otid(); const int bid = __builtin_amdgcn_readfirstlane(((volatile LAS unsigned*)&xb_words)[3]); const int lane = t_ & 63; const int grp = __builtin_amdgcn_readfirstlane(t_ >> 8); \
  const int w = __builtin_amdgcn_readfirstlane((t_ >> 6) & 3); const int bid2 = bid * 2 + grp; char* smg = smem + grp * GRP_LDS; \
  const int vb = (bid & 7) * (nb >> 3) + (bid >> 3); (void)lane; (void)w; (void)bid2; (void)smg; (void)vb
#define GSYNC() do { for (int rs_ = 0; rs_ < REP_SYNC; ++rs_) xcd_barrier(xb); } while (0)


#define XB_TMO      128
#define XB_XCNT(j)  (256  + 64 * (j))
#define XB_XSUB(j)  (1280 + 64 * (j))
#define XB_XGEN(j)  (2304 + 64 * (j))
#define XB_TOP      3328
#define XB_TOPGEN   3392
#define XCD_BAR_WORDS 3456
#define XB_SPIN_CAP (1u << 21)
#define LAS __attribute__((address_space(3)))
DI unsigned xb_ld(unsigned* p)              { return __hip_atomic_load(p, __ATOMIC_RELAXED, __HIP_MEMORY_SCOPE_AGENT); }
DI unsigned xb_add(unsigned* p, unsigned v) { return __hip_atomic_fetch_add(p, v, __ATOMIC_RELAXED, __HIP_MEMORY_SCOPE_AGENT); }
DI unsigned xb_xcc_id() { return (unsigned)__builtin_amdgcn_s_getreg((3 << 11) | 20) & 0xFu; }
#define XB_SPIN(cond, bar) do { unsigned _sp = 0; while (cond) { __builtin_amdgcn_s_sleep(1); \
    if ((++_sp & 255u) == 0u) { if (xb_ld(&(bar)[XB_TMO])) break; if (_sp > XB_SPIN_CAP) { atomicAdd(&(bar)[XB_TMO], 1u); break; } } } } while (0)
struct XcdBarrier { unsigned* bar; unsigned x; volatile LAS unsigned* st; };
DI XcdBarrier xcd_barrier_post(unsigned* bar, volatile LAS unsigned* st) {
  XcdBarrier b; b.bar = bar; b.x = xb_xcc_id(); b.st = st;
  if (threadIdx.x == 0) { const unsigned rank = xb_add(&bar[XB_XCNT(b.x)], 1u); st[2] = rank; }
  return b;
}
DI void xcd_barrier_complete(unsigned* bar, unsigned x, unsigned& nloc, unsigned& nx) {
  const unsigned G = gridDim.x * gridDim.y * gridDim.z;
  unsigned sum, cnt, mine, sp = 0u;
  for (;;) {
    sum = 0u; cnt = 0u; mine = 0u;
#pragma unroll
    for (unsigned j = 0; j < 16; ++j) { const unsigned c = xb_ld(&bar[XB_XCNT(j)]); sum += c; cnt += (c > 0u) ? 1u : 0u; mine = (j == x) ? c : mine; }
    if (sum == G) break;
    __builtin_amdgcn_s_sleep(1);
    if ((++sp & 255u) == 0u) { if (xb_ld(&bar[XB_TMO])) break; if (sp > XB_SPIN_CAP) { atomicAdd(&bar[XB_TMO], 1u); break; } }
  }
  nloc = mine > 0u ? mine : 1u; nx = cnt > 0u ? cnt : 1u;
}
DI void xcd_barrier(const XcdBarrier& b) {
  asm volatile("s_waitcnt vmcnt(0)" ::: "memory");
  __syncthreads();
  if (threadIdx.x == 0) {
    unsigned* bar = b.bar;
    __builtin_amdgcn_s_waitcnt(0);
    unsigned nloc = b.st[0], nx = b.st[1];
    if (nloc == 0u) { xcd_barrier_complete(bar, b.x, nloc, nx); b.st[0] = nloc; b.st[1] = nx; }
    const unsigned old = xb_add(&bar[XB_XSUB(b.x)], 1u);
    const unsigned gen = old / nloc;
    if (old + 1u == (gen + 1u) * nloc) {
      __builtin_amdgcn_fence(__ATOMIC_RELEASE, "agent");
      asm volatile("s_waitcnt vmcnt(0)" ::: "memory");
      const unsigned og = xb_add(&bar[XB_TOP], 1u);
      const unsigned tg = og / nx;
      if (og + 1u == (tg + 1u) * nx) xb_add(&bar[XB_TOPGEN], 1u);
      else XB_SPIN(xb_ld(&bar[XB_TOPGEN]) == tg, bar);
      __builtin_amdgcn_fence(__ATOMIC_ACQUIRE, "agent");
      xb_add(&bar[XB_XGEN(b.x)], 1u);
      asm volatile("s_waitcnt vmcnt(0)" ::: "memory");
    } else {
      XB_SPIN(xb_ld(&bar[XB_XGEN(b.x)]) == gen, bar);
      __builtin_amdgcn_fence(__ATOMIC_ACQUIRE, "agent");
      asm volatile("s_waitcnt vmcnt(0)" ::: "memory");
    }
  }
  __syncthreads();
}
constexpr size_t O_BAR = O_MISC + 16384;

struct Params {
  const float* x_prompt; const float* x_sample;
  const float* ffn1_norm; const float* ffn1_w_in; const float* ffn1_w_out; const float* mix_norm; const float* w_in;
  const float* hy_conv_w; const float* hy_conv_b; const float* hy_w1; const float* hy_b1; const float* hy_w2; const float* hy_b2;
  const float* hy_w3; const float* hy_freq; const float* hy_skip;
  const float* gqa_q_norm; const float* gqa_k_norm; const float* diff_lambda; const float* diff_subln; const float* rel_bias;
  const float* w_branch; const float* w_out; const float* ffn2_norm; const float* ffn2_w_in; const float* ffn2_w_out; const float* final_norm;
  float* out; char* ws;
};

DI unsigned pack2(float a, float b) { f2_t v = {a, b}; bf2_t r = __builtin_convertvector(v, bf2_t); return __builtin_bit_cast(unsigned, r); }
DI u16 f2bf(float a) { return (u16)(pack2(a, 0.f) & 0xffffu); }
DI float bf2f(u16 v) { return __uint_as_float(((unsigned)v) << 16); }
DI float bflo(unsigned v) { return __uint_as_float(v << 16); }
DI float bfhi(unsigned v) { return __uint_as_float(v & 0xffff0000u); }
DI int otid() { int t = threadIdx.x; asm volatile("" : "+v"(t)); return t; }
DI int crow(int reg, int h) { return (reg & 3) + 8 * (reg >> 2) + 4 * h; }
DI float wave_sum(float v) {
  v += __shfl_xor(v, 32); v += __shfl_xor(v, 16); v += __shfl_xor(v, 8); v += __shfl_xor(v, 4); v += __shfl_xor(v, 2); v += __shfl_xor(v, 1);
  return v;
}
DI float half_sum(float v) {
  v += __shfl_xor(v, 16); v += __shfl_xor(v, 8); v += __shfl_xor(v, 4); v += __shfl_xor(v, 2); v += __shfl_xor(v, 1);
  return v;
}

DI void convT_tile(const float* __restrict__ src, int K, int N, u16* __restrict__ dst, int kt, int nt, int perm_half, char* smem) {
  float* t = (float*)smem;
  const int tid = otid() & 255;
  __syncthreads();
  {
    const int col = tid & 63, r0 = tid >> 6;
#pragma unroll
    for (int i = 0; i < 16; ++i) { int row = r0 + 4 * i; t[row * 65 + col] = src[(size_t)(kt * 64 + row) * N + nt * 64 + col]; }
  }
  __syncthreads();
  {
    const int nl = tid >> 2, kq = tid & 3;
    int n = nt * 64 + nl;
    if (perm_half > 0) { if (n < perm_half) n = (n >> 7) * 256 + (n & 127); else { int j = n - perm_half; n = (j >> 7) * 256 + 128 + (j & 127); } }
    u32x4 o0, o1;
#pragma unroll
    for (int i = 0; i < 4; ++i) {
      o0[i] = pack2(t[(kq * 16 + 2 * i) * 65 + nl], t[(kq * 16 + 2 * i + 1) * 65 + nl]);
      o1[i] = pack2(t[(kq * 16 + 8 + 2 * i) * 65 + nl], t[(kq * 16 + 8 + 2 * i + 1) * 65 + nl]);
    }
    u16* d = dst + (size_t)n * K + kt * 64 + kq * 16;
    *(u32x4*)d = o0; *(u32x4*)(d + 8) = o1;
  }
}

DI void filter_item(const Params& P, int layer, int L, int tb, u16* __restrict__ G, char* smem) {
  float* h1 = (float*)smem;
  float* h2 = h1 + 64 * 65;
  const int tid = otid() & 255, lane = tid & 63, w = __builtin_amdgcn_readfirstlane(tid >> 6);
  const float* w1 = P.hy_w1 + layer * 33 * 64; const float* b1 = P.hy_b1 + layer * 64;
  const float* w2 = P.hy_w2 + layer * 64 * 64; const float* b2 = P.hy_b2 + layer * 64;
  const float* w3 = P.hy_w3 + layer * 64 * 1024; const float* fr = P.hy_freq + layer * 64;
  const int t = tb * 64 + lane;
  const float tl = (float)t / (float)(L - 1);
  __syncthreads();
  {
    float a[16];
#pragma unroll
    for (int u = 0; u < 16; ++u) a[u] = b1[w * 16 + u] + tl * w1[w * 16 + u];
    const float base = (float)(2.0 * 3.14159265358979323846 / (double)L) * (float)t;
    for (int b = 0; b < 16; ++b) {
      const float band = 1e-4f + (float)b * ((15.0f - 1e-4f) / 15.0f);
      const float ang = base * band;
      const float cs = cosf(ang), sn = -sinf(ang);
#pragma unroll
      for (int u = 0; u < 16; ++u) a[u] += cs * w1[(1 + b) * 64 + w * 16 + u] + sn * w1[(17 + b) * 64 + w * 16 + u];
    }
#pragma unroll
    for (int u = 0; u < 16; ++u) h1[lane * 65 + w * 16 + u] = sinf(fr[w * 16 + u] * a[u]);
  }
  __syncthreads();
  {
    float a[16];
#pragma unroll
    for (int u = 0; u < 16; ++u) a[u] = b2[w * 16 + u];
    for (int k = 0; k < 64; ++k) {
      const float hv = h1[lane * 65 + k];
#pragma unroll
      for (int u = 0; u < 16; ++u) a[u] += hv * w2[k * 64 + w * 16 + u];
    }
#pragma unroll
    for (int u = 0; u < 16; ++u) h2[lane * 65 + w * 16 + u] = sinf(fr[w * 16 + u] * a[u]);
  }
  __syncthreads();
  const float min_decay = -3.0701134573253946f, max_decay = -15.350567286626973f;
  for (int og = 0; og < 64; ++og) {
    const int o = w * 256 + og * 4;
    float a0 = 0.f, a1 = 0.f, a2 = 0.f, a3 = 0.f;
#pragma unroll 4
    for (int k = 0; k < 64; ++k) {
      const float hv = h2[lane * 65 + k];
      const f32x4 wv = *(const f32x4*)(w3 + k * 1024 + o);
      a0 += hv * wv[0]; a1 += hv * wv[1]; a2 += hv * wv[2]; a3 += hv * wv[3];
    }
    float av[4] = {a0, a1, a2, a3};
#pragma unroll
    for (int q = 0; q < 4; ++q) {
      const int oo = o + q; const int ch = oo & 511;
      const float delta = min_decay + (float)ch * ((max_decay - min_decay) / 511.0f);
      const float val = av[q] * expf(-tl * fabsf(delta));
      u16* Gc = G + (size_t)ch * (2 * L);
      if (oo < 512) Gc[L - t] = f2bf(val);
      else { if (t >= 1) Gc[L + t] = f2bf(val); else Gc[0] = 0; }
    }
  }
}

DI void norm_row_bf16(const float* __restrict__ x, const float* __restrict__ g, u16* __restrict__ out, int lane) {
  f32x4 v[4]; float ss = 0.f;
#pragma unroll
  for (int i = 0; i < 4; ++i) { v[i] = *(const f32x4*)(x + lane * 4 + 256 * i); ss += v[i][0] * v[i][0] + v[i][1] * v[i][1] + v[i][2] * v[i][2] + v[i][3] * v[i][3]; }
  ss = wave_sum(ss);
  const float rs = rsqrtf(ss * (1.0f / 1024.0f) + 1e-6f);
#pragma unroll
  for (int i = 0; i < 4; ++i) {
    const f32x4 gg = *(const f32x4*)(g + lane * 4 + 256 * i);
    u32x2 o; o[0] = pack2(v[i][0] * rs * gg[0], v[i][1] * rs * gg[1]); o[1] = pack2(v[i][2] * rs * gg[2], v[i][3] * rs * gg[3]);
    *(u32x2*)(out + lane * 4 + 256 * i) = o;
  }
}
DI void norm_row_f32_inplace(float* __restrict__ x, const float* __restrict__ g, int lane) {
  f32x4 v[4]; float ss = 0.f;
#pragma unroll
  for (int i = 0; i < 4; ++i) { v[i] = *(const f32x4*)(x + lane * 4 + 256 * i); ss += v[i][0] * v[i][0] + v[i][1] * v[i][1] + v[i][2] * v[i][2] + v[i][3] * v[i][3]; }
  ss = wave_sum(ss);
  const float rs = rsqrtf(ss * (1.0f / 1024.0f) + 1e-6f);
#pragma unroll
  for (int i = 0; i < 4; ++i) {
    const f32x4 gg = *(const f32x4*)(g + lane * 4 + 256 * i);
    f32x4 o; o[0] = v[i][0] * rs * gg[0]; o[1] = v[i][1] * rs * gg[1]; o[2] = v[i][2] * rs * gg[2]; o[3] = v[i][3] * rs * gg[3];
    *(f32x4*)(x + lane * 4 + 256 * i) = o;
  }
}

namespace pg8 {
#define PG8_LAS __attribute__((address_space(3)))
typedef unsigned short bf16_t;
typedef short bf16x8 __attribute__((ext_vector_type(8)));
typedef float f32x4 __attribute__((ext_vector_type(4)));
typedef unsigned u32x4 __attribute__((ext_vector_type(4)));
constexpr int BM = 256, BK = 64, HALF = 128, HTB = HALF * BK * 2  , STAGE_BYTES = 8 * HTB, NXCD = 8, WGM = 8;

__host__ __device__ __forceinline__ int lds_byte(int r, int c) { const int st = (r >> 4) * 2 + (c >> 5), rr = r & 15, cc = c & 31, ob = rr * 64 + cc * 2; return st * 1024 + (ob ^ (((ob >> 9) & 1) << 5)); }
__host__ __device__ __forceinline__ void stage_rc(int b, int& R, int& C) { const int st = b / 1024, sb = b % 1024, swz = sb ^ (((sb >> 9) & 1) << 5); R = (st >> 1) * 16 + swz / 64; C = (st & 1) * 32 + (swz % 64) / 2; }
__host__ __device__ __forceinline__ int perm32(int rho) { const int n = rho >> 4, i = rho & 15; return 8 * (i >> 2) + 4 * n + (i & 3); }

struct Unit { int pm, pn; };
struct Gemm { const bf16_t* A; const bf16_t* Bt; int M, N, K; };

struct StaticOrder {
    int nM, nN, nwg, G, c;
    __host__ __device__ void init(int M, int N, int G_, int c_) { nM = M / BM; nN = N / BM; nwg = nM * nN; G = G_; c = c_; }
    __host__ __device__ bool next(int i, Unit& u) const {
        const long L = (long)i * G + c; if (L >= nwg) return false;
        int wgid = (int)L; { const int q = nwg / NXCD, r = nwg % NXCD, xcd = wgid % NXCD, off = wgid / NXCD; wgid = (xcd < r ? xcd * (q + 1) : r * (q + 1) + (xcd - r) * q) + off; }
        const int nig = WGM * nN, gid = wgid / nig, fm = gid * WGM, gsz = (nM - fm) < WGM ? (nM - fm) : WGM;
        u.pm = fm + ((wgid % nig) % gsz); u.pn = (wgid % nig) / gsz; return true;
    }
    __device__ __forceinline__ void a_ready(const Unit&) const {}
    __device__ __forceinline__ void done(const Unit&) const {}
};

template <class Epi, class Sched, bool STAMP = false>
__device__ __forceinline__ void gemm_phase(PG8_LAS unsigned char* lds, const Gemm g, const Sched& S, const Epi& E, unsigned long long* stamps) {
    const int tid = otid(), wid = __builtin_amdgcn_readfirstlane(tid >> 6), lane = tid & 63, wr = wid >> 2, wc = wid & 3, fr = lane & 15, fq = lane >> 4;
    const int K = g.K, nt = K / BK;
    int ts_lo = 0, ts_hi = 0, nts = 0; const unsigned long long rt_entry = STAMP ? (unsigned long long)wall_clock64() : 0ull;
#define PG8_STAMP() do { if (STAMP && wid == 0 && nts < 64) { const unsigned long long _c = (unsigned long long)clock64(); \
        ts_lo = (lane == nts) ? (int)(unsigned)_c : ts_lo; ts_hi = (lane == nts) ? (int)(unsigned)(_c >> 32) : ts_hi; ++nts; } } while (0)
    PG8_STAMP();
    unsigned voffA[2], voffB[2];
#pragma unroll
    for (int i = 0; i < 2; ++i) { int R, C; stage_rc(tid * 16 + i * 8192, R, C); const int Rb = E.perm ? ((R & ~31) + perm32(R & 31)) : R;
        voffA[i] = (unsigned)(R * K + C) * 2u; voffB[i] = (unsigned)(Rb * K + C) * 2u; }
    const size_t kstep = (size_t)(BK * 2);
    const size_t hstep = (size_t)HALF * K * 2;
    const size_t tstep = 2 * hstep;
    const unsigned ldsw = (unsigned)wid * 1024u;
    const int aoff = lds_byte(wr * 64 + fr, fq * 8), boff = lds_byte(wc * 32 + fr, fq * 8);
#define PG8_SA(b, h) (((b) * 2 + (h)) * HTB)
#define PG8_SB(b, h) ((4 + (b) * 2 + (h)) * HTB)
#define PG8_STAGE(bufoff, gbase, voff) do { _Pragma("unroll") for (int _i = 0; _i < 2; ++_i) \
        __builtin_amdgcn_global_load_lds((const unsigned*)((const char*)(gbase) + (voff)[_i]), (PG8_LAS unsigned*)(lds + (bufoff) + ldsw + _i * 8192), 16, 0, 0); } while (0)
#define PG8_LDA(dst, b, h) do { _Pragma("unroll") for (int m = 0; m < 4; ++m) _Pragma("unroll") for (int k = 0; k < 2; ++k) dst[m][k] = *(const PG8_LAS bf16x8*)(lds + PG8_SA(b, h) + aoff + m * 2048 + k * 1024); } while (0)
#define PG8_LDB(dst, b, h) do { _Pragma("unroll") for (int n = 0; n < 2; ++n) _Pragma("unroll") for (int k = 0; k < 2; ++k) dst[n][k] = *(const PG8_LAS bf16x8*)(lds + PG8_SB(b, h) + boff + n * 2048 + k * 1024); } while (0)
#define PG8_MMA(ai, bj, At, Bt) do { __builtin_amdgcn_s_setprio(1); _Pragma("unroll") for (int m = 0; m < 4; ++m) _Pragma("unroll") for (int n = 0; n < 2; ++n) _Pragma("unroll") for (int k = 0; k < 2; ++k) \
        acc[ai][bj][m][n] = __builtin_amdgcn_mfma_f32_16x16x32_bf16(Bt[n][k], At[m][k], acc[ai][bj][m][n], 0, 0, 0); __builtin_amdgcn_s_setprio(0); } while (0)
#define PG8_WAIT_V(n) asm volatile("s_waitcnt vmcnt(" #n ")" ::: "memory")
#define PG8_WAIT_L(n) asm volatile("s_waitcnt lgkmcnt(" #n ")" ::: "memory")
#define PG8_BAR __builtin_amdgcn_s_barrier()
#define PG8_SCHED __builtin_amdgcn_sched_barrier(0)
    Unit cur, nxt; int ui = 0;
    if (!S.next(0, cur)) return;
    f32x4 acc[2][2][4][2];
#pragma unroll
    for (int a = 0; a < 2; ++a)
#pragma unroll
        for (int b = 0; b < 2; ++b)
#pragma unroll
            for (int m = 0; m < 4; ++m)
#pragma unroll
                for (int n = 0; n < 2; ++n) acc[a][b][m][n] = (f32x4){0.f, 0.f, 0.f, 0.f};
    bf16x8 At[4][2], B0[2][2], B1[2][2];
    const char* cA = (const char*)g.A + (size_t)cur.pm * tstep; const char* cB = (const char*)g.Bt + (size_t)cur.pn * tstep;
    S.a_ready(cur);
    PG8_STAGE(PG8_SB(0, 0), cB, voffB); PG8_STAGE(PG8_SA(0, 0), cA, voffA); PG8_STAGE(PG8_SB(0, 1), cB + hstep, voffB); PG8_STAGE(PG8_SA(0, 1), cA + hstep, voffA);
    if (wr == 1) PG8_BAR;
    PG8_WAIT_V(4); PG8_BAR;
    PG8_STAGE(PG8_SB(1, 0), cB + kstep, voffB); PG8_STAGE(PG8_SA(1, 0), cA + kstep, voffA); PG8_STAGE(PG8_SB(1, 1), cB + hstep + kstep, voffB);
    PG8_WAIT_V(6); PG8_BAR;
    PG8_STAMP();
    for (;;) {
        const bool has_next = S.next(ui + 1, nxt);
        const char* nA = has_next ? (const char*)g.A + (size_t)nxt.pm * tstep : cA; const char* nB = has_next ? (const char*)g.Bt + (size_t)nxt.pn * tstep : cB;
        for (int t = 0; t < nt; t += 2) {
            const bool last = (t == nt - 2);
            const char* a1 = cA + (size_t)(t + 1) * kstep;
            const char* a2 = last ? nA : cA + (size_t)(t + 2) * kstep; const char* b2 = last ? nB : cB + (size_t)(t + 2) * kstep;
            const char* a3 = a2 + kstep; const char* b3 = b2 + kstep;
            if (last && has_next) S.a_ready(nxt);
            PG8_LDB(B0, 0, 0); PG8_SCHED; PG8_LDA(At, 0, 0); PG8_STAGE(PG8_SA(1, 1), a1 + hstep, voffA);
            PG8_WAIT_L(8); PG8_BAR; PG8_WAIT_L(0); PG8_MMA(0, 0, At, B0); PG8_BAR; PG8_SCHED;
            PG8_LDB(B1, 0, 1); PG8_STAGE(PG8_SB(0, 0), b2, voffB);
            PG8_BAR; PG8_WAIT_L(0); PG8_MMA(0, 1, At, B1); PG8_BAR;
            PG8_LDA(At, 0, 1); PG8_STAGE(PG8_SA(0, 0), a2, voffA);
            PG8_BAR; PG8_WAIT_L(0); PG8_MMA(1, 0, At, B0); PG8_BAR; PG8_SCHED;
            PG8_STAGE(PG8_SB(0, 1), b2 + hstep, voffB);
            PG8_WAIT_V(6); PG8_BAR; PG8_MMA(1, 1, At, B1); PG8_BAR;
            PG8_LDB(B0, 1, 0); PG8_SCHED; PG8_LDA(At, 1, 0); PG8_STAGE(PG8_SA(0, 1), a2 + hstep, voffA);
            PG8_WAIT_L(8); PG8_BAR; PG8_WAIT_L(0); PG8_MMA(0, 0, At, B0); PG8_BAR; PG8_SCHED;
            PG8_LDB(B1, 1, 1); PG8_STAGE(PG8_SB(1, 0), b3, voffB);
            PG8_BAR; PG8_WAIT_L(0); PG8_MMA(0, 1, At, B1); PG8_BAR;
            PG8_LDA(At, 1, 1); PG8_STAGE(PG8_SA(1, 0), a3, voffA);
            PG8_BAR; PG8_WAIT_L(0); PG8_MMA(1, 0, At, B0); PG8_BAR; PG8_SCHED;
            PG8_STAGE(PG8_SB(1, 1), b3 + hstep, voffB);
            PG8_WAIT_V(6); PG8_BAR; PG8_MMA(1, 1, At, B1); PG8_BAR;
        }
        PG8_STAMP();
        if constexpr (!Epi::AFTER_DRAIN) { E(acc, cur, wr, wc, fr, fq); S.done(cur); }
        PG8_STAMP();
        if (!has_next) break;
#pragma unroll
        for (int a = 0; a < 2; ++a)
#pragma unroll
            for (int b = 0; b < 2; ++b)
#pragma unroll
                for (int m = 0; m < 4; ++m)
#pragma unroll
                    for (int n = 0; n < 2; ++n) acc[a][b][m][n] = (f32x4){0.f, 0.f, 0.f, 0.f};
        cur = nxt; cA = nA; cB = nB; ++ui;
    }
    PG8_WAIT_V(0);
    if (wr == 0) PG8_BAR;
    PG8_BAR;
    if constexpr (Epi::AFTER_DRAIN) { E.fused(acc, cur, wr, wc, fr, fq, lds, wid, lane); S.done(cur); }
    PG8_STAMP();
    if (STAMP && wid == 0) { stamps[lane] = lane < nts ? (((unsigned long long)(unsigned)ts_hi << 32) | (unsigned)ts_lo) : 0ull;
        if (lane == 62) stamps[62] = rt_entry; if (lane == 63) stamps[63] = (unsigned long long)wall_clock64(); }
#undef PG8_STAMP
#undef PG8_SA
#undef PG8_SB
#undef PG8_STAGE
#undef PG8_LDA
#undef PG8_LDB
#undef PG8_MMA
#undef PG8_WAIT_V
#undef PG8_WAIT_L
#undef PG8_BAR
#undef PG8_SCHED
}
}

enum { EPI_SWIGLU = 0, EPI_RESID = 1, EPI_PROJ = 2, EPI_MERGE = 3 };
struct EpiAny {
  static constexpr bool AFTER_DRAIN = false;
  int mode; bool perm;
  u16* O; int ldo; const float* xin; float* xout; float scale; const u16* gate; float* macc; int br;
  DI void operator()(const pg8::f32x4 (&acc)[2][2][4][2], const pg8::Unit& u, int wr, int wc, int fr, int fq) const {
    const int row0 = u.pm * 256 + wr * 64 + fr;
    if (mode == EPI_SWIGLU) {
      const int col0 = u.pn * 128 + wc * 32 + 8 * fq;
#pragma unroll
      for (int ai = 0; ai < 2; ++ai)
#pragma unroll
        for (int m = 0; m < 4; ++m) {
          float v[8];
#pragma unroll
          for (int n = 0; n < 2; ++n)
#pragma unroll
            for (int e = 0; e < 4; ++e) { const float gv = acc[ai][0][m][n][e], uv = acc[ai][1][m][n][e]; v[4 * n + e] = gv * __builtin_amdgcn_rcpf(1.0f + __builtin_amdgcn_exp2f(-LOG2E * gv)) * uv; }
          u32x4 o; o[0] = pack2(v[0], v[1]); o[1] = pack2(v[2], v[3]); o[2] = pack2(v[4], v[5]); o[3] = pack2(v[6], v[7]);
          *(u32x4*)(O + (size_t)(row0 + ai * 128 + m * 16) * ldo + col0) = o;
        }
    } else if (mode == EPI_PROJ) {
      const int col0 = u.pn * 256 + wc * 32 + 8 * fq;
      const bool sg = (u.pn * 256 >= OFF_GATE);
#pragma unroll
      for (int ai = 0; ai < 2; ++ai)
#pragma unroll
        for (int m = 0; m < 4; ++m)
#pragma unroll
          for (int bj = 0; bj < 2; ++bj) {
            float v[8];
#pragma unroll
            for (int n = 0; n < 2; ++n)
#pragma unroll
              for (int e = 0; e < 4; ++e) { float t = acc[ai][bj][m][n][e]; if (sg) t = __builtin_amdgcn_rcpf(1.0f + __builtin_amdgcn_exp2f(-LOG2E * t)); v[4 * n + e] = t; }
            u32x4 o; o[0] = pack2(v[0], v[1]); o[1] = pack2(v[2], v[3]); o[2] = pack2(v[4], v[5]); o[3] = pack2(v[6], v[7]);
            *(u32x4*)(O + (size_t)(row0 + ai * 128 + m * 16) * INC + col0 + bj * 128) = o;
          }
    } else if (mode == EPI_RESID) {
      const int col0 = u.pn * 256 + wc * 32 + 4 * fq;
#pragma unroll
      for (int ai = 0; ai < 2; ++ai)
#pragma unroll
        for (int m = 0; m < 4; ++m)
#pragma unroll
          for (int bj = 0; bj < 2; ++bj)
#pragma unroll
            for (int n = 0; n < 2; ++n) {
              const size_t idx = (size_t)(row0 + ai * 128 + m * 16) * DM + col0 + bj * 128 + n * 16;
              f32x4 xv = *(const f32x4*)(xin + idx);
#pragma unroll
              for (int e = 0; e < 4; ++e) xv[e] += scale * acc[ai][bj][m][n][e];
              *(f32x4*)(xout + idx) = xv;
            }
    } else {
      const int col0 = u.pn * 256 + wc * 32 + 4 * fq;
#pragma unroll
      for (int ai = 0; ai < 2; ++ai)
#pragma unroll
        for (int m = 0; m < 4; ++m)
#pragma unroll
          for (int bj = 0; bj < 2; ++bj)
#pragma unroll
            for (int n = 0; n < 2; ++n) {
              const int row = row0 + ai * 128 + m * 16, col = col0 + bj * 128 + n * 16;
              const u32x2 gt = *(const u32x2*)(gate + (size_t)row * INC + OFF_GATE + br * DM + col);
              f32x4 v;
              v[0] = bflo(gt[0]) * acc[ai][bj][m][n][0]; v[1] = bfhi(gt[0]) * acc[ai][bj][m][n][1];
              v[2] = bflo(gt[1]) * acc[ai][bj][m][n][2]; v[3] = bfhi(gt[1]) * acc[ai][bj][m][n][3];
              const size_t idx = (size_t)row * DM + col;
              if (br > 0) { const f32x4 pv = *(const f32x4*)(macc + idx); v[0] += pv[0]; v[1] += pv[1]; v[2] += pv[2]; v[3] += pv[3]; }
              if (br < 2) *(f32x4*)(macc + idx) = v;
              else { u32x2 o; o[0] = pack2(v[0], v[1]); o[1] = pack2(v[2], v[3]); *(u32x2*)(outb_() + idx) = o; }
            }
    }
  }
  DI u16* outb_() const { return O; }
};

DI void qk_prep_item(const Params& P, int layer, u16* __restrict__ p, int L, int it) {
  const int tid = otid() & 255, lane = tid & 63, w = __builtin_amdgcn_readfirstlane(tid >> 6);
  const int u = it * 8 + w * 2 + (lane >> 5);
  const int tok = u / 10, hd = u - tok * 10;
  const int i = lane & 31;
  const int col0 = (hd < 8) ? (OFF_GQ + hd * 64) : (OFF_GK + (hd - 8) * 64);
  const float* gn = (hd < 8) ? (P.gqa_q_norm + layer * 64) : (P.gqa_k_norm + layer * 64);
  unsigned* ptr = (unsigned*)(p + (size_t)tok * INC + col0) + i;
  const unsigned v = *ptr;
  float a = bflo(v), b = bfhi(v);
  const float ss = half_sum(a * a + b * b);
  const float rs = rsqrtf(ss * (1.0f / 64.0f) + 1e-6f);
  a = a * rs * gn[2 * i]; b = b * rs * gn[2 * i + 1];
  const int tl = tok % L;
  const float pos = (i < 16) ? (float)(tl >> 6) : (float)(tl & 63);
  const int jj = i & 15;
  const float inv = powf(10000.0f, -(float)(2 * jj) / 32.0f);
  const float ang = pos * inv;
  const float c = cosf(ang), s = sinf(ang);
  *ptr = pack2(a * c - b * s, a * s + b * c);
}

DI void transpose_item(const Params& P, int layer, const u16* __restrict__ p, int L, int kind, int ct, int tt, u16* __restrict__ dst, char* smem) {
  u16* tile = (u16*)smem;
  const int tid = otid() & 255;
  const int t0 = tt * 64;
  const int seq = t0 / L, tl0 = t0 - seq * L;
  const int C = (kind == 0) ? 128 : 512;
  __syncthreads();
  {
    const int col = tid & 63, r0 = tid >> 6;
    const int cidx = ct * 64 + col;
    if (kind < 2) {
      const int off = (kind == 0 ? OFF_GV : OFF_DV) + cidx;
#pragma unroll
      for (int i = 0; i < 16; ++i) { const int row = r0 + 4 * i; tile[col * 72 + row] = p[(size_t)(t0 + row) * INC + off]; }
    } else {
      const float* cw = P.hy_conv_w + layer * 3 * 1536; const float* cb = P.hy_conv_b + layer * 1536;
      const int c1 = 512 + cidx, c2 = 1024 + cidx;
      const float w10 = cw[c1], w11 = cw[1536 + c1], w12 = cw[3072 + c1], b1 = cb[c1];
      const float w20 = cw[c2], w21 = cw[1536 + c2], w22 = cw[3072 + c2], b2 = cb[c2];
#pragma unroll
      for (int i = 0; i < 16; ++i) {
        const int row = r0 + 4 * i; const int tl = tl0 + row;
        const u16* pr = p + (size_t)(t0 + row) * INC;
        const float xm1 = (tl > 0) ? bf2f(pr[c1 - INC]) : 0.f, x0 = bf2f(pr[c1]), xp1 = (tl < L - 1) ? bf2f(pr[c1 + INC]) : 0.f;
        const float vm1 = (tl > 0) ? bf2f(pr[c2 - INC]) : 0.f, v0 = bf2f(pr[c2]), vp1 = (tl < L - 1) ? bf2f(pr[c2 + INC]) : 0.f;
        const float x1c = xm1 * w10 + x0 * w11 + xp1 * w12 + b1;
        const float vc = vm1 * w20 + v0 * w21 + vp1 * w22 + b2;
        tile[col * 72 + row] = f2bf(vc * x1c);
      }
    }
  }
  __syncthreads();
  {
    const int c = tid >> 2, q = tid & 3;
    const u32x4 a = *(const u32x4*)(tile + c * 72 + q * 16), b = *(const u32x4*)(tile + c * 72 + q * 16 + 8);
    u16* d = dst + ((size_t)seq * C + ct * 64 + c) * L + tl0 + q * 16;
    *(u32x4*)d = a; *(u32x4*)(d + 8) = b;
  }
}

DI int kperm(int rho) { return (rho & ~0xC) | ((rho & 4) << 1) | ((rho & 8) >> 1); }
template <int DV, bool BIAS, bool SWAP>
DI void attn_tile(const u16* __restrict__ Qp, const u16* __restrict__ Kp, const u16* __restrict__ VTp, int L,
                  u16* __restrict__ Op, int ldo, int q0, const float* __restrict__ btab, char* smem) {
  constexpr int NDT = DV / 32;
  constexpr int VCH = DV / 32;
  constexpr int KS_SZ = 64 * 64, VS_SZ = DV * 64;
  constexpr int NL = 2 + VCH;
  u16* Ks = (u16*)smem;
  u16* Vs = Ks + 3 * KS_SZ;
  float* bt = (float*)(Vs + 3 * VS_SZ);
  const int tid = otid() & 255, lane = tid & 63, w = __builtin_amdgcn_readfirstlane(tid >> 6), r = lane & 31, h = lane >> 5;
  const float sc = 0.125f * LOG2E;
  __syncthreads();
  if (BIAS) { for (int i = tid; i < 257; i += 256) bt[i] = btab[i]; }
  bf16x8 qf[4];
  {
    const u16* qrow = Qp + (size_t)(q0 + 32 * w + r) * INC + 8 * h;
#pragma unroll
    for (int s = 0; s < 4; ++s) qf[s] = *(const bf16x8*)(qrow + 16 * s);
  }
  const int qpos = q0 + 32 * w + r;
  f32x16 O[NDT];
#pragma unroll
  for (int d = 0; d < NDT; ++d)
#pragma unroll
    for (int q = 0; q < 16; ++q) O[d][q] = 0.f;
  float m = -INFINITY, l = 0.f;
  const int lrow = tid >> 3, lsw = (tid & 7) ^ ((tid >> 4) & 7);
  const u16* Kg0 = Kp + (size_t)kperm(lrow) * INC + lsw * 8;
  const u16* Vg = VTp + (size_t)lrow * L + lsw * 8;
  const int ksw = (r >> 1) & 7;
#define ATT_LOADK(tile, bufp) do { _Pragma("unroll") for (int i_ = 0; i_ < 2; ++i_) \
    __builtin_amdgcn_global_load_lds((const unsigned*)(Kg0 + ((size_t)(tile) * 64 + 32 * i_) * INC), (unsigned*)((char*)(bufp) + tid * 16 + i_ * 4096), 16, 0, 0); } while (0)
#define ATT_LOADV(tile, bufp) do { _Pragma("unroll") for (int i_ = 0; i_ < VCH; ++i_) \
    __builtin_amdgcn_global_load_lds((const unsigned*)(Vg + (size_t)(32 * i_) * L + (size_t)(tile) * 64), (unsigned*)((char*)(bufp) + tid * 16 + i_ * 4096), 16, 0, 0); } while (0)
  ATT_LOADK(0, Ks); ATT_LOADK(1, Ks + KS_SZ); ATT_LOADK(2, Ks + 2 * KS_SZ); ATT_LOADV(0, Vs);
  for (int i = tid; i < VS_SZ / 8; i += 256) { u32x4 z = {0u, 0u, 0u, 0u}; *(u32x4*)(Vs + 2 * VS_SZ + i * 8) = z; }
  asm volatile("s_waitcnt vmcnt(0) lgkmcnt(0)\n\ts_barrier" ::: "memory");
  f32x16 Sc[2];
#pragma unroll
  for (int kt = 0; kt < 2; ++kt) {
#pragma unroll
    for (int q = 0; q < 16; ++q) Sc[kt][q] = 0.f;
#pragma unroll
    for (int s = 0; s < 4; ++s) {
      const bf16x8 a = *(const bf16x8*)(Ks + (32 * kt + r) * 64 + (((2 * s + h) ^ ksw) << 3));
      Sc[kt] = MFMA(a, qf[s], Sc[kt]);
    }
  }
  bf16x8 pf[2][2];
#pragma unroll
  for (int kt = 0; kt < 2; ++kt)
#pragma unroll
    for (int s = 0; s < 2; ++s)
#pragma unroll
      for (int j = 0; j < 8; ++j) pf[kt][s][j] = 0;
  const int nkb = L >> 6;
  int r0 = 0, r1 = 1, r2 = 2;
  for (int kb = 0; kb < nkb; ++kb) {
    { const int kt3 = (kb + 3 < nkb) ? kb + 3 : nkb - 1; ATT_LOADK(kt3, Ks + r0 * KS_SZ); }
    { const int vt1 = (kb + 1 < nkb) ? kb + 1 : nkb - 1; ATT_LOADV(vt1, Vs + r1 * VS_SZ); }
    f32x16 Sn[2];
    bf16x8 pn[2][2];
    float alpha = 1.0f; bool resc = false;
    auto partA = [&]() __attribute__((always_inline)) {
      const u16* Kb = Ks + r1 * KS_SZ;
#pragma unroll
      for (int kt = 0; kt < 2; ++kt) {
#pragma unroll
        for (int q = 0; q < 16; ++q) Sn[kt][q] = 0.f;
#pragma unroll
        for (int s = 0; s < 4; ++s) {
          const bf16x8 a = *(const bf16x8*)(Kb + (32 * kt + r) * 64 + (((2 * s + h) ^ ksw) << 3));
          Sn[kt] = MFMA(a, qf[s], Sn[kt]);
        }
      }
      const u16* Vb = Vs + r2 * VS_SZ;
#pragma unroll
      for (int kt = 0; kt < 2; ++kt)
#pragma unroll
        for (int s = 0; s < 2; ++s)
#pragma unroll
          for (int d = 0; d < NDT; ++d) {
            const bf16x8 av = *(const bf16x8*)(Vb + (32 * d + r) * 64 + (((4 * kt + 2 * s + h) ^ ksw) << 3));
            O[d] = MFMA(av, pf[kt][s], O[d]);
          }
    };
    auto partB = [&]() __attribute__((always_inline)) {
      if (BIAS) {
        const int kmin = kb * 64;
        if (kmin - (q0 + 127) >= 128 || q0 - (kmin + 63) >= 128) {
          const float cb = (kmin > q0) ? bt[256] : bt[0];
#pragma unroll
          for (int kt = 0; kt < 2; ++kt)
#pragma unroll
            for (int q = 0; q < 16; ++q) Sc[kt][q] = Sc[kt][q] * sc + cb;
        } else {
#pragma unroll
          for (int kt = 0; kt < 2; ++kt)
#pragma unroll
            for (int q = 0; q < 16; ++q) {
              int rel = kmin + 32 * kt + kperm(crow(q, h)) - qpos;
              rel = rel < -128 ? -128 : (rel > 128 ? 128 : rel);
              Sc[kt][q] = Sc[kt][q] * sc + bt[rel + 128];
            }
        }
      }
      float mx = Sc[0][0];
#pragma unroll
      for (int kt = 0; kt < 2; ++kt)
#pragma unroll
        for (int q = 0; q < 16; ++q) mx = fmaxf(mx, Sc[kt][q]);
      mx = fmaxf(mx, __shfl_xor(mx, 32));
      if (!BIAS) mx *= sc;
      if (__any(mx > m + 6.0f)) {
        const float mn = fmaxf(m, mx);
        alpha = __builtin_amdgcn_exp2f(m - mn);
        m = mn; l *= alpha; resc = true;
      }
      const float nm = -m;
#pragma unroll
      for (int kt = 0; kt < 2; ++kt) {
#pragma unroll
        for (int q = 0; q < 16; ++q) {
          const float pv = BIAS ? __builtin_amdgcn_exp2f(Sc[kt][q] + nm) : __builtin_amdgcn_exp2f(__builtin_fmaf(Sc[kt][q], sc, nm));
          Sc[kt][q] = pv; l += pv;
        }
#pragma unroll
        for (int s = 0; s < 2; ++s) {
          u32x4 pk;
#pragma unroll
          for (int q = 0; q < 4; ++q) pk[q] = pack2(Sc[kt][8 * s + 2 * q], Sc[kt][8 * s + 2 * q + 1]);
          pn[kt][s] = __builtin_bit_cast(bf16x8, pk);
        }
      }
    };
    if (SWAP) { partB(); partA(); } else { partA(); partB(); }
    if (resc) {
#pragma unroll
      for (int d = 0; d < NDT; ++d)
#pragma unroll
        for (int q = 0; q < 16; ++q) O[d][q] *= alpha;
    }
    asm volatile("s_waitcnt vmcnt(%0) lgkmcnt(0)\n\ts_barrier" :: "n"(NL) : "memory");
    { const int tmp = r0; r0 = r1; r1 = r2; r2 = tmp; }
#pragma unroll
    for (int kt = 0; kt < 2; ++kt) {
      Sc[kt] = Sn[kt];
#pragma unroll
      for (int s = 0; s < 2; ++s) pf[kt][s] = pn[kt][s];
    }
  }
  asm volatile("s_waitcnt vmcnt(0)" ::: "memory");
  {
    const u16* Vb = Vs + r2 * VS_SZ;
#pragma unroll
    for (int kt = 0; kt < 2; ++kt)
#pragma unroll
      for (int s = 0; s < 2; ++s)
#pragma unroll
        for (int d = 0; d < NDT; ++d) {
          const bf16x8 av = *(const bf16x8*)(Vb + (32 * d + r) * 64 + (((4 * kt + 2 * s + h) ^ ksw) << 3));
          O[d] = MFMA(av, pf[kt][s], O[d]);
        }
  }
#undef ATT_LOADK
#undef ATT_LOADV
  l += __shfl_xor(l, 32);
  const float inv = __builtin_amdgcn_rcpf(l);
  int ldo2 = ldo; asm volatile("" : "+s"(ldo2));
  u16* orow = Op + (size_t)qpos * ldo2;
#pragma unroll
  for (int d = 0; d < NDT; ++d)
#pragma unroll
    for (int g4 = 0; g4 < 4; ++g4) {
      u32x2 o; o[0] = pack2(O[d][4 * g4] * inv, O[d][4 * g4 + 1] * inv); o[1] = pack2(O[d][4 * g4 + 2] * inv, O[d][4 * g4 + 3] * inv);
      *(u32x2*)(orow + 32 * d + 8 * g4 + 4 * h) = o;
    }
}

DI void hyena_item(int c, const u16* __restrict__ G, const u16* __restrict__ zT, u16* __restrict__ yT, int nseq, int L, char* smem) {
  u16* zs = (u16*)smem;
  u16* fw = zs + 20480;
  const int tid = otid() & 255, lane = tid & 63, w = __builtin_amdgcn_readfirstlane(tid >> 6), r = lane & 31, h = lane >> 5;
  const int ZL = L + 2048;
  __syncthreads();
  for (int q = 0; q < nseq; ++q) {
    const u16* src = zT + ((size_t)q * 512 + c) * L;
    u16* dst = zs + q * ZL;
    const u32x4 zero = {0u, 0u, 0u, 0u};
    for (int i = tid; i < 128; i += 256) { *(u32x4*)(dst + i * 8) = zero; *(u32x4*)(dst + 1024 + L + i * 8) = zero; }
    for (int i = tid; i < (L >> 3); i += 256) *(u32x4*)(dst + 1024 + i * 8) = *(const u32x4*)(src + i * 8);
  }
  int tq[4], tJ[4];
#pragma unroll
  for (int i = 0; i < 4; ++i) { if (nseq == 2) { tq[i] = i & 1; tJ[i] = 2 * w + (i >> 1); } else { tq[i] = 0; tJ[i] = 4 * w + i; } }
  f32x16 acc[4];
#pragma unroll
  for (int i = 0; i < 4; ++i)
#pragma unroll
    for (int q = 0; q < 16; ++q) acc[i][q] = 0.f;
  const int E0 = -L + 16, ELAST = L - 32;
  const int npass = (2 * L - 32 + 8191) / 8192;
  const u16* Gc = G + (size_t)c * (2 * L);
  for (int ps = 0; ps < npass; ++ps) {
    const int ea = E0 + 8192 * ps, eb = ea + 8192;
    const int wb = L - eb - 16;
    __syncthreads();
    for (int i = tid; i < 1032; i += 256) {
      const int gi = wb + i * 8;
      u32x4 v = {0u, 0u, 0u, 0u};
      if (gi >= 0 && gi < 2 * L) v = *(const u32x4*)(Gc + gi);
      *(u32x4*)(fw + i * 8) = v;
    }
    __syncthreads();
    const int eend = (eb - 16 < ELAST) ? (eb - 16) : ELAST;
    for (int e = ea; e <= eend; e += 16) {
      bool in[4]; bool any = false;
#pragma unroll
      for (int i = 0; i < 4; ++i) { in[i] = (e >= 1024 * tJ[i] - L + 16) && (e <= 1024 * tJ[i] + 992); any = any || in[i]; }
      if (!any) continue;
      const int idx0 = L - e - r + 8 * h - wb;
      bf16x8 a;
#pragma unroll
      for (int j = 0; j < 8; ++j) a[j] = (short)fw[idx0 + j];
#pragma unroll
      for (int i = 0; i < 4; ++i) {
        if (in[i]) {
          const bf16x8 b = *(const bf16x8*)(zs + tq[i] * ZL + 1024 + 1024 * tJ[i] + 32 * r - e + 8 * h);
          acc[i] = MFMA(a, b, acc[i]);
        }
      }
    }
  }
#pragma unroll
  for (int i = 0; i < 4; ++i) {
    u16* dst = yT + ((size_t)tq[i] * 512 + c) * L + 1024 * tJ[i] + 32 * r + 4 * h;
#pragma unroll
    for (int g4 = 0; g4 < 4; ++g4) {
      u32x2 o; o[0] = pack2(acc[i][4 * g4], acc[i][4 * g4 + 1]); o[1] = pack2(acc[i][4 * g4 + 2], acc[i][4 * g4 + 3]);
      *(u32x2*)(dst + 8 * g4) = o;
    }
  }
}

DI void diff_post_item(const Params& P, int layer, float lam, float lam_init, const u16* __restrict__ dO, u16* __restrict__ ydf, int it) {
  const int tid = otid() & 255, lane = tid & 63, w = __builtin_amdgcn_readfirstlane(tid >> 6);
  const int u = it * 8 + w * 2 + (lane >> 5);
  const int i = lane & 31;
  const u32x2 a = *(const u32x2*)(dO + (size_t)u * 256 + 4 * i);
  const u32x2 b = *(const u32x2*)(dO + (size_t)u * 256 + 128 + 4 * i);
  float o[4];
  o[0] = bflo(a[0]) - lam * bflo(b[0]); o[1] = bfhi(a[0]) - lam * bfhi(b[0]);
  o[2] = bflo(a[1]) - lam * bflo(b[1]); o[3] = bfhi(a[1]) - lam * bfhi(b[1]);
  const float ss = half_sum(o[0] * o[0] + o[1] * o[1] + o[2] * o[2] + o[3] * o[3]);
  const float rs = rsqrtf(ss * (1.0f / 128.0f) + 1e-5f) * (1.0f - lam_init);
  const float* g = P.diff_subln + layer * 128 + 4 * i;
  u32x2 ov; ov[0] = pack2(o[0] * rs * g[0], o[1] * rs * g[1]); ov[1] = pack2(o[2] * rs * g[2], o[3] * rs * g[3]);
  *(u32x2*)(ydf + (size_t)u * 128 + 4 * i) = ov;
}
DI void hyena_post_item(const Params& P, int layer, const u16* __restrict__ p, int L, const u16* __restrict__ yT, const u16* __restrict__ zT,
                        int ct, int tt, u16* __restrict__ yhy, char* smem) {
  float* tile = (float*)smem;
  const int tid = otid() & 255;
  const int t0 = tt * 64; const int seq = t0 / L, tl0 = t0 - seq * L;
  __syncthreads();
  {
    const int tcol = tid & 63, c0 = tid >> 6;
#pragma unroll
    for (int i = 0; i < 16; ++i) {
      const int cc = c0 + 4 * i; const int c = ct * 64 + cc;
      const size_t gi = ((size_t)seq * 512 + c) * L + tl0 + tcol;
      tile[cc * 65 + tcol] = bf2f(yT[gi]) + bf2f(zT[gi]) * P.hy_skip[layer * 512 + c];
    }
  }
  __syncthreads();
  {
    const int col = tid & 63, r0 = tid >> 6; const int c = ct * 64 + col;
    const float* cw = P.hy_conv_w + layer * 3 * 1536; const float* cb = P.hy_conv_b + layer * 1536;
    const float w0 = cw[c], w1 = cw[1536 + c], w2 = cw[3072 + c], b0 = cb[c];
#pragma unroll
    for (int i = 0; i < 16; ++i) {
      const int row = r0 + 4 * i; const int tl = tl0 + row;
      const u16* pr = p + (size_t)(t0 + row) * INC + c;
      const float xm1 = (tl > 0) ? bf2f(pr[-INC]) : 0.f, x0 = bf2f(pr[0]), xp1 = (tl < L - 1) ? bf2f(pr[INC]) : 0.f;
      const float x0c = xm1 * w0 + x0 * w1 + xp1 * w2 + b0;
      yhy[(size_t)(t0 + row) * 512 + c] = f2bf(x0c * tile[col * 65 + row]);
    }
  }
}

__global__ void __launch_bounds__(512) fwd_megakernel(Params Parg) {
  cg::grid_group grid = cg::this_grid();
  extern __shared__ __attribute__((aligned(16))) char smem_dyn[];
  char* smem = smem_dyn + 16;
  uint4& xb_words = *(uint4*)smem_dyn;
  const int nb = gridDim.x, nb2 = nb * 2;
#define KPARAMS() const Params __attribute__((address_space(4)))* pp_ = (const Params __attribute__((address_space(4)))*)__builtin_amdgcn_kernarg_segment_ptr(); \
  asm volatile("" : "+s"(pp_)); const Params& P = *(const Params*)pp_; char* ws = P.ws
  if (threadIdx.x == 0) xb_words = make_uint4(0u, 0u, 0u, blockIdx.x);
  __syncthreads();
  XcdBarrier xb;
  { KPARAMS(); xb = xcd_barrier_post((unsigned*)(ws + O_BAR), (volatile LAS unsigned*)&xb_words); }

  for (int step = 0; step < 80; ++step) {
    const int layer = step / 40, ls = step - layer * 40;
    PHASE_IDS();
    KPARAMS();
    float* misc = (float*)(ws + O_MISC);
    u16* pbuf = (u16*)(ws + O_P); u16* hid = pbuf; u16* hn = (u16*)(ws + O_HN); u16* merged = hn;
    if (ls == 0) {
      u16* filt8 = (u16*)(ws + O_FILT8); u16* filt16 = (u16*)(ws + O_FILT16);
      const int n1 = 16 * 88, n2 = 44 * 16, n3 = 16 * 108, n4 = 3 * 8 * 16, n5 = 16 * 16;
      const int nfilt = 128 + 256;
      const int total = n1 + n2 + n3 + n4 + n5 + n1 + n2 + nfilt;
      for (int it = bid2; it < total; it += nb2) {
        int t = it;
        if (t < nfilt) {
          const bool big = t < 256;
          filter_item(P, layer, big ? 16384 : 8192, big ? t : t - 256, big ? filt16 : filt8, smg);
          continue;
        }
        t -= nfilt;
        const float* src; int K, N, kt, nt, ph = 0; u16* dst;
        if (t < n1) { src = P.ffn1_w_in + (size_t)layer * 1024 * 5632; K = 1024; N = 5632; dst = (u16*)(ws + O_F1IN); kt = t / 88; nt = t % 88; ph = 2816; }
        else if ((t -= n1) < n2) { src = P.ffn1_w_out + (size_t)layer * 2816 * 1024; K = 2816; N = 1024; dst = (u16*)(ws + O_F1OUT); kt = t / 16; nt = t % 16; }
        else if ((t -= n2) < n3) { src = P.w_in + (size_t)layer * 1024 * 6912; K = 1024; N = 6912; dst = (u16*)(ws + O_WIN); kt = t / 108; nt = t % 108; }
        else if ((t -= n3) < n4) { const int br = t / 128, tt = t % 128; src = P.w_branch + ((size_t)layer * 3 + br) * 512 * 1024; K = 512; N = 1024;
                                   dst = (u16*)(ws + O_WBR) + (size_t)br * 1024 * 512; kt = tt / 16; nt = tt % 16; }
        else if ((t -= n4) < n5) { src = P.w_out + (size_t)layer * 1024 * 1024; K = 1024; N = 1024; dst = (u16*)(ws + O_WOUT); kt = t / 16; nt = t % 16; }
        else if ((t -= n5) < n1) { src = P.ffn2_w_in + (size_t)layer * 1024 * 5632; K = 1024; N = 5632; dst = (u16*)(ws + O_F2IN); kt = t / 88; nt = t % 88; ph = 2816; }
        else { t -= n1; src = P.ffn2_w_out + (size_t)layer * 2816 * 1024; K = 2816; N = 1024; dst = (u16*)(ws + O_F2OUT); kt = t / 16; nt = t % 16; }
        convT_tile(src, K, N, dst, kt, nt, ph, smg);
      }
      if (bid == 0 && grp == 0) {
        const int tid = t_;
        if (tid < 2) {
          const float* lp = P.diff_lambda + tid * 256;
          float s1 = 0.f, s2 = 0.f;
          for (int i = 0; i < 64; ++i) { s1 += lp[i] * lp[64 + i]; s2 += lp[128 + i] * lp[192 + i]; }
          const float lam_init = 0.8f - 0.6f * expf(-0.3f * (float)tid);
          misc[tid] = expf(s1) - expf(s2) + lam_init;
        }
        for (int i = tid; i < 4 * 257; i += 256) {
          const int hh = i / 257, idx = i % 257; const int rel = idx - 128; const int n = rel < 0 ? -rel : rel;
          int b;
          if (n < 8) b = n; else { int lg = 8 + (int)(logf((float)n / 8.0f) / 2.772588722239781f * 8.0f); b = lg < 15 ? lg : 15; }
          if (rel > 0) b += 16;
          misc[64 + i] = P.rel_bias[b * 4 + hh] * LOG2E;
        }
      }
      if (step == 0) {
        grid.sync();
        if (threadIdx.x == 0) {
          unsigned* bar = (unsigned*)(ws + O_BAR); bool even = ((nb & 7) == 0);
          for (int j = 0; j < 16; ++j) { const unsigned c = xb_ld(&bar[XB_XCNT(j)]); if (c != ((j < 8) ? (unsigned)(nb >> 3) : 0u)) even = false; }
          volatile LAS unsigned* st = (volatile LAS unsigned*)&xb_words;
          if (even) st[3] = st[2] * 8u + xb.x;
        }
        __syncthreads();
      } else GSYNC();
      continue;
    }
    const int cs = ls - 1; const int ch = cs / 13, st = cs - ch * 13;
    const int nseq = (ch < 2) ? 2 : 1, L = (ch < 2) ? 8192 : 16384;
    const float* xin0 = (ch < 2) ? (P.x_prompt + (size_t)ch * TCH * DM) : P.x_sample;
    float* xres = P.out + (size_t)ch * TCH * DM;
    const float* xcur = (layer == 0) ? xin0 : xres;
    for (int rp_ = 0; rp_ <= ((REPMASK >> st) & 1); ++rp_) {
    if (st == 0 || st == 3 || st == 10) {
      const float* src = (st == 0) ? xcur : xres;
      const float* gn = ((st == 0) ? P.ffn1_norm : (st == 3 ? P.mix_norm : P.ffn2_norm)) + layer * DM;
      for (int it = bid2; it < TCH / 4; it += nb2) { const int row = it * 4 + w; norm_row_bf16(src + (size_t)row * DM, gn, hn + (size_t)row * DM, lane); }
    } else if (st == 1 || st == 2 || st == 4 || st == 8 || st == 9 || st == 11 || st == 12) {
      EpiAny E{}; const u16* A; const u16* Bt; int N, K; int nrep = 1;
      if (st == 1 || st == 11) { A = hn; Bt = (u16*)(ws + (st == 1 ? O_F1IN : O_F2IN)); N = 5632; K = DM; E.mode = EPI_SWIGLU; E.perm = true; E.O = hid; E.ldo = DFF; }
      else if (st == 2 || st == 12) { A = hid; Bt = (u16*)(ws + (st == 2 ? O_F1OUT : O_F2OUT)); N = DM; K = DFF; E.mode = EPI_RESID; E.perm = false;
                                      E.xin = (st == 2) ? xcur : xres; E.xout = xres; E.scale = 0.5f; }
      else if (st == 4) { A = hn; Bt = (u16*)(ws + O_WIN); N = INC; K = DM; E.mode = EPI_PROJ; E.perm = true; E.O = pbuf; }
      else if (st == 8) { A = (u16*)(ws + O_YHY); Bt = (u16*)(ws + O_WBR); N = DM; K = 512; E.mode = EPI_MERGE; E.perm = false; E.gate = pbuf; E.macc = (float*)(ws + O_ZT); E.O = merged; nrep = 3; }
      else { A = merged; Bt = (u16*)(ws + O_WOUT); N = DM; K = DM; E.mode = EPI_RESID; E.perm = false; E.xin = xres; E.xout = xres; E.scale = 1.0f; }
      for (int rp = 0; rp < nrep; ++rp) {
        E.br = rp;
        pg8::Gemm gg{A + (size_t)rp * TCH * 512, Bt + (size_t)rp * 1024 * 512, TCH, N, K};
        pg8::StaticOrder S; S.init(TCH, N, nb, bid);
        pg8::gemm_phase<EpiAny, pg8::StaticOrder, false>((PG8_LAS unsigned char*)smem, gg, S, E, nullptr);
      }
    } else if (st == 5) {
      const int nqk = TCH * 10 / 8, ntr = 256 * 18;
      for (int it = bid2; it < nqk + ntr; it += nb2) {
        if (it < nqk) { qk_prep_item(P, layer, pbuf, L, it); continue; }
        const int t = it - nqk; const int tt = t / 18, cc = t % 18;
        const int kind = (cc < 2) ? 0 : (cc < 10 ? 1 : 2);
        const int ct = (cc < 2) ? cc : (cc < 10 ? cc - 2 : cc - 10);
        u16* dst = (u16*)(ws + (kind == 0 ? O_VTG : (kind == 1 ? O_VTD : O_ZT)));
        transpose_item(P, layer, pbuf, L, kind, ct, tt, dst, smg);
      }
    } else if (st == 6) {
      u16* zT = (u16*)(ws + O_ZT); u16* yT = (u16*)(ws + O_YT); u16* dO = (u16*)(ws + O_DIFFO);
      u16* vtg = (u16*)(ws + O_VTG); u16* vtd = (u16*)(ws + O_VTD); u16* ygq = (u16*)(ws + O_YGQ);
      const u16* filt = (u16*)(ws + ((ch < 2) ? O_FILT8 : O_FILT16));
      const int nqt = L / 128;
      const int xcd = bid & 7, nxu = (nb >> 3) * 2, u0 = (bid >> 3) * 2, nitem = nseq * nqt;
      for (int e0 = u0; e0 < nitem; e0 += nxu) {
        const int e = e0 + grp;
        const int seq = e / nqt, qt = e - seq * nqt;
        const int hh = xcd >> 1, cc = xcd & 1;
        const size_t tb = (size_t)seq * L;
        const u16* Qd = pbuf + tb * INC + OFF_DQ + xcd * 64; const u16* Kd = pbuf + tb * INC + OFF_DK + xcd * 64;
        const u16* Vd = vtd + ((size_t)seq * 512 + hh * 128) * L; u16* Od = dO + tb * 1024 + (hh * 2 + cc) * 128;
        if (grp) attn_tile<128, true, true>(Qd, Kd, Vd, L, Od, 1024, qt * 128, misc + 64 + hh * 257, smg);
        else attn_tile<128, true, false>(Qd, Kd, Vd, L, Od, 1024, qt * 128, misc + 64 + hh * 257, smg);
      }
      for (int e0 = u0; e0 < nitem; e0 += nxu) {
        const int e = e0 + grp;
        const int seq = e / nqt, qt = e - seq * nqt;
        const int kvh = xcd >> 2;
        const size_t tb = (size_t)seq * L;
        const u16* Qd = pbuf + tb * INC + OFF_GQ + xcd * 64; const u16* Kd = pbuf + tb * INC + OFF_GK + kvh * 64;
        const u16* Vd = vtg + ((size_t)seq * 128 + kvh * 64) * L; u16* Od = ygq + tb * 512 + xcd * 64;
        if (grp) attn_tile<64, false, true>(Qd, Kd, Vd, L, Od, 512, qt * 128, nullptr, smg);
        else attn_tile<64, false, false>(Qd, Kd, Vd, L, Od, 512, qt * 128, nullptr, smg);
      }
      for (int c = bid2; c < 512; c += nb2) hyena_item(c, filt, zT, yT, nseq, L, smg);
    } else {
      u16* zT = (u16*)(ws + O_ZT); u16* yT = (u16*)(ws + O_YT); u16* dO = (u16*)(ws + O_DIFFO);
      u16* yhy = (u16*)(ws + O_YHY); u16* ydf = (u16*)(ws + O_YDF);
      const float lam = misc[layer];
      const float lam_init = 0.8f - 0.6f * expf(-0.3f * (float)layer);
      const int ndp = TCH * 4 / 8, nhp = 256 * 8;
      for (int it = bid2; it < ndp + nhp; it += nb2) {
        if (it < ndp) diff_post_item(P, layer, lam, lam_init, dO, ydf, it);
        else { const int t = it - ndp; hyena_post_item(P, layer, pbuf, L, yT, zT, t % 8, t / 8, yhy, smg); }
      }
    }
    }
    GSYNC();
  }
  { PHASE_IDS(); KPARAMS(); (void)ws;
    for (int it = bid2; it < NTOK / 4; it += nb2) { const int row = it * 4 + w; norm_row_f32_inplace(P.out + (size_t)row * DM, P.final_norm, lane); }
  }
}

extern "C" void kernel_launch(void* const* d_in, const int* in_sizes, int n_in, void* d_out, int out_size, void* d_ws, size_t ws_size,
                              hipStream_t stream) {
  static int grid_blocks = 0;
  if (!grid_blocks) {
    int dev = 0, cus = 0, per_cu = 0;
    (void)hipGetDevice(&dev);
    (void)hipDeviceGetAttribute(&cus, hipDeviceAttributeMultiprocessorCount, dev);
    (void)hipFuncSetAttribute((const void*)fwd_megakernel, hipFuncAttributeMaxDynamicSharedMemorySize, SMEM_BYTES + 16);
    (void)hipOccupancyMaxActiveBlocksPerMultiprocessor(&per_cu, fwd_megakernel, 512, SMEM_BYTES + 16);
    if (per_cu < 1) per_cu = 1;
    if (per_cu > 1) per_cu = 1;
    grid_blocks = cus * per_cu;
  }
  Params p{};
  const float* const* in = (const float* const*)d_in;
  p.x_prompt = in[0]; p.x_sample = in[1]; p.ffn1_norm = in[2]; p.ffn1_w_in = in[3]; p.ffn1_w_out = in[4]; p.mix_norm = in[5]; p.w_in = in[6];
  p.hy_conv_w = in[7]; p.hy_conv_b = in[8]; p.hy_w1 = in[9]; p.hy_b1 = in[10]; p.hy_w2 = in[11]; p.hy_b2 = in[12]; p.hy_w3 = in[13];
  p.hy_freq = in[14]; p.hy_skip = in[15]; p.gqa_q_norm = in[16]; p.gqa_k_norm = in[17]; p.diff_lambda = in[18]; p.diff_subln = in[19];
  p.rel_bias = in[20]; p.w_branch = in[21]; p.w_out = in[22]; p.ffn2_norm = in[23]; p.ffn2_w_in = in[24]; p.ffn2_w_out = in[25]; p.final_norm = in[26];
  p.out = (float*)d_out; p.ws = (char*)d_ws;
  void* args[] = {&p};
  (void)hipMemsetAsync((char*)d_ws + O_BAR, 0, XCD_BAR_WORDS * 4, stream);
  hipError_t e = hipLaunchCooperativeKernel((void*)fwd_megakernel, dim3(grid_blocks), dim3(512), args, SMEM_BYTES + 16, stream);
  if (e != hipSuccess) fprintf(stderr, "cooperative launch failed: %s (grid %d)\n", hipGetErrorString(e), grid_blocks);
}
```

```cpp
#include <hip/hip_runtime.h>
#include <hip/hip_cooperative_groups.h>
#include <stdint.h>
#include <cstdio>
namespace cg = cooperative_groups;

typedef unsigned short u16;
typedef __attribute__((ext_vector_type(8))) short bf16x8;
typedef __attribute__((ext_vector_type(16))) float f32x16;
typedef __attribute__((ext_vector_type(4))) float f32x4;
typedef __attribute__((ext_vector_type(4))) unsigned u32x4;
typedef __attribute__((ext_vector_type(2))) unsigned u32x2;
typedef __attribute__((ext_vector_type(2))) __bf16 bf2_t;
typedef __attribute__((ext_vector_type(2))) float f2_t;
#define DI __device__ __forceinline__
#define MFMA(a, b, c) __builtin_amdgcn_mfma_f32_32x32x16_bf16((a), (b), (c), 0, 0, 0)

constexpr int DM = 1024, DFF = 2816, INC = 6912, TCH = 16384, NTOK = 49152;
constexpr int OFF_GQ = 1536, OFF_GK = 2048, OFF_GV = 2176, OFF_DQ = 2304, OFF_DK = 2816, OFF_DV = 3328, OFF_GATE = 3840;
constexpr float LOG2E = 1.4426950408889634f;

constexpr size_t SZ_F1IN = (size_t)5632 * 1024 * 2, SZ_F1OUT = (size_t)1024 * 2816 * 2, SZ_WIN = (size_t)6912 * 1024 * 2,
                 SZ_WBR = (size_t)3 * 1024 * 512 * 2, SZ_WOUT = (size_t)1024 * 1024 * 2;
constexpr size_t O_F1IN = 0, O_F1OUT = O_F1IN + SZ_F1IN, O_WIN = O_F1OUT + SZ_F1OUT, O_WBR = O_WIN + SZ_WIN, O_WOUT = O_WBR + SZ_WBR,
                 O_F2IN = O_WOUT + SZ_WOUT, O_F2OUT = O_F2IN + SZ_F1IN, O_FILT8 = O_F2OUT + SZ_F1OUT,
                 O_FILT16 = O_FILT8 + (size_t)512 * 16384 * 2, O_MISC = O_FILT16 + (size_t)512 * 32768 * 2,
                 O_P = O_MISC + 65536, O_HN = O_P + (size_t)TCH * INC * 2, O_ZT = O_HN + (size_t)TCH * 1024 * 2,
                 O_YT = O_ZT + (size_t)TCH * 512 * 2, O_DIFFO = O_YT + (size_t)TCH * 512 * 2, O_VTG = O_DIFFO + (size_t)TCH * 1024 * 2,
                 O_VTD = O_VTG + (size_t)TCH * 128 * 2, O_YHY = O_VTD + (size_t)TCH * 512 * 2, O_YGQ = O_YHY + (size_t)TCH * 512 * 2,
                 O_YDF = O_YGQ + (size_t)TCH * 512 * 2, O_END = O_YDF + (size_t)TCH * 512 * 2;
static_assert(O_END <= (size_t)536870912, "workspace overflow");
constexpr int SMEM_BYTES = 151552;
constexpr int GRP_LDS = 75776;
#define REPMASK 0
#define REP_SYNC 1
#define PHASE_IDS() const int t_ = otid(); const int bid = __builtin_amdgcn_readfirstlane(((volatile LAS unsigned*)&xb_words)[3]); const int lane = t_ & 63; const int grp = __builtin_amdgcn_readfirstlane(t_ >> 8); \
  const int w = __builtin_amdgcn_readfirstlane((t_ >> 6) & 3); const int bid2 = bid * 2 + grp; char* smg = smem + grp * GRP_LDS; \
  const int vb = (bid & 7) * (nb >> 3) + (bid >> 3); (void)lane; (void)w; (void)bid2; (void)smg; (void)vb
#define GSYNC() do { for (int rs_ = 0; rs_ < REP_SYNC; ++rs_) xcd_barrier(xb); } while (0)


#define XB_TMO      128
#define XB_XCNT(j)  (256  + 64 * (j))
#define XB_XSUB(j)  (1280 + 64 * (j))
#define XB_XGEN(j)  (2304 + 64 * (j))
#define XB_TOP      3328
#define XB_TOPGEN   3392
#define XCD_BAR_WORDS 3456
#define XB_SPIN_CAP (1u << 21)
#define LAS __attribute__((address_space(3)))
DI unsigned xb_ld(unsigned* p)              { return __hip_atomic_load(p, __ATOMIC_RELAXED, __HIP_MEMORY_SCOPE_AGENT); }
DI unsigned xb_add(unsigned* p, unsigned v) { return __hip_atomic_fetch_add(p, v, __ATOMIC_RELAXED, __HIP_MEMORY_SCOPE_AGENT); }
DI unsigned xb_xcc_id() { return (unsigned)__builtin_amdgcn_s_getreg((3 << 11) | 20) & 0xFu; }
#define XB_SPIN(cond, bar) do { unsigned _sp = 0; while (cond) { __builtin_amdgcn_s_sleep(1); \
    if ((++_sp & 255u) == 0u) { if (xb_ld(&(bar)[XB_TMO])) break; if (_sp > XB_SPIN_CAP) { atomicAdd(&(bar)[XB_TMO], 1u); break; } } } } while (0)
struct XcdBarrier { unsigned* bar; unsigned x; volatile LAS unsigned* st; };
DI XcdBarrier xcd_barrier_post(unsigned* bar, volatile LAS unsigned* st) {
  XcdBarrier b; b.bar = bar; b.x = xb_xcc_id(); b.st = st;
  if (threadIdx.x == 0) { const unsigned rank = xb_add(&bar[XB_XCNT(b.x)], 1u); st[2] = rank; }
  return b;
}
DI void xcd_barrier_complete(unsigned* bar, unsigned x, unsigned& nloc, unsigned& nx) {
  const unsigned G = gridDim.x * gridDim.y * gridDim.z;
  unsigned sum, cnt, mine, sp = 0u;
  for (;;) {
    sum = 0u; cnt = 0u; mine = 0u;
#pragma unroll
    for (unsigned j = 0; j < 16; ++j) { const unsigned c = xb_ld(&bar[XB_XCNT(j)]); sum += c; cnt += (c > 0u) ? 1u : 0u; mine = (j == x) ? c : mine; }
    if (sum == G) break;
    __builtin_amdgcn_s_sleep(1);
    if ((++sp & 255u) == 0u) { if (xb_ld(&bar[XB_TMO])) break; if (sp > XB_SPIN_CAP) { atomicAdd(&bar[XB_TMO], 1u); break; } }
  }
  nloc = mine > 0u ? mine : 1u; nx = cnt > 0u ? cnt : 1u;
}
DI void xcd_barrier(const XcdBarrier& b) {
  asm volatile("s_waitcnt vmcnt(0)" ::: "memory");
  __syncthreads();
  if (threadIdx.x == 0) {
    unsigned* bar = b.bar;
    __builtin_amdgcn_s_waitcnt(0);
    unsigned nloc = b.st[0], nx = b.st[1];
    if (nloc == 0u) { xcd_barrier_complete(bar, b.x, nloc, nx); b.st[0] = nloc; b.st[1] = nx; }
    const unsigned old = xb_add(&bar[XB_XSUB(b.x)], 1u);
    const unsigned gen = old / nloc;
    if (old + 1u == (gen + 1u) * nloc) {
      __builtin_amdgcn_fence(__ATOMIC_RELEASE, "agent");
      asm volatile("s_waitcnt vmcnt(0)" ::: "memory");
      const unsigned og = xb_add(&bar[XB_TOP], 1u);
      const unsigned tg = og / nx;
      if (og + 1u == (tg + 1u) * nx) xb_add(&bar[XB_TOPGEN], 1u);
      else XB_SPIN(xb_ld(&bar[XB_TOPGEN]) == tg, bar);
      __builtin_amdgcn_fence(__ATOMIC_ACQUIRE, "agent");
      xb_add(&bar[XB_XGEN(b.x)], 1u);
      asm volatile("s_waitcnt vmcnt(0)" ::: "memory");
    } else {
      XB_SPIN(xb_ld(&bar[XB_XGEN(b.x)]) == gen, bar);
      __builtin_amdgcn_fence(__ATOMIC_ACQUIRE, "agent");
      asm volatile("s_waitcnt vmcnt(0)" ::: "memory");
    }
  }
  __syncthreads();
}
constexpr size_t O_BAR = O_MISC + 16384;

struct Params {
  const float* x_prompt; const float* x_sample;
  const float* ffn1_norm; const float* ffn1_w_in; const float* ffn1_w_out; const float* mix_norm; const float* w_in;
  const float* hy_conv_w; const float* hy_conv_b; const float* hy_w1; const float* hy_b1; const float* hy_w2; const float* hy_b2;
  const float* hy_w3; const float* hy_freq; const float* hy_skip;
  const float* gqa_q_norm; const float* gqa_k_norm; const float* diff_lambda; const float* diff_subln; const float* rel_bias;
  const float* w_branch; const float* w_out; const float* ffn2_norm; const float* ffn2_w_in; const float* ffn2_w_out; const float* final_norm;
  float* out; char* ws;
};

DI unsigned pack2(float a, float b) { f2_t v = {a, b}; bf2_t r = __builtin_convertvector(v, bf2_t); return __builtin_bit_cast(unsigned, r); }
DI u16 f2bf(float a) { return (u16)(pack2(a, 0.f) & 0xffffu); }
DI float bf2f(u16 v) { return __uint_as_float(((unsigned)v) << 16); }
DI float bflo(unsigned v) { return __uint_as_float(v << 16); }
DI float bfhi(unsigned v) { return __uint_as_float(v & 0xffff0000u); }
DI int otid() { int t = threadIdx.x; asm volatile("" : "+v"(t)); return t; }
DI int crow(int reg, int h) { return (reg & 3) + 8 * (reg >> 2) + 4 * h; }
DI float wave_sum(float v) {
  v += __shfl_xor(v, 32); v += __shfl_xor(v, 16); v += __shfl_xor(v, 8); v += __shfl_xor(v, 4); v += __shfl_xor(v, 2); v += __shfl_xor(v, 1);
  return v;
}
DI float half_sum(float v) {
  v += __shfl_xor(v, 16); v += __shfl_xor(v, 8); v += __shfl_xor(v, 4); v += __shfl_xor(v, 2); v += __shfl_xor(v, 1);
  return v;
}

DI void convT_tile(const float* __restrict__ src, int K, int N, u16* __restrict__ dst, int kt, int nt, int perm_half, char* smem) {
  float* t = (float*)smem;
  const int tid = otid() & 255;
  __syncthreads();
  {
    const int col = tid & 63, r0 = tid >> 6;
#pragma unroll
    for (int i = 0; i < 16; ++i) { int row = r0 + 4 * i; t[row * 65 + col] = src[(size_t)(kt * 64 + row) * N + nt * 64 + col]; }
  }
  __syncthreads();
  {
    const int nl = tid >> 2, kq = tid & 3;
    int n = nt * 64 + nl;
    if (perm_half > 0) { if (n < perm_half) n = (n >> 7) * 256 + (n & 127); else { int j = n - perm_half; n = (j >> 7) * 256 + 128 + (j & 127); } }
    u32x4 o0, o1;
#pragma unroll
    for (int i = 0; i < 4; ++i) {
      o0[i] = pack2(t[(kq * 16 + 2 * i) * 65 + nl], t[(kq * 16 + 2 * i + 1) * 65 + nl]);
      o1[i] = pack2(t[(kq * 16 + 8 + 2 * i) * 65 + nl], t[(kq * 16 + 8 + 2 * i + 1) * 65 + nl]);
    }
    u16* d = dst + (size_t)n * K + kt * 64 + kq * 16;
    *(u32x4*)d = o0; *(u32x4*)(d + 8) = o1;
  }
}

DI void filter_item(const Params& P, int layer, int L, int tb, u16* __restrict__ G, char* smem) {
  float* h1 = (float*)smem;
  float* h2 = h1 + 64 * 65;
  const int tid = otid() & 255, lane = tid & 63, w = __builtin_amdgcn_readfirstlane(tid >> 6);
  const float* w1 = P.hy_w1 + layer * 33 * 64; const float* b1 = P.hy_b1 + layer * 64;
  const float* w2 = P.hy_w2 + layer * 64 * 64; const float* b2 = P.hy_b2 + layer * 64;
  const float* w3 = P.hy_w3 + layer * 64 * 1024; const float* fr = P.hy_freq + layer * 64;
  const int t = tb * 64 + lane;
  const float tl = (float)t / (float)(L - 1);
  __syncthreads();
  {
    float a[16];
#pragma unroll
    for (int u = 0; u < 16; ++u) a[u] = b1[w * 16 + u] + tl * w1[w * 16 + u];
    const float base = (float)(2.0 * 3.14159265358979323846 / (double)L) * (float)t;
    for (int b = 0; b < 16; ++b) {
      const float band = 1e-4f + (float)b * ((15.0f - 1e-4f) / 15.0f);
      const float ang = base * band;
      const float cs = cosf(ang), sn = -sinf(ang);
#pragma unroll
      for (int u = 0; u < 16; ++u) a[u] += cs * w1[(1 + b) * 64 + w * 16 + u] + sn * w1[(17 + b) * 64 + w * 16 + u];
    }
#pragma unroll
    for (int u = 0; u < 16; ++u) h1[lane * 65 + w * 16 + u] = sinf(fr[w * 16 + u] * a[u]);
  }
  __syncthreads();
  {
    float a[16];
#pragma unroll
    for (int u = 0; u < 16; ++u) a[u] = b2[w * 16 + u];
    for (int k = 0; k < 64; ++k) {
      const float hv = h1[lane * 65 + k];
#pragma unroll
      for (int u = 0; u < 16; ++u) a[u] += hv * w2[k * 64 + w * 16 + u];
    }
#pragma unroll
    for (int u = 0; u < 16; ++u) h2[lane * 65 + w * 16 + u] = sinf(fr[w * 16 + u] * a[u]);
  }
  __syncthreads();
  const float min_decay = -3.0701134573253946f, max_decay = -15.350567286626973f;
  for (int og = 0; og < 64; ++og) {
    const int o = w * 256 + og * 4;
    float a0 = 0.f, a1 = 0.f, a2 = 0.f, a3 = 0.f;
#pragma unroll 4
    for (int k = 0; k < 64; ++k) {
      const float hv = h2[lane * 65 + k];
      const f32x4 wv = *(const f32x4*)(w3 + k * 1024 + o);
      a0 += hv * wv[0]; a1 += hv * wv[1]; a2 += hv * wv[2]; a3 += hv * wv[3];
    }
    float av[4] = {a0, a1, a2, a3};
#pragma unroll
    for (int q = 0; q < 4; ++q) {
      const int oo = o + q; const int ch = oo & 511;
      const float delta = min_decay + (float)ch * ((max_decay - min_decay) / 511.0f);
      const float val = av[q] * expf(-tl * fabsf(delta));
      u16* Gc = G + (size_t)ch * (2 * L);
      if (oo < 512) Gc[L - t] = f2bf(val);
      else { if (t >= 1) Gc[L + t] = f2bf(val); else Gc[0] = 0; }
    }
  }
}

DI void norm_row_bf16(const float* __restrict__ x, const float* __restrict__ g, u16* __restrict__ out, int lane) {
  f32x4 v[4]; float ss = 0.f;
#pragma unroll
  for (int i = 0; i < 4; ++i) { v[i] = *(const f32x4*)(x + lane * 4 + 256 * i); ss += v[i][0] * v[i][0] + v[i][1] * v[i][1] + v[i][2] * v[i][2] + v[i][3] * v[i][3]; }
  ss = wave_sum(ss);
  const float rs = rsqrtf(ss * (1.0f / 1024.0f) + 1e-6f);
#pragma unroll
  for (int i = 0; i < 4; ++i) {
    const f32x4 gg = *(const f32x4*)(g + lane * 4 + 256 * i);
    u32x2 o; o[0] = pack2(v[i][0] * rs * gg[0], v[i][1] * rs * gg[1]); o[1] = pack2(v[i][2] * rs * gg[2], v[i][3] * rs * gg[3]);
    *(u32x2*)(out + lane * 4 + 256 * i) = o;
  }
}
DI void norm_row_f32_inplace(float* __restrict__ x, const float* __restrict__ g, int lane) {
  f32x4 v[4]; float ss = 0.f;
#pragma unroll
  for (int i = 0; i < 4; ++i) { v[i] = *(const f32x4*)(x + lane * 4 + 256 * i); ss += v[i][0] * v[i][0] + v[i][1] * v[i][1] + v[i][2] * v[i][2] + v[i][3] * v[i][3]; }
  ss = wave_sum(ss);
  const float rs = rsqrtf(ss * (1.0f / 1024.0f) + 1e-6f);
#pragma unroll
  for (int i = 0; i < 4; ++i) {
    const f32x4 gg = *(const f32x4*)(g + lane * 4 + 256 * i);
    f32x4 o; o[0] = v[i][0] * rs * gg[0]; o[1] = v[i][1] * rs * gg[1]; o[2] = v[i][2] * rs * gg[2]; o[3] = v[i][3] * rs * gg[3];
    *(f32x4*)(x + lane * 4 + 256 * i) = o;
  }
}

namespace pg8 {
#define PG8_LAS __attribute__((address_space(3)))
typedef unsigned short bf16_t;
typedef short bf16x8 __attribute__((ext_vector_type(8)));
typedef float f32x4 __attribute__((ext_vector_type(4)));
typedef unsigned u32x4 __attribute__((ext_vector_type(4)));
constexpr int BM = 256, BK = 64, HALF = 128, HTB = HALF * BK * 2  , STAGE_BYTES = 8 * HTB, NXCD = 8, WGM = 8;

__host__ __device__ __forceinline__ int lds_byte(int r, int c) { const int st = (r >> 4) * 2 + (c >> 5), rr = r & 15, cc = c & 31, ob = rr * 64 + cc * 2; return st * 1024 + (ob ^ (((ob >> 9) & 1) << 5)); }
__host__ __device__ __forceinline__ void stage_rc(int b, int& R, int& C) { const int st = b / 1024, sb = b % 1024, swz = sb ^ (((sb >> 9) & 1) << 5); R = (st >> 1) * 16 + swz / 64; C = (st & 1) * 32 + (swz % 64) / 2; }
__host__ __device__ __forceinline__ int perm32(int rho) { const int n = rho >> 4, i = rho & 15; return 8 * (i >> 2) + 4 * n + (i & 3); }

struct Unit { int pm, pn; };
struct Gemm { const bf16_t* A; const bf16_t* Bt; int M, N, K; };

struct StaticOrder {
    int nM, nN, nwg, G, c;
    __host__ __device__ void init(int M, int N, int G_, int c_) { nM = M / BM; nN = N / BM; nwg = nM * nN; G = G_; c = c_; }
    __host__ __device__ bool next(int i, Unit& u) const {
        const long L = (long)i * G + c; if (L >= nwg) return false;
        int wgid = (int)L; { const int q = nwg / NXCD, r = nwg % NXCD, xcd = wgid % NXCD, off = wgid / NXCD; wgid = (xcd < r ? xcd * (q + 1) : r * (q + 1) + (xcd - r) * q) + off; }
        const int nig = WGM * nN, gid = wgid / nig, fm = gid * WGM, gsz = (nM - fm) < WGM ? (nM - fm) : WGM;
        u.pm = fm + ((wgid % nig) % gsz); u.pn = (wgid % nig) / gsz; return true;
    }
    __device__ __forceinline__ void a_ready(const Unit&) const {}
    __device__ __forceinline__ void done(const Unit&) const {}
};

template <class Epi, class Sched, bool STAMP = false>
__device__ __forceinline__ void gemm_phase(PG8_LAS unsigned char* lds, const Gemm g, const Sched& S, const Epi& E, unsigned long long* stamps) {
    const int tid = otid(), wid = __builtin_amdgcn_readfirstlane(tid >> 6), lane = tid & 63, wr = wid >> 2, wc = wid & 3, fr = lane & 15, fq = lane >> 4;
    const int K = g.K, nt = K / BK;
    int ts_lo = 0, ts_hi = 0, nts = 0; const unsigned long long rt_entry = STAMP ? (unsigned long long)wall_clock64() : 0ull;
#define PG8_STAMP() do { if (STAMP && wid == 0 && nts < 64) { const unsigned long long _c = (unsigned long long)clock64(); \
        ts_lo = (lane == nts) ? (int)(unsigned)_c : ts_lo; ts_hi = (lane == nts) ? (int)(unsigned)(_c >> 32) : ts_hi; ++nts; } } while (0)
    PG8_STAMP();
    unsigned voffA[2], voffB[2];
#pragma unroll
    for (int i = 0; i < 2; ++i) { int R, C; stage_rc(tid * 16 + i * 8192, R, C); const int Rb = E.perm ? ((R & ~31) + perm32(R & 31)) : R;
        voffA[i] = (unsigned)(R * K + C) * 2u; voffB[i] = (unsigned)(Rb * K + C) * 2u; }
    const size_t kstep = (size_t)(BK * 2);
    const size_t hstep = (size_t)HALF * K * 2;
    const size_t tstep = 2 * hstep;
    const unsigned ldsw = (unsigned)wid * 1024u;
    const int aoff = lds_byte(wr * 64 + fr, fq * 8), boff = lds_byte(wc * 32 + fr, fq * 8);
#define PG8_SA(b, h) (((b) * 2 + (h)) * HTB)
#define PG8_SB(b, h) ((4 + (b) * 2 + (h)) * HTB)
#define PG8_STAGE(bufoff, gbase, voff) do { _Pragma("unroll") for (int _i = 0; _i < 2; ++_i) \
        __builtin_amdgcn_global_load_lds((const unsigned*)((const char*)(gbase) + (voff)[_i]), (PG8_LAS unsigned*)(lds + (bufoff) + ldsw + _i * 8192), 16, 0, 0); } while (0)
#define PG8_LDA(dst, b, h) do { _Pragma("unroll") for (int m = 0; m < 4; ++m) _Pragma("unroll") for (int k = 0; k < 2; ++k) dst[m][k] = *(const PG8_LAS bf16x8*)(lds + PG8_SA(b, h) + aoff + m * 2048 + k * 1024); } while (0)
#define PG8_LDB(dst, b, h) do { _Pragma("unroll") for (int n = 0; n < 2; ++n) _Pragma("unroll") for (int k = 0; k < 2; ++k) dst[n][k] = *(const PG8_LAS bf16x8*)(lds + PG8_SB(b, h) + boff + n * 2048 + k * 1024); } while (0)
#define PG8_MMA(ai, bj, At, Bt) do { __builtin_amdgcn_s_setprio(1); _Pragma("unroll") for (int m = 0; m < 4; ++m) _Pragma("unroll") for (int n = 0; n < 2; ++n) _Pragma("unroll") for (int k = 0; k < 2; ++k) \
        acc[ai][bj][m][n] = __builtin_amdgcn_mfma_f32_16x16x32_bf16(Bt[n][k], At[m][k], acc[ai][bj][m][n], 0, 0, 0); __builtin_amdgcn_s_setprio(0); } while (0)
#define PG8_WAIT_V(n) asm volatile("s_waitcnt vmcnt(" #n ")" ::: "memory")
#define PG8_WAIT_L(n) asm volatile("s_waitcnt lgkmcnt(" #n ")" ::: "memory")
#define PG8_BAR __builtin_amdgcn_s_barrier()
#define PG8_SCHED __builtin_amdgcn_sched_barrier(0)
    Unit cur, nxt; int ui = 0;
    if (!S.next(0, cur)) return;
    f32x4 acc[2][2][4][2];
#pragma unroll
    for (int a = 0; a < 2; ++a)
#pragma unroll
        for (int b = 0; b < 2; ++b)
#pragma unroll
            for (int m = 0; m < 4; ++m)
#pragma unroll
                for (int n = 0; n < 2; ++n) acc[a][b][m][n] = (f32x4){0.f, 0.f, 0.f, 0.f};
    bf16x8 At[4][2], B0[2][2], B1[2][2];
    const char* cA = (const char*)g.A + (size_t)cur.pm * tstep; const char* cB = (const char*)g.Bt + (size_t)cur.pn * tstep;
    S.a_ready(cur);
    PG8_STAGE(PG8_SB(0, 0), cB, voffB); PG8_STAGE(PG8_SA(0, 0), cA, voffA); PG8_STAGE(PG8_SB(0, 1), cB + hstep, voffB); PG8_STAGE(PG8_SA(0, 1), cA + hstep, voffA);
    if (wr == 1) PG8_BAR;
    PG8_WAIT_V(4); PG8_BAR;
    PG8_STAGE(PG8_SB(1, 0), cB + kstep, voffB); PG8_STAGE(PG8_SA(1, 0), cA + kstep, voffA); PG8_STAGE(PG8_SB(1, 1), cB + hstep + kstep, voffB);
    PG8_WAIT_V(6); PG8_BAR;
    PG8_STAMP();
    for (;;) {
        const bool has_next = S.next(ui + 1, nxt);
        const char* nA = has_next ? (const char*)g.A + (size_t)nxt.pm * tstep : cA; const char* nB = has_next ? (const char*)g.Bt + (size_t)nxt.pn * tstep : cB;
        for (int t = 0; t < nt; t += 2) {
            const bool last = (t == nt - 2);
            const char* a1 = cA + (size_t)(t + 1) * kstep;
            const char* a2 = last ? nA : cA + (size_t)(t + 2) * kstep; const char* b2 = last ? nB : cB + (size_t)(t + 2) * kstep;
            const char* a3 = a2 + kstep; const char* b3 = b2 + kstep;
            if (last && has_next) S.a_ready(nxt);
            PG8_LDB(B0, 0, 0); PG8_SCHED; PG8_LDA(At, 0, 0); PG8_STAGE(PG8_SA(1, 1), a1 + hstep, voffA);
            PG8_WAIT_L(8); PG8_BAR; PG8_WAIT_L(0); PG8_MMA(0, 0, At, B0); PG8_BAR; PG8_SCHED;
            PG8_LDB(B1, 0, 1); PG8_STAGE(PG8_SB(0, 0), b2, voffB);
            PG8_BAR; PG8_WAIT_L(0); PG8_MMA(0, 1, At, B1); PG8_BAR;
            PG8_LDA(At, 0, 1); PG8_STAGE(PG8_SA(0, 0), a2, voffA);
            PG8_BAR; PG8_WAIT_L(0); PG8_MMA(1, 0, At, B0); PG8_BAR; PG8_SCHED;
            PG8_STAGE(PG8_SB(0, 1), b2 + hstep, voffB);
            PG8_WAIT_V(6); PG8_BAR; PG8_MMA(1, 1, At, B1); PG8_BAR;
            PG8_LDB(B0, 1, 0); PG8_SCHED; PG8_LDA(At, 1, 0); PG8_STAGE(PG8_SA(0, 1), a2 + hstep, voffA);
            PG8_WAIT_L(8); PG8_BAR; PG8_WAIT_L(0); PG8_MMA(0, 0, At, B0); PG8_BAR; PG8_SCHED;
            PG8_LDB(B1, 1, 1); PG8_STAGE(PG8_SB(1, 0), b3, voffB);
            PG8_BAR; PG8_WAIT_L(0); PG8_MMA(0, 1, At, B1); PG8_BAR;
            PG8_LDA(At, 1, 1); PG8_STAGE(PG8_SA(1, 0), a3, voffA);
            PG8_BAR; PG8_WAIT_L(0); PG8_MMA(1, 0, At, B0); PG8_BAR; PG8_SCHED;
            PG8_STAGE(PG8_SB(1, 1), b3 + hstep, voffB);
            PG8_WAIT_V(6); PG8_BAR; PG8_MMA(1, 1, At, B1); PG8_BAR;
        }
        PG8_STAMP();
        if constexpr (!Epi::AFTER_DRAIN) { E(acc, cur, wr, wc, fr, fq); S.done(cur); }
        PG8_STAMP();
        if (!has_next) break;
#pragma unroll
        for (int a = 0; a < 2; ++a)
#pragma unroll
            for (int b = 0; b < 2; ++b)
#pragma unroll
                for (int m = 0; m < 4; ++m)
#pragma unroll
                    for (int n = 0; n < 2; ++n) acc[a][b][m][n] = (f32x4){0.f, 0.f, 0.f, 0.f};
        cur = nxt; cA = nA; cB = nB; ++ui;
    }
    PG8_WAIT_V(0);
    if (wr == 0) PG8_BAR;
    PG8_BAR;
    if constexpr (Epi::AFTER_DRAIN) { E.fused(acc, cur, wr, wc, fr, fq, lds, wid, lane); S.done(cur); }
    PG8_STAMP();
    if (STAMP && wid == 0) { stamps[lane] = lane < nts ? (((unsigned long long)(unsigned)ts_hi << 32) | (unsigned)ts_lo) : 0ull;
        if (lane == 62) stamps[62] = rt_entry; if (lane == 63) stamps[63] = (unsigned long long)wall_clock64(); }
#undef PG8_STAMP
#undef PG8_SA
#undef PG8_SB
#undef PG8_STAGE
#undef PG8_LDA
#undef PG8_LDB
#undef PG8_MMA
#undef PG8_WAIT_V
#undef PG8_WAIT_L
#undef PG8_BAR
#undef PG8_SCHED
}
}

enum { EPI_SWIGLU = 0, EPI_RESID = 1, EPI_PROJ = 2, EPI_MERGE = 3 };
struct EpiAny {
  static constexpr bool AFTER_DRAIN = false;
  int mode; bool perm;
  u16* O; int ldo; const float* xin; float* xout; float scale; const u16* gate; float* macc; int br;
  DI void operator()(const pg8::f32x4 (&acc)[2][2][4][2], const pg8::Unit& u, int wr, int wc, int fr, int fq) const {
    const int row0 = u.pm * 256 + wr * 64 + fr;
    if (mode == EPI_SWIGLU) {
      const int col0 = u.pn * 128 + wc * 32 + 8 * fq;
#pragma unroll
      for (int ai = 0; ai < 2; ++ai)
#pragma unroll
        for (int m = 0; m < 4; ++m) {
          float v[8];
#pragma unroll
          for (int n = 0; n < 2; ++n)
#pragma unroll
            for (int e = 0; e < 4; ++e) { const float gv = acc[ai][0][m][n][e], uv = acc[ai][1][m][n][e]; v[4 * n + e] = gv * __builtin_amdgcn_rcpf(1.0f + __builtin_amdgcn_exp2f(-LOG2E * gv)) * uv; }
          u32x4 o; o[0] = pack2(v[0], v[1]); o[1] = pack2(v[2], v[3]); o[2] = pack2(v[4], v[5]); o[3] = pack2(v[6], v[7]);
          *(u32x4*)(O + (size_t)(row0 + ai * 128 + m * 16) * ldo + col0) = o;
        }
    } else if (mode == EPI_PROJ) {
      const int col0 = u.pn * 256 + wc * 32 + 8 * fq;
      const bool sg = (u.pn * 256 >= OFF_GATE);
#pragma unroll
      for (int ai = 0; ai < 2; ++ai)
#pragma unroll
        for (int m = 0; m < 4; ++m)
#pragma unroll
          for (int bj = 0; bj < 2; ++bj) {
            float v[8];
#pragma unroll
            for (int n = 0; n < 2; ++n)
#pragma unroll
              for (int e = 0; e < 4; ++e) { float t = acc[ai][bj][m][n][e]; if (sg) t = __builtin_amdgcn_rcpf(1.0f + __builtin_amdgcn_exp2f(-LOG2E * t)); v[4 * n + e] = t; }
            u32x4 o; o[0] = pack2(v[0], v[1]); o[1] = pack2(v[2], v[3]); o[2] = pack2(v[4], v[5]); o[3] = pack2(v[6], v[7]);
            *(u32x4*)(O + (size_t)(row0 + ai * 128 + m * 16) * INC + col0 + bj * 128) = o;
          }
    } else if (mode == EPI_RESID) {
      const int col0 = u.pn * 256 + wc * 32 + 4 * fq;
#pragma unroll
      for (int ai = 0; ai < 2; ++ai)
#pragma unroll
        for (int m = 0; m < 4; ++m)
#pragma unroll
          for (int bj = 0; bj < 2; ++bj)
#pragma unroll
            for (int n = 0; n < 2; ++n) {
              const size_t idx = (size_t)(row0 + ai * 128 + m * 16) * DM + col0 + bj * 128 + n * 16;
              f32x4 xv = *(const f32x4*)(xin + idx);
#pragma unroll
              for (int e = 0; e < 4; ++e) xv[e] += scale * acc[ai][bj][m][n][e];
              *(f32x4*)(xout + idx) = xv;
            }
    } else {
      const int col0 = u.pn * 256 + wc * 32 + 4 * fq;
#pragma unroll
      for (int ai = 0; ai < 2; ++ai)
#pragma unroll
        for (int m = 0; m < 4; ++m)
#pragma unroll
          for (int bj = 0; bj < 2; ++bj)
#pragma unroll
            for (int n = 0; n < 2; ++n) {
              const int row = row0 + ai * 128 + m * 16, col = col0 + bj * 128 + n * 16;
              const u32x2 gt = *(const u32x2*)(gate + (size_t)row * INC + OFF_GATE + br * DM + col);
              f32x4 v;
              v[0] = bflo(gt[0]) * acc[ai][bj][m][n][0]; v[1] = bfhi(gt[0]) * acc[ai][bj][m][n][1];
              v[2] = bflo(gt[1]) * acc[ai][bj][m][n][2]; v[3] = bfhi(gt[1]) * acc[ai][bj][m][n][3];
              const size_t idx = (size_t)row * DM + col;
              if (br > 0) { const f32x4 pv = *(const f32x4*)(macc + idx); v[0] += pv[0]; v[1] += pv[1]; v[2] += pv[2]; v[3] += pv[3]; }
              if (br < 2) *(f32x4*)(macc + idx) = v;
              else { u32x2 o; o[0] = pack2(v[0], v[1]); o[1] = pack2(v[2], v[3]); *(u32x2*)(outb_() + idx) = o; }
            }
    }
  }
  DI u16* outb_() const { return O; }
};

DI void qk_prep_item(const Params& P, int layer, u16* __restrict__ p, int L, int it) {
  const int tid = otid() & 255, lane = tid & 63, w = __builtin_amdgcn_readfirstlane(tid >> 6);
  const int u = it * 8 + w * 2 + (lane >> 5);
  const int tok = u / 10, hd = u - tok * 10;
  const int i = lane & 31;
  const int col0 = (hd < 8) ? (OFF_GQ + hd * 64) : (OFF_GK + (hd - 8) * 64);
  const float* gn = (hd < 8) ? (P.gqa_q_norm + layer * 64) : (P.gqa_k_norm + layer * 64);
  unsigned* ptr = (unsigned*)(p + (size_t)tok * INC + col0) + i;
  const unsigned v = *ptr;
  float a = bflo(v), b = bfhi(v);
  const float ss = half_sum(a * a + b * b);
  const float rs = rsqrtf(ss * (1.0f / 64.0f) + 1e-6f);
  a = a * rs * gn[2 * i]; b = b * rs * gn[2 * i + 1];
  const int tl = tok % L;
  const float pos = (i < 16) ? (float)(tl >> 6) : (float)(tl & 63);
  const int jj = i & 15;
  const float inv = powf(10000.0f, -(float)(2 * jj) / 32.0f);
  const float ang = pos * inv;
  const float c = cosf(ang), s = sinf(ang);
  *ptr = pack2(a * c - b * s, a * s + b * c);
}

DI void transpose_item(const Params& P, int layer, const u16* __restrict__ p, int L, int kind, int ct, int tt, u16* __restrict__ dst, char* smem) {
  u16* tile = (u16*)smem;
  const int tid = otid() & 255;
  const int t0 = tt * 64;
  const int seq = t0 / L, tl0 = t0 - seq * L;
  const int C = (kind == 0) ? 128 : 512;
  __syncthreads();
  {
    const int col = tid & 63, r0 = tid >> 6;
    const int cidx = ct * 64 + col;
    if (kind < 2) {
      const int off = (kind == 0 ? OFF_GV : OFF_DV) + cidx;
#pragma unroll
      for (int i = 0; i < 16; ++i) { const int row = r0 + 4 * i; tile[col * 72 + row] = p[(size_t)(t0 + row) * INC + off]; }
    } else {
      const float* cw = P.hy_conv_w + layer * 3 * 1536; const float* cb = P.hy_conv_b + layer * 1536;
      const int c1 = 512 + cidx, c2 = 1024 + cidx;
      const float w10 = cw[c1], w11 = cw[1536 + c1], w12 = cw[3072 + c1], b1 = cb[c1];
      const float w20 = cw[c2], w21 = cw[1536 + c2], w22 = cw[3072 + c2], b2 = cb[c2];
#pragma unroll
      for (int i = 0; i < 16; ++i) {
        const int row = r0 + 4 * i; const int tl = tl0 + row;
        const u16* pr = p + (size_t)(t0 + row) * INC;
        const float xm1 = (tl > 0) ? bf2f(pr[c1 - INC]) : 0.f, x0 = bf2f(pr[c1]), xp1 = (tl < L - 1) ? bf2f(pr[c1 + INC]) : 0.f;
        const float vm1 = (tl > 0) ? bf2f(pr[c2 - INC]) : 0.f, v0 = bf2f(pr[c2]), vp1 = (tl < L - 1) ? bf2f(pr[c2 + INC]) : 0.f;
        const float x1c = xm1 * w10 + x0 * w11 + xp1 * w12 + b1;
        const float vc = vm1 * w20 + v0 * w21 + vp1 * w22 + b2;
        tile[col * 72 + row] = f2bf(vc * x1c);
      }
    }
  }
  __syncthreads();
  {
    const int c = tid >> 2, q = tid & 3;
    const u32x4 a = *(const u32x4*)(tile + c * 72 + q * 16), b = *(const u32x4*)(tile + c * 72 + q * 16 + 8);
    u16* d = dst + ((size_t)seq * C + ct * 64 + c) * L + tl0 + q * 16;
    *(u32x4*)d = a; *(u32x4*)(d + 8) = b;
  }
}

DI int kperm(int rho) { return (rho & ~0xC) | ((rho & 4) << 1) | ((rho & 8) >> 1); }
template <int DV, bool BIAS, bool SWAP>
DI void attn_tile(const u16* __restrict__ Qp, const u16* __restrict__ Kp, const u16* __restrict__ VTp, int L,
                  u16* __restrict__ Op, int ldo, int q0, const float* __restrict__ btab, char* smem) {
  constexpr int NDT = DV / 32;
  constexpr int VCH = DV / 32;
  constexpr int KS_SZ = 64 * 64, VS_SZ = DV * 64;
  constexpr int NL = 2 + VCH;
  constexpr int KLEAD = SWAP ? 3 : 2;
  u16* Ks = (u16*)smem;
  u16* Vs = Ks + 3 * KS_SZ;
  float* bt = (float*)(Vs + 3 * VS_SZ);
  const int tid = otid() & 255, lane = tid & 63, w = __builtin_amdgcn_readfirstlane(tid >> 6), r = lane & 31, h = lane >> 5;
  const float sc = 0.125f * LOG2E;
  __syncthreads();
  if (BIAS) { for (int i = tid; i < 257; i += 256) bt[i] = btab[i]; }
  bf16x8 qf[4];
  {
    const u16* qrow = Qp + (size_t)(q0 + 32 * w + r) * INC + 8 * h;
#pragma unroll
    for (int s = 0; s < 4; ++s) qf[s] = *(const bf16x8*)(qrow + 16 * s);
  }
  const int qpos = q0 + 32 * w + r;
  f32x16 O[NDT];
#pragma unroll
  for (int d = 0; d < NDT; ++d)
#pragma unroll
    for (int q = 0; q < 16; ++q) O[d][q] = 0.f;
  float m = -INFINITY, l = 0.f;
  const int lrow = tid >> 3, lsw = (tid & 7) ^ ((tid >> 4) & 7);
  const u16* Kg0 = Kp + (size_t)kperm(lrow) * INC + lsw * 8;
  const u16* Vg = VTp + (size_t)lrow * L + lsw * 8;
  const int ksw = (r >> 1) & 7;
  const int nkb = L >> 6;
#define ATT_LOADK(tile, bufp) do { const int t__ = ((tile) < nkb) ? (tile) : nkb - 1; _Pragma("unroll") for (int i_ = 0; i_ < 2; ++i_) \
    __builtin_amdgcn_global_load_lds((const unsigned*)(Kg0 + ((size_t)t__ * 64 + 32 * i_) * INC), (unsigned*)((char*)(bufp) + tid * 16 + i_ * 4096), 16, 0, 0); } while (0)
#define ATT_LOADV(tile, bufp) do { const int t__ = ((tile) < nkb) ? (tile) : nkb - 1; _Pragma("unroll") for (int i_ = 0; i_ < VCH; ++i_) \
    __builtin_amdgcn_global_load_lds((const unsigned*)(Vg + (size_t)(32 * i_) * L + (size_t)t__ * 64), (unsigned*)((char*)(bufp) + tid * 16 + i_ * 4096), 16, 0, 0); } while (0)
  f32x16 Sc[2];
  auto qk = [&](const u16* Kb) __attribute__((always_inline)) {
    bf16x8 kf[2][4];
#pragma unroll
    for (int kt = 0; kt < 2; ++kt)
#pragma unroll
      for (int s = 0; s < 4; ++s) kf[kt][s] = *(const bf16x8*)(Kb + (32 * kt + r) * 64 + (((2 * s + h) ^ ksw) << 3));
#pragma unroll
    for (int kt = 0; kt < 2; ++kt) {
#pragma unroll
      for (int q = 0; q < 16; ++q) Sc[kt][q] = 0.f;
#pragma unroll
      for (int s = 0; s < 4; ++s) Sc[kt] = MFMA(kf[kt][s], qf[s], Sc[kt]);
    }
    __builtin_amdgcn_sched_group_barrier(0x100, 8, 0);
    __builtin_amdgcn_sched_group_barrier(0x008, 8, 0);
  };
  bf16x8 pf[2][2];
  auto softmax = [&](int kb) __attribute__((always_inline)) {
    if (BIAS) {
      const int kmin = kb * 64;
      if (kmin - (q0 + 127) >= 128 || q0 - (kmin + 63) >= 128) {
        const float cb = (kmin > q0) ? bt[256] : bt[0];
#pragma unroll
        for (int kt = 0; kt < 2; ++kt)
#pragma unroll
          for (int q = 0; q < 16; ++q) Sc[kt][q] = Sc[kt][q] * sc + cb;
      } else {
#pragma unroll
        for (int kt = 0; kt < 2; ++kt)
#pragma unroll
          for (int q = 0; q < 16; ++q) {
            int rel = kmin + 32 * kt + kperm(crow(q, h)) - qpos;
            rel = rel < -128 ? -128 : (rel > 128 ? 128 : rel);
            Sc[kt][q] = Sc[kt][q] * sc + bt[rel + 128];
          }
      }
    }
    float mx = Sc[0][0];
#pragma unroll
    for (int kt = 0; kt < 2; ++kt)
#pragma unroll
      for (int q = 0; q < 16; ++q) mx = fmaxf(mx, Sc[kt][q]);
    mx = fmaxf(mx, __shfl_xor(mx, 32));
    if (!BIAS) mx *= sc;
    if (__any(mx > m + 6.0f)) {
      const float mn = fmaxf(m, mx);
      const float alpha = __builtin_amdgcn_exp2f(m - mn);
      m = mn; l *= alpha;
#pragma unroll
      for (int d = 0; d < NDT; ++d)
#pragma unroll
        for (int q = 0; q < 16; ++q) O[d][q] *= alpha;
    }
    const float nm = -m;
#pragma unroll
    for (int kt = 0; kt < 2; ++kt) {
#pragma unroll
      for (int q = 0; q < 16; ++q) {
        const float pv = BIAS ? __builtin_amdgcn_exp2f(Sc[kt][q] + nm) : __builtin_amdgcn_exp2f(__builtin_fmaf(Sc[kt][q], sc, nm));
        Sc[kt][q] = pv; l += pv;
      }
#pragma unroll
      for (int s = 0; s < 2; ++s) {
        u32x4 pk;
#pragma unroll
        for (int q = 0; q < 4; ++q) pk[q] = pack2(Sc[kt][8 * s + 2 * q], Sc[kt][8 * s + 2 * q + 1]);
        pf[kt][s] = __builtin_bit_cast(bf16x8, pk);
      }
    }
  };
  auto pv = [&](const u16* Vb) __attribute__((always_inline)) {
    bf16x8 vf[4][NDT];
#pragma unroll
    for (int ks = 0; ks < 4; ++ks)
#pragma unroll
      for (int d = 0; d < NDT; ++d) vf[ks][d] = *(const bf16x8*)(Vb + (32 * d + r) * 64 + (((2 * ks + h) ^ ksw) << 3));
#pragma unroll
    for (int ks = 0; ks < 4; ++ks)
#pragma unroll
      for (int d = 0; d < NDT; ++d) O[d] = MFMA(vf[ks][d], pf[ks >> 1][ks & 1], O[d]);
    __builtin_amdgcn_sched_group_barrier(0x100, 2 * NDT, 0);
    __builtin_amdgcn_sched_group_barrier(0x008, NDT, 0);
    __builtin_amdgcn_sched_group_barrier(0x100, NDT, 0);
    __builtin_amdgcn_sched_group_barrier(0x008, NDT, 0);
    __builtin_amdgcn_sched_group_barrier(0x100, NDT, 0);
    __builtin_amdgcn_sched_group_barrier(0x008, 2 * NDT, 0);
  };
  ATT_LOADK(0, Ks); ATT_LOADK(1, Ks + KS_SZ); if (SWAP) ATT_LOADK(2, Ks + 2 * KS_SZ);
  ATT_LOADV(0, Vs); ATT_LOADV(1, Vs + VS_SZ);
  asm volatile("s_waitcnt vmcnt(0) lgkmcnt(0)\n\ts_barrier" ::: "memory");
  if (SWAP) qk(Ks);
  int r0 = 0, r1 = 1, r2 = 2;
  for (int kb = 0; kb < nkb; ++kb) {
    ATT_LOADK(kb + KLEAD, Ks + (SWAP ? r0 : r2) * KS_SZ);
    ATT_LOADV(kb + 2, Vs + r2 * VS_SZ);
    if (!SWAP) qk(Ks + r0 * KS_SZ);
    softmax(kb);
    pv(Vs + r0 * VS_SZ);
    if (SWAP) qk(Ks + r1 * KS_SZ);
    asm volatile("s_waitcnt vmcnt(%0) lgkmcnt(0)\n\ts_barrier" :: "n"(NL) : "memory");
    { const int tmp = r0; r0 = r1; r1 = r2; r2 = tmp; }
  }
  asm volatile("s_waitcnt vmcnt(0)" ::: "memory");
#undef ATT_LOADK
#undef ATT_LOADV
  l += __shfl_xor(l, 32);
  const float inv = __builtin_amdgcn_rcpf(l);
  int ldo2 = ldo; asm volatile("" : "+s"(ldo2));
  u16* orow = Op + (size_t)qpos * ldo2;
#pragma unroll
  for (int d = 0; d < NDT; ++d)
#pragma unroll
    for (int g4 = 0; g4 < 4; ++g4) {
      u32x2 o; o[0] = pack2(O[d][4 * g4] * inv, O[d][4 * g4 + 1] * inv); o[1] = pack2(O[d][4 * g4 + 2] * inv, O[d][4 * g4 + 3] * inv);
      *(u32x2*)(orow + 32 * d + 8 * g4 + 4 * h) = o;
    }
}

DI void hyena_item(int c, const u16* __restrict__ G, const u16* __restrict__ zT, u16* __restrict__ yT, int nseq, int L, char* smem) {
  u16* zs = (u16*)smem;
  u16* fw = zs + 20480;
  const int tid = otid() & 255, lane = tid & 63, w = __builtin_amdgcn_readfirstlane(tid >> 6), r = lane & 31, h = lane >> 5;
  const int ZL = L + 2048;
  __syncthreads();
  for (int q = 0; q < nseq; ++q) {
    const u16* src = zT + ((size_t)q * 512 + c) * L;
    u16* dst = zs + q * ZL;
    const u32x4 zero = {0u, 0u, 0u, 0u};
    for (int i = tid; i < 128; i += 256) { *(u32x4*)(dst + i * 8) = zero; *(u32x4*)(dst + 1024 + L + i * 8) = zero; }
    for (int i = tid; i < (L >> 3); i += 256) *(u32x4*)(dst + 1024 + i * 8) = *(const u32x4*)(src + i * 8);
  }
  int tq[4], tJ[4];
#pragma unroll
  for (int i = 0; i < 4; ++i) { if (nseq == 2) { tq[i] = i & 1; tJ[i] = 2 * w + (i >> 1); } else { tq[i] = 0; tJ[i] = 4 * w + i; } }
  f32x16 acc[4];
#pragma unroll
  for (int i = 0; i < 4; ++i)
#pragma unroll
    for (int q = 0; q < 16; ++q) acc[i][q] = 0.f;
  const int E0 = -L + 16, ELAST = L - 32;
  const int npass = (2 * L - 32 + 8191) / 8192;
  const u16* Gc = G + (size_t)c * (2 * L);
  for (int ps = 0; ps < npass; ++ps) {
    const int ea = E0 + 8192 * ps, eb = ea + 8192;
    const int wb = L - eb - 16;
    __syncthreads();
    for (int i = tid; i < 1032; i += 256) {
      const int gi = wb + i * 8;
      u32x4 v = {0u, 0u, 0u, 0u};
      if (gi >= 0 && gi < 2 * L) v = *(const u32x4*)(Gc + gi);
      *(u32x4*)(fw + i * 8) = v;
    }
    __syncthreads();
    const int eend = (eb - 16 < ELAST) ? (eb - 16) : ELAST;
    for (int e = ea; e <= eend; e += 16) {
      bool in[4]; bool any = false;
#pragma unroll
      for (int i = 0; i < 4; ++i) { in[i] = (e >= 1024 * tJ[i] - L + 16) && (e <= 1024 * tJ[i] + 992); any = any || in[i]; }
      if (!any) continue;
      const int idx0 = L - e - r + 8 * h - wb;
      bf16x8 a;
#pragma unroll
      for (int j = 0; j < 8; ++j) a[j] = (short)fw[idx0 + j];
#pragma unroll
      for (int i = 0; i < 4; ++i) {
        if (in[i]) {
          const bf16x8 b = *(const bf16x8*)(zs + tq[i] * ZL + 1024 + 1024 * tJ[i] + 32 * r - e + 8 * h);
          acc[i] = MFMA(a, b, acc[i]);
        }
      }
    }
  }
#pragma unroll
  for (int i = 0; i < 4; ++i) {
    u16* dst = yT + ((size_t)tq[i] * 512 + c) * L + 1024 * tJ[i] + 32 * r + 4 * h;
#pragma unroll
    for (int g4 = 0; g4 < 4; ++g4) {
      u32x2 o; o[0] = pack2(acc[i][4 * g4], acc[i][4 * g4 + 1]); o[1] = pack2(acc[i][4 * g4 + 2], acc[i][4 * g4 + 3]);
      *(u32x2*)(dst + 8 * g4) = o;
    }
  }
}

DI void diff_post_item(const Params& P, int layer, float lam, float lam_init, const u16* __restrict__ dO, u16* __restrict__ ydf, int it) {
  const int tid = otid() & 255, lane = tid & 63, w = __builtin_amdgcn_readfirstlane(tid >> 6);
  const int u = it * 8 + w * 2 + (lane >> 5);
  const int i = lane & 31;
  const u32x2 a = *(const u32x2*)(dO + (size_t)u * 256 + 4 * i);
  const u32x2 b = *(const u32x2*)(dO + (size_t)u * 256 + 128 + 4 * i);
  float o[4];
  o[0] = bflo(a[0]) - lam * bflo(b[0]); o[1] = bfhi(a[0]) - lam * bfhi(b[0]);
  o[2] = bflo(a[1]) - lam * bflo(b[1]); o[3] = bfhi(a[1]) - lam * bfhi(b[1]);
  const float ss = half_sum(o[0] * o[0] + o[1] * o[1] + o[2] * o[2] + o[3] * o[3]);
  const float rs = rsqrtf(ss * (1.0f / 128.0f) + 1e-5f) * (1.0f - lam_init);
  const float* g = P.diff_subln + layer * 128 + 4 * i;
  u32x2 ov; ov[0] = pack2(o[0] * rs * g[0], o[1] * rs * g[1]); ov[1] = pack2(o[2] * rs * g[2], o[3] * rs * g[3]);
  *(u32x2*)(ydf + (size_t)u * 128 + 4 * i) = ov;
}
DI void hyena_post_item(const Params& P, int layer, const u16* __restrict__ p, int L, const u16* __restrict__ yT, const u16* __restrict__ zT,
                        int ct, int tt, u16* __restrict__ yhy, char* smem) {
  float* tile = (float*)smem;
  const int tid = otid() & 255;
  const int t0 = tt * 64; const int seq = t0 / L, tl0 = t0 - seq * L;
  __syncthreads();
  {
    const int tcol = tid & 63, c0 = tid >> 6;
#pragma unroll
    for (int i = 0; i < 16; ++i) {
      const int cc = c0 + 4 * i; const int c = ct * 64 + cc;
      const size_t gi = ((size_t)seq * 512 + c) * L + tl0 + tcol;
      tile[cc * 65 + tcol] = bf2f(yT[gi]) + bf2f(zT[gi]) * P.hy_skip[layer * 512 + c];
    }
  }
  __syncthreads();
  {
    const int col = tid & 63, r0 = tid >> 6; const int c = ct * 64 + col;
    const float* cw = P.hy_conv_w + layer * 3 * 1536; const float* cb = P.hy_conv_b + layer * 1536;
    const float w0 = cw[c], w1 = cw[1536 + c], w2 = cw[3072 + c], b0 = cb[c];
#pragma unroll
    for (int i = 0; i < 16; ++i) {
      const int row = r0 + 4 * i; const int tl = tl0 + row;
      const u16* pr = p + (size_t)(t0 + row) * INC + c;
      const float xm1 = (tl > 0) ? bf2f(pr[-INC]) : 0.f, x0 = bf2f(pr[0]), xp1 = (tl < L - 1) ? bf2f(pr[INC]) : 0.f;
      const float x0c = xm1 * w0 + x0 * w1 + xp1 * w2 + b0;
      yhy[(size_t)(t0 + row) * 512 + c] = f2bf(x0c * tile[col * 65 + row]);
    }
  }
}

__global__ void __launch_bounds__(512) fwd_megakernel(Params Parg) {
  cg::grid_group grid = cg::this_grid();
  extern __shared__ __attribute__((aligned(16))) char smem_dyn[];
  char* smem = smem_dyn + 16;
  uint4& xb_words = *(uint4*)smem_dyn;
  const int nb = gridDim.x, nb2 = nb * 2;
#define KPARAMS() const Params __attribute__((address_space(4)))* pp_ = (const Params __attribute__((address_space(4)))*)__builtin_amdgcn_kernarg_segment_ptr(); \
  asm volatile("" : "+s"(pp_)); const Params& P = *(const Params*)pp_; char* ws = P.ws
  if (threadIdx.x == 0) xb_words = make_uint4(0u, 0u, 0u, blockIdx.x);
  __syncthreads();
  XcdBarrier xb;
  { KPARAMS(); xb = xcd_barrier_post((unsigned*)(ws + O_BAR), (volatile LAS unsigned*)&xb_words); }

  for (int step = 0; step < 80; ++step) {
    const int layer = step / 40, ls = step - layer * 40;
    PHASE_IDS();
    KPARAMS();
    float* misc = (float*)(ws + O_MISC);
    u16* pbuf = (u16*)(ws + O_P); u16* hid = pbuf; u16* hn = (u16*)(ws + O_HN); u16* merged = hn;
    if (ls == 0) {
      u16* filt8 = (u16*)(ws + O_FILT8); u16* filt16 = (u16*)(ws + O_FILT16);
      const int n1 = 16 * 88, n2 = 44 * 16, n3 = 16 * 108, n4 = 3 * 8 * 16, n5 = 16 * 16;
      const int nfilt = 128 + 256;
      const int total = n1 + n2 + n3 + n4 + n5 + n1 + n2 + nfilt;
      for (int it = bid2; it < total; it += nb2) {
        int t = it;
        if (t < nfilt) {
          const bool big = t < 256;
          filter_item(P, layer, big ? 16384 : 8192, big ? t : t - 256, big ? filt16 : filt8, smg);
          continue;
        }
        t -= nfilt;
        const float* src; int K, N, kt, nt, ph = 0; u16* dst;
        if (t < n1) { src = P.ffn1_w_in + (size_t)layer * 1024 * 5632; K = 1024; N = 5632; dst = (u16*)(ws + O_F1IN); kt = t / 88; nt = t % 88; ph = 2816; }
        else if ((t -= n1) < n2) { src = P.ffn1_w_out + (size_t)layer * 2816 * 1024; K = 2816; N = 1024; dst = (u16*)(ws + O_F1OUT); kt = t / 16; nt = t % 16; }
        else if ((t -= n2) < n3) { src = P.w_in + (size_t)layer * 1024 * 6912; K = 1024; N = 6912; dst = (u16*)(ws + O_WIN); kt = t / 108; nt = t % 108; }
        else if ((t -= n3) < n4) { const int br = t / 128, tt = t % 128; src = P.w_branch + ((size_t)layer * 3 + br) * 512 * 1024; K = 512; N = 1024;
                                   dst = (u16*)(ws + O_WBR) + (size_t)br * 1024 * 512; kt = tt / 16; nt = tt % 16; }
        else if ((t -= n4) < n5) { src = P.w_out + (size_t)layer * 1024 * 1024; K = 1024; N = 1024; dst = (u16*)(ws + O_WOUT); kt = t / 16; nt = t % 16; }
        else if ((t -= n5) < n1) { src = P.ffn2_w_in + (size_t)layer * 1024 * 5632; K = 1024; N = 5632; dst = (u16*)(ws + O_F2IN); kt = t / 88; nt = t % 88; ph = 2816; }
        else { t -= n1; src = P.ffn2_w_out + (size_t)layer * 2816 * 1024; K = 2816; N = 1024; dst = (u16*)(ws + O_F2OUT); kt = t / 16; nt = t % 16; }
        convT_tile(src, K, N, dst, kt, nt, ph, smg);
      }
      if (bid == 0 && grp == 0) {
        const int tid = t_;
        if (tid < 2) {
          const float* lp = P.diff_lambda + tid * 256;
          float s1 = 0.f, s2 = 0.f;
          for (int i = 0; i < 64; ++i) { s1 += lp[i] * lp[64 + i]; s2 += lp[128 + i] * lp[192 + i]; }
          const float lam_init = 0.8f - 0.6f * expf(-0.3f * (float)tid);
          misc[tid] = expf(s1) - expf(s2) + lam_init;
        }
        for (int i = tid; i < 4 * 257; i += 256) {
          const int hh = i / 257, idx = i % 257; const int rel = idx - 128; const int n = rel < 0 ? -rel : rel;
          int b;
          if (n < 8) b = n; else { int lg = 8 + (int)(logf((float)n / 8.0f) / 2.772588722239781f * 8.0f); b = lg < 15 ? lg : 15; }
          if (rel > 0) b += 16;
          misc[64 + i] = P.rel_bias[b * 4 + hh] * LOG2E;
        }
      }
      if (step == 0) {
        grid.sync();
        if (threadIdx.x == 0) {
          unsigned* bar = (unsigned*)(ws + O_BAR); bool even = ((nb & 7) == 0);
          for (int j = 0; j < 16; ++j) { const unsigned c = xb_ld(&bar[XB_XCNT(j)]); if (c != ((j < 8) ? (unsigned)(nb >> 3) : 0u)) even = false; }
          volatile LAS unsigned* st = (volatile LAS unsigned*)&xb_words;
          if (even) st[3] = st[2] * 8u + xb.x;
        }
        __syncthreads();
      } else GSYNC();
      continue;
    }
    const int cs = ls - 1; const int ch = cs / 13, st = cs - ch * 13;
    const int nseq = (ch < 2) ? 2 : 1, L = (ch < 2) ? 8192 : 16384;
    const float* xin0 = (ch < 2) ? (P.x_prompt + (size_t)ch * TCH * DM) : P.x_sample;
    float* xres = P.out + (size_t)ch * TCH * DM;
    const float* xcur = (layer == 0) ? xin0 : xres;
    for (int rp_ = 0; rp_ <= ((REPMASK >> st) & 1); ++rp_) {
    if (st == 0 || st == 3 || st == 10) {
      const float* src = (st == 0) ? xcur : xres;
      const float* gn = ((st == 0) ? P.ffn1_norm : (st == 3 ? P.mix_norm : P.ffn2_norm)) + layer * DM;
      for (int it = bid2; it < TCH / 4; it += nb2) { const int row = it * 4 + w; norm_row_bf16(src + (size_t)row * DM, gn, hn + (size_t)row * DM, lane); }
    } else if (st == 1 || st == 2 || st == 4 || st == 8 || st == 9 || st == 11 || st == 12) {
      EpiAny E{}; const u16* A; const u16* Bt; int N, K; int nrep = 1;
      if (st == 1 || st == 11) { A = hn; Bt = (u16*)(ws + (st == 1 ? O_F1IN : O_F2IN)); N = 5632; K = DM; E.mode = EPI_SWIGLU; E.perm = true; E.O = hid; E.ldo = DFF; }
      else if (st == 2 || st == 12) { A = hid; Bt = (u16*)(ws + (st == 2 ? O_F1OUT : O_F2OUT)); N = DM; K = DFF; E.mode = EPI_RESID; E.perm = false;
                                      E.xin = (st == 2) ? xcur : xres; E.xout = xres; E.scale = 0.5f; }
      else if (st == 4) { A = hn; Bt = (u16*)(ws + O_WIN); N = INC; K = DM; E.mode = EPI_PROJ; E.perm = true; E.O = pbuf; }
      else if (st == 8) { A = (u16*)(ws + O_YHY); Bt = (u16*)(ws + O_WBR); N = DM; K = 512; E.mode = EPI_MERGE; E.perm = false; E.gate = pbuf; E.macc = (float*)(ws + O_ZT); E.O = merged; nrep = 3; }
      else { A = merged; Bt = (u16*)(ws + O_WOUT); N = DM; K = DM; E.mode = EPI_RESID; E.perm = false; E.xin = xres; E.xout = xres; E.scale = 1.0f; }
      for (int rp = 0; rp < nrep; ++rp) {
        E.br = rp;
        pg8::Gemm gg{A + (size_t)rp * TCH * 512, Bt + (size_t)rp * 1024 * 512, TCH, N, K};
        pg8::StaticOrder S; S.init(TCH, N, nb, bid);
        pg8::gemm_phase<EpiAny, pg8::StaticOrder, false>((PG8_LAS unsigned char*)smem, gg, S, E, nullptr);
      }
    } else if (st == 5) {
      const int nqk = TCH * 10 / 8, ntr = 256 * 18;
      for (int it = bid2; it < nqk + ntr; it += nb2) {
        if (it < nqk) { qk_prep_item(P, layer, pbuf, L, it); continue; }
        const int t = it - nqk; const int tt = t / 18, cc = t % 18;
        const int kind = (cc < 2) ? 0 : (cc < 10 ? 1 : 2);
        const int ct = (cc < 2) ? cc : (cc < 10 ? cc - 2 : cc - 10);
        u16* dst = (u16*)(ws + (kind == 0 ? O_VTG : (kind == 1 ? O_VTD : O_ZT)));
        transpose_item(P, layer, pbuf, L, kind, ct, tt, dst, smg);
      }
    } else if (st == 6) {
      u16* zT = (u16*)(ws + O_ZT); u16* yT = (u16*)(ws + O_YT); u16* dO = (u16*)(ws + O_DIFFO);
      u16* vtg = (u16*)(ws + O_VTG); u16* vtd = (u16*)(ws + O_VTD); u16* ygq = (u16*)(ws + O_YGQ);
      const u16* filt = (u16*)(ws + ((ch < 2) ? O_FILT8 : O_FILT16));
      const int nqt = L / 128;
      const int xcd = bid & 7, nxu = (nb >> 3) * 2, u0 = (bid >> 3) * 2, nitem = nseq * nqt;
      for (int e0 = u0; e0 < nitem; e0 += nxu) {
        const int e = e0 + grp;
        const int seq = e / nqt, qt = e - seq * nqt;
        const int hh = xcd >> 1, cc = xcd & 1;
        const size_t tb = (size_t)seq * L;
        const u16* Qd = pbuf + tb * INC + OFF_DQ + xcd * 64; const u16* Kd = pbuf + tb * INC + OFF_DK + xcd * 64;
        const u16* Vd = vtd + ((size_t)seq * 512 + hh * 128) * L; u16* Od = dO + tb * 1024 + (hh * 2 + cc) * 128;
        if (grp) attn_tile<128, true, true>(Qd, Kd, Vd, L, Od, 1024, qt * 128, misc + 64 + hh * 257, smg);
        else attn_tile<128, true, false>(Qd, Kd, Vd, L, Od, 1024, qt * 128, misc + 64 + hh * 257, smg);
      }
      for (int e0 = u0; e0 < nitem; e0 += nxu) {
        const int e = e0 + grp;
        const int seq = e / nqt, qt = e - seq * nqt;
        const int kvh = xcd >> 2;
        const size_t tb = (size_t)seq * L;
        const u16* Qd = pbuf + tb * INC + OFF_GQ + xcd * 64; const u16* Kd = pbuf + tb * INC + OFF_GK + kvh * 64;
        const u16* Vd = vtg + ((size_t)seq * 128 + kvh * 64) * L; u16* Od = ygq + tb * 512 + xcd * 64;
        if (grp) attn_tile<64, false, true>(Qd, Kd, Vd, L, Od, 512, qt * 128, nullptr, smg);
        else attn_tile<64, false, false>(Qd, Kd, Vd, L, Od, 512, qt * 128, nullptr, smg);
      }
      for (int c = bid2; c < 512; c += nb2) hyena_item(c, filt, zT, yT, nseq, L, smg);
    } else {
      u16* zT = (u16*)(ws + O_ZT); u16* yT = (u16*)(ws + O_YT); u16* dO = (u16*)(ws + O_DIFFO);
      u16* yhy = (u16*)(ws + O_YHY); u16* ydf = (u16*)(ws + O_YDF);
      const float lam = misc[layer];
      const float lam_init = 0.8f - 0.6f * expf(-0.3f * (float)layer);
      const int ndp = TCH * 4 / 8, nhp = 256 * 8;
      for (int it = bid2; it < ndp + nhp; it += nb2) {
        if (it < ndp) diff_post_item(P, layer, lam, lam_init, dO, ydf, it);
        else { const int t = it - ndp; hyena_post_item(P, layer, pbuf, L, yT, zT, t % 8, t / 8, yhy, smg); }
      }
    }
    }
    GSYNC();
  }
  { PHASE_IDS(); KPARAMS(); (void)ws;
    for (int it = bid2; it < NTOK / 4; it += nb2) { const int row = it * 4 + w; norm_row_f32_inplace(P.out + (size_t)row * DM, P.final_norm, lane); }
  }
}

extern "C" void kernel_launch(void* const* d_in, const int* in_sizes, int n_in, void* d_out, int out_size, void* d_ws, size_t ws_size,
                              hipStream_t stream) {
  static int grid_blocks = 0;
  if (!grid_blocks) {
    int dev = 0, cus = 0, per_cu = 0;
    (void)hipGetDevice(&dev);
    (void)hipDeviceGetAttribute(&cus, hipDeviceAttributeMultiprocessorCount, dev);
    (void)hipFuncSetAttribute((const void*)fwd_megakernel, hipFuncAttributeMaxDynamicSharedMemorySize, SMEM_BYTES + 16);
    (void)hipOccupancyMaxActiveBlocksPerMultiprocessor(&per_cu, fwd_megakernel, 512, SMEM_BYTES + 16);
    if (per_cu < 1) per_cu = 1;
    if (per_cu > 1) per_cu = 1;
    grid_blocks = cus * per_cu;
  }
  Params p{};
  const float* const* in = (const float* const*)d_in;
  p.x_prompt = in[0]; p.x_sample = in[1]; p.ffn1_norm = in[2]; p.ffn1_w_in = in[3]; p.ffn1_w_out = in[4]; p.mix_norm = in[5]; p.w_in = in[6];
  p.hy_conv_w = in[7]; p.hy_conv_b = in[8]; p.hy_w1 = in[9]; p.hy_b1 = in[10]; p.hy_w2 = in[11]; p.hy_b2 = in[12]; p.hy_w3 = in[13];
  p.hy_freq = in[14]; p.hy_skip = in[15]; p.gqa_q_norm = in[16]; p.gqa_k_norm = in[17]; p.diff_lambda = in[18]; p.diff_subln = in[19];
  p.rel_bias = in[20]; p.w_branch = in[21]; p.w_out = in[22]; p.ffn2_norm = in[23]; p.ffn2_w_in = in[24]; p.ffn2_w_out = in[25]; p.final_norm = in[26];
  p.out = (float*)d_out; p.ws = (char*)d_ws;
  void* args[] = {&p};
  (void)hipMemsetAsync((char*)d_ws + O_BAR, 0, XCD_BAR_WORDS * 4, stream);
  hipError_t e = hipLaunchCooperativeKernel((void*)fwd_megakernel, dim3(grid_blocks), dim3(512), args, SMEM_BYTES + 16, stream);
  if (e != hipSuccess) fprintf(stderr, "cooperative launch failed: %s (grid %d)\n", hipGetErrorString(e), grid_blocks);
}
```

```cpp
#include <hip/hip_runtime.h>
#include <hip/hip_cooperative_groups.h>
#include <stdint.h>
#include <cstdio>
namespace cg = cooperative_groups;

typedef unsigned short u16;
typedef __attribute__((ext_vector_type(8))) short bf16x8;
typedef __attribute__((ext_vector_type(16))) float f32x16;
typedef __attribute__((ext_vector_type(4))) float f32x4;
typedef __attribute__((ext_vector_type(4))) unsigned u32x4;
typedef __attribute__((ext_vector_type(2))) unsigned u32x2;
typedef __attribute__((ext_vector_type(2))) __bf16 bf2_t;
typedef __attribute__((ext_vector_type(2))) float f2_t;
#define DI __device__ __forceinline__
#define MFMA(a, b, c) __builtin_amdgcn_mfma_f32_32x32x16_bf16((a), (b), (c), 0, 0, 0)

constexpr int DM = 1024, DFF = 2816, INC = 6912, TCH = 16384, NTOK = 49152;
constexpr int OFF_GQ = 1536, OFF_GK = 2048, OFF_GV = 2176, OFF_DQ = 2304, OFF_DK = 2816, OFF_DV = 3328, OFF_GATE = 3840;
constexpr float LOG2E = 1.4426950408889634f;

constexpr size_t SZ_F1IN = (size_t)5632 * 1024 * 2, SZ_F1OUT = (size_t)1024 * 2816 * 2, SZ_WIN = (size_t)6912 * 1024 * 2,
                 SZ_WBR = (size_t)3 * 1024 * 512 * 2, SZ_WOUT = (size_t)1024 * 1024 * 2;
constexpr size_t O_F1IN = 0, O_F1OUT = O_F1IN + SZ_F1IN, O_WIN = O_F1OUT + SZ_F1OUT, O_WBR = O_WIN + SZ_WIN, O_WOUT = O_WBR + SZ_WBR,
                 O_F2IN = O_WOUT + SZ_WOUT, O_F2OUT = O_F2IN + SZ_F1IN, O_FILT8 = O_F2OUT + SZ_F1OUT,
                 O_FILT16 = O_FILT8 + (size_t)512 * 16384 * 2, O_MISC = O_FILT16 + (size_t)512 * 32768 * 2,
                 O_P = O_MISC + 65536, O_HN = O_P + (size_t)TCH * INC * 2, O_ZT = O_HN + (size_t)TCH * 1024 * 2,
                 O_YT = O_ZT + (size_t)TCH * 512 * 2, O_DIFFO = O_YT + (size_t)TCH * 512 * 2, O_VTG = O_DIFFO + (size_t)TCH * 1024 * 2,
                 O_VTD = O_VTG + (size_t)TCH * 128 * 2, O_YHY = O_VTD + (size_t)TCH * 512 * 2, O_YGQ = O_YHY + (size_t)TCH * 512 * 2,
                 O_YDF = O_YGQ + (size_t)TCH * 512 * 2, O_END = O_YDF + (size_t)TCH * 512 * 2;
static_assert(O_END <= (size_t)536870912, "workspace overflow");
constexpr int SMEM_BYTES = 151552;
constexpr int GRP_LDS = 75776;
#define REPMASK 0
#define REP_SYNC 1
#define PHASE_IDS() const int t_ = otid(); const int bid = __builtin_amdgcn_readfirstlane(((volatile LAS unsigned*)&xb_words)[3]); const int lane = t_ & 63; const int grp = __builtin_amdgcn_readfirstlane(t_ >> 8); \
  const int w = __builtin_amdgcn_readfirstlane((t_ >> 6) & 3); const int bid2 = bid * 2 + grp; char* smg = smem + grp * GRP_LDS; \
  const int vb = (bid & 7) * (nb >> 3) + (bid >> 3); (void)lane; (void)w; (void)bid2; (void)smg; (void)vb
#define GSYNC() do { for (int rs_ = 0; rs_ < REP_SYNC; ++rs_) xcd_barrier(xb); } while (0)


#define XB_TMO      128
#define XB_XCNT(j)  (256  + 64 * (j))
#define XB_XSUB(j)  (1280 + 64 * (j))
#define XB_XGEN(j)  (2304 + 64 * (j))
#define XB_TOP      3328
#define XB_TOPGEN   3392
#define XCD_BAR_WORDS 3456
#define XB_SPIN_CAP (1u << 21)
#define LAS __attribute__((address_space(3)))
DI unsigned xb_ld(unsigned* p)              { return __hip_atomic_load(p, __ATOMIC_RELAXED, __HIP_MEMORY_SCOPE_AGENT); }
DI unsigned xb_add(unsigned* p, unsigned v) { return __hip_atomic_fetch_add(p, v, __ATOMIC_RELAXED, __HIP_MEMORY_SCOPE_AGENT); }
DI unsigned xb_xcc_id() { return (unsigned)__builtin_amdgcn_s_getreg((3 << 11) | 20) & 0xFu; }
#define XB_SPIN(cond, bar) do { unsigned _sp = 0; while (cond) { __builtin_amdgcn_s_sleep(1); \
    if ((++_sp & 255u) == 0u) { if (xb_ld(&(bar)[XB_TMO])) break; if (_sp > XB_SPIN_CAP) { atomicAdd(&(bar)[XB_TMO], 1u); break; } } } } while (0)
struct XcdBarrier { unsigned* bar; unsigned x; volatile LAS unsigned* st; };
DI XcdBarrier xcd_barrier_post(unsigned* bar, volatile LAS unsigned* st) {
  XcdBarrier b; b.bar = bar; b.x = xb_xcc_id(); b.st = st;
  if (threadIdx.x == 0) { const unsigned rank = xb_add(&bar[XB_XCNT(b.x)], 1u); st[2] = rank; }
  return b;
}
DI void xcd_barrier_complete(unsigned* bar, unsigned x, unsigned& nloc, unsigned& nx) {
  const unsigned G = gridDim.x * gridDim.y * gridDim.z;
  unsigned sum, cnt, mine, sp = 0u;
  for (;;) {
    sum = 0u; cnt = 0u; mine = 0u;
#pragma unroll
    for (unsigned j = 0; j < 16; ++j) { const unsigned c = xb_ld(&bar[XB_XCNT(j)]); sum += c; cnt += (c > 0u) ? 1u : 0u; mine = (j == x) ? c : mine; }
    if (sum == G) break;
    __builtin_amdgcn_s_sleep(1);
    if ((++sp & 255u) == 0u) { if (xb_ld(&bar[XB_TMO])) break; if (sp > XB_SPIN_CAP) { atomicAdd(&bar[XB_TMO], 1u); break; } }
  }
  nloc = mine > 0u ? mine : 1u; nx = cnt > 0u ? cnt : 1u;
}
DI void xcd_barrier(const XcdBarrier& b) {
  asm volatile("s_waitcnt vmcnt(0)" ::: "memory");
  __syncthreads();
  if (threadIdx.x == 0) {
    unsigned* bar = b.bar;
    __builtin_amdgcn_s_waitcnt(0);
    unsigned nloc = b.st[0], nx = b.st[1];
    if (nloc == 0u) { xcd_barrier_complete(bar, b.x, nloc, nx); b.st[0] = nloc; b.st[1] = nx; }
    const unsigned old = xb_add(&bar[XB_XSUB(b.x)], 1u);
    const unsigned gen = old / nloc;
    if (old + 1u == (gen + 1u) * nloc) {
      __builtin_amdgcn_fence(__ATOMIC_RELEASE, "agent");
      asm volatile("s_waitcnt vmcnt(0)" ::: "memory");
      const unsigned og = xb_add(&bar[XB_TOP], 1u);
      const unsigned tg = og / nx;
      if (og + 1u == (tg + 1u) * nx) xb_add(&bar[XB_TOPGEN], 1u);
      else XB_SPIN(xb_ld(&bar[XB_TOPGEN]) == tg, bar);
      __builtin_amdgcn_fence(__ATOMIC_ACQUIRE, "agent");
      xb_add(&bar[XB_XGEN(b.x)], 1u);
      asm volatile("s_waitcnt vmcnt(0)" ::: "memory");
    } else {
      XB_SPIN(xb_ld(&bar[XB_XGEN(b.x)]) == gen, bar);
      __builtin_amdgcn_fence(__ATOMIC_ACQUIRE, "agent");
      asm volatile("s_waitcnt vmcnt(0)" ::: "memory");
    }
  }
  __syncthreads();
}
constexpr size_t O_BAR = O_MISC + 16384;

struct Params {
  const float* x_prompt; const float* x_sample;
  const float* ffn1_norm; const float* ffn1_w_in; const float* ffn1_w_out; const float* mix_norm; const float* w_in;
  const float* hy_conv_w; const float* hy_conv_b; const float* hy_w1; const float* hy_b1; const float* hy_w2; const float* hy_b2;
  const float* hy_w3; const float* hy_freq; const float* hy_skip;
  const float* gqa_q_norm; const float* gqa_k_norm; const float* diff_lambda; const float* diff_subln; const float* rel_bias;
  const float* w_branch; const float* w_out; const float* ffn2_norm; const float* ffn2_w_in; const float* ffn2_w_out; const float* final_norm;
  float* out; char* ws;
};

DI unsigned pack2(float a, float b) { f2_t v = {a, b}; bf2_t r = __builtin_convertvector(v, bf2_t); return __builtin_bit_cast(unsigned, r); }
DI u16 f2bf(float a) { return (u16)(pack2(a, 0.f) & 0xffffu); }
DI float bf2f(u16 v) { return __uint_as_float(((unsigned)v) << 16); }
DI float bflo(unsigned v) { return __uint_as_float(v << 16); }
DI float bfhi(unsigned v) { return __uint_as_float(v & 0xffff0000u); }
DI int otid() { int t = threadIdx.x; asm volatile("" : "+v"(t)); return t; }
DI int crow(int reg, int h) { return (reg & 3) + 8 * (reg >> 2) + 4 * h; }
DI float wave_sum(float v) {
  v += __shfl_xor(v, 32); v += __shfl_xor(v, 16); v += __shfl_xor(v, 8); v += __shfl_xor(v, 4); v += __shfl_xor(v, 2); v += __shfl_xor(v, 1);
  return v;
}
DI float half_sum(float v) {
  v += __shfl_xor(v, 16); v += __shfl_xor(v, 8); v += __shfl_xor(v, 4); v += __shfl_xor(v, 2); v += __shfl_xor(v, 1);
  return v;
}

DI void convT_tile(const float* __restrict__ src, int K, int N, u16* __restrict__ dst, int kt, int nt, int perm_half, char* smem) {
  float* t = (float*)smem;
  const int tid = otid() & 255;
  __syncthreads();
  {
    const int col = tid & 63, r0 = tid >> 6;
#pragma unroll
    for (int i = 0; i < 16; ++i) { int row = r0 + 4 * i; t[row * 65 + col] = src[(size_t)(kt * 64 + row) * N + nt * 64 + col]; }
  }
  __syncthreads();
  {
    const int nl = tid >> 2, kq = tid & 3;
    int n = nt * 64 + nl;
    if (perm_half > 0) { if (n < perm_half) n = (n >> 7) * 256 + (n & 127); else { int j = n - perm_half; n = (j >> 7) * 256 + 128 + (j & 127); } }
    u32x4 o0, o1;
#pragma unroll
    for (int i = 0; i < 4; ++i) {
      o0[i] = pack2(t[(kq * 16 + 2 * i) * 65 + nl], t[(kq * 16 + 2 * i + 1) * 65 + nl]);
      o1[i] = pack2(t[(kq * 16 + 8 + 2 * i) * 65 + nl], t[(kq * 16 + 8 + 2 * i + 1) * 65 + nl]);
    }
    u16* d = dst + (size_t)n * K + kt * 64 + kq * 16;
    *(u32x4*)d = o0; *(u32x4*)(d + 8) = o1;
  }
}

DI void filter_item(const Params& P, int layer, int L, int tb, u16* __restrict__ G, char* smem) {
  float* h1 = (float*)smem;
  float* h2 = h1 + 64 * 65;
  const int tid = otid() & 255, lane = tid & 63, w = __builtin_amdgcn_readfirstlane(tid >> 6);
  const float* w1 = P.hy_w1 + layer * 33 * 64; const float* b1 = P.hy_b1 + layer * 64;
  const float* w2 = P.hy_w2 + layer * 64 * 64; const float* b2 = P.hy_b2 + layer * 64;
  const float* w3 = P.hy_w3 + layer * 64 * 1024; const float* fr = P.hy_freq + layer * 64;
  const int t = tb * 64 + lane;
  const float tl = (float)t / (float)(L - 1);
  __syncthreads();
  {
    float a[16];
#pragma unroll
    for (int u = 0; u < 16; ++u) a[u] = b1[w * 16 + u] + tl * w1[w * 16 + u];
    const float base = (float)(2.0 * 3.14159265358979323846 / (double)L) * (float)t;
    for (int b = 0; b < 16; ++b) {
      const float band = 1e-4f + (float)b * ((15.0f - 1e-4f) / 15.0f);
      const float ang = base * band;
      const float cs = cosf(ang), sn = -sinf(ang);
#pragma unroll
      for (int u = 0; u < 16; ++u) a[u] += cs * w1[(1 + b) * 64 + w * 16 + u] + sn * w1[(17 + b) * 64 + w * 16 + u];
    }
#pragma unroll
    for (int u = 0; u < 16; ++u) h1[lane * 65 + w * 16 + u] = sinf(fr[w * 16 + u] * a[u]);
  }
  __syncthreads();
  {
    float a[16];
#pragma unroll
    for (int u = 0; u < 16; ++u) a[u] = b2[w * 16 + u];
    for (int k = 0; k < 64; ++k) {
      const float hv = h1[lane * 65 + k];
#pragma unroll
      for (int u = 0; u < 16; ++u) a[u] += hv * w2[k * 64 + w * 16 + u];
    }
#pragma unroll
    for (int u = 0; u < 16; ++u) h2[lane * 65 + w * 16 + u] = sinf(fr[w * 16 + u] * a[u]);
  }
  __syncthreads();
  const float min_decay = -3.0701134573253946f, max_decay = -15.350567286626973f;
  for (int og = 0; og < 64; ++og) {
    const int o = w * 256 + og * 4;
    float a0 = 0.f, a1 = 0.f, a2 = 0.f, a3 = 0.f;
#pragma unroll 4
    for (int k = 0; k < 64; ++k) {
      const float hv = h2[lane * 65 + k];
      const f32x4 wv = *(const f32x4*)(w3 + k * 1024 + o);
      a0 += hv * wv[0]; a1 += hv * wv[1]; a2 += hv * wv[2]; a3 += hv * wv[3];
    }
    float av[4] = {a0, a1, a2, a3};
#pragma unroll
    for (int q = 0; q < 4; ++q) {
      const int oo = o + q; const int ch = oo & 511;
      const float delta = min_decay + (float)ch * ((max_decay - min_decay) / 511.0f);
      const float val = av[q] * expf(-tl * fabsf(delta));
      u16* Gc = G + (size_t)ch * (2 * L);
      if (oo < 512) Gc[L - t] = f2bf(val);
      else { if (t >= 1) Gc[L + t] = f2bf(val); else Gc[0] = 0; }
    }
  }
}

DI void norm_row_bf16(const float* __restrict__ x, const float* __restrict__ g, u16* __restrict__ out, int lane) {
  f32x4 v[4]; float ss = 0.f;
#pragma unroll
  for (int i = 0; i < 4; ++i) { v[i] = *(const f32x4*)(x + lane * 4 + 256 * i); ss += v[i][0] * v[i][0] + v[i][1] * v[i][1] + v[i][2] * v[i][2] + v[i][3] * v[i][3]; }
  ss = wave_sum(ss);
  const float rs = rsqrtf(ss * (1.0f / 1024.0f) + 1e-6f);
#pragma unroll
  for (int i = 0; i < 4; ++i) {
    const f32x4 gg = *(const f32x4*)(g + lane * 4 + 256 * i);
    u32x2 o; o[0] = pack2(v[i][0] * rs * gg[0], v[i][1] * rs * gg[1]); o[1] = pack2(v[i][2] * rs * gg[2], v[i][3] * rs * gg[3]);
    *(u32x2*)(out + lane * 4 + 256 * i) = o;
  }
}
DI void norm_row_f32_inplace(float* __restrict__ x, const float* __restrict__ g, int lane) {
  f32x4 v[4]; float ss = 0.f;
#pragma unroll
  for (int i = 0; i < 4; ++i) { v[i] = *(const f32x4*)(x + lane * 4 + 256 * i); ss += v[i][0] * v[i][0] + v[i][1] * v[i][1] + v[i][2] * v[i][2] + v[i][3] * v[i][3]; }
  ss = wave_sum(ss);
  const float rs = rsqrtf(ss * (1.0f / 1024.0f) + 1e-6f);
#pragma unroll
  for (int i = 0; i < 4; ++i) {
    const f32x4 gg = *(const f32x4*)(g + lane * 4 + 256 * i);
    f32x4 o; o[0] = v[i][0] * rs * gg[0]; o[1] = v[i][1] * rs * gg[1]; o[2] = v[i][2] * rs * gg[2]; o[3] = v[i][3] * rs * gg[3];
    *(f32x4*)(x + lane * 4 + 256 * i) = o;
  }
}

namespace pg8 {
#define PG8_LAS __attribute__((address_space(3)))
typedef unsigned short bf16_t;
typedef short bf16x8 __attribute__((ext_vector_type(8)));
typedef float f32x4 __attribute__((ext_vector_type(4)));
typedef unsigned u32x4 __attribute__((ext_vector_type(4)));
constexpr int BM = 256, BK = 64, HALF = 128, HTB = HALF * BK * 2  , STAGE_BYTES = 8 * HTB, NXCD = 8, WGM = 8;

__host__ __device__ __forceinline__ int lds_byte(int r, int c) { const int st = (r >> 4) * 2 + (c >> 5), rr = r & 15, cc = c & 31, ob = rr * 64 + cc * 2; return st * 1024 + (ob ^ (((ob >> 9) & 1) << 5)); }
__host__ __device__ __forceinline__ void stage_rc(int b, int& R, int& C) { const int st = b / 1024, sb = b % 1024, swz = sb ^ (((sb >> 9) & 1) << 5); R = (st >> 1) * 16 + swz / 64; C = (st & 1) * 32 + (swz % 64) / 2; }
__host__ __device__ __forceinline__ int perm32(int rho) { const int n = rho >> 4, i = rho & 15; return 8 * (i >> 2) + 4 * n + (i & 3); }

struct Unit { int pm, pn; };
struct Gemm { const bf16_t* A; const bf16_t* Bt; int M, N, K; };

struct StaticOrder {
    int nM, nN, nwg, G, c;
    __host__ __device__ void init(int M, int N, int G_, int c_) { nM = M / BM; nN = N / BM; nwg = nM * nN; G = G_; c = c_; }
    __host__ __device__ bool next(int i, Unit& u) const {
        const long L = (long)i * G + c; if (L >= nwg) return false;
        int wgid = (int)L; { const int q = nwg / NXCD, r = nwg % NXCD, xcd = wgid % NXCD, off = wgid / NXCD; wgid = (xcd < r ? xcd * (q + 1) : r * (q + 1) + (xcd - r) * q) + off; }
        const int nig = WGM * nN, gid = wgid / nig, fm = gid * WGM, gsz = (nM - fm) < WGM ? (nM - fm) : WGM;
        u.pm = fm + ((wgid % nig) % gsz); u.pn = (wgid % nig) / gsz; return true;
    }
    __device__ __forceinline__ void a_ready(const Unit&) const {}
    __device__ __forceinline__ void done(const Unit&) const {}
};

template <class Epi, class Sched, bool STAMP = false>
__device__ __forceinline__ void gemm_phase(PG8_LAS unsigned char* lds, const Gemm g, const Sched& S, const Epi& E, unsigned long long* stamps) {
    const int tid = otid(), wid = __builtin_amdgcn_readfirstlane(tid >> 6), lane = tid & 63, wr = wid >> 2, wc = wid & 3, fr = lane & 15, fq = lane >> 4;
    const int K = g.K, nt = K / BK;
    int ts_lo = 0, ts_hi = 0, nts = 0; const unsigned long long rt_entry = STAMP ? (unsigned long long)wall_clock64() : 0ull;
#define PG8_STAMP() do { if (STAMP && wid == 0 && nts < 64) { const unsigned long long _c = (unsigned long long)clock64(); \
        ts_lo = (lane == nts) ? (int)(unsigned)_c : ts_lo; ts_hi = (lane == nts) ? (int)(unsigned)(_c >> 32) : ts_hi; ++nts; } } while (0)
    PG8_STAMP();
    unsigned voffA[2], voffB[2];
#pragma unroll
    for (int i = 0; i < 2; ++i) { int R, C; stage_rc(tid * 16 + i * 8192, R, C); const int Rb = E.perm ? ((R & ~31) + perm32(R & 31)) : R;
        voffA[i] = (unsigned)(R * K + C) * 2u; voffB[i] = (unsigned)(Rb * K + C) * 2u; }
    const size_t kstep = (size_t)(BK * 2);
    const size_t hstep = (size_t)HALF * K * 2;
    const size_t tstep = 2 * hstep;
    const unsigned ldsw = (unsigned)wid * 1024u;
    const int aoff = lds_byte(wr * 64 + fr, fq * 8), boff = lds_byte(wc * 32 + fr, fq * 8);
#define PG8_SA(b, h) (((b) * 2 + (h)) * HTB)
#define PG8_SB(b, h) ((4 + (b) * 2 + (h)) * HTB)
#define PG8_STAGE(bufoff, gbase, voff) do { _Pragma("unroll") for (int _i = 0; _i < 2; ++_i) \
        __builtin_amdgcn_global_load_lds((const unsigned*)((const char*)(gbase) + (voff)[_i]), (PG8_LAS unsigned*)(lds + (bufoff) + ldsw + _i * 8192), 16, 0, 0); } while (0)
#define PG8_LDA(dst, b, h) do { _Pragma("unroll") for (int m = 0; m < 4; ++m) _Pragma("unroll") for (int k = 0; k < 2; ++k) dst[m][k] = *(const PG8_LAS bf16x8*)(lds + PG8_SA(b, h) + aoff + m * 2048 + k * 1024); } while (0)
#define PG8_LDB(dst, b, h) do { _Pragma("unroll") for (int n = 0; n < 2; ++n) _Pragma("unroll") for (int k = 0; k < 2; ++k) dst[n][k] = *(const PG8_LAS bf16x8*)(lds + PG8_SB(b, h) + boff + n * 2048 + k * 1024); } while (0)
#define PG8_MMA(ai, bj, At, Bt) do { __builtin_amdgcn_s_setprio(1); _Pragma("unroll") for (int m = 0; m < 4; ++m) _Pragma("unroll") for (int n = 0; n < 2; ++n) _Pragma("unroll") for (int k = 0; k < 2; ++k) \
        acc[ai][bj][m][n] = __builtin_amdgcn_mfma_f32_16x16x32_bf16(Bt[n][k], At[m][k], acc[ai][bj][m][n], 0, 0, 0); __builtin_amdgcn_s_setprio(0); } while (0)
#define PG8_WAIT_V(n) asm volatile("s_waitcnt vmcnt(" #n ")" ::: "memory")
#define PG8_WAIT_L(n) asm volatile("s_waitcnt lgkmcnt(" #n ")" ::: "memory")
#define PG8_BAR __builtin_amdgcn_s_barrier()
#define PG8_SCHED __builtin_amdgcn_sched_barrier(0)
    Unit cur, nxt; int ui = 0;
    if (!S.next(0, cur)) return;
    f32x4 acc[2][2][4][2];
#pragma unroll
    for (int a = 0; a < 2; ++a)
#pragma unroll
        for (int b = 0; b < 2; ++b)
#pragma unroll
            for (int m = 0; m < 4; ++m)
#pragma unroll
                for (int n = 0; n < 2; ++n) acc[a][b][m][n] = (f32x4){0.f, 0.f, 0.f, 0.f};
    bf16x8 At[4][2], B0[2][2], B1[2][2];
    const char* cA = (const char*)g.A + (size_t)cur.pm * tstep; const char* cB = (const char*)g.Bt + (size_t)cur.pn * tstep;
    S.a_ready(cur);
    PG8_STAGE(PG8_SB(0, 0), cB, voffB); PG8_STAGE(PG8_SA(0, 0), cA, voffA); PG8_STAGE(PG8_SB(0, 1), cB + hstep, voffB); PG8_STAGE(PG8_SA(0, 1), cA + hstep, voffA);
    if (wr == 1) PG8_BAR;
    PG8_WAIT_V(4); PG8_BAR;
    PG8_STAGE(PG8_SB(1, 0), cB + kstep, voffB); PG8_STAGE(PG8_SA(1, 0), cA + kstep, voffA); PG8_STAGE(PG8_SB(1, 1), cB + hstep + kstep, voffB);
    PG8_WAIT_V(6); PG8_BAR;
    PG8_STAMP();
    for (;;) {
        const bool has_next = S.next(ui + 1, nxt);
        const char* nA = has_next ? (const char*)g.A + (size_t)nxt.pm * tstep : cA; const char* nB = has_next ? (const char*)g.Bt + (size_t)nxt.pn * tstep : cB;
        for (int t = 0; t < nt; t += 2) {
            const bool last = (t == nt - 2);
            const char* a1 = cA + (size_t)(t + 1) * kstep;
            const char* a2 = last ? nA : cA + (size_t)(t + 2) * kstep; const char* b2 = last ? nB : cB + (size_t)(t + 2) * kstep;
            const char* a3 = a2 + kstep; const char* b3 = b2 + kstep;
            if (last && has_next) S.a_ready(nxt);
            PG8_LDB(B0, 0, 0); PG8_SCHED; PG8_LDA(At, 0, 0); PG8_STAGE(PG8_SA(1, 1), a1 + hstep, voffA);
            PG8_WAIT_L(8); PG8_BAR; PG8_WAIT_L(0); PG8_MMA(0, 0, At, B0); PG8_BAR; PG8_SCHED;
            PG8_LDB(B1, 0, 1); PG8_STAGE(PG8_SB(0, 0), b2, voffB);
            PG8_BAR; PG8_WAIT_L(0); PG8_MMA(0, 1, At, B1); PG8_BAR;
            PG8_LDA(At, 0, 1); PG8_STAGE(PG8_SA(0, 0), a2, voffA);
            PG8_BAR; PG8_WAIT_L(0); PG8_MMA(1, 0, At, B0); PG8_BAR; PG8_SCHED;
            PG8_STAGE(PG8_SB(0, 1), b2 + hstep, voffB);
            PG8_WAIT_V(6); PG8_BAR; PG8_MMA(1, 1, At, B1); PG8_BAR;
            PG8_LDB(B0, 1, 0); PG8_SCHED; PG8_LDA(At, 1, 0); PG8_STAGE(PG8_SA(0, 1), a2 + hstep, voffA);
            PG8_WAIT_L(8); PG8_BAR; PG8_WAIT_L(0); PG8_MMA(0, 0, At, B0); PG8_BAR; PG8_SCHED;
            PG8_LDB(B1, 1, 1); PG8_STAGE(PG8_SB(1, 0), b3, voffB);
            PG8_BAR; PG8_WAIT_L(0); PG8_MMA(0, 1, At, B1); PG8_BAR;
            PG8_LDA(At, 1, 1); PG8_STAGE(PG8_SA(1, 0), a3, voffA);
            PG8_BAR; PG8_WAIT_L(0); PG8_MMA(1, 0, At, B0); PG8_BAR; PG8_SCHED;
            PG8_STAGE(PG8_SB(1, 1), b3 + hstep, voffB);
            PG8_WAIT_V(6); PG8_BAR; PG8_MMA(1, 1, At, B1); PG8_BAR;
        }
        PG8_STAMP();
        if constexpr (!Epi::AFTER_DRAIN) { E(acc, cur, wr, wc, fr, fq); S.done(cur); }
        PG8_STAMP();
        if (!has_next) break;
#pragma unroll
        for (int a = 0; a < 2; ++a)
#pragma unroll
            for (int b = 0; b < 2; ++b)
#pragma unroll
                for (int m = 0; m < 4; ++m)
#pragma unroll
                    for (int n = 0; n < 2; ++n) acc[a][b][m][n] = (f32x4){0.f, 0.f, 0.f, 0.f};
        cur = nxt; cA = nA; cB = nB; ++ui;
    }
    PG8_WAIT_V(0);
    if (wr == 0) PG8_BAR;
    PG8_BAR;
    if constexpr (Epi::AFTER_DRAIN) { E.fused(acc, cur, wr, wc, fr, fq, lds, wid, lane); S.done(cur); }
    PG8_STAMP();
    if (STAMP && wid == 0) { stamps[lane] = lane < nts ? (((unsigned long long)(unsigned)ts_hi << 32) | (unsigned)ts_lo) : 0ull;
        if (lane == 62) stamps[62] = rt_entry; if (lane == 63) stamps[63] = (unsigned long long)wall_clock64(); }
#undef PG8_STAMP
#undef PG8_SA
#undef PG8_SB
#undef PG8_STAGE
#undef PG8_LDA
#undef PG8_LDB
#undef PG8_MMA
#undef PG8_WAIT_V
#undef PG8_WAIT_L
#undef PG8_BAR
#undef PG8_SCHED
}
}

enum { EPI_SWIGLU = 0, EPI_RESID = 1, EPI_PROJ = 2, EPI_MERGE = 3 };
struct EpiAny {
  static constexpr bool AFTER_DRAIN = false;
  int mode; bool perm;
  u16* O; int ldo; const float* xin; float* xout; float scale; const u16* gate; float* macc; int br;
  DI void operator()(const pg8::f32x4 (&acc)[2][2][4][2], const pg8::Unit& u, int wr, int wc, int fr, int fq) const {
    const int row0 = u.pm * 256 + wr * 64 + fr;
    if (mode == EPI_SWIGLU) {
      const int col0 = u.pn * 128 + wc * 32 + 8 * fq;
#pragma unroll
      for (int ai = 0; ai < 2; ++ai)
#pragma unroll
        for (int m = 0; m < 4; ++m) {
          float v[8];
#pragma unroll
          for (int n = 0; n < 2; ++n)
#pragma unroll
            for (int e = 0; e < 4; ++e) { const float gv = acc[ai][0][m][n][e], uv = acc[ai][1][m][n][e]; v[4 * n + e] = gv * __builtin_amdgcn_rcpf(1.0f + __builtin_amdgcn_exp2f(-LOG2E * gv)) * uv; }
          u32x4 o; o[0] = pack2(v[0], v[1]); o[1] = pack2(v[2], v[3]); o[2] = pack2(v[4], v[5]); o[3] = pack2(v[6], v[7]);
          *(u32x4*)(O + (size_t)(row0 + ai * 128 + m * 16) * ldo + col0) = o;
        }
    } else if (mode == EPI_PROJ) {
      const int col0 = u.pn * 256 + wc * 32 + 8 * fq;
      const bool sg = (u.pn * 256 >= OFF_GATE);
#pragma unroll
      for (int ai = 0; ai < 2; ++ai)
#pragma unroll
        for (int m = 0; m < 4; ++m)
#pragma unroll
          for (int bj = 0; bj < 2; ++bj) {
            float v[8];
#pragma unroll
            for (int n = 0; n < 2; ++n)
#pragma unroll
              for (int e = 0; e < 4; ++e) { float t = acc[ai][bj][m][n][e]; if (sg) t = __builtin_amdgcn_rcpf(1.0f + __builtin_amdgcn_exp2f(-LOG2E * t)); v[4 * n + e] = t; }
            u32x4 o; o[0] = pack2(v[0], v[1]); o[1] = pack2(v[2], v[3]); o[2] = pack2(v[4], v[5]); o[3] = pack2(v[6], v[7]);
            *(u32x4*)(O + (size_t)(row0 + ai * 128 + m * 16) * INC + col0 + bj * 128) = o;
          }
    } else if (mode == EPI_RESID) {
      const int col0 = u.pn * 256 + wc * 32 + 4 * fq;
#pragma unroll
      for (int ai = 0; ai < 2; ++ai)
#pragma unroll
        for (int m = 0; m < 4; ++m)
#pragma unroll
          for (int bj = 0; bj < 2; ++bj)
#pragma unroll
            for (int n = 0; n < 2; ++n) {
              const size_t idx = (size_t)(row0 + ai * 128 + m * 16) * DM + col0 + bj * 128 + n * 16;
              f32x4 xv = *(const f32x4*)(xin + idx);
#pragma unroll
              for (int e = 0; e < 4; ++e) xv[e] += scale * acc[ai][bj][m][n][e];
              *(f32x4*)(xout + idx) = xv;
            }
    } else {
      const int col0 = u.pn * 256 + wc * 32 + 4 * fq;
#pragma unroll
      for (int ai = 0; ai < 2; ++ai)
#pragma unroll
        for (int m = 0; m < 4; ++m)
#pragma unroll
          for (int bj = 0; bj < 2; ++bj)
#pragma unroll
            for (int n = 0; n < 2; ++n) {
              const int row = row0 + ai * 128 + m * 16, col = col0 + bj * 128 + n * 16;
              const u32x2 gt = *(const u32x2*)(gate + (size_t)row * INC + OFF_GATE + br * DM + col);
              f32x4 v;
              v[0] = bflo(gt[0]) * acc[ai][bj][m][n][0]; v[1] = bfhi(gt[0]) * acc[ai][bj][m][n][1];
              v[2] = bflo(gt[1]) * acc[ai][bj][m][n][2]; v[3] = bfhi(gt[1]) * acc[ai][bj][m][n][3];
              const size_t idx = (size_t)row * DM + col;
              if (br > 0) { const f32x4 pv = *(const f32x4*)(macc + idx); v[0] += pv[0]; v[1] += pv[1]; v[2] += pv[2]; v[3] += pv[3]; }
              if (br < 2) *(f32x4*)(macc + idx) = v;
              else { u32x2 o; o[0] = pack2(v[0], v[1]); o[1] = pack2(v[2], v[3]); *(u32x2*)(outb_() + idx) = o; }
            }
    }
  }
  DI u16* outb_() const { return O; }
};

DI void qk_prep_item(const Params& P, int layer, u16* __restrict__ p, int L, int it) {
  const int tid = otid() & 255, lane = tid & 63, w = __builtin_amdgcn_readfirstlane(tid >> 6);
  const int u = it * 8 + w * 2 + (lane >> 5);
  const int tok = u / 10, hd = u - tok * 10;
  const int i = lane & 31;
  const int col0 = (hd < 8) ? (OFF_GQ + hd * 64) : (OFF_GK + (hd - 8) * 64);
  const float* gn = (hd < 8) ? (P.gqa_q_norm + layer * 64) : (P.gqa_k_norm + layer * 64);
  unsigned* ptr = (unsigned*)(p + (size_t)tok * INC + col0) + i;
  const unsigned v = *ptr;
  float a = bflo(v), b = bfhi(v);
  const float ss = half_sum(a * a + b * b);
  const float rs = rsqrtf(ss * (1.0f / 64.0f) + 1e-6f);
  a = a * rs * gn[2 * i]; b = b * rs * gn[2 * i + 1];
  const int tl = tok % L;
  const float pos = (i < 16) ? (float)(tl >> 6) : (float)(tl & 63);
  const int jj = i & 15;
  const float inv = powf(10000.0f, -(float)(2 * jj) / 32.0f);
  const float ang = pos * inv;
  const float c = cosf(ang), s = sinf(ang);
  *ptr = pack2(a * c - b * s, a * s + b * c);
}

DI void transpose_item(const Params& P, int layer, const u16* __restrict__ p, int L, int kind, int ct, int tt, u16* __restrict__ dst, char* smem) {
  u16* tile = (u16*)smem;
  const int tid = otid() & 255;
  const int t0 = tt * 64;
  const int seq = t0 / L, tl0 = t0 - seq * L;
  const int C = (kind == 0) ? 128 : 512;
  __syncthreads();
  {
    const int col = tid & 63, r0 = tid >> 6;
    const int cidx = ct * 64 + col;
    if (kind < 2) {
      const int off = (kind == 0 ? OFF_GV : OFF_DV) + cidx;
#pragma unroll
      for (int i = 0; i < 16; ++i) { const int row = r0 + 4 * i; tile[col * 72 + row] = p[(size_t)(t0 + row) * INC + off]; }
    } else {
      const float* cw = P.hy_conv_w + layer * 3 * 1536; const float* cb = P.hy_conv_b + layer * 1536;
      const int c1 = 512 + cidx, c2 = 1024 + cidx;
      const float w10 = cw[c1], w11 = cw[1536 + c1], w12 = cw[3072 + c1], b1 = cb[c1];
      const float w20 = cw[c2], w21 = cw[1536 + c2], w22 = cw[3072 + c2], b2 = cb[c2];
#pragma unroll
      for (int i = 0; i < 16; ++i) {
        const int row = r0 + 4 * i; const int tl = tl0 + row;
        const u16* pr = p + (size_t)(t0 + row) * INC;
        const float xm1 = (tl > 0) ? bf2f(pr[c1 - INC]) : 0.f, x0 = bf2f(pr[c1]), xp1 = (tl < L - 1) ? bf2f(pr[c1 + INC]) : 0.f;
        const float vm1 = (tl > 0) ? bf2f(pr[c2 - INC]) : 0.f, v0 = bf2f(pr[c2]), vp1 = (tl < L - 1) ? bf2f(pr[c2 + INC]) : 0.f;
        const float x1c = xm1 * w10 + x0 * w11 + xp1 * w12 + b1;
        const float vc = vm1 * w20 + v0 * w21 + vp1 * w22 + b2;
        tile[col * 72 + row] = f2bf(vc * x1c);
      }
    }
  }
  __syncthreads();
  {
    const int c = tid >> 2, q = tid & 3;
    const u32x4 a = *(const u32x4*)(tile + c * 72 + q * 16), b = *(const u32x4*)(tile + c * 72 + q * 16 + 8);
    u16* d = dst + ((size_t)seq * C + ct * 64 + c) * L + tl0 + q * 16;
    *(u32x4*)d = a; *(u32x4*)(d + 8) = b;
  }
}

DI int kperm(int rho) { return (rho & ~0xC) | ((rho & 4) << 1) | ((rho & 8) >> 1); }
template <int DV, bool BIAS, bool SWAP>
DI void attn_tile(const u16* __restrict__ Qp, const u16* __restrict__ Kp, const u16* __restrict__ VTp, int L,
                  u16* __restrict__ Op, int ldo, int q0, const float* __restrict__ btab, char* smem) {
  constexpr int NDT = DV / 32;
  constexpr int VCH = DV / 32;
  constexpr int KS_SZ = 64 * 64, VS_SZ = DV * 64;
  constexpr int NL = 2 + VCH;
  constexpr int KLEAD = SWAP ? 3 : 2;
  u16* Ks = (u16*)smem;
  u16* Vs = Ks + 3 * KS_SZ;
  float* bt = (float*)(Vs + 3 * VS_SZ);
  const int tid = otid() & 255, lane = tid & 63, w = __builtin_amdgcn_readfirstlane(tid >> 6), r = lane & 31, h = lane >> 5;
  const float sc = 0.125f * LOG2E;
  __syncthreads();
  if (BIAS) { for (int i = tid; i < 257; i += 256) bt[i] = btab[i]; }
  bf16x8 qf[4];
  {
    const u16* qrow = Qp + (size_t)(q0 + 32 * w + r) * INC + 8 * h;
#pragma unroll
    for (int s = 0; s < 4; ++s) qf[s] = *(const bf16x8*)(qrow + 16 * s);
  }
  const int qpos = q0 + 32 * w + r;
  f32x16 O[NDT];
#pragma unroll
  for (int d = 0; d < NDT; ++d)
#pragma unroll
    for (int q = 0; q < 16; ++q) O[d][q] = 0.f;
  float m = -INFINITY, l = 0.f;
  const int lrow = tid >> 3, lsw = (tid & 7) ^ ((tid >> 4) & 7);
  const u16* Kg0 = Kp + (size_t)kperm(lrow) * INC + lsw * 8;
  const u16* Vg = VTp + (size_t)lrow * L + lsw * 8;
  const int ksw = (r >> 1) & 7;
  const int nkb = L >> 6;
#define ATT_LOADK(tile, bufp) do { const int t__ = ((tile) < nkb) ? (tile) : nkb - 1; _Pragma("unroll") for (int i_ = 0; i_ < 2; ++i_) \
    __builtin_amdgcn_global_load_lds((const unsigned*)(Kg0 + ((size_t)t__ * 64 + 32 * i_) * INC), (unsigned*)((char*)(bufp) + tid * 16 + i_ * 4096), 16, 0, 0); } while (0)
#define ATT_LOADV(tile, bufp) do { const int t__ = ((tile) < nkb) ? (tile) : nkb - 1; _Pragma("unroll") for (int i_ = 0; i_ < VCH; ++i_) \
    __builtin_amdgcn_global_load_lds((const unsigned*)(Vg + (size_t)(32 * i_) * L + (size_t)t__ * 64), (unsigned*)((char*)(bufp) + tid * 16 + i_ * 4096), 16, 0, 0); } while (0)
  f32x16 Sc[2];
  auto qk = [&](const u16* Kb) __attribute__((always_inline)) {
    bf16x8 kf[2][4];
#pragma unroll
    for (int kt = 0; kt < 2; ++kt)
#pragma unroll
      for (int s = 0; s < 4; ++s) kf[kt][s] = *(const bf16x8*)(Kb + (32 * kt + r) * 64 + (((2 * s + h) ^ ksw) << 3));
#pragma unroll
    for (int kt = 0; kt < 2; ++kt) {
#pragma unroll
      for (int q = 0; q < 16; ++q) Sc[kt][q] = 0.f;
#pragma unroll
      for (int s = 0; s < 4; ++s) Sc[kt] = MFMA(kf[kt][s], qf[s], Sc[kt]);
    }
    __builtin_amdgcn_sched_group_barrier(0x100, 8, 0);
    __builtin_amdgcn_sched_group_barrier(0x008, 8, 0);
  };
  bf16x8 pf[2][2];
  auto softmax = [&](int kb) __attribute__((always_inline)) {
    if (BIAS) {
      const int kmin = kb * 64;
      if (kmin - (q0 + 127) >= 128 || q0 - (kmin + 63) >= 128) {
        const float cb = (kmin > q0) ? bt[256] : bt[0];
#pragma unroll
        for (int kt = 0; kt < 2; ++kt)
#pragma unroll
          for (int q = 0; q < 16; ++q) Sc[kt][q] = Sc[kt][q] * sc + cb;
      } else {
#pragma unroll
        for (int kt = 0; kt < 2; ++kt)
#pragma unroll
          for (int q = 0; q < 16; ++q) {
            int rel = kmin + 32 * kt + kperm(crow(q, h)) - qpos;
            rel = rel < -128 ? -128 : (rel > 128 ? 128 : rel);
            Sc[kt][q] = Sc[kt][q] * sc + bt[rel + 128];
          }
      }
    }
    float mx = Sc[0][0];
#pragma unroll
    for (int kt = 0; kt < 2; ++kt)
#pragma unroll
      for (int q = 0; q < 16; ++q) mx = fmaxf(mx, Sc[kt][q]);
    mx = fmaxf(mx, __shfl_xor(mx, 32));
    if (!BIAS) mx *= sc;
    if (__any(mx > m + 6.0f)) {
      const float mn = fmaxf(m, mx);
      const float alpha = __builtin_amdgcn_exp2f(m - mn);
      m = mn; l *= alpha;
#pragma unroll
      for (int d = 0; d < NDT; ++d)
#pragma unroll
        for (int q = 0; q < 16; ++q) O[d][q] *= alpha;
    }
    const float nm = -m;
#pragma unroll
    for (int kt = 0; kt < 2; ++kt) {
#pragma unroll
      for (int q = 0; q < 16; ++q) {
        const float pv = BIAS ? __builtin_amdgcn_exp2f(Sc[kt][q] + nm) : __builtin_amdgcn_exp2f(__builtin_fmaf(Sc[kt][q], sc, nm));
        Sc[kt][q] = pv; l += pv;
      }
#pragma unroll
      for (int s = 0; s < 2; ++s) {
        u32x4 pk;
#pragma unroll
        for (int q = 0; q < 4; ++q) pk[q] = pack2(Sc[kt][8 * s + 2 * q], Sc[kt][8 * s + 2 * q + 1]);
        pf[kt][s] = __builtin_bit_cast(bf16x8, pk);
      }
    }
  };
  auto pv = [&](const u16* Vb) __attribute__((always_inline)) {
    bf16x8 vf[4][NDT];
#pragma unroll
    for (int ks = 0; ks < 4; ++ks)
#pragma unroll
      for (int d = 0; d < NDT; ++d) vf[ks][d] = *(const bf16x8*)(Vb + (32 * d + r) * 64 + (((2 * ks + h) ^ ksw) << 3));
#pragma unroll
    for (int ks = 0; ks < 4; ++ks)
#pragma unroll
      for (int d = 0; d < NDT; ++d) O[d] = MFMA(vf[ks][d], pf[ks >> 1][ks & 1], O[d]);
    __builtin_amdgcn_sched_group_barrier(0x100, 2 * NDT, 0);
    __builtin_amdgcn_sched_group_barrier(0x008, NDT, 0);
    __builtin_amdgcn_sched_group_barrier(0x100, NDT, 0);
    __builtin_amdgcn_sched_group_barrier(0x008, NDT, 0);
    __builtin_amdgcn_sched_group_barrier(0x100, NDT, 0);
    __builtin_amdgcn_sched_group_barrier(0x008, 2 * NDT, 0);
  };
  ATT_LOADK(0, Ks); ATT_LOADK(1, Ks + KS_SZ); if (SWAP) ATT_LOADK(2, Ks + 2 * KS_SZ);
  ATT_LOADV(0, Vs); ATT_LOADV(1, Vs + VS_SZ);
  asm volatile("s_waitcnt vmcnt(0) lgkmcnt(0)\n\ts_barrier" ::: "memory");
  if (SWAP) qk(Ks);
  int r0 = 0, r1 = 1, r2 = 2;
  for (int kb = 0; kb < nkb; ++kb) {
    ATT_LOADK(kb + KLEAD, Ks + (SWAP ? r0 : r2) * KS_SZ);
    ATT_LOADV(kb + 2, Vs + r2 * VS_SZ);
    if (!SWAP) qk(Ks + r0 * KS_SZ);
    softmax(kb);
    pv(Vs + r0 * VS_SZ);
    if (SWAP) qk(Ks + r1 * KS_SZ);
    asm volatile("s_waitcnt vmcnt(%0) lgkmcnt(0)\n\ts_barrier" :: "n"(NL) : "memory");
    { const int tmp = r0; r0 = r1; r1 = r2; r2 = tmp; }
  }
  asm volatile("s_waitcnt vmcnt(0)" ::: "memory");
#undef ATT_LOADK
#undef ATT_LOADV
  l += __shfl_xor(l, 32);
  const float inv = __builtin_amdgcn_rcpf(l);
  int ldo2 = ldo; asm volatile("" : "+s"(ldo2));
  u16* orow = Op + (size_t)qpos * ldo2;
#pragma unroll
  for (int d = 0; d < NDT; ++d)
#pragma unroll
    for (int g4 = 0; g4 < 4; ++g4) {
      u32x2 o; o[0] = pack2(O[d][4 * g4] * inv, O[d][4 * g4 + 1] * inv); o[1] = pack2(O[d][4 * g4 + 2] * inv, O[d][4 * g4 + 3] * inv);
      *(u32x2*)(orow + 32 * d + 8 * g4 + 4 * h) = o;
    }
}

DI void hyena_item(int c, const u16* __restrict__ G, const u16* __restrict__ zT, u16* __restrict__ yT, int nseq, int L, char* smem) {
  u16* zs = (u16*)smem;
  u16* fw = zs + 20480;
  u16* fw1 = fw + 8256;
  const int tid = otid() & 255, lane = tid & 63, w = __builtin_amdgcn_readfirstlane(tid >> 6), r = lane & 31, h = lane >> 5;
  const int ZL = L + 2048;
  __syncthreads();
  for (int q = 0; q < nseq; ++q) {
    const u16* src = zT + ((size_t)q * 512 + c) * L;
    u16* dst = zs + q * ZL;
    const u32x4 zero = {0u, 0u, 0u, 0u};
    for (int i = tid; i < 128; i += 256) { *(u32x4*)(dst + i * 8) = zero; *(u32x4*)(dst + 1024 + L + i * 8) = zero; }
    for (int i = tid; i < (L >> 3); i += 256) *(u32x4*)(dst + 1024 + i * 8) = *(const u32x4*)(src + i * 8);
  }
  int tq[4], tJ[4];
#pragma unroll
  for (int i = 0; i < 4; ++i) { if (nseq == 2) { tq[i] = i & 1; tJ[i] = 2 * w + (i >> 1); } else { tq[i] = 0; tJ[i] = 4 * w + i; } }
  f32x16 acc[4];
#pragma unroll
  for (int i = 0; i < 4; ++i)
#pragma unroll
    for (int q = 0; q < 16; ++q) acc[i][q] = 0.f;
  const int E0 = -L + 16, ELAST = L - 32;
  const int npass = (2 * L - 32 + 8191) / 8192;
  const u16* Gc = G + (size_t)c * (2 * L);
  for (int ps = 0; ps < npass; ++ps) {
    const int ea = E0 + 8192 * ps, eb = ea + 8192;
    const int wb = L - eb - 16;
    __syncthreads();
    for (int i = tid; i < 1032; i += 256) {
      const int gi = wb + i * 8;
      u32x4 v = {0u, 0u, 0u, 0u};
      if (gi >= 0 && gi < 2 * L) v = *(const u32x4*)(Gc + gi);
      *(u32x4*)(fw + i * 8) = v;
    }
    __syncthreads();
    for (int i = tid; i < 4127; i += 256) { const unsigned lo = ((const unsigned*)fw)[i], hi = ((const unsigned*)fw)[i + 1]; ((unsigned*)fw1)[i] = (lo >> 16) | (hi << 16); }
    __syncthreads();
    const int eend = (eb - 16 < ELAST) ? (eb - 16) : ELAST;
    auto slow = [&](int e_lo, int e_hi) __attribute__((always_inline)) {
      for (int e = e_lo; e <= e_hi; e += 16) {
        bool in[4]; bool any = false;
#pragma unroll
        for (int i = 0; i < 4; ++i) { in[i] = (e >= 1024 * tJ[i] - L + 16) && (e <= 1024 * tJ[i] + 992); any = any || in[i]; }
        if (!any) continue;
        const int idx0 = L - e - r + 8 * h - wb;
        const unsigned* aw = (idx0 & 1) ? (const unsigned*)(fw1 + idx0 - 1) : (const unsigned*)(fw + idx0);
        u32x4 av; av[0] = aw[0]; av[1] = aw[1]; av[2] = aw[2]; av[3] = aw[3];
        const bf16x8 a = __builtin_bit_cast(bf16x8, av);
#pragma unroll
        for (int i = 0; i < 4; ++i) {
          if (in[i]) {
            const bf16x8 b = *(const bf16x8*)(zs + tq[i] * ZL + 1024 + 1024 * tJ[i] + 32 * r - e + 8 * h);
            acc[i] = MFMA(a, b, acc[i]);
          }
        }
      }
    };
    int mlo = 1024 * tJ[3] - L + 16, mhi = 1024 * tJ[0] + 992;
    if (mlo < ea) mlo = ea; if (mhi > eend) mhi = eend;
    if (mlo > mhi) { slow(ea, eend); }
    else {
      slow(ea, mlo - 16);
      {
        const int idx0 = L - mlo - r + 8 * h - wb;
        const unsigned* ap = (idx0 & 1) ? (const unsigned*)(fw1 + idx0 - 1) : (const unsigned*)(fw + idx0);
        const u16* bp0 = zs + tq[0] * ZL + 1024 + 1024 * tJ[0] + 32 * r - mlo + 8 * h;
        const u16* bp1 = zs + tq[1] * ZL + 1024 + 1024 * tJ[1] + 32 * r - mlo + 8 * h;
        const u16* bp2 = zs + tq[2] * ZL + 1024 + 1024 * tJ[2] + 32 * r - mlo + 8 * h;
        const u16* bp3 = zs + tq[3] * ZL + 1024 + 1024 * tJ[3] + 32 * r - mlo + 8 * h;
        const int n = ((mhi - mlo) >> 4) + 1;
        bf16x8 a, b0, b1, b2, b3;
        { u32x4 av; av[0] = ap[0]; av[1] = ap[1]; av[2] = ap[2]; av[3] = ap[3]; a = __builtin_bit_cast(bf16x8, av); }
        b0 = *(const bf16x8*)bp0; b1 = *(const bf16x8*)bp1; b2 = *(const bf16x8*)bp2; b3 = *(const bf16x8*)bp3;
        for (int k = 0; k < n; ++k) {
          ap -= 8; bp0 -= 16; bp1 -= 16; bp2 -= 16; bp3 -= 16;
          bf16x8 an, c0, c1, c2, c3;
          { u32x4 av; av[0] = ap[0]; av[1] = ap[1]; av[2] = ap[2]; av[3] = ap[3]; an = __builtin_bit_cast(bf16x8, av); }
          c0 = *(const bf16x8*)bp0; c1 = *(const bf16x8*)bp1; c2 = *(const bf16x8*)bp2; c3 = *(const bf16x8*)bp3;
          acc[0] = MFMA(a, b0, acc[0]); acc[1] = MFMA(a, b1, acc[1]); acc[2] = MFMA(a, b2, acc[2]); acc[3] = MFMA(a, b3, acc[3]);
          a = an; b0 = c0; b1 = c1; b2 = c2; b3 = c3;
        }
      }
      slow(mhi + 16, eend);
    }
  }
#pragma unroll
  for (int i = 0; i < 4; ++i) {
    u16* dst = yT + ((size_t)tq[i] * 512 + c) * L + 1024 * tJ[i] + 32 * r + 4 * h;
#pragma unroll
    for (int g4 = 0; g4 < 4; ++g4) {
      u32x2 o; o[0] = pack2(acc[i][4 * g4], acc[i][4 * g4 + 1]); o[1] = pack2(acc[i][4 * g4 + 2], acc[i][4 * g4 + 3]);
      *(u32x2*)(dst + 8 * g4) = o;
    }
  }
}

DI void diff_post_item(const Params& P, int layer, float lam, float lam_init, const u16* __restrict__ dO, u16* __restrict__ ydf, int it) {
  const int tid = otid() & 255, lane = tid & 63, w = __builtin_amdgcn_readfirstlane(tid >> 6);
  const int u = it * 8 + w * 2 + (lane >> 5);
  const int i = lane & 31;
  const u32x2 a = *(const u32x2*)(dO + (size_t)u * 256 + 4 * i);
  const u32x2 b = *(const u32x2*)(dO + (size_t)u * 256 + 128 + 4 * i);
  float o[4];
  o[0] = bflo(a[0]) - lam * bflo(b[0]); o[1] = bfhi(a[0]) - lam * bfhi(b[0]);
  o[2] = bflo(a[1]) - lam * bflo(b[1]); o[3] = bfhi(a[1]) - lam * bfhi(b[1]);
  const float ss = half_sum(o[0] * o[0] + o[1] * o[1] + o[2] * o[2] + o[3] * o[3]);
  const float rs = rsqrtf(ss * (1.0f / 128.0f) + 1e-5f) * (1.0f - lam_init);
  const float* g = P.diff_subln + layer * 128 + 4 * i;
  u32x2 ov; ov[0] = pack2(o[0] * rs * g[0], o[1] * rs * g[1]); ov[1] = pack2(o[2] * rs * g[2], o[3] * rs * g[3]);
  *(u32x2*)(ydf + (size_t)u * 128 + 4 * i) = ov;
}
DI void hyena_post_item(const Params& P, int layer, const u16* __restrict__ p, int L, const u16* __restrict__ yT, const u16* __restrict__ zT,
                        int ct, int tt, u16* __restrict__ yhy, char* smem) {
  float* tile = (float*)smem;
  const int tid = otid() & 255;
  const int t0 = tt * 64; const int seq = t0 / L, tl0 = t0 - seq * L;
  __syncthreads();
  {
    const int tcol = tid & 63, c0 = tid >> 6;
#pragma unroll
    for (int i = 0; i < 16; ++i) {
      const int cc = c0 + 4 * i; const int c = ct * 64 + cc;
      const size_t gi = ((size_t)seq * 512 + c) * L + tl0 + tcol;
      tile[cc * 65 + tcol] = bf2f(yT[gi]) + bf2f(zT[gi]) * P.hy_skip[layer * 512 + c];
    }
  }
  __syncthreads();
  {
    const int col = tid & 63, r0 = tid >> 6; const int c = ct * 64 + col;
    const float* cw = P.hy_conv_w + layer * 3 * 1536; const float* cb = P.hy_conv_b + layer * 1536;
    const float w0 = cw[c], w1 = cw[1536 + c], w2 = cw[3072 + c], b0 = cb[c];
#pragma unroll
    for (int i = 0; i < 16; ++i) {
      const int row = r0 + 4 * i; const int tl = tl0 + row;
      const u16* pr = p + (size_t)(t0 + row) * INC + c;
      const float xm1 = (tl > 0) ? bf2f(pr[-INC]) : 0.f, x0 = bf2f(pr[0]), xp1 = (tl < L - 1) ? bf2f(pr[INC]) : 0.f;
      const float x0c = xm1 * w0 + x0 * w1 + xp1 * w2 + b0;
      yhy[(size_t)(t0 + row) * 512 + c] = f2bf(x0c * tile[col * 65 + row]);
    }
  }
}

__global__ void __launch_bounds__(512) fwd_megakernel(Params Parg) {
  cg::grid_group grid = cg::this_grid();
  extern __shared__ __attribute__((aligned(16))) char smem_dyn[];
  char* smem = smem_dyn + 16;
  uint4& xb_words = *(uint4*)smem_dyn;
  const int nb = gridDim.x, nb2 = nb * 2;
#define KPARAMS() const Params __attribute__((address_space(4)))* pp_ = (const Params __attribute__((address_space(4)))*)__builtin_amdgcn_kernarg_segment_ptr(); \
  asm volatile("" : "+s"(pp_)); const Params& P = *(const Params*)pp_; char* ws = P.ws
  if (threadIdx.x == 0) xb_words = make_uint4(0u, 0u, 0u, blockIdx.x);
  __syncthreads();
  XcdBarrier xb;
  { KPARAMS(); xb = xcd_barrier_post((unsigned*)(ws + O_BAR), (volatile LAS unsigned*)&xb_words); }

  for (int step = 0; step < 80; ++step) {
    const int layer = step / 40, ls = step - layer * 40;
    PHASE_IDS();
    KPARAMS();
    float* misc = (float*)(ws + O_MISC);
    u16* pbuf = (u16*)(ws + O_P); u16* hid = pbuf; u16* hn = (u16*)(ws + O_HN); u16* merged = hn;
    if (ls == 0) {
      u16* filt8 = (u16*)(ws + O_FILT8); u16* filt16 = (u16*)(ws + O_FILT16);
      const int n1 = 16 * 88, n2 = 44 * 16, n3 = 16 * 108, n4 = 3 * 8 * 16, n5 = 16 * 16;
      const int nfilt = 128 + 256;
      const int total = n1 + n2 + n3 + n4 + n5 + n1 + n2 + nfilt;
      for (int it = bid2; it < total; it += nb2) {
        int t = it;
        if (t < nfilt) {
          const bool big = t < 256;
          filter_item(P, layer, big ? 16384 : 8192, big ? t : t - 256, big ? filt16 : filt8, smg);
          continue;
        }
        t -= nfilt;
        const float* src; int K, N, kt, nt, ph = 0; u16* dst;
        if (t < n1) { src = P.ffn1_w_in + (size_t)layer * 1024 * 5632; K = 1024; N = 5632; dst = (u16*)(ws + O_F1IN); kt = t / 88; nt = t % 88; ph = 2816; }
        else if ((t -= n1) < n2) { src = P.ffn1_w_out + (size_t)layer * 2816 * 1024; K = 2816; N = 1024; dst = (u16*)(ws + O_F1OUT); kt = t / 16; nt = t % 16; }
        else if ((t -= n2) < n3) { src = P.w_in + (size_t)layer * 1024 * 6912; K = 1024; N = 6912; dst = (u16*)(ws + O_WIN); kt = t / 108; nt = t % 108; }
        else if ((t -= n3) < n4) { const int br = t / 128, tt = t % 128; src = P.w_branch + ((size_t)layer * 3 + br) * 512 * 1024; K = 512; N = 1024;
                                   dst = (u16*)(ws + O_WBR) + (size_t)br * 1024 * 512; kt = tt / 16; nt = tt % 16; }
        else if ((t -= n4) < n5) { src = P.w_out + (size_t)layer * 1024 * 1024; K = 1024; N = 1024; dst = (u16*)(ws + O_WOUT); kt = t / 16; nt = t % 16; }
        else if ((t -= n5) < n1) { src = P.ffn2_w_in + (size_t)layer * 1024 * 5632; K = 1024; N = 5632; dst = (u16*)(ws + O_F2IN); kt = t / 88; nt = t % 88; ph = 2816; }
        else { t -= n1; src = P.ffn2_w_out + (size_t)layer * 2816 * 1024; K = 2816; N = 1024; dst = (u16*)(ws + O_F2OUT); kt = t / 16; nt = t % 16; }
        convT_tile(src, K, N, dst, kt, nt, ph, smg);
      }
      if (bid == 0 && grp == 0) {
        const int tid = t_;
        if (tid < 2) {
          const float* lp = P.diff_lambda + tid * 256;
          float s1 = 0.f, s2 = 0.f;
          for (int i = 0; i < 64; ++i) { s1 += lp[i] * lp[64 + i]; s2 += lp[128 + i] * lp[192 + i]; }
          const float lam_init = 0.8f - 0.6f * expf(-0.3f * (float)tid);
          misc[tid] = expf(s1) - expf(s2) + lam_init;
        }
        for (int i = tid; i < 4 * 257; i += 256) {
          const int hh = i / 257, idx = i % 257; const int rel = idx - 128; const int n = rel < 0 ? -rel : rel;
          int b;
          if (n < 8) b = n; else { int lg = 8 + (int)(logf((float)n / 8.0f) / 2.772588722239781f * 8.0f); b = lg < 15 ? lg : 15; }
          if (rel > 0) b += 16;
          misc[64 + i] = P.rel_bias[b * 4 + hh] * LOG2E;
        }
      }
      if (step == 0) {
        grid.sync();
        if (threadIdx.x == 0) {
          unsigned* bar = (unsigned*)(ws + O_BAR); bool even = ((nb & 7) == 0);
          for (int j = 0; j < 16; ++j) { const unsigned c = xb_ld(&bar[XB_XCNT(j)]); if (c != ((j < 8) ? (unsigned)(nb >> 3) : 0u)) even = false; }
          volatile LAS unsigned* st = (volatile LAS unsigned*)&xb_words;
          if (even) st[3] = st[2] * 8u + xb.x;
        }
        __syncthreads();
      } else GSYNC();
      continue;
    }
    const int cs = ls - 1; const int ch = cs / 13, st = cs - ch * 13;
    const int nseq = (ch < 2) ? 2 : 1, L = (ch < 2) ? 8192 : 16384;
    const float* xin0 = (ch < 2) ? (P.x_prompt + (size_t)ch * TCH * DM) : P.x_sample;
    float* xres = P.out + (size_t)ch * TCH * DM;
    const float* xcur = (layer == 0) ? xin0 : xres;
    for (int rp_ = 0; rp_ <= ((REPMASK >> st) & 1); ++rp_) {
    if (st == 0 || st == 3 || st == 10) {
      const float* src = (st == 0) ? xcur : xres;
      const float* gn = ((st == 0) ? P.ffn1_norm : (st == 3 ? P.mix_norm : P.ffn2_norm)) + layer * DM;
      for (int it = bid2; it < TCH / 4; it += nb2) { const int row = it * 4 + w; norm_row_bf16(src + (size_t)row * DM, gn, hn + (size_t)row * DM, lane); }
    } else if (st == 1 || st == 2 || st == 4 || st == 8 || st == 9 || st == 11 || st == 12) {
      EpiAny E{}; const u16* A; const u16* Bt; int N, K; int nrep = 1;
      if (st == 1 || st == 11) { A = hn; Bt = (u16*)(ws + (st == 1 ? O_F1IN : O_F2IN)); N = 5632; K = DM; E.mode = EPI_SWIGLU; E.perm = true; E.O = hid; E.ldo = DFF; }
      else if (st == 2 || st == 12) { A = hid; Bt = (u16*)(ws + (st == 2 ? O_F1OUT : O_F2OUT)); N = DM; K = DFF; E.mode = EPI_RESID; E.perm = false;
                                      E.xin = (st == 2) ? xcur : xres; E.xout = xres; E.scale = 0.5f; }
      else if (st == 4) { A = hn; Bt = (u16*)(ws + O_WIN); N = INC; K = DM; E.mode = EPI_PROJ; E.perm = true; E.O = pbuf; }
      else if (st == 8) { A = (u16*)(ws + O_YHY); Bt = (u16*)(ws + O_WBR); N = DM; K = 512; E.mode = EPI_MERGE; E.perm = false; E.gate = pbuf; E.macc = (float*)(ws + O_ZT); E.O = merged; nrep = 3; }
      else { A = merged; Bt = (u16*)(ws + O_WOUT); N = DM; K = DM; E.mode = EPI_RESID; E.perm = false; E.xin = xres; E.xout = xres; E.scale = 1.0f; }
      for (int rp = 0; rp < nrep; ++rp) {
        E.br = rp;
        pg8::Gemm gg{A + (size_t)rp * TCH * 512, Bt + (size_t)rp * 1024 * 512, TCH, N, K};
        pg8::StaticOrder S; S.init(TCH, N, nb, bid);
        pg8::gemm_phase<EpiAny, pg8::StaticOrder, false>((PG8_LAS unsigned char*)smem, gg, S, E, nullptr);
      }
    } else if (st == 5) {
      const int nqk = TCH * 10 / 8, ntr = 256 * 18;
      for (int it = bid2; it < nqk + ntr; it += nb2) {
        if (it < nqk) { qk_prep_item(P, layer, pbuf, L, it); continue; }
        const int t = it - nqk; const int tt = t / 18, cc = t % 18;
        const int kind = (cc < 2) ? 0 : (cc < 10 ? 1 : 2);
        const int ct = (cc < 2) ? cc : (cc < 10 ? cc - 2 : cc - 10);
        u16* dst = (u16*)(ws + (kind == 0 ? O_VTG : (kind == 1 ? O_VTD : O_ZT)));
        transpose_item(P, layer, pbuf, L, kind, ct, tt, dst, smg);
      }
    } else if (st == 6) {
      u16* zT = (u16*)(ws + O_ZT); u16* yT = (u16*)(ws + O_YT); u16* dO = (u16*)(ws + O_DIFFO);
      u16* vtg = (u16*)(ws + O_VTG); u16* vtd = (u16*)(ws + O_VTD); u16* ygq = (u16*)(ws + O_YGQ);
      const u16* filt = (u16*)(ws + ((ch < 2) ? O_FILT8 : O_FILT16));
      const int nqt = L / 128;
      const int xcd = bid & 7, nxu = (nb >> 3) * 2, u0 = (bid >> 3) * 2, nitem = nseq * nqt;
      for (int e0 = u0; e0 < nitem; e0 += nxu) {
        const int e = e0 + grp;
        const int seq = e / nqt, qt = e - seq * nqt;
        const int hh = xcd >> 1, cc = xcd & 1;
        const size_t tb = (size_t)seq * L;
        const u16* Qd = pbuf + tb * INC + OFF_DQ + xcd * 64; const u16* Kd = pbuf + tb * INC + OFF_DK + xcd * 64;
        const u16* Vd = vtd + ((size_t)seq * 512 + hh * 128) * L; u16* Od = dO + tb * 1024 + (hh * 2 + cc) * 128;
        if (grp) attn_tile<128, true, true>(Qd, Kd, Vd, L, Od, 1024, qt * 128, misc + 64 + hh * 257, smg);
        else attn_tile<128, true, false>(Qd, Kd, Vd, L, Od, 1024, qt * 128, misc + 64 + hh * 257, smg);
      }
      for (int e0 = u0; e0 < nitem; e0 += nxu) {
        const int e = e0 + grp;
        const int seq = e / nqt, qt = e - seq * nqt;
        const int kvh = xcd >> 2;
        const size_t tb = (size_t)seq * L;
        const u16* Qd = pbuf + tb * INC + OFF_GQ + xcd * 64; const u16* Kd = pbuf + tb * INC + OFF_GK + kvh * 64;
        const u16* Vd = vtg + ((size_t)seq * 128 + kvh * 64) * L; u16* Od = ygq + tb * 512 + xcd * 64;
        if (grp) attn_tile<64, false, true>(Qd, Kd, Vd, L, Od, 512, qt * 128, nullptr, smg);
        else attn_tile<64, false, false>(Qd, Kd, Vd, L, Od, 512, qt * 128, nullptr, smg);
      }
      for (int c = bid2; c < 512; c += nb2) hyena_item(c, filt, zT, yT, nseq, L, smg);
    } else {
      u16* zT = (u16*)(ws + O_ZT); u16* yT = (u16*)(ws + O_YT); u16* dO = (u16*)(ws + O_DIFFO);
      u16* yhy = (u16*)(ws + O_YHY); u16* ydf = (u16*)(ws + O_YDF);
      const float lam = misc[layer];
      const float lam_init = 0.8f - 0.6f * expf(-0.3f * (float)layer);
      const int ndp = TCH * 4 / 8, nhp = 256 * 8;
      for (int it = bid2; it < ndp + nhp; it += nb2) {
        if (it < ndp) diff_post_item(P, layer, lam, lam_init, dO, ydf, it);
        else { const int t = it - ndp; hyena_post_item(P, layer, pbuf, L, yT, zT, t % 8, t / 8, yhy, smg); }
      }
    }
    }
    GSYNC();
  }
  { PHASE_IDS(); KPARAMS(); (void)ws;
    for (int it = bid2; it < NTOK / 4; it += nb2) { const int row = it * 4 + w; norm_row_f32_inplace(P.out + (size_t)row * DM, P.final_norm, lane); }
  }
}

extern "C" void kernel_launch(void* const* d_in, const int* in_sizes, int n_in, void* d_out, int out_size, void* d_ws, size_t ws_size,
                              hipStream_t stream) {
  static int grid_blocks = 0;
  if (!grid_blocks) {
    int dev = 0, cus = 0, per_cu = 0;
    (void)hipGetDevice(&dev);
    (void)hipDeviceGetAttribute(&cus, hipDeviceAttributeMultiprocessorCount, dev);
    (void)hipFuncSetAttribute((const void*)fwd_megakernel, hipFuncAttributeMaxDynamicSharedMemorySize, SMEM_BYTES + 16);
    (void)hipOccupancyMaxActiveBlocksPerMultiprocessor(&per_cu, fwd_megakernel, 512, SMEM_BYTES + 16);
    if (per_cu < 1) per_cu = 1;
    if (per_cu > 1) per_cu = 1;
    grid_blocks = cus * per_cu;
  }
  Params p{};
  const float* const* in = (const float* const*)d_in;
  p.x_prompt = in[0]; p.x_sample = in[1]; p.ffn1_norm = in[2]; p.ffn1_w_in = in[3]; p.ffn1_w_out = in[4]; p.mix_norm = in[5]; p.w_in = in[6];
  p.hy_conv_w = in[7]; p.hy_conv_b = in[8]; p.hy_w1 = in[9]; p.hy_b1 = in[10]; p.hy_w2 = in[11]; p.hy_b2 = in[12]; p.hy_w3 = in[13];
  p.hy_freq = in[14]; p.hy_skip = in[15]; p.gqa_q_norm = in[16]; p.gqa_k_norm = in[17]; p.diff_lambda = in[18]; p.diff_subln = in[19];
  p.rel_bias = in[20]; p.w_branch = in[21]; p.w_out = in[22]; p.ffn2_norm = in[23]; p.ffn2_w_in = in[24]; p.ffn2_w_out = in[25]; p.final_norm = in[26];
  p.out = (float*)d_out; p.ws = (char*)d_ws;
  void* args[] = {&p};
  (void)hipMemsetAsync((char*)d_ws + O_BAR, 0, XCD_BAR_WORDS * 4, stream);
  hipError_t e = hipLaunchCooperativeKernel((void*)fwd_megakernel, dim3(grid_blocks), dim3(512), args, SMEM_BYTES + 16, stream);
  if (e != hipSuccess) fprintf(stderr, "cooperative launch failed: %s (grid %d)\n", hipGetErrorString(e), grid_blocks);
}
```

```cpp
#include <hip/hip_runtime.h>
#include <hip/hip_cooperative_groups.h>
#include <stdint.h>
#include <cstdio>
namespace cg = cooperative_groups;

typedef unsigned short u16;
typedef __attribute__((ext_vector_type(8))) short bf16x8;
typedef __attribute__((ext_vector_type(16))) float f32x16;
typedef __attribute__((ext_vector_type(4))) float f32x4;
typedef __attribute__((ext_vector_type(4))) unsigned u32x4;
typedef __attribute__((ext_vector_type(2))) unsigned u32x2;
typedef __attribute__((ext_vector_type(2))) __bf16 bf2_t;
typedef __attribute__((ext_vector_type(2))) float f2_t;
#define DI __device__ __forceinline__
#define MFMA(a, b, c) __builtin_amdgcn_mfma_f32_32x32x16_bf16((a), (b), (c), 0, 0, 0)

constexpr int DM = 1024, DFF = 2816, INC = 6912, TCH = 16384, NTOK = 49152;
constexpr int OFF_GQ = 1536, OFF_GK = 2048, OFF_GV = 2176, OFF_DQ = 2304, OFF_DK = 2816, OFF_DV = 3328, OFF_GATE = 3840;
constexpr float LOG2E = 1.4426950408889634f;

constexpr size_t SZ_F1IN = (size_t)5632 * 1024 * 2, SZ_F1OUT = (size_t)1024 * 2816 * 2, SZ_WIN = (size_t)6912 * 1024 * 2,
                 SZ_WBR = (size_t)3 * 1024 * 512 * 2, SZ_WOUT = (size_t)1024 * 1024 * 2;
constexpr size_t O_F1IN = 0, O_F1OUT = O_F1IN + SZ_F1IN, O_WIN = O_F1OUT + SZ_F1OUT, O_WBR = O_WIN + SZ_WIN, O_WOUT = O_WBR + SZ_WBR,
                 O_F2IN = O_WOUT + SZ_WOUT, O_F2OUT = O_F2IN + SZ_F1IN, O_FILT8 = O_F2OUT + SZ_F1OUT,
                 O_FILT16 = O_FILT8 + (size_t)512 * 16384 * 2, O_MISC = O_FILT16 + (size_t)512 * 32768 * 2,
                 O_P = O_MISC + 65536, O_HN = O_P + (size_t)TCH * INC * 2, O_ZT = O_HN + (size_t)TCH * 1024 * 2,
                 O_YT = O_ZT + (size_t)TCH * 512 * 2, O_DIFFO = O_YT + (size_t)TCH * 512 * 2, O_VTG = O_DIFFO + (size_t)TCH * 1024 * 2,
                 O_VTD = O_VTG + (size_t)TCH * 128 * 2, O_YHY = O_VTD + (size_t)TCH * 512 * 2, O_YGQ = O_YHY + (size_t)TCH * 512 * 2,
                 O_YDF = O_YGQ + (size_t)TCH * 512 * 2, O_END = O_YDF + (size_t)TCH * 512 * 2;
static_assert(O_END <= (size_t)536870912, "workspace overflow");
constexpr int SMEM_BYTES = 151552;
constexpr int GRP_LDS = 75776;
#define REPMASK 0
#define REP_SYNC 1
#define PHASE_IDS() const int t_ = otid(); const int bid = __builtin_amdgcn_readfirstlane(((volatile LAS unsigned*)&xb_words)[3]); const int lane = t_ & 63; const int grp = __builtin_amdgcn_readfirstlane(t_ >> 8); \
  const int w = __builtin_amdgcn_readfirstlane((t_ >> 6) & 3); const int bid2 = bid * 2 + grp; char* smg = smem + grp * GRP_LDS; \
  const int vb = (bid & 7) * (nb >> 3) + (bid >> 3); (void)lane; (void)w; (void)bid2; (void)smg; (void)vb
#define GSYNC() do { for (int rs_ = 0; rs_ < REP_SYNC; ++rs_) xcd_barrier(xb); } while (0)


#define XB_TMO      128
#define XB_XCNT(j)  (256  + 64 * (j))
#define XB_XSUB(j)  (1280 + 64 * (j))
#define XB_XGEN(j)  (2304 + 64 * (j))
#define XB_TOP      3328
#define XB_TOPGEN   3392
#define XCD_BAR_WORDS 3456
#define XB_SPIN_CAP (1u << 21)
#define LAS __attribute__((address_space(3)))
DI unsigned xb_ld(unsigned* p)              { return __hip_atomic_load(p, __ATOMIC_RELAXED, __HIP_MEMORY_SCOPE_AGENT); }
DI unsigned xb_add(unsigned* p, unsigned v) { return __hip_atomic_fetch_add(p, v, __ATOMIC_RELAXED, __HIP_MEMORY_SCOPE_AGENT); }
DI unsigned xb_xcc_id() { return (unsigned)__builtin_amdgcn_s_getreg((3 << 11) | 20) & 0xFu; }
#define XB_SPIN(cond, bar) do { unsigned _sp = 0; while (cond) { __builtin_amdgcn_s_sleep(1); \
    if ((++_sp & 255u) == 0u) { if (xb_ld(&(bar)[XB_TMO])) break; if (_sp > XB_SPIN_CAP) { atomicAdd(&(bar)[XB_TMO], 1u); break; } } } } while (0)
struct XcdBarrier { unsigned* bar; unsigned x; volatile LAS unsigned* st; };
DI XcdBarrier xcd_barrier_post(unsigned* bar, volatile LAS unsigned* st) {
  XcdBarrier b; b.bar = bar; b.x = xb_xcc_id(); b.st = st;
  if (threadIdx.x == 0) { const unsigned rank = xb_add(&bar[XB_XCNT(b.x)], 1u); st[2] = rank; }
  return b;
}
DI void xcd_barrier_complete(unsigned* bar, unsigned x, unsigned& nloc, unsigned& nx) {
  const unsigned G = gridDim.x * gridDim.y * gridDim.z;
  unsigned sum, cnt, mine, sp = 0u;
  for (;;) {
    sum = 0u; cnt = 0u; mine = 0u;
#pragma unroll
    for (unsigned j = 0; j < 16; ++j) { const unsigned c = xb_ld(&bar[XB_XCNT(j)]); sum += c; cnt += (c > 0u) ? 1u : 0u; mine = (j == x) ? c : mine; }
    if (sum == G) break;
    __builtin_amdgcn_s_sleep(1);
    if ((++sp & 255u) == 0u) { if (xb_ld(&bar[XB_TMO])) break; if (sp > XB_SPIN_CAP) { atomicAdd(&bar[XB_TMO], 1u); break; } }
  }
  nloc = mine > 0u ? mine : 1u; nx = cnt > 0u ? cnt : 1u;
}
DI void xcd_barrier(const XcdBarrier& b) {
  asm volatile("s_waitcnt vmcnt(0)" ::: "memory");
  __syncthreads();
  if (threadIdx.x == 0) {
    unsigned* bar = b.bar;
    __builtin_amdgcn_s_waitcnt(0);
    unsigned nloc = b.st[0], nx = b.st[1];
    if (nloc == 0u) { xcd_barrier_complete(bar, b.x, nloc, nx); b.st[0] = nloc; b.st[1] = nx; }
    const unsigned old = xb_add(&bar[XB_XSUB(b.x)], 1u);
    const unsigned gen = old / nloc;
    if (old + 1u == (gen + 1u) * nloc) {
      __builtin_amdgcn_fence(__ATOMIC_RELEASE, "agent");
      asm volatile("s_waitcnt vmcnt(0)" ::: "memory");
      const unsigned og = xb_add(&bar[XB_TOP], 1u);
      const unsigned tg = og / nx;
      if (og + 1u == (tg + 1u) * nx) xb_add(&bar[XB_TOPGEN], 1u);
      else XB_SPIN(xb_ld(&bar[XB_TOPGEN]) == tg, bar);
      __builtin_amdgcn_fence(__ATOMIC_ACQUIRE, "agent");
      xb_add(&bar[XB_XGEN(b.x)], 1u);
      asm volatile("s_waitcnt vmcnt(0)" ::: "memory");
    } else {
      XB_SPIN(xb_ld(&bar[XB_XGEN(b.x)]) == gen, bar);
      __builtin_amdgcn_fence(__ATOMIC_ACQUIRE, "agent");
      asm volatile("s_waitcnt vmcnt(0)" ::: "memory");
    }
  }
  __syncthreads();
}
constexpr size_t O_BAR = O_MISC + 16384;

struct Params {
  const float* x_prompt; const float* x_sample;
  const float* ffn1_norm; const float* ffn1_w_in; const float* ffn1_w_out; const float* mix_norm; const float* w_in;
  const float* hy_conv_w; const float* hy_conv_b; const float* hy_w1; const float* hy_b1; const float* hy_w2; const float* hy_b2;
  const float* hy_w3; const float* hy_freq; const float* hy_skip;
  const float* gqa_q_norm; const float* gqa_k_norm; const float* diff_lambda; const float* diff_subln; const float* rel_bias;
  const float* w_branch; const float* w_out; const float* ffn2_norm; const float* ffn2_w_in; const float* ffn2_w_out; const float* final_norm;
  float* out; char* ws;
};

DI unsigned pack2(float a, float b) { f2_t v = {a, b}; bf2_t r = __builtin_convertvector(v, bf2_t); return __builtin_bit_cast(unsigned, r); }
DI u16 f2bf(float a) { return (u16)(pack2(a, 0.f) & 0xffffu); }
DI float bf2f(u16 v) { return __uint_as_float(((unsigned)v) << 16); }
DI float bflo(unsigned v) { return __uint_as_float(v << 16); }
DI float bfhi(unsigned v) { return __uint_as_float(v & 0xffff0000u); }
DI int otid() { int t = threadIdx.x; asm volatile("" : "+v"(t)); return t; }
DI int crow(int reg, int h) { return (reg & 3) + 8 * (reg >> 2) + 4 * h; }
DI float wave_sum(float v) {
  v += __shfl_xor(v, 32); v += __shfl_xor(v, 16); v += __shfl_xor(v, 8); v += __shfl_xor(v, 4); v += __shfl_xor(v, 2); v += __shfl_xor(v, 1);
  return v;
}
DI float half_sum(float v) {
  v += __shfl_xor(v, 16); v += __shfl_xor(v, 8); v += __shfl_xor(v, 4); v += __shfl_xor(v, 2); v += __shfl_xor(v, 1);
  return v;
}

DI void convT_tile(const float* __restrict__ src, int K, int N, u16* __restrict__ dst, int kt, int nt, int perm_half, char* smem) {
  float* t = (float*)smem;
  const int tid = otid() & 255;
  __syncthreads();
  {
    const int col = tid & 63, r0 = tid >> 6;
#pragma unroll
    for (int i = 0; i < 16; ++i) { int row = r0 + 4 * i; t[row * 65 + col] = src[(size_t)(kt * 64 + row) * N + nt * 64 + col]; }
  }
  __syncthreads();
  {
    const int nl = tid >> 2, kq = tid & 3;
    int n = nt * 64 + nl;
    if (perm_half > 0) { if (n < perm_half) n = (n >> 7) * 256 + (n & 127); else { int j = n - perm_half; n = (j >> 7) * 256 + 128 + (j & 127); } }
    u32x4 o0, o1;
#pragma unroll
    for (int i = 0; i < 4; ++i) {
      o0[i] = pack2(t[(kq * 16 + 2 * i) * 65 + nl], t[(kq * 16 + 2 * i + 1) * 65 + nl]);
      o1[i] = pack2(t[(kq * 16 + 8 + 2 * i) * 65 + nl], t[(kq * 16 + 8 + 2 * i + 1) * 65 + nl]);
    }
    u16* d = dst + (size_t)n * K + kt * 64 + kq * 16;
    *(u32x4*)d = o0; *(u32x4*)(d + 8) = o1;
  }
}

DI void filter_item(const Params& P, int layer, int L, int tb, u16* __restrict__ G, char* smem) {
  float* h1 = (float*)smem;
  float* h2 = h1 + 64 * 65;
  const int tid = otid() & 255, lane = tid & 63, w = __builtin_amdgcn_readfirstlane(tid >> 6);
  const float* w1 = P.hy_w1 + layer * 33 * 64; const float* b1 = P.hy_b1 + layer * 64;
  const float* w2 = P.hy_w2 + layer * 64 * 64; const float* b2 = P.hy_b2 + layer * 64;
  const float* w3 = P.hy_w3 + layer * 64 * 1024; const float* fr = P.hy_freq + layer * 64;
  const int t = tb * 64 + lane;
  const float tl = (float)t / (float)(L - 1);
  __syncthreads();
  {
    float a[16];
#pragma unroll
    for (int u = 0; u < 16; ++u) a[u] = b1[w * 16 + u] + tl * w1[w * 16 + u];
    const float base = (float)(2.0 * 3.14159265358979323846 / (double)L) * (float)t;
    for (int b = 0; b < 16; ++b) {
      const float band = 1e-4f + (float)b * ((15.0f - 1e-4f) / 15.0f);
      const float ang = base * band;
      const float cs = cosf(ang), sn = -sinf(ang);
#pragma unroll
      for (int u = 0; u < 16; ++u) a[u] += cs * w1[(1 + b) * 64 + w * 16 + u] + sn * w1[(17 + b) * 64 + w * 16 + u];
    }
#pragma unroll
    for (int u = 0; u < 16; ++u) h1[lane * 65 + w * 16 + u] = sinf(fr[w * 16 + u] * a[u]);
  }
  __syncthreads();
  {
    float a[16];
#pragma unroll
    for (int u = 0; u < 16; ++u) a[u] = b2[w * 16 + u];
    for (int k = 0; k < 64; ++k) {
      const float hv = h1[lane * 65 + k];
#pragma unroll
      for (int u = 0; u < 16; ++u) a[u] += hv * w2[k * 64 + w * 16 + u];
    }
#pragma unroll
    for (int u = 0; u < 16; ++u) h2[lane * 65 + w * 16 + u] = sinf(fr[w * 16 + u] * a[u]);
  }
  __syncthreads();
  const float min_decay = -3.0701134573253946f, max_decay = -15.350567286626973f;
  for (int og = 0; og < 64; ++og) {
    const int o = w * 256 + og * 4;
    float a0 = 0.f, a1 = 0.f, a2 = 0.f, a3 = 0.f;
#pragma unroll 4
    for (int k = 0; k < 64; ++k) {
      const float hv = h2[lane * 65 + k];
      const f32x4 wv = *(const f32x4*)(w3 + k * 1024 + o);
      a0 += hv * wv[0]; a1 += hv * wv[1]; a2 += hv * wv[2]; a3 += hv * wv[3];
    }
    float av[4] = {a0, a1, a2, a3};
#pragma unroll
    for (int q = 0; q < 4; ++q) {
      const int oo = o + q; const int ch = oo & 511;
      const float delta = min_decay + (float)ch * ((max_decay - min_decay) / 511.0f);
      const float val = av[q] * expf(-tl * fabsf(delta));
      u16* Gc = G + (size_t)ch * (2 * L);
      if (oo < 512) Gc[L - t] = f2bf(val);
      else { if (t >= 1) Gc[L + t] = f2bf(val); else Gc[0] = 0; }
    }
  }
}

DI void norm_row_bf16(const float* __restrict__ x, const float* __restrict__ g, u16* __restrict__ out, int lane) {
  f32x4 v[4]; float ss = 0.f;
#pragma unroll
  for (int i = 0; i < 4; ++i) { v[i] = *(const f32x4*)(x + lane * 4 + 256 * i); ss += v[i][0] * v[i][0] + v[i][1] * v[i][1] + v[i][2] * v[i][2] + v[i][3] * v[i][3]; }
  ss = wave_sum(ss);
  const float rs = rsqrtf(ss * (1.0f / 1024.0f) + 1e-6f);
#pragma unroll
  for (int i = 0; i < 4; ++i) {
    const f32x4 gg = *(const f32x4*)(g + lane * 4 + 256 * i);
    u32x2 o; o[0] = pack2(v[i][0] * rs * gg[0], v[i][1] * rs * gg[1]); o[1] = pack2(v[i][2] * rs * gg[2], v[i][3] * rs * gg[3]);
    *(u32x2*)(out + lane * 4 + 256 * i) = o;
  }
}
DI void norm_row_f32_inplace(float* __restrict__ x, const float* __restrict__ g, int lane) {
  f32x4 v[4]; float ss = 0.f;
#pragma unroll
  for (int i = 0; i < 4; ++i) { v[i] = *(const f32x4*)(x + lane * 4 + 256 * i); ss += v[i][0] * v[i][0] + v[i][1] * v[i][1] + v[i][2] * v[i][2] + v[i][3] * v[i][3]; }
  ss = wave_sum(ss);
  const float rs = rsqrtf(ss * (1.0f / 1024.0f) + 1e-6f);
#pragma unroll
  for (int i = 0; i < 4; ++i) {
    const f32x4 gg = *(const f32x4*)(g + lane * 4 + 256 * i);
    f32x4 o; o[0] = v[i][0] * rs * gg[0]; o[1] = v[i][1] * rs * gg[1]; o[2] = v[i][2] * rs * gg[2]; o[3] = v[i][3] * rs * gg[3];
    *(f32x4*)(x + lane * 4 + 256 * i) = o;
  }
}

namespace pg8 {
#define PG8_LAS __attribute__((address_space(3)))
typedef unsigned short bf16_t;
typedef short bf16x8 __attribute__((ext_vector_type(8)));
typedef float f32x4 __attribute__((ext_vector_type(4)));
typedef unsigned u32x4 __attribute__((ext_vector_type(4)));
constexpr int BM = 256, BK = 64, HALF = 128, HTB = HALF * BK * 2  , STAGE_BYTES = 8 * HTB, NXCD = 8, WGM = 8;

__host__ __device__ __forceinline__ int lds_byte(int r, int c) { const int st = (r >> 4) * 2 + (c >> 5), rr = r & 15, cc = c & 31, ob = rr * 64 + cc * 2; return st * 1024 + (ob ^ (((ob >> 9) & 1) << 5)); }
__host__ __device__ __forceinline__ void stage_rc(int b, int& R, int& C) { const int st = b / 1024, sb = b % 1024, swz = sb ^ (((sb >> 9) & 1) << 5); R = (st >> 1) * 16 + swz / 64; C = (st & 1) * 32 + (swz % 64) / 2; }
__host__ __device__ __forceinline__ int perm32(int rho) { const int n = rho >> 4, i = rho & 15; return 8 * (i >> 2) + 4 * n + (i & 3); }

struct Unit { int pm, pn; };
struct Gemm { const bf16_t* A; const bf16_t* Bt; int M, N, K; };

struct StaticOrder {
    int nM, nN, nwg, G, c;
    __host__ __device__ void init(int M, int N, int G_, int c_) { nM = M / BM; nN = N / BM; nwg = nM * nN; G = G_; c = c_; }
    __host__ __device__ bool next(int i, Unit& u) const {
        const long L = (long)i * G + c; if (L >= nwg) return false;
        int wgid = (int)L; { const int q = nwg / NXCD, r = nwg % NXCD, xcd = wgid % NXCD, off = wgid / NXCD; wgid = (xcd < r ? xcd * (q + 1) : r * (q + 1) + (xcd - r) * q) + off; }
        const int nig = WGM * nN, gid = wgid / nig, fm = gid * WGM, gsz = (nM - fm) < WGM ? (nM - fm) : WGM;
        u.pm = fm + ((wgid % nig) % gsz); u.pn = (wgid % nig) / gsz; return true;
    }
    __device__ __forceinline__ void a_ready(const Unit&) const {}
    __device__ __forceinline__ void done(const Unit&) const {}
};

template <class Epi, class Sched, bool STAMP = false>
__device__ __forceinline__ void gemm_phase(PG8_LAS unsigned char* lds, const Gemm g, const Sched& S, const Epi& E, unsigned long long* stamps) {
    const int tid = otid(), wid = __builtin_amdgcn_readfirstlane(tid >> 6), lane = tid & 63, wr = wid >> 2, wc = wid & 3, fr = lane & 15, fq = lane >> 4;
    const int K = g.K, nt = K / BK;
    int ts_lo = 0, ts_hi = 0, nts = 0; const unsigned long long rt_entry = STAMP ? (unsigned long long)wall_clock64() : 0ull;
#define PG8_STAMP() do { if (STAMP && wid == 0 && nts < 64) { const unsigned long long _c = (unsigned long long)clock64(); \
        ts_lo = (lane == nts) ? (int)(unsigned)_c : ts_lo; ts_hi = (lane == nts) ? (int)(unsigned)(_c >> 32) : ts_hi; ++nts; } } while (0)
    PG8_STAMP();
    unsigned voffA[2], voffB[2];
#pragma unroll
    for (int i = 0; i < 2; ++i) { int R, C; stage_rc(tid * 16 + i * 8192, R, C); const int Rb = E.perm ? ((R & ~31) + perm32(R & 31)) : R;
        voffA[i] = (unsigned)(R * K + C) * 2u; voffB[i] = (unsigned)(Rb * K + C) * 2u; }
    const size_t kstep = (size_t)(BK * 2);
    const size_t hstep = (size_t)HALF * K * 2;
    const size_t tstep = 2 * hstep;
    const unsigned ldsw = (unsigned)wid * 1024u;
    const int aoff = lds_byte(wr * 64 + fr, fq * 8), boff = lds_byte(wc * 32 + fr, fq * 8);
#define PG8_SA(b, h) (((b) * 2 + (h)) * HTB)
#define PG8_SB(b, h) ((4 + (b) * 2 + (h)) * HTB)
#define PG8_STAGE(bufoff, gbase, voff) do { _Pragma("unroll") for (int _i = 0; _i < 2; ++_i) \
        __builtin_amdgcn_global_load_lds((const unsigned*)((const char*)(gbase) + (voff)[_i]), (PG8_LAS unsigned*)(lds + (bufoff) + ldsw + _i * 8192), 16, 0, 0); } while (0)
#define PG8_LDA(dst, b, h) do { _Pragma("unroll") for (int m = 0; m < 4; ++m) _Pragma("unroll") for (int k = 0; k < 2; ++k) dst[m][k] = *(const PG8_LAS bf16x8*)(lds + PG8_SA(b, h) + aoff + m * 2048 + k * 1024); } while (0)
#define PG8_LDB(dst, b, h) do { _Pragma("unroll") for (int n = 0; n < 2; ++n) _Pragma("unroll") for (int k = 0; k < 2; ++k) dst[n][k] = *(const PG8_LAS bf16x8*)(lds + PG8_SB(b, h) + boff + n * 2048 + k * 1024); } while (0)
#define PG8_MMA(ai, bj, At, Bt) do { __builtin_amdgcn_s_setprio(1); _Pragma("unroll") for (int m = 0; m < 4; ++m) _Pragma("unroll") for (int n = 0; n < 2; ++n) _Pragma("unroll") for (int k = 0; k < 2; ++k) \
        acc[ai][bj][m][n] = __builtin_amdgcn_mfma_f32_16x16x32_bf16(Bt[n][k], At[m][k], acc[ai][bj][m][n], 0, 0, 0); __builtin_amdgcn_s_setprio(0); } while (0)
#define PG8_WAIT_V(n) asm volatile("s_waitcnt vmcnt(" #n ")" ::: "memory")
#define PG8_WAIT_L(n) asm volatile("s_waitcnt lgkmcnt(" #n ")" ::: "memory")
#define PG8_BAR __builtin_amdgcn_s_barrier()
#define PG8_SCHED __builtin_amdgcn_sched_barrier(0)
    Unit cur, nxt; int ui = 0;
    if (!S.next(0, cur)) return;
    f32x4 acc[2][2][4][2];
#pragma unroll
    for (int a = 0; a < 2; ++a)
#pragma unroll
        for (int b = 0; b < 2; ++b)
#pragma unroll
            for (int m = 0; m < 4; ++m)
#pragma unroll
                for (int n = 0; n < 2; ++n) acc[a][b][m][n] = (f32x4){0.f, 0.f, 0.f, 0.f};
    bf16x8 At[4][2], B0[2][2], B1[2][2];
    const char* cA = (const char*)g.A + (size_t)cur.pm * tstep; const char* cB = (const char*)g.Bt + (size_t)cur.pn * tstep;
    S.a_ready(cur);
    PG8_STAGE(PG8_SB(0, 0), cB, voffB); PG8_STAGE(PG8_SA(0, 0), cA, voffA); PG8_STAGE(PG8_SB(0, 1), cB + hstep, voffB); PG8_STAGE(PG8_SA(0, 1), cA + hstep, voffA);
    if (wr == 1) PG8_BAR;
    PG8_WAIT_V(4); PG8_BAR;
    PG8_STAGE(PG8_SB(1, 0), cB + kstep, voffB); PG8_STAGE(PG8_SA(1, 0), cA + kstep, voffA); PG8_STAGE(PG8_SB(1, 1), cB + hstep + kstep, voffB);
    PG8_WAIT_V(6); PG8_BAR;
    PG8_STAMP();
    for (;;) {
        const bool has_next = S.next(ui + 1, nxt);
        const char* nA = has_next ? (const char*)g.A + (size_t)nxt.pm * tstep : cA; const char* nB = has_next ? (const char*)g.Bt + (size_t)nxt.pn * tstep : cB;
        for (int t = 0; t < nt; t += 2) {
            const bool last = (t == nt - 2);
            const char* a1 = cA + (size_t)(t + 1) * kstep;
            const char* a2 = last ? nA : cA + (size_t)(t + 2) * kstep; const char* b2 = last ? nB : cB + (size_t)(t + 2) * kstep;
            const char* a3 = a2 + kstep; const char* b3 = b2 + kstep;
            if (last && has_next) S.a_ready(nxt);
            PG8_LDB(B0, 0, 0); PG8_SCHED; PG8_LDA(At, 0, 0); PG8_STAGE(PG8_SA(1, 1), a1 + hstep, voffA);
            PG8_WAIT_L(8); PG8_BAR; PG8_WAIT_L(0); PG8_MMA(0, 0, At, B0); PG8_BAR; PG8_SCHED;
            PG8_LDB(B1, 0, 1); PG8_STAGE(PG8_SB(0, 0), b2, voffB);
            PG8_BAR; PG8_WAIT_L(0); PG8_MMA(0, 1, At, B1); PG8_BAR;
            PG8_LDA(At, 0, 1); PG8_STAGE(PG8_SA(0, 0), a2, voffA);
            PG8_BAR; PG8_WAIT_L(0); PG8_MMA(1, 0, At, B0); PG8_BAR; PG8_SCHED;
            PG8_STAGE(PG8_SB(0, 1), b2 + hstep, voffB);
            PG8_WAIT_V(6); PG8_BAR; PG8_MMA(1, 1, At, B1); PG8_BAR;
            PG8_LDB(B0, 1, 0); PG8_SCHED; PG8_LDA(At, 1, 0); PG8_STAGE(PG8_SA(0, 1), a2 + hstep, voffA);
            PG8_WAIT_L(8); PG8_BAR; PG8_WAIT_L(0); PG8_MMA(0, 0, At, B0); PG8_BAR; PG8_SCHED;
            PG8_LDB(B1, 1, 1); PG8_STAGE(PG8_SB(1, 0), b3, voffB);
            PG8_BAR; PG8_WAIT_L(0); PG8_MMA(0, 1, At, B1); PG8_BAR;
            PG8_LDA(At, 1, 1); PG8_STAGE(PG8_SA(1, 0), a3, voffA);
            PG8_BAR; PG8_WAIT_L(0); PG8_MMA(1, 0, At, B0); PG8_BAR; PG8_SCHED;
            PG8_STAGE(PG8_SB(1, 1), b3 + hstep, voffB);
            PG8_WAIT_V(6); PG8_BAR; PG8_MMA(1, 1, At, B1); PG8_BAR;
        }
        PG8_STAMP();
        if constexpr (!Epi::AFTER_DRAIN) { E(acc, cur, wr, wc, fr, fq); S.done(cur); }
        PG8_STAMP();
        if (!has_next) break;
#pragma unroll
        for (int a = 0; a < 2; ++a)
#pragma unroll
            for (int b = 0; b < 2; ++b)
#pragma unroll
                for (int m = 0; m < 4; ++m)
#pragma unroll
                    for (int n = 0; n < 2; ++n) acc[a][b][m][n] = (f32x4){0.f, 0.f, 0.f, 0.f};
        cur = nxt; cA = nA; cB = nB; ++ui;
    }
    PG8_WAIT_V(0);
    if (wr == 0) PG8_BAR;
    PG8_BAR;
    if constexpr (Epi::AFTER_DRAIN) { E.fused(acc, cur, wr, wc, fr, fq, lds, wid, lane); S.done(cur); }
    PG8_STAMP();
    if (STAMP && wid == 0) { stamps[lane] = lane < nts ? (((unsigned long long)(unsigned)ts_hi << 32) | (unsigned)ts_lo) : 0ull;
        if (lane == 62) stamps[62] = rt_entry; if (lane == 63) stamps[63] = (unsigned long long)wall_clock64(); }
#undef PG8_STAMP
#undef PG8_SA
#undef PG8_SB
#undef PG8_STAGE
#undef PG8_LDA
#undef PG8_LDB
#undef PG8_MMA
#undef PG8_WAIT_V
#undef PG8_WAIT_L
#undef PG8_BAR
#undef PG8_SCHED
}
}

enum { EPI_SWIGLU = 0, EPI_RESID = 1, EPI_PROJ = 2, EPI_MERGE = 3 };
struct EpiAny {
  static constexpr bool AFTER_DRAIN = false;
  int mode; bool perm;
  u16* O; int ldo; const float* xin; float* xout; float scale; const u16* gate; float* macc; int br;
  DI void operator()(const pg8::f32x4 (&acc)[2][2][4][2], const pg8::Unit& u, int wr, int wc, int fr, int fq) const {
    const int row0 = u.pm * 256 + wr * 64 + fr;
    if (mode == EPI_SWIGLU) {
      const int col0 = u.pn * 128 + wc * 32 + 8 * fq;
#pragma unroll
      for (int ai = 0; ai < 2; ++ai)
#pragma unroll
        for (int m = 0; m < 4; ++m) {
          float v[8];
#pragma unroll
          for (int n = 0; n < 2; ++n)
#pragma unroll
            for (int e = 0; e < 4; ++e) { const float gv = acc[ai][0][m][n][e], uv = acc[ai][1][m][n][e]; v[4 * n + e] = gv * __builtin_amdgcn_rcpf(1.0f + __builtin_amdgcn_exp2f(-LOG2E * gv)) * uv; }
          u32x4 o; o[0] = pack2(v[0], v[1]); o[1] = pack2(v[2], v[3]); o[2] = pack2(v[4], v[5]); o[3] = pack2(v[6], v[7]);
          *(u32x4*)(O + (size_t)(row0 + ai * 128 + m * 16) * ldo + col0) = o;
        }
    } else if (mode == EPI_PROJ) {
      const int col0 = u.pn * 256 + wc * 32 + 8 * fq;
      const bool sg = (u.pn * 256 >= OFF_GATE);
#pragma unroll
      for (int ai = 0; ai < 2; ++ai)
#pragma unroll
        for (int m = 0; m < 4; ++m)
#pragma unroll
          for (int bj = 0; bj < 2; ++bj) {
            float v[8];
#pragma unroll
            for (int n = 0; n < 2; ++n)
#pragma unroll
              for (int e = 0; e < 4; ++e) { float t = acc[ai][bj][m][n][e]; if (sg) t = __builtin_amdgcn_rcpf(1.0f + __builtin_amdgcn_exp2f(-LOG2E * t)); v[4 * n + e] = t; }
            u32x4 o; o[0] = pack2(v[0], v[1]); o[1] = pack2(v[2], v[3]); o[2] = pack2(v[4], v[5]); o[3] = pack2(v[6], v[7]);
            *(u32x4*)(O + (size_t)(row0 + ai * 128 + m * 16) * INC + col0 + bj * 128) = o;
          }
    } else if (mode == EPI_RESID) {
      const int col0 = u.pn * 256 + wc * 32 + 4 * fq;
#pragma unroll
      for (int ai = 0; ai < 2; ++ai)
#pragma unroll
        for (int m = 0; m < 4; ++m)
#pragma unroll
          for (int bj = 0; bj < 2; ++bj)
#pragma unroll
            for (int n = 0; n < 2; ++n) {
              const size_t idx = (size_t)(row0 + ai * 128 + m * 16) * DM + col0 + bj * 128 + n * 16;
              f32x4 xv = *(const f32x4*)(xin + idx);
#pragma unroll
              for (int e = 0; e < 4; ++e) xv[e] += scale * acc[ai][bj][m][n][e];
              *(f32x4*)(xout + idx) = xv;
            }
    } else {
      const int col0 = u.pn * 256 + wc * 32 + 4 * fq;
#pragma unroll
      for (int ai = 0; ai < 2; ++ai)
#pragma unroll
        for (int m = 0; m < 4; ++m)
#pragma unroll
          for (int bj = 0; bj < 2; ++bj)
#pragma unroll
            for (int n = 0; n < 2; ++n) {
              const int row = row0 + ai * 128 + m * 16, col = col0 + bj * 128 + n * 16;
              const u32x2 gt = *(const u32x2*)(gate + (size_t)row * INC + OFF_GATE + br * DM + col);
              f32x4 v;
              v[0] = bflo(gt[0]) * acc[ai][bj][m][n][0]; v[1] = bfhi(gt[0]) * acc[ai][bj][m][n][1];
              v[2] = bflo(gt[1]) * acc[ai][bj][m][n][2]; v[3] = bfhi(gt[1]) * acc[ai][bj][m][n][3];
              const size_t idx = (size_t)row * DM + col;
              if (br > 0) { const f32x4 pv = *(const f32x4*)(macc + idx); v[0] += pv[0]; v[1] += pv[1]; v[2] += pv[2]; v[3] += pv[3]; }
              if (br < 2) *(f32x4*)(macc + idx) = v;
              else { u32x2 o; o[0] = pack2(v[0], v[1]); o[1] = pack2(v[2], v[3]); *(u32x2*)(outb_() + idx) = o; }
            }
    }
  }
  DI u16* outb_() const { return O; }
};

DI void qk_prep_item(const Params& P, int layer, u16* __restrict__ p, int L, int it) {
  const int tid = otid() & 255, lane = tid & 63, w = __builtin_amdgcn_readfirstlane(tid >> 6);
  const int u = it * 8 + w * 2 + (lane >> 5);
  const int tok = u / 10, hd = u - tok * 10;
  const int i = lane & 31;
  const int col0 = (hd < 8) ? (OFF_GQ + hd * 64) : (OFF_GK + (hd - 8) * 64);
  const float* gn = (hd < 8) ? (P.gqa_q_norm + layer * 64) : (P.gqa_k_norm + layer * 64);
  unsigned* ptr = (unsigned*)(p + (size_t)tok * INC + col0) + i;
  const unsigned v = *ptr;
  float a = bflo(v), b = bfhi(v);
  const float ss = half_sum(a * a + b * b);
  const float rs = rsqrtf(ss * (1.0f / 64.0f) + 1e-6f);
  a = a * rs * gn[2 * i]; b = b * rs * gn[2 * i + 1];
  const int tl = tok % L;
  const float pos = (i < 16) ? (float)(tl >> 6) : (float)(tl & 63);
  const int jj = i & 15;
  const float inv = powf(10000.0f, -(float)(2 * jj) / 32.0f);
  const float ang = pos * inv;
  const float c = cosf(ang), s = sinf(ang);
  *ptr = pack2(a * c - b * s, a * s + b * c);
}

DI void transpose_item(const Params& P, int layer, const u16* __restrict__ p, int L, int kind, int ct, int tt, u16* __restrict__ dst, char* smem) {
  u16* tile = (u16*)smem;
  const int tid = otid() & 255;
  const int t0 = tt * 64;
  const int seq = t0 / L, tl0 = t0 - seq * L;
  const int C = (kind == 0) ? 128 : 512;
  __syncthreads();
  {
    const int col = tid & 63, r0 = tid >> 6;
    const int cidx = ct * 64 + col;
    if (kind < 2) {
      const int off = (kind == 0 ? OFF_GV : OFF_DV) + cidx;
#pragma unroll
      for (int i = 0; i < 16; ++i) { const int row = r0 + 4 * i; tile[col * 72 + row] = p[(size_t)(t0 + row) * INC + off]; }
    } else {
      const float* cw = P.hy_conv_w + layer * 3 * 1536; const float* cb = P.hy_conv_b + layer * 1536;
      const int c1 = 512 + cidx, c2 = 1024 + cidx;
      const float w10 = cw[c1], w11 = cw[1536 + c1], w12 = cw[3072 + c1], b1 = cb[c1];
      const float w20 = cw[c2], w21 = cw[1536 + c2], w22 = cw[3072 + c2], b2 = cb[c2];
#pragma unroll
      for (int i = 0; i < 16; ++i) {
        const int row = r0 + 4 * i; const int tl = tl0 + row;
        const u16* pr = p + (size_t)(t0 + row) * INC;
        const float xm1 = (tl > 0) ? bf2f(pr[c1 - INC]) : 0.f, x0 = bf2f(pr[c1]), xp1 = (tl < L - 1) ? bf2f(pr[c1 + INC]) : 0.f;
        const float vm1 = (tl > 0) ? bf2f(pr[c2 - INC]) : 0.f, v0 = bf2f(pr[c2]), vp1 = (tl < L - 1) ? bf2f(pr[c2 + INC]) : 0.f;
        const float x1c = xm1 * w10 + x0 * w11 + xp1 * w12 + b1;
        const float vc = vm1 * w20 + v0 * w21 + vp1 * w22 + b2;
        tile[col * 72 + row] = f2bf(vc * x1c);
      }
    }
  }
  __syncthreads();
  {
    const int c = tid >> 2, q = tid & 3;
    const u32x4 a = *(const u32x4*)(tile + c * 72 + q * 16), b = *(const u32x4*)(tile + c * 72 + q * 16 + 8);
    u16* d = dst + ((size_t)seq * C + ct * 64 + c) * L + tl0 + q * 16;
    *(u32x4*)d = a; *(u32x4*)(d + 8) = b;
  }
}

DI int kperm(int rho) { return (rho & ~0xC) | ((rho & 4) << 1) | ((rho & 8) >> 1); }
template <int DV, bool BIAS, bool SWAP>
DI void attn_tile(const u16* __restrict__ Qp, const u16* __restrict__ Kp, const u16* __restrict__ VTp, int L,
                  u16* __restrict__ Op, int ldo, int q0, const float* __restrict__ btab, char* smem) {
  constexpr int NDT = DV / 32;
  constexpr int VCH = DV / 64;
  constexpr int KS_SZ = 64 * 64, VS_SZ = DV * 64;
  constexpr int NL = 1 + VCH;
  u16* Ks = (u16*)smem;
  u16* Vs = Ks + 4 * KS_SZ;
  float* bt = (float*)(Vs + 3 * VS_SZ);
  const int tid = otid(), lane = tid & 63, w = __builtin_amdgcn_readfirstlane(tid >> 6), r = lane & 31, h = lane >> 5;
  const float sc = 0.125f * LOG2E;
  __syncthreads();
  if (BIAS) { for (int i = tid; i < 257; i += 512) bt[i] = btab[i]; }
  bf16x8 qf[4];
  {
    const u16* qrow = Qp + (size_t)(q0 + 32 * w + r) * INC + 8 * h;
#pragma unroll
    for (int s = 0; s < 4; ++s) qf[s] = *(const bf16x8*)(qrow + 16 * s);
  }
  const int qpos = q0 + 32 * w + r;
  f32x16 O[NDT];
#pragma unroll
  for (int d = 0; d < NDT; ++d)
#pragma unroll
    for (int q = 0; q < 16; ++q) O[d][q] = 0.f;
  float m = -INFINITY, l = 0.f;
  const int lrow = tid >> 3, lsw = (tid & 7) ^ ((tid >> 4) & 7);
  const u16* Kg0 = Kp + (size_t)kperm(lrow) * INC + lsw * 8;
  const u16* Vg = VTp + (size_t)lrow * L + lsw * 8;
  const int ksw = (r >> 1) & 7;
  const int nkb = L >> 6;
#define ATT_LOADK(tile, bufp) do { const int t__ = ((tile) < nkb) ? (tile) : nkb - 1; \
    __builtin_amdgcn_global_load_lds((const unsigned*)(Kg0 + ((size_t)t__ * 64) * INC), (unsigned*)((char*)(bufp) + tid * 16), 16, 0, 0); } while (0)
#define ATT_LOADV(tile, bufp) do { const int t__ = ((tile) < nkb) ? (tile) : nkb - 1; _Pragma("unroll") for (int i_ = 0; i_ < VCH; ++i_) \
    __builtin_amdgcn_global_load_lds((const unsigned*)(Vg + (size_t)(64 * i_) * L + (size_t)t__ * 64), (unsigned*)((char*)(bufp) + tid * 16 + i_ * 8192), 16, 0, 0); } while (0)
  f32x16 Sc[2];
  auto qk = [&](const u16* Kb) __attribute__((always_inline)) {
    bf16x8 kf[2][4];
#pragma unroll
    for (int kt = 0; kt < 2; ++kt)
#pragma unroll
      for (int s = 0; s < 4; ++s) kf[kt][s] = *(const bf16x8*)(Kb + (32 * kt + r) * 64 + (((2 * s + h) ^ ksw) << 3));
#pragma unroll
    for (int kt = 0; kt < 2; ++kt) {
#pragma unroll
      for (int q = 0; q < 16; ++q) Sc[kt][q] = 0.f;
#pragma unroll
      for (int s = 0; s < 4; ++s) Sc[kt] = MFMA(kf[kt][s], qf[s], Sc[kt]);
    }
    __builtin_amdgcn_sched_group_barrier(0x100, 8, 0);
    __builtin_amdgcn_sched_group_barrier(0x008, 8, 0);
  };
  bf16x8 pf[2][2];
  auto softmax = [&](int kb) __attribute__((always_inline)) {
    float cb = 0.f; bool near = false;
    if (BIAS) {
      const int kmin = kb * 64;
      near = !(kmin - (q0 + 255) >= 128 || q0 - (kmin + 63) >= 128);
      cb = (kmin > q0) ? bt[256] : bt[0];
      if (near) {
        const float isc = 1.0f / sc;
#pragma unroll
        for (int kt = 0; kt < 2; ++kt)
#pragma unroll
          for (int q = 0; q < 16; ++q) {
            int rel = kmin + 32 * kt + kperm(crow(q, h)) - qpos;
            rel = rel < -128 ? -128 : (rel > 128 ? 128 : rel);
            Sc[kt][q] += bt[rel + 128] * isc;
          }
        cb = 0.f;
      }
    }
    float mx = Sc[0][0];
#pragma unroll
    for (int kt = 0; kt < 2; ++kt)
#pragma unroll
      for (int q = 0; q < 16; ++q) mx = fmaxf(mx, Sc[kt][q]);
    mx = fmaxf(mx, __shfl_xor(mx, 32));
    mx = __builtin_fmaf(mx, sc, cb);
    if (__any(mx > m + 6.0f)) {
      asm volatile("" ::: "memory");
      const float mn = fmaxf(m, mx);
      const float alpha = __builtin_amdgcn_exp2f(m - mn);
      m = mn; l *= alpha;
#pragma unroll
      for (int d = 0; d < NDT; ++d)
#pragma unroll
        for (int q = 0; q < 16; ++q) O[d][q] *= alpha;
    }
    const float nm = cb - m;
#pragma unroll
    for (int kt = 0; kt < 2; ++kt) {
#pragma unroll
      for (int q = 0; q < 16; ++q) {
        const float pv = __builtin_amdgcn_exp2f(__builtin_fmaf(Sc[kt][q], sc, nm));
        Sc[kt][q] = pv; l += pv;
      }
#pragma unroll
      for (int s = 0; s < 2; ++s) {
        u32x4 pk;
#pragma unroll
        for (int q = 0; q < 4; ++q) pk[q] = pack2(Sc[kt][8 * s + 2 * q], Sc[kt][8 * s + 2 * q + 1]);
        pf[kt][s] = __builtin_bit_cast(bf16x8, pk);
      }
    }
  };
  auto pv = [&](const u16* Vb) __attribute__((always_inline)) {
    bf16x8 vf[4][NDT];
#pragma unroll
    for (int ks = 0; ks < 4; ++ks)
#pragma unroll
      for (int d = 0; d < NDT; ++d) vf[ks][d] = *(const bf16x8*)(Vb + (32 * d + r) * 64 + (((2 * ks + h) ^ ksw) << 3));
#pragma unroll
    for (int ks = 0; ks < 4; ++ks)
#pragma unroll
      for (int d = 0; d < NDT; ++d) O[d] = MFMA(vf[ks][d], pf[ks >> 1][ks & 1], O[d]);
    __builtin_amdgcn_sched_group_barrier(0x100, 2 * NDT, 0);
    __builtin_amdgcn_sched_group_barrier(0x008, NDT, 0);
    __builtin_amdgcn_sched_group_barrier(0x100, NDT, 0);
    __builtin_amdgcn_sched_group_barrier(0x008, NDT, 0);
    __builtin_amdgcn_sched_group_barrier(0x100, NDT, 0);
    __builtin_amdgcn_sched_group_barrier(0x008, 2 * NDT, 0);
  };
  ATT_LOADK(0, Ks); ATT_LOADK(1, Ks + KS_SZ); ATT_LOADK(2, Ks + 2 * KS_SZ);
  ATT_LOADV(0, Vs); ATT_LOADV(1, Vs + VS_SZ);
  asm volatile("s_waitcnt vmcnt(0) lgkmcnt(0)\n\ts_barrier" ::: "memory");
  if (SWAP) qk(Ks);
  int r0 = 0, r2 = 2;
  for (int kb = 0; kb < nkb; ++kb) {
    ATT_LOADK(kb + 3, Ks + ((kb + 3) & 3) * KS_SZ);
    ATT_LOADV(kb + 2, Vs + r2 * VS_SZ);
    if (!SWAP) qk(Ks + (kb & 3) * KS_SZ);
    softmax(kb);
    pv(Vs + r0 * VS_SZ);
    if (SWAP) qk(Ks + ((kb + 1) & 3) * KS_SZ);
    asm volatile("s_waitcnt vmcnt(%0) lgkmcnt(0)\n\ts_barrier" :: "n"(NL) : "memory");
    r2 = r0; r0 = (r0 == 2) ? 0 : r0 + 1;
  }
  asm volatile("s_waitcnt vmcnt(0)" ::: "memory");
#undef ATT_LOADK
#undef ATT_LOADV
  l += __shfl_xor(l, 32);
  const float inv = __builtin_amdgcn_rcpf(l);
  int ldo2 = ldo; asm volatile("" : "+s"(ldo2));
  u16* orow = Op + (size_t)qpos * ldo2;
#pragma unroll
  for (int d = 0; d < NDT; ++d)
#pragma unroll
    for (int g4 = 0; g4 < 4; ++g4) {
      u32x2 o; o[0] = pack2(O[d][4 * g4] * inv, O[d][4 * g4 + 1] * inv); o[1] = pack2(O[d][4 * g4 + 2] * inv, O[d][4 * g4 + 3] * inv);
      *(u32x2*)(orow + 32 * d + 8 * g4 + 4 * h) = o;
    }
}

DI void hyena_item(int c, const u16* __restrict__ G, const u16* __restrict__ zT, u16* __restrict__ yT, int nseq, int L, char* smem) {
  u16* zs = (u16*)smem;
  u16* fw = zs + 20480;
  u16* fw1 = fw + 8256;
  const int tid = otid() & 255, lane = tid & 63, w = __builtin_amdgcn_readfirstlane(tid >> 6), r = lane & 31, h = lane >> 5;
  const int ZL = L + 2048;
  __syncthreads();
  for (int q = 0; q < nseq; ++q) {
    const u16* src = zT + ((size_t)q * 512 + c) * L;
    u16* dst = zs + q * ZL;
    const u32x4 zero = {0u, 0u, 0u, 0u};
    for (int i = tid; i < 128; i += 256) { *(u32x4*)(dst + i * 8) = zero; *(u32x4*)(dst + 1024 + L + i * 8) = zero; }
    for (int i = tid; i < (L >> 3); i += 256) *(u32x4*)(dst + 1024 + i * 8) = *(const u32x4*)(src + i * 8);
  }
  int tq[4], tJ[4];
#pragma unroll
  for (int i = 0; i < 4; ++i) { if (nseq == 2) { tq[i] = i & 1; tJ[i] = 2 * w + (i >> 1); } else { tq[i] = 0; tJ[i] = 4 * w + i; } }
  f32x16 acc[4];
#pragma unroll
  for (int i = 0; i < 4; ++i)
#pragma unroll
    for (int q = 0; q < 16; ++q) acc[i][q] = 0.f;
  const int E0 = -L + 16, ELAST = L - 32;
  const int npass = (2 * L - 32 + 8191) / 8192;
  const u16* Gc = G + (size_t)c * (2 * L);
  for (int ps = 0; ps < npass; ++ps) {
    const int ea = E0 + 8192 * ps, eb = ea + 8192;
    const int wb = L - eb - 16;
    __syncthreads();
    for (int i = tid; i < 1032; i += 256) {
      const int gi = wb + i * 8;
      u32x4 v = {0u, 0u, 0u, 0u};
      if (gi >= 0 && gi < 2 * L) v = *(const u32x4*)(Gc + gi);
      *(u32x4*)(fw + i * 8) = v;
    }
    __syncthreads();
    for (int i = tid; i < 4127; i += 256) { const unsigned lo = ((const unsigned*)fw)[i], hi = ((const unsigned*)fw)[i + 1]; ((unsigned*)fw1)[i] = (lo >> 16) | (hi << 16); }
    __syncthreads();
    const int eend = (eb - 16 < ELAST) ? (eb - 16) : ELAST;
    auto slow = [&](int e_lo, int e_hi) __attribute__((always_inline)) {
      for (int e = e_lo; e <= e_hi; e += 16) {
        bool in[4]; bool any = false;
#pragma unroll
        for (int i = 0; i < 4; ++i) { in[i] = (e >= 1024 * tJ[i] - L + 16) && (e <= 1024 * tJ[i] + 992); any = any || in[i]; }
        if (!any) continue;
        const int idx0 = L - e - r + 8 * h - wb;
        const unsigned* aw = (idx0 & 1) ? (const unsigned*)(fw1 + idx0 - 1) : (const unsigned*)(fw + idx0);
        u32x4 av; av[0] = aw[0]; av[1] = aw[1]; av[2] = aw[2]; av[3] = aw[3];
        const bf16x8 a = __builtin_bit_cast(bf16x8, av);
#pragma unroll
        for (int i = 0; i < 4; ++i) {
          if (in[i]) {
            const bf16x8 b = *(const bf16x8*)(zs + tq[i] * ZL + 1024 + 1024 * tJ[i] + 32 * r - e + 8 * h);
            acc[i] = MFMA(a, b, acc[i]);
          }
        }
      }
    };
    int mlo = 1024 * tJ[3] - L + 16, mhi = 1024 * tJ[0] + 992;
    if (mlo < ea) mlo = ea; if (mhi > eend) mhi = eend;
    if (mlo > mhi) { slow(ea, eend); }
    else {
      slow(ea, mlo - 16);
      {
        const int idx0 = L - mlo - r + 8 * h - wb;
        const unsigned* ap = (idx0 & 1) ? (const unsigned*)(fw1 + idx0 - 1) : (const unsigned*)(fw + idx0);
        const u16* bp0 = zs + tq[0] * ZL + 1024 + 1024 * tJ[0] + 32 * r - mlo + 8 * h;
        const u16* bp1 = zs + tq[1] * ZL + 1024 + 1024 * tJ[1] + 32 * r - mlo + 8 * h;
        const u16* bp2 = zs + tq[2] * ZL + 1024 + 1024 * tJ[2] + 32 * r - mlo + 8 * h;
        const u16* bp3 = zs + tq[3] * ZL + 1024 + 1024 * tJ[3] + 32 * r - mlo + 8 * h;
        const int n = ((mhi - mlo) >> 4) + 1;
        bf16x8 a, b0, b1, b2, b3;
        { u32x4 av; av[0] = ap[0]; av[1] = ap[1]; av[2] = ap[2]; av[3] = ap[3]; a = __builtin_bit_cast(bf16x8, av); }
        b0 = *(const bf16x8*)bp0; b1 = *(const bf16x8*)bp1; b2 = *(const bf16x8*)bp2; b3 = *(const bf16x8*)bp3;
        for (int k = 0; k < n; ++k) {
          ap -= 8; bp0 -= 16; bp1 -= 16; bp2 -= 16; bp3 -= 16;
          bf16x8 an, c0, c1, c2, c3;
          { u32x4 av; av[0] = ap[0]; av[1] = ap[1]; av[2] = ap[2]; av[3] = ap[3]; an = __builtin_bit_cast(bf16x8, av); }
          c0 = *(const bf16x8*)bp0; c1 = *(const bf16x8*)bp1; c2 = *(const bf16x8*)bp2; c3 = *(const bf16x8*)bp3;
          acc[0] = MFMA(a, b0, acc[0]); acc[1] = MFMA(a, b1, acc[1]); acc[2] = MFMA(a, b2, acc[2]); acc[3] = MFMA(a, b3, acc[3]);
          a = an; b0 = c0; b1 = c1; b2 = c2; b3 = c3;
        }
      }
      slow(mhi + 16, eend);
    }
  }
#pragma unroll
  for (int i = 0; i < 4; ++i) {
    u16* dst = yT + ((size_t)tq[i] * 512 + c) * L + 1024 * tJ[i] + 32 * r + 4 * h;
#pragma unroll
    for (int g4 = 0; g4 < 4; ++g4) {
      u32x2 o; o[0] = pack2(acc[i][4 * g4], acc[i][4 * g4 + 1]); o[1] = pack2(acc[i][4 * g4 + 2], acc[i][4 * g4 + 3]);
      *(u32x2*)(dst + 8 * g4) = o;
    }
  }
}

DI void diff_post_item(const Params& P, int layer, float lam, float lam_init, const u16* __restrict__ dO, u16* __restrict__ ydf, int it) {
  const int tid = otid() & 255, lane = tid & 63, w = __builtin_amdgcn_readfirstlane(tid >> 6);
  const int u = it * 8 + w * 2 + (lane >> 5);
  const int i = lane & 31;
  const u32x2 a = *(const u32x2*)(dO + (size_t)u * 256 + 4 * i);
  const u32x2 b = *(const u32x2*)(dO + (size_t)u * 256 + 128 + 4 * i);
  float o[4];
  o[0] = bflo(a[0]) - lam * bflo(b[0]); o[1] = bfhi(a[0]) - lam * bfhi(b[0]);
  o[2] = bflo(a[1]) - lam * bflo(b[1]); o[3] = bfhi(a[1]) - lam * bfhi(b[1]);
  const float ss = half_sum(o[0] * o[0] + o[1] * o[1] + o[2] * o[2] + o[3] * o[3]);
  const float rs = rsqrtf(ss * (1.0f / 128.0f) + 1e-5f) * (1.0f - lam_init);
  const float* g = P.diff_subln + layer * 128 + 4 * i;
  u32x2 ov; ov[0] = pack2(o[0] * rs * g[0], o[1] * rs * g[1]); ov[1] = pack2(o[2] * rs * g[2], o[3] * rs * g[3]);
  *(u32x2*)(ydf + (size_t)u * 128 + 4 * i) = ov;
}
DI void hyena_post_item(const Params& P, int layer, const u16* __restrict__ p, int L, const u16* __restrict__ yT, const u16* __restrict__ zT,
                        int ct, int tt, u16* __restrict__ yhy, char* smem) {
  float* tile = (float*)smem;
  const int tid = otid() & 255;
  const int t0 = tt * 64; const int seq = t0 / L, tl0 = t0 - seq * L;
  __syncthreads();
  {
    const int tcol = tid & 63, c0 = tid >> 6;
#pragma unroll
    for (int i = 0; i < 16; ++i) {
      const int cc = c0 + 4 * i; const int c = ct * 64 + cc;
      const size_t gi = ((size_t)seq * 512 + c) * L + tl0 + tcol;
      tile[cc * 65 + tcol] = bf2f(yT[gi]) + bf2f(zT[gi]) * P.hy_skip[layer * 512 + c];
    }
  }
  __syncthreads();
  {
    const int col = tid & 63, r0 = tid >> 6; const int c = ct * 64 + col;
    const float* cw = P.hy_conv_w + layer * 3 * 1536; const float* cb = P.hy_conv_b + layer * 1536;
    const float w0 = cw[c], w1 = cw[1536 + c], w2 = cw[3072 + c], b0 = cb[c];
#pragma unroll
    for (int i = 0; i < 16; ++i) {
      const int row = r0 + 4 * i; const int tl = tl0 + row;
      const u16* pr = p + (size_t)(t0 + row) * INC + c;
      const float xm1 = (tl > 0) ? bf2f(pr[-INC]) : 0.f, x0 = bf2f(pr[0]), xp1 = (tl < L - 1) ? bf2f(pr[INC]) : 0.f;
      const float x0c = xm1 * w0 + x0 * w1 + xp1 * w2 + b0;
      yhy[(size_t)(t0 + row) * 512 + c] = f2bf(x0c * tile[col * 65 + row]);
    }
  }
}

__global__ void __launch_bounds__(512) fwd_megakernel(Params Parg) {
  cg::grid_group grid = cg::this_grid();
  extern __shared__ __attribute__((aligned(16))) char smem_dyn[];
  char* smem = smem_dyn + 16;
  uint4& xb_words = *(uint4*)smem_dyn;
  const int nb = gridDim.x, nb2 = nb * 2;
#define KPARAMS() const Params __attribute__((address_space(4)))* pp_ = (const Params __attribute__((address_space(4)))*)__builtin_amdgcn_kernarg_segment_ptr(); \
  asm volatile("" : "+s"(pp_)); const Params& P = *(const Params*)pp_; char* ws = P.ws
  if (threadIdx.x == 0) xb_words = make_uint4(0u, 0u, 0u, blockIdx.x);
  __syncthreads();
  XcdBarrier xb;
  { KPARAMS(); xb = xcd_barrier_post((unsigned*)(ws + O_BAR), (volatile LAS unsigned*)&xb_words); }

  for (int step = 0; step < 80; ++step) {
    const int layer = step / 40, ls = step - layer * 40;
    PHASE_IDS();
    KPARAMS();
    float* misc = (float*)(ws + O_MISC);
    u16* pbuf = (u16*)(ws + O_P); u16* hid = pbuf; u16* hn = (u16*)(ws + O_HN); u16* merged = hn;
    if (ls == 0) {
      u16* filt8 = (u16*)(ws + O_FILT8); u16* filt16 = (u16*)(ws + O_FILT16);
      const int n1 = 16 * 88, n2 = 44 * 16, n3 = 16 * 108, n4 = 3 * 8 * 16, n5 = 16 * 16;
      const int nfilt = 128 + 256;
      const int total = n1 + n2 + n3 + n4 + n5 + n1 + n2 + nfilt;
      for (int it = bid2; it < total; it += nb2) {
        int t = it;
        if (t < nfilt) {
          const bool big = t < 256;
          filter_item(P, layer, big ? 16384 : 8192, big ? t : t - 256, big ? filt16 : filt8, smg);
          continue;
        }
        t -= nfilt;
        const float* src; int K, N, kt, nt, ph = 0; u16* dst;
        if (t < n1) { src = P.ffn1_w_in + (size_t)layer * 1024 * 5632; K = 1024; N = 5632; dst = (u16*)(ws + O_F1IN); kt = t / 88; nt = t % 88; ph = 2816; }
        else if ((t -= n1) < n2) { src = P.ffn1_w_out + (size_t)layer * 2816 * 1024; K = 2816; N = 1024; dst = (u16*)(ws + O_F1OUT); kt = t / 16; nt = t % 16; }
        else if ((t -= n2) < n3) { src = P.w_in + (size_t)layer * 1024 * 6912; K = 1024; N = 6912; dst = (u16*)(ws + O_WIN); kt = t / 108; nt = t % 108; }
        else if ((t -= n3) < n4) { const int br = t / 128, tt = t % 128; src = P.w_branch + ((size_t)layer * 3 + br) * 512 * 1024; K = 512; N = 1024;
                                   dst = (u16*)(ws + O_WBR) + (size_t)br * 1024 * 512; kt = tt / 16; nt = tt % 16; }
        else if ((t -= n4) < n5) { src = P.w_out + (size_t)layer * 1024 * 1024; K = 1024; N = 1024; dst = (u16*)(ws + O_WOUT); kt = t / 16; nt = t % 16; }
        else if ((t -= n5) < n1) { src = P.ffn2_w_in + (size_t)layer * 1024 * 5632; K = 1024; N = 5632; dst = (u16*)(ws + O_F2IN); kt = t / 88; nt = t % 88; ph = 2816; }
        else { t -= n1; src = P.ffn2_w_out + (size_t)layer * 2816 * 1024; K = 2816; N = 1024; dst = (u16*)(ws + O_F2OUT); kt = t / 16; nt = t % 16; }
        convT_tile(src, K, N, dst, kt, nt, ph, smg);
      }
      if (bid == 0 && grp == 0) {
        const int tid = t_;
        if (tid < 2) {
          const float* lp = P.diff_lambda + tid * 256;
          float s1 = 0.f, s2 = 0.f;
          for (int i = 0; i < 64; ++i) { s1 += lp[i] * lp[64 + i]; s2 += lp[128 + i] * lp[192 + i]; }
          const float lam_init = 0.8f - 0.6f * expf(-0.3f * (float)tid);
          misc[tid] = expf(s1) - expf(s2) + lam_init;
        }
        for (int i = tid; i < 4 * 257; i += 256) {
          const int hh = i / 257, idx = i % 257; const int rel = idx - 128; const int n = rel < 0 ? -rel : rel;
          int b;
          if (n < 8) b = n; else { int lg = 8 + (int)(logf((float)n / 8.0f) / 2.772588722239781f * 8.0f); b = lg < 15 ? lg : 15; }
          if (rel > 0) b += 16;
          misc[64 + i] = P.rel_bias[b * 4 + hh] * LOG2E;
        }
      }
      if (step == 0) {
        grid.sync();
        if (threadIdx.x == 0) {
          unsigned* bar = (unsigned*)(ws + O_BAR); bool even = ((nb & 7) == 0);
          for (int j = 0; j < 16; ++j) { const unsigned c = xb_ld(&bar[XB_XCNT(j)]); if (c != ((j < 8) ? (unsigned)(nb >> 3) : 0u)) even = false; }
          volatile LAS unsigned* st = (volatile LAS unsigned*)&xb_words;
          if (even) st[3] = st[2] * 8u + xb.x;
        }
        __syncthreads();
      } else GSYNC();
      continue;
    }
    const int cs = ls - 1; const int ch = cs / 13, st = cs - ch * 13;
    const int nseq = (ch < 2) ? 2 : 1, L = (ch < 2) ? 8192 : 16384;
    const float* xin0 = (ch < 2) ? (P.x_prompt + (size_t)ch * TCH * DM) : P.x_sample;
    float* xres = P.out + (size_t)ch * TCH * DM;
    const float* xcur = (layer == 0) ? xin0 : xres;
    for (int rp_ = 0; rp_ <= ((REPMASK >> st) & 1); ++rp_) {
    if (st == 0 || st == 3 || st == 10) {
      const float* src = (st == 0) ? xcur : xres;
      const float* gn = ((st == 0) ? P.ffn1_norm : (st == 3 ? P.mix_norm : P.ffn2_norm)) + layer * DM;
      for (int it = bid2; it < TCH / 4; it += nb2) { const int row = it * 4 + w; norm_row_bf16(src + (size_t)row * DM, gn, hn + (size_t)row * DM, lane); }
    } else if (st == 1 || st == 2 || st == 4 || st == 8 || st == 9 || st == 11 || st == 12) {
      EpiAny E{}; const u16* A; const u16* Bt; int N, K; int nrep = 1;
      if (st == 1 || st == 11) { A = hn; Bt = (u16*)(ws + (st == 1 ? O_F1IN : O_F2IN)); N = 5632; K = DM; E.mode = EPI_SWIGLU; E.perm = true; E.O = hid; E.ldo = DFF; }
      else if (st == 2 || st == 12) { A = hid; Bt = (u16*)(ws + (st == 2 ? O_F1OUT : O_F2OUT)); N = DM; K = DFF; E.mode = EPI_RESID; E.perm = false;
                                      E.xin = (st == 2) ? xcur : xres; E.xout = xres; E.scale = 0.5f; }
      else if (st == 4) { A = hn; Bt = (u16*)(ws + O_WIN); N = INC; K = DM; E.mode = EPI_PROJ; E.perm = true; E.O = pbuf; }
      else if (st == 8) { A = (u16*)(ws + O_YHY); Bt = (u16*)(ws + O_WBR); N = DM; K = 512; E.mode = EPI_MERGE; E.perm = false; E.gate = pbuf; E.macc = (float*)(ws + O_ZT); E.O = merged; nrep = 3; }
      else { A = merged; Bt = (u16*)(ws + O_WOUT); N = DM; K = DM; E.mode = EPI_RESID; E.perm = false; E.xin = xres; E.xout = xres; E.scale = 1.0f; }
      for (int rp = 0; rp < nrep; ++rp) {
        E.br = rp;
        pg8::Gemm gg{A + (size_t)rp * TCH * 512, Bt + (size_t)rp * 1024 * 512, TCH, N, K};
        pg8::StaticOrder S; S.init(TCH, N, nb, bid);
        pg8::gemm_phase<EpiAny, pg8::StaticOrder, false>((PG8_LAS unsigned char*)smem, gg, S, E, nullptr);
      }
    } else if (st == 5) {
      const int nqk = TCH * 10 / 8, ntr = 256 * 18;
      for (int it = bid2; it < nqk + ntr; it += nb2) {
        if (it < nqk) { qk_prep_item(P, layer, pbuf, L, it); continue; }
        const int t = it - nqk; const int tt = t / 18, cc = t % 18;
        const int kind = (cc < 2) ? 0 : (cc < 10 ? 1 : 2);
        const int ct = (cc < 2) ? cc : (cc < 10 ? cc - 2 : cc - 10);
        u16* dst = (u16*)(ws + (kind == 0 ? O_VTG : (kind == 1 ? O_VTD : O_ZT)));
        transpose_item(P, layer, pbuf, L, kind, ct, tt, dst, smg);
      }
    } else if (st == 6) {
      u16* zT = (u16*)(ws + O_ZT); u16* yT = (u16*)(ws + O_YT); u16* dO = (u16*)(ws + O_DIFFO);
      u16* vtg = (u16*)(ws + O_VTG); u16* vtd = (u16*)(ws + O_VTD); u16* ygq = (u16*)(ws + O_YGQ);
      const u16* filt = (u16*)(ws + ((ch < 2) ? O_FILT8 : O_FILT16));
      const int nqt = L / 256;
      const int xcd = bid & 7, nxu = nb >> 3, nitem = nseq * nqt;
      for (int e = bid >> 3; e < nitem; e += nxu) {
        const int seq = e / nqt, qt = e - seq * nqt;
        const int hh = xcd >> 1, cc = xcd & 1;
        const size_t tb = (size_t)seq * L;
        const u16* Qd = pbuf + tb * INC + OFF_DQ + xcd * 64; const u16* Kd = pbuf + tb * INC + OFF_DK + xcd * 64;
        const u16* Vd = vtd + ((size_t)seq * 512 + hh * 128) * L; u16* Od = dO + tb * 1024 + (hh * 2 + cc) * 128;
        if (grp) attn_tile<128, true, true>(Qd, Kd, Vd, L, Od, 1024, qt * 256, misc + 64 + hh * 257, smem);
        else attn_tile<128, true, false>(Qd, Kd, Vd, L, Od, 1024, qt * 256, misc + 64 + hh * 257, smem);
      }
      for (int e = bid >> 3; e < nitem; e += nxu) {
        const int seq = e / nqt, qt = e - seq * nqt;
        const int kvh = xcd >> 2;
        const size_t tb = (size_t)seq * L;
        const u16* Qd = pbuf + tb * INC + OFF_GQ + xcd * 64; const u16* Kd = pbuf + tb * INC + OFF_GK + kvh * 64;
        const u16* Vd = vtg + ((size_t)seq * 128 + kvh * 64) * L; u16* Od = ygq + tb * 512 + xcd * 64;
        if (grp) attn_tile<64, false, true>(Qd, Kd, Vd, L, Od, 512, qt * 256, nullptr, smem);
        else attn_tile<64, false, false>(Qd, Kd, Vd, L, Od, 512, qt * 256, nullptr, smem);
      }
      for (int c = bid2; c < 512; c += nb2) hyena_item(c, filt, zT, yT, nseq, L, smg);
    } else {
      u16* zT = (u16*)(ws + O_ZT); u16* yT = (u16*)(ws + O_YT); u16* dO = (u16*)(ws + O_DIFFO);
      u16* yhy = (u16*)(ws + O_YHY); u16* ydf = (u16*)(ws + O_YDF);
      const float lam = misc[layer];
      const float lam_init = 0.8f - 0.6f * expf(-0.3f * (float)layer);
      const int ndp = TCH * 4 / 8, nhp = 256 * 8;
      for (int it = bid2; it < ndp + nhp; it += nb2) {
        if (it < ndp) diff_post_item(P, layer, lam, lam_init, dO, ydf, it);
        else { const int t = it - ndp; hyena_post_item(P, layer, pbuf, L, yT, zT, t % 8, t / 8, yhy, smg); }
      }
    }
    }
    GSYNC();
  }
  { PHASE_IDS(); KPARAMS(); (void)ws;
    for (int it = bid2; it < NTOK / 4; it += nb2) { const int row = it * 4 + w; norm_row_f32_inplace(P.out + (size_t)row * DM, P.final_norm, lane); }
  }
}

extern "C" void kernel_launch(void* const* d_in, const int* in_sizes, int n_in, void* d_out, int out_size, void* d_ws, size_t ws_size,
                              hipStream_t stream) {
  static int grid_blocks = 0;
  if (!grid_blocks) {
    int dev = 0, cus = 0, per_cu = 0;
    (void)hipGetDevice(&dev);
    (void)hipDeviceGetAttribute(&cus, hipDeviceAttributeMultiprocessorCount, dev);
    (void)hipFuncSetAttribute((const void*)fwd_megakernel, hipFuncAttributeMaxDynamicSharedMemorySize, SMEM_BYTES + 16);
    (void)hipOccupancyMaxActiveBlocksPerMultiprocessor(&per_cu, fwd_megakernel, 512, SMEM_BYTES + 16);
    if (per_cu < 1) per_cu = 1;
    if (per_cu > 1) per_cu = 1;
    grid_blocks = cus * per_cu;
  }
  Params p{};
  const float* const* in = (const float* const*)d_in;
  p.x_prompt = in[0]; p.x_sample = in[1]; p.ffn1_norm = in[2]; p.ffn1_w_in = in[3]; p.ffn1_w_out = in[4]; p.mix_norm = in[5]; p.w_in = in[6];
  p.hy_conv_w = in[7]; p.hy_conv_b = in[8]; p.hy_w1 = in[9]; p.hy_b1 = in[10]; p.hy_w2 = in[11]; p.hy_b2 = in[12]; p.hy_w3 = in[13];
  p.hy_freq = in[14]; p.hy_skip = in[15]; p.gqa_q_norm = in[16]; p.gqa_k_norm = in[17]; p.diff_lambda = in[18]; p.diff_subln = in[19];
  p.rel_bias = in[20]; p.w_branch = in[21]; p.w_out = in[22]; p.ffn2_norm = in[23]; p.ffn2_w_in = in[24]; p.ffn2_w_out = in[25]; p.final_norm = in[26];
  p.out = (float*)d_out; p.ws = (char*)d_ws;
  void* args[] = {&p};
  (void)hipMemsetAsync((char*)d_ws + O_BAR, 0, XCD_BAR_WORDS * 4, stream);
  hipError_t e = hipLaunchCooperativeKernel((void*)fwd_megakernel, dim3(grid_blocks), dim3(512), args, SMEM_BYTES + 16, stream);
  if (e != hipSuccess) fprintf(stderr, "cooperative launch failed: %s (grid %d)\n", hipGetErrorString(e), grid_blocks);
}
```

```cpp
#include <hip/hip_runtime.h>
#include <hip/hip_cooperative_groups.h>
#include <stdint.h>
#include <cstdio>
namespace cg = cooperative_groups;

typedef unsigned short u16;
typedef __attribute__((ext_vector_type(8))) short bf16x8;
typedef __attribute__((ext_vector_type(16))) float f32x16;
typedef __attribute__((ext_vector_type(4))) float f32x4;
typedef __attribute__((ext_vector_type(4))) unsigned u32x4;
typedef __attribute__((ext_vector_type(2))) unsigned u32x2;
typedef __attribute__((ext_vector_type(2))) __bf16 bf2_t;
typedef __attribute__((ext_vector_type(2))) float f2_t;
#define DI __device__ __forceinline__
#define MFMA(a, b, c) __builtin_amdgcn_mfma_f32_32x32x16_bf16((a), (b), (c), 0, 0, 0)

constexpr int DM = 1024, DFF = 2816, INC = 6912, TCH = 16384, NTOK = 49152;
constexpr int OFF_GQ = 1536, OFF_GK = 2048, OFF_GV = 2176, OFF_DQ = 2304, OFF_DK = 2816, OFF_DV = 3328, OFF_GATE = 3840;
constexpr float LOG2E = 1.4426950408889634f;

constexpr size_t SZ_F1IN = (size_t)5632 * 1024 * 2, SZ_F1OUT = (size_t)1024 * 2816 * 2, SZ_WIN = (size_t)6912 * 1024 * 2,
                 SZ_WBR = (size_t)3 * 1024 * 512 * 2, SZ_WOUT = (size_t)1024 * 1024 * 2;
constexpr size_t O_F1IN = 0, O_F1OUT = O_F1IN + SZ_F1IN, O_WIN = O_F1OUT + SZ_F1OUT, O_WBR = O_WIN + SZ_WIN, O_WOUT = O_WBR + SZ_WBR,
                 O_F2IN = O_WOUT + SZ_WOUT, O_F2OUT = O_F2IN + SZ_F1IN, O_FILT8 = O_F2OUT + SZ_F1OUT,
                 O_FILT16 = O_FILT8 + (size_t)512 * 16384 * 2, O_MISC = O_FILT16 + (size_t)512 * 32768 * 2,
                 O_P = O_MISC + 131072, O_HN = O_P + (size_t)TCH * INC * 2, O_ZT = O_HN + (size_t)TCH * 1024 * 2,
                 O_YT = O_ZT + (size_t)TCH * 512 * 2, O_DIFFO = O_YT + (size_t)TCH * 512 * 2, O_VTG = O_DIFFO + (size_t)TCH * 1024 * 2,
                 O_VTD = O_VTG + (size_t)TCH * 128 * 2, O_YHY = O_VTD + (size_t)TCH * 512 * 2, O_YGQ = O_YHY + (size_t)TCH * 512 * 2,
                 O_YDF = O_YGQ + (size_t)TCH * 512 * 2, O_END = O_YDF + (size_t)TCH * 512 * 2;
static_assert(O_END <= (size_t)536870912, "workspace overflow");
constexpr int SMEM_BYTES = 151552;
constexpr int GRP_LDS = 75776;
#define REPMASK 0
#define REP_SYNC 1
#define PHASE_IDS() const int t_ = otid(); const int bid = __builtin_amdgcn_readfirstlane(((volatile LAS unsigned*)&xb_words)[3]); const int lane = t_ & 63; const int grp = __builtin_amdgcn_readfirstlane(t_ >> 8); \
  const int w = __builtin_amdgcn_readfirstlane((t_ >> 6) & 3); const int bid2 = bid * 2 + grp; char* smg = smem + grp * GRP_LDS; \
  const int vb = (bid & 7) * (nb >> 3) + (bid >> 3); (void)lane; (void)w; (void)bid2; (void)smg; (void)vb
#define GSYNC() do { for (int rs_ = 0; rs_ < REP_SYNC; ++rs_) xcd_barrier(xb); } while (0)


#define XB_TMO      128
#define XB_XCNT(j)  (256  + 64 * (j))
#define XB_XSUB(j)  (1280 + 64 * (j))
#define XB_XGEN(j)  (2304 + 64 * (j))
#define XB_TOP      3328
#define XB_TOPGEN   3392
#define XCD_BAR_WORDS 3456
#define XB_SPIN_CAP (1u << 21)
#define LAS __attribute__((address_space(3)))
DI unsigned xb_ld(unsigned* p)              { return __hip_atomic_load(p, __ATOMIC_RELAXED, __HIP_MEMORY_SCOPE_AGENT); }
DI unsigned xb_add(unsigned* p, unsigned v) { return __hip_atomic_fetch_add(p, v, __ATOMIC_RELAXED, __HIP_MEMORY_SCOPE_AGENT); }
DI unsigned xb_xcc_id() { return (unsigned)__builtin_amdgcn_s_getreg((3 << 11) | 20) & 0xFu; }
#define XB_SPIN(cond, bar) do { unsigned _sp = 0; while (cond) { __builtin_amdgcn_s_sleep(1); \
    if ((++_sp & 255u) == 0u) { if (xb_ld(&(bar)[XB_TMO])) break; if (_sp > XB_SPIN_CAP) { atomicAdd(&(bar)[XB_TMO], 1u); break; } } } } while (0)
struct XcdBarrier { unsigned* bar; unsigned x; volatile LAS unsigned* st; };
DI XcdBarrier xcd_barrier_post(unsigned* bar, volatile LAS unsigned* st) {
  XcdBarrier b; b.bar = bar; b.x = xb_xcc_id(); b.st = st;
  if (threadIdx.x == 0) { const unsigned rank = xb_add(&bar[XB_XCNT(b.x)], 1u); st[2] = rank; }
  return b;
}
DI void xcd_barrier_complete(unsigned* bar, unsigned x, unsigned& nloc, unsigned& nx) {
  const unsigned G = gridDim.x * gridDim.y * gridDim.z;
  unsigned sum, cnt, mine, sp = 0u;
  for (;;) {
    sum = 0u; cnt = 0u; mine = 0u;
#pragma unroll
    for (unsigned j = 0; j < 16; ++j) { const unsigned c = xb_ld(&bar[XB_XCNT(j)]); sum += c; cnt += (c > 0u) ? 1u : 0u; mine = (j == x) ? c : mine; }
    if (sum == G) break;
    __builtin_amdgcn_s_sleep(1);
    if ((++sp & 255u) == 0u) { if (xb_ld(&bar[XB_TMO])) break; if (sp > XB_SPIN_CAP) { atomicAdd(&bar[XB_TMO], 1u); break; } }
  }
  nloc = mine > 0u ? mine : 1u; nx = cnt > 0u ? cnt : 1u;
}
DI void xcd_barrier(const XcdBarrier& b) {
  asm volatile("s_waitcnt vmcnt(0)" ::: "memory");
  __syncthreads();
  if (threadIdx.x == 0) {
    unsigned* bar = b.bar;
    __builtin_amdgcn_s_waitcnt(0);
    unsigned nloc = b.st[0], nx = b.st[1];
    if (nloc == 0u) { xcd_barrier_complete(bar, b.x, nloc, nx); b.st[0] = nloc; b.st[1] = nx; }
    const unsigned old = xb_add(&bar[XB_XSUB(b.x)], 1u);
    const unsigned gen = old / nloc;
    if (old + 1u == (gen + 1u) * nloc) {
      __builtin_amdgcn_fence(__ATOMIC_RELEASE, "agent");
      asm volatile("s_waitcnt vmcnt(0)" ::: "memory");
      const unsigned og = xb_add(&bar[XB_TOP], 1u);
      const unsigned tg = og / nx;
      if (og + 1u == (tg + 1u) * nx) xb_add(&bar[XB_TOPGEN], 1u);
      else XB_SPIN(xb_ld(&bar[XB_TOPGEN]) == tg, bar);
      __builtin_amdgcn_fence(__ATOMIC_ACQUIRE, "agent");
      xb_add(&bar[XB_XGEN(b.x)], 1u);
      asm volatile("s_waitcnt vmcnt(0)" ::: "memory");
    } else {
      XB_SPIN(xb_ld(&bar[XB_XGEN(b.x)]) == gen, bar);
      __builtin_amdgcn_fence(__ATOMIC_ACQUIRE, "agent");
      asm volatile("s_waitcnt vmcnt(0)" ::: "memory");
    }
  }
  __syncthreads();
}
constexpr size_t O_BAR = O_MISC + 16384;
constexpr size_t O_ROPE = O_MISC + 65536;

struct Params {
  const float* x_prompt; const float* x_sample;
  const float* ffn1_norm; const float* ffn1_w_in; const float* ffn1_w_out; const float* mix_norm; const float* w_in;
  const float* hy_conv_w; const float* hy_conv_b; const float* hy_w1; const float* hy_b1; const float* hy_w2; const float* hy_b2;
  const float* hy_w3; const float* hy_freq; const float* hy_skip;
  const float* gqa_q_norm; const float* gqa_k_norm; const float* diff_lambda; const float* diff_subln; const float* rel_bias;
  const float* w_branch; const float* w_out; const float* ffn2_norm; const float* ffn2_w_in; const float* ffn2_w_out; const float* final_norm;
  float* out; char* ws;
};

DI unsigned pack2(float a, float b) { f2_t v = {a, b}; bf2_t r = __builtin_convertvector(v, bf2_t); return __builtin_bit_cast(unsigned, r); }
DI u16 f2bf(float a) { return (u16)(pack2(a, 0.f) & 0xffffu); }
DI float bf2f(u16 v) { return __uint_as_float(((unsigned)v) << 16); }
DI float bflo(unsigned v) { return __uint_as_float(v << 16); }
DI float bfhi(unsigned v) { return __uint_as_float(v & 0xffff0000u); }
DI int otid() { int t = threadIdx.x; asm volatile("" : "+v"(t)); return t; }
DI int crow(int reg, int h) { return (reg & 3) + 8 * (reg >> 2) + 4 * h; }
DI float wave_sum(float v) {
  v += __shfl_xor(v, 32); v += __shfl_xor(v, 16); v += __shfl_xor(v, 8); v += __shfl_xor(v, 4); v += __shfl_xor(v, 2); v += __shfl_xor(v, 1);
  return v;
}
DI float half_sum(float v) {
  v += __shfl_xor(v, 16); v += __shfl_xor(v, 8); v += __shfl_xor(v, 4); v += __shfl_xor(v, 2); v += __shfl_xor(v, 1);
  return v;
}

DI void convT_tile(const float* __restrict__ src, int K, int N, u16* __restrict__ dst, int kt, int nt, int perm_half, char* smem) {
  float* t = (float*)smem;
  const int tid = otid() & 255;
  __syncthreads();
  {
    const int col = tid & 63, r0 = tid >> 6;
#pragma unroll
    for (int i = 0; i < 16; ++i) { int row = r0 + 4 * i; t[row * 65 + col] = src[(size_t)(kt * 64 + row) * N + nt * 64 + col]; }
  }
  __syncthreads();
  {
    const int nl = tid >> 2, kq = tid & 3;
    int n = nt * 64 + nl;
    if (perm_half > 0) { if (n < perm_half) n = (n >> 7) * 256 + (n & 127); else { int j = n - perm_half; n = (j >> 7) * 256 + 128 + (j & 127); } }
    u32x4 o0, o1;
#pragma unroll
    for (int i = 0; i < 4; ++i) {
      o0[i] = pack2(t[(kq * 16 + 2 * i) * 65 + nl], t[(kq * 16 + 2 * i + 1) * 65 + nl]);
      o1[i] = pack2(t[(kq * 16 + 8 + 2 * i) * 65 + nl], t[(kq * 16 + 8 + 2 * i + 1) * 65 + nl]);
    }
    u16* d = dst + (size_t)n * K + kt * 64 + kq * 16;
    *(u32x4*)d = o0; *(u32x4*)(d + 8) = o1;
  }
}

DI void filter_item(const Params& P, int layer, int L, int tb, u16* __restrict__ G, char* smem) {
  float* h1 = (float*)smem;
  float* h2 = h1 + 64 * 65;
  const int tid = otid() & 255, lane = tid & 63, w = __builtin_amdgcn_readfirstlane(tid >> 6);
  const float* w1 = P.hy_w1 + layer * 33 * 64; const float* b1 = P.hy_b1 + layer * 64;
  const float* w2 = P.hy_w2 + layer * 64 * 64; const float* b2 = P.hy_b2 + layer * 64;
  const float* w3 = P.hy_w3 + layer * 64 * 1024; const float* fr = P.hy_freq + layer * 64;
  const int t = tb * 64 + lane;
  const float tl = (float)t / (float)(L - 1);
  __syncthreads();
  {
    float a[16];
#pragma unroll
    for (int u = 0; u < 16; ++u) a[u] = b1[w * 16 + u] + tl * w1[w * 16 + u];
    const float base = (float)(2.0 * 3.14159265358979323846 / (double)L) * (float)t;
    for (int b = 0; b < 16; ++b) {
      const float band = 1e-4f + (float)b * ((15.0f - 1e-4f) / 15.0f);
      const float ang = base * band;
      const float cs = cosf(ang), sn = -sinf(ang);
#pragma unroll
      for (int u = 0; u < 16; ++u) a[u] += cs * w1[(1 + b) * 64 + w * 16 + u] + sn * w1[(17 + b) * 64 + w * 16 + u];
    }
#pragma unroll
    for (int u = 0; u < 16; ++u) h1[lane * 65 + w * 16 + u] = sinf(fr[w * 16 + u] * a[u]);
  }
  __syncthreads();
  {
    float a[16];
#pragma unroll
    for (int u = 0; u < 16; ++u) a[u] = b2[w * 16 + u];
    for (int k = 0; k < 64; ++k) {
      const float hv = h1[lane * 65 + k];
#pragma unroll
      for (int u = 0; u < 16; ++u) a[u] += hv * w2[k * 64 + w * 16 + u];
    }
#pragma unroll
    for (int u = 0; u < 16; ++u) h2[lane * 65 + w * 16 + u] = sinf(fr[w * 16 + u] * a[u]);
  }
  __syncthreads();
  const float min_decay = -3.0701134573253946f, max_decay = -15.350567286626973f;
  for (int og = 0; og < 64; ++og) {
    const int o = w * 256 + og * 4;
    float a0 = 0.f, a1 = 0.f, a2 = 0.f, a3 = 0.f;
#pragma unroll 4
    for (int k = 0; k < 64; ++k) {
      const float hv = h2[lane * 65 + k];
      const f32x4 wv = *(const f32x4*)(w3 + k * 1024 + o);
      a0 += hv * wv[0]; a1 += hv * wv[1]; a2 += hv * wv[2]; a3 += hv * wv[3];
    }
    float av[4] = {a0, a1, a2, a3};
#pragma unroll
    for (int q = 0; q < 4; ++q) {
      const int oo = o + q; const int ch = oo & 511;
      const float delta = min_decay + (float)ch * ((max_decay - min_decay) / 511.0f);
      const float val = av[q] * expf(-tl * fabsf(delta));
      u16* Gc = G + (size_t)ch * (2 * L);
      if (oo < 512) Gc[L - t] = f2bf(val);
      else { if (t >= 1) Gc[L + t] = f2bf(val); else Gc[0] = 0; }
    }
  }
}

DI void norm_row_bf16(const float* __restrict__ x, const float* __restrict__ g, u16* __restrict__ out, int lane) {
  f32x4 v[4]; float ss = 0.f;
#pragma unroll
  for (int i = 0; i < 4; ++i) { v[i] = *(const f32x4*)(x + lane * 4 + 256 * i); ss += v[i][0] * v[i][0] + v[i][1] * v[i][1] + v[i][2] * v[i][2] + v[i][3] * v[i][3]; }
  ss = wave_sum(ss);
  const float rs = rsqrtf(ss * (1.0f / 1024.0f) + 1e-6f);
#pragma unroll
  for (int i = 0; i < 4; ++i) {
    const f32x4 gg = *(const f32x4*)(g + lane * 4 + 256 * i);
    u32x2 o; o[0] = pack2(v[i][0] * rs * gg[0], v[i][1] * rs * gg[1]); o[1] = pack2(v[i][2] * rs * gg[2], v[i][3] * rs * gg[3]);
    *(u32x2*)(out + lane * 4 + 256 * i) = o;
  }
}
DI void norm_row_f32_inplace(float* __restrict__ x, const float* __restrict__ g, int lane) {
  f32x4 v[4]; float ss = 0.f;
#pragma unroll
  for (int i = 0; i < 4; ++i) { v[i] = *(const f32x4*)(x + lane * 4 + 256 * i); ss += v[i][0] * v[i][0] + v[i][1] * v[i][1] + v[i][2] * v[i][2] + v[i][3] * v[i][3]; }
  ss = wave_sum(ss);
  const float rs = rsqrtf(ss * (1.0f / 1024.0f) + 1e-6f);
#pragma unroll
  for (int i = 0; i < 4; ++i) {
    const f32x4 gg = *(const f32x4*)(g + lane * 4 + 256 * i);
    f32x4 o; o[0] = v[i][0] * rs * gg[0]; o[1] = v[i][1] * rs * gg[1]; o[2] = v[i][2] * rs * gg[2]; o[3] = v[i][3] * rs * gg[3];
    *(f32x4*)(x + lane * 4 + 256 * i) = o;
  }
}

namespace pg8 {
#define PG8_LAS __attribute__((address_space(3)))
typedef unsigned short bf16_t;
typedef short bf16x8 __attribute__((ext_vector_type(8)));
typedef float f32x4 __attribute__((ext_vector_type(4)));
typedef unsigned u32x4 __attribute__((ext_vector_type(4)));
constexpr int BM = 256, BK = 64, HALF = 128, HTB = HALF * BK * 2  , STAGE_BYTES = 8 * HTB, NXCD = 8, WGM = 8;

__host__ __device__ __forceinline__ int lds_byte(int r, int c) { const int st = (r >> 4) * 2 + (c >> 5), rr = r & 15, cc = c & 31, ob = rr * 64 + cc * 2; return st * 1024 + (ob ^ (((ob >> 9) & 1) << 5)); }
__host__ __device__ __forceinline__ void stage_rc(int b, int& R, int& C) { const int st = b / 1024, sb = b % 1024, swz = sb ^ (((sb >> 9) & 1) << 5); R = (st >> 1) * 16 + swz / 64; C = (st & 1) * 32 + (swz % 64) / 2; }
__host__ __device__ __forceinline__ int perm32(int rho) { const int n = rho >> 4, i = rho & 15; return 8 * (i >> 2) + 4 * n + (i & 3); }

struct Unit { int pm, pn; };
struct Gemm { const bf16_t* A; const bf16_t* Bt; int M, N, K; };

struct StaticOrder {
    int nM, nN, nwg, G, c;
    __host__ __device__ void init(int M, int N, int G_, int c_) { nM = M / BM; nN = N / BM; nwg = nM * nN; G = G_; c = c_; }
    __host__ __device__ bool next(int i, Unit& u) const {
        const long L = (long)i * G + c; if (L >= nwg) return false;
        int wgid = (int)L; { const int q = nwg / NXCD, r = nwg % NXCD, xcd = wgid % NXCD, off = wgid / NXCD; wgid = (xcd < r ? xcd * (q + 1) : r * (q + 1) + (xcd - r) * q) + off; }
        const int nig = WGM * nN, gid = wgid / nig, fm = gid * WGM, gsz = (nM - fm) < WGM ? (nM - fm) : WGM;
        u.pm = fm + ((wgid % nig) % gsz); u.pn = (wgid % nig) / gsz; return true;
    }
    __device__ __forceinline__ void a_ready(const Unit&) const {}
    __device__ __forceinline__ void done(const Unit&) const {}
};

template <class Epi, class Sched, bool STAMP = false>
__device__ __forceinline__ void gemm_phase(PG8_LAS unsigned char* lds, const Gemm g, const Sched& S, const Epi& E, unsigned long long* stamps) {
    const int tid = otid(), wid = __builtin_amdgcn_readfirstlane(tid >> 6), lane = tid & 63, wr = wid >> 2, wc = wid & 3, fr = lane & 15, fq = lane >> 4;
    const int K = g.K, nt = K / BK;
    int ts_lo = 0, ts_hi = 0, nts = 0; const unsigned long long rt_entry = STAMP ? (unsigned long long)wall_clock64() : 0ull;
#define PG8_STAMP() do { if (STAMP && wid == 0 && nts < 64) { const unsigned long long _c = (unsigned long long)clock64(); \
        ts_lo = (lane == nts) ? (int)(unsigned)_c : ts_lo; ts_hi = (lane == nts) ? (int)(unsigned)(_c >> 32) : ts_hi; ++nts; } } while (0)
    PG8_STAMP();
    unsigned voffA[2], voffB[2];
#pragma unroll
    for (int i = 0; i < 2; ++i) { int R, C; stage_rc(tid * 16 + i * 8192, R, C); const int Rb = E.perm ? ((R & ~31) + perm32(R & 31)) : R;
        voffA[i] = (unsigned)(R * K + C) * 2u; voffB[i] = (unsigned)(Rb * K + C) * 2u; }
    const size_t kstep = (size_t)(BK * 2);
    const size_t hstep = (size_t)HALF * K * 2;
    const size_t tstep = 2 * hstep;
    const unsigned ldsw = (unsigned)wid * 1024u;
    const int aoff = lds_byte(wr * 64 + fr, fq * 8), boff = lds_byte(wc * 32 + fr, fq * 8);
#define PG8_SA(b, h) (((b) * 2 + (h)) * HTB)
#define PG8_SB(b, h) ((4 + (b) * 2 + (h)) * HTB)
#define PG8_STAGE(bufoff, gbase, voff) do { _Pragma("unroll") for (int _i = 0; _i < 2; ++_i) \
        __builtin_amdgcn_global_load_lds((const unsigned*)((const char*)(gbase) + (voff)[_i]), (PG8_LAS unsigned*)(lds + (bufoff) + ldsw + _i * 8192), 16, 0, 0); } while (0)
#define PG8_LDA(dst, b, h) do { _Pragma("unroll") for (int m = 0; m < 4; ++m) _Pragma("unroll") for (int k = 0; k < 2; ++k) dst[m][k] = *(const PG8_LAS bf16x8*)(lds + PG8_SA(b, h) + aoff + m * 2048 + k * 1024); } while (0)
#define PG8_LDB(dst, b, h) do { _Pragma("unroll") for (int n = 0; n < 2; ++n) _Pragma("unroll") for (int k = 0; k < 2; ++k) dst[n][k] = *(const PG8_LAS bf16x8*)(lds + PG8_SB(b, h) + boff + n * 2048 + k * 1024); } while (0)
#define PG8_MMA(ai, bj, At, Bt) do { __builtin_amdgcn_s_setprio(1); _Pragma("unroll") for (int m = 0; m < 4; ++m) _Pragma("unroll") for (int n = 0; n < 2; ++n) _Pragma("unroll") for (int k = 0; k < 2; ++k) \
        acc[ai][bj][m][n] = __builtin_amdgcn_mfma_f32_16x16x32_bf16(Bt[n][k], At[m][k], acc[ai][bj][m][n], 0, 0, 0); __builtin_amdgcn_s_setprio(0); } while (0)
#define PG8_WAIT_V(n) asm volatile("s_waitcnt vmcnt(" #n ")" ::: "memory")
#define PG8_WAIT_L(n) asm volatile("s_waitcnt lgkmcnt(" #n ")" ::: "memory")
#define PG8_BAR __builtin_amdgcn_s_barrier()
#define PG8_SCHED __builtin_amdgcn_sched_barrier(0)
    Unit cur, nxt; int ui = 0;
    if (!S.next(0, cur)) return;
    f32x4 acc[2][2][4][2];
#pragma unroll
    for (int a = 0; a < 2; ++a)
#pragma unroll
        for (int b = 0; b < 2; ++b)
#pragma unroll
            for (int m = 0; m < 4; ++m)
#pragma unroll
                for (int n = 0; n < 2; ++n) acc[a][b][m][n] = (f32x4){0.f, 0.f, 0.f, 0.f};
    bf16x8 At[4][2], B0[2][2], B1[2][2];
    const char* cA = (const char*)g.A + (size_t)cur.pm * tstep; const char* cB = (const char*)g.Bt + (size_t)cur.pn * tstep;
    S.a_ready(cur);
    PG8_STAGE(PG8_SB(0, 0), cB, voffB); PG8_STAGE(PG8_SA(0, 0), cA, voffA); PG8_STAGE(PG8_SB(0, 1), cB + hstep, voffB); PG8_STAGE(PG8_SA(0, 1), cA + hstep, voffA);
    if (wr == 1) PG8_BAR;
    PG8_WAIT_V(4); PG8_BAR;
    PG8_STAGE(PG8_SB(1, 0), cB + kstep, voffB); PG8_STAGE(PG8_SA(1, 0), cA + kstep, voffA); PG8_STAGE(PG8_SB(1, 1), cB + hstep + kstep, voffB);
    PG8_WAIT_V(6); PG8_BAR;
    PG8_STAMP();
    for (;;) {
        const bool has_next = S.next(ui + 1, nxt);
        const char* nA = has_next ? (const char*)g.A + (size_t)nxt.pm * tstep : cA; const char* nB = has_next ? (const char*)g.Bt + (size_t)nxt.pn * tstep : cB;
        for (int t = 0; t < nt; t += 2) {
            const bool last = (t == nt - 2);
            const char* a1 = cA + (size_t)(t + 1) * kstep;
            const char* a2 = last ? nA : cA + (size_t)(t + 2) * kstep; const char* b2 = last ? nB : cB + (size_t)(t + 2) * kstep;
            const char* a3 = a2 + kstep; const char* b3 = b2 + kstep;
            if (last && has_next) S.a_ready(nxt);
            PG8_LDB(B0, 0, 0); PG8_SCHED; PG8_LDA(At, 0, 0); PG8_STAGE(PG8_SA(1, 1), a1 + hstep, voffA);
            PG8_WAIT_L(8); PG8_BAR; PG8_WAIT_L(0); PG8_MMA(0, 0, At, B0); PG8_BAR; PG8_SCHED;
            PG8_LDB(B1, 0, 1); PG8_STAGE(PG8_SB(0, 0), b2, voffB);
            PG8_BAR; PG8_WAIT_L(0); PG8_MMA(0, 1, At, B1); PG8_BAR;
            PG8_LDA(At, 0, 1); PG8_STAGE(PG8_SA(0, 0), a2, voffA);
            PG8_BAR; PG8_WAIT_L(0); PG8_MMA(1, 0, At, B0); PG8_BAR; PG8_SCHED;
            PG8_STAGE(PG8_SB(0, 1), b2 + hstep, voffB);
            PG8_WAIT_V(6); PG8_BAR; PG8_MMA(1, 1, At, B1); PG8_BAR;
            PG8_LDB(B0, 1, 0); PG8_SCHED; PG8_LDA(At, 1, 0); PG8_STAGE(PG8_SA(0, 1), a2 + hstep, voffA);
            PG8_WAIT_L(8); PG8_BAR; PG8_WAIT_L(0); PG8_MMA(0, 0, At, B0); PG8_BAR; PG8_SCHED;
            PG8_LDB(B1, 1, 1); PG8_STAGE(PG8_SB(1, 0), b3, voffB);
            PG8_BAR; PG8_WAIT_L(0); PG8_MMA(0, 1, At, B1); PG8_BAR;
            PG8_LDA(At, 1, 1); PG8_STAGE(PG8_SA(1, 0), a3, voffA);
            PG8_BAR; PG8_WAIT_L(0); PG8_MMA(1, 0, At, B0); PG8_BAR; PG8_SCHED;
            PG8_STAGE(PG8_SB(1, 1), b3 + hstep, voffB);
            PG8_WAIT_V(6); PG8_BAR; PG8_MMA(1, 1, At, B1); PG8_BAR;
        }
        PG8_STAMP();
        if constexpr (!Epi::AFTER_DRAIN) { E(acc, cur, wr, wc, fr, fq); S.done(cur); }
        PG8_STAMP();
        if (!has_next) break;
#pragma unroll
        for (int a = 0; a < 2; ++a)
#pragma unroll
            for (int b = 0; b < 2; ++b)
#pragma unroll
                for (int m = 0; m < 4; ++m)
#pragma unroll
                    for (int n = 0; n < 2; ++n) acc[a][b][m][n] = (f32x4){0.f, 0.f, 0.f, 0.f};
        cur = nxt; cA = nA; cB = nB; ++ui;
    }
    PG8_WAIT_V(0);
    if (wr == 0) PG8_BAR;
    PG8_BAR;
    if constexpr (Epi::AFTER_DRAIN) { E.fused(acc, cur, wr, wc, fr, fq, lds, wid, lane); S.done(cur); }
    PG8_STAMP();
    if (STAMP && wid == 0) { stamps[lane] = lane < nts ? (((unsigned long long)(unsigned)ts_hi << 32) | (unsigned)ts_lo) : 0ull;
        if (lane == 62) stamps[62] = rt_entry; if (lane == 63) stamps[63] = (unsigned long long)wall_clock64(); }
#undef PG8_STAMP
#undef PG8_SA
#undef PG8_SB
#undef PG8_STAGE
#undef PG8_LDA
#undef PG8_LDB
#undef PG8_MMA
#undef PG8_WAIT_V
#undef PG8_WAIT_L
#undef PG8_BAR
#undef PG8_SCHED
}
}

enum { EPI_SWIGLU = 0, EPI_RESID = 1, EPI_PROJ = 2, EPI_MERGE = 3 };
struct AnyOrder : pg8::StaticOrder {
  bool merge3;
  __device__ __forceinline__ bool next(int i, pg8::Unit& u) const {
    if (!merge3) return pg8::StaticOrder::next(i, u);
    const int ti = i / 3, br = i - ti * 3; pg8::Unit t;
    if (!pg8::StaticOrder::next(ti, t)) return false;
    u.pm = t.pm + 64 * br; u.pn = t.pn + 4 * br; return true;
  }
};
struct EpiAny {
  static constexpr bool AFTER_DRAIN = false;
  int mode; bool perm;
  u16* O; int ldo; const float* xin; float* xout; float scale; const u16* gate; float* macc; int br;
  DI void operator()(const pg8::f32x4 (&acc)[2][2][4][2], const pg8::Unit& u, int wr, int wc, int fr, int fq) const {
    const int row0 = (u.pm & 63) * 256 + wr * 64 + fr;
    if (mode == EPI_SWIGLU) {
      const int col0 = u.pn * 128 + wc * 32 + 8 * fq;
#pragma unroll
      for (int ai = 0; ai < 2; ++ai)
#pragma unroll
        for (int m = 0; m < 4; ++m) {
          float v[8];
#pragma unroll
          for (int n = 0; n < 2; ++n)
#pragma unroll
            for (int e = 0; e < 4; ++e) { const float gv = acc[ai][0][m][n][e], uv = acc[ai][1][m][n][e]; v[4 * n + e] = gv * __builtin_amdgcn_rcpf(1.0f + __builtin_amdgcn_exp2f(-LOG2E * gv)) * uv; }
          u32x4 o; o[0] = pack2(v[0], v[1]); o[1] = pack2(v[2], v[3]); o[2] = pack2(v[4], v[5]); o[3] = pack2(v[6], v[7]);
          *(u32x4*)(O + (size_t)(row0 + ai * 128 + m * 16) * ldo + col0) = o;
        }
    } else if (mode == EPI_PROJ) {
      const int col0 = u.pn * 256 + wc * 32 + 8 * fq;
      const bool sg = (u.pn * 256 >= OFF_GATE);
#pragma unroll
      for (int ai = 0; ai < 2; ++ai)
#pragma unroll
        for (int m = 0; m < 4; ++m)
#pragma unroll
          for (int bj = 0; bj < 2; ++bj) {
            float v[8];
#pragma unroll
            for (int n = 0; n < 2; ++n)
#pragma unroll
              for (int e = 0; e < 4; ++e) { float t = acc[ai][bj][m][n][e]; if (sg) t = __builtin_amdgcn_rcpf(1.0f + __builtin_amdgcn_exp2f(-LOG2E * t)); v[4 * n + e] = t; }
            u32x4 o; o[0] = pack2(v[0], v[1]); o[1] = pack2(v[2], v[3]); o[2] = pack2(v[4], v[5]); o[3] = pack2(v[6], v[7]);
            *(u32x4*)(O + (size_t)(row0 + ai * 128 + m * 16) * INC + col0 + bj * 128) = o;
          }
    } else if (mode == EPI_RESID) {
      const int col0 = u.pn * 256 + wc * 32 + 4 * fq;
#pragma unroll
      for (int ai = 0; ai < 2; ++ai)
#pragma unroll
        for (int m = 0; m < 4; ++m)
#pragma unroll
          for (int bj = 0; bj < 2; ++bj)
#pragma unroll
            for (int n = 0; n < 2; ++n) {
              const size_t idx = (size_t)(row0 + ai * 128 + m * 16) * DM + col0 + bj * 128 + n * 16;
              f32x4 xv = *(const f32x4*)(xin + idx);
#pragma unroll
              for (int e = 0; e < 4; ++e) xv[e] += scale * acc[ai][bj][m][n][e];
              *(f32x4*)(xout + idx) = xv;
            }
    } else {
      const int col0 = (u.pn & 3) * 256 + wc * 32 + 4 * fq; const int br = u.pm >> 6;
#pragma unroll
      for (int ai = 0; ai < 2; ++ai)
#pragma unroll
        for (int m = 0; m < 4; ++m)
#pragma unroll
          for (int bj = 0; bj < 2; ++bj)
#pragma unroll
            for (int n = 0; n < 2; ++n) {
              const int row = row0 + ai * 128 + m * 16, col = col0 + bj * 128 + n * 16;
              const u32x2 gt = *(const u32x2*)(gate + (size_t)row * INC + OFF_GATE + br * DM + col);
              f32x4 v;
              v[0] = bflo(gt[0]) * acc[ai][bj][m][n][0]; v[1] = bfhi(gt[0]) * acc[ai][bj][m][n][1];
              v[2] = bflo(gt[1]) * acc[ai][bj][m][n][2]; v[3] = bfhi(gt[1]) * acc[ai][bj][m][n][3];
              const size_t idx = (size_t)row * DM + col;
              if (br > 0) { const f32x4 pv = *(const f32x4*)(macc + idx); v[0] += pv[0]; v[1] += pv[1]; v[2] += pv[2]; v[3] += pv[3]; }
              if (br < 2) *(f32x4*)(macc + idx) = v;
              else { u32x2 o; o[0] = pack2(v[0], v[1]); o[1] = pack2(v[2], v[3]); *(u32x2*)(outb_() + idx) = o; }
            }
    }
  }
  DI u16* outb_() const { return O; }
};

DI void qk_prep_item(const Params& P, int layer, u16* __restrict__ p, int L, int it, const float* __restrict__ rope) {
  const int tid = otid() & 255, lane = tid & 63, w = __builtin_amdgcn_readfirstlane(tid >> 6);
  const int u = it * 8 + w * 2 + (lane >> 5);
  const int tok = u / 10, hd = u - tok * 10;
  const int i = lane & 31;
  const int col0 = (hd < 8) ? (OFF_GQ + hd * 64) : (OFF_GK + (hd - 8) * 64);
  const float* gn = (hd < 8) ? (P.gqa_q_norm + layer * 64) : (P.gqa_k_norm + layer * 64);
  unsigned* ptr = (unsigned*)(p + (size_t)tok * INC + col0) + i;
  const unsigned v = *ptr;
  float a = bflo(v), b = bfhi(v);
  const float ss = half_sum(a * a + b * b);
  const float rs = rsqrtf(ss * (1.0f / 64.0f) + 1e-6f);
  a = a * rs * gn[2 * i]; b = b * rs * gn[2 * i + 1];
  const int tl = tok % L;
  const int jj = i & 15;
  const float* rt = rope + ((i < 16) ? ((tl >> 6) * 16 + jj) : (4096 + (tl & 63) * 16 + jj)) * 2;
  const float c = rt[0], s = rt[1];
  *ptr = pack2(a * c - b * s, a * s + b * c);
}

DI void transpose_item(const Params& P, int layer, const u16* __restrict__ p, int L, int kind, int ct, int tt, u16* __restrict__ dst, char* smem) {
  u16* tile = (u16*)smem;
  const int tid = otid() & 255;
  const int t0 = tt * 64;
  const int seq = t0 / L, tl0 = t0 - seq * L;
  const int C = (kind == 0) ? 128 : 512;
  __syncthreads();
  {
    const int col = tid & 63, r0 = tid >> 6;
    const int cidx = ct * 64 + col;
    if (kind < 2) {
      const int off = (kind == 0 ? OFF_GV : OFF_DV) + cidx;
#pragma unroll
      for (int i = 0; i < 16; ++i) { const int row = r0 + 4 * i; tile[col * 72 + row] = p[(size_t)(t0 + row) * INC + off]; }
    } else {
      const float* cw = P.hy_conv_w + layer * 3 * 1536; const float* cb = P.hy_conv_b + layer * 1536;
      const int c1 = 512 + cidx, c2 = 1024 + cidx;
      const float w10 = cw[c1], w11 = cw[1536 + c1], w12 = cw[3072 + c1], b1 = cb[c1];
      const float w20 = cw[c2], w21 = cw[1536 + c2], w22 = cw[3072 + c2], b2 = cb[c2];
#pragma unroll
      for (int i = 0; i < 16; ++i) {
        const int row = r0 + 4 * i; const int tl = tl0 + row;
        const u16* pr = p + (size_t)(t0 + row) * INC;
        const float xm1 = (tl > 0) ? bf2f(pr[c1 - INC]) : 0.f, x0 = bf2f(pr[c1]), xp1 = (tl < L - 1) ? bf2f(pr[c1 + INC]) : 0.f;
        const float vm1 = (tl > 0) ? bf2f(pr[c2 - INC]) : 0.f, v0 = bf2f(pr[c2]), vp1 = (tl < L - 1) ? bf2f(pr[c2 + INC]) : 0.f;
        const float x1c = xm1 * w10 + x0 * w11 + xp1 * w12 + b1;
        const float vc = vm1 * w20 + v0 * w21 + vp1 * w22 + b2;
        tile[col * 72 + row] = f2bf(vc * x1c);
      }
    }
  }
  __syncthreads();
  {
    const int c = tid >> 2, q = tid & 3;
    const u32x4 a = *(const u32x4*)(tile + c * 72 + q * 16), b = *(const u32x4*)(tile + c * 72 + q * 16 + 8);
    u16* d = dst + ((size_t)seq * C + ct * 64 + c) * L + tl0 + q * 16;
    *(u32x4*)d = a; *(u32x4*)(d + 8) = b;
  }
}

DI int kperm(int rho) { return (rho & ~0xC) | ((rho & 4) << 1) | ((rho & 8) >> 1); }
template <int DV, bool BIAS, bool SWAP>
DI void attn_tile(const u16* __restrict__ Qp, const u16* __restrict__ Kp, const u16* __restrict__ VTp, int L,
                  u16* __restrict__ Op, int ldo, int q0, const float* __restrict__ btab, char* smem) {
  constexpr int NDT = DV / 32;
  constexpr int VCH = DV / 64;
  constexpr int KS_SZ = 64 * 64, VS_SZ = DV * 64;
  constexpr int NL = 1 + VCH;
  u16* Ks = (u16*)smem;
  u16* Vs = Ks + 4 * KS_SZ;
  float* bt = (float*)(Vs + 3 * VS_SZ);
  const int tid = otid(), lane = tid & 63, w = __builtin_amdgcn_readfirstlane(tid >> 6), r = lane & 31, h = lane >> 5;
  const float sc = 0.125f * LOG2E;
  __syncthreads();
  if (BIAS) { for (int i = tid; i < 257; i += 512) bt[i] = btab[i]; }
  bf16x8 qf[4];
  {
    const u16* qrow = Qp + (size_t)(q0 + 32 * w + r) * INC + 8 * h;
#pragma unroll
    for (int s = 0; s < 4; ++s) qf[s] = *(const bf16x8*)(qrow + 16 * s);
  }
  const int qpos = q0 + 32 * w + r;
  f32x16 O[NDT];
#pragma unroll
  for (int d = 0; d < NDT; ++d)
#pragma unroll
    for (int q = 0; q < 16; ++q) O[d][q] = 0.f;
  float m = -INFINITY, l = 0.f;
  const int lrow = tid >> 3, lsw = (tid & 7) ^ ((tid >> 4) & 7);
  const u16* Kg0 = Kp + (size_t)kperm(lrow) * INC + lsw * 8;
  const u16* Vg = VTp + (size_t)lrow * L + lsw * 8;
  const int ksw = (r >> 1) & 7;
  const int nkb = L >> 6;
#define ATT_LOADK(tile, bufp) do { const int t__ = ((tile) < nkb) ? (tile) : nkb - 1; \
    __builtin_amdgcn_global_load_lds((const unsigned*)(Kg0 + ((size_t)t__ * 64) * INC), (unsigned*)((char*)(bufp) + tid * 16), 16, 0, 0); } while (0)
#define ATT_LOADV(tile, bufp) do { const int t__ = ((tile) < nkb) ? (tile) : nkb - 1; _Pragma("unroll") for (int i_ = 0; i_ < VCH; ++i_) \
    __builtin_amdgcn_global_load_lds((const unsigned*)(Vg + (size_t)(64 * i_) * L + (size_t)t__ * 64), (unsigned*)((char*)(bufp) + tid * 16 + i_ * 8192), 16, 0, 0); } while (0)
  f32x16 Sc[2];
  auto qk = [&](const u16* Kb) __attribute__((always_inline)) {
    bf16x8 kf[2][4];
#pragma unroll
    for (int kt = 0; kt < 2; ++kt)
#pragma unroll
      for (int s = 0; s < 4; ++s) kf[kt][s] = *(const bf16x8*)(Kb + (32 * kt + r) * 64 + (((2 * s + h) ^ ksw) << 3));
#pragma unroll
    for (int kt = 0; kt < 2; ++kt) {
#pragma unroll
      for (int q = 0; q < 16; ++q) Sc[kt][q] = 0.f;
#pragma unroll
      for (int s = 0; s < 4; ++s) Sc[kt] = MFMA(kf[kt][s], qf[s], Sc[kt]);
    }
    __builtin_amdgcn_sched_group_barrier(0x100, 8, 0);
    __builtin_amdgcn_sched_group_barrier(0x008, 8, 0);
  };
  bf16x8 pf[2][2];
  auto softmax = [&](int kb) __attribute__((always_inline)) {
    float cb = 0.f; bool near = false;
    if (BIAS) {
      const int kmin = kb * 64;
      near = !(kmin - (q0 + 255) >= 128 || q0 - (kmin + 63) >= 128);
      cb = (kmin > q0) ? bt[256] : bt[0];
      if (near) {
        const float isc = 1.0f / sc;
#pragma unroll
        for (int kt = 0; kt < 2; ++kt)
#pragma unroll
          for (int q = 0; q < 16; ++q) {
            int rel = kmin + 32 * kt + kperm(crow(q, h)) - qpos;
            rel = rel < -128 ? -128 : (rel > 128 ? 128 : rel);
            Sc[kt][q] += bt[rel + 128] * isc;
          }
        cb = 0.f;
      }
    }
    float mx = Sc[0][0];
#pragma unroll
    for (int kt = 0; kt < 2; ++kt)
#pragma unroll
      for (int q = 0; q < 16; ++q) mx = fmaxf(mx, Sc[kt][q]);
    mx = fmaxf(mx, __shfl_xor(mx, 32));
    mx = __builtin_fmaf(mx, sc, cb);
    if (__any(mx > m + 6.0f)) {
      asm volatile("" ::: "memory");
      const float mn = fmaxf(m, mx);
      const float alpha = __builtin_amdgcn_exp2f(m - mn);
      m = mn; l *= alpha;
#pragma unroll
      for (int d = 0; d < NDT; ++d)
#pragma unroll
        for (int q = 0; q < 16; ++q) O[d][q] *= alpha;
    }
    const float nm = cb - m;
#pragma unroll
    for (int kt = 0; kt < 2; ++kt) {
#pragma unroll
      for (int q = 0; q < 16; ++q) {
        const float pv = __builtin_amdgcn_exp2f(__builtin_fmaf(Sc[kt][q], sc, nm));
        Sc[kt][q] = pv; l += pv;
      }
#pragma unroll
      for (int s = 0; s < 2; ++s) {
        u32x4 pk;
#pragma unroll
        for (int q = 0; q < 4; ++q) pk[q] = pack2(Sc[kt][8 * s + 2 * q], Sc[kt][8 * s + 2 * q + 1]);
        pf[kt][s] = __builtin_bit_cast(bf16x8, pk);
      }
    }
  };
  auto pv = [&](const u16* Vb) __attribute__((always_inline)) {
    bf16x8 vf[4][NDT];
#pragma unroll
    for (int ks = 0; ks < 4; ++ks)
#pragma unroll
      for (int d = 0; d < NDT; ++d) vf[ks][d] = *(const bf16x8*)(Vb + (32 * d + r) * 64 + (((2 * ks + h) ^ ksw) << 3));
#pragma unroll
    for (int ks = 0; ks < 4; ++ks)
#pragma unroll
      for (int d = 0; d < NDT; ++d) O[d] = MFMA(vf[ks][d], pf[ks >> 1][ks & 1], O[d]);
    __builtin_amdgcn_sched_group_barrier(0x100, 2 * NDT, 0);
    __builtin_amdgcn_sched_group_barrier(0x008, NDT, 0);
    __builtin_amdgcn_sched_group_barrier(0x100, NDT, 0);
    __builtin_amdgcn_sched_group_barrier(0x008, NDT, 0);
    __builtin_amdgcn_sched_group_barrier(0x100, NDT, 0);
    __builtin_amdgcn_sched_group_barrier(0x008, 2 * NDT, 0);
  };
  ATT_LOADK(0, Ks); ATT_LOADK(1, Ks + KS_SZ); ATT_LOADK(2, Ks + 2 * KS_SZ);
  ATT_LOADV(0, Vs); ATT_LOADV(1, Vs + VS_SZ);
  asm volatile("s_waitcnt vmcnt(0) lgkmcnt(0)\n\ts_barrier" ::: "memory");
  if (SWAP) qk(Ks);
  int r0 = 0, r2 = 2;
  for (int kb = 0; kb < nkb; ++kb) {
    ATT_LOADK(kb + 3, Ks + ((kb + 3) & 3) * KS_SZ);
    ATT_LOADV(kb + 2, Vs + r2 * VS_SZ);
    if (!SWAP) qk(Ks + (kb & 3) * KS_SZ);
    softmax(kb);
    pv(Vs + r0 * VS_SZ);
    if (SWAP) qk(Ks + ((kb + 1) & 3) * KS_SZ);
    asm volatile("s_waitcnt vmcnt(%0) lgkmcnt(0)\n\ts_barrier" :: "n"(NL) : "memory");
    r2 = r0; r0 = (r0 == 2) ? 0 : r0 + 1;
  }
  asm volatile("s_waitcnt vmcnt(0)" ::: "memory");
#undef ATT_LOADK
#undef ATT_LOADV
  l += __shfl_xor(l, 32);
  const float inv = __builtin_amdgcn_rcpf(l);
  int ldo2 = ldo; asm volatile("" : "+s"(ldo2));
  u16* orow = Op + (size_t)qpos * ldo2;
#pragma unroll
  for (int d = 0; d < NDT; ++d)
#pragma unroll
    for (int g4 = 0; g4 < 4; ++g4) {
      u32x2 o; o[0] = pack2(O[d][4 * g4] * inv, O[d][4 * g4 + 1] * inv); o[1] = pack2(O[d][4 * g4 + 2] * inv, O[d][4 * g4 + 3] * inv);
      *(u32x2*)(orow + 32 * d + 8 * g4 + 4 * h) = o;
    }
}

DI void hyena_item(int c, const u16* __restrict__ G, const u16* __restrict__ zT, u16* __restrict__ yT, int nseq, int L, char* smem) {
  u16* zs = (u16*)smem;
  u16* fw = zs + 20480;
  u16* fw1 = fw + 8256;
  const int tid = otid() & 255, lane = tid & 63, w = __builtin_amdgcn_readfirstlane(tid >> 6), r = lane & 31, h = lane >> 5;
  const int ZL = L + 2048;
  __syncthreads();
  for (int q = 0; q < nseq; ++q) {
    const u16* src = zT + ((size_t)q * 512 + c) * L;
    u16* dst = zs + q * ZL;
    const u32x4 zero = {0u, 0u, 0u, 0u};
    for (int i = tid; i < 128; i += 256) { *(u32x4*)(dst + i * 8) = zero; *(u32x4*)(dst + 1024 + L + i * 8) = zero; }
    for (int i = tid; i < (L >> 3); i += 256) *(u32x4*)(dst + 1024 + i * 8) = *(const u32x4*)(src + i * 8);
  }
  int tq[4], tJ[4];
#pragma unroll
  for (int i = 0; i < 4; ++i) { if (nseq == 2) { tq[i] = i & 1; tJ[i] = 2 * w + (i >> 1); } else { tq[i] = 0; tJ[i] = 4 * w + i; } }
  f32x16 acc[4];
#pragma unroll
  for (int i = 0; i < 4; ++i)
#pragma unroll
    for (int q = 0; q < 16; ++q) acc[i][q] = 0.f;
  const int E0 = -L + 16, ELAST = L - 32;
  const int npass = (2 * L - 32 + 8191) / 8192;
  const u16* Gc = G + (size_t)c * (2 * L);
  for (int ps = 0; ps < npass; ++ps) {
    const int ea = E0 + 8192 * ps, eb = ea + 8192;
    const int wb = L - eb - 16;
    __syncthreads();
    for (int i = tid; i < 1032; i += 256) {
      const int gi = wb + i * 8;
      u32x4 v = {0u, 0u, 0u, 0u};
      if (gi >= 0 && gi < 2 * L) v = *(const u32x4*)(Gc + gi);
      *(u32x4*)(fw + i * 8) = v;
    }
    __syncthreads();
    for (int i = tid; i < 4127; i += 256) { const unsigned lo = ((const unsigned*)fw)[i], hi = ((const unsigned*)fw)[i + 1]; ((unsigned*)fw1)[i] = (lo >> 16) | (hi << 16); }
    __syncthreads();
    const int eend = (eb - 16 < ELAST) ? (eb - 16) : ELAST;
    auto slow = [&](int e_lo, int e_hi) __attribute__((always_inline)) {
      for (int e = e_lo; e <= e_hi; e += 16) {
        bool in[4]; bool any = false;
#pragma unroll
        for (int i = 0; i < 4; ++i) { in[i] = (e >= 1024 * tJ[i] - L + 16) && (e <= 1024 * tJ[i] + 992); any = any || in[i]; }
        if (!any) continue;
        const int idx0 = L - e - r + 8 * h - wb;
        const unsigned* aw = (idx0 & 1) ? (const unsigned*)(fw1 + idx0 - 1) : (const unsigned*)(fw + idx0);
        u32x4 av; av[0] = aw[0]; av[1] = aw[1]; av[2] = aw[2]; av[3] = aw[3];
        const bf16x8 a = __builtin_bit_cast(bf16x8, av);
#pragma unroll
        for (int i = 0; i < 4; ++i) {
          if (in[i]) {
            const bf16x8 b = *(const bf16x8*)(zs + tq[i] * ZL + 1024 + 1024 * tJ[i] + 32 * r - e + 8 * h);
            acc[i] = MFMA(a, b, acc[i]);
          }
        }
      }
    };
    int mlo = 1024 * tJ[3] - L + 16, mhi = 1024 * tJ[0] + 992;
    if (mlo < ea) mlo = ea; if (mhi > eend) mhi = eend;
    if (mlo > mhi) { slow(ea, eend); }
    else {
      slow(ea, mlo - 16);
      {
        const int idx0 = L - mlo - r + 8 * h - wb;
        const unsigned* ap = (idx0 & 1) ? (const unsigned*)(fw1 + idx0 - 1) : (const unsigned*)(fw + idx0);
        const u16* bp0 = zs + tq[0] * ZL + 1024 + 1024 * tJ[0] + 32 * r - mlo + 8 * h;
        const u16* bp1 = zs + tq[1] * ZL + 1024 + 1024 * tJ[1] + 32 * r - mlo + 8 * h;
        const u16* bp2 = zs + tq[2] * ZL + 1024 + 1024 * tJ[2] + 32 * r - mlo + 8 * h;
        const u16* bp3 = zs + tq[3] * ZL + 1024 + 1024 * tJ[3] + 32 * r - mlo + 8 * h;
        const int n = ((mhi - mlo) >> 4) + 1;
        bf16x8 a, b0, b1, b2, b3;
        { u32x4 av; av[0] = ap[0]; av[1] = ap[1]; av[2] = ap[2]; av[3] = ap[3]; a = __builtin_bit_cast(bf16x8, av); }
        b0 = *(const bf16x8*)bp0; b1 = *(const bf16x8*)bp1; b2 = *(const bf16x8*)bp2; b3 = *(const bf16x8*)bp3;
        for (int k = 0; k < n; ++k) {
          ap -= 8; bp0 -= 16; bp1 -= 16; bp2 -= 16; bp3 -= 16;
          bf16x8 an, c0, c1, c2, c3;
          { u32x4 av; av[0] = ap[0]; av[1] = ap[1]; av[2] = ap[2]; av[3] = ap[3]; an = __builtin_bit_cast(bf16x8, av); }
          c0 = *(const bf16x8*)bp0; c1 = *(const bf16x8*)bp1; c2 = *(const bf16x8*)bp2; c3 = *(const bf16x8*)bp3;
          acc[0] = MFMA(a, b0, acc[0]); acc[1] = MFMA(a, b1, acc[1]); acc[2] = MFMA(a, b2, acc[2]); acc[3] = MFMA(a, b3, acc[3]);
          a = an; b0 = c0; b1 = c1; b2 = c2; b3 = c3;
        }
      }
      slow(mhi + 16, eend);
    }
  }
#pragma unroll
  for (int i = 0; i < 4; ++i) {
    u16* dst = yT + ((size_t)tq[i] * 512 + c) * L + 1024 * tJ[i] + 32 * r + 4 * h;
#pragma unroll
    for (int g4 = 0; g4 < 4; ++g4) {
      u32x2 o; o[0] = pack2(acc[i][4 * g4], acc[i][4 * g4 + 1]); o[1] = pack2(acc[i][4 * g4 + 2], acc[i][4 * g4 + 3]);
      *(u32x2*)(dst + 8 * g4) = o;
    }
  }
}

DI void diff_post_item(const Params& P, int layer, float lam, float lam_init, const u16* __restrict__ dO, u16* __restrict__ ydf, int it) {
  const int tid = otid() & 255, lane = tid & 63, w = __builtin_amdgcn_readfirstlane(tid >> 6);
  const int u = it * 8 + w * 2 + (lane >> 5);
  const int i = lane & 31;
  const u32x2 a = *(const u32x2*)(dO + (size_t)u * 256 + 4 * i);
  const u32x2 b = *(const u32x2*)(dO + (size_t)u * 256 + 128 + 4 * i);
  float o[4];
  o[0] = bflo(a[0]) - lam * bflo(b[0]); o[1] = bfhi(a[0]) - lam * bfhi(b[0]);
  o[2] = bflo(a[1]) - lam * bflo(b[1]); o[3] = bfhi(a[1]) - lam * bfhi(b[1]);
  const float ss = half_sum(o[0] * o[0] + o[1] * o[1] + o[2] * o[2] + o[3] * o[3]);
  const float rs = rsqrtf(ss * (1.0f / 128.0f) + 1e-5f) * (1.0f - lam_init);
  const float* g = P.diff_subln + layer * 128 + 4 * i;
  u32x2 ov; ov[0] = pack2(o[0] * rs * g[0], o[1] * rs * g[1]); ov[1] = pack2(o[2] * rs * g[2], o[3] * rs * g[3]);
  *(u32x2*)(ydf + (size_t)u * 128 + 4 * i) = ov;
}
DI void hyena_post_item(const Params& P, int layer, const u16* __restrict__ p, int L, const u16* __restrict__ yT, const u16* __restrict__ zT,
                        int ct, int tt, u16* __restrict__ yhy, char* smem) {
  float* tile = (float*)smem;
  const int tid = otid() & 255;
  const int t0 = tt * 64; const int seq = t0 / L, tl0 = t0 - seq * L;
  __syncthreads();
  {
    const int tcol = tid & 63, c0 = tid >> 6;
#pragma unroll
    for (int i = 0; i < 16; ++i) {
      const int cc = c0 + 4 * i; const int c = ct * 64 + cc;
      const size_t gi = ((size_t)seq * 512 + c) * L + tl0 + tcol;
      tile[cc * 65 + tcol] = bf2f(yT[gi]) + bf2f(zT[gi]) * P.hy_skip[layer * 512 + c];
    }
  }
  __syncthreads();
  {
    const int col = tid & 63, r0 = tid >> 6; const int c = ct * 64 + col;
    const float* cw = P.hy_conv_w + layer * 3 * 1536; const float* cb = P.hy_conv_b + layer * 1536;
    const float w0 = cw[c], w1 = cw[1536 + c], w2 = cw[3072 + c], b0 = cb[c];
#pragma unroll
    for (int i = 0; i < 16; ++i) {
      const int row = r0 + 4 * i; const int tl = tl0 + row;
      const u16* pr = p + (size_t)(t0 + row) * INC + c;
      const float xm1 = (tl > 0) ? bf2f(pr[-INC]) : 0.f, x0 = bf2f(pr[0]), xp1 = (tl < L - 1) ? bf2f(pr[INC]) : 0.f;
      const float x0c = xm1 * w0 + x0 * w1 + xp1 * w2 + b0;
      yhy[(size_t)(t0 + row) * 512 + c] = f2bf(x0c * tile[col * 65 + row]);
    }
  }
}

__global__ void __launch_bounds__(512) fwd_megakernel(Params Parg) {
  cg::grid_group grid = cg::this_grid();
  extern __shared__ __attribute__((aligned(16))) char smem_dyn[];
  char* smem = smem_dyn + 16;
  uint4& xb_words = *(uint4*)smem_dyn;
  const int nb = gridDim.x, nb2 = nb * 2;
#define KPARAMS() const Params __attribute__((address_space(4)))* pp_ = (const Params __attribute__((address_space(4)))*)__builtin_amdgcn_kernarg_segment_ptr(); \
  asm volatile("" : "+s"(pp_)); const Params& P = *(const Params*)pp_; char* ws = P.ws
  if (threadIdx.x == 0) xb_words = make_uint4(0u, 0u, 0u, blockIdx.x);
  __syncthreads();
  XcdBarrier xb;
  { KPARAMS(); xb = xcd_barrier_post((unsigned*)(ws + O_BAR), (volatile LAS unsigned*)&xb_words); }

  for (int step = 0; step < 80; ++step) {
    const int layer = step / 40, ls = step - layer * 40;
    PHASE_IDS();
    KPARAMS();
    float* misc = (float*)(ws + O_MISC);
    u16* pbuf = (u16*)(ws + O_P); u16* hid = pbuf; u16* hn = (u16*)(ws + O_HN); u16* merged = hn;
    if (ls == 0) {
      u16* filt8 = (u16*)(ws + O_FILT8); u16* filt16 = (u16*)(ws + O_FILT16);
      const int n1 = 16 * 88, n2 = 44 * 16, n3 = 16 * 108, n4 = 3 * 8 * 16, n5 = 16 * 16;
      const int nfilt = 128 + 256;
      const int total = n1 + n2 + n3 + n4 + n5 + n1 + n2 + nfilt;
      for (int it = bid2; it < total; it += nb2) {
        int t = it;
        if (t < nfilt) {
          const bool big = t < 256;
          filter_item(P, layer, big ? 16384 : 8192, big ? t : t - 256, big ? filt16 : filt8, smg);
          continue;
        }
        t -= nfilt;
        const float* src; int K, N, kt, nt, ph = 0; u16* dst;
        if (t < n1) { src = P.ffn1_w_in + (size_t)layer * 1024 * 5632; K = 1024; N = 5632; dst = (u16*)(ws + O_F1IN); kt = t / 88; nt = t % 88; ph = 2816; }
        else if ((t -= n1) < n2) { src = P.ffn1_w_out + (size_t)layer * 2816 * 1024; K = 2816; N = 1024; dst = (u16*)(ws + O_F1OUT); kt = t / 16; nt = t % 16; }
        else if ((t -= n2) < n3) { src = P.w_in + (size_t)layer * 1024 * 6912; K = 1024; N = 6912; dst = (u16*)(ws + O_WIN); kt = t / 108; nt = t % 108; }
        else if ((t -= n3) < n4) { const int br = t / 128, tt = t % 128; src = P.w_branch + ((size_t)layer * 3 + br) * 512 * 1024; K = 512; N = 1024;
                                   dst = (u16*)(ws + O_WBR) + (size_t)br * 1024 * 512; kt = tt / 16; nt = tt % 16; }
        else if ((t -= n4) < n5) { src = P.w_out + (size_t)layer * 1024 * 1024; K = 1024; N = 1024; dst = (u16*)(ws + O_WOUT); kt = t / 16; nt = t % 16; }
        else if ((t -= n5) < n1) { src = P.ffn2_w_in + (size_t)layer * 1024 * 5632; K = 1024; N = 5632; dst = (u16*)(ws + O_F2IN); kt = t / 88; nt = t % 88; ph = 2816; }
        else { t -= n1; src = P.ffn2_w_out + (size_t)layer * 2816 * 1024; K = 2816; N = 1024; dst = (u16*)(ws + O_F2OUT); kt = t / 16; nt = t % 16; }
        convT_tile(src, K, N, dst, kt, nt, ph, smg);
      }
      if (bid == 1 && grp == 0 && layer == 0) {
        float* rope = (float*)(ws + O_ROPE);
        for (int i = t_; i < 320 * 16; i += 256) {
          const int pos = (i < 4096) ? (i >> 4) : ((i - 4096) >> 4); const int jj = i & 15;
          const float inv = powf(10000.0f, -(float)(2 * jj) / 32.0f);
          const float ang = (float)pos * inv;
          rope[2 * i] = cosf(ang); rope[2 * i + 1] = sinf(ang);
        }
      }
      if (bid == 0 && grp == 0) {
        const int tid = t_;
        if (tid < 2) {
          const float* lp = P.diff_lambda + tid * 256;
          float s1 = 0.f, s2 = 0.f;
          for (int i = 0; i < 64; ++i) { s1 += lp[i] * lp[64 + i]; s2 += lp[128 + i] * lp[192 + i]; }
          const float lam_init = 0.8f - 0.6f * expf(-0.3f * (float)tid);
          misc[tid] = expf(s1) - expf(s2) + lam_init;
        }
        for (int i = tid; i < 4 * 257; i += 256) {
          const int hh = i / 257, idx = i % 257; const int rel = idx - 128; const int n = rel < 0 ? -rel : rel;
          int b;
          if (n < 8) b = n; else { int lg = 8 + (int)(logf((float)n / 8.0f) / 2.772588722239781f * 8.0f); b = lg < 15 ? lg : 15; }
          if (rel > 0) b += 16;
          misc[64 + i] = P.rel_bias[b * 4 + hh] * LOG2E;
        }
      }
      if (step == 0) {
        grid.sync();
        if (threadIdx.x == 0) {
          unsigned* bar = (unsigned*)(ws + O_BAR); bool even = ((nb & 7) == 0);
          for (int j = 0; j < 16; ++j) { const unsigned c = xb_ld(&bar[XB_XCNT(j)]); if (c != ((j < 8) ? (unsigned)(nb >> 3) : 0u)) even = false; }
          volatile LAS unsigned* st = (volatile LAS unsigned*)&xb_words;
          if (even) st[3] = st[2] * 8u + xb.x;
        }
        __syncthreads();
      } else GSYNC();
      continue;
    }
    const int cs = ls - 1; const int ch = cs / 13, st = cs - ch * 13;
    const int nseq = (ch < 2) ? 2 : 1, L = (ch < 2) ? 8192 : 16384;
    const float* xin0 = (ch < 2) ? (P.x_prompt + (size_t)ch * TCH * DM) : P.x_sample;
    float* xres = P.out + (size_t)ch * TCH * DM;
    const float* xcur = (layer == 0) ? xin0 : xres;
    for (int rp_ = 0; rp_ <= ((REPMASK >> st) & 1); ++rp_) {
    if (st == 0 || st == 3 || st == 10) {
      const float* src = (st == 0) ? xcur : xres;
      const float* gn = ((st == 0) ? P.ffn1_norm : (st == 3 ? P.mix_norm : P.ffn2_norm)) + layer * DM;
      for (int it = bid2; it < TCH / 4; it += nb2) { const int row = it * 4 + w; norm_row_bf16(src + (size_t)row * DM, gn, hn + (size_t)row * DM, lane); }
    } else if (st == 1 || st == 2 || st == 4 || st == 8 || st == 9 || st == 11 || st == 12) {
      EpiAny E{}; const u16* A; const u16* Bt; int N, K;
      if (st == 1 || st == 11) { A = hn; Bt = (u16*)(ws + (st == 1 ? O_F1IN : O_F2IN)); N = 5632; K = DM; E.mode = EPI_SWIGLU; E.perm = true; E.O = hid; E.ldo = DFF; }
      else if (st == 2 || st == 12) { A = hid; Bt = (u16*)(ws + (st == 2 ? O_F1OUT : O_F2OUT)); N = DM; K = DFF; E.mode = EPI_RESID; E.perm = false;
                                      E.xin = (st == 2) ? xcur : xres; E.xout = xres; E.scale = 0.5f; }
      else if (st == 4) { A = hn; Bt = (u16*)(ws + O_WIN); N = INC; K = DM; E.mode = EPI_PROJ; E.perm = true; E.O = pbuf; }
      else if (st == 8) { A = (u16*)(ws + O_YHY); Bt = (u16*)(ws + O_WBR); N = DM; K = 512; E.mode = EPI_MERGE; E.perm = false; E.gate = pbuf; E.macc = (float*)(ws + O_ZT); E.O = merged; }
      else { A = merged; Bt = (u16*)(ws + O_WOUT); N = DM; K = DM; E.mode = EPI_RESID; E.perm = false; E.xin = xres; E.xout = xres; E.scale = 1.0f; }
      {
        pg8::Gemm gg{A, Bt, TCH, N, K};
        AnyOrder S; S.init(TCH, N, nb, bid); S.merge3 = (st == 8);
        pg8::gemm_phase<EpiAny, AnyOrder, false>((PG8_LAS unsigned char*)smem, gg, S, E, nullptr);
      }
    } else if (st == 5) {
      const int nqk = TCH * 10 / 8, ntr = 256 * 18;
      for (int it = bid2; it < nqk + ntr; it += nb2) {
        if (it < nqk) { qk_prep_item(P, layer, pbuf, L, it, (const float*)(ws + O_ROPE)); continue; }
        const int t = it - nqk; const int tt = t / 18, cc = t % 18;
        const int kind = (cc < 2) ? 0 : (cc < 10 ? 1 : 2);
        const int ct = (cc < 2) ? cc : (cc < 10 ? cc - 2 : cc - 10);
        u16* dst = (u16*)(ws + (kind == 0 ? O_VTG : (kind == 1 ? O_VTD : O_ZT)));
        transpose_item(P, layer, pbuf, L, kind, ct, tt, dst, smg);
      }
    } else if (st == 6) {
      u16* zT = (u16*)(ws + O_ZT); u16* yT = (u16*)(ws + O_YT); u16* dO = (u16*)(ws + O_DIFFO);
      u16* vtg = (u16*)(ws + O_VTG); u16* vtd = (u16*)(ws + O_VTD); u16* ygq = (u16*)(ws + O_YGQ);
      const u16* filt = (u16*)(ws + ((ch < 2) ? O_FILT8 : O_FILT16));
      const int nqt = L / 256;
      const int xcd = bid & 7, nxu = nb >> 3, nitem = nseq * nqt;
      for (int e = bid >> 3; e < nitem; e += nxu) {
        const int seq = e / nqt, qt = e - seq * nqt;
        const int hh = xcd >> 1, cc = xcd & 1;
        const size_t tb = (size_t)seq * L;
        const u16* Qd = pbuf + tb * INC + OFF_DQ + xcd * 64; const u16* Kd = pbuf + tb * INC + OFF_DK + xcd * 64;
        const u16* Vd = vtd + ((size_t)seq * 512 + hh * 128) * L; u16* Od = dO + tb * 1024 + (hh * 2 + cc) * 128;
        attn_tile<128, true, false>(Qd, Kd, Vd, L, Od, 1024, qt * 256, misc + 64 + hh * 257, smem);
      }
      for (int e = bid >> 3; e < nitem; e += nxu) {
        const int seq = e / nqt, qt = e - seq * nqt;
        const int kvh = xcd >> 2;
        const size_t tb = (size_t)seq * L;
        const u16* Qd = pbuf + tb * INC + OFF_GQ + xcd * 64; const u16* Kd = pbuf + tb * INC + OFF_GK + kvh * 64;
        const u16* Vd = vtg + ((size_t)seq * 128 + kvh * 64) * L; u16* Od = ygq + tb * 512 + xcd * 64;
        attn_tile<64, false, false>(Qd, Kd, Vd, L, Od, 512, qt * 256, nullptr, smem);
      }
      for (int c = bid2; c < 512; c += nb2) hyena_item(c, filt, zT, yT, nseq, L, smg);
    } else {
      u16* zT = (u16*)(ws + O_ZT); u16* yT = (u16*)(ws + O_YT); u16* dO = (u16*)(ws + O_DIFFO);
      u16* yhy = (u16*)(ws + O_YHY); u16* ydf = (u16*)(ws + O_YDF);
      const float lam = misc[layer];
      const float lam_init = 0.8f - 0.6f * expf(-0.3f * (float)layer);
      const int ndp = TCH * 4 / 8, nhp = 256 * 8;
      for (int it = bid2; it < ndp + nhp; it += nb2) {
        if (it < ndp) diff_post_item(P, layer, lam, lam_init, dO, ydf, it);
        else { const int t = it - ndp; hyena_post_item(P, layer, pbuf, L, yT, zT, t % 8, t / 8, yhy, smg); }
      }
    }
    }
    GSYNC();
  }
  { PHASE_IDS(); KPARAMS(); (void)ws;
    for (int it = bid2; it < NTOK / 4; it += nb2) { const int row = it * 4 + w; norm_row_f32_inplace(P.out + (size_t)row * DM, P.final_norm, lane); }
  }
}

extern "C" void kernel_launch(void* const* d_in, const int* in_sizes, int n_in, void* d_out, int out_size, void* d_ws, size_t ws_size,
                              hipStream_t stream) {
  static int grid_blocks = 0;
  if (!grid_blocks) {
    int dev = 0, cus = 0, per_cu = 0;
    (void)hipGetDevice(&dev);
    (void)hipDeviceGetAttribute(&cus, hipDeviceAttributeMultiprocessorCount, dev);
    (void)hipFuncSetAttribute((const void*)fwd_megakernel, hipFuncAttributeMaxDynamicSharedMemorySize, SMEM_BYTES + 16);
    (void)hipOccupancyMaxActiveBlocksPerMultiprocessor(&per_cu, fwd_megakernel, 512, SMEM_BYTES + 16);
    if (per_cu < 1) per_cu = 1;
    if (per_cu > 1) per_cu = 1;
    grid_blocks = cus * per_cu;
  }
  Params p{};
  const float* const* in = (const float* const*)d_in;
  p.x_prompt = in[0]; p.x_sample = in[1]; p.ffn1_norm = in[2]; p.ffn1_w_in = in[3]; p.ffn1_w_out = in[4]; p.mix_norm = in[5]; p.w_in = in[6];
  p.hy_conv_w = in[7]; p.hy_conv_b = in[8]; p.hy_w1 = in[9]; p.hy_b1 = in[10]; p.hy_w2 = in[11]; p.hy_b2 = in[12]; p.hy_w3 = in[13];
  p.hy_freq = in[14]; p.hy_skip = in[15]; p.gqa_q_norm = in[16]; p.gqa_k_norm = in[17]; p.diff_lambda = in[18]; p.diff_subln = in[19];
  p.rel_bias = in[20]; p.w_branch = in[21]; p.w_out = in[22]; p.ffn2_norm = in[23]; p.ffn2_w_in = in[24]; p.ffn2_w_out = in[25]; p.final_norm = in[26];
  p.out = (float*)d_out; p.ws = (char*)d_ws;
  void* args[] = {&p};
  (void)hipMemsetAsync((char*)d_ws + O_BAR, 0, XCD_BAR_WORDS * 4, stream);
  hipError_t e = hipLaunchCooperativeKernel((void*)fwd_megakernel, dim3(grid_blocks), dim3(512), args, SMEM_BYTES + 16, stream);
  if (e != hipSuccess) fprintf(stderr, "cooperative launch failed: %s (grid %d)\n", hipGetErrorString(e), grid_blocks);
}
```

```cpp
#include <hip/hip_runtime.h>
#include <hip/hip_cooperative_groups.h>
#include <stdint.h>
#include <cstdio>
namespace cg = cooperative_groups;

typedef unsigned short u16;
typedef __attribute__((ext_vector_type(8))) short bf16x8;
typedef __attribute__((ext_vector_type(16))) float f32x16;
typedef __attribute__((ext_vector_type(4))) float f32x4;
typedef __attribute__((ext_vector_type(4))) unsigned u32x4;
typedef __attribute__((ext_vector_type(2))) unsigned u32x2;
typedef __attribute__((ext_vector_type(2))) __bf16 bf2_t;
typedef __attribute__((ext_vector_type(2))) float f2_t;
#define DI __device__ __forceinline__
#define MFMA(a, b, c) __builtin_amdgcn_mfma_f32_32x32x16_bf16((a), (b), (c), 0, 0, 0)

constexpr int DM = 1024, DFF = 2816, INC = 6912, TCH = 16384, NTOK = 49152;
constexpr int OFF_GQ = 1536, OFF_GK = 2048, OFF_GV = 2176, OFF_DQ = 2304, OFF_DK = 2816, OFF_DV = 3328, OFF_GATE = 3840;
constexpr float LOG2E = 1.4426950408889634f;

constexpr size_t SZ_F1IN = (size_t)5632 * 1024 * 2, SZ_F1OUT = (size_t)1024 * 2816 * 2, SZ_WIN = (size_t)6912 * 1024 * 2,
                 SZ_WBR = (size_t)3 * 1024 * 512 * 2, SZ_WOUT = (size_t)1024 * 1024 * 2;
constexpr size_t O_F1IN = 0, O_F1OUT = O_F1IN + SZ_F1IN, O_WIN = O_F1OUT + SZ_F1OUT, O_WBR = O_WIN + SZ_WIN, O_WOUT = O_WBR + SZ_WBR,
                 O_F2IN = O_WOUT + SZ_WOUT, O_F2OUT = O_F2IN + SZ_F1IN, O_FILT8 = O_F2OUT + SZ_F1OUT,
                 O_FILT16 = O_FILT8 + (size_t)512 * 16384 * 2, O_MISC = O_FILT16 + (size_t)512 * 32768 * 2,
                 O_P = O_MISC + 131072, O_HN = O_P + (size_t)TCH * INC * 2, O_ZT = O_HN + (size_t)TCH * 1024 * 2,
                 O_YT = O_ZT + (size_t)TCH * 512 * 2, O_DIFFO = O_YT + (size_t)TCH * 512 * 2, O_VTG = O_DIFFO + (size_t)TCH * 1024 * 2,
                 O_VTD = O_VTG + (size_t)TCH * 128 * 2, O_YHY = O_VTD + (size_t)TCH * 512 * 2, O_YGQ = O_YHY + (size_t)TCH * 512 * 2,
                 O_YDF = O_YGQ + (size_t)TCH * 512 * 2, O_END = O_YDF + (size_t)TCH * 512 * 2;
static_assert(O_END <= (size_t)536870912, "workspace overflow");
constexpr int SMEM_BYTES = 151552;
constexpr int GRP_LDS = 75776;
#define REPMASK 0
#define REP_SYNC 1
#define PHASE_IDS() const int t_ = otid(); const int bid = __builtin_amdgcn_readfirstlane(((volatile LAS unsigned*)&xb_words)[3]); const int lane = t_ & 63; const int grp = __builtin_amdgcn_readfirstlane(t_ >> 8); \
  const int w = __builtin_amdgcn_readfirstlane((t_ >> 6) & 3); const int bid2 = bid * 2 + grp; char* smg = smem + grp * GRP_LDS; \
  const int vb = (bid & 7) * (nb >> 3) + (bid >> 3); (void)lane; (void)w; (void)bid2; (void)smg; (void)vb
#define GSYNC() do { for (int rs_ = 0; rs_ < REP_SYNC; ++rs_) xcd_barrier(xb); } while (0)


#define XB_TMO      128
#define XB_XCNT(j)  (256  + 64 * (j))
#define XB_XSUB(j)  (1280 + 64 * (j))
#define XB_XGEN(j)  (2304 + 64 * (j))
#define XB_TOP      3328
#define XB_TOPGEN   3392
#define XCD_BAR_WORDS 3456
#define XB_SPIN_CAP (1u << 21)
#define LAS __attribute__((address_space(3)))
DI unsigned xb_ld(unsigned* p)              { return __hip_atomic_load(p, __ATOMIC_RELAXED, __HIP_MEMORY_SCOPE_AGENT); }
DI unsigned xb_add(unsigned* p, unsigned v) { return __hip_atomic_fetch_add(p, v, __ATOMIC_RELAXED, __HIP_MEMORY_SCOPE_AGENT); }
DI unsigned xb_xcc_id() { return (unsigned)__builtin_amdgcn_s_getreg((3 << 11) | 20) & 0xFu; }
#define XB_SPIN(cond, bar) do { unsigned _sp = 0; while (cond) { __builtin_amdgcn_s_sleep(1); \
    if ((++_sp & 255u) == 0u) { if (xb_ld(&(bar)[XB_TMO])) break; if (_sp > XB_SPIN_CAP) { atomicAdd(&(bar)[XB_TMO], 1u); break; } } } } while (0)
struct XcdBarrier { unsigned* bar; unsigned x; volatile LAS unsigned* st; };
DI XcdBarrier xcd_barrier_post(unsigned* bar, volatile LAS unsigned* st) {
  XcdBarrier b; b.bar = bar; b.x = xb_xcc_id(); b.st = st;
  if (threadIdx.x == 0) { const unsigned rank = xb_add(&bar[XB_XCNT(b.x)], 1u); st[2] = rank; }
  return b;
}
DI void xcd_barrier_complete(unsigned* bar, unsigned x, unsigned& nloc, unsigned& nx) {
  const unsigned G = gridDim.x * gridDim.y * gridDim.z;
  unsigned sum, cnt, mine, sp = 0u;
  for (;;) {
    sum = 0u; cnt = 0u; mine = 0u;
#pragma unroll
    for (unsigned j = 0; j < 16; ++j) { const unsigned c = xb_ld(&bar[XB_XCNT(j)]); sum += c; cnt += (c > 0u) ? 1u : 0u; mine = (j == x) ? c : mine; }
    if (sum == G) break;
    __builtin_amdgcn_s_sleep(1);
    if ((++sp & 255u) == 0u) { if (xb_ld(&bar[XB_TMO])) break; if (sp > XB_SPIN_CAP) { atomicAdd(&bar[XB_TMO], 1u); break; } }
  }
  nloc = mine > 0u ? mine : 1u; nx = cnt > 0u ? cnt : 1u;
}
DI void xcd_barrier(const XcdBarrier& b) {
  asm volatile("s_waitcnt vmcnt(0)" ::: "memory");
  __syncthreads();
  if (threadIdx.x == 0) {
    unsigned* bar = b.bar;
    __builtin_amdgcn_s_waitcnt(0);
    unsigned nloc = b.st[0], nx = b.st[1];
    if (nloc == 0u) { xcd_barrier_complete(bar, b.x, nloc, nx); b.st[0] = nloc; b.st[1] = nx; }
    const unsigned old = xb_add(&bar[XB_XSUB(b.x)], 1u);
    const unsigned gen = old / nloc;
    if (old + 1u == (gen + 1u) * nloc) {
      __builtin_amdgcn_fence(__ATOMIC_RELEASE, "agent");
      asm volatile("s_waitcnt vmcnt(0)" ::: "memory");
      const unsigned og = xb_add(&bar[XB_TOP], 1u);
      const unsigned tg = og / nx;
      if (og + 1u == (tg + 1u) * nx) xb_add(&bar[XB_TOPGEN], 1u);
      else XB_SPIN(xb_ld(&bar[XB_TOPGEN]) == tg, bar);
      __builtin_amdgcn_fence(__ATOMIC_ACQUIRE, "agent");
      xb_add(&bar[XB_XGEN(b.x)], 1u);
      asm volatile("s_waitcnt vmcnt(0)" ::: "memory");
    } else {
      XB_SPIN(xb_ld(&bar[XB_XGEN(b.x)]) == gen, bar);
      __builtin_amdgcn_fence(__ATOMIC_ACQUIRE, "agent");
      asm volatile("s_waitcnt vmcnt(0)" ::: "memory");
    }
  }
  __syncthreads();
}
constexpr size_t O_BAR = O_MISC + 16384;
constexpr size_t O_ROPE = O_MISC + 65536;

struct Params {
  const float* x_prompt; const float* x_sample;
  const float* ffn1_norm; const float* ffn1_w_in; const float* ffn1_w_out; const float* mix_norm; const float* w_in;
  const float* hy_conv_w; const float* hy_conv_b; const float* hy_w1; const float* hy_b1; const float* hy_w2; const float* hy_b2;
  const float* hy_w3; const float* hy_freq; const float* hy_skip;
  const float* gqa_q_norm; const float* gqa_k_norm; const float* diff_lambda; const float* diff_subln; const float* rel_bias;
  const float* w_branch; const float* w_out; const float* ffn2_norm; const float* ffn2_w_in; const float* ffn2_w_out; const float* final_norm;
  float* out; char* ws;
};

DI unsigned pack2(float a, float b) { f2_t v = {a, b}; bf2_t r = __builtin_convertvector(v, bf2_t); return __builtin_bit_cast(unsigned, r); }
DI u16 f2bf(float a) { return (u16)(pack2(a, 0.f) & 0xffffu); }
DI float bf2f(u16 v) { return __uint_as_float(((unsigned)v) << 16); }
DI float bflo(unsigned v) { return __uint_as_float(v << 16); }
DI float bfhi(unsigned v) { return __uint_as_float(v & 0xffff0000u); }
DI int otid() { int t = threadIdx.x; asm volatile("" : "+v"(t)); return t; }
DI int crow(int reg, int h) { return (reg & 3) + 8 * (reg >> 2) + 4 * h; }
DI float wave_sum(float v) {
  v += __shfl_xor(v, 32); v += __shfl_xor(v, 16); v += __shfl_xor(v, 8); v += __shfl_xor(v, 4); v += __shfl_xor(v, 2); v += __shfl_xor(v, 1);
  return v;
}
DI float half_sum(float v) {
  v += __shfl_xor(v, 16); v += __shfl_xor(v, 8); v += __shfl_xor(v, 4); v += __shfl_xor(v, 2); v += __shfl_xor(v, 1);
  return v;
}

DI void convT_tile(const float* __restrict__ src, int K, int N, u16* __restrict__ dst, int kt, int nt, int perm_half, char* smem) {
  float* t = (float*)smem;
  const int tid = otid() & 255;
  __syncthreads();
  {
    const int col = tid & 63, r0 = tid >> 6;
#pragma unroll
    for (int i = 0; i < 16; ++i) { int row = r0 + 4 * i; t[row * 65 + col] = src[(size_t)(kt * 64 + row) * N + nt * 64 + col]; }
  }
  __syncthreads();
  {
    const int nl = tid >> 2, kq = tid & 3;
    int n = nt * 64 + nl;
    if (perm_half > 0) { if (n < perm_half) n = (n >> 7) * 256 + (n & 127); else { int j = n - perm_half; n = (j >> 7) * 256 + 128 + (j & 127); } }
    u32x4 o0, o1;
#pragma unroll
    for (int i = 0; i < 4; ++i) {
      o0[i] = pack2(t[(kq * 16 + 2 * i) * 65 + nl], t[(kq * 16 + 2 * i + 1) * 65 + nl]);
      o1[i] = pack2(t[(kq * 16 + 8 + 2 * i) * 65 + nl], t[(kq * 16 + 8 + 2 * i + 1) * 65 + nl]);
    }
    u16* d = dst + (size_t)n * K + kt * 64 + kq * 16;
    *(u32x4*)d = o0; *(u32x4*)(d + 8) = o1;
  }
}

DI void filter_item(const Params& P, int layer, int L, int tb, u16* __restrict__ G, char* smem) {
  float* h1 = (float*)smem;
  float* h2 = h1 + 64 * 65;
  const int tid = otid() & 255, lane = tid & 63, w = __builtin_amdgcn_readfirstlane(tid >> 6);
  const float* w1 = P.hy_w1 + layer * 33 * 64; const float* b1 = P.hy_b1 + layer * 64;
  const float* w2 = P.hy_w2 + layer * 64 * 64; const float* b2 = P.hy_b2 + layer * 64;
  const float* w3 = P.hy_w3 + layer * 64 * 1024; const float* fr = P.hy_freq + layer * 64;
  const int t = tb * 64 + lane;
  const float tl = (float)t / (float)(L - 1);
  __syncthreads();
  {
    float a[16];
#pragma unroll
    for (int u = 0; u < 16; ++u) a[u] = b1[w * 16 + u] + tl * w1[w * 16 + u];
    const float base = (float)(2.0 * 3.14159265358979323846 / (double)L) * (float)t;
    for (int b = 0; b < 16; ++b) {
      const float band = 1e-4f + (float)b * ((15.0f - 1e-4f) / 15.0f);
      const float ang = base * band;
      const float cs = cosf(ang), sn = -sinf(ang);
#pragma unroll
      for (int u = 0; u < 16; ++u) a[u] += cs * w1[(1 + b) * 64 + w * 16 + u] + sn * w1[(17 + b) * 64 + w * 16 + u];
    }
#pragma unroll
    for (int u = 0; u < 16; ++u) h1[lane * 65 + w * 16 + u] = sinf(fr[w * 16 + u] * a[u]);
  }
  __syncthreads();
  {
    float a[16];
#pragma unroll
    for (int u = 0; u < 16; ++u) a[u] = b2[w * 16 + u];
    for (int k = 0; k < 64; ++k) {
      const float hv = h1[lane * 65 + k];
#pragma unroll
      for (int u = 0; u < 16; ++u) a[u] += hv * w2[k * 64 + w * 16 + u];
    }
#pragma unroll
    for (int u = 0; u < 16; ++u) h2[lane * 65 + w * 16 + u] = sinf(fr[w * 16 + u] * a[u]);
  }
  __syncthreads();
  const float min_decay = -3.0701134573253946f, max_decay = -15.350567286626973f;
  for (int og = 0; og < 64; ++og) {
    const int o = w * 256 + og * 4;
    float a0 = 0.f, a1 = 0.f, a2 = 0.f, a3 = 0.f;
#pragma unroll 4
    for (int k = 0; k < 64; ++k) {
      const float hv = h2[lane * 65 + k];
      const f32x4 wv = *(const f32x4*)(w3 + k * 1024 + o);
      a0 += hv * wv[0]; a1 += hv * wv[1]; a2 += hv * wv[2]; a3 += hv * wv[3];
    }
    float av[4] = {a0, a1, a2, a3};
#pragma unroll
    for (int q = 0; q < 4; ++q) {
      const int oo = o + q; const int ch = oo & 511;
      const float delta = min_decay + (float)ch * ((max_decay - min_decay) / 511.0f);
      const float val = av[q] * expf(-tl * fabsf(delta));
      u16* Gc = G + (size_t)ch * (2 * L);
      if (oo < 512) Gc[L - t] = f2bf(val);
      else { if (t >= 1) Gc[L + t] = f2bf(val); else Gc[0] = 0; }
    }
  }
}

DI void norm_row_bf16(const float* __restrict__ x, const float* __restrict__ g, u16* __restrict__ out, int lane) {
  f32x4 v[4]; float ss = 0.f;
#pragma unroll
  for (int i = 0; i < 4; ++i) { v[i] = *(const f32x4*)(x + lane * 4 + 256 * i); ss += v[i][0] * v[i][0] + v[i][1] * v[i][1] + v[i][2] * v[i][2] + v[i][3] * v[i][3]; }
  ss = wave_sum(ss);
  const float rs = rsqrtf(ss * (1.0f / 1024.0f) + 1e-6f);
#pragma unroll
  for (int i = 0; i < 4; ++i) {
    const f32x4 gg = *(const f32x4*)(g + lane * 4 + 256 * i);
    u32x2 o; o[0] = pack2(v[i][0] * rs * gg[0], v[i][1] * rs * gg[1]); o[1] = pack2(v[i][2] * rs * gg[2], v[i][3] * rs * gg[3]);
    *(u32x2*)(out + lane * 4 + 256 * i) = o;
  }
}
DI void norm_row_f32_inplace(float* __restrict__ x, const float* __restrict__ g, int lane) {
  f32x4 v[4]; float ss = 0.f;
#pragma unroll
  for (int i = 0; i < 4; ++i) { v[i] = *(const f32x4*)(x + lane * 4 + 256 * i); ss += v[i][0] * v[i][0] + v[i][1] * v[i][1] + v[i][2] * v[i][2] + v[i][3] * v[i][3]; }
  ss = wave_sum(ss);
  const float rs = rsqrtf(ss * (1.0f / 1024.0f) + 1e-6f);
#pragma unroll
  for (int i = 0; i < 4; ++i) {
    const f32x4 gg = *(const f32x4*)(g + lane * 4 + 256 * i);
    f32x4 o; o[0] = v[i][0] * rs * gg[0]; o[1] = v[i][1] * rs * gg[1]; o[2] = v[i][2] * rs * gg[2]; o[3] = v[i][3] * rs * gg[3];
    *(f32x4*)(x + lane * 4 + 256 * i) = o;
  }
}

namespace pg8 {
#define PG8_LAS __attribute__((address_space(3)))
typedef unsigned short bf16_t;
typedef short bf16x8 __attribute__((ext_vector_type(8)));
typedef float f32x4 __attribute__((ext_vector_type(4)));
typedef unsigned u32x4 __attribute__((ext_vector_type(4)));
constexpr int BM = 256, BK = 64, HALF = 128, HTB = HALF * BK * 2  , STAGE_BYTES = 8 * HTB, NXCD = 8, WGM = 8;

__host__ __device__ __forceinline__ int lds_byte(int r, int c) { const int st = (r >> 4) * 2 + (c >> 5), rr = r & 15, cc = c & 31, ob = rr * 64 + cc * 2; return st * 1024 + (ob ^ (((ob >> 9) & 1) << 5)); }
__host__ __device__ __forceinline__ void stage_rc(int b, int& R, int& C) { const int st = b / 1024, sb = b % 1024, swz = sb ^ (((sb >> 9) & 1) << 5); R = (st >> 1) * 16 + swz / 64; C = (st & 1) * 32 + (swz % 64) / 2; }
__host__ __device__ __forceinline__ int perm32(int rho) { const int n = rho >> 4, i = rho & 15; return 8 * (i >> 2) + 4 * n + (i & 3); }

struct Unit { int pm, pn; };
struct Gemm { const bf16_t* A; const bf16_t* Bt; int M, N, K; };

struct StaticOrder {
    int nM, nN, nwg, G, c;
    __host__ __device__ void init(int M, int N, int G_, int c_) { nM = M / BM; nN = N / BM; nwg = nM * nN; G = G_; c = c_; }
    __host__ __device__ bool next(int i, Unit& u) const {
        const long L = (long)i * G + c; if (L >= nwg) return false;
        int wgid = (int)L; { const int q = nwg / NXCD, r = nwg % NXCD, xcd = wgid % NXCD, off = wgid / NXCD; wgid = (xcd < r ? xcd * (q + 1) : r * (q + 1) + (xcd - r) * q) + off; }
        const int nig = WGM * nN, gid = wgid / nig, fm = gid * WGM, gsz = (nM - fm) < WGM ? (nM - fm) : WGM;
        u.pm = fm + ((wgid % nig) % gsz); u.pn = (wgid % nig) / gsz; return true;
    }
    __device__ __forceinline__ void a_ready(const Unit&) const {}
    __device__ __forceinline__ void done(const Unit&) const {}
};

template <class Epi, class Sched, bool STAMP = false>
__device__ __forceinline__ void gemm_phase(PG8_LAS unsigned char* lds, const Gemm g, const Sched& S, const Epi& E, unsigned long long* stamps) {
    const int tid = otid(), wid = __builtin_amdgcn_readfirstlane(tid >> 6), lane = tid & 63, wr = wid >> 2, wc = wid & 3, fr = lane & 15, fq = lane >> 4;
    const int K = g.K, nt = K / BK;
    int ts_lo = 0, ts_hi = 0, nts = 0; const unsigned long long rt_entry = STAMP ? (unsigned long long)wall_clock64() : 0ull;
#define PG8_STAMP() do { if (STAMP && wid == 0 && nts < 64) { const unsigned long long _c = (unsigned long long)clock64(); \
        ts_lo = (lane == nts) ? (int)(unsigned)_c : ts_lo; ts_hi = (lane == nts) ? (int)(unsigned)(_c >> 32) : ts_hi; ++nts; } } while (0)
    PG8_STAMP();
    unsigned voffA[2], voffB[2];
#pragma unroll
    for (int i = 0; i < 2; ++i) { int R, C; stage_rc(tid * 16 + i * 8192, R, C); const int Rb = E.perm ? ((R & ~31) + perm32(R & 31)) : R;
        voffA[i] = (unsigned)(R * K + C) * 2u; voffB[i] = (unsigned)(Rb * K + C) * 2u; }
    const size_t kstep = (size_t)(BK * 2);
    const size_t hstep = (size_t)HALF * K * 2;
    const size_t tstep = 2 * hstep;
    const unsigned ldsw = (unsigned)wid * 1024u;
    const int aoff = lds_byte(wr * 64 + fr, fq * 8), boff = lds_byte(wc * 32 + fr, fq * 8);
#define PG8_SA(b, h) (((b) * 2 + (h)) * HTB)
#define PG8_SB(b, h) ((4 + (b) * 2 + (h)) * HTB)
#define PG8_STAGE(bufoff, gbase, voff) do { _Pragma("unroll") for (int _i = 0; _i < 2; ++_i) \
        __builtin_amdgcn_global_load_lds((const unsigned*)((const char*)(gbase) + (voff)[_i]), (PG8_LAS unsigned*)(lds + (bufoff) + ldsw + _i * 8192), 16, 0, 0); } while (0)
#define PG8_LDA(dst, b, h) do { _Pragma("unroll") for (int m = 0; m < 4; ++m) _Pragma("unroll") for (int k = 0; k < 2; ++k) dst[m][k] = *(const PG8_LAS bf16x8*)(lds + PG8_SA(b, h) + aoff + m * 2048 + k * 1024); } while (0)
#define PG8_LDB(dst, b, h) do { _Pragma("unroll") for (int n = 0; n < 2; ++n) _Pragma("unroll") for (int k = 0; k < 2; ++k) dst[n][k] = *(const PG8_LAS bf16x8*)(lds + PG8_SB(b, h) + boff + n * 2048 + k * 1024); } while (0)
#define PG8_MMA(ai, bj, At, Bt) do { __builtin_amdgcn_s_setprio(1); _Pragma("unroll") for (int m = 0; m < 4; ++m) _Pragma("unroll") for (int n = 0; n < 2; ++n) _Pragma("unroll") for (int k = 0; k < 2; ++k) \
        acc[ai][bj][m][n] = __builtin_amdgcn_mfma_f32_16x16x32_bf16(Bt[n][k], At[m][k], acc[ai][bj][m][n], 0, 0, 0); __builtin_amdgcn_s_setprio(0); } while (0)
#define PG8_WAIT_V(n) asm volatile("s_waitcnt vmcnt(" #n ")" ::: "memory")
#define PG8_WAIT_L(n) asm volatile("s_waitcnt lgkmcnt(" #n ")" ::: "memory")
#define PG8_BAR __builtin_amdgcn_s_barrier()
#define PG8_SCHED __builtin_amdgcn_sched_barrier(0)
    Unit cur, nxt; int ui = 0;
    if (!S.next(0, cur)) return;
    f32x4 acc[2][2][4][2];
#pragma unroll
    for (int a = 0; a < 2; ++a)
#pragma unroll
        for (int b = 0; b < 2; ++b)
#pragma unroll
            for (int m = 0; m < 4; ++m)
#pragma unroll
                for (int n = 0; n < 2; ++n) acc[a][b][m][n] = (f32x4){0.f, 0.f, 0.f, 0.f};
    bf16x8 At[4][2], B0[2][2], B1[2][2];
    const char* cA = (const char*)g.A + (size_t)cur.pm * tstep; const char* cB = (const char*)g.Bt + (size_t)cur.pn * tstep;
    S.a_ready(cur);
    PG8_STAGE(PG8_SB(0, 0), cB, voffB); PG8_STAGE(PG8_SA(0, 0), cA, voffA); PG8_STAGE(PG8_SB(0, 1), cB + hstep, voffB); PG8_STAGE(PG8_SA(0, 1), cA + hstep, voffA);
    if (wr == 1) PG8_BAR;
    PG8_WAIT_V(4); PG8_BAR;
    PG8_STAGE(PG8_SB(1, 0), cB + kstep, voffB); PG8_STAGE(PG8_SA(1, 0), cA + kstep, voffA); PG8_STAGE(PG8_SB(1, 1), cB + hstep + kstep, voffB);
    PG8_WAIT_V(6); PG8_BAR;
    PG8_STAMP();
    for (;;) {
        const bool has_next = S.next(ui + 1, nxt);
        const char* nA = has_next ? (const char*)g.A + (size_t)nxt.pm * tstep : cA; const char* nB = has_next ? (const char*)g.Bt + (size_t)nxt.pn * tstep : cB;
        for (int t = 0; t < nt; t += 2) {
            const bool last = (t == nt - 2);
            const char* a1 = cA + (size_t)(t + 1) * kstep;
            const char* a2 = last ? nA : cA + (size_t)(t + 2) * kstep; const char* b2 = last ? nB : cB + (size_t)(t + 2) * kstep;
            const char* a3 = a2 + kstep; const char* b3 = b2 + kstep;
            if (last && has_next) S.a_ready(nxt);
            PG8_LDB(B0, 0, 0); PG8_SCHED; PG8_LDA(At, 0, 0); PG8_STAGE(PG8_SA(1, 1), a1 + hstep, voffA);
            PG8_WAIT_L(8); PG8_BAR; PG8_WAIT_L(0); PG8_MMA(0, 0, At, B0); PG8_BAR; PG8_SCHED;
            PG8_LDB(B1, 0, 1); PG8_STAGE(PG8_SB(0, 0), b2, voffB);
            PG8_BAR; PG8_WAIT_L(0); PG8_MMA(0, 1, At, B1); PG8_BAR;
            PG8_LDA(At, 0, 1); PG8_STAGE(PG8_SA(0, 0), a2, voffA);
            PG8_BAR; PG8_WAIT_L(0); PG8_MMA(1, 0, At, B0); PG8_BAR; PG8_SCHED;
            PG8_STAGE(PG8_SB(0, 1), b2 + hstep, voffB);
            PG8_WAIT_V(6); PG8_BAR; PG8_MMA(1, 1, At, B1); PG8_BAR;
            PG8_LDB(B0, 1, 0); PG8_SCHED; PG8_LDA(At, 1, 0); PG8_STAGE(PG8_SA(0, 1), a2 + hstep, voffA);
            PG8_WAIT_L(8); PG8_BAR; PG8_WAIT_L(0); PG8_MMA(0, 0, At, B0); PG8_BAR; PG8_SCHED;
            PG8_LDB(B1, 1, 1); PG8_STAGE(PG8_SB(1, 0), b3, voffB);
            PG8_BAR; PG8_WAIT_L(0); PG8_MMA(0, 1, At, B1); PG8_BAR;
            PG8_LDA(At, 1, 1); PG8_STAGE(PG8_SA(1, 0), a3, voffA);
            PG8_BAR; PG8_WAIT_L(0); PG8_MMA(1, 0, At, B0); PG8_BAR; PG8_SCHED;
            PG8_STAGE(PG8_SB(1, 1), b3 + hstep, voffB);
            PG8_WAIT_V(6); PG8_BAR; PG8_MMA(1, 1, At, B1); PG8_BAR;
        }
        PG8_STAMP();
        if constexpr (!Epi::AFTER_DRAIN) { E(acc, cur, wr, wc, fr, fq); S.done(cur); }
        PG8_STAMP();
        if (!has_next) break;
#pragma unroll
        for (int a = 0; a < 2; ++a)
#pragma unroll
            for (int b = 0; b < 2; ++b)
#pragma unroll
                for (int m = 0; m < 4; ++m)
#pragma unroll
                    for (int n = 0; n < 2; ++n) acc[a][b][m][n] = (f32x4){0.f, 0.f, 0.f, 0.f};
        cur = nxt; cA = nA; cB = nB; ++ui;
    }
    PG8_WAIT_V(0);
    if (wr == 0) PG8_BAR;
    PG8_BAR;
    if constexpr (Epi::AFTER_DRAIN) { E.fused(acc, cur, wr, wc, fr, fq, lds, wid, lane); S.done(cur); }
    PG8_STAMP();
    if (STAMP && wid == 0) { stamps[lane] = lane < nts ? (((unsigned long long)(unsigned)ts_hi << 32) | (unsigned)ts_lo) : 0ull;
        if (lane == 62) stamps[62] = rt_entry; if (lane == 63) stamps[63] = (unsigned long long)wall_clock64(); }
#undef PG8_STAMP
#undef PG8_SA
#undef PG8_SB
#undef PG8_STAGE
#undef PG8_LDA
#undef PG8_LDB
#undef PG8_MMA
#undef PG8_WAIT_V
#undef PG8_WAIT_L
#undef PG8_BAR
#undef PG8_SCHED
}
}

enum { EPI_SWIGLU = 0, EPI_RESID = 1, EPI_PROJ = 2, EPI_MERGE = 3 };
struct AnyOrder : pg8::StaticOrder {
  bool merge3;
  __device__ __forceinline__ bool next(int i, pg8::Unit& u) const {
    if (!merge3) return pg8::StaticOrder::next(i, u);
    const int ti = i / 3, br = i - ti * 3; pg8::Unit t;
    if (!pg8::StaticOrder::next(ti, t)) return false;
    u.pm = t.pm + 64 * br; u.pn = t.pn + 4 * br; return true;
  }
};
struct EpiAny {
  static constexpr bool AFTER_DRAIN = false;
  int mode; bool perm;
  u16* O; int ldo; const float* xin; float* xout; float scale; const u16* gate; float* macc; int br;
  DI void operator()(const pg8::f32x4 (&acc)[2][2][4][2], const pg8::Unit& u, int wr, int wc, int fr, int fq) const {
    const int row0 = (u.pm & 63) * 256 + wr * 64 + fr;
    if (mode == EPI_SWIGLU) {
      const int col0 = u.pn * 128 + wc * 32 + 8 * fq;
#pragma unroll
      for (int ai = 0; ai < 2; ++ai)
#pragma unroll
        for (int m = 0; m < 4; ++m) {
          float v[8];
#pragma unroll
          for (int n = 0; n < 2; ++n)
#pragma unroll
            for (int e = 0; e < 4; ++e) { const float gv = acc[ai][0][m][n][e], uv = acc[ai][1][m][n][e]; v[4 * n + e] = gv * __builtin_amdgcn_rcpf(1.0f + __builtin_amdgcn_exp2f(-LOG2E * gv)) * uv; }
          u32x4 o; o[0] = pack2(v[0], v[1]); o[1] = pack2(v[2], v[3]); o[2] = pack2(v[4], v[5]); o[3] = pack2(v[6], v[7]);
          *(u32x4*)(O + (size_t)(row0 + ai * 128 + m * 16) * ldo + col0) = o;
        }
    } else if (mode == EPI_PROJ) {
      const int col0 = u.pn * 256 + wc * 32 + 8 * fq;
      const bool sg = (u.pn * 256 >= OFF_GATE);
#pragma unroll
      for (int ai = 0; ai < 2; ++ai)
#pragma unroll
        for (int m = 0; m < 4; ++m)
#pragma unroll
          for (int bj = 0; bj < 2; ++bj) {
            float v[8];
#pragma unroll
            for (int n = 0; n < 2; ++n)
#pragma unroll
              for (int e = 0; e < 4; ++e) { float t = acc[ai][bj][m][n][e]; if (sg) t = __builtin_amdgcn_rcpf(1.0f + __builtin_amdgcn_exp2f(-LOG2E * t)); v[4 * n + e] = t; }
            u32x4 o; o[0] = pack2(v[0], v[1]); o[1] = pack2(v[2], v[3]); o[2] = pack2(v[4], v[5]); o[3] = pack2(v[6], v[7]);
            *(u32x4*)(O + (size_t)(row0 + ai * 128 + m * 16) * INC + col0 + bj * 128) = o;
          }
    } else if (mode == EPI_RESID) {
      const int col0 = u.pn * 256 + wc * 32 + 4 * fq;
#pragma unroll
      for (int ai = 0; ai < 2; ++ai)
#pragma unroll
        for (int m = 0; m < 4; ++m)
#pragma unroll
          for (int bj = 0; bj < 2; ++bj)
#pragma unroll
            for (int n = 0; n < 2; ++n) {
              const size_t idx = (size_t)(row0 + ai * 128 + m * 16) * DM + col0 + bj * 128 + n * 16;
              f32x4 xv = *(const f32x4*)(xin + idx);
#pragma unroll
              for (int e = 0; e < 4; ++e) xv[e] += scale * acc[ai][bj][m][n][e];
              *(f32x4*)(xout + idx) = xv;
            }
    } else {
      const int col0 = (u.pn & 3) * 256 + wc * 32 + 4 * fq; const int br = u.pm >> 6;
#pragma unroll
      for (int ai = 0; ai < 2; ++ai)
#pragma unroll
        for (int m = 0; m < 4; ++m)
#pragma unroll
          for (int bj = 0; bj < 2; ++bj)
#pragma unroll
            for (int n = 0; n < 2; ++n) {
              const int row = row0 + ai * 128 + m * 16, col = col0 + bj * 128 + n * 16;
              const u32x2 gt = *(const u32x2*)(gate + (size_t)row * INC + OFF_GATE + br * DM + col);
              f32x4 v;
              v[0] = bflo(gt[0]) * acc[ai][bj][m][n][0]; v[1] = bfhi(gt[0]) * acc[ai][bj][m][n][1];
              v[2] = bflo(gt[1]) * acc[ai][bj][m][n][2]; v[3] = bfhi(gt[1]) * acc[ai][bj][m][n][3];
              const size_t idx = (size_t)row * DM + col;
              if (br > 0) { const f32x4 pv = *(const f32x4*)(macc + idx); v[0] += pv[0]; v[1] += pv[1]; v[2] += pv[2]; v[3] += pv[3]; }
              if (br < 2) *(f32x4*)(macc + idx) = v;
              else { u32x2 o; o[0] = pack2(v[0], v[1]); o[1] = pack2(v[2], v[3]); *(u32x2*)(outb_() + idx) = o; }
            }
    }
  }
  DI u16* outb_() const { return O; }
};

DI void qk_prep_item(const Params& P, int layer, u16* __restrict__ p, int L, int it, const float* __restrict__ rope) {
  const int tid = otid() & 255, lane = tid & 63, w = __builtin_amdgcn_readfirstlane(tid >> 6);
  const int u = it * 8 + w * 2 + (lane >> 5);
  const int tok = u / 10, hd = u - tok * 10;
  const int i = lane & 31;
  const int col0 = (hd < 8) ? (OFF_GQ + hd * 64) : (OFF_GK + (hd - 8) * 64);
  const float* gn = (hd < 8) ? (P.gqa_q_norm + layer * 64) : (P.gqa_k_norm + layer * 64);
  unsigned* ptr = (unsigned*)(p + (size_t)tok * INC + col0) + i;
  const unsigned v = *ptr;
  float a = bflo(v), b = bfhi(v);
  const float ss = half_sum(a * a + b * b);
  const float rs = rsqrtf(ss * (1.0f / 64.0f) + 1e-6f);
  a = a * rs * gn[2 * i]; b = b * rs * gn[2 * i + 1];
  const int tl = tok % L;
  const int jj = i & 15;
  const float* rt = rope + ((i < 16) ? ((tl >> 6) * 16 + jj) : (4096 + (tl & 63) * 16 + jj)) * 2;
  const float c = rt[0], s = rt[1];
  *ptr = pack2(a * c - b * s, a * s + b * c);
}

DI void transpose_item(const Params& P, int layer, const u16* __restrict__ p, int L, int kind, int ct, int tt, u16* __restrict__ dst, char* smem) {
  u16* tile = (u16*)smem;
  const int tid = otid() & 255;
  const int t0 = tt * 64;
  const int seq = t0 / L, tl0 = t0 - seq * L;
  const int C = (kind == 0) ? 128 : 512;
  __syncthreads();
  {
    const int col = tid & 63, r0 = tid >> 6;
    const int cidx = ct * 64 + col;
    if (kind < 2) {
      const int off = (kind == 0 ? OFF_GV : OFF_DV) + cidx;
#pragma unroll
      for (int i = 0; i < 16; ++i) { const int row = r0 + 4 * i; tile[col * 72 + row] = p[(size_t)(t0 + row) * INC + off]; }
    } else {
      const float* cw = P.hy_conv_w + layer * 3 * 1536; const float* cb = P.hy_conv_b + layer * 1536;
      const int c1 = 512 + cidx, c2 = 1024 + cidx;
      const float w10 = cw[c1], w11 = cw[1536 + c1], w12 = cw[3072 + c1], b1 = cb[c1];
      const float w20 = cw[c2], w21 = cw[1536 + c2], w22 = cw[3072 + c2], b2 = cb[c2];
#pragma unroll
      for (int i = 0; i < 16; ++i) {
        const int row = r0 + 4 * i; const int tl = tl0 + row;
        const u16* pr = p + (size_t)(t0 + row) * INC;
        const float xm1 = (tl > 0) ? bf2f(pr[c1 - INC]) : 0.f, x0 = bf2f(pr[c1]), xp1 = (tl < L - 1) ? bf2f(pr[c1 + INC]) : 0.f;
        const float vm1 = (tl > 0) ? bf2f(pr[c2 - INC]) : 0.f, v0 = bf2f(pr[c2]), vp1 = (tl < L - 1) ? bf2f(pr[c2 + INC]) : 0.f;
        const float x1c = xm1 * w10 + x0 * w11 + xp1 * w12 + b1;
        const float vc = vm1 * w20 + v0 * w21 + vp1 * w22 + b2;
        tile[col * 72 + row] = f2bf(vc * x1c);
      }
    }
  }
  __syncthreads();
  {
    const int c = tid >> 2, q = tid & 3;
    const u32x4 a = *(const u32x4*)(tile + c * 72 + q * 16), b = *(const u32x4*)(tile + c * 72 + q * 16 + 8);
    u16* d = dst + ((size_t)seq * C + ct * 64 + c) * L + tl0 + q * 16;
    *(u32x4*)d = a; *(u32x4*)(d + 8) = b;
  }
}

DI int kperm(int rho) { return (rho & ~0xC) | ((rho & 4) << 1) | ((rho & 8) >> 1); }
template <int DV, bool BIAS, bool SWAP>
DI void attn_tile(const u16* __restrict__ Qp, const u16* __restrict__ Kp, const u16* __restrict__ VTp, int L,
                  u16* __restrict__ Op, int ldo, int q0, const float* __restrict__ btab, char* smem) {
  constexpr int NDT = DV / 32;
  constexpr int VCH = DV / 64;
  constexpr int KS_SZ = 64 * 64, VS_SZ = DV * 64;
  constexpr int NL = 1 + VCH;
  u16* Ks = (u16*)smem;
  u16* Vs = Ks + 4 * KS_SZ;
  float* bt = (float*)(Vs + 3 * VS_SZ);
  const int tid = otid(), lane = tid & 63, w = __builtin_amdgcn_readfirstlane(tid >> 6), r = lane & 31, h = lane >> 5;
  const float sc = 0.125f * LOG2E;
  __syncthreads();
  if (BIAS) { for (int i = tid; i < 257; i += 512) bt[i] = btab[i]; }
  bf16x8 qf[4];
  {
    const u16* qrow = Qp + (size_t)(q0 + 32 * w + r) * INC + 8 * h;
#pragma unroll
    for (int s = 0; s < 4; ++s) qf[s] = *(const bf16x8*)(qrow + 16 * s);
  }
  const int qpos = q0 + 32 * w + r;
  f32x16 O[NDT];
#pragma unroll
  for (int d = 0; d < NDT; ++d)
#pragma unroll
    for (int q = 0; q < 16; ++q) O[d][q] = 0.f;
  float m = -INFINITY, l = 0.f;
  const int lrow = tid >> 3, lsw = (tid & 7) ^ ((tid >> 4) & 7);
  const u16* Kg0 = Kp + (size_t)kperm(lrow) * INC + lsw * 8;
  const u16* Vg = VTp + (size_t)lrow * L + lsw * 8;
  const int ksw = (r >> 1) & 7;
  const int nkb = L >> 6;
#define ATT_LOADK(tile, bufp) do { const int t__ = ((tile) < nkb) ? (tile) : nkb - 1; \
    __builtin_amdgcn_global_load_lds((const unsigned*)(Kg0 + ((size_t)t__ * 64) * INC), (unsigned*)((char*)(bufp) + tid * 16), 16, 0, 0); } while (0)
#define ATT_LOADV(tile, bufp) do { const int t__ = ((tile) < nkb) ? (tile) : nkb - 1; _Pragma("unroll") for (int i_ = 0; i_ < VCH; ++i_) \
    __builtin_amdgcn_global_load_lds((const unsigned*)(Vg + (size_t)(64 * i_) * L + (size_t)t__ * 64), (unsigned*)((char*)(bufp) + tid * 16 + i_ * 8192), 16, 0, 0); } while (0)
  f32x16 Sc[2];
  auto qk = [&](const u16* Kb) __attribute__((always_inline)) {
    bf16x8 kf[2][4];
#pragma unroll
    for (int kt = 0; kt < 2; ++kt)
#pragma unroll
      for (int s = 0; s < 4; ++s) kf[kt][s] = *(const bf16x8*)(Kb + (32 * kt + r) * 64 + (((2 * s + h) ^ ksw) << 3));
#pragma unroll
    for (int kt = 0; kt < 2; ++kt) {
#pragma unroll
      for (int q = 0; q < 16; ++q) Sc[kt][q] = 0.f;
#pragma unroll
      for (int s = 0; s < 4; ++s) Sc[kt] = MFMA(kf[kt][s], qf[s], Sc[kt]);
    }
    __builtin_amdgcn_sched_group_barrier(0x100, 8, 0);
    __builtin_amdgcn_sched_group_barrier(0x008, 8, 0);
  };
  bf16x8 pf[2][2];
  auto softmax = [&](int kb) __attribute__((always_inline)) {
    float cb = 0.f; bool near = false;
    if (BIAS) {
      const int kmin = kb * 64;
      near = !(kmin - (q0 + 255) >= 128 || q0 - (kmin + 63) >= 128);
      cb = (kmin > q0) ? bt[256] : bt[0];
      if (near) {
        const float isc = 1.0f / sc;
#pragma unroll
        for (int kt = 0; kt < 2; ++kt)
#pragma unroll
          for (int q = 0; q < 16; ++q) {
            int rel = kmin + 32 * kt + kperm(crow(q, h)) - qpos;
            rel = rel < -128 ? -128 : (rel > 128 ? 128 : rel);
            Sc[kt][q] += bt[rel + 128] * isc;
          }
        cb = 0.f;
      }
    }
    float mx = Sc[0][0];
#pragma unroll
    for (int kt = 0; kt < 2; ++kt)
#pragma unroll
      for (int q = 0; q < 16; ++q) mx = fmaxf(mx, Sc[kt][q]);
    mx = fmaxf(mx, __shfl_xor(mx, 32));
    mx = __builtin_fmaf(mx, sc, cb);
    if (__any(mx > m + 6.0f)) {
      asm volatile("" ::: "memory");
      const float mn = fmaxf(m, mx);
      const float alpha = __builtin_amdgcn_exp2f(m - mn);
      m = mn; l *= alpha;
#pragma unroll
      for (int d = 0; d < NDT; ++d)
#pragma unroll
        for (int q = 0; q < 16; ++q) O[d][q] *= alpha;
    }
    const float nm = cb - m;
#pragma unroll
    for (int kt = 0; kt < 2; ++kt) {
#pragma unroll
      for (int q = 0; q < 16; ++q) {
        const float pv = __builtin_amdgcn_exp2f(__builtin_fmaf(Sc[kt][q], sc, nm));
        Sc[kt][q] = pv; l += pv;
      }
#pragma unroll
      for (int s = 0; s < 2; ++s) {
        u32x4 pk;
#pragma unroll
        for (int q = 0; q < 4; ++q) pk[q] = pack2(Sc[kt][8 * s + 2 * q], Sc[kt][8 * s + 2 * q + 1]);
        pf[kt][s] = __builtin_bit_cast(bf16x8, pk);
      }
    }
  };
  auto pv = [&](const u16* Vb) __attribute__((always_inline)) {
    bf16x8 vf[4][NDT];
#pragma unroll
    for (int ks = 0; ks < 4; ++ks)
#pragma unroll
      for (int d = 0; d < NDT; ++d) vf[ks][d] = *(const bf16x8*)(Vb + (32 * d + r) * 64 + (((2 * ks + h) ^ ksw) << 3));
#pragma unroll
    for (int ks = 0; ks < 4; ++ks)
#pragma unroll
      for (int d = 0; d < NDT; ++d) O[d] = MFMA(vf[ks][d], pf[ks >> 1][ks & 1], O[d]);
    __builtin_amdgcn_sched_group_barrier(0x100, 2 * NDT, 0);
    __builtin_amdgcn_sched_group_barrier(0x008, NDT, 0);
    __builtin_amdgcn_sched_group_barrier(0x100, NDT, 0);
    __builtin_amdgcn_sched_group_barrier(0x008, NDT, 0);
    __builtin_amdgcn_sched_group_barrier(0x100, NDT, 0);
    __builtin_amdgcn_sched_group_barrier(0x008, 2 * NDT, 0);
  };
  ATT_LOADK(0, Ks); ATT_LOADK(1, Ks + KS_SZ); ATT_LOADK(2, Ks + 2 * KS_SZ);
  ATT_LOADV(0, Vs); ATT_LOADV(1, Vs + VS_SZ);
  asm volatile("s_waitcnt vmcnt(0) lgkmcnt(0)\n\ts_barrier" ::: "memory");
  if (SWAP) qk(Ks);
  int r0 = 0, r2 = 2;
  for (int kb = 0; kb < nkb; ++kb) {
    ATT_LOADK(kb + 3, Ks + ((kb + 3) & 3) * KS_SZ);
    ATT_LOADV(kb + 2, Vs + r2 * VS_SZ);
    if (!SWAP) qk(Ks + (kb & 3) * KS_SZ);
    softmax(kb);
    pv(Vs + r0 * VS_SZ);
    if (SWAP) qk(Ks + ((kb + 1) & 3) * KS_SZ);
    asm volatile("s_waitcnt vmcnt(%0) lgkmcnt(0)\n\ts_barrier" :: "n"(NL) : "memory");
    r2 = r0; r0 = (r0 == 2) ? 0 : r0 + 1;
  }
  asm volatile("s_waitcnt vmcnt(0)" ::: "memory");
#undef ATT_LOADK
#undef ATT_LOADV
  l += __shfl_xor(l, 32);
  const float inv = __builtin_amdgcn_rcpf(l);
  int ldo2 = ldo; asm volatile("" : "+s"(ldo2));
  u16* orow = Op + (size_t)qpos * ldo2;
#pragma unroll
  for (int d = 0; d < NDT; ++d)
#pragma unroll
    for (int g4 = 0; g4 < 4; ++g4) {
      u32x2 o; o[0] = pack2(O[d][4 * g4] * inv, O[d][4 * g4 + 1] * inv); o[1] = pack2(O[d][4 * g4 + 2] * inv, O[d][4 * g4 + 3] * inv);
      *(u32x2*)(orow + 32 * d + 8 * g4 + 4 * h) = o;
    }
}

DI void attn_tile2(const u16* __restrict__ Qp, const u16* __restrict__ Kp, const u16* __restrict__ VTp, int L,
                   u16* __restrict__ Op, int ldo, int q0, char* smem) {
  constexpr int DV = 64, NDT = 2, VCH = 1, RT = 2;
  constexpr int KS_SZ = 64 * 64, VS_SZ = DV * 64;
  constexpr int NL = 1 + VCH;
  u16* Ks = (u16*)smem;
  u16* Vs = Ks + 4 * KS_SZ;
  const int tid = otid(), lane = tid & 63, w = __builtin_amdgcn_readfirstlane(tid >> 6), r = lane & 31, h = lane >> 5;
  const float sc = 0.125f * LOG2E;
  __syncthreads();
  bf16x8 qf[RT][4];
#pragma unroll
  for (int t = 0; t < RT; ++t) {
    const u16* qrow = Qp + (size_t)(q0 + 64 * w + 32 * t + r) * INC + 8 * h;
#pragma unroll
    for (int s = 0; s < 4; ++s) qf[t][s] = *(const bf16x8*)(qrow + 16 * s);
  }
  f32x16 O[RT][NDT];
#pragma unroll
  for (int t = 0; t < RT; ++t)
#pragma unroll
    for (int d = 0; d < NDT; ++d)
#pragma unroll
      for (int q = 0; q < 16; ++q) O[t][d][q] = 0.f;
  float m[RT], l[RT];
#pragma unroll
  for (int t = 0; t < RT; ++t) { m[t] = -INFINITY; l[t] = 0.f; }
  const int lrow = tid >> 3, lsw = (tid & 7) ^ ((tid >> 4) & 7);
  const u16* Kg0 = Kp + (size_t)kperm(lrow) * INC + lsw * 8;
  const u16* Vg = VTp + (size_t)lrow * L + lsw * 8;
  const int ksw = (r >> 1) & 7;
  const int nkb = L >> 6;
#define ATT_LOADK(tile, bufp) do { const int t__ = ((tile) < nkb) ? (tile) : nkb - 1; \
    __builtin_amdgcn_global_load_lds((const unsigned*)(Kg0 + ((size_t)t__ * 64) * INC), (unsigned*)((char*)(bufp) + tid * 16), 16, 0, 0); } while (0)
#define ATT_LOADV(tile, bufp) do { const int t__ = ((tile) < nkb) ? (tile) : nkb - 1; \
    __builtin_amdgcn_global_load_lds((const unsigned*)(Vg + (size_t)t__ * 64), (unsigned*)((char*)(bufp) + tid * 16), 16, 0, 0); } while (0)
  ATT_LOADK(0, Ks); ATT_LOADK(1, Ks + KS_SZ); ATT_LOADK(2, Ks + 2 * KS_SZ);
  ATT_LOADV(0, Vs); ATT_LOADV(1, Vs + VS_SZ);
  asm volatile("s_waitcnt vmcnt(0) lgkmcnt(0)\n\ts_barrier" ::: "memory");
  int r0 = 0, r2 = 2;
  for (int kb = 0; kb < nkb; ++kb) {
    ATT_LOADK(kb + 3, Ks + ((kb + 3) & 3) * KS_SZ);
    ATT_LOADV(kb + 2, Vs + r2 * VS_SZ);
    const u16* Kb = Ks + (kb & 3) * KS_SZ; const u16* Vb = Vs + r0 * VS_SZ;
    f32x16 Sc[RT][2];
    {
      bf16x8 kf[2][4];
#pragma unroll
      for (int kt = 0; kt < 2; ++kt)
#pragma unroll
        for (int s = 0; s < 4; ++s) kf[kt][s] = *(const bf16x8*)(Kb + (32 * kt + r) * 64 + (((2 * s + h) ^ ksw) << 3));
#pragma unroll
      for (int t = 0; t < RT; ++t)
#pragma unroll
        for (int kt = 0; kt < 2; ++kt) {
#pragma unroll
          for (int q = 0; q < 16; ++q) Sc[t][kt][q] = 0.f;
#pragma unroll
          for (int s = 0; s < 4; ++s) Sc[t][kt] = MFMA(kf[kt][s], qf[t][s], Sc[t][kt]);
        }
      __builtin_amdgcn_sched_group_barrier(0x100, 8, 0);
      __builtin_amdgcn_sched_group_barrier(0x008, 16, 0);
    }
    bf16x8 pf[RT][2][2];
#pragma unroll
    for (int t = 0; t < RT; ++t) {
      float mx = Sc[t][0][0];
#pragma unroll
      for (int kt = 0; kt < 2; ++kt)
#pragma unroll
        for (int q = 0; q < 16; ++q) mx = fmaxf(mx, Sc[t][kt][q]);
      mx = fmaxf(mx, __shfl_xor(mx, 32));
      mx *= sc;
      if (__any(mx > m[t] + 6.0f)) {
        asm volatile("" ::: "memory");
        const float mn = fmaxf(m[t], mx);
        const float alpha = __builtin_amdgcn_exp2f(m[t] - mn);
        m[t] = mn; l[t] *= alpha;
#pragma unroll
        for (int d = 0; d < NDT; ++d)
#pragma unroll
          for (int q = 0; q < 16; ++q) O[t][d][q] *= alpha;
      }
      const float nm = -m[t];
#pragma unroll
      for (int kt = 0; kt < 2; ++kt) {
#pragma unroll
        for (int q = 0; q < 16; ++q) { const float pv = __builtin_amdgcn_exp2f(__builtin_fmaf(Sc[t][kt][q], sc, nm)); Sc[t][kt][q] = pv; l[t] += pv; }
#pragma unroll
        for (int s = 0; s < 2; ++s) {
          u32x4 pk;
#pragma unroll
          for (int q = 0; q < 4; ++q) pk[q] = pack2(Sc[t][kt][8 * s + 2 * q], Sc[t][kt][8 * s + 2 * q + 1]);
          pf[t][kt][s] = __builtin_bit_cast(bf16x8, pk);
        }
      }
    }
    {
      bf16x8 vf[4][NDT];
#pragma unroll
      for (int ks = 0; ks < 4; ++ks)
#pragma unroll
        for (int d = 0; d < NDT; ++d) vf[ks][d] = *(const bf16x8*)(Vb + (32 * d + r) * 64 + (((2 * ks + h) ^ ksw) << 3));
#pragma unroll
      for (int ks = 0; ks < 4; ++ks)
#pragma unroll
        for (int d = 0; d < NDT; ++d)
#pragma unroll
          for (int t = 0; t < RT; ++t) O[t][d] = MFMA(vf[ks][d], pf[t][ks >> 1][ks & 1], O[t][d]);
      __builtin_amdgcn_sched_group_barrier(0x100, 4, 0);
      __builtin_amdgcn_sched_group_barrier(0x008, 4, 0);
      __builtin_amdgcn_sched_group_barrier(0x100, 4, 0);
      __builtin_amdgcn_sched_group_barrier(0x008, 12, 0);
    }
    asm volatile("s_waitcnt vmcnt(%0) lgkmcnt(0)\n\ts_barrier" :: "n"(NL) : "memory");
    r2 = r0; r0 = (r0 == 2) ? 0 : r0 + 1;
  }
  asm volatile("s_waitcnt vmcnt(0)" ::: "memory");
#undef ATT_LOADK
#undef ATT_LOADV
  int ldo2 = ldo; asm volatile("" : "+s"(ldo2));
#pragma unroll
  for (int t = 0; t < RT; ++t) {
    float lt = l[t]; lt += __shfl_xor(lt, 32);
    const float inv = __builtin_amdgcn_rcpf(lt);
    u16* orow = Op + (size_t)(q0 + 64 * w + 32 * t + r) * ldo2;
#pragma unroll
    for (int d = 0; d < NDT; ++d)
#pragma unroll
      for (int g4 = 0; g4 < 4; ++g4) {
        u32x2 o; o[0] = pack2(O[t][d][4 * g4] * inv, O[t][d][4 * g4 + 1] * inv); o[1] = pack2(O[t][d][4 * g4 + 2] * inv, O[t][d][4 * g4 + 3] * inv);
        *(u32x2*)(orow + 32 * d + 8 * g4 + 4 * h) = o;
      }
  }
}

DI void hyena_item(int c, const u16* __restrict__ G, const u16* __restrict__ zT, u16* __restrict__ yT, int nseq, int L, char* smem) {
  u16* zs = (u16*)smem;
  u16* fw = zs + 20480;
  u16* fw1 = fw + 8256;
  const int tid = otid() & 255, lane = tid & 63, w = __builtin_amdgcn_readfirstlane(tid >> 6), r = lane & 31, h = lane >> 5;
  const int ZL = L + 2048;
  __syncthreads();
  for (int q = 0; q < nseq; ++q) {
    const u16* src = zT + ((size_t)q * 512 + c) * L;
    u16* dst = zs + q * ZL;
    const u32x4 zero = {0u, 0u, 0u, 0u};
    for (int i = tid; i < 128; i += 256) { *(u32x4*)(dst + i * 8) = zero; *(u32x4*)(dst + 1024 + L + i * 8) = zero; }
    for (int i = tid; i < (L >> 3); i += 256) *(u32x4*)(dst + 1024 + i * 8) = *(const u32x4*)(src + i * 8);
  }
  int tq[4], tJ[4];
#pragma unroll
  for (int i = 0; i < 4; ++i) { if (nseq == 2) { tq[i] = i & 1; tJ[i] = 2 * w + (i >> 1); } else { tq[i] = 0; tJ[i] = 4 * w + i; } }
  f32x16 acc[4];
#pragma unroll
  for (int i = 0; i < 4; ++i)
#pragma unroll
    for (int q = 0; q < 16; ++q) acc[i][q] = 0.f;
  const int E0 = -L + 16, ELAST = L - 32;
  const int npass = (2 * L - 32 + 8191) / 8192;
  const u16* Gc = G + (size_t)c * (2 * L);
  for (int ps = 0; ps < npass; ++ps) {
    const int ea = E0 + 8192 * ps, eb = ea + 8192;
    const int wb = L - eb - 16;
    __syncthreads();
    for (int i = tid; i < 1032; i += 256) {
      const int gi = wb + i * 8;
      u32x4 v = {0u, 0u, 0u, 0u};
      if (gi >= 0 && gi < 2 * L) v = *(const u32x4*)(Gc + gi);
      *(u32x4*)(fw + i * 8) = v;
    }
    __syncthreads();
    for (int i = tid; i < 4127; i += 256) { const unsigned lo = ((const unsigned*)fw)[i], hi = ((const unsigned*)fw)[i + 1]; ((unsigned*)fw1)[i] = (lo >> 16) | (hi << 16); }
    __syncthreads();
    const int eend = (eb - 16 < ELAST) ? (eb - 16) : ELAST;
    auto slow = [&](int e_lo, int e_hi) __attribute__((always_inline)) {
      for (int e = e_lo; e <= e_hi; e += 16) {
        bool in[4]; bool any = false;
#pragma unroll
        for (int i = 0; i < 4; ++i) { in[i] = (e >= 1024 * tJ[i] - L + 16) && (e <= 1024 * tJ[i] + 992); any = any || in[i]; }
        if (!any) continue;
        const int idx0 = L - e - r + 8 * h - wb;
        const unsigned* aw = (idx0 & 1) ? (const unsigned*)(fw1 + idx0 - 1) : (const unsigned*)(fw + idx0);
        u32x4 av; av[0] = aw[0]; av[1] = aw[1]; av[2] = aw[2]; av[3] = aw[3];
        const bf16x8 a = __builtin_bit_cast(bf16x8, av);
#pragma unroll
        for (int i = 0; i < 4; ++i) {
          if (in[i]) {
            const bf16x8 b = *(const bf16x8*)(zs + tq[i] * ZL + 1024 + 1024 * tJ[i] + 32 * r - e + 8 * h);
            acc[i] = MFMA(a, b, acc[i]);
          }
        }
      }
    };
    int mlo = 1024 * tJ[3] - L + 16, mhi = 1024 * tJ[0] + 992;
    if (mlo < ea) mlo = ea; if (mhi > eend) mhi = eend;
    if (mlo > mhi) { slow(ea, eend); }
    else {
      slow(ea, mlo - 16);
      {
        const int idx0 = L - mlo - r + 8 * h - wb;
        const unsigned* ap = (idx0 & 1) ? (const unsigned*)(fw1 + idx0 - 1) : (const unsigned*)(fw + idx0);
        const u16* bp0 = zs + tq[0] * ZL + 1024 + 1024 * tJ[0] + 32 * r - mlo + 8 * h;
        const u16* bp1 = zs + tq[1] * ZL + 1024 + 1024 * tJ[1] + 32 * r - mlo + 8 * h;
        const u16* bp2 = zs + tq[2] * ZL + 1024 + 1024 * tJ[2] + 32 * r - mlo + 8 * h;
        const u16* bp3 = zs + tq[3] * ZL + 1024 + 1024 * tJ[3] + 32 * r - mlo + 8 * h;
        const int n = ((mhi - mlo) >> 4) + 1;
        bf16x8 a, b0, b1, b2, b3;
        { u32x4 av; av[0] = ap[0]; av[1] = ap[1]; av[2] = ap[2]; av[3] = ap[3]; a = __builtin_bit_cast(bf16x8, av); }
        b0 = *(const bf16x8*)bp0; b1 = *(const bf16x8*)bp1; b2 = *(const bf16x8*)bp2; b3 = *(const bf16x8*)bp3;
        for (int k = 0; k < n; ++k) {
          ap -= 8; bp0 -= 16; bp1 -= 16; bp2 -= 16; bp3 -= 16;
          bf16x8 an, c0, c1, c2, c3;
          { u32x4 av; av[0] = ap[0]; av[1] = ap[1]; av[2] = ap[2]; av[3] = ap[3]; an = __builtin_bit_cast(bf16x8, av); }
          c0 = *(const bf16x8*)bp0; c1 = *(const bf16x8*)bp1; c2 = *(const bf16x8*)bp2; c3 = *(const bf16x8*)bp3;
          acc[0] = MFMA(a, b0, acc[0]); acc[1] = MFMA(a, b1, acc[1]); acc[2] = MFMA(a, b2, acc[2]); acc[3] = MFMA(a, b3, acc[3]);
          a = an; b0 = c0; b1 = c1; b2 = c2; b3 = c3;
        }
      }
      slow(mhi + 16, eend);
    }
  }
#pragma unroll
  for (int i = 0; i < 4; ++i) {
    u16* dst = yT + ((size_t)tq[i] * 512 + c) * L + 1024 * tJ[i] + 32 * r + 4 * h;
#pragma unroll
    for (int g4 = 0; g4 < 4; ++g4) {
      u32x2 o; o[0] = pack2(acc[i][4 * g4], acc[i][4 * g4 + 1]); o[1] = pack2(acc[i][4 * g4 + 2], acc[i][4 * g4 + 3]);
      *(u32x2*)(dst + 8 * g4) = o;
    }
  }
}

DI void diff_post_item(const Params& P, int layer, float lam, float lam_init, const u16* __restrict__ dO, u16* __restrict__ ydf, int it) {
  const int tid = otid() & 255, lane = tid & 63, w = __builtin_amdgcn_readfirstlane(tid >> 6);
  const int u = it * 8 + w * 2 + (lane >> 5);
  const int i = lane & 31;
  const u32x2 a = *(const u32x2*)(dO + (size_t)u * 256 + 4 * i);
  const u32x2 b = *(const u32x2*)(dO + (size_t)u * 256 + 128 + 4 * i);
  float o[4];
  o[0] = bflo(a[0]) - lam * bflo(b[0]); o[1] = bfhi(a[0]) - lam * bfhi(b[0]);
  o[2] = bflo(a[1]) - lam * bflo(b[1]); o[3] = bfhi(a[1]) - lam * bfhi(b[1]);
  const float ss = half_sum(o[0] * o[0] + o[1] * o[1] + o[2] * o[2] + o[3] * o[3]);
  const float rs = rsqrtf(ss * (1.0f / 128.0f) + 1e-5f) * (1.0f - lam_init);
  const float* g = P.diff_subln + layer * 128 + 4 * i;
  u32x2 ov; ov[0] = pack2(o[0] * rs * g[0], o[1] * rs * g[1]); ov[1] = pack2(o[2] * rs * g[2], o[3] * rs * g[3]);
  *(u32x2*)(ydf + (size_t)u * 128 + 4 * i) = ov;
}
DI void hyena_post_item(const Params& P, int layer, const u16* __restrict__ p, int L, const u16* __restrict__ yT, const u16* __restrict__ zT,
                        int ct, int tt, u16* __restrict__ yhy, char* smem) {
  float* tile = (float*)smem;
  const int tid = otid() & 255;
  const int t0 = tt * 64; const int seq = t0 / L, tl0 = t0 - seq * L;
  __syncthreads();
  {
    const int tcol = tid & 63, c0 = tid >> 6;
#pragma unroll
    for (int i = 0; i < 16; ++i) {
      const int cc = c0 + 4 * i; const int c = ct * 64 + cc;
      const size_t gi = ((size_t)seq * 512 + c) * L + tl0 + tcol;
      tile[cc * 65 + tcol] = bf2f(yT[gi]) + bf2f(zT[gi]) * P.hy_skip[layer * 512 + c];
    }
  }
  __syncthreads();
  {
    const int col = tid & 63, r0 = tid >> 6; const int c = ct * 64 + col;
    const float* cw = P.hy_conv_w + layer * 3 * 1536; const float* cb = P.hy_conv_b + layer * 1536;
    const float w0 = cw[c], w1 = cw[1536 + c], w2 = cw[3072 + c], b0 = cb[c];
#pragma unroll
    for (int i = 0; i < 16; ++i) {
      const int row = r0 + 4 * i; const int tl = tl0 + row;
      const u16* pr = p + (size_t)(t0 + row) * INC + c;
      const float xm1 = (tl > 0) ? bf2f(pr[-INC]) : 0.f, x0 = bf2f(pr[0]), xp1 = (tl < L - 1) ? bf2f(pr[INC]) : 0.f;
      const float x0c = xm1 * w0 + x0 * w1 + xp1 * w2 + b0;
      yhy[(size_t)(t0 + row) * 512 + c] = f2bf(x0c * tile[col * 65 + row]);
    }
  }
}

__global__ void __launch_bounds__(512) fwd_megakernel(Params Parg) {
  cg::grid_group grid = cg::this_grid();
  extern __shared__ __attribute__((aligned(16))) char smem_dyn[];
  char* smem = smem_dyn + 16;
  uint4& xb_words = *(uint4*)smem_dyn;
  const int nb = gridDim.x, nb2 = nb * 2;
#define KPARAMS() const Params __attribute__((address_space(4)))* pp_ = (const Params __attribute__((address_space(4)))*)__builtin_amdgcn_kernarg_segment_ptr(); \
  asm volatile("" : "+s"(pp_)); const Params& P = *(const Params*)pp_; char* ws = P.ws
  if (threadIdx.x == 0) xb_words = make_uint4(0u, 0u, 0u, blockIdx.x);
  __syncthreads();
  XcdBarrier xb;
  { KPARAMS(); xb = xcd_barrier_post((unsigned*)(ws + O_BAR), (volatile LAS unsigned*)&xb_words); }

  for (int step = 0; step < 80; ++step) {
    const int layer = step / 40, ls = step - layer * 40;
    PHASE_IDS();
    KPARAMS();
    float* misc = (float*)(ws + O_MISC);
    u16* pbuf = (u16*)(ws + O_P); u16* hid = pbuf; u16* hn = (u16*)(ws + O_HN); u16* merged = hn;
    if (ls == 0) {
      u16* filt8 = (u16*)(ws + O_FILT8); u16* filt16 = (u16*)(ws + O_FILT16);
      const int n1 = 16 * 88, n2 = 44 * 16, n3 = 16 * 108, n4 = 3 * 8 * 16, n5 = 16 * 16;
      const int nfilt = 128 + 256;
      const int total = n1 + n2 + n3 + n4 + n5 + n1 + n2 + nfilt;
      for (int it = bid2; it < total; it += nb2) {
        int t = it;
        if (t < nfilt) {
          const bool big = t < 256;
          filter_item(P, layer, big ? 16384 : 8192, big ? t : t - 256, big ? filt16 : filt8, smg);
          continue;
        }
        t -= nfilt;
        const float* src; int K, N, kt, nt, ph = 0; u16* dst;
        if (t < n1) { src = P.ffn1_w_in + (size_t)layer * 1024 * 5632; K = 1024; N = 5632; dst = (u16*)(ws + O_F1IN); kt = t / 88; nt = t % 88; ph = 2816; }
        else if ((t -= n1) < n2) { src = P.ffn1_w_out + (size_t)layer * 2816 * 1024; K = 2816; N = 1024; dst = (u16*)(ws + O_F1OUT); kt = t / 16; nt = t % 16; }
        else if ((t -= n2) < n3) { src = P.w_in + (size_t)layer * 1024 * 6912; K = 1024; N = 6912; dst = (u16*)(ws + O_WIN); kt = t / 108; nt = t % 108; }
        else if ((t -= n3) < n4) { const int br = t / 128, tt = t % 128; src = P.w_branch + ((size_t)layer * 3 + br) * 512 * 1024; K = 512; N = 1024;
                                   dst = (u16*)(ws + O_WBR) + (size_t)br * 1024 * 512; kt = tt / 16; nt = tt % 16; }
        else if ((t -= n4) < n5) { src = P.w_out + (size_t)layer * 1024 * 1024; K = 1024; N = 1024; dst = (u16*)(ws + O_WOUT); kt = t / 16; nt = t % 16; }
        else if ((t -= n5) < n1) { src = P.ffn2_w_in + (size_t)layer * 1024 * 5632; K = 1024; N = 5632; dst = (u16*)(ws + O_F2IN); kt = t / 88; nt = t % 88; ph = 2816; }
        else { t -= n1; src = P.ffn2_w_out + (size_t)layer * 2816 * 1024; K = 2816; N = 1024; dst = (u16*)(ws + O_F2OUT); kt = t / 16; nt = t % 16; }
        convT_tile(src, K, N, dst, kt, nt, ph, smg);
      }
      if (bid == 1 && grp == 0 && layer == 0) {
        float* rope = (float*)(ws + O_ROPE);
        for (int i = t_; i < 320 * 16; i += 256) {
          const int pos = (i < 4096) ? (i >> 4) : ((i - 4096) >> 4); const int jj = i & 15;
          const float inv = powf(10000.0f, -(float)(2 * jj) / 32.0f);
          const float ang = (float)pos * inv;
          rope[2 * i] = cosf(ang); rope[2 * i + 1] = sinf(ang);
        }
      }
      if (bid == 0 && grp == 0) {
        const int tid = t_;
        if (tid < 2) {
          const float* lp = P.diff_lambda + tid * 256;
          float s1 = 0.f, s2 = 0.f;
          for (int i = 0; i < 64; ++i) { s1 += lp[i] * lp[64 + i]; s2 += lp[128 + i] * lp[192 + i]; }
          const float lam_init = 0.8f - 0.6f * expf(-0.3f * (float)tid);
          misc[tid] = expf(s1) - expf(s2) + lam_init;
        }
        for (int i = tid; i < 4 * 257; i += 256) {
          const int hh = i / 257, idx = i % 257; const int rel = idx - 128; const int n = rel < 0 ? -rel : rel;
          int b;
          if (n < 8) b = n; else { int lg = 8 + (int)(logf((float)n / 8.0f) / 2.772588722239781f * 8.0f); b = lg < 15 ? lg : 15; }
          if (rel > 0) b += 16;
          misc[64 + i] = P.rel_bias[b * 4 + hh] * LOG2E;
        }
      }
      if (step == 0) {
        grid.sync();
        if (threadIdx.x == 0) {
          unsigned* bar = (unsigned*)(ws + O_BAR); bool even = ((nb & 7) == 0);
          for (int j = 0; j < 16; ++j) { const unsigned c = xb_ld(&bar[XB_XCNT(j)]); if (c != ((j < 8) ? (unsigned)(nb >> 3) : 0u)) even = false; }
          volatile LAS unsigned* st = (volatile LAS unsigned*)&xb_words;
          if (even) st[3] = st[2] * 8u + xb.x;
        }
        __syncthreads();
      } else GSYNC();
      continue;
    }
    const int cs = ls - 1; const int ch = cs / 13, st = cs - ch * 13;
    const int nseq = (ch < 2) ? 2 : 1, L = (ch < 2) ? 8192 : 16384;
    const float* xin0 = (ch < 2) ? (P.x_prompt + (size_t)ch * TCH * DM) : P.x_sample;
    float* xres = P.out + (size_t)ch * TCH * DM;
    const float* xcur = (layer == 0) ? xin0 : xres;
    for (int rp_ = 0; rp_ <= ((REPMASK >> st) & 1); ++rp_) {
    if (st == 0 || st == 3 || st == 10) {
      const float* src = (st == 0) ? xcur : xres;
      const float* gn = ((st == 0) ? P.ffn1_norm : (st == 3 ? P.mix_norm : P.ffn2_norm)) + layer * DM;
      for (int it = bid2; it < TCH / 4; it += nb2) { const int row = it * 4 + w; norm_row_bf16(src + (size_t)row * DM, gn, hn + (size_t)row * DM, lane); }
    } else if (st == 1 || st == 2 || st == 4 || st == 8 || st == 9 || st == 11 || st == 12) {
      EpiAny E{}; const u16* A; const u16* Bt; int N, K;
      if (st == 1 || st == 11) { A = hn; Bt = (u16*)(ws + (st == 1 ? O_F1IN : O_F2IN)); N = 5632; K = DM; E.mode = EPI_SWIGLU; E.perm = true; E.O = hid; E.ldo = DFF; }
      else if (st == 2 || st == 12) { A = hid; Bt = (u16*)(ws + (st == 2 ? O_F1OUT : O_F2OUT)); N = DM; K = DFF; E.mode = EPI_RESID; E.perm = false;
                                      E.xin = (st == 2) ? xcur : xres; E.xout = xres; E.scale = 0.5f; }
      else if (st == 4) { A = hn; Bt = (u16*)(ws + O_WIN); N = INC; K = DM; E.mode = EPI_PROJ; E.perm = true; E.O = pbuf; }
      else if (st == 8) { A = (u16*)(ws + O_YHY); Bt = (u16*)(ws + O_WBR); N = DM; K = 512; E.mode = EPI_MERGE; E.perm = false; E.gate = pbuf; E.macc = (float*)(ws + O_ZT); E.O = merged; }
      else { A = merged; Bt = (u16*)(ws + O_WOUT); N = DM; K = DM; E.mode = EPI_RESID; E.perm = false; E.xin = xres; E.xout = xres; E.scale = 1.0f; }
      {
        pg8::Gemm gg{A, Bt, TCH, N, K};
        AnyOrder S; S.init(TCH, N, nb, bid); S.merge3 = (st == 8);
        pg8::gemm_phase<EpiAny, AnyOrder, false>((PG8_LAS unsigned char*)smem, gg, S, E, nullptr);
      }
    } else if (st == 5) {
      const int nqk = TCH * 10 / 8, ntr = 256 * 18;
      for (int it = bid2; it < nqk + ntr; it += nb2) {
        if (it < nqk) { qk_prep_item(P, layer, pbuf, L, it, (const float*)(ws + O_ROPE)); continue; }
        const int t = it - nqk; const int tt = t / 18, cc = t % 18;
        const int kind = (cc < 2) ? 0 : (cc < 10 ? 1 : 2);
        const int ct = (cc < 2) ? cc : (cc < 10 ? cc - 2 : cc - 10);
        u16* dst = (u16*)(ws + (kind == 0 ? O_VTG : (kind == 1 ? O_VTD : O_ZT)));
        transpose_item(P, layer, pbuf, L, kind, ct, tt, dst, smg);
      }
    } else if (st == 6) {
      u16* zT = (u16*)(ws + O_ZT); u16* yT = (u16*)(ws + O_YT); u16* dO = (u16*)(ws + O_DIFFO);
      u16* vtg = (u16*)(ws + O_VTG); u16* vtd = (u16*)(ws + O_VTD); u16* ygq = (u16*)(ws + O_YGQ);
      const u16* filt = (u16*)(ws + ((ch < 2) ? O_FILT8 : O_FILT16));
      const int nqt = L / 256;
      const int xcd = bid & 7, nxu = nb >> 3, nitem = nseq * nqt;
      for (int e = bid >> 3; e < nitem; e += nxu) {
        const int seq = e / nqt, qt = e - seq * nqt;
        const int hh = xcd >> 1, cc = xcd & 1;
        const size_t tb = (size_t)seq * L;
        const u16* Qd = pbuf + tb * INC + OFF_DQ + xcd * 64; const u16* Kd = pbuf + tb * INC + OFF_DK + xcd * 64;
        const u16* Vd = vtd + ((size_t)seq * 512 + hh * 128) * L; u16* Od = dO + tb * 1024 + (hh * 2 + cc) * 128;
        attn_tile<128, true, false>(Qd, Kd, Vd, L, Od, 1024, qt * 256, misc + 64 + hh * 257, smem);
      }
      {
        const int nqt2 = L / 512, nitem2 = nseq * nqt2;
        for (int e = bid >> 3; e < nitem2; e += nxu) {
          const int seq = e / nqt2, qt = e - seq * nqt2;
          const int kvh = xcd >> 2;
          const size_t tb = (size_t)seq * L;
          const u16* Qd = pbuf + tb * INC + OFF_GQ + xcd * 64; const u16* Kd = pbuf + tb * INC + OFF_GK + kvh * 64;
          const u16* Vd = vtg + ((size_t)seq * 128 + kvh * 64) * L; u16* Od = ygq + tb * 512 + xcd * 64;
          attn_tile2(Qd, Kd, Vd, L, Od, 512, qt * 512, smem);
        }
      }
      for (int c = bid2; c < 512; c += nb2) hyena_item(c, filt, zT, yT, nseq, L, smg);
    } else {
      u16* zT = (u16*)(ws + O_ZT); u16* yT = (u16*)(ws + O_YT); u16* dO = (u16*)(ws + O_DIFFO);
      u16* yhy = (u16*)(ws + O_YHY); u16* ydf = (u16*)(ws + O_YDF);
      const float lam = misc[layer];
      const float lam_init = 0.8f - 0.6f * expf(-0.3f * (float)layer);
      const int ndp = TCH * 4 / 8, nhp = 256 * 8;
      for (int it = bid2; it < ndp + nhp; it += nb2) {
        if (it < ndp) diff_post_item(P, layer, lam, lam_init, dO, ydf, it);
        else { const int t = it - ndp; hyena_post_item(P, layer, pbuf, L, yT, zT, t % 8, t / 8, yhy, smg); }
      }
    }
    }
    GSYNC();
  }
  { PHASE_IDS(); KPARAMS(); (void)ws;
    for (int it = bid2; it < NTOK / 4; it += nb2) { const int row = it * 4 + w; norm_row_f32_inplace(P.out + (size_t)row * DM, P.final_norm, lane); }
  }
}

extern "C" void kernel_launch(void* const* d_in, const int* in_sizes, int n_in, void* d_out, int out_size, void* d_ws, size_t ws_size,
                              hipStream_t stream) {
  static int grid_blocks = 0;
  if (!grid_blocks) {
    int dev = 0, cus = 0, per_cu = 0;
    (void)hipGetDevice(&dev);
    (void)hipDeviceGetAttribute(&cus, hipDeviceAttributeMultiprocessorCount, dev);
    (void)hipFuncSetAttribute((const void*)fwd_megakernel, hipFuncAttributeMaxDynamicSharedMemorySize, SMEM_BYTES + 16);
    (void)hipOccupancyMaxActiveBlocksPerMultiprocessor(&per_cu, fwd_megakernel, 512, SMEM_BYTES + 16);
    if (per_cu < 1) per_cu = 1;
    if (per_cu > 1) per_cu = 1;
    grid_blocks = cus * per_cu;
  }
  Params p{};
  const float* const* in = (const float* const*)d_in;
  p.x_prompt = in[0]; p.x_sample = in[1]; p.ffn1_norm = in[2]; p.ffn1_w_in = in[3]; p.ffn1_w_out = in[4]; p.mix_norm = in[5]; p.w_in = in[6];
  p.hy_conv_w = in[7]; p.hy_conv_b = in[8]; p.hy_w1 = in[9]; p.hy_b1 = in[10]; p.hy_w2 = in[11]; p.hy_b2 = in[12]; p.hy_w3 = in[13];
  p.hy_freq = in[14]; p.hy_skip = in[15]; p.gqa_q_norm = in[16]; p.gqa_k_norm = in[17]; p.diff_lambda = in[18]; p.diff_subln = in[19];
  p.rel_bias = in[20]; p.w_branch = in[21]; p.w_out = in[22]; p.ffn2_norm = in[23]; p.ffn2_w_in = in[24]; p.ffn2_w_out = in[25]; p.final_norm = in[26];
  p.out = (float*)d_out; p.ws = (char*)d_ws;
  void* args[] = {&p};
  (void)hipMemsetAsync((char*)d_ws + O_BAR, 0, XCD_BAR_WORDS * 4, stream);
  hipError_t e = hipLaunchCooperativeKernel((void*)fwd_megakernel, dim3(grid_blocks), dim3(512), args, SMEM_BYTES + 16, stream);
  if (e != hipSuccess) fprintf(stderr, "cooperative launch failed: %s (grid %d)\n", hipGetErrorString(e), grid_blocks);
}
```

```cpp
#include <hip/hip_runtime.h>
#include <hip/hip_cooperative_groups.h>
#include <stdint.h>
#include <cstdio>
namespace cg = cooperative_groups;

typedef unsigned short u16;
typedef __attribute__((ext_vector_type(8))) short bf16x8;
typedef __attribute__((ext_vector_type(16))) float f32x16;
typedef __attribute__((ext_vector_type(4))) float f32x4;
typedef __attribute__((ext_vector_type(4))) unsigned u32x4;
typedef __attribute__((ext_vector_type(2))) unsigned u32x2;
typedef __attribute__((ext_vector_type(2))) __bf16 bf2_t;
typedef __attribute__((ext_vector_type(2))) float f2_t;
#define DI __device__ __forceinline__
#define MFMA(a, b, c) __builtin_amdgcn_mfma_f32_32x32x16_bf16((a), (b), (c), 0, 0, 0)

constexpr int DM = 1024, DFF = 2816, INC = 6912, TCH = 16384, NTOK = 49152;
constexpr int OFF_GQ = 1536, OFF_GK = 2048, OFF_GV = 2176, OFF_DQ = 2304, OFF_DK = 2816, OFF_DV = 3328, OFF_GATE = 3840;
constexpr float LOG2E = 1.4426950408889634f;

constexpr size_t SZ_F1IN = (size_t)5632 * 1024 * 2, SZ_F1OUT = (size_t)1024 * 2816 * 2, SZ_WIN = (size_t)6912 * 1024 * 2,
                 SZ_WBR = (size_t)3 * 1024 * 512 * 2, SZ_WOUT = (size_t)1024 * 1024 * 2;
constexpr size_t O_F1IN = 0, O_F1OUT = O_F1IN + SZ_F1IN, O_WIN = O_F1OUT + SZ_F1OUT, O_WBR = O_WIN + SZ_WIN, O_WOUT = O_WBR + SZ_WBR,
                 O_F2IN = O_WOUT + SZ_WOUT, O_F2OUT = O_F2IN + SZ_F1IN, O_FILT8 = O_F2OUT + SZ_F1OUT,
                 O_FILT16 = O_FILT8 + (size_t)512 * 16384 * 2, O_MISC = O_FILT16 + (size_t)512 * 32768 * 2,
                 O_P = O_MISC + 131072, O_HN = O_P + (size_t)TCH * INC * 2, O_ZT = O_HN + (size_t)TCH * 1024 * 2,
                 O_YT = O_ZT + (size_t)TCH * 512 * 2, O_DIFFO = O_YT + (size_t)TCH * 512 * 2, O_VTG = O_DIFFO + (size_t)TCH * 1024 * 2,
                 O_VTD = O_VTG + (size_t)TCH * 128 * 2, O_YHY = O_VTD + (size_t)TCH * 512 * 2, O_YGQ = O_YHY + (size_t)TCH * 512 * 2,
                 O_YDF = O_YGQ + (size_t)TCH * 512 * 2, O_END = O_YDF + (size_t)TCH * 512 * 2;
static_assert(O_END <= (size_t)536870912, "workspace overflow");
constexpr int SMEM_BYTES = 151552;
constexpr int GRP_LDS = 75776;
#define REPMASK 0
#define REP_SYNC 1
#define PHASE_IDS() const int t_ = otid(); const int bid = __builtin_amdgcn_readfirstlane(((volatile LAS unsigned*)&xb_words)[3]); const int lane = t_ & 63; const int grp = __builtin_amdgcn_readfirstlane(t_ >> 8); \
  const int w = __builtin_amdgcn_readfirstlane((t_ >> 6) & 3); const int bid2 = bid * 2 + grp; char* smg = smem + grp * GRP_LDS; \
  const int vb = (bid & 7) * (nb >> 3) + (bid >> 3); (void)lane; (void)w; (void)bid2; (void)smg; (void)vb
#define GSYNC() do { for (int rs_ = 0; rs_ < REP_SYNC; ++rs_) xcd_barrier(xb); } while (0)


#define XB_TMO      128
#define XB_XCNT(j)  (256  + 64 * (j))
#define XB_XSUB(j)  (1280 + 64 * (j))
#define XB_XGEN(j)  (2304 + 64 * (j))
#define XB_TOP      3328
#define XB_TOPGEN   3392
#define XCD_BAR_WORDS 3456
#define XB_SPIN_CAP (1u << 21)
#define LAS __attribute__((address_space(3)))
DI unsigned xb_ld(unsigned* p)              { return __hip_atomic_load(p, __ATOMIC_RELAXED, __HIP_MEMORY_SCOPE_AGENT); }
DI unsigned xb_add(unsigned* p, unsigned v) { return __hip_atomic_fetch_add(p, v, __ATOMIC_RELAXED, __HIP_MEMORY_SCOPE_AGENT); }
DI unsigned xb_xcc_id() { return (unsigned)__builtin_amdgcn_s_getreg((3 << 11) | 20) & 0xFu; }
#define XB_SPIN(cond, bar) do { unsigned _sp = 0; while (cond) { __builtin_amdgcn_s_sleep(1); \
    if ((++_sp & 255u) == 0u) { if (xb_ld(&(bar)[XB_TMO])) break; if (_sp > XB_SPIN_CAP) { atomicAdd(&(bar)[XB_TMO], 1u); break; } } } } while (0)
struct XcdBarrier { unsigned* bar; unsigned x; volatile LAS unsigned* st; };
DI XcdBarrier xcd_barrier_post(unsigned* bar, volatile LAS unsigned* st) {
  XcdBarrier b; b.bar = bar; b.x = xb_xcc_id(); b.st = st;
  if (threadIdx.x == 0) { const unsigned rank = xb_add(&bar[XB_XCNT(b.x)], 1u); st[2] = rank; }
  return b;
}
DI void xcd_barrier_complete(unsigned* bar, unsigned x, unsigned& nloc, unsigned& nx) {
  const unsigned G = gridDim.x * gridDim.y * gridDim.z;
  unsigned sum, cnt, mine, sp = 0u;
  for (;;) {
    sum = 0u; cnt = 0u; mine = 0u;
#pragma unroll
    for (unsigned j = 0; j < 16; ++j) { const unsigned c = xb_ld(&bar[XB_XCNT(j)]); sum += c; cnt += (c > 0u) ? 1u : 0u; mine = (j == x) ? c : mine; }
    if (sum == G) break;
    __builtin_amdgcn_s_sleep(1);
    if ((++sp & 255u) == 0u) { if (xb_ld(&bar[XB_TMO])) break; if (sp > XB_SPIN_CAP) { atomicAdd(&bar[XB_TMO], 1u); break; } }
  }
  nloc = mine > 0u ? mine : 1u; nx = cnt > 0u ? cnt : 1u;
}
DI void xcd_barrier(const XcdBarrier& b) {
  asm volatile("s_waitcnt vmcnt(0)" ::: "memory");
  __syncthreads();
  if (threadIdx.x == 0) {
    unsigned* bar = b.bar;
    __builtin_amdgcn_s_waitcnt(0);
    unsigned nloc = b.st[0], nx = b.st[1];
    if (nloc == 0u) { xcd_barrier_complete(bar, b.x, nloc, nx); b.st[0] = nloc; b.st[1] = nx; }
    const unsigned old = xb_add(&bar[XB_XSUB(b.x)], 1u);
    const unsigned gen = old / nloc;
    if (old + 1u == (gen + 1u) * nloc) {
      __builtin_amdgcn_fence(__ATOMIC_RELEASE, "agent");
      asm volatile("s_waitcnt vmcnt(0)" ::: "memory");
      const unsigned og = xb_add(&bar[XB_TOP], 1u);
      const unsigned tg = og / nx;
      if (og + 1u == (tg + 1u) * nx) xb_add(&bar[XB_TOPGEN], 1u);
      else XB_SPIN(xb_ld(&bar[XB_TOPGEN]) == tg, bar);
      __builtin_amdgcn_fence(__ATOMIC_ACQUIRE, "agent");
      xb_add(&bar[XB_XGEN(b.x)], 1u);
      asm volatile("s_waitcnt vmcnt(0)" ::: "memory");
    } else {
      XB_SPIN(xb_ld(&bar[XB_XGEN(b.x)]) == gen, bar);
      __builtin_amdgcn_fence(__ATOMIC_ACQUIRE, "agent");
      asm volatile("s_waitcnt vmcnt(0)" ::: "memory");
    }
  }
  __syncthreads();
}
constexpr size_t O_BAR = O_MISC + 16384;
constexpr size_t O_ROPE = O_MISC + 65536;

struct Params {
  const float* x_prompt; const float* x_sample;
  const float* ffn1_norm; const float* ffn1_w_in; const float* ffn1_w_out; const float* mix_norm; const float* w_in;
  const float* hy_conv_w; const float* hy_conv_b; const float* hy_w1; const float* hy_b1; const float* hy_w2; const float* hy_b2;
  const float* hy_w3; const float* hy_freq; const float* hy_skip;
  const float* gqa_q_norm; const float* gqa_k_norm; const float* diff_lambda; const float* diff_subln; const float* rel_bias;
  const float* w_branch; const float* w_out; const float* ffn2_norm; const float* ffn2_w_in; const float* ffn2_w_out; const float* final_norm;
  float* out; char* ws;
};

DI unsigned pack2(float a, float b) { f2_t v = {a, b}; bf2_t r = __builtin_convertvector(v, bf2_t); return __builtin_bit_cast(unsigned, r); }
DI u16 f2bf(float a) { return (u16)(pack2(a, 0.f) & 0xffffu); }
DI float bf2f(u16 v) { return __uint_as_float(((unsigned)v) << 16); }
DI float bflo(unsigned v) { return __uint_as_float(v << 16); }
DI float bfhi(unsigned v) { return __uint_as_float(v & 0xffff0000u); }
DI int otid() { int t = threadIdx.x; asm volatile("" : "+v"(t)); return t; }
DI float xhalf_max(float x) {
  typedef unsigned u2_t __attribute__((ext_vector_type(2)));
  const u2_t rr = __builtin_amdgcn_permlane32_swap(__float_as_uint(x), __float_as_uint(x), false, false);
  return fmaxf(__uint_as_float(rr[0]), __uint_as_float(rr[1]));
}
DI float xhalf_sum(float x) {
  typedef unsigned u2_t __attribute__((ext_vector_type(2)));
  const u2_t rr = __builtin_amdgcn_permlane32_swap(__float_as_uint(x), __float_as_uint(x), false, false);
  return __uint_as_float(rr[0]) + __uint_as_float(rr[1]);
}
DI int crow(int reg, int h) { return (reg & 3) + 8 * (reg >> 2) + 4 * h; }
DI float wave_sum(float v) {
  v += __shfl_xor(v, 32); v += __shfl_xor(v, 16); v += __shfl_xor(v, 8); v += __shfl_xor(v, 4); v += __shfl_xor(v, 2); v += __shfl_xor(v, 1);
  return v;
}
DI float half_sum(float v) {
  v += __shfl_xor(v, 16); v += __shfl_xor(v, 8); v += __shfl_xor(v, 4); v += __shfl_xor(v, 2); v += __shfl_xor(v, 1);
  return v;
}

DI void convT_tile(const float* __restrict__ src, int K, int N, u16* __restrict__ dst, int kt, int nt, int perm_half, char* smem) {
  float* t = (float*)smem;
  const int tid = otid() & 255;
  __syncthreads();
  {
    const int col = tid & 63, r0 = tid >> 6;
#pragma unroll
    for (int i = 0; i < 16; ++i) { int row = r0 + 4 * i; t[row * 65 + col] = src[(size_t)(kt * 64 + row) * N + nt * 64 + col]; }
  }
  __syncthreads();
  {
    const int nl = tid >> 2, kq = tid & 3;
    int n = nt * 64 + nl;
    if (perm_half > 0) { if (n < perm_half) n = (n >> 7) * 256 + (n & 127); else { int j = n - perm_half; n = (j >> 7) * 256 + 128 + (j & 127); } }
    u32x4 o0, o1;
#pragma unroll
    for (int i = 0; i < 4; ++i) {
      o0[i] = pack2(t[(kq * 16 + 2 * i) * 65 + nl], t[(kq * 16 + 2 * i + 1) * 65 + nl]);
      o1[i] = pack2(t[(kq * 16 + 8 + 2 * i) * 65 + nl], t[(kq * 16 + 8 + 2 * i + 1) * 65 + nl]);
    }
    u16* d = dst + (size_t)n * K + kt * 64 + kq * 16;
    *(u32x4*)d = o0; *(u32x4*)(d + 8) = o1;
  }
}

DI void filter_item(const Params& P, int layer, int L, int tb, u16* __restrict__ G, char* smem) {
  float* h1 = (float*)smem;
  float* h2 = h1 + 64 * 65;
  const int tid = otid() & 255, lane = tid & 63, w = __builtin_amdgcn_readfirstlane(tid >> 6);
  const float* w1 = P.hy_w1 + layer * 33 * 64; const float* b1 = P.hy_b1 + layer * 64;
  const float* w2 = P.hy_w2 + layer * 64 * 64; const float* b2 = P.hy_b2 + layer * 64;
  const float* w3 = P.hy_w3 + layer * 64 * 1024; const float* fr = P.hy_freq + layer * 64;
  const int t = tb * 64 + lane;
  const float tl = (float)t / (float)(L - 1);
  __syncthreads();
  {
    float a[16];
#pragma unroll
    for (int u = 0; u < 16; ++u) a[u] = b1[w * 16 + u] + tl * w1[w * 16 + u];
    const float base = (float)(2.0 * 3.14159265358979323846 / (double)L) * (float)t;
    for (int b = 0; b < 16; ++b) {
      const float band = 1e-4f + (float)b * ((15.0f - 1e-4f) / 15.0f);
      const float ang = base * band;
      const float cs = cosf(ang), sn = -sinf(ang);
#pragma unroll
      for (int u = 0; u < 16; ++u) a[u] += cs * w1[(1 + b) * 64 + w * 16 + u] + sn * w1[(17 + b) * 64 + w * 16 + u];
    }
#pragma unroll
    for (int u = 0; u < 16; ++u) h1[lane * 65 + w * 16 + u] = sinf(fr[w * 16 + u] * a[u]);
  }
  __syncthreads();
  {
    float a[16];
#pragma unroll
    for (int u = 0; u < 16; ++u) a[u] = b2[w * 16 + u];
    for (int k = 0; k < 64; ++k) {
      const float hv = h1[lane * 65 + k];
#pragma unroll
      for (int u = 0; u < 16; ++u) a[u] += hv * w2[k * 64 + w * 16 + u];
    }
#pragma unroll
    for (int u = 0; u < 16; ++u) h2[lane * 65 + w * 16 + u] = sinf(fr[w * 16 + u] * a[u]);
  }
  __syncthreads();
  const float min_decay = -3.0701134573253946f, max_decay = -15.350567286626973f;
  for (int og = 0; og < 64; ++og) {
    const int o = w * 256 + og * 4;
    float a0 = 0.f, a1 = 0.f, a2 = 0.f, a3 = 0.f;
#pragma unroll 4
    for (int k = 0; k < 64; ++k) {
      const float hv = h2[lane * 65 + k];
      const f32x4 wv = *(const f32x4*)(w3 + k * 1024 + o);
      a0 += hv * wv[0]; a1 += hv * wv[1]; a2 += hv * wv[2]; a3 += hv * wv[3];
    }
    float av[4] = {a0, a1, a2, a3};
#pragma unroll
    for (int q = 0; q < 4; ++q) {
      const int oo = o + q; const int ch = oo & 511;
      const float delta = min_decay + (float)ch * ((max_decay - min_decay) / 511.0f);
      const float val = av[q] * expf(-tl * fabsf(delta));
      u16* Gc = G + (size_t)ch * (2 * L);
      if (oo < 512) Gc[L - t] = f2bf(val);
      else { if (t >= 1) Gc[L + t] = f2bf(val); else Gc[0] = 0; }
    }
  }
}

DI void norm_row_bf16(const float* __restrict__ x, const float* __restrict__ g, u16* __restrict__ out, int lane) {
  f32x4 v[4]; float ss = 0.f;
#pragma unroll
  for (int i = 0; i < 4; ++i) { v[i] = *(const f32x4*)(x + lane * 4 + 256 * i); ss += v[i][0] * v[i][0] + v[i][1] * v[i][1] + v[i][2] * v[i][2] + v[i][3] * v[i][3]; }
  ss = wave_sum(ss);
  const float rs = rsqrtf(ss * (1.0f / 1024.0f) + 1e-6f);
#pragma unroll
  for (int i = 0; i < 4; ++i) {
    const f32x4 gg = *(const f32x4*)(g + lane * 4 + 256 * i);
    u32x2 o; o[0] = pack2(v[i][0] * rs * gg[0], v[i][1] * rs * gg[1]); o[1] = pack2(v[i][2] * rs * gg[2], v[i][3] * rs * gg[3]);
    *(u32x2*)(out + lane * 4 + 256 * i) = o;
  }
}
DI void norm_row_f32_inplace(float* __restrict__ x, const float* __restrict__ g, int lane) {
  f32x4 v[4]; float ss = 0.f;
#pragma unroll
  for (int i = 0; i < 4; ++i) { v[i] = *(const f32x4*)(x + lane * 4 + 256 * i); ss += v[i][0] * v[i][0] + v[i][1] * v[i][1] + v[i][2] * v[i][2] + v[i][3] * v[i][3]; }
  ss = wave_sum(ss);
  const float rs = rsqrtf(ss * (1.0f / 1024.0f) + 1e-6f);
#pragma unroll
  for (int i = 0; i < 4; ++i) {
    const f32x4 gg = *(const f32x4*)(g + lane * 4 + 256 * i);
    f32x4 o; o[0] = v[i][0] * rs * gg[0]; o[1] = v[i][1] * rs * gg[1]; o[2] = v[i][2] * rs * gg[2]; o[3] = v[i][3] * rs * gg[3];
    *(f32x4*)(x + lane * 4 + 256 * i) = o;
  }
}

namespace pg8 {
#define PG8_LAS __attribute__((address_space(3)))
typedef unsigned short bf16_t;
typedef short bf16x8 __attribute__((ext_vector_type(8)));
typedef float f32x4 __attribute__((ext_vector_type(4)));
typedef unsigned u32x4 __attribute__((ext_vector_type(4)));
constexpr int BM = 256, BK = 64, HALF = 128, HTB = HALF * BK * 2  , STAGE_BYTES = 8 * HTB, NXCD = 8, WGM = 8;

__host__ __device__ __forceinline__ int lds_byte(int r, int c) { const int st = (r >> 4) * 2 + (c >> 5), rr = r & 15, cc = c & 31, ob = rr * 64 + cc * 2; return st * 1024 + (ob ^ (((ob >> 9) & 1) << 5)); }
__host__ __device__ __forceinline__ void stage_rc(int b, int& R, int& C) { const int st = b / 1024, sb = b % 1024, swz = sb ^ (((sb >> 9) & 1) << 5); R = (st >> 1) * 16 + swz / 64; C = (st & 1) * 32 + (swz % 64) / 2; }
__host__ __device__ __forceinline__ int perm32(int rho) { const int n = rho >> 4, i = rho & 15; return 8 * (i >> 2) + 4 * n + (i & 3); }

struct Unit { int pm, pn; };
struct Gemm { const bf16_t* A; const bf16_t* Bt; int M, N, K; };

struct StaticOrder {
    int nM, nN, nwg, G, c;
    __host__ __device__ void init(int M, int N, int G_, int c_) { nM = M / BM; nN = N / BM; nwg = nM * nN; G = G_; c = c_; }
    __host__ __device__ bool next(int i, Unit& u) const {
        const long L = (long)i * G + c; if (L >= nwg) return false;
        int wgid = (int)L; { const int q = nwg / NXCD, r = nwg % NXCD, xcd = wgid % NXCD, off = wgid / NXCD; wgid = (xcd < r ? xcd * (q + 1) : r * (q + 1) + (xcd - r) * q) + off; }
        const int nig = WGM * nN, gid = wgid / nig, fm = gid * WGM, gsz = (nM - fm) < WGM ? (nM - fm) : WGM;
        u.pm = fm + ((wgid % nig) % gsz); u.pn = (wgid % nig) / gsz; return true;
    }
    __device__ __forceinline__ void a_ready(const Unit&) const {}
    __device__ __forceinline__ void done(const Unit&) const {}
};

template <class Epi, class Sched, bool STAMP = false>
__device__ __forceinline__ void gemm_phase(PG8_LAS unsigned char* lds, const Gemm g, const Sched& S, const Epi& E, unsigned long long* stamps) {
    const int tid = otid(), wid = __builtin_amdgcn_readfirstlane(tid >> 6), lane = tid & 63, wr = wid >> 2, wc = wid & 3, fr = lane & 15, fq = lane >> 4;
    const int K = g.K, nt = K / BK;
    int ts_lo = 0, ts_hi = 0, nts = 0; const unsigned long long rt_entry = STAMP ? (unsigned long long)wall_clock64() : 0ull;
#define PG8_STAMP() do { if (STAMP && wid == 0 && nts < 64) { const unsigned long long _c = (unsigned long long)clock64(); \
        ts_lo = (lane == nts) ? (int)(unsigned)_c : ts_lo; ts_hi = (lane == nts) ? (int)(unsigned)(_c >> 32) : ts_hi; ++nts; } } while (0)
    PG8_STAMP();
    unsigned voffA[2], voffB[2];
#pragma unroll
    for (int i = 0; i < 2; ++i) { int R, C; stage_rc(tid * 16 + i * 8192, R, C); const int Rb = E.perm ? ((R & ~31) + perm32(R & 31)) : R;
        voffA[i] = (unsigned)(R * K + C) * 2u; voffB[i] = (unsigned)(Rb * K + C) * 2u; }
    const size_t kstep = (size_t)(BK * 2);
    const size_t hstep = (size_t)HALF * K * 2;
    const size_t tstep = 2 * hstep;
    const unsigned ldsw = (unsigned)wid * 1024u;
    const int aoff = lds_byte(wr * 64 + fr, fq * 8), boff = lds_byte(wc * 32 + fr, fq * 8);
#define PG8_SA(b, h) (((b) * 2 + (h)) * HTB)
#define PG8_SB(b, h) ((4 + (b) * 2 + (h)) * HTB)
#define PG8_STAGE(bufoff, gbase, voff) do { _Pragma("unroll") for (int _i = 0; _i < 2; ++_i) \
        __builtin_amdgcn_global_load_lds((const unsigned*)((const char*)(gbase) + (voff)[_i]), (PG8_LAS unsigned*)(lds + (bufoff) + ldsw + _i * 8192), 16, 0, 0); } while (0)
#define PG8_LDA(dst, b, h) do { _Pragma("unroll") for (int m = 0; m < 4; ++m) _Pragma("unroll") for (int k = 0; k < 2; ++k) dst[m][k] = *(const PG8_LAS bf16x8*)(lds + PG8_SA(b, h) + aoff + m * 2048 + k * 1024); } while (0)
#define PG8_LDB(dst, b, h) do { _Pragma("unroll") for (int n = 0; n < 2; ++n) _Pragma("unroll") for (int k = 0; k < 2; ++k) dst[n][k] = *(const PG8_LAS bf16x8*)(lds + PG8_SB(b, h) + boff + n * 2048 + k * 1024); } while (0)
#define PG8_MMA(ai, bj, At, Bt) do { __builtin_amdgcn_s_setprio(1); _Pragma("unroll") for (int m = 0; m < 4; ++m) _Pragma("unroll") for (int n = 0; n < 2; ++n) _Pragma("unroll") for (int k = 0; k < 2; ++k) \
        acc[ai][bj][m][n] = __builtin_amdgcn_mfma_f32_16x16x32_bf16(Bt[n][k], At[m][k], acc[ai][bj][m][n], 0, 0, 0); __builtin_amdgcn_s_setprio(0); } while (0)
#define PG8_WAIT_V(n) asm volatile("s_waitcnt vmcnt(" #n ")" ::: "memory")
#define PG8_WAIT_L(n) asm volatile("s_waitcnt lgkmcnt(" #n ")" ::: "memory")
#define PG8_BAR __builtin_amdgcn_s_barrier()
#define PG8_SCHED __builtin_amdgcn_sched_barrier(0)
    Unit cur, nxt; int ui = 0;
    if (!S.next(0, cur)) return;
    f32x4 acc[2][2][4][2];
#pragma unroll
    for (int a = 0; a < 2; ++a)
#pragma unroll
        for (int b = 0; b < 2; ++b)
#pragma unroll
            for (int m = 0; m < 4; ++m)
#pragma unroll
                for (int n = 0; n < 2; ++n) acc[a][b][m][n] = (f32x4){0.f, 0.f, 0.f, 0.f};
    bf16x8 At[4][2], B0[2][2], B1[2][2];
    const char* cA = (const char*)g.A + (size_t)cur.pm * tstep; const char* cB = (const char*)g.Bt + (size_t)cur.pn * tstep;
    S.a_ready(cur);
    PG8_STAGE(PG8_SB(0, 0), cB, voffB); PG8_STAGE(PG8_SA(0, 0), cA, voffA); PG8_STAGE(PG8_SB(0, 1), cB + hstep, voffB); PG8_STAGE(PG8_SA(0, 1), cA + hstep, voffA);
    if (wr == 1) PG8_BAR;
    PG8_WAIT_V(4); PG8_BAR;
    PG8_STAGE(PG8_SB(1, 0), cB + kstep, voffB); PG8_STAGE(PG8_SA(1, 0), cA + kstep, voffA); PG8_STAGE(PG8_SB(1, 1), cB + hstep + kstep, voffB);
    PG8_WAIT_V(6); PG8_BAR;
    PG8_STAMP();
    for (;;) {
        const bool has_next = S.next(ui + 1, nxt);
        const char* nA = has_next ? (const char*)g.A + (size_t)nxt.pm * tstep : cA; const char* nB = has_next ? (const char*)g.Bt + (size_t)nxt.pn * tstep : cB;
        for (int t = 0; t < nt; t += 2) {
            const bool last = (t == nt - 2);
            const char* a1 = cA + (size_t)(t + 1) * kstep;
            const char* a2 = last ? nA : cA + (size_t)(t + 2) * kstep; const char* b2 = last ? nB : cB + (size_t)(t + 2) * kstep;
            const char* a3 = a2 + kstep; const char* b3 = b2 + kstep;
            if (last && has_next) S.a_ready(nxt);
            PG8_LDB(B0, 0, 0); PG8_SCHED; PG8_LDA(At, 0, 0); PG8_STAGE(PG8_SA(1, 1), a1 + hstep, voffA);
            PG8_WAIT_L(8); PG8_BAR; PG8_WAIT_L(0); PG8_MMA(0, 0, At, B0); PG8_BAR; PG8_SCHED;
            PG8_LDB(B1, 0, 1); PG8_STAGE(PG8_SB(0, 0), b2, voffB);
            PG8_BAR; PG8_WAIT_L(0); PG8_MMA(0, 1, At, B1); PG8_BAR;
            PG8_LDA(At, 0, 1); PG8_STAGE(PG8_SA(0, 0), a2, voffA);
            PG8_BAR; PG8_WAIT_L(0); PG8_MMA(1, 0, At, B0); PG8_BAR; PG8_SCHED;
            PG8_STAGE(PG8_SB(0, 1), b2 + hstep, voffB);
            PG8_WAIT_V(6); PG8_BAR; PG8_MMA(1, 1, At, B1); PG8_BAR;
            PG8_LDB(B0, 1, 0); PG8_SCHED; PG8_LDA(At, 1, 0); PG8_STAGE(PG8_SA(0, 1), a2 + hstep, voffA);
            PG8_WAIT_L(8); PG8_BAR; PG8_WAIT_L(0); PG8_MMA(0, 0, At, B0); PG8_BAR; PG8_SCHED;
            PG8_LDB(B1, 1, 1); PG8_STAGE(PG8_SB(1, 0), b3, voffB);
            PG8_BAR; PG8_WAIT_L(0); PG8_MMA(0, 1, At, B1); PG8_BAR;
            PG8_LDA(At, 1, 1); PG8_STAGE(PG8_SA(1, 0), a3, voffA);
            PG8_BAR; PG8_WAIT_L(0); PG8_MMA(1, 0, At, B0); PG8_BAR; PG8_SCHED;
            PG8_STAGE(PG8_SB(1, 1), b3 + hstep, voffB);
            PG8_WAIT_V(6); PG8_BAR; PG8_MMA(1, 1, At, B1); PG8_BAR;
        }
        PG8_STAMP();
        if constexpr (!Epi::AFTER_DRAIN) { E(acc, cur, wr, wc, fr, fq); S.done(cur); }
        PG8_STAMP();
        if (!has_next) break;
#pragma unroll
        for (int a = 0; a < 2; ++a)
#pragma unroll
            for (int b = 0; b < 2; ++b)
#pragma unroll
                for (int m = 0; m < 4; ++m)
#pragma unroll
                    for (int n = 0; n < 2; ++n) acc[a][b][m][n] = (f32x4){0.f, 0.f, 0.f, 0.f};
        cur = nxt; cA = nA; cB = nB; ++ui;
    }
    PG8_WAIT_V(0);
    if (wr == 0) PG8_BAR;
    PG8_BAR;
    if constexpr (Epi::AFTER_DRAIN) { E.fused(acc, cur, wr, wc, fr, fq, lds, wid, lane); S.done(cur); }
    PG8_STAMP();
    if (STAMP && wid == 0) { stamps[lane] = lane < nts ? (((unsigned long long)(unsigned)ts_hi << 32) | (unsigned)ts_lo) : 0ull;
        if (lane == 62) stamps[62] = rt_entry; if (lane == 63) stamps[63] = (unsigned long long)wall_clock64(); }
#undef PG8_STAMP
#undef PG8_SA
#undef PG8_SB
#undef PG8_STAGE
#undef PG8_LDA
#undef PG8_LDB
#undef PG8_MMA
#undef PG8_WAIT_V
#undef PG8_WAIT_L
#undef PG8_BAR
#undef PG8_SCHED
}
}

enum { EPI_SWIGLU = 0, EPI_RESID = 1, EPI_PROJ = 2, EPI_MERGE = 3 };
struct AnyOrder : pg8::StaticOrder {
  bool merge3;
  __device__ __forceinline__ bool next(int i, pg8::Unit& u) const {
    if (!merge3) return pg8::StaticOrder::next(i, u);
    const int ti = i / 3, br = i - ti * 3; pg8::Unit t;
    if (!pg8::StaticOrder::next(ti, t)) return false;
    u.pm = t.pm + 64 * br; u.pn = t.pn + 4 * br; return true;
  }
};
struct EpiAny {
  static constexpr bool AFTER_DRAIN = false;
  int mode; bool perm;
  u16* O; int ldo; const float* xin; float* xout; float scale; const u16* gate; float* macc; int br;
  DI void operator()(const pg8::f32x4 (&acc)[2][2][4][2], const pg8::Unit& u, int wr, int wc, int fr, int fq) const {
    const int row0 = (u.pm & 63) * 256 + wr * 64 + fr;
    if (mode == EPI_SWIGLU) {
      const int col0 = u.pn * 128 + wc * 32 + 8 * fq;
#pragma unroll
      for (int ai = 0; ai < 2; ++ai)
#pragma unroll
        for (int m = 0; m < 4; ++m) {
          float v[8];
#pragma unroll
          for (int n = 0; n < 2; ++n)
#pragma unroll
            for (int e = 0; e < 4; ++e) { const float gv = acc[ai][0][m][n][e], uv = acc[ai][1][m][n][e]; v[4 * n + e] = gv * __builtin_amdgcn_rcpf(1.0f + __builtin_amdgcn_exp2f(-LOG2E * gv)) * uv; }
          u32x4 o; o[0] = pack2(v[0], v[1]); o[1] = pack2(v[2], v[3]); o[2] = pack2(v[4], v[5]); o[3] = pack2(v[6], v[7]);
          *(u32x4*)(O + (size_t)(row0 + ai * 128 + m * 16) * ldo + col0) = o;
        }
    } else if (mode == EPI_PROJ) {
      const int col0 = u.pn * 256 + wc * 32 + 8 * fq;
      const bool sg = (u.pn * 256 >= OFF_GATE);
#pragma unroll
      for (int ai = 0; ai < 2; ++ai)
#pragma unroll
        for (int m = 0; m < 4; ++m)
#pragma unroll
          for (int bj = 0; bj < 2; ++bj) {
            float v[8];
#pragma unroll
            for (int n = 0; n < 2; ++n)
#pragma unroll
              for (int e = 0; e < 4; ++e) { float t = acc[ai][bj][m][n][e]; if (sg) t = __builtin_amdgcn_rcpf(1.0f + __builtin_amdgcn_exp2f(-LOG2E * t)); v[4 * n + e] = t; }
            u32x4 o; o[0] = pack2(v[0], v[1]); o[1] = pack2(v[2], v[3]); o[2] = pack2(v[4], v[5]); o[3] = pack2(v[6], v[7]);
            *(u32x4*)(O + (size_t)(row0 + ai * 128 + m * 16) * INC + col0 + bj * 128) = o;
          }
    } else if (mode == EPI_RESID) {
      const int col0 = u.pn * 256 + wc * 32 + 4 * fq;
#pragma unroll
      for (int ai = 0; ai < 2; ++ai)
#pragma unroll
        for (int m = 0; m < 4; ++m)
#pragma unroll
          for (int bj = 0; bj < 2; ++bj)
#pragma unroll
            for (int n = 0; n < 2; ++n) {
              const size_t idx = (size_t)(row0 + ai * 128 + m * 16) * DM + col0 + bj * 128 + n * 16;
              f32x4 xv = *(const f32x4*)(xin + idx);
#pragma unroll
              for (int e = 0; e < 4; ++e) xv[e] += scale * acc[ai][bj][m][n][e];
              *(f32x4*)(xout + idx) = xv;
            }
    } else {
      const int col0 = (u.pn & 3) * 256 + wc * 32 + 4 * fq; const int br = u.pm >> 6;
#pragma unroll
      for (int ai = 0; ai < 2; ++ai)
#pragma unroll
        for (int m = 0; m < 4; ++m)
#pragma unroll
          for (int bj = 0; bj < 2; ++bj)
#pragma unroll
            for (int n = 0; n < 2; ++n) {
              const int row = row0 + ai * 128 + m * 16, col = col0 + bj * 128 + n * 16;
              const u32x2 gt = *(const u32x2*)(gate + (size_t)row * INC + OFF_GATE + br * DM + col);
              f32x4 v;
              v[0] = bflo(gt[0]) * acc[ai][bj][m][n][0]; v[1] = bfhi(gt[0]) * acc[ai][bj][m][n][1];
              v[2] = bflo(gt[1]) * acc[ai][bj][m][n][2]; v[3] = bfhi(gt[1]) * acc[ai][bj][m][n][3];
              const size_t idx = (size_t)row * DM + col;
              if (br > 0) { const f32x4 pv = *(const f32x4*)(macc + idx); v[0] += pv[0]; v[1] += pv[1]; v[2] += pv[2]; v[3] += pv[3]; }
              if (br < 2) *(f32x4*)(macc + idx) = v;
              else { u32x2 o; o[0] = pack2(v[0], v[1]); o[1] = pack2(v[2], v[3]); *(u32x2*)(outb_() + idx) = o; }
            }
    }
  }
  DI u16* outb_() const { return O; }
};

DI void qk_prep_item(const Params& P, int layer, u16* __restrict__ p, int L, int it, const float* __restrict__ rope) {
  const int tid = otid() & 255, lane = tid & 63, w = __builtin_amdgcn_readfirstlane(tid >> 6);
  const int u = it * 8 + w * 2 + (lane >> 5);
  const int tok = u / 10, hd = u - tok * 10;
  const int i = lane & 31;
  const int col0 = (hd < 8) ? (OFF_GQ + hd * 64) : (OFF_GK + (hd - 8) * 64);
  const float* gn = (hd < 8) ? (P.gqa_q_norm + layer * 64) : (P.gqa_k_norm + layer * 64);
  unsigned* ptr = (unsigned*)(p + (size_t)tok * INC + col0) + i;
  const unsigned v = *ptr;
  float a = bflo(v), b = bfhi(v);
  const float ss = half_sum(a * a + b * b);
  const float rs = rsqrtf(ss * (1.0f / 64.0f) + 1e-6f);
  a = a * rs * gn[2 * i]; b = b * rs * gn[2 * i + 1];
  const int tl = tok % L;
  const int jj = i & 15;
  const float* rt = rope + ((i < 16) ? ((tl >> 6) * 16 + jj) : (4096 + (tl & 63) * 16 + jj)) * 2;
  const float c = rt[0], s = rt[1];
  *ptr = pack2(a * c - b * s, a * s + b * c);
}

DI void transpose_item(const Params& P, int layer, const u16* __restrict__ p, int L, int kind, int ct, int tt, u16* __restrict__ dst, char* smem) {
  u16* tile = (u16*)smem;
  const int tid = otid() & 255;
  const int t0 = tt * 64;
  const int seq = t0 / L, tl0 = t0 - seq * L;
  const int C = (kind == 0) ? 128 : 512;
  __syncthreads();
  {
    const int col = tid & 63, r0 = tid >> 6;
    const int cidx = ct * 64 + col;
    if (kind < 2) {
      const int off = (kind == 0 ? OFF_GV : OFF_DV) + cidx;
#pragma unroll
      for (int i = 0; i < 16; ++i) { const int row = r0 + 4 * i; tile[col * 72 + row] = p[(size_t)(t0 + row) * INC + off]; }
    } else {
      const float* cw = P.hy_conv_w + layer * 3 * 1536; const float* cb = P.hy_conv_b + layer * 1536;
      const int c1 = 512 + cidx, c2 = 1024 + cidx;
      const float w10 = cw[c1], w11 = cw[1536 + c1], w12 = cw[3072 + c1], b1 = cb[c1];
      const float w20 = cw[c2], w21 = cw[1536 + c2], w22 = cw[3072 + c2], b2 = cb[c2];
#pragma unroll
      for (int i = 0; i < 16; ++i) {
        const int row = r0 + 4 * i; const int tl = tl0 + row;
        const u16* pr = p + (size_t)(t0 + row) * INC;
        const float xm1 = (tl > 0) ? bf2f(pr[c1 - INC]) : 0.f, x0 = bf2f(pr[c1]), xp1 = (tl < L - 1) ? bf2f(pr[c1 + INC]) : 0.f;
        const float vm1 = (tl > 0) ? bf2f(pr[c2 - INC]) : 0.f, v0 = bf2f(pr[c2]), vp1 = (tl < L - 1) ? bf2f(pr[c2 + INC]) : 0.f;
        const float x1c = xm1 * w10 + x0 * w11 + xp1 * w12 + b1;
        const float vc = vm1 * w20 + v0 * w21 + vp1 * w22 + b2;
        tile[col * 72 + row] = f2bf(vc * x1c);
      }
    }
  }
  __syncthreads();
  {
    const int c = tid >> 2, q = tid & 3;
    const u32x4 a = *(const u32x4*)(tile + c * 72 + q * 16), b = *(const u32x4*)(tile + c * 72 + q * 16 + 8);
    u16* d = dst + ((size_t)seq * C + ct * 64 + c) * L + tl0 + q * 16;
    *(u32x4*)d = a; *(u32x4*)(d + 8) = b;
  }
}

DI int kperm(int rho) { return (rho & ~0xC) | ((rho & 4) << 1) | ((rho & 8) >> 1); }
template <int DV, bool BIAS, bool SWAP>
DI void attn_tile(const u16* __restrict__ Qp, const u16* __restrict__ Kp, const u16* __restrict__ VTp, int L,
                  u16* __restrict__ Op, int ldo, int q0, const float* __restrict__ btab, char* smem) {
  constexpr int NDT = DV / 32;
  constexpr int VCH = DV / 64;
  constexpr int KS_SZ = 64 * 64, VS_SZ = DV * 64;
  constexpr int NL = 1 + VCH;
  u16* Ks = (u16*)smem;
  u16* Vs = Ks + 4 * KS_SZ;
  float* bt = (float*)(Vs + 3 * VS_SZ);
  const int tid = otid(), lane = tid & 63, w = __builtin_amdgcn_readfirstlane(tid >> 6), r = lane & 31, h = lane >> 5;
  const float sc = 0.125f * LOG2E;
  __syncthreads();
  if (BIAS) { for (int i = tid; i < 257; i += 512) bt[i] = btab[i]; }
  bf16x8 qf[4];
  {
    const u16* qrow = Qp + (size_t)(q0 + 32 * w + r) * INC + 8 * h;
#pragma unroll
    for (int s = 0; s < 4; ++s) qf[s] = *(const bf16x8*)(qrow + 16 * s);
  }
  const int qpos = q0 + 32 * w + r;
  f32x16 O[NDT];
#pragma unroll
  for (int d = 0; d < NDT; ++d)
#pragma unroll
    for (int q = 0; q < 16; ++q) O[d][q] = 0.f;
  float m = -INFINITY, l = 0.f;
  const int lrow = tid >> 3, lsw = (tid & 7) ^ ((tid >> 4) & 7);
  const u16* Kg0 = Kp + (size_t)kperm(lrow) * INC + lsw * 8;
  const u16* Vg = VTp + (size_t)lrow * L + lsw * 8;
  const int ksw = (r >> 1) & 7;
  const int nkb = L >> 6;
#define ATT_LOADK(tile, bufp) do { const int t__ = ((tile) < nkb) ? (tile) : nkb - 1; \
    __builtin_amdgcn_global_load_lds((const unsigned*)(Kg0 + ((size_t)t__ * 64) * INC), (unsigned*)((char*)(bufp) + tid * 16), 16, 0, 0); } while (0)
#define ATT_LOADV(tile, bufp) do { const int t__ = ((tile) < nkb) ? (tile) : nkb - 1; _Pragma("unroll") for (int i_ = 0; i_ < VCH; ++i_) \
    __builtin_amdgcn_global_load_lds((const unsigned*)(Vg + (size_t)(64 * i_) * L + (size_t)t__ * 64), (unsigned*)((char*)(bufp) + tid * 16 + i_ * 8192), 16, 0, 0); } while (0)
  f32x16 Sc[2];
  auto qk = [&](const u16* Kb) __attribute__((always_inline)) {
    bf16x8 kf[2][4];
#pragma unroll
    for (int kt = 0; kt < 2; ++kt)
#pragma unroll
      for (int s = 0; s < 4; ++s) kf[kt][s] = *(const bf16x8*)(Kb + (32 * kt + r) * 64 + (((2 * s + h) ^ ksw) << 3));
#pragma unroll
    for (int kt = 0; kt < 2; ++kt) {
#pragma unroll
      for (int q = 0; q < 16; ++q) Sc[kt][q] = 0.f;
#pragma unroll
      for (int s = 0; s < 4; ++s) Sc[kt] = MFMA(kf[kt][s], qf[s], Sc[kt]);
    }
    __builtin_amdgcn_sched_group_barrier(0x100, 8, 0);
    __builtin_amdgcn_sched_group_barrier(0x008, 8, 0);
  };
  bf16x8 pf[2][2];
  auto softmax = [&](int kb) __attribute__((always_inline)) {
    float cb = 0.f; bool near = false;
    if (BIAS) {
      const int kmin = kb * 64;
      near = !(kmin - (q0 + 255) >= 128 || q0 - (kmin + 63) >= 128);
      cb = (kmin > q0) ? bt[256] : bt[0];
      if (near) {
        const float isc = 1.0f / sc;
#pragma unroll
        for (int kt = 0; kt < 2; ++kt)
#pragma unroll
          for (int q = 0; q < 16; ++q) {
            int rel = kmin + 32 * kt + kperm(crow(q, h)) - qpos;
            rel = rel < -128 ? -128 : (rel > 128 ? 128 : rel);
            Sc[kt][q] += bt[rel + 128] * isc;
          }
        cb = 0.f;
      }
    }
    float mx = Sc[0][0];
#pragma unroll
    for (int kt = 0; kt < 2; ++kt)
#pragma unroll
      for (int q = 0; q < 16; ++q) mx = fmaxf(mx, Sc[kt][q]);
    mx = xhalf_max(mx);
    mx = __builtin_fmaf(mx, sc, cb);
    if (__any(mx > m + 6.0f)) {
      asm volatile("" ::: "memory");
      const float mn = fmaxf(m, mx);
      const float alpha = __builtin_amdgcn_exp2f(m - mn);
      m = mn; l *= alpha;
#pragma unroll
      for (int d = 0; d < NDT; ++d)
#pragma unroll
        for (int q = 0; q < 16; ++q) O[d][q] *= alpha;
    }
    const float nm = cb - m;
#pragma unroll
    for (int kt = 0; kt < 2; ++kt) {
#pragma unroll
      for (int q = 0; q < 16; ++q) {
        const float pv = __builtin_amdgcn_exp2f(__builtin_fmaf(Sc[kt][q], sc, nm));
        Sc[kt][q] = pv; l += pv;
      }
#pragma unroll
      for (int s = 0; s < 2; ++s) {
        u32x4 pk;
#pragma unroll
        for (int q = 0; q < 4; ++q) pk[q] = pack2(Sc[kt][8 * s + 2 * q], Sc[kt][8 * s + 2 * q + 1]);
        pf[kt][s] = __builtin_bit_cast(bf16x8, pk);
      }
    }
  };
  auto pv = [&](const u16* Vb) __attribute__((always_inline)) {
    bf16x8 vf[4][NDT];
#pragma unroll
    for (int ks = 0; ks < 4; ++ks)
#pragma unroll
      for (int d = 0; d < NDT; ++d) vf[ks][d] = *(const bf16x8*)(Vb + (32 * d + r) * 64 + (((2 * ks + h) ^ ksw) << 3));
#pragma unroll
    for (int ks = 0; ks < 4; ++ks)
#pragma unroll
      for (int d = 0; d < NDT; ++d) O[d] = MFMA(vf[ks][d], pf[ks >> 1][ks & 1], O[d]);
    __builtin_amdgcn_sched_group_barrier(0x100, 2 * NDT, 0);
    __builtin_amdgcn_sched_group_barrier(0x008, NDT, 0);
    __builtin_amdgcn_sched_group_barrier(0x100, NDT, 0);
    __builtin_amdgcn_sched_group_barrier(0x008, NDT, 0);
    __builtin_amdgcn_sched_group_barrier(0x100, NDT, 0);
    __builtin_amdgcn_sched_group_barrier(0x008, 2 * NDT, 0);
  };
  ATT_LOADK(0, Ks); ATT_LOADK(1, Ks + KS_SZ); ATT_LOADK(2, Ks + 2 * KS_SZ);
  ATT_LOADV(0, Vs); ATT_LOADV(1, Vs + VS_SZ);
  asm volatile("s_waitcnt vmcnt(0) lgkmcnt(0)\n\ts_barrier" ::: "memory");
  if (SWAP) qk(Ks);
  int r0 = 0, r2 = 2;
  for (int kb = 0; kb < nkb; ++kb) {
    ATT_LOADK(kb + 3, Ks + ((kb + 3) & 3) * KS_SZ);
    ATT_LOADV(kb + 2, Vs + r2 * VS_SZ);
    if (!SWAP) qk(Ks + (kb & 3) * KS_SZ);
    softmax(kb);
    pv(Vs + r0 * VS_SZ);
    if (SWAP) qk(Ks + ((kb + 1) & 3) * KS_SZ);
    asm volatile("s_waitcnt vmcnt(%0) lgkmcnt(0)\n\ts_barrier" :: "n"(NL) : "memory");
    r2 = r0; r0 = (r0 == 2) ? 0 : r0 + 1;
  }
  asm volatile("s_waitcnt vmcnt(0)" ::: "memory");
#undef ATT_LOADK
#undef ATT_LOADV
  l += __shfl_xor(l, 32);
  const float inv = __builtin_amdgcn_rcpf(l);
  int ldo2 = ldo; asm volatile("" : "+s"(ldo2));
  u16* orow = Op + (size_t)qpos * ldo2;
#pragma unroll
  for (int d = 0; d < NDT; ++d)
#pragma unroll
    for (int g4 = 0; g4 < 4; ++g4) {
      u32x2 o; o[0] = pack2(O[d][4 * g4] * inv, O[d][4 * g4 + 1] * inv); o[1] = pack2(O[d][4 * g4 + 2] * inv, O[d][4 * g4 + 3] * inv);
      *(u32x2*)(orow + 32 * d + 8 * g4 + 4 * h) = o;
    }
}

DI void attn_tile2(const u16* __restrict__ Qp, const u16* __restrict__ Kp, const u16* __restrict__ VTp, int L,
                   u16* __restrict__ Op, int ldo, int q0, char* smem) {
  constexpr int DV = 64, NDT = 2, VCH = 1, RT = 2;
  constexpr int KS_SZ = 64 * 64, VS_SZ = DV * 64;
  constexpr int NL = 1 + VCH;
  u16* Ks = (u16*)smem;
  u16* Vs = Ks + 4 * KS_SZ;
  const int tid = otid(), lane = tid & 63, w = __builtin_amdgcn_readfirstlane(tid >> 6), r = lane & 31, h = lane >> 5;
  const float sc = 0.125f * LOG2E;
  __syncthreads();
  bf16x8 qf[RT][4];
#pragma unroll
  for (int t = 0; t < RT; ++t) {
    const u16* qrow = Qp + (size_t)(q0 + 64 * w + 32 * t + r) * INC + 8 * h;
#pragma unroll
    for (int s = 0; s < 4; ++s) qf[t][s] = *(const bf16x8*)(qrow + 16 * s);
  }
  f32x16 O[RT][NDT];
#pragma unroll
  for (int t = 0; t < RT; ++t)
#pragma unroll
    for (int d = 0; d < NDT; ++d)
#pragma unroll
      for (int q = 0; q < 16; ++q) O[t][d][q] = 0.f;
  float m[RT], l[RT];
#pragma unroll
  for (int t = 0; t < RT; ++t) { m[t] = -INFINITY; l[t] = 0.f; }
  const int lrow = tid >> 3, lsw = (tid & 7) ^ ((tid >> 4) & 7);
  const u16* Kg0 = Kp + (size_t)kperm(lrow) * INC + lsw * 8;
  const u16* Vg = VTp + (size_t)lrow * L + lsw * 8;
  const int ksw = (r >> 1) & 7;
  const int nkb = L >> 6;
#define ATT_LOADK(tile, bufp) do { const int t__ = ((tile) < nkb) ? (tile) : nkb - 1; \
    __builtin_amdgcn_global_load_lds((const unsigned*)(Kg0 + ((size_t)t__ * 64) * INC), (unsigned*)((char*)(bufp) + tid * 16), 16, 0, 0); } while (0)
#define ATT_LOADV(tile, bufp) do { const int t__ = ((tile) < nkb) ? (tile) : nkb - 1; \
    __builtin_amdgcn_global_load_lds((const unsigned*)(Vg + (size_t)t__ * 64), (unsigned*)((char*)(bufp) + tid * 16), 16, 0, 0); } while (0)
  ATT_LOADK(0, Ks); ATT_LOADK(1, Ks + KS_SZ); ATT_LOADK(2, Ks + 2 * KS_SZ);
  ATT_LOADV(0, Vs); ATT_LOADV(1, Vs + VS_SZ);
  asm volatile("s_waitcnt vmcnt(0) lgkmcnt(0)\n\ts_barrier" ::: "memory");
  int r0 = 0, r2 = 2;
  for (int kb = 0; kb < nkb; ++kb) {
    ATT_LOADK(kb + 3, Ks + ((kb + 3) & 3) * KS_SZ);
    ATT_LOADV(kb + 2, Vs + r2 * VS_SZ);
    const u16* Kb = Ks + (kb & 3) * KS_SZ; const u16* Vb = Vs + r0 * VS_SZ;
    f32x16 Sc[RT][2];
    {
      bf16x8 kf[2][4];
#pragma unroll
      for (int kt = 0; kt < 2; ++kt)
#pragma unroll
        for (int s = 0; s < 4; ++s) kf[kt][s] = *(const bf16x8*)(Kb + (32 * kt + r) * 64 + (((2 * s + h) ^ ksw) << 3));
#pragma unroll
      for (int t = 0; t < RT; ++t)
#pragma unroll
        for (int kt = 0; kt < 2; ++kt) {
#pragma unroll
          for (int q = 0; q < 16; ++q) Sc[t][kt][q] = 0.f;
#pragma unroll
          for (int s = 0; s < 4; ++s) Sc[t][kt] = MFMA(kf[kt][s], qf[t][s], Sc[t][kt]);
        }
      __builtin_amdgcn_sched_group_barrier(0x100, 8, 0);
      __builtin_amdgcn_sched_group_barrier(0x008, 16, 0);
    }
    bf16x8 pf[RT][2][2];
#pragma unroll
    for (int t = 0; t < RT; ++t) {
      float mx = Sc[t][0][0];
#pragma unroll
      for (int kt = 0; kt < 2; ++kt)
#pragma unroll
        for (int q = 0; q < 16; ++q) mx = fmaxf(mx, Sc[t][kt][q]);
      mx = xhalf_max(mx);
      mx *= sc;
      if (__any(mx > m[t] + 6.0f)) {
        asm volatile("" ::: "memory");
        const float mn = fmaxf(m[t], mx);
        const float alpha = __builtin_amdgcn_exp2f(m[t] - mn);
        m[t] = mn; l[t] *= alpha;
#pragma unroll
        for (int d = 0; d < NDT; ++d)
#pragma unroll
          for (int q = 0; q < 16; ++q) O[t][d][q] *= alpha;
      }
      const float nm = -m[t];
#pragma unroll
      for (int kt = 0; kt < 2; ++kt) {
#pragma unroll
        for (int q = 0; q < 16; ++q) { const float pv = __builtin_amdgcn_exp2f(__builtin_fmaf(Sc[t][kt][q], sc, nm)); Sc[t][kt][q] = pv; l[t] += pv; }
#pragma unroll
        for (int s = 0; s < 2; ++s) {
          u32x4 pk;
#pragma unroll
          for (int q = 0; q < 4; ++q) pk[q] = pack2(Sc[t][kt][8 * s + 2 * q], Sc[t][kt][8 * s + 2 * q + 1]);
          pf[t][kt][s] = __builtin_bit_cast(bf16x8, pk);
        }
      }
    }
    {
      bf16x8 vf[4][NDT];
#pragma unroll
      for (int ks = 0; ks < 4; ++ks)
#pragma unroll
        for (int d = 0; d < NDT; ++d) vf[ks][d] = *(const bf16x8*)(Vb + (32 * d + r) * 64 + (((2 * ks + h) ^ ksw) << 3));
#pragma unroll
      for (int ks = 0; ks < 4; ++ks)
#pragma unroll
        for (int d = 0; d < NDT; ++d)
#pragma unroll
          for (int t = 0; t < RT; ++t) O[t][d] = MFMA(vf[ks][d], pf[t][ks >> 1][ks & 1], O[t][d]);
      __builtin_amdgcn_sched_group_barrier(0x100, 4, 0);
      __builtin_amdgcn_sched_group_barrier(0x008, 4, 0);
      __builtin_amdgcn_sched_group_barrier(0x100, 4, 0);
      __builtin_amdgcn_sched_group_barrier(0x008, 12, 0);
    }
    asm volatile("s_waitcnt vmcnt(%0) lgkmcnt(0)\n\ts_barrier" :: "n"(NL) : "memory");
    r2 = r0; r0 = (r0 == 2) ? 0 : r0 + 1;
  }
  asm volatile("s_waitcnt vmcnt(0)" ::: "memory");
#undef ATT_LOADK
#undef ATT_LOADV
  int ldo2 = ldo; asm volatile("" : "+s"(ldo2));
#pragma unroll
  for (int t = 0; t < RT; ++t) {
    float lt = l[t]; lt += __shfl_xor(lt, 32);
    const float inv = __builtin_amdgcn_rcpf(lt);
    u16* orow = Op + (size_t)(q0 + 64 * w + 32 * t + r) * ldo2;
#pragma unroll
    for (int d = 0; d < NDT; ++d)
#pragma unroll
      for (int g4 = 0; g4 < 4; ++g4) {
        u32x2 o; o[0] = pack2(O[t][d][4 * g4] * inv, O[t][d][4 * g4 + 1] * inv); o[1] = pack2(O[t][d][4 * g4 + 2] * inv, O[t][d][4 * g4 + 3] * inv);
        *(u32x2*)(orow + 32 * d + 8 * g4 + 4 * h) = o;
      }
  }
}

template <int ILO, int IHI>
DI void hy_seg(int lo, int hi, f32x16 (&acc)[4], const u16* fw, const u16* fw1, const u16* zs, const int (&tq)[4], const int (&tJ)[4],
               int ZL, int L, int wb, int r, int h) {
  if (lo > hi) return;
  const int idx0 = L - lo - r + 8 * h - wb;
  const unsigned* ap = (idx0 & 1) ? (const unsigned*)(fw1 + idx0 - 1) : (const unsigned*)(fw + idx0);
  const u16* bp[4];
#pragma unroll
  for (int i = ILO; i <= IHI; ++i) bp[i] = zs + tq[i] * ZL + 1024 + 1024 * tJ[i] + 32 * r - lo + 8 * h;
  const int n = ((hi - lo) >> 4) + 1;
  bf16x8 a, b[4];
  { u32x4 av; av[0] = ap[0]; av[1] = ap[1]; av[2] = ap[2]; av[3] = ap[3]; a = __builtin_bit_cast(bf16x8, av); }
#pragma unroll
  for (int i = ILO; i <= IHI; ++i) b[i] = *(const bf16x8*)bp[i];
  for (int k = 0; k < n; ++k) {
    ap -= 8;
    bf16x8 an, c[4];
    { u32x4 av; av[0] = ap[0]; av[1] = ap[1]; av[2] = ap[2]; av[3] = ap[3]; an = __builtin_bit_cast(bf16x8, av); }
#pragma unroll
    for (int i = ILO; i <= IHI; ++i) { bp[i] -= 16; c[i] = *(const bf16x8*)bp[i]; }
#pragma unroll
    for (int i = ILO; i <= IHI; ++i) acc[i] = MFMA(a, b[i], acc[i]);
    a = an;
#pragma unroll
    for (int i = ILO; i <= IHI; ++i) b[i] = c[i];
  }
}

DI void hyena_item(int c, const u16* __restrict__ G, const u16* __restrict__ zT, u16* __restrict__ yT, int nseq, int L, char* smem) {
  u16* zs = (u16*)smem;
  u16* fw = zs + 20480;
  u16* fw1 = fw + 8256;
  const int tid = otid() & 255, lane = tid & 63, w = __builtin_amdgcn_readfirstlane(tid >> 6), r = lane & 31, h = lane >> 5;
  const int ZL = L + 2048;
  __syncthreads();
  for (int q = 0; q < nseq; ++q) {
    const u16* src = zT + ((size_t)q * 512 + c) * L;
    u16* dst = zs + q * ZL;
    const u32x4 zero = {0u, 0u, 0u, 0u};
    for (int i = tid; i < 128; i += 256) { *(u32x4*)(dst + i * 8) = zero; *(u32x4*)(dst + 1024 + L + i * 8) = zero; }
    for (int i = tid; i < (L >> 3); i += 256) *(u32x4*)(dst + 1024 + i * 8) = *(const u32x4*)(src + i * 8);
  }
  int tq[4], tJ[4];
#pragma unroll
  for (int i = 0; i < 4; ++i) { if (nseq == 2) { tq[i] = i & 1; tJ[i] = 2 * w + (i >> 1); } else { tq[i] = 0; tJ[i] = 4 * w + i; } }
  f32x16 acc[4];
#pragma unroll
  for (int i = 0; i < 4; ++i)
#pragma unroll
    for (int q = 0; q < 16; ++q) acc[i][q] = 0.f;
  const int E0 = -L + 16, ELAST = L - 32;
  const int npass = (2 * L - 32 + 8191) / 8192;
  const u16* Gc = G + (size_t)c * (2 * L);
  for (int ps = 0; ps < npass; ++ps) {
    const int ea = E0 + 8192 * ps, eb = ea + 8192;
    const int wb = L - eb - 16;
    __syncthreads();
    for (int i = tid; i < 1032; i += 256) {
      const int gi = wb + i * 8;
      u32x4 v = {0u, 0u, 0u, 0u};
      if (gi >= 0 && gi < 2 * L) v = *(const u32x4*)(Gc + gi);
      *(u32x4*)(fw + i * 8) = v;
    }
    __syncthreads();
    for (int i = tid; i < 4127; i += 256) { const unsigned lo = ((const unsigned*)fw)[i], hi = ((const unsigned*)fw)[i + 1]; ((unsigned*)fw1)[i] = (lo >> 16) | (hi << 16); }
    __syncthreads();
    const int eend = (eb - 16 < ELAST) ? (eb - 16) : ELAST;
    int emn[4], emx[4];
#pragma unroll
    for (int i = 0; i < 4; ++i) { emn[i] = 1024 * tJ[i] - L + 16; emx[i] = 1024 * tJ[i] + 992; }
#define HY_CLIP_LO(v) ((v) < ea ? ea : (v))
#define HY_CLIP_HI(v) ((v) > eend ? eend : (v))
    hy_seg<0, 0>(HY_CLIP_LO(emn[0]), HY_CLIP_HI(emn[1] - 16), acc, fw, fw1, zs, tq, tJ, ZL, L, wb, r, h);
    hy_seg<0, 1>(HY_CLIP_LO(emn[1]), HY_CLIP_HI(emn[2] - 16), acc, fw, fw1, zs, tq, tJ, ZL, L, wb, r, h);
    hy_seg<0, 2>(HY_CLIP_LO(emn[2]), HY_CLIP_HI(emn[3] - 16), acc, fw, fw1, zs, tq, tJ, ZL, L, wb, r, h);
    hy_seg<0, 3>(HY_CLIP_LO(emn[3]), HY_CLIP_HI(emx[0]), acc, fw, fw1, zs, tq, tJ, ZL, L, wb, r, h);
    hy_seg<1, 3>(HY_CLIP_LO(emx[0] + 16), HY_CLIP_HI(emx[1]), acc, fw, fw1, zs, tq, tJ, ZL, L, wb, r, h);
    hy_seg<2, 3>(HY_CLIP_LO(emx[1] + 16), HY_CLIP_HI(emx[2]), acc, fw, fw1, zs, tq, tJ, ZL, L, wb, r, h);
    hy_seg<3, 3>(HY_CLIP_LO(emx[2] + 16), HY_CLIP_HI(emx[3]), acc, fw, fw1, zs, tq, tJ, ZL, L, wb, r, h);
#undef HY_CLIP_LO
#undef HY_CLIP_HI
  }
#pragma unroll
  for (int i = 0; i < 4; ++i) {
    u16* dst = yT + ((size_t)tq[i] * 512 + c) * L + 1024 * tJ[i] + 32 * r + 4 * h;
#pragma unroll
    for (int g4 = 0; g4 < 4; ++g4) {
      u32x2 o; o[0] = pack2(acc[i][4 * g4], acc[i][4 * g4 + 1]); o[1] = pack2(acc[i][4 * g4 + 2], acc[i][4 * g4 + 3]);
      *(u32x2*)(dst + 8 * g4) = o;
    }
  }
}

DI void diff_post_item(const Params& P, int layer, float lam, float lam_init, const u16* __restrict__ dO, u16* __restrict__ ydf, int it) {
  const int tid = otid() & 255, lane = tid & 63, w = __builtin_amdgcn_readfirstlane(tid >> 6);
  const int u = it * 8 + w * 2 + (lane >> 5);
  const int i = lane & 31;
  const u32x2 a = *(const u32x2*)(dO + (size_t)u * 256 + 4 * i);
  const u32x2 b = *(const u32x2*)(dO + (size_t)u * 256 + 128 + 4 * i);
  float o[4];
  o[0] = bflo(a[0]) - lam * bflo(b[0]); o[1] = bfhi(a[0]) - lam * bfhi(b[0]);
  o[2] = bflo(a[1]) - lam * bflo(b[1]); o[3] = bfhi(a[1]) - lam * bfhi(b[1]);
  const float ss = half_sum(o[0] * o[0] + o[1] * o[1] + o[2] * o[2] + o[3] * o[3]);
  const float rs = rsqrtf(ss * (1.0f / 128.0f) + 1e-5f) * (1.0f - lam_init);
  const float* g = P.diff_subln + layer * 128 + 4 * i;
  u32x2 ov; ov[0] = pack2(o[0] * rs * g[0], o[1] * rs * g[1]); ov[1] = pack2(o[2] * rs * g[2], o[3] * rs * g[3]);
  *(u32x2*)(ydf + (size_t)u * 128 + 4 * i) = ov;
}
DI void hyena_post_item(const Params& P, int layer, const u16* __restrict__ p, int L, const u16* __restrict__ yT, const u16* __restrict__ zT,
                        int ct, int tt, u16* __restrict__ yhy, char* smem) {
  float* tile = (float*)smem;
  const int tid = otid() & 255;
  const int t0 = tt * 64; const int seq = t0 / L, tl0 = t0 - seq * L;
  __syncthreads();
  {
    const int tcol = tid & 63, c0 = tid >> 6;
#pragma unroll
    for (int i = 0; i < 16; ++i) {
      const int cc = c0 + 4 * i; const int c = ct * 64 + cc;
      const size_t gi = ((size_t)seq * 512 + c) * L + tl0 + tcol;
      tile[cc * 65 + tcol] = bf2f(yT[gi]) + bf2f(zT[gi]) * P.hy_skip[layer * 512 + c];
    }
  }
  __syncthreads();
  {
    const int col = tid & 63, r0 = tid >> 6; const int c = ct * 64 + col;
    const float* cw = P.hy_conv_w + layer * 3 * 1536; const float* cb = P.hy_conv_b + layer * 1536;
    const float w0 = cw[c], w1 = cw[1536 + c], w2 = cw[3072 + c], b0 = cb[c];
#pragma unroll
    for (int i = 0; i < 16; ++i) {
      const int row = r0 + 4 * i; const int tl = tl0 + row;
      const u16* pr = p + (size_t)(t0 + row) * INC + c;
      const float xm1 = (tl > 0) ? bf2f(pr[-INC]) : 0.f, x0 = bf2f(pr[0]), xp1 = (tl < L - 1) ? bf2f(pr[INC]) : 0.f;
      const float x0c = xm1 * w0 + x0 * w1 + xp1 * w2 + b0;
      yhy[(size_t)(t0 + row) * 512 + c] = f2bf(x0c * tile[col * 65 + row]);
    }
  }
}

__global__ void __launch_bounds__(512) fwd_megakernel(Params Parg) {
  cg::grid_group grid = cg::this_grid();
  extern __shared__ __attribute__((aligned(16))) char smem_dyn[];
  char* smem = smem_dyn + 16;
  uint4& xb_words = *(uint4*)smem_dyn;
  const int nb = gridDim.x, nb2 = nb * 2;
#define KPARAMS() const Params __attribute__((address_space(4)))* pp_ = (const Params __attribute__((address_space(4)))*)__builtin_amdgcn_kernarg_segment_ptr(); \
  asm volatile("" : "+s"(pp_)); const Params& P = *(const Params*)pp_; char* ws = P.ws
  if (threadIdx.x == 0) xb_words = make_uint4(0u, 0u, 0u, blockIdx.x);
  __syncthreads();
  XcdBarrier xb;
  { KPARAMS(); xb = xcd_barrier_post((unsigned*)(ws + O_BAR), (volatile LAS unsigned*)&xb_words); }

  for (int step = 0; step < 80; ++step) {
    const int layer = step / 40, ls = step - layer * 40;
    PHASE_IDS();
    KPARAMS();
    float* misc = (float*)(ws + O_MISC);
    u16* pbuf = (u16*)(ws + O_P); u16* hid = pbuf; u16* hn = (u16*)(ws + O_HN); u16* merged = hn;
    if (ls == 0) {
      u16* filt8 = (u16*)(ws + O_FILT8); u16* filt16 = (u16*)(ws + O_FILT16);
      const int n1 = 16 * 88, n2 = 44 * 16, n3 = 16 * 108, n4 = 3 * 8 * 16, n5 = 16 * 16;
      const int nfilt = 128 + 256;
      const int total = n1 + n2 + n3 + n4 + n5 + n1 + n2 + nfilt;
      for (int it = bid2; it < total; it += nb2) {
        int t = it;
        if (t < nfilt) {
          const bool big = t < 256;
          filter_item(P, layer, big ? 16384 : 8192, big ? t : t - 256, big ? filt16 : filt8, smg);
          continue;
        }
        t -= nfilt;
        const float* src; int K, N, kt, nt, ph = 0; u16* dst;
        if (t < n1) { src = P.ffn1_w_in + (size_t)layer * 1024 * 5632; K = 1024; N = 5632; dst = (u16*)(ws + O_F1IN); kt = t / 88; nt = t % 88; ph = 2816; }
        else if ((t -= n1) < n2) { src = P.ffn1_w_out + (size_t)layer * 2816 * 1024; K = 2816; N = 1024; dst = (u16*)(ws + O_F1OUT); kt = t / 16; nt = t % 16; }
        else if ((t -= n2) < n3) { src = P.w_in + (size_t)layer * 1024 * 6912; K = 1024; N = 6912; dst = (u16*)(ws + O_WIN); kt = t / 108; nt = t % 108; }
        else if ((t -= n3) < n4) { const int br = t / 128, tt = t % 128; src = P.w_branch + ((size_t)layer * 3 + br) * 512 * 1024; K = 512; N = 1024;
                                   dst = (u16*)(ws + O_WBR) + (size_t)br * 1024 * 512; kt = tt / 16; nt = tt % 16; }
        else if ((t -= n4) < n5) { src = P.w_out + (size_t)layer * 1024 * 1024; K = 1024; N = 1024; dst = (u16*)(ws + O_WOUT); kt = t / 16; nt = t % 16; }
        else if ((t -= n5) < n1) { src = P.ffn2_w_in + (size_t)layer * 1024 * 5632; K = 1024; N = 5632; dst = (u16*)(ws + O_F2IN); kt = t / 88; nt = t % 88; ph = 2816; }
        else { t -= n1; src = P.ffn2_w_out + (size_t)layer * 2816 * 1024; K = 2816; N = 1024; dst = (u16*)(ws + O_F2OUT); kt = t / 16; nt = t % 16; }
        convT_tile(src, K, N, dst, kt, nt, ph, smg);
      }
      if (bid == 1 && grp == 0 && layer == 0) {
        float* rope = (float*)(ws + O_ROPE);
        for (int i = t_; i < 320 * 16; i += 256) {
          const int pos = (i < 4096) ? (i >> 4) : ((i - 4096) >> 4); const int jj = i & 15;
          const float inv = powf(10000.0f, -(float)(2 * jj) / 32.0f);
          const float ang = (float)pos * inv;
          rope[2 * i] = cosf(ang); rope[2 * i + 1] = sinf(ang);
        }
      }
      if (bid == 0 && grp == 0) {
        const int tid = t_;
        if (tid < 2) {
          const float* lp = P.diff_lambda + tid * 256;
          float s1 = 0.f, s2 = 0.f;
          for (int i = 0; i < 64; ++i) { s1 += lp[i] * lp[64 + i]; s2 += lp[128 + i] * lp[192 + i]; }
          const float lam_init = 0.8f - 0.6f * expf(-0.3f * (float)tid);
          misc[tid] = expf(s1) - expf(s2) + lam_init;
        }
        for (int i = tid; i < 4 * 257; i += 256) {
          const int hh = i / 257, idx = i % 257; const int rel = idx - 128; const int n = rel < 0 ? -rel : rel;
          int b;
          if (n < 8) b = n; else { int lg = 8 + (int)(logf((float)n / 8.0f) / 2.772588722239781f * 8.0f); b = lg < 15 ? lg : 15; }
          if (rel > 0) b += 16;
          misc[64 + i] = P.rel_bias[b * 4 + hh] * LOG2E;
        }
      }
      if (step == 0) {
        grid.sync();
        if (threadIdx.x == 0) {
          unsigned* bar = (unsigned*)(ws + O_BAR); bool even = ((nb & 7) == 0);
          for (int j = 0; j < 16; ++j) { const unsigned c = xb_ld(&bar[XB_XCNT(j)]); if (c != ((j < 8) ? (unsigned)(nb >> 3) : 0u)) even = false; }
          volatile LAS unsigned* st = (volatile LAS unsigned*)&xb_words;
          if (even) st[3] = st[2] * 8u + xb.x;
        }
        __syncthreads();
      } else GSYNC();
      continue;
    }
    const int cs = ls - 1; const int ch = cs / 13, st = cs - ch * 13;
    const int nseq = (ch < 2) ? 2 : 1, L = (ch < 2) ? 8192 : 16384;
    const float* xin0 = (ch < 2) ? (P.x_prompt + (size_t)ch * TCH * DM) : P.x_sample;
    float* xres = P.out + (size_t)ch * TCH * DM;
    const float* xcur = (layer == 0) ? xin0 : xres;
    for (int rp_ = 0; rp_ <= ((REPMASK >> st) & 1); ++rp_) {
    if (st == 0 || st == 3 || st == 10) {
      const float* src = (st == 0) ? xcur : xres;
      const float* gn = ((st == 0) ? P.ffn1_norm : (st == 3 ? P.mix_norm : P.ffn2_norm)) + layer * DM;
      for (int it = bid2; it < TCH / 4; it += nb2) { const int row = it * 4 + w; norm_row_bf16(src + (size_t)row * DM, gn, hn + (size_t)row * DM, lane); }
    } else if (st == 1 || st == 2 || st == 4 || st == 8 || st == 9 || st == 11 || st == 12) {
      EpiAny E{}; const u16* A; const u16* Bt; int N, K;
      if (st == 1 || st == 11) { A = hn; Bt = (u16*)(ws + (st == 1 ? O_F1IN : O_F2IN)); N = 5632; K = DM; E.mode = EPI_SWIGLU; E.perm = true; E.O = hid; E.ldo = DFF; }
      else if (st == 2 || st == 12) { A = hid; Bt = (u16*)(ws + (st == 2 ? O_F1OUT : O_F2OUT)); N = DM; K = DFF; E.mode = EPI_RESID; E.perm = false;
                                      E.xin = (st == 2) ? xcur : xres; E.xout = xres; E.scale = 0.5f; }
      else if (st == 4) { A = hn; Bt = (u16*)(ws + O_WIN); N = INC; K = DM; E.mode = EPI_PROJ; E.perm = true; E.O = pbuf; }
      else if (st == 8) { A = (u16*)(ws + O_YHY); Bt = (u16*)(ws + O_WBR); N = DM; K = 512; E.mode = EPI_MERGE; E.perm = false; E.gate = pbuf; E.macc = (float*)(ws + O_ZT); E.O = merged; }
      else { A = merged; Bt = (u16*)(ws + O_WOUT); N = DM; K = DM; E.mode = EPI_RESID; E.perm = false; E.xin = xres; E.xout = xres; E.scale = 1.0f; }
      {
        pg8::Gemm gg{A, Bt, TCH, N, K};
        AnyOrder S; S.init(TCH, N, nb, bid); S.merge3 = (st == 8);
        pg8::gemm_phase<EpiAny, AnyOrder, false>((PG8_LAS unsigned char*)smem, gg, S, E, nullptr);
      }
    } else if (st == 5) {
      const int nqk = TCH * 10 / 8, ntr = 256 * 18;
      for (int it = bid2; it < nqk + ntr; it += nb2) {
        if (it < nqk) { qk_prep_item(P, layer, pbuf, L, it, (const float*)(ws + O_ROPE)); continue; }
        const int t = it - nqk; const int tt = t / 18, cc = t % 18;
        const int kind = (cc < 2) ? 0 : (cc < 10 ? 1 : 2);
        const int ct = (cc < 2) ? cc : (cc < 10 ? cc - 2 : cc - 10);
        u16* dst = (u16*)(ws + (kind == 0 ? O_VTG : (kind == 1 ? O_VTD : O_ZT)));
        transpose_item(P, layer, pbuf, L, kind, ct, tt, dst, smg);
      }
    } else if (st == 6) {
      u16* zT = (u16*)(ws + O_ZT); u16* yT = (u16*)(ws + O_YT); u16* dO = (u16*)(ws + O_DIFFO);
      u16* vtg = (u16*)(ws + O_VTG); u16* vtd = (u16*)(ws + O_VTD); u16* ygq = (u16*)(ws + O_YGQ);
      const u16* filt = (u16*)(ws + ((ch < 2) ? O_FILT8 : O_FILT16));
      const int nqt = L / 256;
      const int xcd = bid & 7, nxu = nb >> 3, nitem = nseq * nqt;
      for (int e = bid >> 3; e < nitem; e += nxu) {
        const int seq = e / nqt, qt = e - seq * nqt;
        const int hh = xcd >> 1, cc = xcd & 1;
        const size_t tb = (size_t)seq * L;
        const u16* Qd = pbuf + tb * INC + OFF_DQ + xcd * 64; const u16* Kd = pbuf + tb * INC + OFF_DK + xcd * 64;
        const u16* Vd = vtd + ((size_t)seq * 512 + hh * 128) * L; u16* Od = dO + tb * 1024 + (hh * 2 + cc) * 128;
        attn_tile<128, true, false>(Qd, Kd, Vd, L, Od, 1024, qt * 256, misc + 64 + hh * 257, smem);
      }
      {
        const int nqt2 = L / 512, nitem2 = nseq * nqt2;
        for (int e = bid >> 3; e < nitem2; e += nxu) {
          const int seq = e / nqt2, qt = e - seq * nqt2;
          const int kvh = xcd >> 2;
          const size_t tb = (size_t)seq * L;
          const u16* Qd = pbuf + tb * INC + OFF_GQ + xcd * 64; const u16* Kd = pbuf + tb * INC + OFF_GK + kvh * 64;
          const u16* Vd = vtg + ((size_t)seq * 128 + kvh * 64) * L; u16* Od = ygq + tb * 512 + xcd * 64;
          attn_tile2(Qd, Kd, Vd, L, Od, 512, qt * 512, smem);
        }
      }
      for (int c = bid2; c < 512; c += nb2) hyena_item(c, filt, zT, yT, nseq, L, smg);
    } else {
      u16* zT = (u16*)(ws + O_ZT); u16* yT = (u16*)(ws + O_YT); u16* dO = (u16*)(ws + O_DIFFO);
      u16* yhy = (u16*)(ws + O_YHY); u16* ydf = (u16*)(ws + O_YDF);
      const float lam = misc[layer];
      const float lam_init = 0.8f - 0.6f * expf(-0.3f * (float)layer);
      const int ndp = TCH * 4 / 8, nhp = 256 * 8;
      for (int it = bid2; it < ndp + nhp; it += nb2) {
        if (it < ndp) diff_post_item(P, layer, lam, lam_init, dO, ydf, it);
        else { const int t = it - ndp; hyena_post_item(P, layer, pbuf, L, yT, zT, t % 8, t / 8, yhy, smg); }
      }
    }
    }
    GSYNC();
  }
  { PHASE_IDS(); KPARAMS(); (void)ws;
    for (int it = bid2; it < NTOK / 4; it += nb2) { const int row = it * 4 + w; norm_row_f32_inplace(P.out + (size_t)row * DM, P.final_norm, lane); }
  }
}

extern "C" void kernel_launch(void* const* d_in, const int* in_sizes, int n_in, void* d_out, int out_size, void* d_ws, size_t ws_size,
                              hipStream_t stream) {
  static int grid_blocks = 0;
  if (!grid_blocks) {
    int dev = 0, cus = 0, per_cu = 0;
    (void)hipGetDevice(&dev);
    (void)hipDeviceGetAttribute(&cus, hipDeviceAttributeMultiprocessorCount, dev);
    (void)hipFuncSetAttribute((const void*)fwd_megakernel, hipFuncAttributeMaxDynamicSharedMemorySize, SMEM_BYTES + 16);
    (void)hipOccupancyMaxActiveBlocksPerMultiprocessor(&per_cu, fwd_megakernel, 512, SMEM_BYTES + 16);
    if (per_cu < 1) per_cu = 1;
    if (per_cu > 1) per_cu = 1;
    grid_blocks = cus * per_cu;
  }
  Params p{};
  const float* const* in = (const float* const*)d_in;
  p.x_prompt = in[0]; p.x_sample = in[1]; p.ffn1_norm = in[2]; p.ffn1_w_in = in[3]; p.ffn1_w_out = in[4]; p.mix_norm = in[5]; p.w_in = in[6];
  p.hy_conv_w = in[7]; p.hy_conv_b = in[8]; p.hy_w1 = in[9]; p.hy_b1 = in[10]; p.hy_w2 = in[11]; p.hy_b2 = in[12]; p.hy_w3 = in[13];
  p.hy_freq = in[14]; p.hy_skip = in[15]; p.gqa_q_norm = in[16]; p.gqa_k_norm = in[17]; p.diff_lambda = in[18]; p.diff_subln = in[19];
  p.rel_bias = in[20]; p.w_branch = in[21]; p.w_out = in[22]; p.ffn2_norm = in[23]; p.ffn2_w_in = in[24]; p.ffn2_w_out = in[25]; p.final_norm = in[26];
  p.out = (float*)d_out; p.ws = (char*)d_ws;
  void* args[] = {&p};
  (void)hipMemsetAsync((char*)d_ws + O_BAR, 0, XCD_BAR_WORDS * 4, stream);
  hipError_t e = hipLaunchCooperativeKernel((void*)fwd_megakernel, dim3(grid_blocks), dim3(512), args, SMEM_BYTES + 16, stream);
  if (e != hipSuccess) fprintf(stderr, "cooperative launch failed: %s (grid %d)\n", hipGetErrorString(e), grid_blocks);
}
```

```cpp
#include <hip/hip_runtime.h>
#include <hip/hip_cooperative_groups.h>
#include <stdint.h>
#include <cstdio>
namespace cg = cooperative_groups;

typedef unsigned short u16;
typedef __attribute__((ext_vector_type(8))) short bf16x8;
typedef __attribute__((ext_vector_type(16))) float f32x16;
typedef __attribute__((ext_vector_type(4))) float f32x4;
typedef __attribute__((ext_vector_type(4))) unsigned u32x4;
typedef __attribute__((ext_vector_type(2))) unsigned u32x2;
typedef __attribute__((ext_vector_type(2))) __bf16 bf2_t;
typedef __attribute__((ext_vector_type(2))) float f2_t;
#define DI __device__ __forceinline__
#define MFMA(a, b, c) __builtin_amdgcn_mfma_f32_32x32x16_bf16((a), (b), (c), 0, 0, 0)

constexpr int DM = 1024, DFF = 2816, INC = 6912, TCH = 16384, NTOK = 49152;
constexpr int OFF_GQ = 1536, OFF_GK = 2048, OFF_GV = 2176, OFF_DQ = 2304, OFF_DK = 2816, OFF_DV = 3328, OFF_GATE = 3840;
constexpr float LOG2E = 1.4426950408889634f;

constexpr size_t SZ_F1IN = (size_t)5632 * 1024 * 2, SZ_F1OUT = (size_t)1024 * 2816 * 2, SZ_WIN = (size_t)6912 * 1024 * 2,
                 SZ_WBR = (size_t)3 * 1024 * 512 * 2, SZ_WOUT = (size_t)1024 * 1024 * 2;
constexpr size_t O_F1IN = 0, O_F1OUT = O_F1IN + SZ_F1IN, O_WIN = O_F1OUT + SZ_F1OUT, O_WBR = O_WIN + SZ_WIN, O_WOUT = O_WBR + SZ_WBR,
                 O_F2IN = O_WOUT + SZ_WOUT, O_F2OUT = O_F2IN + SZ_F1IN, O_FILT8 = O_F2OUT + SZ_F1OUT,
                 O_FILT16 = O_FILT8 + (size_t)512 * 16384 * 2, O_MISC = O_FILT16 + (size_t)512 * 32768 * 2,
                 O_P = O_MISC + 131072, O_HN = O_P + (size_t)TCH * INC * 2, O_ZT = O_HN + (size_t)TCH * 1024 * 2,
                 O_YT = O_ZT + (size_t)TCH * 512 * 2, O_DIFFO = O_YT + (size_t)TCH * 512 * 2, O_VTG = O_DIFFO + (size_t)TCH * 1024 * 2,
                 O_VTD = O_VTG + (size_t)TCH * 128 * 2, O_YHY = O_VTD + (size_t)TCH * 512 * 2, O_YGQ = O_YHY + (size_t)TCH * 512 * 2,
                 O_YDF = O_YGQ + (size_t)TCH * 512 * 2, O_END = O_YDF + (size_t)TCH * 512 * 2;
static_assert(O_END <= (size_t)536870912, "workspace overflow");
constexpr int SMEM_BYTES = 151552;
constexpr int GRP_LDS = 75776;
#define REPMASK 0
#define REP_SYNC 1
#define PHASE_IDS() const int t_ = otid(); const int bid = __builtin_amdgcn_readfirstlane(((volatile LAS unsigned*)&xb_words)[3]); const int lane = t_ & 63; const int grp = __builtin_amdgcn_readfirstlane(t_ >> 8); \
  const int w = __builtin_amdgcn_readfirstlane((t_ >> 6) & 3); const int bid2 = bid * 2 + grp; char* smg = smem + grp * GRP_LDS; \
  const int vb = (bid & 7) * (nb >> 3) + (bid >> 3); (void)lane; (void)w; (void)bid2; (void)smg; (void)vb
#define GSYNC() do { for (int rs_ = 0; rs_ < REP_SYNC; ++rs_) xcd_barrier(xb); } while (0)


#define XB_TMO      128
#define XB_XCNT(j)  (256  + 64 * (j))
#define XB_XSUB(j)  (1280 + 64 * (j))
#define XB_XGEN(j)  (2304 + 64 * (j))
#define XB_TOP      3328
#define XB_TOPGEN   3392
#define XCD_BAR_WORDS 3456
#define XB_SPIN_CAP (1u << 21)
#define LAS __attribute__((address_space(3)))
DI unsigned xb_ld(unsigned* p)              { return __hip_atomic_load(p, __ATOMIC_RELAXED, __HIP_MEMORY_SCOPE_AGENT); }
DI unsigned xb_add(unsigned* p, unsigned v) { return __hip_atomic_fetch_add(p, v, __ATOMIC_RELAXED, __HIP_MEMORY_SCOPE_AGENT); }
DI unsigned xb_xcc_id() { return (unsigned)__builtin_amdgcn_s_getreg((3 << 11) | 20) & 0xFu; }
#define XB_SPIN(cond, bar) do { unsigned _sp = 0; while (cond) { __builtin_amdgcn_s_sleep(1); \
    if ((++_sp & 255u) == 0u) { if (xb_ld(&(bar)[XB_TMO])) break; if (_sp > XB_SPIN_CAP) { atomicAdd(&(bar)[XB_TMO], 1u); break; } } } } while (0)
struct XcdBarrier { unsigned* bar; unsigned x; volatile LAS unsigned* st; };
DI XcdBarrier xcd_barrier_post(unsigned* bar, volatile LAS unsigned* st) {
  XcdBarrier b; b.bar = bar; b.x = xb_xcc_id(); b.st = st;
  if (threadIdx.x == 0) { const unsigned rank = xb_add(&bar[XB_XCNT(b.x)], 1u); st[2] = rank; }
  return b;
}
DI void xcd_barrier_complete(unsigned* bar, unsigned x, unsigned& nloc, unsigned& nx) {
  const unsigned G = gridDim.x * gridDim.y * gridDim.z;
  unsigned sum, cnt, mine, sp = 0u;
  for (;;) {
    sum = 0u; cnt = 0u; mine = 0u;
#pragma unroll
    for (unsigned j = 0; j < 16; ++j) { const unsigned c = xb_ld(&bar[XB_XCNT(j)]); sum += c; cnt += (c > 0u) ? 1u : 0u; mine = (j == x) ? c : mine; }
    if (sum == G) break;
    __builtin_amdgcn_s_sleep(1);
    if ((++sp & 255u) == 0u) { if (xb_ld(&bar[XB_TMO])) break; if (sp > XB_SPIN_CAP) { atomicAdd(&bar[XB_TMO], 1u); break; } }
  }
  nloc = mine > 0u ? mine : 1u; nx = cnt > 0u ? cnt : 1u;
}
DI void xcd_barrier(const XcdBarrier& b) {
  asm volatile("s_waitcnt vmcnt(0)" ::: "memory");
  __syncthreads();
  if (threadIdx.x == 0) {
    unsigned* bar = b.bar;
    __builtin_amdgcn_s_waitcnt(0);
    unsigned nloc = b.st[0], nx = b.st[1];
    if (nloc == 0u) { xcd_barrier_complete(bar, b.x, nloc, nx); b.st[0] = nloc; b.st[1] = nx; }
    const unsigned old = xb_add(&bar[XB_XSUB(b.x)], 1u);
    const unsigned gen = old / nloc;
    if (old + 1u == (gen + 1u) * nloc) {
      __builtin_amdgcn_fence(__ATOMIC_RELEASE, "agent");
      asm volatile("s_waitcnt vmcnt(0)" ::: "memory");
      const unsigned og = xb_add(&bar[XB_TOP], 1u);
      const unsigned tg = og / nx;
      if (og + 1u == (tg + 1u) * nx) xb_add(&bar[XB_TOPGEN], 1u);
      else XB_SPIN(xb_ld(&bar[XB_TOPGEN]) == tg, bar);
      __builtin_amdgcn_fence(__ATOMIC_ACQUIRE, "agent");
      xb_add(&bar[XB_XGEN(b.x)], 1u);
      asm volatile("s_waitcnt vmcnt(0)" ::: "memory");
    } else {
      XB_SPIN(xb_ld(&bar[XB_XGEN(b.x)]) == gen, bar);
      __builtin_amdgcn_fence(__ATOMIC_ACQUIRE, "agent");
      asm volatile("s_waitcnt vmcnt(0)" ::: "memory");
    }
  }
  __syncthreads();
}
constexpr size_t O_BAR = O_MISC + 16384;
constexpr size_t O_ROPE = O_MISC + 65536;

struct Params {
  const float* x_prompt; const float* x_sample;
  const float* ffn1_norm; const float* ffn1_w_in; const float* ffn1_w_out; const float* mix_norm; const float* w_in;
  const float* hy_conv_w; const float* hy_conv_b; const float* hy_w1; const float* hy_b1; const float* hy_w2; const float* hy_b2;
  const float* hy_w3; const float* hy_freq; const float* hy_skip;
  const float* gqa_q_norm; const float* gqa_k_norm; const float* diff_lambda; const float* diff_subln; const float* rel_bias;
  const float* w_branch; const float* w_out; const float* ffn2_norm; const float* ffn2_w_in; const float* ffn2_w_out; const float* final_norm;
  float* out; char* ws;
};

DI unsigned pack2(float a, float b) { f2_t v = {a, b}; bf2_t r = __builtin_convertvector(v, bf2_t); return __builtin_bit_cast(unsigned, r); }
DI u16 f2bf(float a) { return (u16)(pack2(a, 0.f) & 0xffffu); }
DI float bf2f(u16 v) { return __uint_as_float(((unsigned)v) << 16); }
DI float bflo(unsigned v) { return __uint_as_float(v << 16); }
DI float bfhi(unsigned v) { return __uint_as_float(v & 0xffff0000u); }
DI int otid() { int t = threadIdx.x; asm volatile("" : "+v"(t)); return t; }
DI float xhalf_max(float x) {
  typedef unsigned u2_t __attribute__((ext_vector_type(2)));
  const u2_t rr = __builtin_amdgcn_permlane32_swap(__float_as_uint(x), __float_as_uint(x), false, false);
  return fmaxf(__uint_as_float(rr[0]), __uint_as_float(rr[1]));
}
DI float xhalf_sum(float x) {
  typedef unsigned u2_t __attribute__((ext_vector_type(2)));
  const u2_t rr = __builtin_amdgcn_permlane32_swap(__float_as_uint(x), __float_as_uint(x), false, false);
  return __uint_as_float(rr[0]) + __uint_as_float(rr[1]);
}
DI int crow(int reg, int h) { return (reg & 3) + 8 * (reg >> 2) + 4 * h; }
DI float wave_sum(float v) {
  v += __shfl_xor(v, 32); v += __shfl_xor(v, 16); v += __shfl_xor(v, 8); v += __shfl_xor(v, 4); v += __shfl_xor(v, 2); v += __shfl_xor(v, 1);
  return v;
}
DI float half_sum(float v) {
  v += __shfl_xor(v, 16); v += __shfl_xor(v, 8); v += __shfl_xor(v, 4); v += __shfl_xor(v, 2); v += __shfl_xor(v, 1);
  return v;
}

DI void convT_tile(const float* __restrict__ src, int K, int N, u16* __restrict__ dst, int kt, int nt, int perm_half, char* smem) {
  float* t = (float*)smem;
  const int tid = otid() & 255;
  __syncthreads();
  {
    const int col = tid & 63, r0 = tid >> 6;
#pragma unroll
    for (int i = 0; i < 16; ++i) { int row = r0 + 4 * i; t[row * 65 + col] = src[(size_t)(kt * 64 + row) * N + nt * 64 + col]; }
  }
  __syncthreads();
  {
    const int nl = tid >> 2, kq = tid & 3;
    int n = nt * 64 + nl;
    if (perm_half > 0) { if (n < perm_half) n = (n >> 7) * 256 + (n & 127); else { int j = n - perm_half; n = (j >> 7) * 256 + 128 + (j & 127); } }
    u32x4 o0, o1;
#pragma unroll
    for (int i = 0; i < 4; ++i) {
      o0[i] = pack2(t[(kq * 16 + 2 * i) * 65 + nl], t[(kq * 16 + 2 * i + 1) * 65 + nl]);
      o1[i] = pack2(t[(kq * 16 + 8 + 2 * i) * 65 + nl], t[(kq * 16 + 8 + 2 * i + 1) * 65 + nl]);
    }
    u16* d = dst + (size_t)n * K + kt * 64 + kq * 16;
    *(u32x4*)d = o0; *(u32x4*)(d + 8) = o1;
  }
}

DI void filter_item(const Params& P, int layer, int L, int tb, u16* __restrict__ G, char* smem) {
  float* h1 = (float*)smem;
  float* h2 = h1 + 64 * 65;
  const int tid = otid() & 255, lane = tid & 63, w = __builtin_amdgcn_readfirstlane(tid >> 6);
  const float* w1 = P.hy_w1 + layer * 33 * 64; const float* b1 = P.hy_b1 + layer * 64;
  const float* w2 = P.hy_w2 + layer * 64 * 64; const float* b2 = P.hy_b2 + layer * 64;
  const float* w3 = P.hy_w3 + layer * 64 * 1024; const float* fr = P.hy_freq + layer * 64;
  const int t = tb * 64 + lane;
  const float tl = (float)t / (float)(L - 1);
  __syncthreads();
  {
    float a[16];
#pragma unroll
    for (int u = 0; u < 16; ++u) a[u] = b1[w * 16 + u] + tl * w1[w * 16 + u];
    const float base = (float)(2.0 * 3.14159265358979323846 / (double)L) * (float)t;
    for (int b = 0; b < 16; ++b) {
      const float band = 1e-4f + (float)b * ((15.0f - 1e-4f) / 15.0f);
      const float ang = base * band;
      const float cs = cosf(ang), sn = -sinf(ang);
#pragma unroll
      for (int u = 0; u < 16; ++u) a[u] += cs * w1[(1 + b) * 64 + w * 16 + u] + sn * w1[(17 + b) * 64 + w * 16 + u];
    }
#pragma unroll
    for (int u = 0; u < 16; ++u) h1[lane * 65 + w * 16 + u] = sinf(fr[w * 16 + u] * a[u]);
  }
  __syncthreads();
  {
    float a[16];
#pragma unroll
    for (int u = 0; u < 16; ++u) a[u] = b2[w * 16 + u];
    for (int k = 0; k < 64; ++k) {
      const float hv = h1[lane * 65 + k];
#pragma unroll
      for (int u = 0; u < 16; ++u) a[u] += hv * w2[k * 64 + w * 16 + u];
    }
#pragma unroll
    for (int u = 0; u < 16; ++u) h2[lane * 65 + w * 16 + u] = sinf(fr[w * 16 + u] * a[u]);
  }
  __syncthreads();
  const float min_decay = -3.0701134573253946f, max_decay = -15.350567286626973f;
  for (int og = 0; og < 64; ++og) {
    const int o = w * 256 + og * 4;
    float a0 = 0.f, a1 = 0.f, a2 = 0.f, a3 = 0.f;
#pragma unroll 4
    for (int k = 0; k < 64; ++k) {
      const float hv = h2[lane * 65 + k];
      const f32x4 wv = *(const f32x4*)(w3 + k * 1024 + o);
      a0 += hv * wv[0]; a1 += hv * wv[1]; a2 += hv * wv[2]; a3 += hv * wv[3];
    }
    float av[4] = {a0, a1, a2, a3};
#pragma unroll
    for (int q = 0; q < 4; ++q) {
      const int oo = o + q; const int ch = oo & 511;
      const float delta = min_decay + (float)ch * ((max_decay - min_decay) / 511.0f);
      const float val = av[q] * expf(-tl * fabsf(delta));
      u16* Gc = G + (size_t)ch * (2 * L);
      if (oo < 512) Gc[L - t] = f2bf(val);
      else { if (t >= 1) Gc[L + t] = f2bf(val); else Gc[0] = 0; }
    }
  }
}

DI void norm_row_bf16(const float* __restrict__ x, const float* __restrict__ g, u16* __restrict__ out, int lane) {
  f32x4 v[4]; float ss = 0.f;
#pragma unroll
  for (int i = 0; i < 4; ++i) { v[i] = *(const f32x4*)(x + lane * 4 + 256 * i); ss += v[i][0] * v[i][0] + v[i][1] * v[i][1] + v[i][2] * v[i][2] + v[i][3] * v[i][3]; }
  ss = wave_sum(ss);
  const float rs = rsqrtf(ss * (1.0f / 1024.0f) + 1e-6f);
#pragma unroll
  for (int i = 0; i < 4; ++i) {
    const f32x4 gg = *(const f32x4*)(g + lane * 4 + 256 * i);
    u32x2 o; o[0] = pack2(v[i][0] * rs * gg[0], v[i][1] * rs * gg[1]); o[1] = pack2(v[i][2] * rs * gg[2], v[i][3] * rs * gg[3]);
    *(u32x2*)(out + lane * 4 + 256 * i) = o;
  }
}
DI void norm_row_f32_inplace(float* __restrict__ x, const float* __restrict__ g, int lane) {
  f32x4 v[4]; float ss = 0.f;
#pragma unroll
  for (int i = 0; i < 4; ++i) { v[i] = *(const f32x4*)(x + lane * 4 + 256 * i); ss += v[i][0] * v[i][0] + v[i][1] * v[i][1] + v[i][2] * v[i][2] + v[i][3] * v[i][3]; }
  ss = wave_sum(ss);
  const float rs = rsqrtf(ss * (1.0f / 1024.0f) + 1e-6f);
#pragma unroll
  for (int i = 0; i < 4; ++i) {
    const f32x4 gg = *(const f32x4*)(g + lane * 4 + 256 * i);
    f32x4 o; o[0] = v[i][0] * rs * gg[0]; o[1] = v[i][1] * rs * gg[1]; o[2] = v[i][2] * rs * gg[2]; o[3] = v[i][3] * rs * gg[3];
    *(f32x4*)(x + lane * 4 + 256 * i) = o;
  }
}

namespace pg8 {
#define PG8_LAS __attribute__((address_space(3)))
typedef unsigned short bf16_t;
typedef short bf16x8 __attribute__((ext_vector_type(8)));
typedef float f32x4 __attribute__((ext_vector_type(4)));
typedef unsigned u32x4 __attribute__((ext_vector_type(4)));
constexpr int BM = 256, BK = 64, HALF = 128, HTB = HALF * BK * 2  , STAGE_BYTES = 8 * HTB, NXCD = 8, WGM = 8;

__host__ __device__ __forceinline__ int lds_byte(int r, int c) { const int st = (r >> 4) * 2 + (c >> 5), rr = r & 15, cc = c & 31, ob = rr * 64 + cc * 2; return st * 1024 + (ob ^ (((ob >> 9) & 1) << 5)); }
__host__ __device__ __forceinline__ void stage_rc(int b, int& R, int& C) { const int st = b / 1024, sb = b % 1024, swz = sb ^ (((sb >> 9) & 1) << 5); R = (st >> 1) * 16 + swz / 64; C = (st & 1) * 32 + (swz % 64) / 2; }
__host__ __device__ __forceinline__ int perm32(int rho) { const int n = rho >> 4, i = rho & 15; return 8 * (i >> 2) + 4 * n + (i & 3); }

struct Unit { int pm, pn; };
struct Gemm { const bf16_t* A; const bf16_t* Bt; int M, N, K; };

struct StaticOrder {
    int nM, nN, nwg, G, c;
    __host__ __device__ void init(int M, int N, int G_, int c_) { nM = M / BM; nN = N / BM; nwg = nM * nN; G = G_; c = c_; }
    __host__ __device__ bool next(int i, Unit& u) const {
        const long L = (long)i * G + c; if (L >= nwg) return false;
        int wgid = (int)L; { const int q = nwg / NXCD, r = nwg % NXCD, xcd = wgid % NXCD, off = wgid / NXCD; wgid = (xcd < r ? xcd * (q + 1) : r * (q + 1) + (xcd - r) * q) + off; }
        const int nig = WGM * nN, gid = wgid / nig, fm = gid * WGM, gsz = (nM - fm) < WGM ? (nM - fm) : WGM;
        u.pm = fm + ((wgid % nig) % gsz); u.pn = (wgid % nig) / gsz; return true;
    }
    __device__ __forceinline__ void a_ready(const Unit&) const {}
    __device__ __forceinline__ void done(const Unit&) const {}
};

template <class Epi, class Sched, bool STAMP = false>
__device__ __forceinline__ void gemm_phase(PG8_LAS unsigned char* lds, const Gemm g, const Sched& S, const Epi& E, unsigned long long* stamps) {
    const int tid = otid(), wid = __builtin_amdgcn_readfirstlane(tid >> 6), lane = tid & 63, wr = wid >> 2, wc = wid & 3, fr = lane & 15, fq = lane >> 4;
    const int K = g.K, nt = K / BK;
    int ts_lo = 0, ts_hi = 0, nts = 0; const unsigned long long rt_entry = STAMP ? (unsigned long long)wall_clock64() : 0ull;
#define PG8_STAMP() do { if (STAMP && wid == 0 && nts < 64) { const unsigned long long _c = (unsigned long long)clock64(); \
        ts_lo = (lane == nts) ? (int)(unsigned)_c : ts_lo; ts_hi = (lane == nts) ? (int)(unsigned)(_c >> 32) : ts_hi; ++nts; } } while (0)
    PG8_STAMP();
    unsigned voffA[2], voffB[2];
#pragma unroll
    for (int i = 0; i < 2; ++i) { int R, C; stage_rc(tid * 16 + i * 8192, R, C); const int Rb = E.perm ? ((R & ~31) + perm32(R & 31)) : R;
        voffA[i] = (unsigned)(R * K + C) * 2u; voffB[i] = (unsigned)(Rb * K + C) * 2u; }
    const size_t kstep = (size_t)(BK * 2);
    const size_t hstep = (size_t)HALF * K * 2;
    const size_t tstep = 2 * hstep;
    const unsigned ldsw = (unsigned)wid * 1024u;
    const int aoff = lds_byte(wr * 64 + fr, fq * 8), boff = lds_byte(wc * 32 + fr, fq * 8);
#define PG8_SA(b, h) (((b) * 2 + (h)) * HTB)
#define PG8_SB(b, h) ((4 + (b) * 2 + (h)) * HTB)
#define PG8_STAGE(bufoff, gbase, voff) do { _Pragma("unroll") for (int _i = 0; _i < 2; ++_i) \
        __builtin_amdgcn_global_load_lds((const unsigned*)((const char*)(gbase) + (voff)[_i]), (PG8_LAS unsigned*)(lds + (bufoff) + ldsw + _i * 8192), 16, 0, 0); } while (0)
#define PG8_LDA(dst, b, h) do { _Pragma("unroll") for (int m = 0; m < 4; ++m) _Pragma("unroll") for (int k = 0; k < 2; ++k) dst[m][k] = *(const PG8_LAS bf16x8*)(lds + PG8_SA(b, h) + aoff + m * 2048 + k * 1024); } while (0)
#define PG8_LDB(dst, b, h) do { _Pragma("unroll") for (int n = 0; n < 2; ++n) _Pragma("unroll") for (int k = 0; k < 2; ++k) dst[n][k] = *(const PG8_LAS bf16x8*)(lds + PG8_SB(b, h) + boff + n * 2048 + k * 1024); } while (0)
#define PG8_MMA(ai, bj, At, Bt) do { __builtin_amdgcn_s_setprio(1); _Pragma("unroll") for (int m = 0; m < 4; ++m) _Pragma("unroll") for (int n = 0; n < 2; ++n) _Pragma("unroll") for (int k = 0; k < 2; ++k) \
        acc[ai][bj][m][n] = __builtin_amdgcn_mfma_f32_16x16x32_bf16(Bt[n][k], At[m][k], acc[ai][bj][m][n], 0, 0, 0); __builtin_amdgcn_s_setprio(0); } while (0)
#define PG8_WAIT_V(n) asm volatile("s_waitcnt vmcnt(" #n ")" ::: "memory")
#define PG8_WAIT_L(n) asm volatile("s_waitcnt lgkmcnt(" #n ")" ::: "memory")
#define PG8_BAR __builtin_amdgcn_s_barrier()
#define PG8_SCHED __builtin_amdgcn_sched_barrier(0)
    Unit cur, nxt; int ui = 0;
    if (!S.next(0, cur)) return;
    f32x4 acc[2][2][4][2];
#pragma unroll
    for (int a = 0; a < 2; ++a)
#pragma unroll
        for (int b = 0; b < 2; ++b)
#pragma unroll
            for (int m = 0; m < 4; ++m)
#pragma unroll
                for (int n = 0; n < 2; ++n) acc[a][b][m][n] = (f32x4){0.f, 0.f, 0.f, 0.f};
    bf16x8 At[4][2], B0[2][2], B1[2][2];
    const char* cA = (const char*)g.A + (size_t)cur.pm * tstep; const char* cB = (const char*)g.Bt + (size_t)cur.pn * tstep;
    S.a_ready(cur);
    PG8_STAGE(PG8_SB(0, 0), cB, voffB); PG8_STAGE(PG8_SA(0, 0), cA, voffA); PG8_STAGE(PG8_SB(0, 1), cB + hstep, voffB); PG8_STAGE(PG8_SA(0, 1), cA + hstep, voffA);
    if (wr == 1) PG8_BAR;
    PG8_WAIT_V(4); PG8_BAR;
    PG8_STAGE(PG8_SB(1, 0), cB + kstep, voffB); PG8_STAGE(PG8_SA(1, 0), cA + kstep, voffA); PG8_STAGE(PG8_SB(1, 1), cB + hstep + kstep, voffB);
    PG8_WAIT_V(6); PG8_BAR;
    PG8_STAMP();
    for (;;) {
        const bool has_next = S.next(ui + 1, nxt);
        const char* nA = has_next ? (const char*)g.A + (size_t)nxt.pm * tstep : cA; const char* nB = has_next ? (const char*)g.Bt + (size_t)nxt.pn * tstep : cB;
        for (int t = 0; t < nt; t += 2) {
            const bool last = (t == nt - 2);
            const char* a1 = cA + (size_t)(t + 1) * kstep;
            const char* a2 = last ? nA : cA + (size_t)(t + 2) * kstep; const char* b2 = last ? nB : cB + (size_t)(t + 2) * kstep;
            const char* a3 = a2 + kstep; const char* b3 = b2 + kstep;
            if (last && has_next) S.a_ready(nxt);
            PG8_LDB(B0, 0, 0); PG8_SCHED; PG8_LDA(At, 0, 0); PG8_STAGE(PG8_SA(1, 1), a1 + hstep, voffA);
            PG8_WAIT_L(8); PG8_BAR; PG8_WAIT_L(0); PG8_MMA(0, 0, At, B0); PG8_BAR; PG8_SCHED;
            PG8_LDB(B1, 0, 1); PG8_STAGE(PG8_SB(0, 0), b2, voffB);
            PG8_BAR; PG8_WAIT_L(0); PG8_MMA(0, 1, At, B1); PG8_BAR;
            PG8_LDA(At, 0, 1); PG8_STAGE(PG8_SA(0, 0), a2, voffA);
            PG8_BAR; PG8_WAIT_L(0); PG8_MMA(1, 0, At, B0); PG8_BAR; PG8_SCHED;
            PG8_STAGE(PG8_SB(0, 1), b2 + hstep, voffB);
            PG8_WAIT_V(6); PG8_BAR; PG8_MMA(1, 1, At, B1); PG8_BAR;
            PG8_LDB(B0, 1, 0); PG8_SCHED; PG8_LDA(At, 1, 0); PG8_STAGE(PG8_SA(0, 1), a2 + hstep, voffA);
            PG8_WAIT_L(8); PG8_BAR; PG8_WAIT_L(0); PG8_MMA(0, 0, At, B0); PG8_BAR; PG8_SCHED;
            PG8_LDB(B1, 1, 1); PG8_STAGE(PG8_SB(1, 0), b3, voffB);
            PG8_BAR; PG8_WAIT_L(0); PG8_MMA(0, 1, At, B1); PG8_BAR;
            PG8_LDA(At, 1, 1); PG8_STAGE(PG8_SA(1, 0), a3, voffA);
            PG8_BAR; PG8_WAIT_L(0); PG8_MMA(1, 0, At, B0); PG8_BAR; PG8_SCHED;
            PG8_STAGE(PG8_SB(1, 1), b3 + hstep, voffB);
            PG8_WAIT_V(6); PG8_BAR; PG8_MMA(1, 1, At, B1); PG8_BAR;
        }
        PG8_STAMP();
        if constexpr (!Epi::AFTER_DRAIN) { E(acc, cur, wr, wc, fr, fq); S.done(cur); }
        PG8_STAMP();
        if (!has_next) break;
#pragma unroll
        for (int a = 0; a < 2; ++a)
#pragma unroll
            for (int b = 0; b < 2; ++b)
#pragma unroll
                for (int m = 0; m < 4; ++m)
#pragma unroll
                    for (int n = 0; n < 2; ++n) acc[a][b][m][n] = (f32x4){0.f, 0.f, 0.f, 0.f};
        cur = nxt; cA = nA; cB = nB; ++ui;
    }
    PG8_WAIT_V(0);
    if (wr == 0) PG8_BAR;
    PG8_BAR;
    if constexpr (Epi::AFTER_DRAIN) { E.fused(acc, cur, wr, wc, fr, fq, lds, wid, lane); S.done(cur); }
    PG8_STAMP();
    if (STAMP && wid == 0) { stamps[lane] = lane < nts ? (((unsigned long long)(unsigned)ts_hi << 32) | (unsigned)ts_lo) : 0ull;
        if (lane == 62) stamps[62] = rt_entry; if (lane == 63) stamps[63] = (unsigned long long)wall_clock64(); }
#undef PG8_STAMP
#undef PG8_SA
#undef PG8_SB
#undef PG8_STAGE
#undef PG8_LDA
#undef PG8_LDB
#undef PG8_MMA
#undef PG8_WAIT_V
#undef PG8_WAIT_L
#undef PG8_BAR
#undef PG8_SCHED
}
}

enum { EPI_SWIGLU = 0, EPI_RESID = 1, EPI_PROJ = 2, EPI_MERGE = 3 };
struct AnyOrder : pg8::StaticOrder {
  bool merge3;
  __device__ __forceinline__ bool next(int i, pg8::Unit& u) const {
    if (!merge3) return pg8::StaticOrder::next(i, u);
    const int ti = i / 3, br = i - ti * 3; pg8::Unit t;
    if (!pg8::StaticOrder::next(ti, t)) return false;
    u.pm = t.pm + 64 * br; u.pn = t.pn + 4 * br; return true;
  }
};
struct EpiAny {
  static constexpr bool AFTER_DRAIN = false;
  int mode; bool perm;
  u16* O; int ldo; const float* xin; float* xout; float scale; const u16* gate; float* macc; int br;
  DI void operator()(const pg8::f32x4 (&acc)[2][2][4][2], const pg8::Unit& u, int wr, int wc, int fr, int fq) const {
    const int row0 = (u.pm & 63) * 256 + wr * 64 + fr;
    if (mode == EPI_SWIGLU) {
      const int col0 = u.pn * 128 + wc * 32 + 8 * fq;
#pragma unroll
      for (int ai = 0; ai < 2; ++ai)
#pragma unroll
        for (int m = 0; m < 4; ++m) {
          float v[8];
#pragma unroll
          for (int n = 0; n < 2; ++n)
#pragma unroll
            for (int e = 0; e < 4; ++e) { const float gv = acc[ai][0][m][n][e], uv = acc[ai][1][m][n][e]; v[4 * n + e] = gv * __builtin_amdgcn_rcpf(1.0f + __builtin_amdgcn_exp2f(-LOG2E * gv)) * uv; }
          u32x4 o; o[0] = pack2(v[0], v[1]); o[1] = pack2(v[2], v[3]); o[2] = pack2(v[4], v[5]); o[3] = pack2(v[6], v[7]);
          *(u32x4*)(O + (size_t)(row0 + ai * 128 + m * 16) * ldo + col0) = o;
        }
    } else if (mode == EPI_PROJ) {
      const int col0 = u.pn * 256 + wc * 32 + 8 * fq;
      const bool sg = (u.pn * 256 >= OFF_GATE);
#pragma unroll
      for (int ai = 0; ai < 2; ++ai)
#pragma unroll
        for (int m = 0; m < 4; ++m)
#pragma unroll
          for (int bj = 0; bj < 2; ++bj) {
            float v[8];
#pragma unroll
            for (int n = 0; n < 2; ++n)
#pragma unroll
              for (int e = 0; e < 4; ++e) { float t = acc[ai][bj][m][n][e]; if (sg) t = __builtin_amdgcn_rcpf(1.0f + __builtin_amdgcn_exp2f(-LOG2E * t)); v[4 * n + e] = t; }
            u32x4 o; o[0] = pack2(v[0], v[1]); o[1] = pack2(v[2], v[3]); o[2] = pack2(v[4], v[5]); o[3] = pack2(v[6], v[7]);
            *(u32x4*)(O + (size_t)(row0 + ai * 128 + m * 16) * INC + col0 + bj * 128) = o;
          }
    } else if (mode == EPI_RESID) {
      const int col0 = u.pn * 256 + wc * 32 + 4 * fq;
#pragma unroll
      for (int ai = 0; ai < 2; ++ai)
#pragma unroll
        for (int m = 0; m < 4; ++m)
#pragma unroll
          for (int bj = 0; bj < 2; ++bj)
#pragma unroll
            for (int n = 0; n < 2; ++n) {
              const size_t idx = (size_t)(row0 + ai * 128 + m * 16) * DM + col0 + bj * 128 + n * 16;
              f32x4 xv = *(const f32x4*)(xin + idx);
#pragma unroll
              for (int e = 0; e < 4; ++e) xv[e] += scale * acc[ai][bj][m][n][e];
              *(f32x4*)(xout + idx) = xv;
            }
    } else {
      const int col0 = (u.pn & 3) * 256 + wc * 32 + 4 * fq; const int br = u.pm >> 6;
#pragma unroll
      for (int ai = 0; ai < 2; ++ai)
#pragma unroll
        for (int m = 0; m < 4; ++m)
#pragma unroll
          for (int bj = 0; bj < 2; ++bj)
#pragma unroll
            for (int n = 0; n < 2; ++n) {
              const int row = row0 + ai * 128 + m * 16, col = col0 + bj * 128 + n * 16;
              const u32x2 gt = *(const u32x2*)(gate + (size_t)row * INC + OFF_GATE + br * DM + col);
              f32x4 v;
              v[0] = bflo(gt[0]) * acc[ai][bj][m][n][0]; v[1] = bfhi(gt[0]) * acc[ai][bj][m][n][1];
              v[2] = bflo(gt[1]) * acc[ai][bj][m][n][2]; v[3] = bfhi(gt[1]) * acc[ai][bj][m][n][3];
              const size_t idx = (size_t)row * DM + col;
              if (br > 0) { const f32x4 pv = *(const f32x4*)(macc + idx); v[0] += pv[0]; v[1] += pv[1]; v[2] += pv[2]; v[3] += pv[3]; }
              if (br < 2) *(f32x4*)(macc + idx) = v;
              else { u32x2 o; o[0] = pack2(v[0], v[1]); o[1] = pack2(v[2], v[3]); *(u32x2*)(outb_() + idx) = o; }
            }
    }
  }
  DI u16* outb_() const { return O; }
};

DI void qk_prep_item(const Params& P, int layer, u16* __restrict__ p, int L, int it, const float* __restrict__ rope) {
  const int tid = otid() & 255, lane = tid & 63, w = __builtin_amdgcn_readfirstlane(tid >> 6);
  const int u = it * 8 + w * 2 + (lane >> 5);
  const int tok = u / 10, hd = u - tok * 10;
  const int i = lane & 31;
  const int col0 = (hd < 8) ? (OFF_GQ + hd * 64) : (OFF_GK + (hd - 8) * 64);
  const float* gn = (hd < 8) ? (P.gqa_q_norm + layer * 64) : (P.gqa_k_norm + layer * 64);
  unsigned* ptr = (unsigned*)(p + (size_t)tok * INC + col0) + i;
  const unsigned v = *ptr;
  float a = bflo(v), b = bfhi(v);
  const float ss = half_sum(a * a + b * b);
  const float rs = rsqrtf(ss * (1.0f / 64.0f) + 1e-6f);
  a = a * rs * gn[2 * i]; b = b * rs * gn[2 * i + 1];
  const int tl = tok % L;
  const int jj = i & 15;
  const float* rt = rope + ((i < 16) ? ((tl >> 6) * 16 + jj) : (4096 + (tl & 63) * 16 + jj)) * 2;
  const float c = rt[0], s = rt[1];
  *ptr = pack2(a * c - b * s, a * s + b * c);
}

DI void transpose_item(const Params& P, int layer, const u16* __restrict__ p, int L, int kind, int ct, int tt, u16* __restrict__ dst, char* smem) {
  u16* tile = (u16*)smem;
  const int tid = otid() & 255;
  const int t0 = tt * 64;
  const int seq = t0 / L, tl0 = t0 - seq * L;
  const int C = (kind == 0) ? 128 : 512;
  __syncthreads();
  {
    const int col = tid & 63, r0 = tid >> 6;
    const int cidx = ct * 64 + col;
    if (kind < 2) {
      const int off = (kind == 0 ? OFF_GV : OFF_DV) + cidx;
#pragma unroll
      for (int i = 0; i < 16; ++i) { const int row = r0 + 4 * i; tile[col * 72 + row] = p[(size_t)(t0 + row) * INC + off]; }
    } else {
      const float* cw = P.hy_conv_w + layer * 3 * 1536; const float* cb = P.hy_conv_b + layer * 1536;
      const int c1 = 512 + cidx, c2 = 1024 + cidx;
      const float w10 = cw[c1], w11 = cw[1536 + c1], w12 = cw[3072 + c1], b1 = cb[c1];
      const float w20 = cw[c2], w21 = cw[1536 + c2], w22 = cw[3072 + c2], b2 = cb[c2];
#pragma unroll
      for (int i = 0; i < 16; ++i) {
        const int row = r0 + 4 * i; const int tl = tl0 + row;
        const u16* pr = p + (size_t)(t0 + row) * INC;
        const float xm1 = (tl > 0) ? bf2f(pr[c1 - INC]) : 0.f, x0 = bf2f(pr[c1]), xp1 = (tl < L - 1) ? bf2f(pr[c1 + INC]) : 0.f;
        const float vm1 = (tl > 0) ? bf2f(pr[c2 - INC]) : 0.f, v0 = bf2f(pr[c2]), vp1 = (tl < L - 1) ? bf2f(pr[c2 + INC]) : 0.f;
        const float x1c = xm1 * w10 + x0 * w11 + xp1 * w12 + b1;
        const float vc = vm1 * w20 + v0 * w21 + vp1 * w22 + b2;
        tile[col * 72 + row] = f2bf(vc * x1c);
      }
    }
  }
  __syncthreads();
  {
    const int c = tid >> 2, q = tid & 3;
    const u32x4 a = *(const u32x4*)(tile + c * 72 + q * 16), b = *(const u32x4*)(tile + c * 72 + q * 16 + 8);
    u16* d = dst + ((size_t)seq * C + ct * 64 + c) * L + tl0 + q * 16;
    *(u32x4*)d = a; *(u32x4*)(d + 8) = b;
  }
}

DI int kperm(int rho) { return (rho & ~0xC) | ((rho & 4) << 1) | ((rho & 8) >> 1); }
template <int DV, bool BIAS, bool SWAP>
DI void attn_tile(const u16* __restrict__ Qp, const u16* __restrict__ Kp, const u16* __restrict__ VTp, int L,
                  u16* __restrict__ Op, int ldo, int q0, const float* __restrict__ btab, char* smem) {
  constexpr int NDT = DV / 32;
  constexpr int VCH = DV / 64;
  constexpr int KS_SZ = 64 * 64, VS_SZ = DV * 64;
  constexpr int NL = 1 + VCH;
  u16* Ks = (u16*)smem;
  u16* Vs = Ks + 4 * KS_SZ;
  float* bt = (float*)(Vs + 3 * VS_SZ);
  const int tid = otid(), lane = tid & 63, w = __builtin_amdgcn_readfirstlane(tid >> 6), r = lane & 31, h = lane >> 5;
  const float sc = 0.125f * LOG2E;
  __syncthreads();
  if (BIAS) { for (int i = tid; i < 257; i += 512) bt[i] = btab[i]; }
  bf16x8 qf[4];
  {
    const u16* qrow = Qp + (size_t)(q0 + 32 * w + r) * INC + 8 * h;
#pragma unroll
    for (int s = 0; s < 4; ++s) qf[s] = *(const bf16x8*)(qrow + 16 * s);
  }
  const int qpos = q0 + 32 * w + r;
  f32x16 O[NDT];
#pragma unroll
  for (int d = 0; d < NDT; ++d)
#pragma unroll
    for (int q = 0; q < 16; ++q) O[d][q] = 0.f;
  float m = -INFINITY, l = 0.f;
  const int lrow = tid >> 3, lsw = (tid & 7) ^ ((tid >> 4) & 7);
  const u16* Kg0 = Kp + (size_t)kperm(lrow) * INC + lsw * 8;
  const u16* Vg = VTp + (size_t)lrow * L + lsw * 8;
  const int ksw = (r >> 1) & 7;
  const int nkb = L >> 6;
#define ATT_LOADK(tile, bufp) do { const int t__ = ((tile) < nkb) ? (tile) : nkb - 1; \
    __builtin_amdgcn_global_load_lds((const unsigned*)(Kg0 + ((size_t)t__ * 64) * INC), (unsigned*)((char*)(bufp) + tid * 16), 16, 0, 0); } while (0)
#define ATT_LOADV(tile, bufp) do { const int t__ = ((tile) < nkb) ? (tile) : nkb - 1; _Pragma("unroll") for (int i_ = 0; i_ < VCH; ++i_) \
    __builtin_amdgcn_global_load_lds((const unsigned*)(Vg + (size_t)(64 * i_) * L + (size_t)t__ * 64), (unsigned*)((char*)(bufp) + tid * 16 + i_ * 8192), 16, 0, 0); } while (0)
  f32x16 Sc[2];
  auto qk = [&](const u16* Kb) __attribute__((always_inline)) {
    bf16x8 kf[2][4];
#pragma unroll
    for (int kt = 0; kt < 2; ++kt)
#pragma unroll
      for (int s = 0; s < 4; ++s) kf[kt][s] = *(const bf16x8*)(Kb + (32 * kt + r) * 64 + (((2 * s + h) ^ ksw) << 3));
#pragma unroll
    for (int kt = 0; kt < 2; ++kt) {
#pragma unroll
      for (int q = 0; q < 16; ++q) Sc[kt][q] = 0.f;
#pragma unroll
      for (int s = 0; s < 4; ++s) Sc[kt] = MFMA(kf[kt][s], qf[s], Sc[kt]);
    }
    __builtin_amdgcn_sched_group_barrier(0x100, 8, 0);
    __builtin_amdgcn_sched_group_barrier(0x008, 8, 0);
  };
  bf16x8 pf[2][2];
  auto softmax = [&](int kb) __attribute__((always_inline)) {
    float cb = 0.f; bool near = false;
    if (BIAS) {
      const int kmin = kb * 64;
      near = !(kmin - (q0 + 255) >= 128 || q0 - (kmin + 63) >= 128);
      cb = (kmin > q0) ? bt[256] : bt[0];
      if (near) {
        const float isc = 1.0f / sc;
#pragma unroll
        for (int kt = 0; kt < 2; ++kt)
#pragma unroll
          for (int q = 0; q < 16; ++q) {
            int rel = kmin + 32 * kt + kperm(crow(q, h)) - qpos;
            rel = rel < -128 ? -128 : (rel > 128 ? 128 : rel);
            Sc[kt][q] += bt[rel + 128] * isc;
          }
        cb = 0.f;
      }
    }
    float mx = Sc[0][0];
#pragma unroll
    for (int kt = 0; kt < 2; ++kt)
#pragma unroll
      for (int q = 0; q < 16; ++q) mx = fmaxf(mx, Sc[kt][q]);
    mx = xhalf_max(mx);
    mx = __builtin_fmaf(mx, sc, cb);
    if (__any(mx > m + 6.0f)) {
      asm volatile("" ::: "memory");
      const float mn = fmaxf(m, mx);
      const float alpha = __builtin_amdgcn_exp2f(m - mn);
      m = mn; l *= alpha;
#pragma unroll
      for (int d = 0; d < NDT; ++d)
#pragma unroll
        for (int q = 0; q < 16; ++q) O[d][q] *= alpha;
    }
    const float nm = cb - m;
#pragma unroll
    for (int kt = 0; kt < 2; ++kt) {
#pragma unroll
      for (int q = 0; q < 16; ++q) {
        const float pv = __builtin_amdgcn_exp2f(__builtin_fmaf(Sc[kt][q], sc, nm));
        Sc[kt][q] = pv; l += pv;
      }
#pragma unroll
      for (int s = 0; s < 2; ++s) {
        u32x4 pk;
#pragma unroll
        for (int q = 0; q < 4; ++q) pk[q] = pack2(Sc[kt][8 * s + 2 * q], Sc[kt][8 * s + 2 * q + 1]);
        pf[kt][s] = __builtin_bit_cast(bf16x8, pk);
      }
    }
  };
  auto pv = [&](const u16* Vb) __attribute__((always_inline)) {
    bf16x8 vf[4][NDT];
#pragma unroll
    for (int ks = 0; ks < 4; ++ks)
#pragma unroll
      for (int d = 0; d < NDT; ++d) vf[ks][d] = *(const bf16x8*)(Vb + (32 * d + r) * 64 + (((2 * ks + h) ^ ksw) << 3));
#pragma unroll
    for (int ks = 0; ks < 4; ++ks)
#pragma unroll
      for (int d = 0; d < NDT; ++d) O[d] = MFMA(vf[ks][d], pf[ks >> 1][ks & 1], O[d]);
    __builtin_amdgcn_sched_group_barrier(0x100, 2 * NDT, 0);
    __builtin_amdgcn_sched_group_barrier(0x008, NDT, 0);
    __builtin_amdgcn_sched_group_barrier(0x100, NDT, 0);
    __builtin_amdgcn_sched_group_barrier(0x008, NDT, 0);
    __builtin_amdgcn_sched_group_barrier(0x100, NDT, 0);
    __builtin_amdgcn_sched_group_barrier(0x008, 2 * NDT, 0);
  };
  ATT_LOADK(0, Ks); ATT_LOADK(1, Ks + KS_SZ); ATT_LOADK(2, Ks + 2 * KS_SZ);
  ATT_LOADV(0, Vs); ATT_LOADV(1, Vs + VS_SZ);
  asm volatile("s_waitcnt vmcnt(0) lgkmcnt(0)\n\ts_barrier" ::: "memory");
  if (SWAP) qk(Ks);
  int r0 = 0, r2 = 2;
  for (int kb = 0; kb < nkb; ++kb) {
    ATT_LOADK(kb + 3, Ks + ((kb + 3) & 3) * KS_SZ);
    ATT_LOADV(kb + 2, Vs + r2 * VS_SZ);
    if (!SWAP) qk(Ks + (kb & 3) * KS_SZ);
    softmax(kb);
    pv(Vs + r0 * VS_SZ);
    if (SWAP) qk(Ks + ((kb + 1) & 3) * KS_SZ);
    asm volatile("s_waitcnt vmcnt(%0) lgkmcnt(0)\n\ts_barrier" :: "n"(NL) : "memory");
    r2 = r0; r0 = (r0 == 2) ? 0 : r0 + 1;
  }
  asm volatile("s_waitcnt vmcnt(0)" ::: "memory");
#undef ATT_LOADK
#undef ATT_LOADV
  l += __shfl_xor(l, 32);
  const float inv = __builtin_amdgcn_rcpf(l);
  int ldo2 = ldo; asm volatile("" : "+s"(ldo2));
  u16* orow = Op + (size_t)qpos * ldo2;
#pragma unroll
  for (int d = 0; d < NDT; ++d)
#pragma unroll
    for (int g4 = 0; g4 < 4; ++g4) {
      u32x2 o; o[0] = pack2(O[d][4 * g4] * inv, O[d][4 * g4 + 1] * inv); o[1] = pack2(O[d][4 * g4 + 2] * inv, O[d][4 * g4 + 3] * inv);
      *(u32x2*)(orow + 32 * d + 8 * g4 + 4 * h) = o;
    }
}

DI void attn_tile2(const u16* __restrict__ Qp, const u16* __restrict__ Kp, const u16* __restrict__ VTp, int L,
                   u16* __restrict__ Op, int ldo, int q0, char* smem) {
  constexpr int DV = 64, NDT = 2, VCH = 1, RT = 2;
  constexpr int KS_SZ = 64 * 64, VS_SZ = DV * 64;
  constexpr int NL = 1 + VCH;
  u16* Ks = (u16*)smem;
  u16* Vs = Ks + 4 * KS_SZ;
  const int tid = otid(), lane = tid & 63, w = __builtin_amdgcn_readfirstlane(tid >> 6), r = lane & 31, h = lane >> 5;
  const float sc = 0.125f * LOG2E;
  __syncthreads();
  bf16x8 qf[RT][4];
#pragma unroll
  for (int t = 0; t < RT; ++t) {
    const u16* qrow = Qp + (size_t)(q0 + 64 * w + 32 * t + r) * INC + 8 * h;
#pragma unroll
    for (int s = 0; s < 4; ++s) qf[t][s] = *(const bf16x8*)(qrow + 16 * s);
  }
  f32x16 O[RT][NDT];
#pragma unroll
  for (int t = 0; t < RT; ++t)
#pragma unroll
    for (int d = 0; d < NDT; ++d)
#pragma unroll
      for (int q = 0; q < 16; ++q) O[t][d][q] = 0.f;
  float m[RT], l[RT];
#pragma unroll
  for (int t = 0; t < RT; ++t) { m[t] = -INFINITY; l[t] = 0.f; }
  const int lrow = tid >> 3, lsw = (tid & 7) ^ ((tid >> 4) & 7);
  const u16* Kg0 = Kp + (size_t)kperm(lrow) * INC + lsw * 8;
  const u16* Vg = VTp + (size_t)lrow * L + lsw * 8;
  const int ksw = (r >> 1) & 7;
  const int nkb = L >> 6;
#define ATT_LOADK(tile, bufp) do { const int t__ = ((tile) < nkb) ? (tile) : nkb - 1; \
    __builtin_amdgcn_global_load_lds((const unsigned*)(Kg0 + ((size_t)t__ * 64) * INC), (unsigned*)((char*)(bufp) + tid * 16), 16, 0, 0); } while (0)
#define ATT_LOADV(tile, bufp) do { const int t__ = ((tile) < nkb) ? (tile) : nkb - 1; \
    __builtin_amdgcn_global_load_lds((const unsigned*)(Vg + (size_t)t__ * 64), (unsigned*)((char*)(bufp) + tid * 16), 16, 0, 0); } while (0)
  ATT_LOADK(0, Ks); ATT_LOADK(1, Ks + KS_SZ); ATT_LOADK(2, Ks + 2 * KS_SZ);
  ATT_LOADV(0, Vs); ATT_LOADV(1, Vs + VS_SZ);
  asm volatile("s_waitcnt vmcnt(0) lgkmcnt(0)\n\ts_barrier" ::: "memory");
  int r0 = 0, r2 = 2;
  for (int kb = 0; kb < nkb; ++kb) {
    ATT_LOADK(kb + 3, Ks + ((kb + 3) & 3) * KS_SZ);
    ATT_LOADV(kb + 2, Vs + r2 * VS_SZ);
    const u16* Kb = Ks + (kb & 3) * KS_SZ; const u16* Vb = Vs + r0 * VS_SZ;
    f32x16 Sc[RT][2];
    {
      bf16x8 kf[2][4];
#pragma unroll
      for (int kt = 0; kt < 2; ++kt)
#pragma unroll
        for (int s = 0; s < 4; ++s) kf[kt][s] = *(const bf16x8*)(Kb + (32 * kt + r) * 64 + (((2 * s + h) ^ ksw) << 3));
#pragma unroll
      for (int t = 0; t < RT; ++t)
#pragma unroll
        for (int kt = 0; kt < 2; ++kt) {
#pragma unroll
          for (int q = 0; q < 16; ++q) Sc[t][kt][q] = 0.f;
#pragma unroll
          for (int s = 0; s < 4; ++s) Sc[t][kt] = MFMA(kf[kt][s], qf[t][s], Sc[t][kt]);
        }
      __builtin_amdgcn_sched_group_barrier(0x100, 8, 0);
      __builtin_amdgcn_sched_group_barrier(0x008, 16, 0);
    }
    bf16x8 pf[RT][2][2];
#pragma unroll
    for (int t = 0; t < RT; ++t) {
      float mx = Sc[t][0][0];
#pragma unroll
      for (int kt = 0; kt < 2; ++kt)
#pragma unroll
        for (int q = 0; q < 16; ++q) mx = fmaxf(mx, Sc[t][kt][q]);
      mx = xhalf_max(mx);
      mx *= sc;
      if (__any(mx > m[t] + 6.0f)) {
        asm volatile("" ::: "memory");
        const float mn = fmaxf(m[t], mx);
        const float alpha = __builtin_amdgcn_exp2f(m[t] - mn);
        m[t] = mn; l[t] *= alpha;
#pragma unroll
        for (int d = 0; d < NDT; ++d)
#pragma unroll
          for (int q = 0; q < 16; ++q) O[t][d][q] *= alpha;
      }
      const float nm = -m[t];
#pragma unroll
      for (int kt = 0; kt < 2; ++kt) {
#pragma unroll
        for (int q = 0; q < 16; ++q) { const float pv = __builtin_amdgcn_exp2f(__builtin_fmaf(Sc[t][kt][q], sc, nm)); Sc[t][kt][q] = pv; l[t] += pv; }
#pragma unroll
        for (int s = 0; s < 2; ++s) {
          u32x4 pk;
#pragma unroll
          for (int q = 0; q < 4; ++q) pk[q] = pack2(Sc[t][kt][8 * s + 2 * q], Sc[t][kt][8 * s + 2 * q + 1]);
          pf[t][kt][s] = __builtin_bit_cast(bf16x8, pk);
        }
      }
    }
    {
      bf16x8 vf[4][NDT];
#pragma unroll
      for (int ks = 0; ks < 4; ++ks)
#pragma unroll
        for (int d = 0; d < NDT; ++d) vf[ks][d] = *(const bf16x8*)(Vb + (32 * d + r) * 64 + (((2 * ks + h) ^ ksw) << 3));
#pragma unroll
      for (int ks = 0; ks < 4; ++ks)
#pragma unroll
        for (int d = 0; d < NDT; ++d)
#pragma unroll
          for (int t = 0; t < RT; ++t) O[t][d] = MFMA(vf[ks][d], pf[t][ks >> 1][ks & 1], O[t][d]);
      __builtin_amdgcn_sched_group_barrier(0x100, 4, 0);
      __builtin_amdgcn_sched_group_barrier(0x008, 4, 0);
      __builtin_amdgcn_sched_group_barrier(0x100, 4, 0);
      __builtin_amdgcn_sched_group_barrier(0x008, 12, 0);
    }
    asm volatile("s_waitcnt vmcnt(%0) lgkmcnt(0)\n\ts_barrier" :: "n"(NL) : "memory");
    r2 = r0; r0 = (r0 == 2) ? 0 : r0 + 1;
  }
  asm volatile("s_waitcnt vmcnt(0)" ::: "memory");
#undef ATT_LOADK
#undef ATT_LOADV
  int ldo2 = ldo; asm volatile("" : "+s"(ldo2));
#pragma unroll
  for (int t = 0; t < RT; ++t) {
    float lt = l[t]; lt += __shfl_xor(lt, 32);
    const float inv = __builtin_amdgcn_rcpf(lt);
    u16* orow = Op + (size_t)(q0 + 64 * w + 32 * t + r) * ldo2;
#pragma unroll
    for (int d = 0; d < NDT; ++d)
#pragma unroll
      for (int g4 = 0; g4 < 4; ++g4) {
        u32x2 o; o[0] = pack2(O[t][d][4 * g4] * inv, O[t][d][4 * g4 + 1] * inv); o[1] = pack2(O[t][d][4 * g4 + 2] * inv, O[t][d][4 * g4 + 3] * inv);
        *(u32x2*)(orow + 32 * d + 8 * g4 + 4 * h) = o;
      }
  }
}

template <int ILO, int IHI>
DI void hy_seg(int lo, int hi, f32x16 (&acc)[4], const u16* fw, const u16* fw1, const u16* zs, const int (&tq)[4], const int (&tJ)[4],
               int ZLP8, int L, int wb, int r, int h) {
  if (lo > hi) return;
  const int idx0 = L - lo - r + 8 * h - wb;
  const unsigned* ap = (idx0 & 1) ? (const unsigned*)(fw1 + idx0 - 1) : (const unsigned*)(fw + idx0);
  const u16* zq[4]; int cs[4];
#pragma unroll
  for (int i = ILO; i <= IHI; ++i) { zq[i] = zs + tq[i] * ZLP8; cs[i] = (1024 + 1024 * tJ[i] + 32 * r - lo + 8 * h) >> 3; }
  const int n = ((hi - lo) >> 4) + 1;
  bf16x8 a, b[4];
  { u32x4 av; av[0] = ap[0]; av[1] = ap[1]; av[2] = ap[2]; av[3] = ap[3]; a = __builtin_bit_cast(bf16x8, av); }
#pragma unroll
  for (int i = ILO; i <= IHI; ++i) b[i] = *(const bf16x8*)(zq[i] + ((cs[i] + (cs[i] >> 2)) << 3));
  for (int k = 0; k < n; ++k) {
    ap -= 8;
    bf16x8 an, c[4];
    { u32x4 av; av[0] = ap[0]; av[1] = ap[1]; av[2] = ap[2]; av[3] = ap[3]; an = __builtin_bit_cast(bf16x8, av); }
#pragma unroll
    for (int i = ILO; i <= IHI; ++i) { cs[i] -= 2; c[i] = *(const bf16x8*)(zq[i] + ((cs[i] + (cs[i] >> 2)) << 3)); }
#pragma unroll
    for (int i = ILO; i <= IHI; ++i) acc[i] = MFMA(a, b[i], acc[i]);
    a = an;
#pragma unroll
    for (int i = ILO; i <= IHI; ++i) b[i] = c[i];
  }
}

DI void hyena_item(int c, const u16* __restrict__ G, const u16* __restrict__ zT, u16* __restrict__ yT, int nseq, int L, char* smem) {
  u16* zs = (u16*)smem;
  u16* fw = zs + 25600;
  u16* fw1 = fw + 4224;
  const int tid = otid() & 255, lane = tid & 63, w = __builtin_amdgcn_readfirstlane(tid >> 6), r = lane & 31, h = lane >> 5;
  const int ZL = L + 2048;
  const int ZLP8 = ((ZL >> 3) + (ZL >> 5)) << 3;
  __syncthreads();
  for (int q = 0; q < nseq; ++q) {
    const u16* src = zT + ((size_t)q * 512 + c) * L;
    u16* dst = zs + q * ZLP8;
    const u32x4 zero = {0u, 0u, 0u, 0u};
    for (int i = tid; i < 128; i += 256) { const int c0 = i, c1 = 128 + (L >> 3) + i; *(u32x4*)(dst + ((c0 + (c0 >> 2)) << 3)) = zero; *(u32x4*)(dst + ((c1 + (c1 >> 2)) << 3)) = zero; }
    for (int i = tid; i < (L >> 3); i += 256) { const int cc = 128 + i; *(u32x4*)(dst + ((cc + (cc >> 2)) << 3)) = *(const u32x4*)(src + i * 8); }
  }
  int tq[4], tJ[4];
#pragma unroll
  for (int i = 0; i < 4; ++i) { if (nseq == 2) { tq[i] = i & 1; tJ[i] = 2 * w + (i >> 1); } else { tq[i] = 0; tJ[i] = 4 * w + i; } }
  f32x16 acc[4];
#pragma unroll
  for (int i = 0; i < 4; ++i)
#pragma unroll
    for (int q = 0; q < 16; ++q) acc[i][q] = 0.f;
  const int E0 = -L + 16, ELAST = L - 32;
  const int npass = (2 * L - 32 + 4095) / 4096;
  const u16* Gc = G + (size_t)c * (2 * L);
  for (int ps = 0; ps < npass; ++ps) {
    const int ea = E0 + 4096 * ps, eb = ea + 4096;
    const int wb = L - eb - 16;
    __syncthreads();
    for (int i = tid; i < 520; i += 256) {
      const int gi = wb + i * 8;
      u32x4 v = {0u, 0u, 0u, 0u};
      if (gi >= 0 && gi < 2 * L) v = *(const u32x4*)(Gc + gi);
      *(u32x4*)(fw + i * 8) = v;
    }
    __syncthreads();
    for (int i = tid; i < 2079; i += 256) { const unsigned lo = ((const unsigned*)fw)[i], hi = ((const unsigned*)fw)[i + 1]; ((unsigned*)fw1)[i] = (lo >> 16) | (hi << 16); }
    __syncthreads();
    const int eend = (eb - 16 < ELAST) ? (eb - 16) : ELAST;
    int emn[4], emx[4];
#pragma unroll
    for (int i = 0; i < 4; ++i) { emn[i] = 1024 * tJ[i] - L + 16; emx[i] = 1024 * tJ[i] + 992; }
#define HY_CLIP_LO(v) ((v) < ea ? ea : (v))
#define HY_CLIP_HI(v) ((v) > eend ? eend : (v))
    hy_seg<0, 0>(HY_CLIP_LO(emn[0]), HY_CLIP_HI(emn[1] - 16), acc, fw, fw1, zs, tq, tJ, ZLP8, L, wb, r, h);
    hy_seg<0, 1>(HY_CLIP_LO(emn[1]), HY_CLIP_HI(emn[2] - 16), acc, fw, fw1, zs, tq, tJ, ZLP8, L, wb, r, h);
    hy_seg<0, 2>(HY_CLIP_LO(emn[2]), HY_CLIP_HI(emn[3] - 16), acc, fw, fw1, zs, tq, tJ, ZLP8, L, wb, r, h);
    hy_seg<0, 3>(HY_CLIP_LO(emn[3]), HY_CLIP_HI(emx[0]), acc, fw, fw1, zs, tq, tJ, ZLP8, L, wb, r, h);
    hy_seg<1, 3>(HY_CLIP_LO(emx[0] + 16), HY_CLIP_HI(emx[1]), acc, fw, fw1, zs, tq, tJ, ZLP8, L, wb, r, h);
    hy_seg<2, 3>(HY_CLIP_LO(emx[1] + 16), HY_CLIP_HI(emx[2]), acc, fw, fw1, zs, tq, tJ, ZLP8, L, wb, r, h);
    hy_seg<3, 3>(HY_CLIP_LO(emx[2] + 16), HY_CLIP_HI(emx[3]), acc, fw, fw1, zs, tq, tJ, ZLP8, L, wb, r, h);
#undef HY_CLIP_LO
#undef HY_CLIP_HI
  }
#pragma unroll
  for (int i = 0; i < 4; ++i) {
    u16* dst = yT + ((size_t)tq[i] * 512 + c) * L + 1024 * tJ[i] + 32 * r + 4 * h;
#pragma unroll
    for (int g4 = 0; g4 < 4; ++g4) {
      u32x2 o; o[0] = pack2(acc[i][4 * g4], acc[i][4 * g4 + 1]); o[1] = pack2(acc[i][4 * g4 + 2], acc[i][4 * g4 + 3]);
      *(u32x2*)(dst + 8 * g4) = o;
    }
  }
}

DI void diff_post_item(const Params& P, int layer, float lam, float lam_init, const u16* __restrict__ dO, u16* __restrict__ ydf, int it) {
  const int tid = otid() & 255, lane = tid & 63, w = __builtin_amdgcn_readfirstlane(tid >> 6);
  const int u = it * 8 + w * 2 + (lane >> 5);
  const int i = lane & 31;
  const u32x2 a = *(const u32x2*)(dO + (size_t)u * 256 + 4 * i);
  const u32x2 b = *(const u32x2*)(dO + (size_t)u * 256 + 128 + 4 * i);
  float o[4];
  o[0] = bflo(a[0]) - lam * bflo(b[0]); o[1] = bfhi(a[0]) - lam * bfhi(b[0]);
  o[2] = bflo(a[1]) - lam * bflo(b[1]); o[3] = bfhi(a[1]) - lam * bfhi(b[1]);
  const float ss = half_sum(o[0] * o[0] + o[1] * o[1] + o[2] * o[2] + o[3] * o[3]);
  const float rs = rsqrtf(ss * (1.0f / 128.0f) + 1e-5f) * (1.0f - lam_init);
  const float* g = P.diff_subln + layer * 128 + 4 * i;
  u32x2 ov; ov[0] = pack2(o[0] * rs * g[0], o[1] * rs * g[1]); ov[1] = pack2(o[2] * rs * g[2], o[3] * rs * g[3]);
  *(u32x2*)(ydf + (size_t)u * 128 + 4 * i) = ov;
}
DI void hyena_post_item(const Params& P, int layer, const u16* __restrict__ p, int L, const u16* __restrict__ yT, const u16* __restrict__ zT,
                        int ct, int tt, u16* __restrict__ yhy, char* smem) {
  float* tile = (float*)smem;
  const int tid = otid() & 255;
  const int t0 = tt * 64; const int seq = t0 / L, tl0 = t0 - seq * L;
  __syncthreads();
  {
    const int tcol = tid & 63, c0 = tid >> 6;
#pragma unroll
    for (int i = 0; i < 16; ++i) {
      const int cc = c0 + 4 * i; const int c = ct * 64 + cc;
      const size_t gi = ((size_t)seq * 512 + c) * L + tl0 + tcol;
      tile[cc * 65 + tcol] = bf2f(yT[gi]) + bf2f(zT[gi]) * P.hy_skip[layer * 512 + c];
    }
  }
  __syncthreads();
  {
    const int col = tid & 63, r0 = tid >> 6; const int c = ct * 64 + col;
    const float* cw = P.hy_conv_w + layer * 3 * 1536; const float* cb = P.hy_conv_b + layer * 1536;
    const float w0 = cw[c], w1 = cw[1536 + c], w2 = cw[3072 + c], b0 = cb[c];
#pragma unroll
    for (int i = 0; i < 16; ++i) {
      const int row = r0 + 4 * i; const int tl = tl0 + row;
      const u16* pr = p + (size_t)(t0 + row) * INC + c;
      const float xm1 = (tl > 0) ? bf2f(pr[-INC]) : 0.f, x0 = bf2f(pr[0]), xp1 = (tl < L - 1) ? bf2f(pr[INC]) : 0.f;
      const float x0c = xm1 * w0 + x0 * w1 + xp1 * w2 + b0;
      yhy[(size_t)(t0 + row) * 512 + c] = f2bf(x0c * tile[col * 65 + row]);
    }
  }
}

__global__ void __launch_bounds__(512) fwd_megakernel(Params Parg) {
  cg::grid_group grid = cg::this_grid();
  extern __shared__ __attribute__((aligned(16))) char smem_dyn[];
  char* smem = smem_dyn + 16;
  uint4& xb_words = *(uint4*)smem_dyn;
  const int nb = gridDim.x, nb2 = nb * 2;
#define KPARAMS() const Params __attribute__((address_space(4)))* pp_ = (const Params __attribute__((address_space(4)))*)__builtin_amdgcn_kernarg_segment_ptr(); \
  asm volatile("" : "+s"(pp_)); const Params& P = *(const Params*)pp_; char* ws = P.ws
  if (threadIdx.x == 0) xb_words = make_uint4(0u, 0u, 0u, blockIdx.x);
  __syncthreads();
  XcdBarrier xb;
  { KPARAMS(); xb = xcd_barrier_post((unsigned*)(ws + O_BAR), (volatile LAS unsigned*)&xb_words); }

  for (int step = 0; step < 80; ++step) {
    const int layer = step / 40, ls = step - layer * 40;
    PHASE_IDS();
    KPARAMS();
    float* misc = (float*)(ws + O_MISC);
    u16* pbuf = (u16*)(ws + O_P); u16* hid = pbuf; u16* hn = (u16*)(ws + O_HN); u16* merged = hn;
    if (ls == 0) {
      u16* filt8 = (u16*)(ws + O_FILT8); u16* filt16 = (u16*)(ws + O_FILT16);
      const int n1 = 16 * 88, n2 = 44 * 16, n3 = 16 * 108, n4 = 3 * 8 * 16, n5 = 16 * 16;
      const int nfilt = 128 + 256;
      const int total = n1 + n2 + n3 + n4 + n5 + n1 + n2 + nfilt;
      for (int it = bid2; it < total; it += nb2) {
        int t = it;
        if (t < nfilt) {
          const bool big = t < 256;
          filter_item(P, layer, big ? 16384 : 8192, big ? t : t - 256, big ? filt16 : filt8, smg);
          continue;
        }
        t -= nfilt;
        const float* src; int K, N, kt, nt, ph = 0; u16* dst;
        if (t < n1) { src = P.ffn1_w_in + (size_t)layer * 1024 * 5632; K = 1024; N = 5632; dst = (u16*)(ws + O_F1IN); kt = t / 88; nt = t % 88; ph = 2816; }
        else if ((t -= n1) < n2) { src = P.ffn1_w_out + (size_t)layer * 2816 * 1024; K = 2816; N = 1024; dst = (u16*)(ws + O_F1OUT); kt = t / 16; nt = t % 16; }
        else if ((t -= n2) < n3) { src = P.w_in + (size_t)layer * 1024 * 6912; K = 1024; N = 6912; dst = (u16*)(ws + O_WIN); kt = t / 108; nt = t % 108; }
        else if ((t -= n3) < n4) { const int br = t / 128, tt = t % 128; src = P.w_branch + ((size_t)layer * 3 + br) * 512 * 1024; K = 512; N = 1024;
                                   dst = (u16*)(ws + O_WBR) + (size_t)br * 1024 * 512; kt = tt / 16; nt = tt % 16; }
        else if ((t -= n4) < n5) { src = P.w_out + (size_t)layer * 1024 * 1024; K = 1024; N = 1024; dst = (u16*)(ws + O_WOUT); kt = t / 16; nt = t % 16; }
        else if ((t -= n5) < n1) { src = P.ffn2_w_in + (size_t)layer * 1024 * 5632; K = 1024; N = 5632; dst = (u16*)(ws + O_F2IN); kt = t / 88; nt = t % 88; ph = 2816; }
        else { t -= n1; src = P.ffn2_w_out + (size_t)layer * 2816 * 1024; K = 2816; N = 1024; dst = (u16*)(ws + O_F2OUT); kt = t / 16; nt = t % 16; }
        convT_tile(src, K, N, dst, kt, nt, ph, smg);
      }
      if (bid == 1 && grp == 0 && layer == 0) {
        float* rope = (float*)(ws + O_ROPE);
        for (int i = t_; i < 320 * 16; i += 256) {
          const int pos = (i < 4096) ? (i >> 4) : ((i - 4096) >> 4); const int jj = i & 15;
          const float inv = powf(10000.0f, -(float)(2 * jj) / 32.0f);
          const float ang = (float)pos * inv;
          rope[2 * i] = cosf(ang); rope[2 * i + 1] = sinf(ang);
        }
      }
      if (bid == 0 && grp == 0) {
        const int tid = t_;
        if (tid < 2) {
          const float* lp = P.diff_lambda + tid * 256;
          float s1 = 0.f, s2 = 0.f;
          for (int i = 0; i < 64; ++i) { s1 += lp[i] * lp[64 + i]; s2 += lp[128 + i] * lp[192 + i]; }
          const float lam_init = 0.8f - 0.6f * expf(-0.3f * (float)tid);
          misc[tid] = expf(s1) - expf(s2) + lam_init;
        }
        for (int i = tid; i < 4 * 257; i += 256) {
          const int hh = i / 257, idx = i % 257; const int rel = idx - 128; const int n = rel < 0 ? -rel : rel;
          int b;
          if (n < 8) b = n; else { int lg = 8 + (int)(logf((float)n / 8.0f) / 2.772588722239781f * 8.0f); b = lg < 15 ? lg : 15; }
          if (rel > 0) b += 16;
          misc[64 + i] = P.rel_bias[b * 4 + hh] * LOG2E;
        }
      }
      if (step == 0) {
        grid.sync();
        if (threadIdx.x == 0) {
          unsigned* bar = (unsigned*)(ws + O_BAR); bool even = ((nb & 7) == 0);
          for (int j = 0; j < 16; ++j) { const unsigned c = xb_ld(&bar[XB_XCNT(j)]); if (c != ((j < 8) ? (unsigned)(nb >> 3) : 0u)) even = false; }
          volatile LAS unsigned* st = (volatile LAS unsigned*)&xb_words;
          if (even) st[3] = st[2] * 8u + xb.x;
        }
        __syncthreads();
      } else GSYNC();
      continue;
    }
    const int cs = ls - 1; const int ch = cs / 13, st = cs - ch * 13;
    const int nseq = (ch < 2) ? 2 : 1, L = (ch < 2) ? 8192 : 16384;
    const float* xin0 = (ch < 2) ? (P.x_prompt + (size_t)ch * TCH * DM) : P.x_sample;
    float* xres = P.out + (size_t)ch * TCH * DM;
    const float* xcur = (layer == 0) ? xin0 : xres;
    for (int rp_ = 0; rp_ <= ((REPMASK >> st) & 1); ++rp_) {
    if (st == 0 || st == 3 || st == 10) {
      const float* src = (st == 0) ? xcur : xres;
      const float* gn = ((st == 0) ? P.ffn1_norm : (st == 3 ? P.mix_norm : P.ffn2_norm)) + layer * DM;
      for (int it = bid2; it < TCH / 4; it += nb2) { const int row = it * 4 + w; norm_row_bf16(src + (size_t)row * DM, gn, hn + (size_t)row * DM, lane); }
    } else if (st == 1 || st == 2 || st == 4 || st == 8 || st == 9 || st == 11 || st == 12) {
      EpiAny E{}; const u16* A; const u16* Bt; int N, K;
      if (st == 1 || st == 11) { A = hn; Bt = (u16*)(ws + (st == 1 ? O_F1IN : O_F2IN)); N = 5632; K = DM; E.mode = EPI_SWIGLU; E.perm = true; E.O = hid; E.ldo = DFF; }
      else if (st == 2 || st == 12) { A = hid; Bt = (u16*)(ws + (st == 2 ? O_F1OUT : O_F2OUT)); N = DM; K = DFF; E.mode = EPI_RESID; E.perm = false;
                                      E.xin = (st == 2) ? xcur : xres; E.xout = xres; E.scale = 0.5f; }
      else if (st == 4) { A = hn; Bt = (u16*)(ws + O_WIN); N = INC; K = DM; E.mode = EPI_PROJ; E.perm = true; E.O = pbuf; }
      else if (st == 8) { A = (u16*)(ws + O_YHY); Bt = (u16*)(ws + O_WBR); N = DM; K = 512; E.mode = EPI_MERGE; E.perm = false; E.gate = pbuf; E.macc = (float*)(ws + O_ZT); E.O = merged; }
      else { A = merged; Bt = (u16*)(ws + O_WOUT); N = DM; K = DM; E.mode = EPI_RESID; E.perm = false; E.xin = xres; E.xout = xres; E.scale = 1.0f; }
      {
        pg8::Gemm gg{A, Bt, TCH, N, K};
        AnyOrder S; S.init(TCH, N, nb, bid); S.merge3 = (st == 8);
        pg8::gemm_phase<EpiAny, AnyOrder, false>((PG8_LAS unsigned char*)smem, gg, S, E, nullptr);
      }
    } else if (st == 5) {
      const int nqk = TCH * 10 / 8, ntr = 256 * 18;
      for (int it = bid2; it < nqk + ntr; it += nb2) {
        if (it < nqk) { qk_prep_item(P, layer, pbuf, L, it, (const float*)(ws + O_ROPE)); continue; }
        const int t = it - nqk; const int tt = t / 18, cc = t % 18;
        const int kind = (cc < 2) ? 0 : (cc < 10 ? 1 : 2);
        const int ct = (cc < 2) ? cc : (cc < 10 ? cc - 2 : cc - 10);
        u16* dst = (u16*)(ws + (kind == 0 ? O_VTG : (kind == 1 ? O_VTD : O_ZT)));
        transpose_item(P, layer, pbuf, L, kind, ct, tt, dst, smg);
      }
    } else if (st == 6) {
      u16* zT = (u16*)(ws + O_ZT); u16* yT = (u16*)(ws + O_YT); u16* dO = (u16*)(ws + O_DIFFO);
      u16* vtg = (u16*)(ws + O_VTG); u16* vtd = (u16*)(ws + O_VTD); u16* ygq = (u16*)(ws + O_YGQ);
      const u16* filt = (u16*)(ws + ((ch < 2) ? O_FILT8 : O_FILT16));
      const int nqt = L / 256;
      const int xcd = bid & 7, nxu = nb >> 3, nitem = nseq * nqt;
      for (int e = bid >> 3; e < nitem; e += nxu) {
        const int seq = e / nqt, qt = e - seq * nqt;
        const int hh = xcd >> 1, cc = xcd & 1;
        const size_t tb = (size_t)seq * L;
        const u16* Qd = pbuf + tb * INC + OFF_DQ + xcd * 64; const u16* Kd = pbuf + tb * INC + OFF_DK + xcd * 64;
        const u16* Vd = vtd + ((size_t)seq * 512 + hh * 128) * L; u16* Od = dO + tb * 1024 + (hh * 2 + cc) * 128;
        attn_tile<128, true, false>(Qd, Kd, Vd, L, Od, 1024, qt * 256, misc + 64 + hh * 257, smem);
      }
      {
        const int nqt2 = L / 512, nitem2 = nseq * nqt2;
        for (int e = bid >> 3; e < nitem2; e += nxu) {
          const int seq = e / nqt2, qt = e - seq * nqt2;
          const int kvh = xcd >> 2;
          const size_t tb = (size_t)seq * L;
          const u16* Qd = pbuf + tb * INC + OFF_GQ + xcd * 64; const u16* Kd = pbuf + tb * INC + OFF_GK + kvh * 64;
          const u16* Vd = vtg + ((size_t)seq * 128 + kvh * 64) * L; u16* Od = ygq + tb * 512 + xcd * 64;
          attn_tile2(Qd, Kd, Vd, L, Od, 512, qt * 512, smem);
        }
      }
      for (int c = bid2; c < 512; c += nb2) hyena_item(c, filt, zT, yT, nseq, L, smg);
    } else {
      u16* zT = (u16*)(ws + O_ZT); u16* yT = (u16*)(ws + O_YT); u16* dO = (u16*)(ws + O_DIFFO);
      u16* yhy = (u16*)(ws + O_YHY); u16* ydf = (u16*)(ws + O_YDF);
      const float lam = misc[layer];
      const float lam_init = 0.8f - 0.6f * expf(-0.3f * (float)layer);
      const int ndp = TCH * 4 / 8, nhp = 256 * 8;
      for (int it = bid2; it < ndp + nhp; it += nb2) {
        if (it < ndp) diff_post_item(P, layer, lam, lam_init, dO, ydf, it);
        else { const int t = it - ndp; hyena_post_item(P, layer, pbuf, L, yT, zT, t % 8, t / 8, yhy, smg); }
      }
    }
    }
    GSYNC();
  }
  { PHASE_IDS(); KPARAMS(); (void)ws;
    for (int it = bid2; it < NTOK / 4; it += nb2) { const int row = it * 4 + w; norm_row_f32_inplace(P.out + (size_t)row * DM, P.final_norm, lane); }
  }
}

extern "C" void kernel_launch(void* const* d_in, const int* in_sizes, int n_in, void* d_out, int out_size, void* d_ws, size_t ws_size,
                              hipStream_t stream) {
  static int grid_blocks = 0;
  if (!grid_blocks) {
    int dev = 0, cus = 0, per_cu = 0;
    (void)hipGetDevice(&dev);
    (void)hipDeviceGetAttribute(&cus, hipDeviceAttributeMultiprocessorCount, dev);
    (void)hipFuncSetAttribute((const void*)fwd_megakernel, hipFuncAttributeMaxDynamicSharedMemorySize, SMEM_BYTES + 16);
    (void)hipOccupancyMaxActiveBlocksPerMultiprocessor(&per_cu, fwd_megakernel, 512, SMEM_BYTES + 16);
    if (per_cu < 1) per_cu = 1;
    if (per_cu > 1) per_cu = 1;
    grid_blocks = cus * per_cu;
  }
  Params p{};
  const float* const* in = (const float* const*)d_in;
  p.x_prompt = in[0]; p.x_sample = in[1]; p.ffn1_norm = in[2]; p.ffn1_w_in = in[3]; p.ffn1_w_out = in[4]; p.mix_norm = in[5]; p.w_in = in[6];
  p.hy_conv_w = in[7]; p.hy_conv_b = in[8]; p.hy_w1 = in[9]; p.hy_b1 = in[10]; p.hy_w2 = in[11]; p.hy_b2 = in[12]; p.hy_w3 = in[13];
  p.hy_freq = in[14]; p.hy_skip = in[15]; p.gqa_q_norm = in[16]; p.gqa_k_norm = in[17]; p.diff_lambda = in[18]; p.diff_subln = in[19];
  p.rel_bias = in[20]; p.w_branch = in[21]; p.w_out = in[22]; p.ffn2_norm = in[23]; p.ffn2_w_in = in[24]; p.ffn2_w_out = in[25]; p.final_norm = in[26];
  p.out = (float*)d_out; p.ws = (char*)d_ws;
  void* args[] = {&p};
  (void)hipMemsetAsync((char*)d_ws + O_BAR, 0, XCD_BAR_WORDS * 4, stream);
  hipError_t e = hipLaunchCooperativeKernel((void*)fwd_megakernel, dim3(grid_blocks), dim3(512), args, SMEM_BYTES + 16, stream);
  if (e != hipSuccess) fprintf(stderr, "cooperative launch failed: %s (grid %d)\n", hipGetErrorString(e), grid_blocks);
}
```

```cpp
#include <hip/hip_runtime.h>
#include <hip/hip_cooperative_groups.h>
#include <stdint.h>
#include <cstdio>
namespace cg = cooperative_groups;

typedef unsigned short u16;
typedef __attribute__((ext_vector_type(8))) short bf16x8;
typedef __attribute__((ext_vector_type(16))) float f32x16;
typedef __attribute__((ext_vector_type(4))) float f32x4;
typedef __attribute__((ext_vector_type(4))) unsigned u32x4;
typedef __attribute__((ext_vector_type(2))) unsigned u32x2;
typedef __attribute__((ext_vector_type(2))) __bf16 bf2_t;
typedef __attribute__((ext_vector_type(2))) float f2_t;
#define DI __device__ __forceinline__
#define MFMA(a, b, c) __builtin_amdgcn_mfma_f32_32x32x16_bf16((a), (b), (c), 0, 0, 0)

constexpr int DM = 1024, DFF = 2816, INC = 6912, TCH = 16384, NTOK = 49152;
constexpr int OFF_GQ = 1536, OFF_GK = 2048, OFF_GV = 2176, OFF_DQ = 2304, OFF_DK = 2816, OFF_DV = 3328, OFF_GATE = 3840;
constexpr float LOG2E = 1.4426950408889634f;

constexpr size_t SZ_F1IN = (size_t)5632 * 1024 * 2, SZ_F1OUT = (size_t)1024 * 2816 * 2, SZ_WIN = (size_t)6912 * 1024 * 2,
                 SZ_WBR = (size_t)3 * 1024 * 512 * 2, SZ_WOUT = (size_t)1024 * 1024 * 2;
constexpr size_t O_F1IN = 0, O_F1OUT = O_F1IN + SZ_F1IN, O_WIN = O_F1OUT + SZ_F1OUT, O_WBR = O_WIN + SZ_WIN, O_WOUT = O_WBR + SZ_WBR,
                 O_F2IN = O_WOUT + SZ_WOUT, O_F2OUT = O_F2IN + SZ_F1IN, O_FILT8 = O_F2OUT + SZ_F1OUT,
                 O_FILT16 = O_FILT8 + (size_t)512 * 16384 * 2, O_MISC = O_FILT16 + (size_t)512 * 32768 * 2,
                 O_P = O_MISC + 131072, O_HN = O_P + (size_t)TCH * INC * 2, O_ZT = O_HN + (size_t)TCH * 1024 * 2,
                 O_YT = O_ZT + (size_t)TCH * 512 * 2, O_DIFFO = O_YT + (size_t)TCH * 512 * 2, O_VTG = O_DIFFO + (size_t)TCH * 1024 * 2,
                 O_VTD = O_VTG + (size_t)TCH * 128 * 2, O_YHY = O_VTD + (size_t)TCH * 512 * 2, O_YGQ = O_YHY + (size_t)TCH * 512 * 2,
                 O_YDF = O_YGQ + (size_t)TCH * 512 * 2, O_END = O_YDF + (size_t)TCH * 512 * 2;
static_assert(O_END <= (size_t)536870912, "workspace overflow");
constexpr int SMEM_BYTES = 151552;
constexpr int GRP_LDS = 75776;
#define REPMASK 0
#define REP_SYNC 1
#define PHASE_IDS() const int t_ = otid(); const int bid = __builtin_amdgcn_readfirstlane(((volatile LAS unsigned*)&xb_words)[3]); const int lane = t_ & 63; const int grp = __builtin_amdgcn_readfirstlane(t_ >> 8); \
  const int w = __builtin_amdgcn_readfirstlane((t_ >> 6) & 3); const int bid2 = bid * 2 + grp; char* smg = smem + grp * GRP_LDS; \
  const int vb = (bid & 7) * (nb >> 3) + (bid >> 3); (void)lane; (void)w; (void)bid2; (void)smg; (void)vb
#define GSYNC() do { for (int rs_ = 0; rs_ < REP_SYNC; ++rs_) xcd_barrier(xb); } while (0)


#define XB_TMO      128
#define XB_XCNT(j)  (256  + 64 * (j))
#define XB_XSUB(j)  (1280 + 64 * (j))
#define XB_XGEN(j)  (2304 + 64 * (j))
#define XB_TOP      3328
#define XB_TOPGEN   3392
#define XCD_BAR_WORDS 3456
#define XB_SPIN_CAP (1u << 21)
#define LAS __attribute__((address_space(3)))
DI unsigned xb_ld(unsigned* p)              { return __hip_atomic_load(p, __ATOMIC_RELAXED, __HIP_MEMORY_SCOPE_AGENT); }
DI unsigned xb_add(unsigned* p, unsigned v) { return __hip_atomic_fetch_add(p, v, __ATOMIC_RELAXED, __HIP_MEMORY_SCOPE_AGENT); }
DI unsigned xb_xcc_id() { return (unsigned)__builtin_amdgcn_s_getreg((3 << 11) | 20) & 0xFu; }
#define XB_SPIN(cond, bar) do { unsigned _sp = 0; while (cond) { __builtin_amdgcn_s_sleep(1); \
    if ((++_sp & 255u) == 0u) { if (xb_ld(&(bar)[XB_TMO])) break; if (_sp > XB_SPIN_CAP) { atomicAdd(&(bar)[XB_TMO], 1u); break; } } } } while (0)
struct XcdBarrier { unsigned* bar; unsigned x; volatile LAS unsigned* st; };
DI XcdBarrier xcd_barrier_post(unsigned* bar, volatile LAS unsigned* st) {
  XcdBarrier b; b.bar = bar; b.x = xb_xcc_id(); b.st = st;
  if (threadIdx.x == 0) { const unsigned rank = xb_add(&bar[XB_XCNT(b.x)], 1u); st[2] = rank; }
  return b;
}
DI void xcd_barrier_complete(unsigned* bar, unsigned x, unsigned& nloc, unsigned& nx) {
  const unsigned G = gridDim.x * gridDim.y * gridDim.z;
  unsigned sum, cnt, mine, sp = 0u;
  for (;;) {
    sum = 0u; cnt = 0u; mine = 0u;
#pragma unroll
    for (unsigned j = 0; j < 16; ++j) { const unsigned c = xb_ld(&bar[XB_XCNT(j)]); sum += c; cnt += (c > 0u) ? 1u : 0u; mine = (j == x) ? c : mine; }
    if (sum == G) break;
    __builtin_amdgcn_s_sleep(1);
    if ((++sp & 255u) == 0u) { if (xb_ld(&bar[XB_TMO])) break; if (sp > XB_SPIN_CAP) { atomicAdd(&bar[XB_TMO], 1u); break; } }
  }
  nloc = mine > 0u ? mine : 1u; nx = cnt > 0u ? cnt : 1u;
}
DI void xcd_barrier(const XcdBarrier& b) {
  asm volatile("s_waitcnt vmcnt(0)" ::: "memory");
  __syncthreads();
  if (threadIdx.x == 0) {
    unsigned* bar = b.bar;
    __builtin_amdgcn_s_waitcnt(0);
    unsigned nloc = b.st[0], nx = b.st[1];
    if (nloc == 0u) { xcd_barrier_complete(bar, b.x, nloc, nx); b.st[0] = nloc; b.st[1] = nx; }
    const unsigned old = xb_add(&bar[XB_XSUB(b.x)], 1u);
    const unsigned gen = old / nloc;
    if (old + 1u == (gen + 1u) * nloc) {
      __builtin_amdgcn_fence(__ATOMIC_RELEASE, "agent");
      asm volatile("s_waitcnt vmcnt(0)" ::: "memory");
      const unsigned og = xb_add(&bar[XB_TOP], 1u);
      const unsigned tg = og / nx;
      if (og + 1u == (tg + 1u) * nx) xb_add(&bar[XB_TOPGEN], 1u);
      else XB_SPIN(xb_ld(&bar[XB_TOPGEN]) == tg, bar);
      __builtin_amdgcn_fence(__ATOMIC_ACQUIRE, "agent");
      xb_add(&bar[XB_XGEN(b.x)], 1u);
      asm volatile("s_waitcnt vmcnt(0)" ::: "memory");
    } else {
      XB_SPIN(xb_ld(&bar[XB_XGEN(b.x)]) == gen, bar);
      __builtin_amdgcn_fence(__ATOMIC_ACQUIRE, "agent");
      asm volatile("s_waitcnt vmcnt(0)" ::: "memory");
    }
  }
  __syncthreads();
}
constexpr size_t O_BAR = O_MISC + 16384;
constexpr size_t O_ROPE = O_MISC + 65536;

struct Params {
  const float* x_prompt; const float* x_sample;
  const float* ffn1_norm; const float* ffn1_w_in; const float* ffn1_w_out; const float* mix_norm; const float* w_in;
  const float* hy_conv_w; const float* hy_conv_b; const float* hy_w1; const float* hy_b1; const float* hy_w2; const float* hy_b2;
  const float* hy_w3; const float* hy_freq; const float* hy_skip;
  const float* gqa_q_norm; const float* gqa_k_norm; const float* diff_lambda; const float* diff_subln; const float* rel_bias;
  const float* w_branch; const float* w_out; const float* ffn2_norm; const float* ffn2_w_in; const float* ffn2_w_out; const float* final_norm;
  float* out; char* ws;
};

DI unsigned pack2(float a, float b) { f2_t v = {a, b}; bf2_t r = __builtin_convertvector(v, bf2_t); return __builtin_bit_cast(unsigned, r); }
DI u16 f2bf(float a) { return (u16)(pack2(a, 0.f) & 0xffffu); }
DI float bf2f(u16 v) { return __uint_as_float(((unsigned)v) << 16); }
DI float bflo(unsigned v) { return __uint_as_float(v << 16); }
DI float bfhi(unsigned v) { return __uint_as_float(v & 0xffff0000u); }
DI int otid() { int t = threadIdx.x; asm volatile("" : "+v"(t)); return t; }
DI float xhalf_max(float x) {
  typedef unsigned u2_t __attribute__((ext_vector_type(2)));
  const u2_t rr = __builtin_amdgcn_permlane32_swap(__float_as_uint(x), __float_as_uint(x), false, false);
  return fmaxf(__uint_as_float(rr[0]), __uint_as_float(rr[1]));
}
DI float xhalf_sum(float x) {
  typedef unsigned u2_t __attribute__((ext_vector_type(2)));
  const u2_t rr = __builtin_amdgcn_permlane32_swap(__float_as_uint(x), __float_as_uint(x), false, false);
  return __uint_as_float(rr[0]) + __uint_as_float(rr[1]);
}
DI int crow(int reg, int h) { return (reg & 3) + 8 * (reg >> 2) + 4 * h; }
DI float wave_sum(float v) {
  v += __shfl_xor(v, 32); v += __shfl_xor(v, 16); v += __shfl_xor(v, 8); v += __shfl_xor(v, 4); v += __shfl_xor(v, 2); v += __shfl_xor(v, 1);
  return v;
}
DI float half_sum(float v) {
  v += __shfl_xor(v, 16); v += __shfl_xor(v, 8); v += __shfl_xor(v, 4); v += __shfl_xor(v, 2); v += __shfl_xor(v, 1);
  return v;
}

DI void convT_tile(const float* __restrict__ src, int K, int N, u16* __restrict__ dst, int kt, int nt, int perm_half, char* smem) {
  float* t = (float*)smem;
  const int tid = otid() & 255;
  __syncthreads();
  {
    const int col = tid & 63, r0 = tid >> 6;
#pragma unroll
    for (int i = 0; i < 16; ++i) { int row = r0 + 4 * i; t[row * 65 + col] = src[(size_t)(kt * 64 + row) * N + nt * 64 + col]; }
  }
  __syncthreads();
  {
    const int nl = tid >> 2, kq = tid & 3;
    int n = nt * 64 + nl;
    if (perm_half > 0) { if (n < perm_half) n = (n >> 7) * 256 + (n & 127); else { int j = n - perm_half; n = (j >> 7) * 256 + 128 + (j & 127); } }
    u32x4 o0, o1;
#pragma unroll
    for (int i = 0; i < 4; ++i) {
      o0[i] = pack2(t[(kq * 16 + 2 * i) * 65 + nl], t[(kq * 16 + 2 * i + 1) * 65 + nl]);
      o1[i] = pack2(t[(kq * 16 + 8 + 2 * i) * 65 + nl], t[(kq * 16 + 8 + 2 * i + 1) * 65 + nl]);
    }
    u16* d = dst + (size_t)n * K + kt * 64 + kq * 16;
    *(u32x4*)d = o0; *(u32x4*)(d + 8) = o1;
  }
}

DI void filter_item(const Params& P, int layer, int L, int tb, u16* __restrict__ G, char* smem) {
  float* h1 = (float*)smem;
  float* h2 = h1 + 64 * 65;
  const int tid = otid() & 255, lane = tid & 63, w = __builtin_amdgcn_readfirstlane(tid >> 6);
  const float* w1 = P.hy_w1 + layer * 33 * 64; const float* b1 = P.hy_b1 + layer * 64;
  const float* w2 = P.hy_w2 + layer * 64 * 64; const float* b2 = P.hy_b2 + layer * 64;
  const float* w3 = P.hy_w3 + layer * 64 * 1024; const float* fr = P.hy_freq + layer * 64;
  const int t = tb * 64 + lane;
  const float tl = (float)t / (float)(L - 1);
  __syncthreads();
  {
    float a[16];
#pragma unroll
    for (int u = 0; u < 16; ++u) a[u] = b1[w * 16 + u] + tl * w1[w * 16 + u];
    const float base = (float)(2.0 * 3.14159265358979323846 / (double)L) * (float)t;
    for (int b = 0; b < 16; ++b) {
      const float band = 1e-4f + (float)b * ((15.0f - 1e-4f) / 15.0f);
      const float ang = base * band;
      const float cs = cosf(ang), sn = -sinf(ang);
#pragma unroll
      for (int u = 0; u < 16; ++u) a[u] += cs * w1[(1 + b) * 64 + w * 16 + u] + sn * w1[(17 + b) * 64 + w * 16 + u];
    }
#pragma unroll
    for (int u = 0; u < 16; ++u) h1[lane * 65 + w * 16 + u] = sinf(fr[w * 16 + u] * a[u]);
  }
  __syncthreads();
  {
    float a[16];
#pragma unroll
    for (int u = 0; u < 16; ++u) a[u] = b2[w * 16 + u];
    for (int k = 0; k < 64; ++k) {
      const float hv = h1[lane * 65 + k];
#pragma unroll
      for (int u = 0; u < 16; ++u) a[u] += hv * w2[k * 64 + w * 16 + u];
    }
#pragma unroll
    for (int u = 0; u < 16; ++u) h2[lane * 65 + w * 16 + u] = sinf(fr[w * 16 + u] * a[u]);
  }
  __syncthreads();
  const float min_decay = -3.0701134573253946f, max_decay = -15.350567286626973f;
  for (int og = 0; og < 64; ++og) {
    const int o = w * 256 + og * 4;
    float a0 = 0.f, a1 = 0.f, a2 = 0.f, a3 = 0.f;
#pragma unroll 4
    for (int k = 0; k < 64; ++k) {
      const float hv = h2[lane * 65 + k];
      const f32x4 wv = *(const f32x4*)(w3 + k * 1024 + o);
      a0 += hv * wv[0]; a1 += hv * wv[1]; a2 += hv * wv[2]; a3 += hv * wv[3];
    }
    float av[4] = {a0, a1, a2, a3};
#pragma unroll
    for (int q = 0; q < 4; ++q) {
      const int oo = o + q; const int ch = oo & 511;
      const float delta = min_decay + (float)ch * ((max_decay - min_decay) / 511.0f);
      const float val = av[q] * expf(-tl * fabsf(delta));
      u16* Gc = G + (size_t)ch * (2 * L);
      if (oo < 512) Gc[L - t] = f2bf(val);
      else { if (t >= 1) Gc[L + t] = f2bf(val); else Gc[0] = 0; }
    }
  }
}

DI void norm_row_bf16(const float* __restrict__ x, const float* __restrict__ g, u16* __restrict__ out, int lane) {
  f32x4 v[4]; float ss = 0.f;
#pragma unroll
  for (int i = 0; i < 4; ++i) { v[i] = *(const f32x4*)(x + lane * 4 + 256 * i); ss += v[i][0] * v[i][0] + v[i][1] * v[i][1] + v[i][2] * v[i][2] + v[i][3] * v[i][3]; }
  ss = wave_sum(ss);
  const float rs = rsqrtf(ss * (1.0f / 1024.0f) + 1e-6f);
#pragma unroll
  for (int i = 0; i < 4; ++i) {
    const f32x4 gg = *(const f32x4*)(g + lane * 4 + 256 * i);
    u32x2 o; o[0] = pack2(v[i][0] * rs * gg[0], v[i][1] * rs * gg[1]); o[1] = pack2(v[i][2] * rs * gg[2], v[i][3] * rs * gg[3]);
    *(u32x2*)(out + lane * 4 + 256 * i) = o;
  }
}
DI void norm_row_f32_inplace(float* __restrict__ x, const float* __restrict__ g, int lane) {
  f32x4 v[4]; float ss = 0.f;
#pragma unroll
  for (int i = 0; i < 4; ++i) { v[i] = *(const f32x4*)(x + lane * 4 + 256 * i); ss += v[i][0] * v[i][0] + v[i][1] * v[i][1] + v[i][2] * v[i][2] + v[i][3] * v[i][3]; }
  ss = wave_sum(ss);
  const float rs = rsqrtf(ss * (1.0f / 1024.0f) + 1e-6f);
#pragma unroll
  for (int i = 0; i < 4; ++i) {
    const f32x4 gg = *(const f32x4*)(g + lane * 4 + 256 * i);
    f32x4 o; o[0] = v[i][0] * rs * gg[0]; o[1] = v[i][1] * rs * gg[1]; o[2] = v[i][2] * rs * gg[2]; o[3] = v[i][3] * rs * gg[3];
    *(f32x4*)(x + lane * 4 + 256 * i) = o;
  }
}

namespace pg8 {
#define PG8_LAS __attribute__((address_space(3)))
typedef unsigned short bf16_t;
typedef short bf16x8 __attribute__((ext_vector_type(8)));
typedef float f32x4 __attribute__((ext_vector_type(4)));
typedef unsigned u32x4 __attribute__((ext_vector_type(4)));
constexpr int BM = 256, BK = 64, HALF = 128, HTB = HALF * BK * 2  , STAGE_BYTES = 8 * HTB, NXCD = 8, WGM = 8;

__host__ __device__ __forceinline__ int lds_byte(int r, int c) { const int st = (r >> 4) * 2 + (c >> 5), rr = r & 15, cc = c & 31, ob = rr * 64 + cc * 2; return st * 1024 + (ob ^ (((ob >> 9) & 1) << 5)); }
__host__ __device__ __forceinline__ void stage_rc(int b, int& R, int& C) { const int st = b / 1024, sb = b % 1024, swz = sb ^ (((sb >> 9) & 1) << 5); R = (st >> 1) * 16 + swz / 64; C = (st & 1) * 32 + (swz % 64) / 2; }
__host__ __device__ __forceinline__ int perm32(int rho) { const int n = rho >> 4, i = rho & 15; return 8 * (i >> 2) + 4 * n + (i & 3); }

struct Unit { int pm, pn; };
struct Gemm { const bf16_t* A; const bf16_t* Bt; int M, N, K; };

struct StaticOrder {
    int nM, nN, nwg, G, c;
    __host__ __device__ void init(int M, int N, int G_, int c_) { nM = M / BM; nN = N / BM; nwg = nM * nN; G = G_; c = c_; }
    __host__ __device__ bool next(int i, Unit& u) const {
        const long L = (long)i * G + c; if (L >= nwg) return false;
        int wgid = (int)L; { const int q = nwg / NXCD, r = nwg % NXCD, xcd = wgid % NXCD, off = wgid / NXCD; wgid = (xcd < r ? xcd * (q + 1) : r * (q + 1) + (xcd - r) * q) + off; }
        const int nig = WGM * nN, gid = wgid / nig, fm = gid * WGM, gsz = (nM - fm) < WGM ? (nM - fm) : WGM;
        u.pm = fm + ((wgid % nig) % gsz); u.pn = (wgid % nig) / gsz; return true;
    }
    __device__ __forceinline__ void a_ready(const Unit&) const {}
    __device__ __forceinline__ void done(const Unit&) const {}
};

template <class Epi, class Sched, bool STAMP = false>
__device__ __forceinline__ void gemm_phase(PG8_LAS unsigned char* lds, const Gemm g, const Sched& S, const Epi& E, unsigned long long* stamps) {
    const int tid = otid(), wid = __builtin_amdgcn_readfirstlane(tid >> 6), lane = tid & 63, wr = wid >> 2, wc = wid & 3, fr = lane & 15, fq = lane >> 4;
    const int K = g.K, nt = K / BK;
    int ts_lo = 0, ts_hi = 0, nts = 0; const unsigned long long rt_entry = STAMP ? (unsigned long long)wall_clock64() : 0ull;
#define PG8_STAMP() do { if (STAMP && wid == 0 && nts < 64) { const unsigned long long _c = (unsigned long long)clock64(); \
        ts_lo = (lane == nts) ? (int)(unsigned)_c : ts_lo; ts_hi = (lane == nts) ? (int)(unsigned)(_c >> 32) : ts_hi; ++nts; } } while (0)
    PG8_STAMP();
    unsigned voffA[2], voffB[2];
#pragma unroll
    for (int i = 0; i < 2; ++i) { int R, C; stage_rc(tid * 16 + i * 8192, R, C); const int Rb = E.perm ? ((R & ~31) + perm32(R & 31)) : R;
        voffA[i] = (unsigned)(R * K + C) * 2u; voffB[i] = (unsigned)(Rb * K + C) * 2u; }
    const size_t kstep = (size_t)(BK * 2);
    const size_t hstep = (size_t)HALF * K * 2;
    const size_t tstep = 2 * hstep;
    const unsigned ldsw = (unsigned)wid * 1024u;
    const int aoff = lds_byte(wr * 64 + fr, fq * 8), boff = lds_byte(wc * 32 + fr, fq * 8);
#define PG8_SA(b, h) (((b) * 2 + (h)) * HTB)
#define PG8_SB(b, h) ((4 + (b) * 2 + (h)) * HTB)
#define PG8_STAGE(bufoff, gbase, voff) do { _Pragma("unroll") for (int _i = 0; _i < 2; ++_i) \
        __builtin_amdgcn_global_load_lds((const unsigned*)((const char*)(gbase) + (voff)[_i]), (PG8_LAS unsigned*)(lds + (bufoff) + ldsw + _i * 8192), 16, 0, 0); } while (0)
#define PG8_LDA(dst, b, h) do { _Pragma("unroll") for (int m = 0; m < 4; ++m) _Pragma("unroll") for (int k = 0; k < 2; ++k) dst[m][k] = *(const PG8_LAS bf16x8*)(lds + PG8_SA(b, h) + aoff + m * 2048 + k * 1024); } while (0)
#define PG8_LDB(dst, b, h) do { _Pragma("unroll") for (int n = 0; n < 2; ++n) _Pragma("unroll") for (int k = 0; k < 2; ++k) dst[n][k] = *(const PG8_LAS bf16x8*)(lds + PG8_SB(b, h) + boff + n * 2048 + k * 1024); } while (0)
#define PG8_MMA(ai, bj, At, Bt) do { __builtin_amdgcn_s_setprio(1); _Pragma("unroll") for (int m = 0; m < 4; ++m) _Pragma("unroll") for (int n = 0; n < 2; ++n) _Pragma("unroll") for (int k = 0; k < 2; ++k) \
        acc[ai][bj][m][n] = __builtin_amdgcn_mfma_f32_16x16x32_bf16(Bt[n][k], At[m][k], acc[ai][bj][m][n], 0, 0, 0); __builtin_amdgcn_s_setprio(0); } while (0)
#define PG8_WAIT_V(n) asm volatile("s_waitcnt vmcnt(" #n ")" ::: "memory")
#define PG8_WAIT_L(n) asm volatile("s_waitcnt lgkmcnt(" #n ")" ::: "memory")
#define PG8_BAR __builtin_amdgcn_s_barrier()
#define PG8_SCHED __builtin_amdgcn_sched_barrier(0)
    Unit cur, nxt; int ui = 0;
    if (!S.next(0, cur)) return;
    f32x4 acc[2][2][4][2];
#pragma unroll
    for (int a = 0; a < 2; ++a)
#pragma unroll
        for (int b = 0; b < 2; ++b)
#pragma unroll
            for (int m = 0; m < 4; ++m)
#pragma unroll
                for (int n = 0; n < 2; ++n) acc[a][b][m][n] = (f32x4){0.f, 0.f, 0.f, 0.f};
    bf16x8 At[4][2], B0[2][2], B1[2][2];
    const char* cA = (const char*)g.A + (size_t)cur.pm * tstep; const char* cB = (const char*)g.Bt + (size_t)cur.pn * tstep;
    S.a_ready(cur);
    PG8_STAGE(PG8_SB(0, 0), cB, voffB); PG8_STAGE(PG8_SA(0, 0), cA, voffA); PG8_STAGE(PG8_SB(0, 1), cB + hstep, voffB); PG8_STAGE(PG8_SA(0, 1), cA + hstep, voffA);
    if (wr == 1) PG8_BAR;
    PG8_WAIT_V(4); PG8_BAR;
    PG8_STAGE(PG8_SB(1, 0), cB + kstep, voffB); PG8_STAGE(PG8_SA(1, 0), cA + kstep, voffA); PG8_STAGE(PG8_SB(1, 1), cB + hstep + kstep, voffB);
    PG8_WAIT_V(6); PG8_BAR;
    PG8_STAMP();
    for (;;) {
        const bool has_next = S.next(ui + 1, nxt);
        const char* nA = has_next ? (const char*)g.A + (size_t)nxt.pm * tstep : cA; const char* nB = has_next ? (const char*)g.Bt + (size_t)nxt.pn * tstep : cB;
        for (int t = 0; t < nt; t += 2) {
            const bool last = (t == nt - 2);
            const char* a1 = cA + (size_t)(t + 1) * kstep;
            const char* a2 = last ? nA : cA + (size_t)(t + 2) * kstep; const char* b2 = last ? nB : cB + (size_t)(t + 2) * kstep;
            const char* a3 = a2 + kstep; const char* b3 = b2 + kstep;
            if (last && has_next) S.a_ready(nxt);
            PG8_LDB(B0, 0, 0); PG8_SCHED; PG8_LDA(At, 0, 0); PG8_STAGE(PG8_SA(1, 1), a1 + hstep, voffA);
            PG8_WAIT_L(8); PG8_BAR; PG8_WAIT_L(0); PG8_MMA(0, 0, At, B0); PG8_BAR; PG8_SCHED;
            PG8_LDB(B1, 0, 1); PG8_STAGE(PG8_SB(0, 0), b2, voffB);
            PG8_BAR; PG8_WAIT_L(0); PG8_MMA(0, 1, At, B1); PG8_BAR;
            PG8_LDA(At, 0, 1); PG8_STAGE(PG8_SA(0, 0), a2, voffA);
            PG8_BAR; PG8_WAIT_L(0); PG8_MMA(1, 0, At, B0); PG8_BAR; PG8_SCHED;
            PG8_STAGE(PG8_SB(0, 1), b2 + hstep, voffB);
            PG8_WAIT_V(6); PG8_BAR; PG8_MMA(1, 1, At, B1); PG8_BAR;
            PG8_LDB(B0, 1, 0); PG8_SCHED; PG8_LDA(At, 1, 0); PG8_STAGE(PG8_SA(0, 1), a2 + hstep, voffA);
            PG8_WAIT_L(8); PG8_BAR; PG8_WAIT_L(0); PG8_MMA(0, 0, At, B0); PG8_BAR; PG8_SCHED;
            PG8_LDB(B1, 1, 1); PG8_STAGE(PG8_SB(1, 0), b3, voffB);
            PG8_BAR; PG8_WAIT_L(0); PG8_MMA(0, 1, At, B1); PG8_BAR;
            PG8_LDA(At, 1, 1); PG8_STAGE(PG8_SA(1, 0), a3, voffA);
            PG8_BAR; PG8_WAIT_L(0); PG8_MMA(1, 0, At, B0); PG8_BAR; PG8_SCHED;
            PG8_STAGE(PG8_SB(1, 1), b3 + hstep, voffB);
            PG8_WAIT_V(6); PG8_BAR; PG8_MMA(1, 1, At, B1); PG8_BAR;
        }
        PG8_STAMP();
        if constexpr (!Epi::AFTER_DRAIN) { E(acc, cur, wr, wc, fr, fq); S.done(cur); }
        PG8_STAMP();
        if (!has_next) break;
        if (!E.keep_acc(cur)) {
#pragma unroll
        for (int a = 0; a < 2; ++a)
#pragma unroll
            for (int b = 0; b < 2; ++b)
#pragma unroll
                for (int m = 0; m < 4; ++m)
#pragma unroll
                    for (int n = 0; n < 2; ++n) acc[a][b][m][n] = (f32x4){0.f, 0.f, 0.f, 0.f};
        }
        cur = nxt; cA = nA; cB = nB; ++ui;
    }
    PG8_WAIT_V(0);
    if (wr == 0) PG8_BAR;
    PG8_BAR;
    if constexpr (Epi::AFTER_DRAIN) { E.fused(acc, cur, wr, wc, fr, fq, lds, wid, lane); S.done(cur); }
    PG8_STAMP();
    if (STAMP && wid == 0) { stamps[lane] = lane < nts ? (((unsigned long long)(unsigned)ts_hi << 32) | (unsigned)ts_lo) : 0ull;
        if (lane == 62) stamps[62] = rt_entry; if (lane == 63) stamps[63] = (unsigned long long)wall_clock64(); }
#undef PG8_STAMP
#undef PG8_SA
#undef PG8_SB
#undef PG8_STAGE
#undef PG8_LDA
#undef PG8_LDB
#undef PG8_MMA
#undef PG8_WAIT_V
#undef PG8_WAIT_L
#undef PG8_BAR
#undef PG8_SCHED
}
}

enum { EPI_SWIGLU = 0, EPI_RESID = 1, EPI_PROJ = 2, EPI_MERGE = 3 };
struct AnyOrder : pg8::StaticOrder {
  bool merge3;
  __device__ __forceinline__ bool next(int i, pg8::Unit& u) const {
    if (!merge3) return pg8::StaticOrder::next(i, u);
    const int ti = i / 3, br = i - ti * 3; pg8::Unit t;
    if (!pg8::StaticOrder::next(ti, t)) return false;
    u.pm = t.pm + 64 * br; u.pn = t.pn + 4 * br; return true;
  }
};
struct EpiAny {
  static constexpr bool AFTER_DRAIN = false;
  int mode; bool perm;
  u16* O; int ldo; const float* xin; float* xout; float scale; const u16* gate; float* macc; int br;
  DI bool keep_acc(const pg8::Unit&) const { return false; }
  DI void operator()(pg8::f32x4 (&acc)[2][2][4][2], const pg8::Unit& u, int wr, int wc, int fr, int fq) const {
    const int row0 = (u.pm & 63) * 256 + wr * 64 + fr;
    if (mode == EPI_SWIGLU) {
      const int col0 = u.pn * 128 + wc * 32 + 8 * fq;
#pragma unroll
      for (int ai = 0; ai < 2; ++ai)
#pragma unroll
        for (int m = 0; m < 4; ++m) {
          float v[8];
#pragma unroll
          for (int n = 0; n < 2; ++n)
#pragma unroll
            for (int e = 0; e < 4; ++e) { const float gv = acc[ai][0][m][n][e], uv = acc[ai][1][m][n][e]; v[4 * n + e] = gv * __builtin_amdgcn_rcpf(1.0f + __builtin_amdgcn_exp2f(-LOG2E * gv)) * uv; }
          u32x4 o; o[0] = pack2(v[0], v[1]); o[1] = pack2(v[2], v[3]); o[2] = pack2(v[4], v[5]); o[3] = pack2(v[6], v[7]);
          *(u32x4*)(O + (size_t)(row0 + ai * 128 + m * 16) * ldo + col0) = o;
        }
    } else if (mode == EPI_PROJ) {
      const int col0 = u.pn * 256 + wc * 32 + 8 * fq;
      const bool sg = (u.pn * 256 >= OFF_GATE);
#pragma unroll
      for (int ai = 0; ai < 2; ++ai)
#pragma unroll
        for (int m = 0; m < 4; ++m)
#pragma unroll
          for (int bj = 0; bj < 2; ++bj) {
            float v[8];
#pragma unroll
            for (int n = 0; n < 2; ++n)
#pragma unroll
              for (int e = 0; e < 4; ++e) { float t = acc[ai][bj][m][n][e]; if (sg) t = __builtin_amdgcn_rcpf(1.0f + __builtin_amdgcn_exp2f(-LOG2E * t)); v[4 * n + e] = t; }
            u32x4 o; o[0] = pack2(v[0], v[1]); o[1] = pack2(v[2], v[3]); o[2] = pack2(v[4], v[5]); o[3] = pack2(v[6], v[7]);
            *(u32x4*)(O + (size_t)(row0 + ai * 128 + m * 16) * INC + col0 + bj * 128) = o;
          }
    } else if (mode == EPI_RESID) {
      const int col0 = u.pn * 256 + wc * 32 + 4 * fq;
#pragma unroll
      for (int ai = 0; ai < 2; ++ai)
#pragma unroll
        for (int m = 0; m < 4; ++m)
#pragma unroll
          for (int bj = 0; bj < 2; ++bj)
#pragma unroll
            for (int n = 0; n < 2; ++n) {
              const size_t idx = (size_t)(row0 + ai * 128 + m * 16) * DM + col0 + bj * 128 + n * 16;
              f32x4 xv = *(const f32x4*)(xin + idx);
#pragma unroll
              for (int e = 0; e < 4; ++e) xv[e] += scale * acc[ai][bj][m][n][e];
              *(f32x4*)(xout + idx) = xv;
            }
    }
  }
  DI u16* outb_() const { return O; }
};

struct EpiMerge {
  static constexpr bool AFTER_DRAIN = false;
  bool perm; const u16* gate; u16* O;
  DI bool keep_acc(const pg8::Unit& u) const { return (u.pm >> 6) < 2; }
  DI u16* outb_() const { return O; }
  DI void operator()(pg8::f32x4 (&acc)[2][2][4][2], const pg8::Unit& u, int wr, int wc, int fr, int fq) const {
    const int row0 = (u.pm & 63) * 256 + wr * 64 + fr;
      const int col0 = (u.pn & 3) * 256 + wc * 32 + 4 * fq; const int br = u.pm >> 6;
#pragma unroll
      for (int ai = 0; ai < 2; ++ai)
#pragma unroll
        for (int m = 0; m < 4; ++m)
#pragma unroll
          for (int bj = 0; bj < 2; ++bj)
#pragma unroll
            for (int n = 0; n < 2; ++n) {
              const int row = row0 + ai * 128 + m * 16, col = col0 + bj * 128 + n * 16;
              const u16* gp = gate + (size_t)row * INC + OFF_GATE + br * DM + col;
              const u32x2 ga = *(const u32x2*)gp;
              float g0[4] = {bflo(ga[0]), bfhi(ga[0]), bflo(ga[1]), bfhi(ga[1])};
              if (br < 2) {
                const u32x2 gb = *(const u32x2*)(gp + DM);
                const float g1[4] = {bflo(gb[0]), bfhi(gb[0]), bflo(gb[1]), bfhi(gb[1])};
#pragma unroll
                for (int e = 0; e < 4; ++e) acc[ai][bj][m][n][e] *= g0[e] * __builtin_amdgcn_rcpf(fmaxf(g1[e], 1e-30f));
              } else {
                u32x2 o; o[0] = pack2(acc[ai][bj][m][n][0] * g0[0], acc[ai][bj][m][n][1] * g0[1]); o[1] = pack2(acc[ai][bj][m][n][2] * g0[2], acc[ai][bj][m][n][3] * g0[3]);
                *(u32x2*)(outb_() + (size_t)row * DM + col) = o;
              }
            }
  }
};

DI void qk_prep_item(const Params& P, int layer, u16* __restrict__ p, int L, int it, const float* __restrict__ rope) {
  const int tid = otid() & 255, lane = tid & 63, w = __builtin_amdgcn_readfirstlane(tid >> 6);
  const int u = it * 8 + w * 2 + (lane >> 5);
  const int tok = u / 10, hd = u - tok * 10;
  const int i = lane & 31;
  const int col0 = (hd < 8) ? (OFF_GQ + hd * 64) : (OFF_GK + (hd - 8) * 64);
  const float* gn = (hd < 8) ? (P.gqa_q_norm + layer * 64) : (P.gqa_k_norm + layer * 64);
  unsigned* ptr = (unsigned*)(p + (size_t)tok * INC + col0) + i;
  const unsigned v = *ptr;
  float a = bflo(v), b = bfhi(v);
  const float ss = half_sum(a * a + b * b);
  const float rs = rsqrtf(ss * (1.0f / 64.0f) + 1e-6f);
  a = a * rs * gn[2 * i]; b = b * rs * gn[2 * i + 1];
  const int tl = tok % L;
  const int jj = i & 15;
  const float* rt = rope + ((i < 16) ? ((tl >> 6) * 16 + jj) : (4096 + (tl & 63) * 16 + jj)) * 2;
  const float c = rt[0], s = rt[1];
  *ptr = pack2(a * c - b * s, a * s + b * c);
}

DI void transpose_item(const Params& P, int layer, const u16* __restrict__ p, int L, int kind, int ct, int tt, u16* __restrict__ dst, char* smem) {
  u16* tile = (u16*)smem;
  const int tid = otid() & 255;
  const int t0 = tt * 64;
  const int seq = t0 / L, tl0 = t0 - seq * L;
  const int C = (kind == 0) ? 128 : 512;
  __syncthreads();
  {
    const int col = tid & 63, r0 = tid >> 6;
    const int cidx = ct * 64 + col;
    if (kind < 2) {
      const int off = (kind == 0 ? OFF_GV : OFF_DV) + cidx;
#pragma unroll
      for (int i = 0; i < 16; ++i) { const int row = r0 + 4 * i; tile[col * 72 + row] = p[(size_t)(t0 + row) * INC + off]; }
    } else {
      const float* cw = P.hy_conv_w + layer * 3 * 1536; const float* cb = P.hy_conv_b + layer * 1536;
      const int c1 = 512 + cidx, c2 = 1024 + cidx;
      const float w10 = cw[c1], w11 = cw[1536 + c1], w12 = cw[3072 + c1], b1 = cb[c1];
      const float w20 = cw[c2], w21 = cw[1536 + c2], w22 = cw[3072 + c2], b2 = cb[c2];
#pragma unroll
      for (int i = 0; i < 16; ++i) {
        const int row = r0 + 4 * i; const int tl = tl0 + row;
        const u16* pr = p + (size_t)(t0 + row) * INC;
        const float xm1 = (tl > 0) ? bf2f(pr[c1 - INC]) : 0.f, x0 = bf2f(pr[c1]), xp1 = (tl < L - 1) ? bf2f(pr[c1 + INC]) : 0.f;
        const float vm1 = (tl > 0) ? bf2f(pr[c2 - INC]) : 0.f, v0 = bf2f(pr[c2]), vp1 = (tl < L - 1) ? bf2f(pr[c2 + INC]) : 0.f;
        const float x1c = xm1 * w10 + x0 * w11 + xp1 * w12 + b1;
        const float vc = vm1 * w20 + v0 * w21 + vp1 * w22 + b2;
        tile[col * 72 + row] = f2bf(vc * x1c);
      }
    }
  }
  __syncthreads();
  {
    const int c = tid >> 2, q = tid & 3;
    const u32x4 a = *(const u32x4*)(tile + c * 72 + q * 16), b = *(const u32x4*)(tile + c * 72 + q * 16 + 8);
    u16* d = dst + ((size_t)seq * C + ct * 64 + c) * L + tl0 + q * 16;
    *(u32x4*)d = a; *(u32x4*)(d + 8) = b;
  }
}

DI int kperm(int rho) { return (rho & ~0xC) | ((rho & 4) << 1) | ((rho & 8) >> 1); }
template <int DV, bool BIAS, bool SWAP>
DI void attn_tile(const u16* __restrict__ Qp, const u16* __restrict__ Kp, const u16* __restrict__ VTp, int L,
                  u16* __restrict__ Op, int ldo, int q0, const float* __restrict__ btab, char* smem) {
  constexpr int NDT = DV / 32;
  constexpr int VCH = DV / 64;
  constexpr int KS_SZ = 64 * 64, VS_SZ = DV * 64;
  constexpr int NL = 1 + VCH;
  u16* Ks = (u16*)smem;
  u16* Vs = Ks + 4 * KS_SZ;
  float* bt = (float*)(Vs + 3 * VS_SZ);
  const int tid = otid(), lane = tid & 63, w = __builtin_amdgcn_readfirstlane(tid >> 6), r = lane & 31, h = lane >> 5;
  const float sc = 0.125f * LOG2E;
  __syncthreads();
  if (BIAS) { for (int i = tid; i < 257; i += 512) bt[i] = btab[i]; }
  bf16x8 qf[4];
  {
    const u16* qrow = Qp + (size_t)(q0 + 32 * w + r) * INC + 8 * h;
#pragma unroll
    for (int s = 0; s < 4; ++s) qf[s] = *(const bf16x8*)(qrow + 16 * s);
  }
  const int qpos = q0 + 32 * w + r;
  f32x16 O[NDT];
#pragma unroll
  for (int d = 0; d < NDT; ++d)
#pragma unroll
    for (int q = 0; q < 16; ++q) O[d][q] = 0.f;
  float m = -INFINITY, l = 0.f;
  const int lrow = tid >> 3, lsw = (tid & 7) ^ ((tid >> 4) & 7);
  const u16* Kg0 = Kp + (size_t)kperm(lrow) * INC + lsw * 8;
  const u16* Vg = VTp + (size_t)lrow * L + lsw * 8;
  const int ksw = (r >> 1) & 7;
  const int nkb = L >> 6;
#define ATT_LOADK(tile, bufp) do { const int t__ = ((tile) < nkb) ? (tile) : nkb - 1; \
    __builtin_amdgcn_global_load_lds((const unsigned*)(Kg0 + ((size_t)t__ * 64) * INC), (unsigned*)((char*)(bufp) + tid * 16), 16, 0, 0); } while (0)
#define ATT_LOADV(tile, bufp) do { const int t__ = ((tile) < nkb) ? (tile) : nkb - 1; _Pragma("unroll") for (int i_ = 0; i_ < VCH; ++i_) \
    __builtin_amdgcn_global_load_lds((const unsigned*)(Vg + (size_t)(64 * i_) * L + (size_t)t__ * 64), (unsigned*)((char*)(bufp) + tid * 16 + i_ * 8192), 16, 0, 0); } while (0)
  f32x16 Sc[2];
  auto qk = [&](const u16* Kb) __attribute__((always_inline)) {
    bf16x8 kf[2][4];
#pragma unroll
    for (int kt = 0; kt < 2; ++kt)
#pragma unroll
      for (int s = 0; s < 4; ++s) kf[kt][s] = *(const bf16x8*)(Kb + (32 * kt + r) * 64 + (((2 * s + h) ^ ksw) << 3));
#pragma unroll
    for (int kt = 0; kt < 2; ++kt) {
#pragma unroll
      for (int q = 0; q < 16; ++q) Sc[kt][q] = 0.f;
#pragma unroll
      for (int s = 0; s < 4; ++s) Sc[kt] = MFMA(kf[kt][s], qf[s], Sc[kt]);
    }
    __builtin_amdgcn_sched_group_barrier(0x100, 8, 0);
    __builtin_amdgcn_sched_group_barrier(0x008, 8, 0);
  };
  bf16x8 pf[2][2];
  auto softmax = [&](int kb) __attribute__((always_inline)) {
    float cb = 0.f; bool near = false;
    if (BIAS) {
      const int kmin = kb * 64;
      near = !(kmin - (q0 + 255) >= 128 || q0 - (kmin + 63) >= 128);
      cb = (kmin > q0) ? bt[256] : bt[0];
      if (near) {
        const float isc = 1.0f / sc;
#pragma unroll
        for (int kt = 0; kt < 2; ++kt)
#pragma unroll
          for (int q = 0; q < 16; ++q) {
            int rel = kmin + 32 * kt + kperm(crow(q, h)) - qpos;
            rel = rel < -128 ? -128 : (rel > 128 ? 128 : rel);
            Sc[kt][q] += bt[rel + 128] * isc;
          }
        cb = 0.f;
      }
    }
    float mx = Sc[0][0];
#pragma unroll
    for (int kt = 0; kt < 2; ++kt)
#pragma unroll
      for (int q = 0; q < 16; ++q) mx = fmaxf(mx, Sc[kt][q]);
    mx = xhalf_max(mx);
    mx = __builtin_fmaf(mx, sc, cb);
    if (__any(mx > m + 6.0f)) {
      asm volatile("" ::: "memory");
      const float mn = fmaxf(m, mx);
      const float alpha = __builtin_amdgcn_exp2f(m - mn);
      m = mn; l *= alpha;
#pragma unroll
      for (int d = 0; d < NDT; ++d)
#pragma unroll
        for (int q = 0; q < 16; ++q) O[d][q] *= alpha;
    }
    const float nm = cb - m;
#pragma unroll
    for (int kt = 0; kt < 2; ++kt) {
#pragma unroll
      for (int q = 0; q < 16; ++q) {
        const float pv = __builtin_amdgcn_exp2f(__builtin_fmaf(Sc[kt][q], sc, nm));
        Sc[kt][q] = pv; l += pv;
      }
#pragma unroll
      for (int s = 0; s < 2; ++s) {
        u32x4 pk;
#pragma unroll
        for (int q = 0; q < 4; ++q) pk[q] = pack2(Sc[kt][8 * s + 2 * q], Sc[kt][8 * s + 2 * q + 1]);
        pf[kt][s] = __builtin_bit_cast(bf16x8, pk);
      }
    }
  };
  auto pv = [&](const u16* Vb) __attribute__((always_inline)) {
    bf16x8 vf[4][NDT];
#pragma unroll
    for (int ks = 0; ks < 4; ++ks)
#pragma unroll
      for (int d = 0; d < NDT; ++d) vf[ks][d] = *(const bf16x8*)(Vb + (32 * d + r) * 64 + (((2 * ks + h) ^ ksw) << 3));
#pragma unroll
    for (int ks = 0; ks < 4; ++ks)
#pragma unroll
      for (int d = 0; d < NDT; ++d) O[d] = MFMA(vf[ks][d], pf[ks >> 1][ks & 1], O[d]);
    __builtin_amdgcn_sched_group_barrier(0x100, 2 * NDT, 0);
    __builtin_amdgcn_sched_group_barrier(0x008, NDT, 0);
    __builtin_amdgcn_sched_group_barrier(0x100, NDT, 0);
    __builtin_amdgcn_sched_group_barrier(0x008, NDT, 0);
    __builtin_amdgcn_sched_group_barrier(0x100, NDT, 0);
    __builtin_amdgcn_sched_group_barrier(0x008, 2 * NDT, 0);
  };
  ATT_LOADK(0, Ks); ATT_LOADK(1, Ks + KS_SZ); ATT_LOADK(2, Ks + 2 * KS_SZ);
  ATT_LOADV(0, Vs); ATT_LOADV(1, Vs + VS_SZ);
  asm volatile("s_waitcnt vmcnt(0) lgkmcnt(0)\n\ts_barrier" ::: "memory");
  if (SWAP) qk(Ks);
  int r0 = 0, r2 = 2;
  for (int kb = 0; kb < nkb; ++kb) {
    ATT_LOADK(kb + 3, Ks + ((kb + 3) & 3) * KS_SZ);
    ATT_LOADV(kb + 2, Vs + r2 * VS_SZ);
    if (!SWAP) qk(Ks + (kb & 3) * KS_SZ);
    softmax(kb);
    pv(Vs + r0 * VS_SZ);
    if (SWAP) qk(Ks + ((kb + 1) & 3) * KS_SZ);
    asm volatile("s_waitcnt vmcnt(%0) lgkmcnt(0)\n\ts_barrier" :: "n"(NL) : "memory");
    r2 = r0; r0 = (r0 == 2) ? 0 : r0 + 1;
  }
  asm volatile("s_waitcnt vmcnt(0)" ::: "memory");
#undef ATT_LOADK
#undef ATT_LOADV
  l += __shfl_xor(l, 32);
  const float inv = __builtin_amdgcn_rcpf(l);
  int ldo2 = ldo; asm volatile("" : "+s"(ldo2));
  u16* orow = Op + (size_t)qpos * ldo2;
#pragma unroll
  for (int d = 0; d < NDT; ++d)
#pragma unroll
    for (int g4 = 0; g4 < 4; ++g4) {
      u32x2 o; o[0] = pack2(O[d][4 * g4] * inv, O[d][4 * g4 + 1] * inv); o[1] = pack2(O[d][4 * g4 + 2] * inv, O[d][4 * g4 + 3] * inv);
      *(u32x2*)(orow + 32 * d + 8 * g4 + 4 * h) = o;
    }
}

DI void attn_tile2(const u16* __restrict__ Qp, const u16* __restrict__ Kp, const u16* __restrict__ VTp, int L,
                   u16* __restrict__ Op, int ldo, int q0, char* smem) {
  constexpr int DV = 64, NDT = 2, VCH = 1, RT = 2;
  constexpr int KS_SZ = 64 * 64, VS_SZ = DV * 64;
  constexpr int NL = 1 + VCH;
  u16* Ks = (u16*)smem;
  u16* Vs = Ks + 4 * KS_SZ;
  const int tid = otid(), lane = tid & 63, w = __builtin_amdgcn_readfirstlane(tid >> 6), r = lane & 31, h = lane >> 5;
  const float sc = 0.125f * LOG2E;
  __syncthreads();
  bf16x8 qf[RT][4];
#pragma unroll
  for (int t = 0; t < RT; ++t) {
    const u16* qrow = Qp + (size_t)(q0 + 64 * w + 32 * t + r) * INC + 8 * h;
#pragma unroll
    for (int s = 0; s < 4; ++s) qf[t][s] = *(const bf16x8*)(qrow + 16 * s);
  }
  f32x16 O[RT][NDT];
#pragma unroll
  for (int t = 0; t < RT; ++t)
#pragma unroll
    for (int d = 0; d < NDT; ++d)
#pragma unroll
      for (int q = 0; q < 16; ++q) O[t][d][q] = 0.f;
  float m[RT], l[RT];
#pragma unroll
  for (int t = 0; t < RT; ++t) { m[t] = -INFINITY; l[t] = 0.f; }
  const int lrow = tid >> 3, lsw = (tid & 7) ^ ((tid >> 4) & 7);
  const u16* Kg0 = Kp + (size_t)kperm(lrow) * INC + lsw * 8;
  const u16* Vg = VTp + (size_t)lrow * L + lsw * 8;
  const int ksw = (r >> 1) & 7;
  const int nkb = L >> 6;
#define ATT_LOADK(tile, bufp) do { const int t__ = ((tile) < nkb) ? (tile) : nkb - 1; \
    __builtin_amdgcn_global_load_lds((const unsigned*)(Kg0 + ((size_t)t__ * 64) * INC), (unsigned*)((char*)(bufp) + tid * 16), 16, 0, 0); } while (0)
#define ATT_LOADV(tile, bufp) do { const int t__ = ((tile) < nkb) ? (tile) : nkb - 1; \
    __builtin_amdgcn_global_load_lds((const unsigned*)(Vg + (size_t)t__ * 64), (unsigned*)((char*)(bufp) + tid * 16), 16, 0, 0); } while (0)
  ATT_LOADK(0, Ks); ATT_LOADK(1, Ks + KS_SZ); ATT_LOADK(2, Ks + 2 * KS_SZ);
  ATT_LOADV(0, Vs); ATT_LOADV(1, Vs + VS_SZ);
  asm volatile("s_waitcnt vmcnt(0) lgkmcnt(0)\n\ts_barrier" ::: "memory");
  int r0 = 0, r2 = 2;
  for (int kb = 0; kb < nkb; ++kb) {
    ATT_LOADK(kb + 3, Ks + ((kb + 3) & 3) * KS_SZ);
    ATT_LOADV(kb + 2, Vs + r2 * VS_SZ);
    const u16* Kb = Ks + (kb & 3) * KS_SZ; const u16* Vb = Vs + r0 * VS_SZ;
    f32x16 Sc[RT][2];
    {
      bf16x8 kf[2][4];
#pragma unroll
      for (int kt = 0; kt < 2; ++kt)
#pragma unroll
        for (int s = 0; s < 4; ++s) kf[kt][s] = *(const bf16x8*)(Kb + (32 * kt + r) * 64 + (((2 * s + h) ^ ksw) << 3));
#pragma unroll
      for (int t = 0; t < RT; ++t)
#pragma unroll
        for (int kt = 0; kt < 2; ++kt) {
#pragma unroll
          for (int q = 0; q < 16; ++q) Sc[t][kt][q] = 0.f;
#pragma unroll
          for (int s = 0; s < 4; ++s) Sc[t][kt] = MFMA(kf[kt][s], qf[t][s], Sc[t][kt]);
        }
      __builtin_amdgcn_sched_group_barrier(0x100, 8, 0);
      __builtin_amdgcn_sched_group_barrier(0x008, 16, 0);
    }
    bf16x8 pf[RT][2][2];
#pragma unroll
    for (int t = 0; t < RT; ++t) {
      float mx = Sc[t][0][0];
#pragma unroll
      for (int kt = 0; kt < 2; ++kt)
#pragma unroll
        for (int q = 0; q < 16; ++q) mx = fmaxf(mx, Sc[t][kt][q]);
      mx = xhalf_max(mx);
      mx *= sc;
      if (__any(mx > m[t] + 6.0f)) {
        asm volatile("" ::: "memory");
        const float mn = fmaxf(m[t], mx);
        const float alpha = __builtin_amdgcn_exp2f(m[t] - mn);
        m[t] = mn; l[t] *= alpha;
#pragma unroll
        for (int d = 0; d < NDT; ++d)
#pragma unroll
          for (int q = 0; q < 16; ++q) O[t][d][q] *= alpha;
      }
      const float nm = -m[t];
#pragma unroll
      for (int kt = 0; kt < 2; ++kt) {
#pragma unroll
        for (int q = 0; q < 16; ++q) { const float pv = __builtin_amdgcn_exp2f(__builtin_fmaf(Sc[t][kt][q], sc, nm)); Sc[t][kt][q] = pv; l[t] += pv; }
#pragma unroll
        for (int s = 0; s < 2; ++s) {
          u32x4 pk;
#pragma unroll
          for (int q = 0; q < 4; ++q) pk[q] = pack2(Sc[t][kt][8 * s + 2 * q], Sc[t][kt][8 * s + 2 * q + 1]);
          pf[t][kt][s] = __builtin_bit_cast(bf16x8, pk);
        }
      }
    }
    {
      bf16x8 vf[4][NDT];
#pragma unroll
      for (int ks = 0; ks < 4; ++ks)
#pragma unroll
        for (int d = 0; d < NDT; ++d) vf[ks][d] = *(const bf16x8*)(Vb + (32 * d + r) * 64 + (((2 * ks + h) ^ ksw) << 3));
#pragma unroll
      for (int ks = 0; ks < 4; ++ks)
#pragma unroll
        for (int d = 0; d < NDT; ++d)
#pragma unroll
          for (int t = 0; t < RT; ++t) O[t][d] = MFMA(vf[ks][d], pf[t][ks >> 1][ks & 1], O[t][d]);
      __builtin_amdgcn_sched_group_barrier(0x100, 4, 0);
      __builtin_amdgcn_sched_group_barrier(0x008, 4, 0);
      __builtin_amdgcn_sched_group_barrier(0x100, 4, 0);
      __builtin_amdgcn_sched_group_barrier(0x008, 12, 0);
    }
    asm volatile("s_waitcnt vmcnt(%0) lgkmcnt(0)\n\ts_barrier" :: "n"(NL) : "memory");
    r2 = r0; r0 = (r0 == 2) ? 0 : r0 + 1;
  }
  asm volatile("s_waitcnt vmcnt(0)" ::: "memory");
#undef ATT_LOADK
#undef ATT_LOADV
  int ldo2 = ldo; asm volatile("" : "+s"(ldo2));
#pragma unroll
  for (int t = 0; t < RT; ++t) {
    float lt = l[t]; lt += __shfl_xor(lt, 32);
    const float inv = __builtin_amdgcn_rcpf(lt);
    u16* orow = Op + (size_t)(q0 + 64 * w + 32 * t + r) * ldo2;
#pragma unroll
    for (int d = 0; d < NDT; ++d)
#pragma unroll
      for (int g4 = 0; g4 < 4; ++g4) {
        u32x2 o; o[0] = pack2(O[t][d][4 * g4] * inv, O[t][d][4 * g4 + 1] * inv); o[1] = pack2(O[t][d][4 * g4 + 2] * inv, O[t][d][4 * g4 + 3] * inv);
        *(u32x2*)(orow + 32 * d + 8 * g4 + 4 * h) = o;
      }
  }
}

template <int ILO, int IHI>
DI void hy_seg(int lo, int hi, f32x16 (&acc)[4], const u16* fw, const u16* fw1, const u16* zs, const int (&tq)[4], const int (&tJ)[4],
               int ZLP8, int L, int wb, int r, int h) {
  if (lo > hi) return;
  const int idx0 = L - lo - r + 8 * h - wb;
  const unsigned* ap = (idx0 & 1) ? (const unsigned*)(fw1 + idx0 - 1) : (const unsigned*)(fw + idx0);
  const u16* zq[4]; int cs[4];
#pragma unroll
  for (int i = ILO; i <= IHI; ++i) { zq[i] = zs + tq[i] * ZLP8; cs[i] = (1024 + 1024 * tJ[i] + 32 * r - lo + 8 * h) >> 3; }
  const int n = ((hi - lo) >> 4) + 1;
  bf16x8 a, b[4];
  { u32x4 av; av[0] = ap[0]; av[1] = ap[1]; av[2] = ap[2]; av[3] = ap[3]; a = __builtin_bit_cast(bf16x8, av); }
#pragma unroll
  for (int i = ILO; i <= IHI; ++i) b[i] = *(const bf16x8*)(zq[i] + ((cs[i] + (cs[i] >> 2)) << 3));
  for (int k = 0; k < n; ++k) {
    ap -= 8;
    bf16x8 an, c[4];
    { u32x4 av; av[0] = ap[0]; av[1] = ap[1]; av[2] = ap[2]; av[3] = ap[3]; an = __builtin_bit_cast(bf16x8, av); }
#pragma unroll
    for (int i = ILO; i <= IHI; ++i) { cs[i] -= 2; c[i] = *(const bf16x8*)(zq[i] + ((cs[i] + (cs[i] >> 2)) << 3)); }
#pragma unroll
    for (int i = ILO; i <= IHI; ++i) acc[i] = MFMA(a, b[i], acc[i]);
    a = an;
#pragma unroll
    for (int i = ILO; i <= IHI; ++i) b[i] = c[i];
  }
}

DI void hyena_item(int c, const u16* __restrict__ G, const u16* __restrict__ zT, u16* __restrict__ yT, int nseq, int L, char* smem) {
  u16* zs = (u16*)smem;
  u16* fw = zs + 25600;
  u16* fw1 = fw + 4224;
  const int tid = otid() & 255, lane = tid & 63, w = __builtin_amdgcn_readfirstlane(tid >> 6), r = lane & 31, h = lane >> 5;
  const int ZL = L + 2048;
  const int ZLP8 = ((ZL >> 3) + (ZL >> 5)) << 3;
  __syncthreads();
  for (int q = 0; q < nseq; ++q) {
    const u16* src = zT + ((size_t)q * 512 + c) * L;
    u16* dst = zs + q * ZLP8;
    const u32x4 zero = {0u, 0u, 0u, 0u};
    for (int i = tid; i < 128; i += 256) { const int c0 = i, c1 = 128 + (L >> 3) + i; *(u32x4*)(dst + ((c0 + (c0 >> 2)) << 3)) = zero; *(u32x4*)(dst + ((c1 + (c1 >> 2)) << 3)) = zero; }
    for (int i = tid; i < (L >> 3); i += 256) { const int cc = 128 + i; *(u32x4*)(dst + ((cc + (cc >> 2)) << 3)) = *(const u32x4*)(src + i * 8); }
  }
  int tq[4], tJ[4];
#pragma unroll
  for (int i = 0; i < 4; ++i) { if (nseq == 2) { tq[i] = i & 1; tJ[i] = 2 * w + (i >> 1); } else { tq[i] = 0; tJ[i] = 4 * w + i; } }
  f32x16 acc[4];
#pragma unroll
  for (int i = 0; i < 4; ++i)
#pragma unroll
    for (int q = 0; q < 16; ++q) acc[i][q] = 0.f;
  const int E0 = -L + 16, ELAST = L - 32;
  const int npass = (2 * L - 32 + 4095) / 4096;
  const u16* Gc = G + (size_t)c * (2 * L);
  for (int ps = 0; ps < npass; ++ps) {
    const int ea = E0 + 4096 * ps, eb = ea + 4096;
    const int wb = L - eb - 16;
    __syncthreads();
    for (int i = tid; i < 520; i += 256) {
      const int gi = wb + i * 8;
      u32x4 v = {0u, 0u, 0u, 0u};
      if (gi >= 0 && gi < 2 * L) v = *(const u32x4*)(Gc + gi);
      *(u32x4*)(fw + i * 8) = v;
    }
    __syncthreads();
    for (int i = tid; i < 2079; i += 256) { const unsigned lo = ((const unsigned*)fw)[i], hi = ((const unsigned*)fw)[i + 1]; ((unsigned*)fw1)[i] = (lo >> 16) | (hi << 16); }
    __syncthreads();
    const int eend = (eb - 16 < ELAST) ? (eb - 16) : ELAST;
    int emn[4], emx[4];
#pragma unroll
    for (int i = 0; i < 4; ++i) { emn[i] = 1024 * tJ[i] - L + 16; emx[i] = 1024 * tJ[i] + 992; }
#define HY_CLIP_LO(v) ((v) < ea ? ea : (v))
#define HY_CLIP_HI(v) ((v) > eend ? eend : (v))
    hy_seg<0, 0>(HY_CLIP_LO(emn[0]), HY_CLIP_HI(emn[1] - 16), acc, fw, fw1, zs, tq, tJ, ZLP8, L, wb, r, h);
    hy_seg<0, 1>(HY_CLIP_LO(emn[1]), HY_CLIP_HI(emn[2] - 16), acc, fw, fw1, zs, tq, tJ, ZLP8, L, wb, r, h);
    hy_seg<0, 2>(HY_CLIP_LO(emn[2]), HY_CLIP_HI(emn[3] - 16), acc, fw, fw1, zs, tq, tJ, ZLP8, L, wb, r, h);
    hy_seg<0, 3>(HY_CLIP_LO(emn[3]), HY_CLIP_HI(emx[0]), acc, fw, fw1, zs, tq, tJ, ZLP8, L, wb, r, h);
    hy_seg<1, 3>(HY_CLIP_LO(emx[0] + 16), HY_CLIP_HI(emx[1]), acc, fw, fw1, zs, tq, tJ, ZLP8, L, wb, r, h);
    hy_seg<2, 3>(HY_CLIP_LO(emx[1] + 16), HY_CLIP_HI(emx[2]), acc, fw, fw1, zs, tq, tJ, ZLP8, L, wb, r, h);
    hy_seg<3, 3>(HY_CLIP_LO(emx[2] + 16), HY_CLIP_HI(emx[3]), acc, fw, fw1, zs, tq, tJ, ZLP8, L, wb, r, h);
#undef HY_CLIP_LO
#undef HY_CLIP_HI
  }
#pragma unroll
  for (int i = 0; i < 4; ++i) {
    u16* dst = yT + ((size_t)tq[i] * 512 + c) * L + 1024 * tJ[i] + 32 * r + 4 * h;
#pragma unroll
    for (int g4 = 0; g4 < 4; ++g4) {
      u32x2 o; o[0] = pack2(acc[i][4 * g4], acc[i][4 * g4 + 1]); o[1] = pack2(acc[i][4 * g4 + 2], acc[i][4 * g4 + 3]);
      *(u32x2*)(dst + 8 * g4) = o;
    }
  }
}

DI void diff_post_item(const Params& P, int layer, float lam, float lam_init, const u16* __restrict__ dO, u16* __restrict__ ydf, int it) {
  const int tid = otid() & 255, lane = tid & 63, w = __builtin_amdgcn_readfirstlane(tid >> 6);
  const int u = it * 8 + w * 2 + (lane >> 5);
  const int i = lane & 31;
  const u32x2 a = *(const u32x2*)(dO + (size_t)u * 256 + 4 * i);
  const u32x2 b = *(const u32x2*)(dO + (size_t)u * 256 + 128 + 4 * i);
  float o[4];
  o[0] = bflo(a[0]) - lam * bflo(b[0]); o[1] = bfhi(a[0]) - lam * bfhi(b[0]);
  o[2] = bflo(a[1]) - lam * bflo(b[1]); o[3] = bfhi(a[1]) - lam * bfhi(b[1]);
  const float ss = half_sum(o[0] * o[0] + o[1] * o[1] + o[2] * o[2] + o[3] * o[3]);
  const float rs = rsqrtf(ss * (1.0f / 128.0f) + 1e-5f) * (1.0f - lam_init);
  const float* g = P.diff_subln + layer * 128 + 4 * i;
  u32x2 ov; ov[0] = pack2(o[0] * rs * g[0], o[1] * rs * g[1]); ov[1] = pack2(o[2] * rs * g[2], o[3] * rs * g[3]);
  *(u32x2*)(ydf + (size_t)u * 128 + 4 * i) = ov;
}
DI void hyena_post_item(const Params& P, int layer, const u16* __restrict__ p, int L, const u16* __restrict__ yT, const u16* __restrict__ zT,
                        int ct, int tt, u16* __restrict__ yhy, char* smem) {
  float* tile = (float*)smem;
  const int tid = otid() & 255;
  const int t0 = tt * 64; const int seq = t0 / L, tl0 = t0 - seq * L;
  __syncthreads();
  {
    const int tcol = tid & 63, c0 = tid >> 6;
#pragma unroll
    for (int i = 0; i < 16; ++i) {
      const int cc = c0 + 4 * i; const int c = ct * 64 + cc;
      const size_t gi = ((size_t)seq * 512 + c) * L + tl0 + tcol;
      tile[cc * 65 + tcol] = bf2f(yT[gi]) + bf2f(zT[gi]) * P.hy_skip[layer * 512 + c];
    }
  }
  __syncthreads();
  {
    const int col = tid & 63, r0 = tid >> 6; const int c = ct * 64 + col;
    const float* cw = P.hy_conv_w + layer * 3 * 1536; const float* cb = P.hy_conv_b + layer * 1536;
    const float w0 = cw[c], w1 = cw[1536 + c], w2 = cw[3072 + c], b0 = cb[c];
#pragma unroll
    for (int i = 0; i < 16; ++i) {
      const int row = r0 + 4 * i; const int tl = tl0 + row;
      const u16* pr = p + (size_t)(t0 + row) * INC + c;
      const float xm1 = (tl > 0) ? bf2f(pr[-INC]) : 0.f, x0 = bf2f(pr[0]), xp1 = (tl < L - 1) ? bf2f(pr[INC]) : 0.f;
      const float x0c = xm1 * w0 + x0 * w1 + xp1 * w2 + b0;
      yhy[(size_t)(t0 + row) * 512 + c] = f2bf(x0c * tile[col * 65 + row]);
    }
  }
}

__global__ void __launch_bounds__(512) fwd_megakernel(Params Parg) {
  cg::grid_group grid = cg::this_grid();
  extern __shared__ __attribute__((aligned(16))) char smem_dyn[];
  char* smem = smem_dyn + 16;
  uint4& xb_words = *(uint4*)smem_dyn;
  const int nb = gridDim.x, nb2 = nb * 2;
#define KPARAMS() const Params __attribute__((address_space(4)))* pp_ = (const Params __attribute__((address_space(4)))*)__builtin_amdgcn_kernarg_segment_ptr(); \
  asm volatile("" : "+s"(pp_)); const Params& P = *(const Params*)pp_; char* ws = P.ws
  if (threadIdx.x == 0) xb_words = make_uint4(0u, 0u, 0u, blockIdx.x);
  __syncthreads();
  XcdBarrier xb;
  { KPARAMS(); xb = xcd_barrier_post((unsigned*)(ws + O_BAR), (volatile LAS unsigned*)&xb_words); }

  for (int step = 0; step < 80; ++step) {
    const int layer = step / 40, ls = step - layer * 40;
    PHASE_IDS();
    KPARAMS();
    float* misc = (float*)(ws + O_MISC);
    u16* pbuf = (u16*)(ws + O_P); u16* hid = pbuf; u16* hn = (u16*)(ws + O_HN); u16* merged = hn;
    if (ls == 0) {
      u16* filt8 = (u16*)(ws + O_FILT8); u16* filt16 = (u16*)(ws + O_FILT16);
      const int n1 = 16 * 88, n2 = 44 * 16, n3 = 16 * 108, n4 = 3 * 8 * 16, n5 = 16 * 16;
      const int nfilt = 128 + 256;
      const int total = n1 + n2 + n3 + n4 + n5 + n1 + n2 + nfilt;
      for (int it = bid2; it < total; it += nb2) {
        int t = it;
        if (t < nfilt) {
          const bool big = t < 256;
          filter_item(P, layer, big ? 16384 : 8192, big ? t : t - 256, big ? filt16 : filt8, smg);
          continue;
        }
        t -= nfilt;
        const float* src; int K, N, kt, nt, ph = 0; u16* dst;
        if (t < n1) { src = P.ffn1_w_in + (size_t)layer * 1024 * 5632; K = 1024; N = 5632; dst = (u16*)(ws + O_F1IN); kt = t / 88; nt = t % 88; ph = 2816; }
        else if ((t -= n1) < n2) { src = P.ffn1_w_out + (size_t)layer * 2816 * 1024; K = 2816; N = 1024; dst = (u16*)(ws + O_F1OUT); kt = t / 16; nt = t % 16; }
        else if ((t -= n2) < n3) { src = P.w_in + (size_t)layer * 1024 * 6912; K = 1024; N = 6912; dst = (u16*)(ws + O_WIN); kt = t / 108; nt = t % 108; }
        else if ((t -= n3) < n4) { const int br = t / 128, tt = t % 128; src = P.w_branch + ((size_t)layer * 3 + br) * 512 * 1024; K = 512; N = 1024;
                                   dst = (u16*)(ws + O_WBR) + (size_t)br * 1024 * 512; kt = tt / 16; nt = tt % 16; }
        else if ((t -= n4) < n5) { src = P.w_out + (size_t)layer * 1024 * 1024; K = 1024; N = 1024; dst = (u16*)(ws + O_WOUT); kt = t / 16; nt = t % 16; }
        else if ((t -= n5) < n1) { src = P.ffn2_w_in + (size_t)layer * 1024 * 5632; K = 1024; N = 5632; dst = (u16*)(ws + O_F2IN); kt = t / 88; nt = t % 88; ph = 2816; }
        else { t -= n1; src = P.ffn2_w_out + (size_t)layer * 2816 * 1024; K = 2816; N = 1024; dst = (u16*)(ws + O_F2OUT); kt = t / 16; nt = t % 16; }
        convT_tile(src, K, N, dst, kt, nt, ph, smg);
      }
      if (bid == 1 && grp == 0 && layer == 0) {
        float* rope = (float*)(ws + O_ROPE);
        for (int i = t_; i < 320 * 16; i += 256) {
          const int pos = (i < 4096) ? (i >> 4) : ((i - 4096) >> 4); const int jj = i & 15;
          const float inv = powf(10000.0f, -(float)(2 * jj) / 32.0f);
          const float ang = (float)pos * inv;
          rope[2 * i] = cosf(ang); rope[2 * i + 1] = sinf(ang);
        }
      }
      if (bid == 0 && grp == 0) {
        const int tid = t_;
        if (tid < 2) {
          const float* lp = P.diff_lambda + tid * 256;
          float s1 = 0.f, s2 = 0.f;
          for (int i = 0; i < 64; ++i) { s1 += lp[i] * lp[64 + i]; s2 += lp[128 + i] * lp[192 + i]; }
          const float lam_init = 0.8f - 0.6f * expf(-0.3f * (float)tid);
          misc[tid] = expf(s1) - expf(s2) + lam_init;
        }
        for (int i = tid; i < 4 * 257; i += 256) {
          const int hh = i / 257, idx = i % 257; const int rel = idx - 128; const int n = rel < 0 ? -rel : rel;
          int b;
          if (n < 8) b = n; else { int lg = 8 + (int)(logf((float)n / 8.0f) / 2.772588722239781f * 8.0f); b = lg < 15 ? lg : 15; }
          if (rel > 0) b += 16;
          misc[64 + i] = P.rel_bias[b * 4 + hh] * LOG2E;
        }
      }
      if (step == 0) {
        grid.sync();
        if (threadIdx.x == 0) {
          unsigned* bar = (unsigned*)(ws + O_BAR); bool even = ((nb & 7) == 0);
          for (int j = 0; j < 16; ++j) { const unsigned c = xb_ld(&bar[XB_XCNT(j)]); if (c != ((j < 8) ? (unsigned)(nb >> 3) : 0u)) even = false; }
          volatile LAS unsigned* st = (volatile LAS unsigned*)&xb_words;
          if (even) st[3] = st[2] * 8u + xb.x;
        }
        __syncthreads();
      } else GSYNC();
      continue;
    }
    const int cs = ls - 1; const int ch = cs / 13, st = cs - ch * 13;
    const int nseq = (ch < 2) ? 2 : 1, L = (ch < 2) ? 8192 : 16384;
    const float* xin0 = (ch < 2) ? (P.x_prompt + (size_t)ch * TCH * DM) : P.x_sample;
    float* xres = P.out + (size_t)ch * TCH * DM;
    const float* xcur = (layer == 0) ? xin0 : xres;
    for (int rp_ = 0; rp_ <= ((REPMASK >> st) & 1); ++rp_) {
    if (st == 0 || st == 3 || st == 10) {
      const float* src = (st == 0) ? xcur : xres;
      const float* gn = ((st == 0) ? P.ffn1_norm : (st == 3 ? P.mix_norm : P.ffn2_norm)) + layer * DM;
      for (int it = bid2; it < TCH / 4; it += nb2) { const int row = it * 4 + w; norm_row_bf16(src + (size_t)row * DM, gn, hn + (size_t)row * DM, lane); }
    } else if (st == 1 || st == 2 || st == 4 || st == 8 || st == 9 || st == 11 || st == 12) {
      EpiAny E{}; const u16* A; const u16* Bt; int N, K;
      if (st == 1 || st == 11) { A = hn; Bt = (u16*)(ws + (st == 1 ? O_F1IN : O_F2IN)); N = 5632; K = DM; E.mode = EPI_SWIGLU; E.perm = true; E.O = hid; E.ldo = DFF; }
      else if (st == 2 || st == 12) { A = hid; Bt = (u16*)(ws + (st == 2 ? O_F1OUT : O_F2OUT)); N = DM; K = DFF; E.mode = EPI_RESID; E.perm = false;
                                      E.xin = (st == 2) ? xcur : xres; E.xout = xres; E.scale = 0.5f; }
      else if (st == 4) { A = hn; Bt = (u16*)(ws + O_WIN); N = INC; K = DM; E.mode = EPI_PROJ; E.perm = true; E.O = pbuf; }
      else if (st == 8) { A = (u16*)(ws + O_YHY); Bt = (u16*)(ws + O_WBR); N = DM; K = 512; E.mode = EPI_MERGE; E.perm = false; E.gate = pbuf; E.macc = (float*)(ws + O_ZT); E.O = merged; }
      else { A = merged; Bt = (u16*)(ws + O_WOUT); N = DM; K = DM; E.mode = EPI_RESID; E.perm = false; E.xin = xres; E.xout = xres; E.scale = 1.0f; }
      if (st == 8) {
        pg8::Gemm gg{A, Bt, TCH, N, K};
        AnyOrder S; S.init(TCH, N, nb, bid); S.merge3 = true;
        EpiMerge EM{false, pbuf, merged};
        pg8::gemm_phase<EpiMerge, AnyOrder, false>((PG8_LAS unsigned char*)smem, gg, S, EM, nullptr);
      } else {
        pg8::Gemm gg{A, Bt, TCH, N, K};
        AnyOrder S; S.init(TCH, N, nb, bid); S.merge3 = false;
        pg8::gemm_phase<EpiAny, AnyOrder, false>((PG8_LAS unsigned char*)smem, gg, S, E, nullptr);
      }
    } else if (st == 5) {
      const int nqk = TCH * 10 / 8, ntr = 256 * 18;
      for (int it = bid2; it < nqk + ntr; it += nb2) {
        if (it < nqk) { qk_prep_item(P, layer, pbuf, L, it, (const float*)(ws + O_ROPE)); continue; }
        const int t = it - nqk; const int tt = t / 18, cc = t % 18;
        const int kind = (cc < 2) ? 0 : (cc < 10 ? 1 : 2);
        const int ct = (cc < 2) ? cc : (cc < 10 ? cc - 2 : cc - 10);
        u16* dst = (u16*)(ws + (kind == 0 ? O_VTG : (kind == 1 ? O_VTD : O_ZT)));
        transpose_item(P, layer, pbuf, L, kind, ct, tt, dst, smg);
      }
    } else if (st == 6) {
      u16* zT = (u16*)(ws + O_ZT); u16* yT = (u16*)(ws + O_YT); u16* dO = (u16*)(ws + O_DIFFO);
      u16* vtg = (u16*)(ws + O_VTG); u16* vtd = (u16*)(ws + O_VTD); u16* ygq = (u16*)(ws + O_YGQ);
      const u16* filt = (u16*)(ws + ((ch < 2) ? O_FILT8 : O_FILT16));
      const int nqt = L / 256;
      const int xcd = bid & 7, nxu = nb >> 3, nitem = nseq * nqt;
      for (int e = bid >> 3; e < nitem; e += nxu) {
        const int seq = e / nqt, qt = e - seq * nqt;
        const int hh = xcd >> 1, cc = xcd & 1;
        const size_t tb = (size_t)seq * L;
        const u16* Qd = pbuf + tb * INC + OFF_DQ + xcd * 64; const u16* Kd = pbuf + tb * INC + OFF_DK + xcd * 64;
        const u16* Vd = vtd + ((size_t)seq * 512 + hh * 128) * L; u16* Od = dO + tb * 1024 + (hh * 2 + cc) * 128;
        attn_tile<128, true, false>(Qd, Kd, Vd, L, Od, 1024, qt * 256, misc + 64 + hh * 257, smem);
      }
      {
        const int nqt2 = L / 512, nitem2 = nseq * nqt2;
        for (int e = bid >> 3; e < nitem2; e += nxu) {
          const int seq = e / nqt2, qt = e - seq * nqt2;
          const int kvh = xcd >> 2;
          const size_t tb = (size_t)seq * L;
          const u16* Qd = pbuf + tb * INC + OFF_GQ + xcd * 64; const u16* Kd = pbuf + tb * INC + OFF_GK + kvh * 64;
          const u16* Vd = vtg + ((size_t)seq * 128 + kvh * 64) * L; u16* Od = ygq + tb * 512 + xcd * 64;
          attn_tile2(Qd, Kd, Vd, L, Od, 512, qt * 512, smem);
        }
      }
      for (int c = bid2; c < 512; c += nb2) hyena_item(c, filt, zT, yT, nseq, L, smg);
    } else {
      u16* zT = (u16*)(ws + O_ZT); u16* yT = (u16*)(ws + O_YT); u16* dO = (u16*)(ws + O_DIFFO);
      u16* yhy = (u16*)(ws + O_YHY); u16* ydf = (u16*)(ws + O_YDF);
      const float lam = misc[layer];
      const float lam_init = 0.8f - 0.6f * expf(-0.3f * (float)layer);
      const int ndp = TCH * 4 / 8, nhp = 256 * 8;
      for (int it = bid2; it < ndp + nhp; it += nb2) {
        if (it < ndp) diff_post_item(P, layer, lam, lam_init, dO, ydf, it);
        else { const int t = it - ndp; hyena_post_item(P, layer, pbuf, L, yT, zT, t % 8, t / 8, yhy, smg); }
      }
    }
    }
    GSYNC();
  }
  { PHASE_IDS(); KPARAMS(); (void)ws;
    for (int it = bid2; it < NTOK / 4; it += nb2) { const int row = it * 4 + w; norm_row_f32_inplace(P.out + (size_t)row * DM, P.final_norm, lane); }
  }
}

extern "C" void kernel_launch(void* const* d_in, const int* in_sizes, int n_in, void* d_out, int out_size, void* d_ws, size_t ws_size,
                              hipStream_t stream) {
  static int grid_blocks = 0;
  if (!grid_blocks) {
    int dev = 0, cus = 0, per_cu = 0;
    (void)hipGetDevice(&dev);
    (void)hipDeviceGetAttribute(&cus, hipDeviceAttributeMultiprocessorCount, dev);
    (void)hipFuncSetAttribute((const void*)fwd_megakernel, hipFuncAttributeMaxDynamicSharedMemorySize, SMEM_BYTES + 16);
    (void)hipOccupancyMaxActiveBlocksPerMultiprocessor(&per_cu, fwd_megakernel, 512, SMEM_BYTES + 16);
    if (per_cu < 1) per_cu = 1;
    if (per_cu > 1) per_cu = 1;
    grid_blocks = cus * per_cu;
  }
  Params p{};
  const float* const* in = (const float* const*)d_in;
  p.x_prompt = in[0]; p.x_sample = in[1]; p.ffn1_norm = in[2]; p.ffn1_w_in = in[3]; p.ffn1_w_out = in[4]; p.mix_norm = in[5]; p.w_in = in[6];
  p.hy_conv_w = in[7]; p.hy_conv_b = in[8]; p.hy_w1 = in[9]; p.hy_b1 = in[10]; p.hy_w2 = in[11]; p.hy_b2 = in[12]; p.hy_w3 = in[13];
  p.hy_freq = in[14]; p.hy_skip = in[15]; p.gqa_q_norm = in[16]; p.gqa_k_norm = in[17]; p.diff_lambda = in[18]; p.diff_subln = in[19];
  p.rel_bias = in[20]; p.w_branch = in[21]; p.w_out = in[22]; p.ffn2_norm = in[23]; p.ffn2_w_in = in[24]; p.ffn2_w_out = in[25]; p.final_norm = in[26];
  p.out = (float*)d_out; p.ws = (char*)d_ws;
  void* args[] = {&p};
  (void)hipMemsetAsync((char*)d_ws + O_BAR, 0, XCD_BAR_WORDS * 4, stream);
  hipError_t e = hipLaunchCooperativeKernel((void*)fwd_megakernel, dim3(grid_blocks), dim3(512), args, SMEM_BYTES + 16, stream);
  if (e != hipSuccess) fprintf(stderr, "cooperative launch failed: %s (grid %d)\n", hipGetErrorString(e), grid_blocks);
}
```

```cpp
#include <hip/hip_runtime.h>
#include <hip/hip_cooperative_groups.h>
#include <stdint.h>
#include <cstdio>
namespace cg = cooperative_groups;

typedef unsigned short u16;
typedef __attribute__((ext_vector_type(8))) short bf16x8;
typedef __attribute__((ext_vector_type(16))) float f32x16;
typedef __attribute__((ext_vector_type(4))) float f32x4;
typedef __attribute__((ext_vector_type(4))) unsigned u32x4;
typedef __attribute__((ext_vector_type(2))) unsigned u32x2;
typedef __attribute__((ext_vector_type(2))) __bf16 bf2_t;
typedef __attribute__((ext_vector_type(2))) float f2_t;
#define DI __device__ __forceinline__
#define MFMA(a, b, c) __builtin_amdgcn_mfma_f32_32x32x16_bf16((a), (b), (c), 0, 0, 0)

constexpr int DM = 1024, DFF = 2816, INC = 6912, TCH = 16384, NTOK = 49152;
constexpr int OFF_GQ = 1536, OFF_GK = 2048, OFF_GV = 2176, OFF_DQ = 2304, OFF_DK = 2816, OFF_DV = 3328, OFF_GATE = 3840;
constexpr float LOG2E = 1.4426950408889634f;

constexpr size_t SZ_F1IN = (size_t)5632 * 1024 * 2, SZ_F1OUT = (size_t)1024 * 2816 * 2, SZ_WIN = (size_t)6912 * 1024 * 2,
                 SZ_WBR = (size_t)3 * 1024 * 512 * 2, SZ_WOUT = (size_t)1024 * 1024 * 2;
constexpr size_t O_F1IN = 0, O_F1OUT = O_F1IN + SZ_F1IN, O_WIN = O_F1OUT + SZ_F1OUT, O_WBR = O_WIN + SZ_WIN, O_WOUT = O_WBR + SZ_WBR,
                 O_F2IN = O_WOUT + SZ_WOUT, O_F2OUT = O_F2IN + SZ_F1IN, O_FILT8 = O_F2OUT + SZ_F1OUT,
                 O_FILT16 = O_FILT8 + (size_t)512 * 16384 * 2, O_MISC = O_FILT16 + (size_t)512 * 32768 * 2,
                 O_P = O_MISC + 131072, O_HN = O_P + (size_t)TCH * INC * 2, O_ZT = O_HN + (size_t)TCH * 1024 * 2,
                 O_YT = O_ZT + (size_t)TCH * 512 * 2, O_DIFFO = O_YT + (size_t)TCH * 512 * 2, O_VTG = O_DIFFO + (size_t)TCH * 1024 * 2,
                 O_VTD = O_VTG + (size_t)TCH * 128 * 2, O_YHY = O_VTD + (size_t)TCH * 512 * 2, O_YGQ = O_YHY + (size_t)TCH * 512 * 2,
                 O_YDF = O_YGQ + (size_t)TCH * 512 * 2, O_END = O_YDF + (size_t)TCH * 512 * 2;
static_assert(O_END <= (size_t)536870912, "workspace overflow");
constexpr int SMEM_BYTES = 151552;
constexpr int GRP_LDS = 75776;
#define REPMASK 0
#define REP_SYNC 1
#define PHASE_IDS() const int t_ = otid(); const int bid = __builtin_amdgcn_readfirstlane(((volatile LAS unsigned*)&xb_words)[3]); const int lane = t_ & 63; const int grp = __builtin_amdgcn_readfirstlane(t_ >> 8); \
  const int w = __builtin_amdgcn_readfirstlane((t_ >> 6) & 3); const int bid2 = bid * 2 + grp; char* smg = smem + grp * GRP_LDS; \
  const int vb = (bid & 7) * (nb >> 3) + (bid >> 3); (void)lane; (void)w; (void)bid2; (void)smg; (void)vb
#define GSYNC() do { for (int rs_ = 0; rs_ < REP_SYNC; ++rs_) xcd_barrier(xb); } while (0)


#define XB_TMO      128
#define XB_XCNT(j)  (256  + 64 * (j))
#define XB_XSUB(j)  (1280 + 64 * (j))
#define XB_XGEN(j)  (2304 + 64 * (j))
#define XB_TOP      3328
#define XB_TOPGEN   3392
#define XCD_BAR_WORDS 3456
#define XB_SPIN_CAP (1u << 21)
#define LAS __attribute__((address_space(3)))
DI unsigned xb_ld(unsigned* p)              { return __hip_atomic_load(p, __ATOMIC_RELAXED, __HIP_MEMORY_SCOPE_AGENT); }
DI unsigned xb_add(unsigned* p, unsigned v) { return __hip_atomic_fetch_add(p, v, __ATOMIC_RELAXED, __HIP_MEMORY_SCOPE_AGENT); }
DI unsigned xb_xcc_id() { return (unsigned)__builtin_amdgcn_s_getreg((3 << 11) | 20) & 0xFu; }
#define XB_SPIN(cond, bar) do { unsigned _sp = 0; while (cond) { __builtin_amdgcn_s_sleep(1); \
    if ((++_sp & 255u) == 0u) { if (xb_ld(&(bar)[XB_TMO])) break; if (_sp > XB_SPIN_CAP) { atomicAdd(&(bar)[XB_TMO], 1u); break; } } } } while (0)
struct XcdBarrier { unsigned* bar; unsigned x; volatile LAS unsigned* st; };
DI XcdBarrier xcd_barrier_post(unsigned* bar, volatile LAS unsigned* st) {
  XcdBarrier b; b.bar = bar; b.x = xb_xcc_id(); b.st = st;
  if (threadIdx.x == 0) { const unsigned rank = xb_add(&bar[XB_XCNT(b.x)], 1u); st[2] = rank; }
  return b;
}
DI void xcd_barrier_complete(unsigned* bar, unsigned x, unsigned& nloc, unsigned& nx) {
  const unsigned G = gridDim.x * gridDim.y * gridDim.z;
  unsigned sum, cnt, mine, sp = 0u;
  for (;;) {
    sum = 0u; cnt = 0u; mine = 0u;
#pragma unroll
    for (unsigned j = 0; j < 16; ++j) { const unsigned c = xb_ld(&bar[XB_XCNT(j)]); sum += c; cnt += (c > 0u) ? 1u : 0u; mine = (j == x) ? c : mine; }
    if (sum == G) break;
    __builtin_amdgcn_s_sleep(1);
    if ((++sp & 255u) == 0u) { if (xb_ld(&bar[XB_TMO])) break; if (sp > XB_SPIN_CAP) { atomicAdd(&bar[XB_TMO], 1u); break; } }
  }
  nloc = mine > 0u ? mine : 1u; nx = cnt > 0u ? cnt : 1u;
}
DI void xcd_barrier(const XcdBarrier& b) {
  asm volatile("s_waitcnt vmcnt(0)" ::: "memory");
  __syncthreads();
  if (threadIdx.x == 0) {
    unsigned* bar = b.bar;
    __builtin_amdgcn_s_waitcnt(0);
    unsigned nloc = b.st[0], nx = b.st[1];
    if (nloc == 0u) { xcd_barrier_complete(bar, b.x, nloc, nx); b.st[0] = nloc; b.st[1] = nx; }
    const unsigned old = xb_add(&bar[XB_XSUB(b.x)], 1u);
    const unsigned gen = old / nloc;
    if (old + 1u == (gen + 1u) * nloc) {
      __builtin_amdgcn_fence(__ATOMIC_RELEASE, "agent");
      asm volatile("s_waitcnt vmcnt(0)" ::: "memory");
      const unsigned og = xb_add(&bar[XB_TOP], 1u);
      const unsigned tg = og / nx;
      if (og + 1u == (tg + 1u) * nx) xb_add(&bar[XB_TOPGEN], 1u);
      else XB_SPIN(xb_ld(&bar[XB_TOPGEN]) == tg, bar);
      __builtin_amdgcn_fence(__ATOMIC_ACQUIRE, "agent");
      xb_add(&bar[XB_XGEN(b.x)], 1u);
      asm volatile("s_waitcnt vmcnt(0)" ::: "memory");
    } else {
      XB_SPIN(xb_ld(&bar[XB_XGEN(b.x)]) == gen, bar);
      __builtin_amdgcn_fence(__ATOMIC_ACQUIRE, "agent");
      asm volatile("s_waitcnt vmcnt(0)" ::: "memory");
    }
  }
  __syncthreads();
}
constexpr size_t O_BAR = O_MISC + 16384;
constexpr size_t O_ROPE = O_MISC + 65536;

struct Params {
  const float* x_prompt; const float* x_sample;
  const float* ffn1_norm; const float* ffn1_w_in; const float* ffn1_w_out; const float* mix_norm; const float* w_in;
  const float* hy_conv_w; const float* hy_conv_b; const float* hy_w1; const float* hy_b1; const float* hy_w2; const float* hy_b2;
  const float* hy_w3; const float* hy_freq; const float* hy_skip;
  const float* gqa_q_norm; const float* gqa_k_norm; const float* diff_lambda; const float* diff_subln; const float* rel_bias;
  const float* w_branch; const float* w_out; const float* ffn2_norm; const float* ffn2_w_in; const float* ffn2_w_out; const float* final_norm;
  float* out; char* ws;
};

DI unsigned pack2(float a, float b) { f2_t v = {a, b}; bf2_t r = __builtin_convertvector(v, bf2_t); return __builtin_bit_cast(unsigned, r); }
DI u16 f2bf(float a) { return (u16)(pack2(a, 0.f) & 0xffffu); }
DI float bf2f(u16 v) { return __uint_as_float(((unsigned)v) << 16); }
DI float bflo(unsigned v) { return __uint_as_float(v << 16); }
DI float bfhi(unsigned v) { return __uint_as_float(v & 0xffff0000u); }
DI int otid() { int t = threadIdx.x; asm volatile("" : "+v"(t)); return t; }
DI float xhalf_max(float x) {
  typedef unsigned u2_t __attribute__((ext_vector_type(2)));
  const u2_t rr = __builtin_amdgcn_permlane32_swap(__float_as_uint(x), __float_as_uint(x), false, false);
  return fmaxf(__uint_as_float(rr[0]), __uint_as_float(rr[1]));
}
DI float xhalf_sum(float x) {
  typedef unsigned u2_t __attribute__((ext_vector_type(2)));
  const u2_t rr = __builtin_amdgcn_permlane32_swap(__float_as_uint(x), __float_as_uint(x), false, false);
  return __uint_as_float(rr[0]) + __uint_as_float(rr[1]);
}
DI int crow(int reg, int h) { return (reg & 3) + 8 * (reg >> 2) + 4 * h; }
DI float wave_sum(float v) {
  v += __shfl_xor(v, 32); v += __shfl_xor(v, 16); v += __shfl_xor(v, 8); v += __shfl_xor(v, 4); v += __shfl_xor(v, 2); v += __shfl_xor(v, 1);
  return v;
}
DI float half_sum(float v) {
  v += __shfl_xor(v, 16); v += __shfl_xor(v, 8); v += __shfl_xor(v, 4); v += __shfl_xor(v, 2); v += __shfl_xor(v, 1);
  return v;
}

DI void convT_tile(const float* __restrict__ src, int K, int N, u16* __restrict__ dst, int kt, int nt, int perm_half, char* smem) {
  float* t = (float*)smem;
  const int tid = otid() & 255;
  __syncthreads();
  {
    const int col = tid & 63, r0 = tid >> 6;
#pragma unroll
    for (int i = 0; i < 16; ++i) { int row = r0 + 4 * i; t[row * 65 + col] = src[(size_t)(kt * 64 + row) * N + nt * 64 + col]; }
  }
  __syncthreads();
  {
    const int nl = tid >> 2, kq = tid & 3;
    int n = nt * 64 + nl;
    if (perm_half > 0) { if (n < perm_half) n = (n >> 7) * 256 + (n & 127); else { int j = n - perm_half; n = (j >> 7) * 256 + 128 + (j & 127); } }
    u32x4 o0, o1;
#pragma unroll
    for (int i = 0; i < 4; ++i) {
      o0[i] = pack2(t[(kq * 16 + 2 * i) * 65 + nl], t[(kq * 16 + 2 * i + 1) * 65 + nl]);
      o1[i] = pack2(t[(kq * 16 + 8 + 2 * i) * 65 + nl], t[(kq * 16 + 8 + 2 * i + 1) * 65 + nl]);
    }
    u16* d = dst + (size_t)n * K + kt * 64 + kq * 16;
    *(u32x4*)d = o0; *(u32x4*)(d + 8) = o1;
  }
}

DI void filter_item(const Params& P, int layer, int L, int tb, u16* __restrict__ G, char* smem) {
  float* h1 = (float*)smem;
  float* h2 = h1 + 64 * 65;
  const int tid = otid() & 255, lane = tid & 63, w = __builtin_amdgcn_readfirstlane(tid >> 6);
  const float* w1 = P.hy_w1 + layer * 33 * 64; const float* b1 = P.hy_b1 + layer * 64;
  const float* w2 = P.hy_w2 + layer * 64 * 64; const float* b2 = P.hy_b2 + layer * 64;
  const float* w3 = P.hy_w3 + layer * 64 * 1024; const float* fr = P.hy_freq + layer * 64;
  const int t = tb * 64 + lane;
  const float tl = (float)t / (float)(L - 1);
  __syncthreads();
  {
    float a[16];
#pragma unroll
    for (int u = 0; u < 16; ++u) a[u] = b1[w * 16 + u] + tl * w1[w * 16 + u];
    const float base = (float)(2.0 * 3.14159265358979323846 / (double)L) * (float)t;
    for (int b = 0; b < 16; ++b) {
      const float band = 1e-4f + (float)b * ((15.0f - 1e-4f) / 15.0f);
      const float ang = base * band;
      const float cs = cosf(ang), sn = -sinf(ang);
#pragma unroll
      for (int u = 0; u < 16; ++u) a[u] += cs * w1[(1 + b) * 64 + w * 16 + u] + sn * w1[(17 + b) * 64 + w * 16 + u];
    }
#pragma unroll
    for (int u = 0; u < 16; ++u) h1[lane * 65 + w * 16 + u] = sinf(fr[w * 16 + u] * a[u]);
  }
  __syncthreads();
  {
    float a[16];
#pragma unroll
    for (int u = 0; u < 16; ++u) a[u] = b2[w * 16 + u];
    for (int k = 0; k < 64; ++k) {
      const float hv = h1[lane * 65 + k];
#pragma unroll
      for (int u = 0; u < 16; ++u) a[u] += hv * w2[k * 64 + w * 16 + u];
    }
#pragma unroll
    for (int u = 0; u < 16; ++u) h2[lane * 65 + w * 16 + u] = sinf(fr[w * 16 + u] * a[u]);
  }
  __syncthreads();
  const float min_decay = -3.0701134573253946f, max_decay = -15.350567286626973f;
  for (int og = 0; og < 64; ++og) {
    const int o = w * 256 + og * 4;
    float a0 = 0.f, a1 = 0.f, a2 = 0.f, a3 = 0.f;
#pragma unroll 4
    for (int k = 0; k < 64; ++k) {
      const float hv = h2[lane * 65 + k];
      const f32x4 wv = *(const f32x4*)(w3 + k * 1024 + o);
      a0 += hv * wv[0]; a1 += hv * wv[1]; a2 += hv * wv[2]; a3 += hv * wv[3];
    }
    float av[4] = {a0, a1, a2, a3};
#pragma unroll
    for (int q = 0; q < 4; ++q) {
      const int oo = o + q; const int ch = oo & 511;
      const float delta = min_decay + (float)ch * ((max_decay - min_decay) / 511.0f);
      const float val = av[q] * expf(-tl * fabsf(delta));
      u16* Gc = G + (size_t)ch * (2 * L);
      if (oo < 512) Gc[L - t] = f2bf(val);
      else { if (t >= 1) Gc[L + t] = f2bf(val); else Gc[0] = 0; }
    }
  }
}

DI void norm_row_bf16(const float* __restrict__ x, const float* __restrict__ g, u16* __restrict__ out, int lane) {
  f32x4 v[4]; float ss = 0.f;
#pragma unroll
  for (int i = 0; i < 4; ++i) { v[i] = *(const f32x4*)(x + lane * 4 + 256 * i); ss += v[i][0] * v[i][0] + v[i][1] * v[i][1] + v[i][2] * v[i][2] + v[i][3] * v[i][3]; }
  ss = wave_sum(ss);
  const float rs = rsqrtf(ss * (1.0f / 1024.0f) + 1e-6f);
#pragma unroll
  for (int i = 0; i < 4; ++i) {
    const f32x4 gg = *(const f32x4*)(g + lane * 4 + 256 * i);
    u32x2 o; o[0] = pack2(v[i][0] * rs * gg[0], v[i][1] * rs * gg[1]); o[1] = pack2(v[i][2] * rs * gg[2], v[i][3] * rs * gg[3]);
    *(u32x2*)(out + lane * 4 + 256 * i) = o;
  }
}
DI void norm_row_f32_inplace(float* __restrict__ x, const float* __restrict__ g, int lane) {
  f32x4 v[4]; float ss = 0.f;
#pragma unroll
  for (int i = 0; i < 4; ++i) { v[i] = *(const f32x4*)(x + lane * 4 + 256 * i); ss += v[i][0] * v[i][0] + v[i][1] * v[i][1] + v[i][2] * v[i][2] + v[i][3] * v[i][3]; }
  ss = wave_sum(ss);
  const float rs = rsqrtf(ss * (1.0f / 1024.0f) + 1e-6f);
#pragma unroll
  for (int i = 0; i < 4; ++i) {
    const f32x4 gg = *(const f32x4*)(g + lane * 4 + 256 * i);
    f32x4 o; o[0] = v[i][0] * rs * gg[0]; o[1] = v[i][1] * rs * gg[1]; o[2] = v[i][2] * rs * gg[2]; o[3] = v[i][3] * rs * gg[3];
    *(f32x4*)(x + lane * 4 + 256 * i) = o;
  }
}

namespace pg8 {
#define PG8_LAS __attribute__((address_space(3)))
typedef unsigned short bf16_t;
typedef short bf16x8 __attribute__((ext_vector_type(8)));
typedef float f32x4 __attribute__((ext_vector_type(4)));
typedef unsigned u32x4 __attribute__((ext_vector_type(4)));
constexpr int BM = 256, BK = 64, HALF = 128, HTB = HALF * BK * 2  , STAGE_BYTES = 8 * HTB, NXCD = 8, WGM = 8;

__host__ __device__ __forceinline__ int lds_byte(int r, int c) { const int st = (r >> 4) * 2 + (c >> 5), rr = r & 15, cc = c & 31, ob = rr * 64 + cc * 2; return st * 1024 + (ob ^ (((ob >> 9) & 1) << 5)); }
__host__ __device__ __forceinline__ void stage_rc(int b, int& R, int& C) { const int st = b / 1024, sb = b % 1024, swz = sb ^ (((sb >> 9) & 1) << 5); R = (st >> 1) * 16 + swz / 64; C = (st & 1) * 32 + (swz % 64) / 2; }
__host__ __device__ __forceinline__ int perm32(int rho) { const int n = rho >> 4, i = rho & 15; return 8 * (i >> 2) + 4 * n + (i & 3); }

struct Unit { int pm, pn; };
struct Gemm { const bf16_t* A; const bf16_t* Bt; int M, N, K; };

struct StaticOrder {
    int nM, nN, nwg, G, c;
    __host__ __device__ void init(int M, int N, int G_, int c_) { nM = M / BM; nN = N / BM; nwg = nM * nN; G = G_; c = c_; }
    __host__ __device__ bool next(int i, Unit& u) const {
        const long L = (long)i * G + c; if (L >= nwg) return false;
        int wgid = (int)L; { const int q = nwg / NXCD, r = nwg % NXCD, xcd = wgid % NXCD, off = wgid / NXCD; wgid = (xcd < r ? xcd * (q + 1) : r * (q + 1) + (xcd - r) * q) + off; }
        const int nig = WGM * nN, gid = wgid / nig, fm = gid * WGM, gsz = (nM - fm) < WGM ? (nM - fm) : WGM;
        u.pm = fm + ((wgid % nig) % gsz); u.pn = (wgid % nig) / gsz; return true;
    }
    __device__ __forceinline__ void a_ready(const Unit&) const {}
    __device__ __forceinline__ void done(const Unit&) const {}
};

template <class Epi, class Sched, bool STAMP = false>
__device__ __forceinline__ void gemm_phase(PG8_LAS unsigned char* lds, const Gemm g, const Sched& S, const Epi& E, unsigned long long* stamps) {
    const int tid = otid(), wid = __builtin_amdgcn_readfirstlane(tid >> 6), lane = tid & 63, wr = wid >> 2, wc = wid & 3, fr = lane & 15, fq = lane >> 4;
    const int K = g.K, nt = K / BK;
    int ts_lo = 0, ts_hi = 0, nts = 0; const unsigned long long rt_entry = STAMP ? (unsigned long long)wall_clock64() : 0ull;
#define PG8_STAMP() do { if (STAMP && wid == 0 && nts < 64) { const unsigned long long _c = (unsigned long long)clock64(); \
        ts_lo = (lane == nts) ? (int)(unsigned)_c : ts_lo; ts_hi = (lane == nts) ? (int)(unsigned)(_c >> 32) : ts_hi; ++nts; } } while (0)
    PG8_STAMP();
    unsigned voffA[2], voffB[2];
#pragma unroll
    for (int i = 0; i < 2; ++i) { int R, C; stage_rc(tid * 16 + i * 8192, R, C); const int Rb = E.perm ? ((R & ~31) + perm32(R & 31)) : R;
        voffA[i] = (unsigned)(R * K + C) * 2u; voffB[i] = (unsigned)(Rb * K + C) * 2u; }
    const size_t kstep = (size_t)(BK * 2);
    const size_t hstep = (size_t)HALF * K * 2;
    const size_t tstep = 2 * hstep;
    const unsigned ldsw = (unsigned)wid * 1024u;
    const int aoff = lds_byte(wr * 64 + fr, fq * 8), boff = lds_byte(wc * 32 + fr, fq * 8);
#define PG8_SA(b, h) (((b) * 2 + (h)) * HTB)
#define PG8_SB(b, h) ((4 + (b) * 2 + (h)) * HTB)
#define PG8_STAGE(bufoff, gbase, voff) do { _Pragma("unroll") for (int _i = 0; _i < 2; ++_i) \
        __builtin_amdgcn_global_load_lds((const unsigned*)((const char*)(gbase) + (voff)[_i]), (PG8_LAS unsigned*)(lds + (bufoff) + ldsw + _i * 8192), 16, 0, 0); } while (0)
#define PG8_LDA(dst, b, h) do { _Pragma("unroll") for (int m = 0; m < 4; ++m) _Pragma("unroll") for (int k = 0; k < 2; ++k) dst[m][k] = *(const PG8_LAS bf16x8*)(lds + PG8_SA(b, h) + aoff + m * 2048 + k * 1024); } while (0)
#define PG8_LDB(dst, b, h) do { _Pragma("unroll") for (int n = 0; n < 2; ++n) _Pragma("unroll") for (int k = 0; k < 2; ++k) dst[n][k] = *(const PG8_LAS bf16x8*)(lds + PG8_SB(b, h) + boff + n * 2048 + k * 1024); } while (0)
#define PG8_MMA(ai, bj, At, Bt) do { __builtin_amdgcn_s_setprio(1); _Pragma("unroll") for (int m = 0; m < 4; ++m) _Pragma("unroll") for (int n = 0; n < 2; ++n) _Pragma("unroll") for (int k = 0; k < 2; ++k) \
        acc[ai][bj][m][n] = __builtin_amdgcn_mfma_f32_16x16x32_bf16(Bt[n][k], At[m][k], acc[ai][bj][m][n], 0, 0, 0); __builtin_amdgcn_s_setprio(0); } while (0)
#define PG8_WAIT_V(n) asm volatile("s_waitcnt vmcnt(" #n ")" ::: "memory")
#define PG8_WAIT_L(n) asm volatile("s_waitcnt lgkmcnt(" #n ")" ::: "memory")
#define PG8_BAR __builtin_amdgcn_s_barrier()
#define PG8_SCHED __builtin_amdgcn_sched_barrier(0)
    Unit cur, nxt; int ui = 0;
    if (!S.next(0, cur)) return;
    f32x4 acc[2][2][4][2];
#pragma unroll
    for (int a = 0; a < 2; ++a)
#pragma unroll
        for (int b = 0; b < 2; ++b)
#pragma unroll
            for (int m = 0; m < 4; ++m)
#pragma unroll
                for (int n = 0; n < 2; ++n) acc[a][b][m][n] = (f32x4){0.f, 0.f, 0.f, 0.f};
    bf16x8 At[4][2], B0[2][2], B1[2][2];
    const char* cA = (const char*)g.A + (size_t)cur.pm * tstep; const char* cB = (const char*)g.Bt + (size_t)cur.pn * tstep;
    S.a_ready(cur);
    PG8_STAGE(PG8_SB(0, 0), cB, voffB); PG8_STAGE(PG8_SA(0, 0), cA, voffA); PG8_STAGE(PG8_SB(0, 1), cB + hstep, voffB); PG8_STAGE(PG8_SA(0, 1), cA + hstep, voffA);
    if (wr == 1) PG8_BAR;
    PG8_WAIT_V(4); PG8_BAR;
    PG8_STAGE(PG8_SB(1, 0), cB + kstep, voffB); PG8_STAGE(PG8_SA(1, 0), cA + kstep, voffA); PG8_STAGE(PG8_SB(1, 1), cB + hstep + kstep, voffB);
    PG8_WAIT_V(6); PG8_BAR;
    PG8_STAMP();
    for (;;) {
        const bool has_next = S.next(ui + 1, nxt);
        const char* nA = has_next ? (const char*)g.A + (size_t)nxt.pm * tstep : cA; const char* nB = has_next ? (const char*)g.Bt + (size_t)nxt.pn * tstep : cB;
        for (int t = 0; t < nt; t += 2) {
            const bool last = (t == nt - 2);
            const char* a1 = cA + (size_t)(t + 1) * kstep;
            const char* a2 = last ? nA : cA + (size_t)(t + 2) * kstep; const char* b2 = last ? nB : cB + (size_t)(t + 2) * kstep;
            const char* a3 = a2 + kstep; const char* b3 = b2 + kstep;
            if (last && has_next) S.a_ready(nxt);
            PG8_LDB(B0, 0, 0); PG8_SCHED; PG8_LDA(At, 0, 0); PG8_STAGE(PG8_SA(1, 1), a1 + hstep, voffA);
            PG8_WAIT_L(8); PG8_BAR; PG8_WAIT_L(0); PG8_MMA(0, 0, At, B0); PG8_BAR; PG8_SCHED;
            PG8_LDB(B1, 0, 1); PG8_STAGE(PG8_SB(0, 0), b2, voffB);
            PG8_BAR; PG8_WAIT_L(0); PG8_MMA(0, 1, At, B1); PG8_BAR;
            PG8_LDA(At, 0, 1); PG8_STAGE(PG8_SA(0, 0), a2, voffA);
            PG8_BAR; PG8_WAIT_L(0); PG8_MMA(1, 0, At, B0); PG8_BAR; PG8_SCHED;
            PG8_STAGE(PG8_SB(0, 1), b2 + hstep, voffB);
            PG8_WAIT_V(6); PG8_BAR; PG8_MMA(1, 1, At, B1); PG8_BAR;
            PG8_LDB(B0, 1, 0); PG8_SCHED; PG8_LDA(At, 1, 0); PG8_STAGE(PG8_SA(0, 1), a2 + hstep, voffA);
            PG8_WAIT_L(8); PG8_BAR; PG8_WAIT_L(0); PG8_MMA(0, 0, At, B0); PG8_BAR; PG8_SCHED;
            PG8_LDB(B1, 1, 1); PG8_STAGE(PG8_SB(1, 0), b3, voffB);
            PG8_BAR; PG8_WAIT_L(0); PG8_MMA(0, 1, At, B1); PG8_BAR;
            PG8_LDA(At, 1, 1); PG8_STAGE(PG8_SA(1, 0), a3, voffA);
            PG8_BAR; PG8_WAIT_L(0); PG8_MMA(1, 0, At, B0); PG8_BAR; PG8_SCHED;
            PG8_STAGE(PG8_SB(1, 1), b3 + hstep, voffB);
            PG8_WAIT_V(6); PG8_BAR; PG8_MMA(1, 1, At, B1); PG8_BAR;
        }
        PG8_STAMP();
        if constexpr (!Epi::AFTER_DRAIN) { E(acc, cur, wr, wc, fr, fq); S.done(cur); }
        PG8_STAMP();
        if (!has_next) break;
        if (!E.keep_acc(cur)) {
#pragma unroll
        for (int a = 0; a < 2; ++a)
#pragma unroll
            for (int b = 0; b < 2; ++b)
#pragma unroll
                for (int m = 0; m < 4; ++m)
#pragma unroll
                    for (int n = 0; n < 2; ++n) acc[a][b][m][n] = (f32x4){0.f, 0.f, 0.f, 0.f};
        }
        cur = nxt; cA = nA; cB = nB; ++ui;
    }
    PG8_WAIT_V(0);
    if (wr == 0) PG8_BAR;
    PG8_BAR;
    if constexpr (Epi::AFTER_DRAIN) { E.fused(acc, cur, wr, wc, fr, fq, lds, wid, lane); S.done(cur); }
    PG8_STAMP();
    if (STAMP && wid == 0) { stamps[lane] = lane < nts ? (((unsigned long long)(unsigned)ts_hi << 32) | (unsigned)ts_lo) : 0ull;
        if (lane == 62) stamps[62] = rt_entry; if (lane == 63) stamps[63] = (unsigned long long)wall_clock64(); }
#undef PG8_STAMP
#undef PG8_SA
#undef PG8_SB
#undef PG8_STAGE
#undef PG8_LDA
#undef PG8_LDB
#undef PG8_MMA
#undef PG8_WAIT_V
#undef PG8_WAIT_L
#undef PG8_BAR
#undef PG8_SCHED
}
}

enum { EPI_SWIGLU = 0, EPI_RESID = 1, EPI_PROJ = 2, EPI_MERGE = 3 };
struct AnyOrder : pg8::StaticOrder {
  bool merge3;
  __device__ __forceinline__ bool next(int i, pg8::Unit& u) const {
    if (!merge3) return pg8::StaticOrder::next(i, u);
    const int ti = i / 3, br = i - ti * 3; pg8::Unit t;
    if (!pg8::StaticOrder::next(ti, t)) return false;
    u.pm = t.pm + 64 * br; u.pn = t.pn + 4 * br; return true;
  }
};
struct EpiAny {
  static constexpr bool AFTER_DRAIN = false;
  int mode; bool perm;
  u16* O; int ldo; const float* xin; float* xout; float scale; const u16* gate; float* macc; int br;
  DI bool keep_acc(const pg8::Unit&) const { return false; }
  DI void operator()(pg8::f32x4 (&acc)[2][2][4][2], const pg8::Unit& u, int wr, int wc, int fr, int fq) const {
    const int row0 = (u.pm & 63) * 256 + wr * 64 + fr;
    if (mode == EPI_SWIGLU) {
      const int col0 = u.pn * 128 + wc * 32 + 8 * fq;
#pragma unroll
      for (int ai = 0; ai < 2; ++ai)
#pragma unroll
        for (int m = 0; m < 4; ++m) {
          float v[8];
#pragma unroll
          for (int n = 0; n < 2; ++n)
#pragma unroll
            for (int e = 0; e < 4; ++e) { const float gv = acc[ai][0][m][n][e], uv = acc[ai][1][m][n][e]; v[4 * n + e] = gv * __builtin_amdgcn_rcpf(1.0f + __builtin_amdgcn_exp2f(-LOG2E * gv)) * uv; }
          u32x4 o; o[0] = pack2(v[0], v[1]); o[1] = pack2(v[2], v[3]); o[2] = pack2(v[4], v[5]); o[3] = pack2(v[6], v[7]);
          *(u32x4*)(O + (size_t)(row0 + ai * 128 + m * 16) * ldo + col0) = o;
        }
    } else if (mode == EPI_PROJ) {
      const int col0 = u.pn * 256 + wc * 32 + 8 * fq;
      const bool sg = (u.pn * 256 >= OFF_GATE);
#pragma unroll
      for (int ai = 0; ai < 2; ++ai)
#pragma unroll
        for (int m = 0; m < 4; ++m)
#pragma unroll
          for (int bj = 0; bj < 2; ++bj) {
            float v[8];
#pragma unroll
            for (int n = 0; n < 2; ++n)
#pragma unroll
              for (int e = 0; e < 4; ++e) { float t = acc[ai][bj][m][n][e]; if (sg) t = __builtin_amdgcn_rcpf(1.0f + __builtin_amdgcn_exp2f(-LOG2E * t)); v[4 * n + e] = t; }
            u32x4 o; o[0] = pack2(v[0], v[1]); o[1] = pack2(v[2], v[3]); o[2] = pack2(v[4], v[5]); o[3] = pack2(v[6], v[7]);
            *(u32x4*)(O + (size_t)(row0 + ai * 128 + m * 16) * INC + col0 + bj * 128) = o;
          }
    } else if (mode == EPI_RESID) {
      const int col0 = u.pn * 256 + wc * 32 + 4 * fq;
#pragma unroll
      for (int ai = 0; ai < 2; ++ai)
#pragma unroll
        for (int m = 0; m < 4; ++m)
#pragma unroll
          for (int bj = 0; bj < 2; ++bj)
#pragma unroll
            for (int n = 0; n < 2; ++n) {
              const size_t idx = (size_t)(row0 + ai * 128 + m * 16) * DM + col0 + bj * 128 + n * 16;
              f32x4 xv = *(const f32x4*)(xin + idx);
#pragma unroll
              for (int e = 0; e < 4; ++e) xv[e] += scale * acc[ai][bj][m][n][e];
              *(f32x4*)(xout + idx) = xv;
            }
    }
  }
  DI u16* outb_() const { return O; }
};

struct EpiMerge {
  static constexpr bool AFTER_DRAIN = false;
  bool perm; const u16* gate; u16* O;
  DI bool keep_acc(const pg8::Unit& u) const { return (u.pm >> 6) < 2; }
  DI void operator()(pg8::f32x4 (&acc)[2][2][4][2], const pg8::Unit& u, int wr, int wc, int fr, int fq) const {
    const int row0 = (u.pm & 63) * 256 + wr * 64 + fr;
    const int col0 = (u.pn & 3) * 256 + wc * 32 + 8 * fq; const int br = u.pm >> 6;
#pragma unroll
    for (int ai = 0; ai < 2; ++ai)
#pragma unroll
      for (int m = 0; m < 4; ++m)
#pragma unroll
        for (int bj = 0; bj < 2; ++bj) {
          const int row = row0 + ai * 128 + m * 16, col = col0 + bj * 128;
          const u16* gp = gate + (size_t)row * INC + OFF_GATE + br * DM + col;
          const u32x4 ga = *(const u32x4*)gp;
          float g0[8];
#pragma unroll
          for (int q = 0; q < 4; ++q) { g0[2 * q] = bflo(ga[q]); g0[2 * q + 1] = bfhi(ga[q]); }
          if (br < 2) {
            const u32x4 gb = *(const u32x4*)(gp + DM);
#pragma unroll
            for (int q = 0; q < 4; ++q) {
              const float r0 = g0[2 * q] * __builtin_amdgcn_rcpf(fmaxf(bflo(gb[q]), 1e-30f)), r1 = g0[2 * q + 1] * __builtin_amdgcn_rcpf(fmaxf(bfhi(gb[q]), 1e-30f));
              acc[ai][bj][m][q >> 1][2 * (q & 1)] *= r0; acc[ai][bj][m][q >> 1][2 * (q & 1) + 1] *= r1;
            }
          } else {
            u32x4 o;
#pragma unroll
            for (int q = 0; q < 4; ++q) o[q] = pack2(acc[ai][bj][m][q >> 1][2 * (q & 1)] * g0[2 * q], acc[ai][bj][m][q >> 1][2 * (q & 1) + 1] * g0[2 * q + 1]);
            *(u32x4*)(O + (size_t)row * DM + col) = o;
          }
        }
  }
};

DI void qk_prep_item(const Params& P, int layer, u16* __restrict__ p, int L, int it, const float* __restrict__ rope) {
  const int tid = otid() & 255, lane = tid & 63, w = __builtin_amdgcn_readfirstlane(tid >> 6);
  const int u = it * 8 + w * 2 + (lane >> 5);
  const int tok = u / 10, hd = u - tok * 10;
  const int i = lane & 31;
  const int col0 = (hd < 8) ? (OFF_GQ + hd * 64) : (OFF_GK + (hd - 8) * 64);
  const float* gn = (hd < 8) ? (P.gqa_q_norm + layer * 64) : (P.gqa_k_norm + layer * 64);
  unsigned* ptr = (unsigned*)(p + (size_t)tok * INC + col0) + i;
  const unsigned v = *ptr;
  float a = bflo(v), b = bfhi(v);
  const float ss = half_sum(a * a + b * b);
  const float rs = rsqrtf(ss * (1.0f / 64.0f) + 1e-6f);
  a = a * rs * gn[2 * i]; b = b * rs * gn[2 * i + 1];
  const int tl = tok % L;
  const int jj = i & 15;
  const float* rt = rope + ((i < 16) ? ((tl >> 6) * 16 + jj) : (4096 + (tl & 63) * 16 + jj)) * 2;
  const float c = rt[0], s = rt[1];
  *ptr = pack2(a * c - b * s, a * s + b * c);
}

DI void transpose_item(const Params& P, int layer, const u16* __restrict__ p, int L, int kind, int ct, int tt, u16* __restrict__ dst, char* smem) {
  u16* tile = (u16*)smem;
  const int tid = otid() & 255;
  const int t0 = tt * 64;
  const int seq = t0 / L, tl0 = t0 - seq * L;
  const int C = (kind == 0) ? 128 : 512;
  __syncthreads();
  {
    const int col = tid & 63, r0 = tid >> 6;
    const int cidx = ct * 64 + col;
    if (kind < 2) {
      const int off = (kind == 0 ? OFF_GV : OFF_DV) + cidx;
#pragma unroll
      for (int i = 0; i < 16; ++i) { const int row = r0 + 4 * i; tile[col * 72 + row] = p[(size_t)(t0 + row) * INC + off]; }
    } else {
      const float* cw = P.hy_conv_w + layer * 3 * 1536; const float* cb = P.hy_conv_b + layer * 1536;
      const int c1 = 512 + cidx, c2 = 1024 + cidx;
      const float w10 = cw[c1], w11 = cw[1536 + c1], w12 = cw[3072 + c1], b1 = cb[c1];
      const float w20 = cw[c2], w21 = cw[1536 + c2], w22 = cw[3072 + c2], b2 = cb[c2];
#pragma unroll
      for (int i = 0; i < 16; ++i) {
        const int row = r0 + 4 * i; const int tl = tl0 + row;
        const u16* pr = p + (size_t)(t0 + row) * INC;
        const float xm1 = (tl > 0) ? bf2f(pr[c1 - INC]) : 0.f, x0 = bf2f(pr[c1]), xp1 = (tl < L - 1) ? bf2f(pr[c1 + INC]) : 0.f;
        const float vm1 = (tl > 0) ? bf2f(pr[c2 - INC]) : 0.f, v0 = bf2f(pr[c2]), vp1 = (tl < L - 1) ? bf2f(pr[c2 + INC]) : 0.f;
        const float x1c = xm1 * w10 + x0 * w11 + xp1 * w12 + b1;
        const float vc = vm1 * w20 + v0 * w21 + vp1 * w22 + b2;
        tile[col * 72 + row] = f2bf(vc * x1c);
      }
    }
  }
  __syncthreads();
  {
    const int c = tid >> 2, q = tid & 3;
    const u32x4 a = *(const u32x4*)(tile + c * 72 + q * 16), b = *(const u32x4*)(tile + c * 72 + q * 16 + 8);
    u16* d = dst + ((size_t)seq * C + ct * 64 + c) * L + tl0 + q * 16;
    *(u32x4*)d = a; *(u32x4*)(d + 8) = b;
  }
}

DI int kperm(int rho) { return (rho & ~0xC) | ((rho & 4) << 1) | ((rho & 8) >> 1); }
template <int DV, bool BIAS, bool SWAP>
DI void attn_tile(const u16* __restrict__ Qp, const u16* __restrict__ Kp, const u16* __restrict__ VTp, int L,
                  u16* __restrict__ Op, int ldo, int q0, const float* __restrict__ btab, char* smem) {
  constexpr int NDT = DV / 32;
  constexpr int VCH = DV / 64;
  constexpr int KS_SZ = 64 * 64, VS_SZ = DV * 64;
  constexpr int NL = 1 + VCH;
  u16* Ks = (u16*)smem;
  u16* Vs = Ks + 4 * KS_SZ;
  float* bt = (float*)(Vs + 3 * VS_SZ);
  const int tid = otid(), lane = tid & 63, w = __builtin_amdgcn_readfirstlane(tid >> 6), r = lane & 31, h = lane >> 5;
  const float sc = 0.125f * LOG2E;
  __syncthreads();
  if (BIAS) { for (int i = tid; i < 257; i += 512) bt[i] = btab[i]; }
  bf16x8 qf[4];
  {
    const u16* qrow = Qp + (size_t)(q0 + 32 * w + r) * INC + 8 * h;
#pragma unroll
    for (int s = 0; s < 4; ++s) qf[s] = *(const bf16x8*)(qrow + 16 * s);
  }
  const int qpos = q0 + 32 * w + r;
  f32x16 O[NDT];
#pragma unroll
  for (int d = 0; d < NDT; ++d)
#pragma unroll
    for (int q = 0; q < 16; ++q) O[d][q] = 0.f;
  float m = -INFINITY, l = 0.f;
  const int lrow = tid >> 3, lsw = (tid & 7) ^ ((tid >> 4) & 7);
  const u16* Kg0 = Kp + (size_t)kperm(lrow) * INC + lsw * 8;
  const u16* Vg = VTp + (size_t)lrow * L + lsw * 8;
  const int ksw = (r >> 1) & 7;
  const int nkb = L >> 6;
#define ATT_LOADK(tile, bufp) do { const int t__ = ((tile) < nkb) ? (tile) : nkb - 1; \
    __builtin_amdgcn_global_load_lds((const unsigned*)(Kg0 + ((size_t)t__ * 64) * INC), (unsigned*)((char*)(bufp) + tid * 16), 16, 0, 0); } while (0)
#define ATT_LOADV(tile, bufp) do { const int t__ = ((tile) < nkb) ? (tile) : nkb - 1; _Pragma("unroll") for (int i_ = 0; i_ < VCH; ++i_) \
    __builtin_amdgcn_global_load_lds((const unsigned*)(Vg + (size_t)(64 * i_) * L + (size_t)t__ * 64), (unsigned*)((char*)(bufp) + tid * 16 + i_ * 8192), 16, 0, 0); } while (0)
  f32x16 Sc[2];
  auto qk = [&](const u16* Kb) __attribute__((always_inline)) {
    bf16x8 kf[2][4];
#pragma unroll
    for (int kt = 0; kt < 2; ++kt)
#pragma unroll
      for (int s = 0; s < 4; ++s) kf[kt][s] = *(const bf16x8*)(Kb + (32 * kt + r) * 64 + (((2 * s + h) ^ ksw) << 3));
#pragma unroll
    for (int kt = 0; kt < 2; ++kt) {
#pragma unroll
      for (int q = 0; q < 16; ++q) Sc[kt][q] = 0.f;
#pragma unroll
      for (int s = 0; s < 4; ++s) Sc[kt] = MFMA(kf[kt][s], qf[s], Sc[kt]);
    }
    __builtin_amdgcn_sched_group_barrier(0x100, 8, 0);
    __builtin_amdgcn_sched_group_barrier(0x008, 8, 0);
  };
  bf16x8 pf[2][2];
  auto softmax = [&](int kb) __attribute__((always_inline)) {
    float cb = 0.f; bool near = false;
    if (BIAS) {
      const int kmin = kb * 64;
      near = !(kmin - (q0 + 255) >= 128 || q0 - (kmin + 63) >= 128);
      cb = (kmin > q0) ? bt[256] : bt[0];
      if (near) {
        const float isc = 1.0f / sc;
#pragma unroll
        for (int kt = 0; kt < 2; ++kt)
#pragma unroll
          for (int q = 0; q < 16; ++q) {
            int rel = kmin + 32 * kt + kperm(crow(q, h)) - qpos;
            rel = rel < -128 ? -128 : (rel > 128 ? 128 : rel);
            Sc[kt][q] += bt[rel + 128] * isc;
          }
        cb = 0.f;
      }
    }
    float mx = Sc[0][0];
#pragma unroll
    for (int kt = 0; kt < 2; ++kt)
#pragma unroll
      for (int q = 0; q < 16; ++q) mx = fmaxf(mx, Sc[kt][q]);
    mx = xhalf_max(mx);
    mx = __builtin_fmaf(mx, sc, cb);
    if (__any(mx > m + 6.0f)) {
      asm volatile("" ::: "memory");
      const float mn = fmaxf(m, mx);
      const float alpha = __builtin_amdgcn_exp2f(m - mn);
      m = mn; l *= alpha;
#pragma unroll
      for (int d = 0; d < NDT; ++d)
#pragma unroll
        for (int q = 0; q < 16; ++q) O[d][q] *= alpha;
    }
    const float nm = cb - m;
#pragma unroll
    for (int kt = 0; kt < 2; ++kt) {
#pragma unroll
      for (int q = 0; q < 16; ++q) {
        const float pv = __builtin_amdgcn_exp2f(__builtin_fmaf(Sc[kt][q], sc, nm));
        Sc[kt][q] = pv; l += pv;
      }
#pragma unroll
      for (int s = 0; s < 2; ++s) {
        u32x4 pk;
#pragma unroll
        for (int q = 0; q < 4; ++q) pk[q] = pack2(Sc[kt][8 * s + 2 * q], Sc[kt][8 * s + 2 * q + 1]);
        pf[kt][s] = __builtin_bit_cast(bf16x8, pk);
      }
    }
  };
  auto pv = [&](const u16* Vb) __attribute__((always_inline)) {
    bf16x8 vf[4][NDT];
#pragma unroll
    for (int ks = 0; ks < 4; ++ks)
#pragma unroll
      for (int d = 0; d < NDT; ++d) vf[ks][d] = *(const bf16x8*)(Vb + (32 * d + r) * 64 + (((2 * ks + h) ^ ksw) << 3));
#pragma unroll
    for (int ks = 0; ks < 4; ++ks)
#pragma unroll
      for (int d = 0; d < NDT; ++d) O[d] = MFMA(vf[ks][d], pf[ks >> 1][ks & 1], O[d]);
    __builtin_amdgcn_sched_group_barrier(0x100, 2 * NDT, 0);
    __builtin_amdgcn_sched_group_barrier(0x008, NDT, 0);
    __builtin_amdgcn_sched_group_barrier(0x100, NDT, 0);
    __builtin_amdgcn_sched_group_barrier(0x008, NDT, 0);
    __builtin_amdgcn_sched_group_barrier(0x100, NDT, 0);
    __builtin_amdgcn_sched_group_barrier(0x008, 2 * NDT, 0);
  };
  ATT_LOADK(0, Ks); ATT_LOADK(1, Ks + KS_SZ); ATT_LOADK(2, Ks + 2 * KS_SZ);
  ATT_LOADV(0, Vs); ATT_LOADV(1, Vs + VS_SZ);
  asm volatile("s_waitcnt vmcnt(0) lgkmcnt(0)\n\ts_barrier" ::: "memory");
  if (SWAP) qk(Ks);
  int r0 = 0, r2 = 2;
  for (int kb = 0; kb < nkb; ++kb) {
    ATT_LOADK(kb + 3, Ks + ((kb + 3) & 3) * KS_SZ);
    ATT_LOADV(kb + 2, Vs + r2 * VS_SZ);
    if (!SWAP) qk(Ks + (kb & 3) * KS_SZ);
    softmax(kb);
    pv(Vs + r0 * VS_SZ);
    if (SWAP) qk(Ks + ((kb + 1) & 3) * KS_SZ);
    asm volatile("s_waitcnt vmcnt(%0) lgkmcnt(0)\n\ts_barrier" :: "n"(NL) : "memory");
    r2 = r0; r0 = (r0 == 2) ? 0 : r0 + 1;
  }
  asm volatile("s_waitcnt vmcnt(0)" ::: "memory");
#undef ATT_LOADK
#undef ATT_LOADV
  l += __shfl_xor(l, 32);
  const float inv = __builtin_amdgcn_rcpf(l);
  int ldo2 = ldo; asm volatile("" : "+s"(ldo2));
  u16* orow = Op + (size_t)qpos * ldo2;
#pragma unroll
  for (int d = 0; d < NDT; ++d)
#pragma unroll
    for (int g4 = 0; g4 < 4; ++g4) {
      u32x2 o; o[0] = pack2(O[d][4 * g4] * inv, O[d][4 * g4 + 1] * inv); o[1] = pack2(O[d][4 * g4 + 2] * inv, O[d][4 * g4 + 3] * inv);
      *(u32x2*)(orow + 32 * d + 8 * g4 + 4 * h) = o;
    }
}

DI void attn_tile2(const u16* __restrict__ Qp, const u16* __restrict__ Kp, const u16* __restrict__ VTp, int L,
                   u16* __restrict__ Op, int ldo, int q0, char* smem) {
  constexpr int DV = 64, NDT = 2, VCH = 1, RT = 2;
  constexpr int KS_SZ = 64 * 64, VS_SZ = DV * 64;
  constexpr int NL = 1 + VCH;
  u16* Ks = (u16*)smem;
  u16* Vs = Ks + 4 * KS_SZ;
  const int tid = otid(), lane = tid & 63, w = __builtin_amdgcn_readfirstlane(tid >> 6), r = lane & 31, h = lane >> 5;
  const float sc = 0.125f * LOG2E;
  __syncthreads();
  bf16x8 qf[RT][4];
#pragma unroll
  for (int t = 0; t < RT; ++t) {
    const u16* qrow = Qp + (size_t)(q0 + 64 * w + 32 * t + r) * INC + 8 * h;
#pragma unroll
    for (int s = 0; s < 4; ++s) qf[t][s] = *(const bf16x8*)(qrow + 16 * s);
  }
  f32x16 O[RT][NDT];
#pragma unroll
  for (int t = 0; t < RT; ++t)
#pragma unroll
    for (int d = 0; d < NDT; ++d)
#pragma unroll
      for (int q = 0; q < 16; ++q) O[t][d][q] = 0.f;
  float m[RT], l[RT];
#pragma unroll
  for (int t = 0; t < RT; ++t) { m[t] = -INFINITY; l[t] = 0.f; }
  const int lrow = tid >> 3, lsw = (tid & 7) ^ ((tid >> 4) & 7);
  const u16* Kg0 = Kp + (size_t)kperm(lrow) * INC + lsw * 8;
  const u16* Vg = VTp + (size_t)lrow * L + lsw * 8;
  const int ksw = (r >> 1) & 7;
  const int nkb = L >> 6;
#define ATT_LOADK(tile, bufp) do { const int t__ = ((tile) < nkb) ? (tile) : nkb - 1; \
    __builtin_amdgcn_global_load_lds((const unsigned*)(Kg0 + ((size_t)t__ * 64) * INC), (unsigned*)((char*)(bufp) + tid * 16), 16, 0, 0); } while (0)
#define ATT_LOADV(tile, bufp) do { const int t__ = ((tile) < nkb) ? (tile) : nkb - 1; \
    __builtin_amdgcn_global_load_lds((const unsigned*)(Vg + (size_t)t__ * 64), (unsigned*)((char*)(bufp) + tid * 16), 16, 0, 0); } while (0)
  ATT_LOADK(0, Ks); ATT_LOADK(1, Ks + KS_SZ); ATT_LOADK(2, Ks + 2 * KS_SZ);
  ATT_LOADV(0, Vs); ATT_LOADV(1, Vs + VS_SZ);
  asm volatile("s_waitcnt vmcnt(0) lgkmcnt(0)\n\ts_barrier" ::: "memory");
  int r0 = 0, r2 = 2;
  for (int kb = 0; kb < nkb; ++kb) {
    ATT_LOADK(kb + 3, Ks + ((kb + 3) & 3) * KS_SZ);
    ATT_LOADV(kb + 2, Vs + r2 * VS_SZ);
    const u16* Kb = Ks + (kb & 3) * KS_SZ; const u16* Vb = Vs + r0 * VS_SZ;
    f32x16 Sc[RT][2];
    {
      bf16x8 kf[2][4];
#pragma unroll
      for (int kt = 0; kt < 2; ++kt)
#pragma unroll
        for (int s = 0; s < 4; ++s) kf[kt][s] = *(const bf16x8*)(Kb + (32 * kt + r) * 64 + (((2 * s + h) ^ ksw) << 3));
#pragma unroll
      for (int t = 0; t < RT; ++t)
#pragma unroll
        for (int kt = 0; kt < 2; ++kt) {
#pragma unroll
          for (int q = 0; q < 16; ++q) Sc[t][kt][q] = 0.f;
#pragma unroll
          for (int s = 0; s < 4; ++s) Sc[t][kt] = MFMA(kf[kt][s], qf[t][s], Sc[t][kt]);
        }
      __builtin_amdgcn_sched_group_barrier(0x100, 8, 0);
      __builtin_amdgcn_sched_group_barrier(0x008, 16, 0);
    }
    bf16x8 pf[RT][2][2];
#pragma unroll
    for (int t = 0; t < RT; ++t) {
      float mx = Sc[t][0][0];
#pragma unroll
      for (int kt = 0; kt < 2; ++kt)
#pragma unroll
        for (int q = 0; q < 16; ++q) mx = fmaxf(mx, Sc[t][kt][q]);
      mx = xhalf_max(mx);
      mx *= sc;
      if (__any(mx > m[t] + 6.0f)) {
        asm volatile("" ::: "memory");
        const float mn = fmaxf(m[t], mx);
        const float alpha = __builtin_amdgcn_exp2f(m[t] - mn);
        m[t] = mn; l[t] *= alpha;
#pragma unroll
        for (int d = 0; d < NDT; ++d)
#pragma unroll
          for (int q = 0; q < 16; ++q) O[t][d][q] *= alpha;
      }
      const float nm = -m[t];
#pragma unroll
      for (int kt = 0; kt < 2; ++kt) {
#pragma unroll
        for (int q = 0; q < 16; ++q) { const float pv = __builtin_amdgcn_exp2f(__builtin_fmaf(Sc[t][kt][q], sc, nm)); Sc[t][kt][q] = pv; l[t] += pv; }
#pragma unroll
        for (int s = 0; s < 2; ++s) {
          u32x4 pk;
#pragma unroll
          for (int q = 0; q < 4; ++q) pk[q] = pack2(Sc[t][kt][8 * s + 2 * q], Sc[t][kt][8 * s + 2 * q + 1]);
          pf[t][kt][s] = __builtin_bit_cast(bf16x8, pk);
        }
      }
    }
    {
      bf16x8 vf[4][NDT];
#pragma unroll
      for (int ks = 0; ks < 4; ++ks)
#pragma unroll
        for (int d = 0; d < NDT; ++d) vf[ks][d] = *(const bf16x8*)(Vb + (32 * d + r) * 64 + (((2 * ks + h) ^ ksw) << 3));
#pragma unroll
      for (int ks = 0; ks < 4; ++ks)
#pragma unroll
        for (int d = 0; d < NDT; ++d)
#pragma unroll
          for (int t = 0; t < RT; ++t) O[t][d] = MFMA(vf[ks][d], pf[t][ks >> 1][ks & 1], O[t][d]);
      __builtin_amdgcn_sched_group_barrier(0x100, 4, 0);
      __builtin_amdgcn_sched_group_barrier(0x008, 4, 0);
      __builtin_amdgcn_sched_group_barrier(0x100, 4, 0);
      __builtin_amdgcn_sched_group_barrier(0x008, 12, 0);
    }
    asm volatile("s_waitcnt vmcnt(%0) lgkmcnt(0)\n\ts_barrier" :: "n"(NL) : "memory");
    r2 = r0; r0 = (r0 == 2) ? 0 : r0 + 1;
  }
  asm volatile("s_waitcnt vmcnt(0)" ::: "memory");
#undef ATT_LOADK
#undef ATT_LOADV
  int ldo2 = ldo; asm volatile("" : "+s"(ldo2));
#pragma unroll
  for (int t = 0; t < RT; ++t) {
    float lt = l[t]; lt += __shfl_xor(lt, 32);
    const float inv = __builtin_amdgcn_rcpf(lt);
    u16* orow = Op + (size_t)(q0 + 64 * w + 32 * t + r) * ldo2;
#pragma unroll
    for (int d = 0; d < NDT; ++d)
#pragma unroll
      for (int g4 = 0; g4 < 4; ++g4) {
        u32x2 o; o[0] = pack2(O[t][d][4 * g4] * inv, O[t][d][4 * g4 + 1] * inv); o[1] = pack2(O[t][d][4 * g4 + 2] * inv, O[t][d][4 * g4 + 3] * inv);
        *(u32x2*)(orow + 32 * d + 8 * g4 + 4 * h) = o;
      }
  }
}

template <int ILO, int IHI>
DI void hy_seg(int lo, int hi, f32x16 (&acc)[4], const u16* fw, const u16* fw1, const u16* zs, const int (&tq)[4], const int (&tJ)[4],
               int ZLP8, int L, int wb, int r, int h) {
  if (lo > hi) return;
  const int idx0 = L - lo - r + 8 * h - wb;
  const unsigned* ap = (idx0 & 1) ? (const unsigned*)(fw1 + idx0 - 1) : (const unsigned*)(fw + idx0);
  const u16* zq[4]; int cs[4];
#pragma unroll
  for (int i = ILO; i <= IHI; ++i) { zq[i] = zs + tq[i] * ZLP8; cs[i] = (1024 + 1024 * tJ[i] + 32 * r - lo + 8 * h) >> 3; }
  const int n = ((hi - lo) >> 4) + 1;
  bf16x8 a, b[4];
  { u32x4 av; av[0] = ap[0]; av[1] = ap[1]; av[2] = ap[2]; av[3] = ap[3]; a = __builtin_bit_cast(bf16x8, av); }
#pragma unroll
  for (int i = ILO; i <= IHI; ++i) b[i] = *(const bf16x8*)(zq[i] + ((cs[i] + (cs[i] >> 2)) << 3));
  for (int k = 0; k < n; ++k) {
    ap -= 8;
    bf16x8 an, c[4];
    { u32x4 av; av[0] = ap[0]; av[1] = ap[1]; av[2] = ap[2]; av[3] = ap[3]; an = __builtin_bit_cast(bf16x8, av); }
#pragma unroll
    for (int i = ILO; i <= IHI; ++i) { cs[i] -= 2; c[i] = *(const bf16x8*)(zq[i] + ((cs[i] + (cs[i] >> 2)) << 3)); }
#pragma unroll
    for (int i = ILO; i <= IHI; ++i) acc[i] = MFMA(a, b[i], acc[i]);
    a = an;
#pragma unroll
    for (int i = ILO; i <= IHI; ++i) b[i] = c[i];
  }
}

DI void hyena_item(int c, const u16* __restrict__ G, const u16* __restrict__ zT, u16* __restrict__ yT, int nseq, int L, char* smem) {
  u16* zs = (u16*)smem;
  u16* fw = zs + 25600;
  u16* fw1 = fw + 4224;
  const int tid = otid() & 255, lane = tid & 63, w = __builtin_amdgcn_readfirstlane(tid >> 6), r = lane & 31, h = lane >> 5;
  const int ZL = L + 2048;
  const int ZLP8 = ((ZL >> 3) + (ZL >> 5)) << 3;
  __syncthreads();
  for (int q = 0; q < nseq; ++q) {
    const u16* src = zT + ((size_t)q * 512 + c) * L;
    u16* dst = zs + q * ZLP8;
    const u32x4 zero = {0u, 0u, 0u, 0u};
    for (int i = tid; i < 128; i += 256) { const int c0 = i, c1 = 128 + (L >> 3) + i; *(u32x4*)(dst + ((c0 + (c0 >> 2)) << 3)) = zero; *(u32x4*)(dst + ((c1 + (c1 >> 2)) << 3)) = zero; }
    for (int i = tid; i < (L >> 3); i += 256) { const int cc = 128 + i; *(u32x4*)(dst + ((cc + (cc >> 2)) << 3)) = *(const u32x4*)(src + i * 8); }
  }
  int tq[4], tJ[4];
#pragma unroll
  for (int i = 0; i < 4; ++i) { if (nseq == 2) { tq[i] = i & 1; tJ[i] = 2 * w + (i >> 1); } else { tq[i] = 0; tJ[i] = 4 * w + i; } }
  f32x16 acc[4];
#pragma unroll
  for (int i = 0; i < 4; ++i)
#pragma unroll
    for (int q = 0; q < 16; ++q) acc[i][q] = 0.f;
  const int E0 = -L + 16, ELAST = L - 32;
  const int npass = (2 * L - 32 + 4095) / 4096;
  const u16* Gc = G + (size_t)c * (2 * L);
  for (int ps = 0; ps < npass; ++ps) {
    const int ea = E0 + 4096 * ps, eb = ea + 4096;
    const int wb = L - eb - 16;
    __syncthreads();
    for (int i = tid; i < 520; i += 256) {
      const int gi = wb + i * 8;
      u32x4 v = {0u, 0u, 0u, 0u};
      if (gi >= 0 && gi < 2 * L) v = *(const u32x4*)(Gc + gi);
      *(u32x4*)(fw + i * 8) = v;
    }
    __syncthreads();
    for (int i = tid; i < 2079; i += 256) { const unsigned lo = ((const unsigned*)fw)[i], hi = ((const unsigned*)fw)[i + 1]; ((unsigned*)fw1)[i] = (lo >> 16) | (hi << 16); }
    __syncthreads();
    const int eend = (eb - 16 < ELAST) ? (eb - 16) : ELAST;
    int emn[4], emx[4];
#pragma unroll
    for (int i = 0; i < 4; ++i) { emn[i] = 1024 * tJ[i] - L + 16; emx[i] = 1024 * tJ[i] + 992; }
#define HY_CLIP_LO(v) ((v) < ea ? ea : (v))
#define HY_CLIP_HI(v) ((v) > eend ? eend : (v))
    hy_seg<0, 0>(HY_CLIP_LO(emn[0]), HY_CLIP_HI(emn[1] - 16), acc, fw, fw1, zs, tq, tJ, ZLP8, L, wb, r, h);
    hy_seg<0, 1>(HY_CLIP_LO(emn[1]), HY_CLIP_HI(emn[2] - 16), acc, fw, fw1, zs, tq, tJ, ZLP8, L, wb, r, h);
    hy_seg<0, 2>(HY_CLIP_LO(emn[2]), HY_CLIP_HI(emn[3] - 16), acc, fw, fw1, zs, tq, tJ, ZLP8, L, wb, r, h);
    hy_seg<0, 3>(HY_CLIP_LO(emn[3]), HY_CLIP_HI(emx[0]), acc, fw, fw1, zs, tq, tJ, ZLP8, L, wb, r, h);
    hy_seg<1, 3>(HY_CLIP_LO(emx[0] + 16), HY_CLIP_HI(emx[1]), acc, fw, fw1, zs, tq, tJ, ZLP8, L, wb, r, h);
    hy_seg<2, 3>(HY_CLIP_LO(emx[1] + 16), HY_CLIP_HI(emx[2]), acc, fw, fw1, zs, tq, tJ, ZLP8, L, wb, r, h);
    hy_seg<3, 3>(HY_CLIP_LO(emx[2] + 16), HY_CLIP_HI(emx[3]), acc, fw, fw1, zs, tq, tJ, ZLP8, L, wb, r, h);
#undef HY_CLIP_LO
#undef HY_CLIP_HI
  }
#pragma unroll
  for (int i = 0; i < 4; ++i) {
    u16* dst = yT + ((size_t)tq[i] * 512 + c) * L + 1024 * tJ[i] + 32 * r + 4 * h;
#pragma unroll
    for (int g4 = 0; g4 < 4; ++g4) {
      u32x2 o; o[0] = pack2(acc[i][4 * g4], acc[i][4 * g4 + 1]); o[1] = pack2(acc[i][4 * g4 + 2], acc[i][4 * g4 + 3]);
      *(u32x2*)(dst + 8 * g4) = o;
    }
  }
}

DI void diff_post_item(const Params& P, int layer, float lam, float lam_init, const u16* __restrict__ dO, u16* __restrict__ ydf, int it) {
  const int tid = otid() & 255, lane = tid & 63, w = __builtin_amdgcn_readfirstlane(tid >> 6);
  const int u = it * 8 + w * 2 + (lane >> 5);
  const int i = lane & 31;
  const u32x2 a = *(const u32x2*)(dO + (size_t)u * 256 + 4 * i);
  const u32x2 b = *(const u32x2*)(dO + (size_t)u * 256 + 128 + 4 * i);
  float o[4];
  o[0] = bflo(a[0]) - lam * bflo(b[0]); o[1] = bfhi(a[0]) - lam * bfhi(b[0]);
  o[2] = bflo(a[1]) - lam * bflo(b[1]); o[3] = bfhi(a[1]) - lam * bfhi(b[1]);
  const float ss = half_sum(o[0] * o[0] + o[1] * o[1] + o[2] * o[2] + o[3] * o[3]);
  const float rs = rsqrtf(ss * (1.0f / 128.0f) + 1e-5f) * (1.0f - lam_init);
  const float* g = P.diff_subln + layer * 128 + 4 * i;
  u32x2 ov; ov[0] = pack2(o[0] * rs * g[0], o[1] * rs * g[1]); ov[1] = pack2(o[2] * rs * g[2], o[3] * rs * g[3]);
  *(u32x2*)(ydf + (size_t)u * 128 + 4 * i) = ov;
}
DI void hyena_post_item(const Params& P, int layer, const u16* __restrict__ p, int L, const u16* __restrict__ yT, const u16* __restrict__ zT,
                        int ct, int tt, u16* __restrict__ yhy, char* smem) {
  float* tile = (float*)smem;
  const int tid = otid() & 255;
  const int t0 = tt * 64; const int seq = t0 / L, tl0 = t0 - seq * L;
  __syncthreads();
  {
    const int tcol = tid & 63, c0 = tid >> 6;
#pragma unroll
    for (int i = 0; i < 16; ++i) {
      const int cc = c0 + 4 * i; const int c = ct * 64 + cc;
      const size_t gi = ((size_t)seq * 512 + c) * L + tl0 + tcol;
      tile[cc * 65 + tcol] = bf2f(yT[gi]) + bf2f(zT[gi]) * P.hy_skip[layer * 512 + c];
    }
  }
  __syncthreads();
  {
    const int col = tid & 63, r0 = tid >> 6; const int c = ct * 64 + col;
    const float* cw = P.hy_conv_w + layer * 3 * 1536; const float* cb = P.hy_conv_b + layer * 1536;
    const float w0 = cw[c], w1 = cw[1536 + c], w2 = cw[3072 + c], b0 = cb[c];
#pragma unroll
    for (int i = 0; i < 16; ++i) {
      const int row = r0 + 4 * i; const int tl = tl0 + row;
      const u16* pr = p + (size_t)(t0 + row) * INC + c;
      const float xm1 = (tl > 0) ? bf2f(pr[-INC]) : 0.f, x0 = bf2f(pr[0]), xp1 = (tl < L - 1) ? bf2f(pr[INC]) : 0.f;
      const float x0c = xm1 * w0 + x0 * w1 + xp1 * w2 + b0;
      yhy[(size_t)(t0 + row) * 512 + c] = f2bf(x0c * tile[col * 65 + row]);
    }
  }
}

__global__ void __launch_bounds__(512) fwd_megakernel(Params Parg) {
  cg::grid_group grid = cg::this_grid();
  extern __shared__ __attribute__((aligned(16))) char smem_dyn[];
  char* smem = smem_dyn + 16;
  uint4& xb_words = *(uint4*)smem_dyn;
  const int nb = gridDim.x, nb2 = nb * 2;
#define KPARAMS() const Params __attribute__((address_space(4)))* pp_ = (const Params __attribute__((address_space(4)))*)__builtin_amdgcn_kernarg_segment_ptr(); \
  asm volatile("" : "+s"(pp_)); const Params& P = *(const Params*)pp_; char* ws = P.ws
  if (threadIdx.x == 0) xb_words = make_uint4(0u, 0u, 0u, blockIdx.x);
  __syncthreads();
  XcdBarrier xb;
  { KPARAMS(); xb = xcd_barrier_post((unsigned*)(ws + O_BAR), (volatile LAS unsigned*)&xb_words); }

  for (int step = 0; step < 80; ++step) {
    const int layer = step / 40, ls = step - layer * 40;
    PHASE_IDS();
    KPARAMS();
    float* misc = (float*)(ws + O_MISC);
    u16* pbuf = (u16*)(ws + O_P); u16* hid = pbuf; u16* hn = (u16*)(ws + O_HN); u16* merged = hn;
    if (ls == 0) {
      u16* filt8 = (u16*)(ws + O_FILT8); u16* filt16 = (u16*)(ws + O_FILT16);
      const int n1 = 16 * 88, n2 = 44 * 16, n3 = 16 * 108, n4 = 3 * 8 * 16, n5 = 16 * 16;
      const int nfilt = 128 + 256;
      const int total = n1 + n2 + n3 + n4 + n5 + n1 + n2 + nfilt;
      for (int it = bid2; it < total; it += nb2) {
        int t = it;
        if (t < nfilt) {
          const bool big = t < 256;
          filter_item(P, layer, big ? 16384 : 8192, big ? t : t - 256, big ? filt16 : filt8, smg);
          continue;
        }
        t -= nfilt;
        const float* src; int K, N, kt, nt, ph = 0; u16* dst;
        if (t < n1) { src = P.ffn1_w_in + (size_t)layer * 1024 * 5632; K = 1024; N = 5632; dst = (u16*)(ws + O_F1IN); kt = t / 88; nt = t % 88; ph = 2816; }
        else if ((t -= n1) < n2) { src = P.ffn1_w_out + (size_t)layer * 2816 * 1024; K = 2816; N = 1024; dst = (u16*)(ws + O_F1OUT); kt = t / 16; nt = t % 16; }
        else if ((t -= n2) < n3) { src = P.w_in + (size_t)layer * 1024 * 6912; K = 1024; N = 6912; dst = (u16*)(ws + O_WIN); kt = t / 108; nt = t % 108; }
        else if ((t -= n3) < n4) { const int br = t / 128, tt = t % 128; src = P.w_branch + ((size_t)layer * 3 + br) * 512 * 1024; K = 512; N = 1024;
                                   dst = (u16*)(ws + O_WBR) + (size_t)br * 1024 * 512; kt = tt / 16; nt = tt % 16; }
        else if ((t -= n4) < n5) { src = P.w_out + (size_t)layer * 1024 * 1024; K = 1024; N = 1024; dst = (u16*)(ws + O_WOUT); kt = t / 16; nt = t % 16; }
        else if ((t -= n5) < n1) { src = P.ffn2_w_in + (size_t)layer * 1024 * 5632; K = 1024; N = 5632; dst = (u16*)(ws + O_F2IN); kt = t / 88; nt = t % 88; ph = 2816; }
        else { t -= n1; src = P.ffn2_w_out + (size_t)layer * 2816 * 1024; K = 2816; N = 1024; dst = (u16*)(ws + O_F2OUT); kt = t / 16; nt = t % 16; }
        convT_tile(src, K, N, dst, kt, nt, ph, smg);
      }
      if (bid == 1 && grp == 0 && layer == 0) {
        float* rope = (float*)(ws + O_ROPE);
        for (int i = t_; i < 320 * 16; i += 256) {
          const int pos = (i < 4096) ? (i >> 4) : ((i - 4096) >> 4); const int jj = i & 15;
          const float inv = powf(10000.0f, -(float)(2 * jj) / 32.0f);
          const float ang = (float)pos * inv;
          rope[2 * i] = cosf(ang); rope[2 * i + 1] = sinf(ang);
        }
      }
      if (bid == 0 && grp == 0) {
        const int tid = t_;
        if (tid < 2) {
          const float* lp = P.diff_lambda + tid * 256;
          float s1 = 0.f, s2 = 0.f;
          for (int i = 0; i < 64; ++i) { s1 += lp[i] * lp[64 + i]; s2 += lp[128 + i] * lp[192 + i]; }
          const float lam_init = 0.8f - 0.6f * expf(-0.3f * (float)tid);
          misc[tid] = expf(s1) - expf(s2) + lam_init;
        }
        for (int i = tid; i < 4 * 257; i += 256) {
          const int hh = i / 257, idx = i % 257; const int rel = idx - 128; const int n = rel < 0 ? -rel : rel;
          int b;
          if (n < 8) b = n; else { int lg = 8 + (int)(logf((float)n / 8.0f) / 2.772588722239781f * 8.0f); b = lg < 15 ? lg : 15; }
          if (rel > 0) b += 16;
          misc[64 + i] = P.rel_bias[b * 4 + hh] * LOG2E;
        }
      }
      if (step == 0) {
        grid.sync();
        if (threadIdx.x == 0) {
          unsigned* bar = (unsigned*)(ws + O_BAR); bool even = ((nb & 7) == 0);
          for (int j = 0; j < 16; ++j) { const unsigned c = xb_ld(&bar[XB_XCNT(j)]); if (c != ((j < 8) ? (unsigned)(nb >> 3) : 0u)) even = false; }
          volatile LAS unsigned* st = (volatile LAS unsigned*)&xb_words;
          if (even) st[3] = st[2] * 8u + xb.x;
        }
        __syncthreads();
      } else GSYNC();
      continue;
    }
    const int cs = ls - 1; const int ch = cs / 13, st = cs - ch * 13;
    const int nseq = (ch < 2) ? 2 : 1, L = (ch < 2) ? 8192 : 16384;
    const float* xin0 = (ch < 2) ? (P.x_prompt + (size_t)ch * TCH * DM) : P.x_sample;
    float* xres = P.out + (size_t)ch * TCH * DM;
    const float* xcur = (layer == 0) ? xin0 : xres;
    for (int rp_ = 0; rp_ <= ((REPMASK >> st) & 1); ++rp_) {
    if (st == 0 || st == 3 || st == 10) {
      const float* src = (st == 0) ? xcur : xres;
      const float* gn = ((st == 0) ? P.ffn1_norm : (st == 3 ? P.mix_norm : P.ffn2_norm)) + layer * DM;
      for (int it = bid2; it < TCH / 4; it += nb2) { const int row = it * 4 + w; norm_row_bf16(src + (size_t)row * DM, gn, hn + (size_t)row * DM, lane); }
    } else if (st == 1 || st == 2 || st == 4 || st == 8 || st == 9 || st == 11 || st == 12) {
      EpiAny E{}; const u16* A; const u16* Bt; int N, K;
      if (st == 1 || st == 11) { A = hn; Bt = (u16*)(ws + (st == 1 ? O_F1IN : O_F2IN)); N = 5632; K = DM; E.mode = EPI_SWIGLU; E.perm = true; E.O = hid; E.ldo = DFF; }
      else if (st == 2 || st == 12) { A = hid; Bt = (u16*)(ws + (st == 2 ? O_F1OUT : O_F2OUT)); N = DM; K = DFF; E.mode = EPI_RESID; E.perm = false;
                                      E.xin = (st == 2) ? xcur : xres; E.xout = xres; E.scale = 0.5f; }
      else if (st == 4) { A = hn; Bt = (u16*)(ws + O_WIN); N = INC; K = DM; E.mode = EPI_PROJ; E.perm = true; E.O = pbuf; }
      else if (st == 8) { A = (u16*)(ws + O_YHY); Bt = (u16*)(ws + O_WBR); N = DM; K = 512; E.mode = EPI_MERGE; E.perm = false; E.gate = pbuf; E.macc = (float*)(ws + O_ZT); E.O = merged; }
      else { A = merged; Bt = (u16*)(ws + O_WOUT); N = DM; K = DM; E.mode = EPI_RESID; E.perm = false; E.xin = xres; E.xout = xres; E.scale = 1.0f; }
      if (st == 8) {
        pg8::Gemm gg{A, Bt, TCH, N, K};
        AnyOrder S; S.init(TCH, N, nb, bid); S.merge3 = true;
        EpiMerge EM{true, pbuf, merged};
        pg8::gemm_phase<EpiMerge, AnyOrder, false>((PG8_LAS unsigned char*)smem, gg, S, EM, nullptr);
      } else {
        pg8::Gemm gg{A, Bt, TCH, N, K};
        AnyOrder S; S.init(TCH, N, nb, bid); S.merge3 = false;
        pg8::gemm_phase<EpiAny, AnyOrder, false>((PG8_LAS unsigned char*)smem, gg, S, E, nullptr);
      }
    } else if (st == 5) {
      const int nqk = TCH * 10 / 8, ntr = 256 * 18;
      for (int it = bid2; it < nqk + ntr; it += nb2) {
        if (it < nqk) { qk_prep_item(P, layer, pbuf, L, it, (const float*)(ws + O_ROPE)); continue; }
        const int t = it - nqk; const int tt = t / 18, cc = t % 18;
        const int kind = (cc < 2) ? 0 : (cc < 10 ? 1 : 2);
        const int ct = (cc < 2) ? cc : (cc < 10 ? cc - 2 : cc - 10);
        u16* dst = (u16*)(ws + (kind == 0 ? O_VTG : (kind == 1 ? O_VTD : O_ZT)));
        transpose_item(P, layer, pbuf, L, kind, ct, tt, dst, smg);
      }
    } else if (st == 6) {
      u16* zT = (u16*)(ws + O_ZT); u16* yT = (u16*)(ws + O_YT); u16* dO = (u16*)(ws + O_DIFFO);
      u16* vtg = (u16*)(ws + O_VTG); u16* vtd = (u16*)(ws + O_VTD); u16* ygq = (u16*)(ws + O_YGQ);
      const u16* filt = (u16*)(ws + ((ch < 2) ? O_FILT8 : O_FILT16));
      const int nqt = L / 256;
      const int xcd = bid & 7, nxu = nb >> 3, nitem = nseq * nqt;
      for (int e = bid >> 3; e < nitem; e += nxu) {
        const int seq = e / nqt, qt = e - seq * nqt;
        const int hh = xcd >> 1, cc = xcd & 1;
        const size_t tb = (size_t)seq * L;
        const u16* Qd = pbuf + tb * INC + OFF_DQ + xcd * 64; const u16* Kd = pbuf + tb * INC + OFF_DK + xcd * 64;
        const u16* Vd = vtd + ((size_t)seq * 512 + hh * 128) * L; u16* Od = dO + tb * 1024 + (hh * 2 + cc) * 128;
        attn_tile<128, true, false>(Qd, Kd, Vd, L, Od, 1024, qt * 256, misc + 64 + hh * 257, smem);
      }
      {
        const int nqt2 = L / 512, nitem2 = nseq * nqt2;
        for (int e = bid >> 3; e < nitem2; e += nxu) {
          const int seq = e / nqt2, qt = e - seq * nqt2;
          const int kvh = xcd >> 2;
          const size_t tb = (size_t)seq * L;
          const u16* Qd = pbuf + tb * INC + OFF_GQ + xcd * 64; const u16* Kd = pbuf + tb * INC + OFF_GK + kvh * 64;
          const u16* Vd = vtg + ((size_t)seq * 128 + kvh * 64) * L; u16* Od = ygq + tb * 512 + xcd * 64;
          attn_tile2(Qd, Kd, Vd, L, Od, 512, qt * 512, smem);
        }
      }
      for (int c = bid2; c < 512; c += nb2) hyena_item(c, filt, zT, yT, nseq, L, smg);
    } else {
      u16* zT = (u16*)(ws + O_ZT); u16* yT = (u16*)(ws + O_YT); u16* dO = (u16*)(ws + O_DIFFO);
      u16* yhy = (u16*)(ws + O_YHY); u16* ydf = (u16*)(ws + O_YDF);
      const float lam = misc[layer];
      const float lam_init = 0.8f - 0.6f * expf(-0.3f * (float)layer);
      const int ndp = TCH * 4 / 8, nhp = 256 * 8;
      for (int it = bid2; it < ndp + nhp; it += nb2) {
        if (it < ndp) diff_post_item(P, layer, lam, lam_init, dO, ydf, it);
        else { const int t = it - ndp; hyena_post_item(P, layer, pbuf, L, yT, zT, t % 8, t / 8, yhy, smg); }
      }
    }
    }
    GSYNC();
  }
  { PHASE_IDS(); KPARAMS(); (void)ws;
    for (int it = bid2; it < NTOK / 4; it += nb2) { const int row = it * 4 + w; norm_row_f32_inplace(P.out + (size_t)row * DM, P.final_norm, lane); }
  }
}

extern "C" void kernel_launch(void* const* d_in, const int* in_sizes, int n_in, void* d_out, int out_size, void* d_ws, size_t ws_size,
                              hipStream_t stream) {
  static int grid_blocks = 0;
  if (!grid_blocks) {
    int dev = 0, cus = 0, per_cu = 0;
    (void)hipGetDevice(&dev);
    (void)hipDeviceGetAttribute(&cus, hipDeviceAttributeMultiprocessorCount, dev);
    (void)hipFuncSetAttribute((const void*)fwd_megakernel, hipFuncAttributeMaxDynamicSharedMemorySize, SMEM_BYTES + 16);
    (void)hipOccupancyMaxActiveBlocksPerMultiprocessor(&per_cu, fwd_megakernel, 512, SMEM_BYTES + 16);
    if (per_cu < 1) per_cu = 1;
    if (per_cu > 1) per_cu = 1;
    grid_blocks = cus * per_cu;
  }
  Params p{};
  const float* const* in = (const float* const*)d_in;
  p.x_prompt = in[0]; p.x_sample = in[1]; p.ffn1_norm = in[2]; p.ffn1_w_in = in[3]; p.ffn1_w_out = in[4]; p.mix_norm = in[5]; p.w_in = in[6];
  p.hy_conv_w = in[7]; p.hy_conv_b = in[8]; p.hy_w1 = in[9]; p.hy_b1 = in[10]; p.hy_w2 = in[11]; p.hy_b2 = in[12]; p.hy_w3 = in[13];
  p.hy_freq = in[14]; p.hy_skip = in[15]; p.gqa_q_norm = in[16]; p.gqa_k_norm = in[17]; p.diff_lambda = in[18]; p.diff_subln = in[19];
  p.rel_bias = in[20]; p.w_branch = in[21]; p.w_out = in[22]; p.ffn2_norm = in[23]; p.ffn2_w_in = in[24]; p.ffn2_w_out = in[25]; p.final_norm = in[26];
  p.out = (float*)d_out; p.ws = (char*)d_ws;
  void* args[] = {&p};
  (void)hipMemsetAsync((char*)d_ws + O_BAR, 0, XCD_BAR_WORDS * 4, stream);
  hipError_t e = hipLaunchCooperativeKernel((void*)fwd_megakernel, dim3(grid_blocks), dim3(512), args, SMEM_BYTES + 16, stream);
  if (e != hipSuccess) fprintf(stderr, "cooperative launch failed: %s (grid %d)\n", hipGetErrorString(e), grid_blocks);
}
```

```cpp
#include <hip/hip_runtime.h>
#include <hip/hip_cooperative_groups.h>
#include <stdint.h>
#include <cstdio>
namespace cg = cooperative_groups;

typedef unsigned short u16;
typedef __attribute__((ext_vector_type(8))) short bf16x8;
typedef __attribute__((ext_vector_type(16))) float f32x16;
typedef __attribute__((ext_vector_type(4))) float f32x4;
typedef __attribute__((ext_vector_type(4))) unsigned u32x4;
typedef __attribute__((ext_vector_type(2))) unsigned u32x2;
typedef __attribute__((ext_vector_type(2))) __bf16 bf2_t;
typedef __attribute__((ext_vector_type(2))) float f2_t;
#define DI __device__ __forceinline__
#define MFMA(a, b, c) __builtin_amdgcn_mfma_f32_32x32x16_bf16((a), (b), (c), 0, 0, 0)

constexpr int DM = 1024, DFF = 2816, INC = 6912, TCH = 16384, NTOK = 49152;
constexpr int OFF_GQ = 1536, OFF_GK = 2048, OFF_GV = 2176, OFF_DQ = 2304, OFF_DK = 2816, OFF_DV = 3328, OFF_GATE = 3840;
constexpr float LOG2E = 1.4426950408889634f;

constexpr size_t SZ_F1IN = (size_t)5632 * 1024 * 2, SZ_F1OUT = (size_t)1024 * 2816 * 2, SZ_WIN = (size_t)6912 * 1024 * 2,
                 SZ_WBR = (size_t)3 * 1024 * 512 * 2, SZ_WOUT = (size_t)1024 * 1024 * 2;
constexpr size_t O_F1IN = 0, O_F1OUT = O_F1IN + SZ_F1IN, O_WIN = O_F1OUT + SZ_F1OUT, O_WBR = O_WIN + SZ_WIN, O_WOUT = O_WBR + SZ_WBR,
                 O_F2IN = O_WOUT + SZ_WOUT, O_F2OUT = O_F2IN + SZ_F1IN, O_FILT8 = O_F2OUT + SZ_F1OUT,
                 O_FILT16 = O_FILT8 + (size_t)512 * 16384 * 2, O_MISC = O_FILT16 + (size_t)512 * 32768 * 2,
                 O_P = O_MISC + 131072, O_HN = O_P + (size_t)TCH * INC * 2, O_ZT = O_HN + (size_t)TCH * 1024 * 2,
                 O_YT = O_ZT + (size_t)TCH * 512 * 2, O_DIFFO = O_YT + (size_t)TCH * 512 * 2, O_VTG = O_DIFFO + (size_t)TCH * 1024 * 2,
                 O_VTD = O_VTG + (size_t)TCH * 128 * 2, O_YHY = O_VTD + (size_t)TCH * 512 * 2, O_YGQ = O_YHY + (size_t)TCH * 512 * 2,
                 O_YDF = O_YGQ + (size_t)TCH * 512 * 2, O_END = O_YDF + (size_t)TCH * 512 * 2;
static_assert(O_END <= (size_t)536870912, "workspace overflow");
constexpr int SMEM_BYTES = 151552;
constexpr int GRP_LDS = 75776;
#define REPMASK 0
#define REP_SYNC 1
#define PHASE_IDS() const int t_ = otid(); const int bid = __builtin_amdgcn_readfirstlane(((volatile LAS unsigned*)&xb_words)[3]); const int lane = t_ & 63; const int grp = __builtin_amdgcn_readfirstlane(t_ >> 8); \
  const int w = __builtin_amdgcn_readfirstlane((t_ >> 6) & 3); const int bid2 = bid * 2 + grp; char* smg = smem + grp * GRP_LDS; \
  const int vb = (bid & 7) * (nb >> 3) + (bid >> 3); (void)lane; (void)w; (void)bid2; (void)smg; (void)vb
#define GSYNC() do { for (int rs_ = 0; rs_ < REP_SYNC; ++rs_) xcd_barrier(xb); } while (0)


#define XB_TMO      128
#define XB_XCNT(j)  (256  + 64 * (j))
#define XB_XSUB(j)  (1280 + 64 * (j))
#define XB_XGEN(j)  (2304 + 64 * (j))
#define XB_TOP      3328
#define XB_TOPGEN   3392
#define XCD_BAR_WORDS 3456
#define XB_SPIN_CAP (1u << 21)
#define LAS __attribute__((address_space(3)))
DI unsigned xb_ld(unsigned* p)              { return __hip_atomic_load(p, __ATOMIC_RELAXED, __HIP_MEMORY_SCOPE_AGENT); }
DI unsigned xb_add(unsigned* p, unsigned v) { return __hip_atomic_fetch_add(p, v, __ATOMIC_RELAXED, __HIP_MEMORY_SCOPE_AGENT); }
DI unsigned xb_xcc_id() { return (unsigned)__builtin_amdgcn_s_getreg((3 << 11) | 20) & 0xFu; }
#define XB_SPIN(cond, bar) do { unsigned _sp = 0; while (cond) { __builtin_amdgcn_s_sleep(1); \
    if ((++_sp & 255u) == 0u) { if (xb_ld(&(bar)[XB_TMO])) break; if (_sp > XB_SPIN_CAP) { atomicAdd(&(bar)[XB_TMO], 1u); break; } } } } while (0)
struct XcdBarrier { unsigned* bar; unsigned x; volatile LAS unsigned* st; };
DI XcdBarrier xcd_barrier_post(unsigned* bar, volatile LAS unsigned* st) {
  XcdBarrier b; b.bar = bar; b.x = xb_xcc_id(); b.st = st;
  if (threadIdx.x == 0) { const unsigned rank = xb_add(&bar[XB_XCNT(b.x)], 1u); st[2] = rank; }
  return b;
}
DI void xcd_barrier_complete(unsigned* bar, unsigned x, unsigned& nloc, unsigned& nx) {
  const unsigned G = gridDim.x * gridDim.y * gridDim.z;
  unsigned sum, cnt, mine, sp = 0u;
  for (;;) {
    sum = 0u; cnt = 0u; mine = 0u;
#pragma unroll
    for (unsigned j = 0; j < 16; ++j) { const unsigned c = xb_ld(&bar[XB_XCNT(j)]); sum += c; cnt += (c > 0u) ? 1u : 0u; mine = (j == x) ? c : mine; }
    if (sum == G) break;
    __builtin_amdgcn_s_sleep(1);
    if ((++sp & 255u) == 0u) { if (xb_ld(&bar[XB_TMO])) break; if (sp > XB_SPIN_CAP) { atomicAdd(&bar[XB_TMO], 1u); break; } }
  }
  nloc = mine > 0u ? mine : 1u; nx = cnt > 0u ? cnt : 1u;
}
DI void xcd_barrier(const XcdBarrier& b) {
  asm volatile("s_waitcnt vmcnt(0)" ::: "memory");
  __syncthreads();
  if (threadIdx.x == 0) {
    unsigned* bar = b.bar;
    __builtin_amdgcn_s_waitcnt(0);
    unsigned nloc = b.st[0], nx = b.st[1];
    if (nloc == 0u) { xcd_barrier_complete(bar, b.x, nloc, nx); b.st[0] = nloc; b.st[1] = nx; }
    const unsigned old = xb_add(&bar[XB_XSUB(b.x)], 1u);
    const unsigned gen = old / nloc;
    if (old + 1u == (gen + 1u) * nloc) {
      __builtin_amdgcn_fence(__ATOMIC_RELEASE, "agent");
      asm volatile("s_waitcnt vmcnt(0)" ::: "memory");
      const unsigned og = xb_add(&bar[XB_TOP], 1u);
      const unsigned tg = og / nx;
      if (og + 1u == (tg + 1u) * nx) xb_add(&bar[XB_TOPGEN], 1u);
      else XB_SPIN(xb_ld(&bar[XB_TOPGEN]) == tg, bar);
      __builtin_amdgcn_fence(__ATOMIC_ACQUIRE, "agent");
      xb_add(&bar[XB_XGEN(b.x)], 1u);
      asm volatile("s_waitcnt vmcnt(0)" ::: "memory");
    } else {
      XB_SPIN(xb_ld(&bar[XB_XGEN(b.x)]) == gen, bar);
      __builtin_amdgcn_fence(__ATOMIC_ACQUIRE, "agent");
      asm volatile("s_waitcnt vmcnt(0)" ::: "memory");
    }
  }
  __syncthreads();
}
constexpr size_t O_BAR = O_MISC + 16384;
constexpr size_t O_ROPE = O_MISC + 65536;

struct Params {
  const float* x_prompt; const float* x_sample;
  const float* ffn1_norm; const float* ffn1_w_in; const float* ffn1_w_out; const float* mix_norm; const float* w_in;
  const float* hy_conv_w; const float* hy_conv_b; const float* hy_w1; const float* hy_b1; const float* hy_w2; const float* hy_b2;
  const float* hy_w3; const float* hy_freq; const float* hy_skip;
  const float* gqa_q_norm; const float* gqa_k_norm; const float* diff_lambda; const float* diff_subln; const float* rel_bias;
  const float* w_branch; const float* w_out; const float* ffn2_norm; const float* ffn2_w_in; const float* ffn2_w_out; const float* final_norm;
  float* out; char* ws;
};

DI unsigned pack2(float a, float b) { f2_t v = {a, b}; bf2_t r = __builtin_convertvector(v, bf2_t); return __builtin_bit_cast(unsigned, r); }
DI u16 f2bf(float a) { return (u16)(pack2(a, 0.f) & 0xffffu); }
DI float bf2f(u16 v) { return __uint_as_float(((unsigned)v) << 16); }
DI float bflo(unsigned v) { return __uint_as_float(v << 16); }
DI float bfhi(unsigned v) { return __uint_as_float(v & 0xffff0000u); }
DI int otid() { int t = threadIdx.x; asm volatile("" : "+v"(t)); return t; }
DI float xhalf_max(float x) {
  typedef unsigned u2_t __attribute__((ext_vector_type(2)));
  const u2_t rr = __builtin_amdgcn_permlane32_swap(__float_as_uint(x), __float_as_uint(x), false, false);
  return fmaxf(__uint_as_float(rr[0]), __uint_as_float(rr[1]));
}
DI float xhalf_sum(float x) {
  typedef unsigned u2_t __attribute__((ext_vector_type(2)));
  const u2_t rr = __builtin_amdgcn_permlane32_swap(__float_as_uint(x), __float_as_uint(x), false, false);
  return __uint_as_float(rr[0]) + __uint_as_float(rr[1]);
}
DI int crow(int reg, int h) { return (reg & 3) + 8 * (reg >> 2) + 4 * h; }
DI float wave_sum(float v) {
  v += __shfl_xor(v, 32); v += __shfl_xor(v, 16); v += __shfl_xor(v, 8); v += __shfl_xor(v, 4); v += __shfl_xor(v, 2); v += __shfl_xor(v, 1);
  return v;
}
DI float half_sum(float v) {
  v += __shfl_xor(v, 16); v += __shfl_xor(v, 8); v += __shfl_xor(v, 4); v += __shfl_xor(v, 2); v += __shfl_xor(v, 1);
  return v;
}

DI void convT_tile(const float* __restrict__ src, int K, int N, u16* __restrict__ dst, int kt, int nt, int perm_half, char* smem) {
  float* t = (float*)smem;
  const int tid = otid() & 255;
  __syncthreads();
  {
    const int col = tid & 63, r0 = tid >> 6;
#pragma unroll
    for (int i = 0; i < 16; ++i) { int row = r0 + 4 * i; t[row * 65 + col] = src[(size_t)(kt * 64 + row) * N + nt * 64 + col]; }
  }
  __syncthreads();
  {
    const int nl = tid >> 2, kq = tid & 3;
    int n = nt * 64 + nl;
    if (perm_half > 0) { if (n < perm_half) n = (n >> 7) * 256 + (n & 127); else { int j = n - perm_half; n = (j >> 7) * 256 + 128 + (j & 127); } }
    u32x4 o0, o1;
#pragma unroll
    for (int i = 0; i < 4; ++i) {
      o0[i] = pack2(t[(kq * 16 + 2 * i) * 65 + nl], t[(kq * 16 + 2 * i + 1) * 65 + nl]);
      o1[i] = pack2(t[(kq * 16 + 8 + 2 * i) * 65 + nl], t[(kq * 16 + 8 + 2 * i + 1) * 65 + nl]);
    }
    u16* d = dst + (size_t)n * K + kt * 64 + kq * 16;
    *(u32x4*)d = o0; *(u32x4*)(d + 8) = o1;
  }
}

DI void filter_item(const Params& P, int layer, int L, int tb, u16* __restrict__ G, char* smem) {
  float* h1 = (float*)smem;
  float* h2 = h1 + 64 * 65;
  const int tid = otid() & 255, lane = tid & 63, w = __builtin_amdgcn_readfirstlane(tid >> 6);
  const float* w1 = P.hy_w1 + layer * 33 * 64; const float* b1 = P.hy_b1 + layer * 64;
  const float* w2 = P.hy_w2 + layer * 64 * 64; const float* b2 = P.hy_b2 + layer * 64;
  const float* w3 = P.hy_w3 + layer * 64 * 1024; const float* fr = P.hy_freq + layer * 64;
  const int t = tb * 64 + lane;
  const float tl = (float)t / (float)(L - 1);
  __syncthreads();
  {
    float a[16];
#pragma unroll
    for (int u = 0; u < 16; ++u) a[u] = b1[w * 16 + u] + tl * w1[w * 16 + u];
    const float base = (float)(2.0 * 3.14159265358979323846 / (double)L) * (float)t;
    for (int b = 0; b < 16; ++b) {
      const float band = 1e-4f + (float)b * ((15.0f - 1e-4f) / 15.0f);
      const float ang = base * band;
      const float cs = cosf(ang), sn = -sinf(ang);
#pragma unroll
      for (int u = 0; u < 16; ++u) a[u] += cs * w1[(1 + b) * 64 + w * 16 + u] + sn * w1[(17 + b) * 64 + w * 16 + u];
    }
#pragma unroll
    for (int u = 0; u < 16; ++u) h1[lane * 65 + w * 16 + u] = sinf(fr[w * 16 + u] * a[u]);
  }
  __syncthreads();
  {
    float a[16];
#pragma unroll
    for (int u = 0; u < 16; ++u) a[u] = b2[w * 16 + u];
    for (int k = 0; k < 64; ++k) {
      const float hv = h1[lane * 65 + k];
#pragma unroll
      for (int u = 0; u < 16; ++u) a[u] += hv * w2[k * 64 + w * 16 + u];
    }
#pragma unroll
    for (int u = 0; u < 16; ++u) h2[lane * 65 + w * 16 + u] = sinf(fr[w * 16 + u] * a[u]);
  }
  __syncthreads();
  const float min_decay = -3.0701134573253946f, max_decay = -15.350567286626973f;
  for (int og = 0; og < 64; ++og) {
    const int o = w * 256 + og * 4;
    float a0 = 0.f, a1 = 0.f, a2 = 0.f, a3 = 0.f;
#pragma unroll 4
    for (int k = 0; k < 64; ++k) {
      const float hv = h2[lane * 65 + k];
      const f32x4 wv = *(const f32x4*)(w3 + k * 1024 + o);
      a0 += hv * wv[0]; a1 += hv * wv[1]; a2 += hv * wv[2]; a3 += hv * wv[3];
    }
    float av[4] = {a0, a1, a2, a3};
#pragma unroll
    for (int q = 0; q < 4; ++q) {
      const int oo = o + q; const int ch = oo & 511;
      const float delta = min_decay + (float)ch * ((max_decay - min_decay) / 511.0f);
      const float val = av[q] * expf(-tl * fabsf(delta));
      u16* Gc = G + (size_t)ch * (2 * L);
      if (oo < 512) Gc[L - t] = f2bf(val);
      else { if (t >= 1) Gc[L + t] = f2bf(val); else Gc[0] = 0; }
    }
  }
}

DI void norm_row_bf16(const float* __restrict__ x, const float* __restrict__ g, u16* __restrict__ out, int lane) {
  f32x4 v[4]; float ss = 0.f;
#pragma unroll
  for (int i = 0; i < 4; ++i) { v[i] = *(const f32x4*)(x + lane * 4 + 256 * i); ss += v[i][0] * v[i][0] + v[i][1] * v[i][1] + v[i][2] * v[i][2] + v[i][3] * v[i][3]; }
  ss = wave_sum(ss);
  const float rs = rsqrtf(ss * (1.0f / 1024.0f) + 1e-6f);
#pragma unroll
  for (int i = 0; i < 4; ++i) {
    const f32x4 gg = *(const f32x4*)(g + lane * 4 + 256 * i);
    u32x2 o; o[0] = pack2(v[i][0] * rs * gg[0], v[i][1] * rs * gg[1]); o[1] = pack2(v[i][2] * rs * gg[2], v[i][3] * rs * gg[3]);
    *(u32x2*)(out + lane * 4 + 256 * i) = o;
  }
}
DI void norm_row_f32_inplace(float* __restrict__ x, const float* __restrict__ g, int lane) {
  f32x4 v[4]; float ss = 0.f;
#pragma unroll
  for (int i = 0; i < 4; ++i) { v[i] = *(const f32x4*)(x + lane * 4 + 256 * i); ss += v[i][0] * v[i][0] + v[i][1] * v[i][1] + v[i][2] * v[i][2] + v[i][3] * v[i][3]; }
  ss = wave_sum(ss);
  const float rs = rsqrtf(ss * (1.0f / 1024.0f) + 1e-6f);
#pragma unroll
  for (int i = 0; i < 4; ++i) {
    const f32x4 gg = *(const f32x4*)(g + lane * 4 + 256 * i);
    f32x4 o; o[0] = v[i][0] * rs * gg[0]; o[1] = v[i][1] * rs * gg[1]; o[2] = v[i][2] * rs * gg[2]; o[3] = v[i][3] * rs * gg[3];
    *(f32x4*)(x + lane * 4 + 256 * i) = o;
  }
}

namespace pg8 {
#define PG8_LAS __attribute__((address_space(3)))
typedef unsigned short bf16_t;
typedef short bf16x8 __attribute__((ext_vector_type(8)));
typedef float f32x4 __attribute__((ext_vector_type(4)));
typedef unsigned u32x4 __attribute__((ext_vector_type(4)));
constexpr int BM = 256, BK = 64, HALF = 128, HTB = HALF * BK * 2  , STAGE_BYTES = 8 * HTB, NXCD = 8, WGM = 8;

__host__ __device__ __forceinline__ int lds_byte(int r, int c) { const int st = (r >> 4) * 2 + (c >> 5), rr = r & 15, cc = c & 31, ob = rr * 64 + cc * 2; return st * 1024 + (ob ^ (((ob >> 9) & 1) << 5)); }
__host__ __device__ __forceinline__ void stage_rc(int b, int& R, int& C) { const int st = b / 1024, sb = b % 1024, swz = sb ^ (((sb >> 9) & 1) << 5); R = (st >> 1) * 16 + swz / 64; C = (st & 1) * 32 + (swz % 64) / 2; }
__host__ __device__ __forceinline__ int perm32(int rho) { const int n = rho >> 4, i = rho & 15; return 8 * (i >> 2) + 4 * n + (i & 3); }

struct Unit { int pm, pn; };
struct Gemm { const bf16_t* A; const bf16_t* Bt; int M, N, K; };

struct StaticOrder {
    int nM, nN, nwg, G, c;
    __host__ __device__ void init(int M, int N, int G_, int c_) { nM = M / BM; nN = N / BM; nwg = nM * nN; G = G_; c = c_; }
    __host__ __device__ bool next(int i, Unit& u) const {
        const long L = (long)i * G + c; if (L >= nwg) return false;
        int wgid = (int)L; { const int q = nwg / NXCD, r = nwg % NXCD, xcd = wgid % NXCD, off = wgid / NXCD; wgid = (xcd < r ? xcd * (q + 1) : r * (q + 1) + (xcd - r) * q) + off; }
        const int nig = WGM * nN, gid = wgid / nig, fm = gid * WGM, gsz = (nM - fm) < WGM ? (nM - fm) : WGM;
        u.pm = fm + ((wgid % nig) % gsz); u.pn = (wgid % nig) / gsz; return true;
    }
    __device__ __forceinline__ void a_ready(const Unit&) const {}
    __device__ __forceinline__ void done(const Unit&) const {}
};

template <class Epi, class Sched, bool STAMP = false>
__device__ __forceinline__ void gemm_phase(PG8_LAS unsigned char* lds, const Gemm g, const Sched& S, const Epi& E, unsigned long long* stamps) {
    const int tid = otid(), wid = __builtin_amdgcn_readfirstlane(tid >> 6), lane = tid & 63, wr = wid >> 2, wc = wid & 3, fr = lane & 15, fq = lane >> 4;
    const int K = g.K, nt = K / BK;
    int ts_lo = 0, ts_hi = 0, nts = 0; const unsigned long long rt_entry = STAMP ? (unsigned long long)wall_clock64() : 0ull;
#define PG8_STAMP() do { if (STAMP && wid == 0 && nts < 64) { const unsigned long long _c = (unsigned long long)clock64(); \
        ts_lo = (lane == nts) ? (int)(unsigned)_c : ts_lo; ts_hi = (lane == nts) ? (int)(unsigned)(_c >> 32) : ts_hi; ++nts; } } while (0)
    PG8_STAMP();
    unsigned voffA[2], voffB[2];
#pragma unroll
    for (int i = 0; i < 2; ++i) { int R, C; stage_rc(tid * 16 + i * 8192, R, C); const int Rb = E.perm ? ((R & ~31) + perm32(R & 31)) : R;
        voffA[i] = (unsigned)(R * K + C) * 2u; voffB[i] = (unsigned)(Rb * K + C) * 2u; }
    const size_t kstep = (size_t)(BK * 2);
    const size_t hstep = (size_t)HALF * K * 2;
    const size_t tstep = 2 * hstep;
    const unsigned ldsw = (unsigned)wid * 1024u;
    const int aoff = lds_byte(wr * 64 + fr, fq * 8), boff = lds_byte(wc * 32 + fr, fq * 8);
#define PG8_SA(b, h) (((b) * 2 + (h)) * HTB)
#define PG8_SB(b, h) ((4 + (b) * 2 + (h)) * HTB)
#define PG8_STAGE(bufoff, gbase, voff) do { _Pragma("unroll") for (int _i = 0; _i < 2; ++_i) \
        __builtin_amdgcn_global_load_lds((const unsigned*)((const char*)(gbase) + (voff)[_i]), (PG8_LAS unsigned*)(lds + (bufoff) + ldsw + _i * 8192), 16, 0, 0); } while (0)
#define PG8_LDA(dst, b, h) do { _Pragma("unroll") for (int m = 0; m < 4; ++m) _Pragma("unroll") for (int k = 0; k < 2; ++k) dst[m][k] = *(const PG8_LAS bf16x8*)(lds + PG8_SA(b, h) + aoff + m * 2048 + k * 1024); } while (0)
#define PG8_LDB(dst, b, h) do { _Pragma("unroll") for (int n = 0; n < 2; ++n) _Pragma("unroll") for (int k = 0; k < 2; ++k) dst[n][k] = *(const PG8_LAS bf16x8*)(lds + PG8_SB(b, h) + boff + n * 2048 + k * 1024); } while (0)
#define PG8_MMA(ai, bj, At, Bt) do { __builtin_amdgcn_s_setprio(1); _Pragma("unroll") for (int m = 0; m < 4; ++m) _Pragma("unroll") for (int n = 0; n < 2; ++n) _Pragma("unroll") for (int k = 0; k < 2; ++k) \
        acc[ai][bj][m][n] = __builtin_amdgcn_mfma_f32_16x16x32_bf16(Bt[n][k], At[m][k], acc[ai][bj][m][n], 0, 0, 0); __builtin_amdgcn_s_setprio(0); } while (0)
#define PG8_WAIT_V(n) asm volatile("s_waitcnt vmcnt(" #n ")" ::: "memory")
#define PG8_WAIT_L(n) asm volatile("s_waitcnt lgkmcnt(" #n ")" ::: "memory")
#define PG8_BAR __builtin_amdgcn_s_barrier()
#define PG8_SCHED __builtin_amdgcn_sched_barrier(0)
    Unit cur, nxt; int ui = 0;
    if (!S.next(0, cur)) return;
    f32x4 acc[2][2][4][2];
#pragma unroll
    for (int a = 0; a < 2; ++a)
#pragma unroll
        for (int b = 0; b < 2; ++b)
#pragma unroll
            for (int m = 0; m < 4; ++m)
#pragma unroll
                for (int n = 0; n < 2; ++n) acc[a][b][m][n] = (f32x4){0.f, 0.f, 0.f, 0.f};
    bf16x8 At[4][2], B0[2][2], B1[2][2];
    const char* cA = (const char*)g.A + (size_t)cur.pm * tstep; const char* cB = (const char*)g.Bt + (size_t)cur.pn * tstep;
    S.a_ready(cur);
    PG8_STAGE(PG8_SB(0, 0), cB, voffB); PG8_STAGE(PG8_SA(0, 0), cA, voffA); PG8_STAGE(PG8_SB(0, 1), cB + hstep, voffB); PG8_STAGE(PG8_SA(0, 1), cA + hstep, voffA);
    if (wr == 1) PG8_BAR;
    PG8_WAIT_V(4); PG8_BAR;
    PG8_STAGE(PG8_SB(1, 0), cB + kstep, voffB); PG8_STAGE(PG8_SA(1, 0), cA + kstep, voffA); PG8_STAGE(PG8_SB(1, 1), cB + hstep + kstep, voffB);
    PG8_WAIT_V(6); PG8_BAR;
    PG8_STAMP();
    for (;;) {
        const bool has_next = S.next(ui + 1, nxt);
        const char* nA = has_next ? (const char*)g.A + (size_t)nxt.pm * tstep : cA; const char* nB = has_next ? (const char*)g.Bt + (size_t)nxt.pn * tstep : cB;
        for (int t = 0; t < nt; t += 2) {
            const bool last = (t == nt - 2);
            const char* a1 = cA + (size_t)(t + 1) * kstep;
            const char* a2 = last ? nA : cA + (size_t)(t + 2) * kstep; const char* b2 = last ? nB : cB + (size_t)(t + 2) * kstep;
            const char* a3 = a2 + kstep; const char* b3 = b2 + kstep;
            if (last && has_next) S.a_ready(nxt);
            PG8_LDB(B0, 0, 0); PG8_SCHED; PG8_LDA(At, 0, 0); PG8_STAGE(PG8_SA(1, 1), a1 + hstep, voffA);
            PG8_WAIT_L(8); PG8_BAR; PG8_WAIT_L(0); PG8_MMA(0, 0, At, B0); PG8_BAR; PG8_SCHED;
            PG8_LDB(B1, 0, 1); PG8_STAGE(PG8_SB(0, 0), b2, voffB);
            PG8_BAR; PG8_WAIT_L(0); PG8_MMA(0, 1, At, B1); PG8_BAR;
            PG8_LDA(At, 0, 1); PG8_STAGE(PG8_SA(0, 0), a2, voffA);
            PG8_BAR; PG8_WAIT_L(0); PG8_MMA(1, 0, At, B0); PG8_BAR; PG8_SCHED;
            PG8_STAGE(PG8_SB(0, 1), b2 + hstep, voffB);
            PG8_WAIT_V(6); PG8_BAR; PG8_MMA(1, 1, At, B1); PG8_BAR;
            PG8_LDB(B0, 1, 0); PG8_SCHED; PG8_LDA(At, 1, 0); PG8_STAGE(PG8_SA(0, 1), a2 + hstep, voffA);
            PG8_WAIT_L(8); PG8_BAR; PG8_WAIT_L(0); PG8_MMA(0, 0, At, B0); PG8_BAR; PG8_SCHED;
            PG8_LDB(B1, 1, 1); PG8_STAGE(PG8_SB(1, 0), b3, voffB);
            PG8_BAR; PG8_WAIT_L(0); PG8_MMA(0, 1, At, B1); PG8_BAR;
            PG8_LDA(At, 1, 1); PG8_STAGE(PG8_SA(1, 0), a3, voffA);
            PG8_BAR; PG8_WAIT_L(0); PG8_MMA(1, 0, At, B0); PG8_BAR; PG8_SCHED;
            PG8_STAGE(PG8_SB(1, 1), b3 + hstep, voffB);
            PG8_WAIT_V(6); PG8_BAR; PG8_MMA(1, 1, At, B1); PG8_BAR;
        }
        PG8_STAMP();
        if constexpr (!Epi::AFTER_DRAIN) { E(acc, cur, wr, wc, fr, fq); S.done(cur); }
        PG8_STAMP();
        if (!has_next) break;
        if (!E.keep_acc(cur)) {
#pragma unroll
        for (int a = 0; a < 2; ++a)
#pragma unroll
            for (int b = 0; b < 2; ++b)
#pragma unroll
                for (int m = 0; m < 4; ++m)
#pragma unroll
                    for (int n = 0; n < 2; ++n) acc[a][b][m][n] = (f32x4){0.f, 0.f, 0.f, 0.f};
        }
        cur = nxt; cA = nA; cB = nB; ++ui;
    }
    PG8_WAIT_V(0);
    if (wr == 0) PG8_BAR;
    PG8_BAR;
    if constexpr (Epi::AFTER_DRAIN) { E.fused(acc, cur, wr, wc, fr, fq, lds, wid, lane); S.done(cur); }
    PG8_STAMP();
    if (STAMP && wid == 0) { stamps[lane] = lane < nts ? (((unsigned long long)(unsigned)ts_hi << 32) | (unsigned)ts_lo) : 0ull;
        if (lane == 62) stamps[62] = rt_entry; if (lane == 63) stamps[63] = (unsigned long long)wall_clock64(); }
#undef PG8_STAMP
#undef PG8_SA
#undef PG8_SB
#undef PG8_STAGE
#undef PG8_LDA
#undef PG8_LDB
#undef PG8_MMA
#undef PG8_WAIT_V
#undef PG8_WAIT_L
#undef PG8_BAR
#undef PG8_SCHED
}
}

enum { EPI_SWIGLU = 0, EPI_RESID = 1, EPI_PROJ = 2, EPI_MERGE = 3 };
struct AnyOrder : pg8::StaticOrder {
  bool merge3;
  __device__ __forceinline__ bool next(int i, pg8::Unit& u) const {
    if (!merge3) return pg8::StaticOrder::next(i, u);
    const int ti = i / 3, br = i - ti * 3; pg8::Unit t;
    if (!pg8::StaticOrder::next(ti, t)) return false;
    u.pm = t.pm + 64 * br; u.pn = t.pn + 4 * br; return true;
  }
};
struct EpiAny {
  static constexpr bool AFTER_DRAIN = false;
  int mode; bool perm;
  u16* O; int ldo; const float* xin; float* xout; float scale; const u16* gate; float* macc; int br;
  int L; u16* vtg; u16* vtd;
  DI bool keep_acc(const pg8::Unit&) const { return false; }
  DI void operator()(pg8::f32x4 (&acc)[2][2][4][2], const pg8::Unit& u, int wr, int wc, int fr, int fq) const {
    const int row0 = (u.pm & 63) * 256 + wr * 64 + fr;
    if (mode == EPI_SWIGLU) {
      const int col0 = u.pn * 128 + wc * 32 + 8 * fq;
#pragma unroll
      for (int ai = 0; ai < 2; ++ai)
#pragma unroll
        for (int m = 0; m < 4; ++m) {
          float v[8];
#pragma unroll
          for (int n = 0; n < 2; ++n)
#pragma unroll
            for (int e = 0; e < 4; ++e) { const float gv = acc[ai][0][m][n][e], uv = acc[ai][1][m][n][e]; v[4 * n + e] = gv * __builtin_amdgcn_rcpf(1.0f + __builtin_amdgcn_exp2f(-LOG2E * gv)) * uv; }
          u32x4 o; o[0] = pack2(v[0], v[1]); o[1] = pack2(v[2], v[3]); o[2] = pack2(v[4], v[5]); o[3] = pack2(v[6], v[7]);
          *(u32x4*)(O + (size_t)(row0 + ai * 128 + m * 16) * ldo + col0) = o;
        }
    } else if (mode == EPI_PROJ) {
      const int col0 = u.pn * 256 + wc * 32 + 8 * fq;
      const bool sg = (u.pn * 256 >= OFF_GATE);
#pragma unroll
      for (int ai = 0; ai < 2; ++ai)
#pragma unroll
        for (int m = 0; m < 4; ++m)
#pragma unroll
          for (int bj = 0; bj < 2; ++bj) {
            float v[8];
#pragma unroll
            for (int n = 0; n < 2; ++n)
#pragma unroll
              for (int e = 0; e < 4; ++e) { float t = acc[ai][bj][m][n][e]; if (sg) t = __builtin_amdgcn_rcpf(1.0f + __builtin_amdgcn_exp2f(-LOG2E * t)); v[4 * n + e] = t; }
            u32x4 o; o[0] = pack2(v[0], v[1]); o[1] = pack2(v[2], v[3]); o[2] = pack2(v[4], v[5]); o[3] = pack2(v[6], v[7]);
            *(u32x4*)(O + (size_t)(row0 + ai * 128 + m * 16) * INC + col0 + bj * 128) = o;
            const bool isg = (u.pn == 8 && bj == 1), isd = (u.pn == 13 || u.pn == 14);
            if (isg || isd) {
              const int row = row0 + ai * 128 + m * 16; const int seq = row / L, tl = row - seq * L;
              const int cidx = isg ? (wc * 32 + 8 * fq) : ((u.pn - 13) * 256 + bj * 128 + wc * 32 + 8 * fq);
              u16* vt = isg ? (vtg + ((size_t)seq * 128 + cidx) * L + tl) : (vtd + ((size_t)seq * 512 + cidx) * L + tl);
#pragma unroll
              for (int q = 0; q < 4; ++q) { vt[(size_t)(2 * q) * L] = (u16)(o[q] & 0xffffu); vt[(size_t)(2 * q + 1) * L] = (u16)(o[q] >> 16); }
            }
          }
    } else if (mode == EPI_RESID) {
      const int col0 = u.pn * 256 + wc * 32 + 4 * fq;
#pragma unroll
      for (int ai = 0; ai < 2; ++ai)
#pragma unroll
        for (int m = 0; m < 4; ++m)
#pragma unroll
          for (int bj = 0; bj < 2; ++bj)
#pragma unroll
            for (int n = 0; n < 2; ++n) {
              const size_t idx = (size_t)(row0 + ai * 128 + m * 16) * DM + col0 + bj * 128 + n * 16;
              f32x4 xv = *(const f32x4*)(xin + idx);
#pragma unroll
              for (int e = 0; e < 4; ++e) xv[e] += scale * acc[ai][bj][m][n][e];
              *(f32x4*)(xout + idx) = xv;
            }
    }
  }
  DI u16* outb_() const { return O; }
};

struct EpiMerge {
  static constexpr bool AFTER_DRAIN = false;
  bool perm; const u16* gate; u16* O;
  DI bool keep_acc(const pg8::Unit& u) const { return (u.pm >> 6) < 2; }
  DI void operator()(pg8::f32x4 (&acc)[2][2][4][2], const pg8::Unit& u, int wr, int wc, int fr, int fq) const {
    const int row0 = (u.pm & 63) * 256 + wr * 64 + fr;
    const int col0 = (u.pn & 3) * 256 + wc * 32 + 8 * fq; const int br = u.pm >> 6;
#pragma unroll
    for (int ai = 0; ai < 2; ++ai)
#pragma unroll
      for (int m = 0; m < 4; ++m)
#pragma unroll
        for (int bj = 0; bj < 2; ++bj) {
          const int row = row0 + ai * 128 + m * 16, col = col0 + bj * 128;
          const u16* gp = gate + (size_t)row * INC + OFF_GATE + br * DM + col;
          const u32x4 ga = *(const u32x4*)gp;
          float g0[8];
#pragma unroll
          for (int q = 0; q < 4; ++q) { g0[2 * q] = bflo(ga[q]); g0[2 * q + 1] = bfhi(ga[q]); }
          if (br < 2) {
            const u32x4 gb = *(const u32x4*)(gp + DM);
#pragma unroll
            for (int q = 0; q < 4; ++q) {
              const float r0 = g0[2 * q] * __builtin_amdgcn_rcpf(fmaxf(bflo(gb[q]), 1e-30f)), r1 = g0[2 * q + 1] * __builtin_amdgcn_rcpf(fmaxf(bfhi(gb[q]), 1e-30f));
              acc[ai][bj][m][q >> 1][2 * (q & 1)] *= r0; acc[ai][bj][m][q >> 1][2 * (q & 1) + 1] *= r1;
            }
          } else {
            u32x4 o;
#pragma unroll
            for (int q = 0; q < 4; ++q) o[q] = pack2(acc[ai][bj][m][q >> 1][2 * (q & 1)] * g0[2 * q], acc[ai][bj][m][q >> 1][2 * (q & 1) + 1] * g0[2 * q + 1]);
            *(u32x4*)(O + (size_t)row * DM + col) = o;
          }
        }
  }
};

DI void qk_prep_item(const Params& P, int layer, u16* __restrict__ p, int L, int it, const float* __restrict__ rope) {
  const int tid = otid() & 255, lane = tid & 63, w = __builtin_amdgcn_readfirstlane(tid >> 6);
  const int u = it * 8 + w * 2 + (lane >> 5);
  const int tok = u / 10, hd = u - tok * 10;
  const int i = lane & 31;
  const int col0 = (hd < 8) ? (OFF_GQ + hd * 64) : (OFF_GK + (hd - 8) * 64);
  const float* gn = (hd < 8) ? (P.gqa_q_norm + layer * 64) : (P.gqa_k_norm + layer * 64);
  unsigned* ptr = (unsigned*)(p + (size_t)tok * INC + col0) + i;
  const unsigned v = *ptr;
  float a = bflo(v), b = bfhi(v);
  const float ss = half_sum(a * a + b * b);
  const float rs = rsqrtf(ss * (1.0f / 64.0f) + 1e-6f);
  a = a * rs * gn[2 * i]; b = b * rs * gn[2 * i + 1];
  const int tl = tok % L;
  const int jj = i & 15;
  const float* rt = rope + ((i < 16) ? ((tl >> 6) * 16 + jj) : (4096 + (tl & 63) * 16 + jj)) * 2;
  const float c = rt[0], s = rt[1];
  *ptr = pack2(a * c - b * s, a * s + b * c);
}

DI void transpose_item(const Params& P, int layer, const u16* __restrict__ p, int L, int kind, int ct, int tt, u16* __restrict__ dst, char* smem) {
  u16* tile = (u16*)smem;
  const int tid = otid() & 255;
  const int t0 = tt * 64;
  const int seq = t0 / L, tl0 = t0 - seq * L;
  const int C = (kind == 0) ? 128 : 512;
  __syncthreads();
  {
    const int col = tid & 63, r0 = tid >> 6;
    const int cidx = ct * 64 + col;
    if (kind < 2) {
      const int off = (kind == 0 ? OFF_GV : OFF_DV) + cidx;
#pragma unroll
      for (int i = 0; i < 16; ++i) { const int row = r0 + 4 * i; tile[col * 72 + row] = p[(size_t)(t0 + row) * INC + off]; }
    } else {
      const float* cw = P.hy_conv_w + layer * 3 * 1536; const float* cb = P.hy_conv_b + layer * 1536;
      const int c1 = 512 + cidx, c2 = 1024 + cidx;
      const float w10 = cw[c1], w11 = cw[1536 + c1], w12 = cw[3072 + c1], b1 = cb[c1];
      const float w20 = cw[c2], w21 = cw[1536 + c2], w22 = cw[3072 + c2], b2 = cb[c2];
#pragma unroll
      for (int i = 0; i < 16; ++i) {
        const int row = r0 + 4 * i; const int tl = tl0 + row;
        const u16* pr = p + (size_t)(t0 + row) * INC;
        const float xm1 = (tl > 0) ? bf2f(pr[c1 - INC]) : 0.f, x0 = bf2f(pr[c1]), xp1 = (tl < L - 1) ? bf2f(pr[c1 + INC]) : 0.f;
        const float vm1 = (tl > 0) ? bf2f(pr[c2 - INC]) : 0.f, v0 = bf2f(pr[c2]), vp1 = (tl < L - 1) ? bf2f(pr[c2 + INC]) : 0.f;
        const float x1c = xm1 * w10 + x0 * w11 + xp1 * w12 + b1;
        const float vc = vm1 * w20 + v0 * w21 + vp1 * w22 + b2;
        tile[col * 72 + row] = f2bf(vc * x1c);
      }
    }
  }
  __syncthreads();
  {
    const int c = tid >> 2, q = tid & 3;
    const u32x4 a = *(const u32x4*)(tile + c * 72 + q * 16), b = *(const u32x4*)(tile + c * 72 + q * 16 + 8);
    u16* d = dst + ((size_t)seq * C + ct * 64 + c) * L + tl0 + q * 16;
    *(u32x4*)d = a; *(u32x4*)(d + 8) = b;
  }
}

DI int kperm(int rho) { return (rho & ~0xC) | ((rho & 4) << 1) | ((rho & 8) >> 1); }
template <int DV, bool BIAS, bool SWAP>
DI void attn_tile(const u16* __restrict__ Qp, const u16* __restrict__ Kp, const u16* __restrict__ VTp, int L,
                  u16* __restrict__ Op, int ldo, int q0, const float* __restrict__ btab, char* smem) {
  constexpr int NDT = DV / 32;
  constexpr int VCH = DV / 64;
  constexpr int KS_SZ = 64 * 64, VS_SZ = DV * 64;
  constexpr int NL = 1 + VCH;
  u16* Ks = (u16*)smem;
  u16* Vs = Ks + 4 * KS_SZ;
  float* bt = (float*)(Vs + 3 * VS_SZ);
  const int tid = otid(), lane = tid & 63, w = __builtin_amdgcn_readfirstlane(tid >> 6), r = lane & 31, h = lane >> 5;
  const float sc = 0.125f * LOG2E;
  __syncthreads();
  if (BIAS) { for (int i = tid; i < 257; i += 512) bt[i] = btab[i]; }
  bf16x8 qf[4];
  {
    const u16* qrow = Qp + (size_t)(q0 + 32 * w + r) * INC + 8 * h;
#pragma unroll
    for (int s = 0; s < 4; ++s) qf[s] = *(const bf16x8*)(qrow + 16 * s);
  }
  const int qpos = q0 + 32 * w + r;
  f32x16 O[NDT];
#pragma unroll
  for (int d = 0; d < NDT; ++d)
#pragma unroll
    for (int q = 0; q < 16; ++q) O[d][q] = 0.f;
  float m = -INFINITY, l = 0.f;
  const int lrow = tid >> 3, lsw = (tid & 7) ^ ((tid >> 4) & 7);
  const u16* Kg0 = Kp + (size_t)kperm(lrow) * INC + lsw * 8;
  const u16* Vg = VTp + (size_t)lrow * L + lsw * 8;
  const int ksw = (r >> 1) & 7;
  const int nkb = L >> 6;
#define ATT_LOADK(tile, bufp) do { const int t__ = ((tile) < nkb) ? (tile) : nkb - 1; \
    __builtin_amdgcn_global_load_lds((const unsigned*)(Kg0 + ((size_t)t__ * 64) * INC), (unsigned*)((char*)(bufp) + tid * 16), 16, 0, 0); } while (0)
#define ATT_LOADV(tile, bufp) do { const int t__ = ((tile) < nkb) ? (tile) : nkb - 1; _Pragma("unroll") for (int i_ = 0; i_ < VCH; ++i_) \
    __builtin_amdgcn_global_load_lds((const unsigned*)(Vg + (size_t)(64 * i_) * L + (size_t)t__ * 64), (unsigned*)((char*)(bufp) + tid * 16 + i_ * 8192), 16, 0, 0); } while (0)
  f32x16 Sc[2];
  auto qk = [&](const u16* Kb) __attribute__((always_inline)) {
    bf16x8 kf[2][4];
#pragma unroll
    for (int kt = 0; kt < 2; ++kt)
#pragma unroll
      for (int s = 0; s < 4; ++s) kf[kt][s] = *(const bf16x8*)(Kb + (32 * kt + r) * 64 + (((2 * s + h) ^ ksw) << 3));
#pragma unroll
    for (int kt = 0; kt < 2; ++kt) {
#pragma unroll
      for (int q = 0; q < 16; ++q) Sc[kt][q] = 0.f;
#pragma unroll
      for (int s = 0; s < 4; ++s) Sc[kt] = MFMA(kf[kt][s], qf[s], Sc[kt]);
    }
    __builtin_amdgcn_sched_group_barrier(0x100, 8, 0);
    __builtin_amdgcn_sched_group_barrier(0x008, 8, 0);
  };
  bf16x8 pf[2][2];
  auto softmax = [&](int kb) __attribute__((always_inline)) {
    float cb = 0.f; bool near = false;
    if (BIAS) {
      const int kmin = kb * 64;
      near = !(kmin - (q0 + 255) >= 128 || q0 - (kmin + 63) >= 128);
      cb = (kmin > q0) ? bt[256] : bt[0];
      if (near) {
        const float isc = 1.0f / sc;
#pragma unroll
        for (int kt = 0; kt < 2; ++kt)
#pragma unroll
          for (int q = 0; q < 16; ++q) {
            int rel = kmin + 32 * kt + kperm(crow(q, h)) - qpos;
            rel = rel < -128 ? -128 : (rel > 128 ? 128 : rel);
            Sc[kt][q] += bt[rel + 128] * isc;
          }
        cb = 0.f;
      }
    }
    float mx = Sc[0][0];
#pragma unroll
    for (int kt = 0; kt < 2; ++kt)
#pragma unroll
      for (int q = 0; q < 16; ++q) mx = fmaxf(mx, Sc[kt][q]);
    mx = xhalf_max(mx);
    mx = __builtin_fmaf(mx, sc, cb);
    if (__any(mx > m + 6.0f)) {
      asm volatile("" ::: "memory");
      const float mn = fmaxf(m, mx);
      const float alpha = __builtin_amdgcn_exp2f(m - mn);
      m = mn; l *= alpha;
#pragma unroll
      for (int d = 0; d < NDT; ++d)
#pragma unroll
        for (int q = 0; q < 16; ++q) O[d][q] *= alpha;
    }
    const float nm = cb - m;
#pragma unroll
    for (int kt = 0; kt < 2; ++kt) {
#pragma unroll
      for (int q = 0; q < 16; ++q) {
        const float pv = __builtin_amdgcn_exp2f(__builtin_fmaf(Sc[kt][q], sc, nm));
        Sc[kt][q] = pv; l += pv;
      }
#pragma unroll
      for (int s = 0; s < 2; ++s) {
        u32x4 pk;
#pragma unroll
        for (int q = 0; q < 4; ++q) pk[q] = pack2(Sc[kt][8 * s + 2 * q], Sc[kt][8 * s + 2 * q + 1]);
        pf[kt][s] = __builtin_bit_cast(bf16x8, pk);
      }
    }
  };
  auto pv = [&](const u16* Vb) __attribute__((always_inline)) {
    bf16x8 vf[4][NDT];
#pragma unroll
    for (int ks = 0; ks < 4; ++ks)
#pragma unroll
      for (int d = 0; d < NDT; ++d) vf[ks][d] = *(const bf16x8*)(Vb + (32 * d + r) * 64 + (((2 * ks + h) ^ ksw) << 3));
#pragma unroll
    for (int ks = 0; ks < 4; ++ks)
#pragma unroll
      for (int d = 0; d < NDT; ++d) O[d] = MFMA(vf[ks][d], pf[ks >> 1][ks & 1], O[d]);
    __builtin_amdgcn_sched_group_barrier(0x100, 2 * NDT, 0);
    __builtin_amdgcn_sched_group_barrier(0x008, NDT, 0);
    __builtin_amdgcn_sched_group_barrier(0x100, NDT, 0);
    __builtin_amdgcn_sched_group_barrier(0x008, NDT, 0);
    __builtin_amdgcn_sched_group_barrier(0x100, NDT, 0);
    __builtin_amdgcn_sched_group_barrier(0x008, 2 * NDT, 0);
  };
  ATT_LOADK(0, Ks); ATT_LOADK(1, Ks + KS_SZ); ATT_LOADK(2, Ks + 2 * KS_SZ);
  ATT_LOADV(0, Vs); ATT_LOADV(1, Vs + VS_SZ);
  asm volatile("s_waitcnt vmcnt(0) lgkmcnt(0)\n\ts_barrier" ::: "memory");
  if (SWAP) qk(Ks);
  int r0 = 0, r2 = 2;
  for (int kb = 0; kb < nkb; ++kb) {
    ATT_LOADK(kb + 3, Ks + ((kb + 3) & 3) * KS_SZ);
    ATT_LOADV(kb + 2, Vs + r2 * VS_SZ);
    if (!SWAP) qk(Ks + (kb & 3) * KS_SZ);
    softmax(kb);
    pv(Vs + r0 * VS_SZ);
    if (SWAP) qk(Ks + ((kb + 1) & 3) * KS_SZ);
    asm volatile("s_waitcnt vmcnt(%0) lgkmcnt(0)\n\ts_barrier" :: "n"(NL) : "memory");
    r2 = r0; r0 = (r0 == 2) ? 0 : r0 + 1;
  }
  asm volatile("s_waitcnt vmcnt(0)" ::: "memory");
#undef ATT_LOADK
#undef ATT_LOADV
  l += __shfl_xor(l, 32);
  const float inv = __builtin_amdgcn_rcpf(l);
  int ldo2 = ldo; asm volatile("" : "+s"(ldo2));
  u16* orow = Op + (size_t)qpos * ldo2;
#pragma unroll
  for (int d = 0; d < NDT; ++d)
#pragma unroll
    for (int g4 = 0; g4 < 4; ++g4) {
      u32x2 o; o[0] = pack2(O[d][4 * g4] * inv, O[d][4 * g4 + 1] * inv); o[1] = pack2(O[d][4 * g4 + 2] * inv, O[d][4 * g4 + 3] * inv);
      *(u32x2*)(orow + 32 * d + 8 * g4 + 4 * h) = o;
    }
}

DI void attn_tile2(const u16* __restrict__ Qp, const u16* __restrict__ Kp, const u16* __restrict__ VTp, int L,
                   u16* __restrict__ Op, int ldo, int q0, char* smem) {
  constexpr int DV = 64, NDT = 2, VCH = 1, RT = 2;
  constexpr int KS_SZ = 64 * 64, VS_SZ = DV * 64;
  constexpr int NL = 1 + VCH;
  u16* Ks = (u16*)smem;
  u16* Vs = Ks + 4 * KS_SZ;
  const int tid = otid(), lane = tid & 63, w = __builtin_amdgcn_readfirstlane(tid >> 6), r = lane & 31, h = lane >> 5;
  const float sc = 0.125f * LOG2E;
  __syncthreads();
  bf16x8 qf[RT][4];
#pragma unroll
  for (int t = 0; t < RT; ++t) {
    const u16* qrow = Qp + (size_t)(q0 + 64 * w + 32 * t + r) * INC + 8 * h;
#pragma unroll
    for (int s = 0; s < 4; ++s) qf[t][s] = *(const bf16x8*)(qrow + 16 * s);
  }
  f32x16 O[RT][NDT];
#pragma unroll
  for (int t = 0; t < RT; ++t)
#pragma unroll
    for (int d = 0; d < NDT; ++d)
#pragma unroll
      for (int q = 0; q < 16; ++q) O[t][d][q] = 0.f;
  float m[RT], l[RT];
#pragma unroll
  for (int t = 0; t < RT; ++t) { m[t] = -INFINITY; l[t] = 0.f; }
  const int lrow = tid >> 3, lsw = (tid & 7) ^ ((tid >> 4) & 7);
  const u16* Kg0 = Kp + (size_t)kperm(lrow) * INC + lsw * 8;
  const u16* Vg = VTp + (size_t)lrow * L + lsw * 8;
  const int ksw = (r >> 1) & 7;
  const int nkb = L >> 6;
#define ATT_LOADK(tile, bufp) do { const int t__ = ((tile) < nkb) ? (tile) : nkb - 1; \
    __builtin_amdgcn_global_load_lds((const unsigned*)(Kg0 + ((size_t)t__ * 64) * INC), (unsigned*)((char*)(bufp) + tid * 16), 16, 0, 0); } while (0)
#define ATT_LOADV(tile, bufp) do { const int t__ = ((tile) < nkb) ? (tile) : nkb - 1; \
    __builtin_amdgcn_global_load_lds((const unsigned*)(Vg + (size_t)t__ * 64), (unsigned*)((char*)(bufp) + tid * 16), 16, 0, 0); } while (0)
  ATT_LOADK(0, Ks); ATT_LOADK(1, Ks + KS_SZ); ATT_LOADK(2, Ks + 2 * KS_SZ);
  ATT_LOADV(0, Vs); ATT_LOADV(1, Vs + VS_SZ);
  asm volatile("s_waitcnt vmcnt(0) lgkmcnt(0)\n\ts_barrier" ::: "memory");
  int r0 = 0, r2 = 2;
  for (int kb = 0; kb < nkb; ++kb) {
    ATT_LOADK(kb + 3, Ks + ((kb + 3) & 3) * KS_SZ);
    ATT_LOADV(kb + 2, Vs + r2 * VS_SZ);
    const u16* Kb = Ks + (kb & 3) * KS_SZ; const u16* Vb = Vs + r0 * VS_SZ;
    f32x16 Sc[RT][2];
    {
      bf16x8 kf[2][4];
#pragma unroll
      for (int kt = 0; kt < 2; ++kt)
#pragma unroll
        for (int s = 0; s < 4; ++s) kf[kt][s] = *(const bf16x8*)(Kb + (32 * kt + r) * 64 + (((2 * s + h) ^ ksw) << 3));
#pragma unroll
      for (int t = 0; t < RT; ++t)
#pragma unroll
        for (int kt = 0; kt < 2; ++kt) {
#pragma unroll
          for (int q = 0; q < 16; ++q) Sc[t][kt][q] = 0.f;
#pragma unroll
          for (int s = 0; s < 4; ++s) Sc[t][kt] = MFMA(kf[kt][s], qf[t][s], Sc[t][kt]);
        }
      __builtin_amdgcn_sched_group_barrier(0x100, 8, 0);
      __builtin_amdgcn_sched_group_barrier(0x008, 16, 0);
    }
    bf16x8 pf[RT][2][2];
#pragma unroll
    for (int t = 0; t < RT; ++t) {
      float mx = Sc[t][0][0];
#pragma unroll
      for (int kt = 0; kt < 2; ++kt)
#pragma unroll
        for (int q = 0; q < 16; ++q) mx = fmaxf(mx, Sc[t][kt][q]);
      mx = xhalf_max(mx);
      mx *= sc;
      if (__any(mx > m[t] + 6.0f)) {
        asm volatile("" ::: "memory");
        const float mn = fmaxf(m[t], mx);
        const float alpha = __builtin_amdgcn_exp2f(m[t] - mn);
        m[t] = mn; l[t] *= alpha;
#pragma unroll
        for (int d = 0; d < NDT; ++d)
#pragma unroll
          for (int q = 0; q < 16; ++q) O[t][d][q] *= alpha;
      }
      const float nm = -m[t];
#pragma unroll
      for (int kt = 0; kt < 2; ++kt) {
#pragma unroll
        for (int q = 0; q < 16; ++q) { const float pv = __builtin_amdgcn_exp2f(__builtin_fmaf(Sc[t][kt][q], sc, nm)); Sc[t][kt][q] = pv; l[t] += pv; }
#pragma unroll
        for (int s = 0; s < 2; ++s) {
          u32x4 pk;
#pragma unroll
          for (int q = 0; q < 4; ++q) pk[q] = pack2(Sc[t][kt][8 * s + 2 * q], Sc[t][kt][8 * s + 2 * q + 1]);
          pf[t][kt][s] = __builtin_bit_cast(bf16x8, pk);
        }
      }
    }
    {
      bf16x8 vf[4][NDT];
#pragma unroll
      for (int ks = 0; ks < 4; ++ks)
#pragma unroll
        for (int d = 0; d < NDT; ++d) vf[ks][d] = *(const bf16x8*)(Vb + (32 * d + r) * 64 + (((2 * ks + h) ^ ksw) << 3));
#pragma unroll
      for (int ks = 0; ks < 4; ++ks)
#pragma unroll
        for (int d = 0; d < NDT; ++d)
#pragma unroll
          for (int t = 0; t < RT; ++t) O[t][d] = MFMA(vf[ks][d], pf[t][ks >> 1][ks & 1], O[t][d]);
      __builtin_amdgcn_sched_group_barrier(0x100, 4, 0);
      __builtin_amdgcn_sched_group_barrier(0x008, 4, 0);
      __builtin_amdgcn_sched_group_barrier(0x100, 4, 0);
      __builtin_amdgcn_sched_group_barrier(0x008, 12, 0);
    }
    asm volatile("s_waitcnt vmcnt(%0) lgkmcnt(0)\n\ts_barrier" :: "n"(NL) : "memory");
    r2 = r0; r0 = (r0 == 2) ? 0 : r0 + 1;
  }
  asm volatile("s_waitcnt vmcnt(0)" ::: "memory");
#undef ATT_LOADK
#undef ATT_LOADV
  int ldo2 = ldo; asm volatile("" : "+s"(ldo2));
#pragma unroll
  for (int t = 0; t < RT; ++t) {
    float lt = l[t]; lt += __shfl_xor(lt, 32);
    const float inv = __builtin_amdgcn_rcpf(lt);
    u16* orow = Op + (size_t)(q0 + 64 * w + 32 * t + r) * ldo2;
#pragma unroll
    for (int d = 0; d < NDT; ++d)
#pragma unroll
      for (int g4 = 0; g4 < 4; ++g4) {
        u32x2 o; o[0] = pack2(O[t][d][4 * g4] * inv, O[t][d][4 * g4 + 1] * inv); o[1] = pack2(O[t][d][4 * g4 + 2] * inv, O[t][d][4 * g4 + 3] * inv);
        *(u32x2*)(orow + 32 * d + 8 * g4 + 4 * h) = o;
      }
  }
}

template <int ILO, int IHI>
DI void hy_seg(int lo, int hi, f32x16 (&acc)[4], const u16* fw, const u16* fw1, const u16* zs, const int (&tq)[4], const int (&tJ)[4],
               int ZLP8, int L, int wb, int r, int h) {
  if (lo > hi) return;
  const int idx0 = L - lo - r + 8 * h - wb;
  const unsigned* ap = (idx0 & 1) ? (const unsigned*)(fw1 + idx0 - 1) : (const unsigned*)(fw + idx0);
  const u16* zq[4]; int cs[4];
#pragma unroll
  for (int i = ILO; i <= IHI; ++i) { zq[i] = zs + tq[i] * ZLP8; cs[i] = (1024 + 1024 * tJ[i] + 32 * r - lo + 8 * h) >> 3; }
  const int n = ((hi - lo) >> 4) + 1;
  bf16x8 a, b[4];
  { u32x4 av; av[0] = ap[0]; av[1] = ap[1]; av[2] = ap[2]; av[3] = ap[3]; a = __builtin_bit_cast(bf16x8, av); }
#pragma unroll
  for (int i = ILO; i <= IHI; ++i) b[i] = *(const bf16x8*)(zq[i] + ((cs[i] + (cs[i] >> 2)) << 3));
  for (int k = 0; k < n; ++k) {
    ap -= 8;
    bf16x8 an, c[4];
    { u32x4 av; av[0] = ap[0]; av[1] = ap[1]; av[2] = ap[2]; av[3] = ap[3]; an = __builtin_bit_cast(bf16x8, av); }
#pragma unroll
    for (int i = ILO; i <= IHI; ++i) { cs[i] -= 2; c[i] = *(const bf16x8*)(zq[i] + ((cs[i] + (cs[i] >> 2)) << 3)); }
#pragma unroll
    for (int i = ILO; i <= IHI; ++i) acc[i] = MFMA(a, b[i], acc[i]);
    a = an;
#pragma unroll
    for (int i = ILO; i <= IHI; ++i) b[i] = c[i];
  }
}

DI void hyena_item(int c, const u16* __restrict__ G, const u16* __restrict__ zT, u16* __restrict__ yT, int nseq, int L, char* smem) {
  u16* zs = (u16*)smem;
  u16* fw = zs + 25600;
  u16* fw1 = fw + 4224;
  const int tid = otid() & 255, lane = tid & 63, w = __builtin_amdgcn_readfirstlane(tid >> 6), r = lane & 31, h = lane >> 5;
  const int ZL = L + 2048;
  const int ZLP8 = ((ZL >> 3) + (ZL >> 5)) << 3;
  __syncthreads();
  for (int q = 0; q < nseq; ++q) {
    const u16* src = zT + ((size_t)q * 512 + c) * L;
    u16* dst = zs + q * ZLP8;
    const u32x4 zero = {0u, 0u, 0u, 0u};
    for (int i = tid; i < 128; i += 256) { const int c0 = i, c1 = 128 + (L >> 3) + i; *(u32x4*)(dst + ((c0 + (c0 >> 2)) << 3)) = zero; *(u32x4*)(dst + ((c1 + (c1 >> 2)) << 3)) = zero; }
    for (int i = tid; i < (L >> 3); i += 256) { const int cc = 128 + i; *(u32x4*)(dst + ((cc + (cc >> 2)) << 3)) = *(const u32x4*)(src + i * 8); }
  }
  int tq[4], tJ[4];
#pragma unroll
  for (int i = 0; i < 4; ++i) { if (nseq == 2) { tq[i] = i & 1; tJ[i] = 2 * w + (i >> 1); } else { tq[i] = 0; tJ[i] = 4 * w + i; } }
  f32x16 acc[4];
#pragma unroll
  for (int i = 0; i < 4; ++i)
#pragma unroll
    for (int q = 0; q < 16; ++q) acc[i][q] = 0.f;
  const int E0 = -L + 16, ELAST = L - 32;
  const int npass = (2 * L - 32 + 4095) / 4096;
  const u16* Gc = G + (size_t)c * (2 * L);
  for (int ps = 0; ps < npass; ++ps) {
    const int ea = E0 + 4096 * ps, eb = ea + 4096;
    const int wb = L - eb - 16;
    __syncthreads();
    for (int i = tid; i < 520; i += 256) {
      const int gi = wb + i * 8;
      u32x4 v = {0u, 0u, 0u, 0u};
      if (gi >= 0 && gi < 2 * L) v = *(const u32x4*)(Gc + gi);
      *(u32x4*)(fw + i * 8) = v;
    }
    __syncthreads();
    for (int i = tid; i < 2079; i += 256) { const unsigned lo = ((const unsigned*)fw)[i], hi = ((const unsigned*)fw)[i + 1]; ((unsigned*)fw1)[i] = (lo >> 16) | (hi << 16); }
    __syncthreads();
    const int eend = (eb - 16 < ELAST) ? (eb - 16) : ELAST;
    int emn[4], emx[4];
#pragma unroll
    for (int i = 0; i < 4; ++i) { emn[i] = 1024 * tJ[i] - L + 16; emx[i] = 1024 * tJ[i] + 992; }
#define HY_CLIP_LO(v) ((v) < ea ? ea : (v))
#define HY_CLIP_HI(v) ((v) > eend ? eend : (v))
    hy_seg<0, 0>(HY_CLIP_LO(emn[0]), HY_CLIP_HI(emn[1] - 16), acc, fw, fw1, zs, tq, tJ, ZLP8, L, wb, r, h);
    hy_seg<0, 1>(HY_CLIP_LO(emn[1]), HY_CLIP_HI(emn[2] - 16), acc, fw, fw1, zs, tq, tJ, ZLP8, L, wb, r, h);
    hy_seg<0, 2>(HY_CLIP_LO(emn[2]), HY_CLIP_HI(emn[3] - 16), acc, fw, fw1, zs, tq, tJ, ZLP8, L, wb, r, h);
    hy_seg<0, 3>(HY_CLIP_LO(emn[3]), HY_CLIP_HI(emx[0]), acc, fw, fw1, zs, tq, tJ, ZLP8, L, wb, r, h);
    hy_seg<1, 3>(HY_CLIP_LO(emx[0] + 16), HY_CLIP_HI(emx[1]), acc, fw, fw1, zs, tq, tJ, ZLP8, L, wb, r, h);
    hy_seg<2, 3>(HY_CLIP_LO(emx[1] + 16), HY_CLIP_HI(emx[2]), acc, fw, fw1, zs, tq, tJ, ZLP8, L, wb, r, h);
    hy_seg<3, 3>(HY_CLIP_LO(emx[2] + 16), HY_CLIP_HI(emx[3]), acc, fw, fw1, zs, tq, tJ, ZLP8, L, wb, r, h);
#undef HY_CLIP_LO
#undef HY_CLIP_HI
  }
#pragma unroll
  for (int i = 0; i < 4; ++i) {
    u16* dst = yT + ((size_t)tq[i] * 512 + c) * L + 1024 * tJ[i] + 32 * r + 4 * h;
#pragma unroll
    for (int g4 = 0; g4 < 4; ++g4) {
      u32x2 o; o[0] = pack2(acc[i][4 * g4], acc[i][4 * g4 + 1]); o[1] = pack2(acc[i][4 * g4 + 2], acc[i][4 * g4 + 3]);
      *(u32x2*)(dst + 8 * g4) = o;
    }
  }
}

DI void diff_post_item(const Params& P, int layer, float lam, float lam_init, const u16* __restrict__ dO, u16* __restrict__ ydf, int it) {
  const int tid = otid() & 255, lane = tid & 63, w = __builtin_amdgcn_readfirstlane(tid >> 6);
  const int u = it * 8 + w * 2 + (lane >> 5);
  const int i = lane & 31;
  const u32x2 a = *(const u32x2*)(dO + (size_t)u * 256 + 4 * i);
  const u32x2 b = *(const u32x2*)(dO + (size_t)u * 256 + 128 + 4 * i);
  float o[4];
  o[0] = bflo(a[0]) - lam * bflo(b[0]); o[1] = bfhi(a[0]) - lam * bfhi(b[0]);
  o[2] = bflo(a[1]) - lam * bflo(b[1]); o[3] = bfhi(a[1]) - lam * bfhi(b[1]);
  const float ss = half_sum(o[0] * o[0] + o[1] * o[1] + o[2] * o[2] + o[3] * o[3]);
  const float rs = rsqrtf(ss * (1.0f / 128.0f) + 1e-5f) * (1.0f - lam_init);
  const float* g = P.diff_subln + layer * 128 + 4 * i;
  u32x2 ov; ov[0] = pack2(o[0] * rs * g[0], o[1] * rs * g[1]); ov[1] = pack2(o[2] * rs * g[2], o[3] * rs * g[3]);
  *(u32x2*)(ydf + (size_t)u * 128 + 4 * i) = ov;
}
DI void hyena_post_item(const Params& P, int layer, const u16* __restrict__ p, int L, const u16* __restrict__ yT, const u16* __restrict__ zT,
                        int ct, int tt, u16* __restrict__ yhy, char* smem) {
  float* tile = (float*)smem;
  const int tid = otid() & 255;
  const int t0 = tt * 64; const int seq = t0 / L, tl0 = t0 - seq * L;
  __syncthreads();
  {
    const int tcol = tid & 63, c0 = tid >> 6;
#pragma unroll
    for (int i = 0; i < 16; ++i) {
      const int cc = c0 + 4 * i; const int c = ct * 64 + cc;
      const size_t gi = ((size_t)seq * 512 + c) * L + tl0 + tcol;
      tile[cc * 65 + tcol] = bf2f(yT[gi]) + bf2f(zT[gi]) * P.hy_skip[layer * 512 + c];
    }
  }
  __syncthreads();
  {
    const int col = tid & 63, r0 = tid >> 6; const int c = ct * 64 + col;
    const float* cw = P.hy_conv_w + layer * 3 * 1536; const float* cb = P.hy_conv_b + layer * 1536;
    const float w0 = cw[c], w1 = cw[1536 + c], w2 = cw[3072 + c], b0 = cb[c];
#pragma unroll
    for (int i = 0; i < 16; ++i) {
      const int row = r0 + 4 * i; const int tl = tl0 + row;
      const u16* pr = p + (size_t)(t0 + row) * INC + c;
      const float xm1 = (tl > 0) ? bf2f(pr[-INC]) : 0.f, x0 = bf2f(pr[0]), xp1 = (tl < L - 1) ? bf2f(pr[INC]) : 0.f;
      const float x0c = xm1 * w0 + x0 * w1 + xp1 * w2 + b0;
      yhy[(size_t)(t0 + row) * 512 + c] = f2bf(x0c * tile[col * 65 + row]);
    }
  }
}

__global__ void __launch_bounds__(512) fwd_megakernel(Params Parg) {
  cg::grid_group grid = cg::this_grid();
  extern __shared__ __attribute__((aligned(16))) char smem_dyn[];
  char* smem = smem_dyn + 16;
  uint4& xb_words = *(uint4*)smem_dyn;
  const int nb = gridDim.x, nb2 = nb * 2;
#define KPARAMS() const Params __attribute__((address_space(4)))* pp_ = (const Params __attribute__((address_space(4)))*)__builtin_amdgcn_kernarg_segment_ptr(); \
  asm volatile("" : "+s"(pp_)); const Params& P = *(const Params*)pp_; char* ws = P.ws
  if (threadIdx.x == 0) xb_words = make_uint4(0u, 0u, 0u, blockIdx.x);
  __syncthreads();
  XcdBarrier xb;
  { KPARAMS(); xb = xcd_barrier_post((unsigned*)(ws + O_BAR), (volatile LAS unsigned*)&xb_words); }

  for (int step = 0; step < 80; ++step) {
    const int layer = step / 40, ls = step - layer * 40;
    PHASE_IDS();
    KPARAMS();
    float* misc = (float*)(ws + O_MISC);
    u16* pbuf = (u16*)(ws + O_P); u16* hid = pbuf; u16* hn = (u16*)(ws + O_HN); u16* merged = hn;
    if (ls == 0) {
      u16* filt8 = (u16*)(ws + O_FILT8); u16* filt16 = (u16*)(ws + O_FILT16);
      const int n1 = 16 * 88, n2 = 44 * 16, n3 = 16 * 108, n4 = 3 * 8 * 16, n5 = 16 * 16;
      const int nfilt = 128 + 256;
      const int total = n1 + n2 + n3 + n4 + n5 + n1 + n2 + nfilt;
      for (int it = bid2; it < total; it += nb2) {
        int t = it;
        if (t < nfilt) {
          const bool big = t < 256;
          filter_item(P, layer, big ? 16384 : 8192, big ? t : t - 256, big ? filt16 : filt8, smg);
          continue;
        }
        t -= nfilt;
        const float* src; int K, N, kt, nt, ph = 0; u16* dst;
        if (t < n1) { src = P.ffn1_w_in + (size_t)layer * 1024 * 5632; K = 1024; N = 5632; dst = (u16*)(ws + O_F1IN); kt = t / 88; nt = t % 88; ph = 2816; }
        else if ((t -= n1) < n2) { src = P.ffn1_w_out + (size_t)layer * 2816 * 1024; K = 2816; N = 1024; dst = (u16*)(ws + O_F1OUT); kt = t / 16; nt = t % 16; }
        else if ((t -= n2) < n3) { src = P.w_in + (size_t)layer * 1024 * 6912; K = 1024; N = 6912; dst = (u16*)(ws + O_WIN); kt = t / 108; nt = t % 108; }
        else if ((t -= n3) < n4) { const int br = t / 128, tt = t % 128; src = P.w_branch + ((size_t)layer * 3 + br) * 512 * 1024; K = 512; N = 1024;
                                   dst = (u16*)(ws + O_WBR) + (size_t)br * 1024 * 512; kt = tt / 16; nt = tt % 16; }
        else if ((t -= n4) < n5) { src = P.w_out + (size_t)layer * 1024 * 1024; K = 1024; N = 1024; dst = (u16*)(ws + O_WOUT); kt = t / 16; nt = t % 16; }
        else if ((t -= n5) < n1) { src = P.ffn2_w_in + (size_t)layer * 1024 * 5632; K = 1024; N = 5632; dst = (u16*)(ws + O_F2IN); kt = t / 88; nt = t % 88; ph = 2816; }
        else { t -= n1; src = P.ffn2_w_out + (size_t)layer * 2816 * 1024; K = 2816; N = 1024; dst = (u16*)(ws + O_F2OUT); kt = t / 16; nt = t % 16; }
        convT_tile(src, K, N, dst, kt, nt, ph, smg);
      }
      if (bid == 1 && grp == 0 && layer == 0) {
        float* rope = (float*)(ws + O_ROPE);
        for (int i = t_; i < 320 * 16; i += 256) {
          const int pos = (i < 4096) ? (i >> 4) : ((i - 4096) >> 4); const int jj = i & 15;
          const float inv = powf(10000.0f, -(float)(2 * jj) / 32.0f);
          const float ang = (float)pos * inv;
          rope[2 * i] = cosf(ang); rope[2 * i + 1] = sinf(ang);
        }
      }
      if (bid == 0 && grp == 0) {
        const int tid = t_;
        if (tid < 2) {
          const float* lp = P.diff_lambda + tid * 256;
          float s1 = 0.f, s2 = 0.f;
          for (int i = 0; i < 64; ++i) { s1 += lp[i] * lp[64 + i]; s2 += lp[128 + i] * lp[192 + i]; }
          const float lam_init = 0.8f - 0.6f * expf(-0.3f * (float)tid);
          misc[tid] = expf(s1) - expf(s2) + lam_init;
        }
        for (int i = tid; i < 4 * 257; i += 256) {
          const int hh = i / 257, idx = i % 257; const int rel = idx - 128; const int n = rel < 0 ? -rel : rel;
          int b;
          if (n < 8) b = n; else { int lg = 8 + (int)(logf((float)n / 8.0f) / 2.772588722239781f * 8.0f); b = lg < 15 ? lg : 15; }
          if (rel > 0) b += 16;
          misc[64 + i] = P.rel_bias[b * 4 + hh] * LOG2E;
        }
      }
      if (step == 0) {
        grid.sync();
        if (threadIdx.x == 0) {
          unsigned* bar = (unsigned*)(ws + O_BAR); bool even = ((nb & 7) == 0);
          for (int j = 0; j < 16; ++j) { const unsigned c = xb_ld(&bar[XB_XCNT(j)]); if (c != ((j < 8) ? (unsigned)(nb >> 3) : 0u)) even = false; }
          volatile LAS unsigned* st = (volatile LAS unsigned*)&xb_words;
          if (even) st[3] = st[2] * 8u + xb.x;
        }
        __syncthreads();
      } else GSYNC();
      continue;
    }
    const int cs = ls - 1; const int ch = cs / 13, st = cs - ch * 13;
    const int nseq = (ch < 2) ? 2 : 1, L = (ch < 2) ? 8192 : 16384;
    const float* xin0 = (ch < 2) ? (P.x_prompt + (size_t)ch * TCH * DM) : P.x_sample;
    float* xres = P.out + (size_t)ch * TCH * DM;
    const float* xcur = (layer == 0) ? xin0 : xres;
    for (int rp_ = 0; rp_ <= ((REPMASK >> st) & 1); ++rp_) {
    if (st == 0 || st == 3 || st == 10) {
      const float* src = (st == 0) ? xcur : xres;
      const float* gn = ((st == 0) ? P.ffn1_norm : (st == 3 ? P.mix_norm : P.ffn2_norm)) + layer * DM;
      for (int it = bid2; it < TCH / 4; it += nb2) { const int row = it * 4 + w; norm_row_bf16(src + (size_t)row * DM, gn, hn + (size_t)row * DM, lane); }
    } else if (st == 1 || st == 2 || st == 4 || st == 8 || st == 9 || st == 11 || st == 12) {
      EpiAny E{}; const u16* A; const u16* Bt; int N, K;
      if (st == 1 || st == 11) { A = hn; Bt = (u16*)(ws + (st == 1 ? O_F1IN : O_F2IN)); N = 5632; K = DM; E.mode = EPI_SWIGLU; E.perm = true; E.O = hid; E.ldo = DFF; }
      else if (st == 2 || st == 12) { A = hid; Bt = (u16*)(ws + (st == 2 ? O_F1OUT : O_F2OUT)); N = DM; K = DFF; E.mode = EPI_RESID; E.perm = false;
                                      E.xin = (st == 2) ? xcur : xres; E.xout = xres; E.scale = 0.5f; }
      else if (st == 4) { A = hn; Bt = (u16*)(ws + O_WIN); N = INC; K = DM; E.mode = EPI_PROJ; E.perm = true; E.O = pbuf; E.L = L; E.vtg = (u16*)(ws + O_VTG); E.vtd = (u16*)(ws + O_VTD); }
      else if (st == 8) { A = (u16*)(ws + O_YHY); Bt = (u16*)(ws + O_WBR); N = DM; K = 512; E.mode = EPI_MERGE; E.perm = false; E.gate = pbuf; E.macc = (float*)(ws + O_ZT); E.O = merged; }
      else { A = merged; Bt = (u16*)(ws + O_WOUT); N = DM; K = DM; E.mode = EPI_RESID; E.perm = false; E.xin = xres; E.xout = xres; E.scale = 1.0f; }
      if (st == 8) {
        pg8::Gemm gg{A, Bt, TCH, N, K};
        AnyOrder S; S.init(TCH, N, nb, bid); S.merge3 = true;
        EpiMerge EM{true, pbuf, merged};
        pg8::gemm_phase<EpiMerge, AnyOrder, false>((PG8_LAS unsigned char*)smem, gg, S, EM, nullptr);
      } else {
        pg8::Gemm gg{A, Bt, TCH, N, K};
        AnyOrder S; S.init(TCH, N, nb, bid); S.merge3 = false;
        pg8::gemm_phase<EpiAny, AnyOrder, false>((PG8_LAS unsigned char*)smem, gg, S, E, nullptr);
      }
    } else if (st == 5) {
      const int nqk = TCH * 10 / 8, ntr = 256 * 8;
      for (int it = bid2; it < nqk + ntr; it += nb2) {
        if (it < nqk) { qk_prep_item(P, layer, pbuf, L, it, (const float*)(ws + O_ROPE)); continue; }
        const int t = it - nqk; const int tt = t >> 3, ct = t & 7;
        transpose_item(P, layer, pbuf, L, 2, ct, tt, (u16*)(ws + O_ZT), smg);
      }
    } else if (st == 6) {
      u16* zT = (u16*)(ws + O_ZT); u16* yT = (u16*)(ws + O_YT); u16* dO = (u16*)(ws + O_DIFFO);
      u16* vtg = (u16*)(ws + O_VTG); u16* vtd = (u16*)(ws + O_VTD); u16* ygq = (u16*)(ws + O_YGQ);
      const u16* filt = (u16*)(ws + ((ch < 2) ? O_FILT8 : O_FILT16));
      const int nqt = L / 256;
      const int xcd = bid & 7, nxu = nb >> 3, nitem = nseq * nqt;
      for (int e = bid >> 3; e < nitem; e += nxu) {
        const int seq = e / nqt, qt = e - seq * nqt;
        const int hh = xcd >> 1, cc = xcd & 1;
        const size_t tb = (size_t)seq * L;
        const u16* Qd = pbuf + tb * INC + OFF_DQ + xcd * 64; const u16* Kd = pbuf + tb * INC + OFF_DK + xcd * 64;
        const u16* Vd = vtd + ((size_t)seq * 512 + hh * 128) * L; u16* Od = dO + tb * 1024 + (hh * 2 + cc) * 128;
        attn_tile<128, true, false>(Qd, Kd, Vd, L, Od, 1024, qt * 256, misc + 64 + hh * 257, smem);
      }
      {
        const int nqt2 = L / 512, nitem2 = nseq * nqt2;
        for (int e = bid >> 3; e < nitem2; e += nxu) {
          const int seq = e / nqt2, qt = e - seq * nqt2;
          const int kvh = xcd >> 2;
          const size_t tb = (size_t)seq * L;
          const u16* Qd = pbuf + tb * INC + OFF_GQ + xcd * 64; const u16* Kd = pbuf + tb * INC + OFF_GK + kvh * 64;
          const u16* Vd = vtg + ((size_t)seq * 128 + kvh * 64) * L; u16* Od = ygq + tb * 512 + xcd * 64;
          attn_tile2(Qd, Kd, Vd, L, Od, 512, qt * 512, smem);
        }
      }
      for (int c = bid2; c < 512; c += nb2) hyena_item(c, filt, zT, yT, nseq, L, smg);
    } else {
      u16* zT = (u16*)(ws + O_ZT); u16* yT = (u16*)(ws + O_YT); u16* dO = (u16*)(ws + O_DIFFO);
      u16* yhy = (u16*)(ws + O_YHY); u16* ydf = (u16*)(ws + O_YDF);
      const float lam = misc[layer];
      const float lam_init = 0.8f - 0.6f * expf(-0.3f * (float)layer);
      const int ndp = TCH * 4 / 8, nhp = 256 * 8;
      for (int it = bid2; it < ndp + nhp; it += nb2) {
        if (it < ndp) diff_post_item(P, layer, lam, lam_init, dO, ydf, it);
        else { const int t = it - ndp; hyena_post_item(P, layer, pbuf, L, yT, zT, t % 8, t / 8, yhy, smg); }
      }
    }
    }
    GSYNC();
  }
  { PHASE_IDS(); KPARAMS(); (void)ws;
    for (int it = bid2; it < NTOK / 4; it += nb2) { const int row = it * 4 + w; norm_row_f32_inplace(P.out + (size_t)row * DM, P.final_norm, lane); }
  }
}

extern "C" void kernel_launch(void* const* d_in, const int* in_sizes, int n_in, void* d_out, int out_size, void* d_ws, size_t ws_size,
                              hipStream_t stream) {
  static int grid_blocks = 0;
  if (!grid_blocks) {
    int dev = 0, cus = 0, per_cu = 0;
    (void)hipGetDevice(&dev);
    (void)hipDeviceGetAttribute(&cus, hipDeviceAttributeMultiprocessorCount, dev);
    (void)hipFuncSetAttribute((const void*)fwd_megakernel, hipFuncAttributeMaxDynamicSharedMemorySize, SMEM_BYTES + 16);
    (void)hipOccupancyMaxActiveBlocksPerMultiprocessor(&per_cu, fwd_megakernel, 512, SMEM_BYTES + 16);
    if (per_cu < 1) per_cu = 1;
    if (per_cu > 1) per_cu = 1;
    grid_blocks = cus * per_cu;
  }
  Params p{};
  const float* const* in = (const float* const*)d_in;
  p.x_prompt = in[0]; p.x_sample = in[1]; p.ffn1_norm = in[2]; p.ffn1_w_in = in[3]; p.ffn1_w_out = in[4]; p.mix_norm = in[5]; p.w_in = in[6];
  p.hy_conv_w = in[7]; p.hy_conv_b = in[8]; p.hy_w1 = in[9]; p.hy_b1 = in[10]; p.hy_w2 = in[11]; p.hy_b2 = in[12]; p.hy_w3 = in[13];
  p.hy_freq = in[14]; p.hy_skip = in[15]; p.gqa_q_norm = in[16]; p.gqa_k_norm = in[17]; p.diff_lambda = in[18]; p.diff_subln = in[19];
  p.rel_bias = in[20]; p.w_branch = in[21]; p.w_out = in[22]; p.ffn2_norm = in[23]; p.ffn2_w_in = in[24]; p.ffn2_w_out = in[25]; p.final_norm = in[26];
  p.out = (float*)d_out; p.ws = (char*)d_ws;
  void* args[] = {&p};
  (void)hipMemsetAsync((char*)d_ws + O_BAR, 0, XCD_BAR_WORDS * 4, stream);
  hipError_t e = hipLaunchCooperativeKernel((void*)fwd_megakernel, dim3(grid_blocks), dim3(512), args, SMEM_BYTES + 16, stream);
  if (e != hipSuccess) fprintf(stderr, "cooperative launch failed: %s (grid %d)\n", hipGetErrorString(e), grid_blocks);
}
```

```cpp
#include <hip/hip_runtime.h>
#include <hip/hip_cooperative_groups.h>
#include <stdint.h>
#include <cstdio>
namespace cg = cooperative_groups;

typedef unsigned short u16;
typedef __attribute__((ext_vector_type(8))) short bf16x8;
typedef __attribute__((ext_vector_type(16))) float f32x16;
typedef __attribute__((ext_vector_type(4))) float f32x4;
typedef __attribute__((ext_vector_type(4))) unsigned u32x4;
typedef __attribute__((ext_vector_type(2))) unsigned u32x2;
typedef __attribute__((ext_vector_type(2))) __bf16 bf2_t;
typedef __attribute__((ext_vector_type(2))) float f2_t;
#define DI __device__ __forceinline__
#define MFMA(a, b, c) __builtin_amdgcn_mfma_f32_32x32x16_bf16((a), (b), (c), 0, 0, 0)

constexpr int DM = 1024, DFF = 2816, INC = 6912, TCH = 16384, NTOK = 49152;
constexpr int OFF_GQ = 1536, OFF_GK = 2048, OFF_GV = 2176, OFF_DQ = 2304, OFF_DK = 2816, OFF_DV = 3328, OFF_GATE = 3840;
constexpr float LOG2E = 1.4426950408889634f;

constexpr size_t SZ_F1IN = (size_t)5632 * 1024 * 2, SZ_F1OUT = (size_t)1024 * 2816 * 2, SZ_WIN = (size_t)6912 * 1024 * 2,
                 SZ_WBR = (size_t)3 * 1024 * 512 * 2, SZ_WOUT = (size_t)1024 * 1024 * 2;
constexpr size_t O_F1IN = 0, O_F1OUT = O_F1IN + SZ_F1IN, O_WIN = O_F1OUT + SZ_F1OUT, O_WBR = O_WIN + SZ_WIN, O_WOUT = O_WBR + SZ_WBR,
                 O_F2IN = O_WOUT + SZ_WOUT, O_F2OUT = O_F2IN + SZ_F1IN, O_FILT8 = O_F2OUT + SZ_F1OUT,
                 O_FILT16 = O_FILT8 + (size_t)512 * 16384 * 2, O_MISC = O_FILT16 + (size_t)512 * 32768 * 2,
                 O_P = O_MISC + 131072, O_HN = O_P + (size_t)TCH * INC * 2, O_ZT = O_HN + (size_t)TCH * 1024 * 2,
                 O_YT = O_ZT + (size_t)TCH * 512 * 2, O_DIFFO = O_YT + (size_t)TCH * 512 * 2, O_VTG = O_DIFFO + (size_t)TCH * 1024 * 2,
                 O_VTD = O_VTG + (size_t)TCH * 128 * 2, O_YHY = O_VTD + (size_t)TCH * 512 * 2, O_YGQ = O_YHY + (size_t)TCH * 512 * 2,
                 O_YDF = O_YGQ + (size_t)TCH * 512 * 2, O_END = O_YDF + (size_t)TCH * 512 * 2;
static_assert(O_END <= (size_t)536870912, "workspace overflow");
constexpr int SMEM_BYTES = 151552;
constexpr int GRP_LDS = 75776;
#define REPMASK 0
#define REP_SYNC 1
#define PHASE_IDS() const int t_ = otid(); const int bid = __builtin_amdgcn_readfirstlane(((volatile LAS unsigned*)&xb_words)[3]); const int lane = t_ & 63; const int grp = __builtin_amdgcn_readfirstlane(t_ >> 8); \
  const int w = __builtin_amdgcn_readfirstlane((t_ >> 6) & 3); const int bid2 = bid * 2 + grp; char* smg = smem + grp * GRP_LDS; \
  const int vb = (bid & 7) * (nb >> 3) + (bid >> 3); (void)lane; (void)w; (void)bid2; (void)smg; (void)vb
#define GSYNC() do { for (int rs_ = 0; rs_ < REP_SYNC; ++rs_) xcd_barrier(xb); } while (0)


#define XB_TMO      128
#define XB_XCNT(j)  (256  + 64 * (j))
#define XB_XSUB(j)  (1280 + 64 * (j))
#define XB_XGEN(j)  (2304 + 64 * (j))
#define XB_TOP      3328
#define XB_TOPGEN   3392
#define XCD_BAR_WORDS 3456
#define XB_SPIN_CAP (1u << 21)
#define LAS __attribute__((address_space(3)))
DI unsigned xb_ld(unsigned* p)              { return __hip_atomic_load(p, __ATOMIC_RELAXED, __HIP_MEMORY_SCOPE_AGENT); }
DI unsigned xb_add(unsigned* p, unsigned v) { return __hip_atomic_fetch_add(p, v, __ATOMIC_RELAXED, __HIP_MEMORY_SCOPE_AGENT); }
DI unsigned xb_xcc_id() { return (unsigned)__builtin_amdgcn_s_getreg((3 << 11) | 20) & 0xFu; }
#define XB_SPIN(cond, bar) do { unsigned _sp = 0; while (cond) { __builtin_amdgcn_s_sleep(1); \
    if ((++_sp & 255u) == 0u) { if (xb_ld(&(bar)[XB_TMO])) break; if (_sp > XB_SPIN_CAP) { atomicAdd(&(bar)[XB_TMO], 1u); break; } } } } while (0)
struct XcdBarrier { unsigned* bar; unsigned x; volatile LAS unsigned* st; };
DI XcdBarrier xcd_barrier_post(unsigned* bar, volatile LAS unsigned* st) {
  XcdBarrier b; b.bar = bar; b.x = xb_xcc_id(); b.st = st;
  if (threadIdx.x == 0) { const unsigned rank = xb_add(&bar[XB_XCNT(b.x)], 1u); st[2] = rank; }
  return b;
}
DI void xcd_barrier_complete(unsigned* bar, unsigned x, unsigned& nloc, unsigned& nx) {
  const unsigned G = gridDim.x * gridDim.y * gridDim.z;
  unsigned sum, cnt, mine, sp = 0u;
  for (;;) {
    sum = 0u; cnt = 0u; mine = 0u;
#pragma unroll
    for (unsigned j = 0; j < 16; ++j) { const unsigned c = xb_ld(&bar[XB_XCNT(j)]); sum += c; cnt += (c > 0u) ? 1u : 0u; mine = (j == x) ? c : mine; }
    if (sum == G) break;
    __builtin_amdgcn_s_sleep(1);
    if ((++sp & 255u) == 0u) { if (xb_ld(&bar[XB_TMO])) break; if (sp > XB_SPIN_CAP) { atomicAdd(&bar[XB_TMO], 1u); break; } }
  }
  nloc = mine > 0u ? mine : 1u; nx = cnt > 0u ? cnt : 1u;
}
DI void xcd_barrier(const XcdBarrier& b) {
  asm volatile("s_waitcnt vmcnt(0)" ::: "memory");
  __syncthreads();
  if (threadIdx.x == 0) {
    unsigned* bar = b.bar;
    __builtin_amdgcn_s_waitcnt(0);
    unsigned nloc = b.st[0], nx = b.st[1];
    if (nloc == 0u) { xcd_barrier_complete(bar, b.x, nloc, nx); b.st[0] = nloc; b.st[1] = nx; }
    const unsigned old = xb_add(&bar[XB_XSUB(b.x)], 1u);
    const unsigned gen = old / nloc;
    if (old + 1u == (gen + 1u) * nloc) {
      __builtin_amdgcn_fence(__ATOMIC_RELEASE, "agent");
      asm volatile("s_waitcnt vmcnt(0)" ::: "memory");
      const unsigned og = xb_add(&bar[XB_TOP], 1u);
      const unsigned tg = og / nx;
      if (og + 1u == (tg + 1u) * nx) xb_add(&bar[XB_TOPGEN], 1u);
      else XB_SPIN(xb_ld(&bar[XB_TOPGEN]) == tg, bar);
      __builtin_amdgcn_fence(__ATOMIC_ACQUIRE, "agent");
      xb_add(&bar[XB_XGEN(b.x)], 1u);
      asm volatile("s_waitcnt vmcnt(0)" ::: "memory");
    } else {
      XB_SPIN(xb_ld(&bar[XB_XGEN(b.x)]) == gen, bar);
      __builtin_amdgcn_fence(__ATOMIC_ACQUIRE, "agent");
      asm volatile("s_waitcnt vmcnt(0)" ::: "memory");
    }
  }
  __syncthreads();
}
constexpr size_t O_BAR = O_MISC + 16384;
constexpr size_t O_ROPE = O_MISC + 65536;

struct Params {
  const float* x_prompt; const float* x_sample;
  const float* ffn1_norm; const float* ffn1_w_in; const float* ffn1_w_out; const float* mix_norm; const float* w_in;
  const float* hy_conv_w; const float* hy_conv_b; const float* hy_w1; const float* hy_b1; const float* hy_w2; const float* hy_b2;
  const float* hy_w3; const float* hy_freq; const float* hy_skip;
  const float* gqa_q_norm; const float* gqa_k_norm; const float* diff_lambda; const float* diff_subln; const float* rel_bias;
  const float* w_branch; const float* w_out; const float* ffn2_norm; const float* ffn2_w_in; const float* ffn2_w_out; const float* final_norm;
  float* out; char* ws;
};

DI unsigned pack2(float a, float b) { f2_t v = {a, b}; bf2_t r = __builtin_convertvector(v, bf2_t); return __builtin_bit_cast(unsigned, r); }
DI u16 f2bf(float a) { return (u16)(pack2(a, 0.f) & 0xffffu); }
DI float bf2f(u16 v) { return __uint_as_float(((unsigned)v) << 16); }
DI float bflo(unsigned v) { return __uint_as_float(v << 16); }
DI float bfhi(unsigned v) { return __uint_as_float(v & 0xffff0000u); }
DI int otid() { int t = threadIdx.x; asm volatile("" : "+v"(t)); return t; }
DI float xhalf_max(float x) {
  typedef unsigned u2_t __attribute__((ext_vector_type(2)));
  const u2_t rr = __builtin_amdgcn_permlane32_swap(__float_as_uint(x), __float_as_uint(x), false, false);
  return fmaxf(__uint_as_float(rr[0]), __uint_as_float(rr[1]));
}
DI float xhalf_sum(float x) {
  typedef unsigned u2_t __attribute__((ext_vector_type(2)));
  const u2_t rr = __builtin_amdgcn_permlane32_swap(__float_as_uint(x), __float_as_uint(x), false, false);
  return __uint_as_float(rr[0]) + __uint_as_float(rr[1]);
}
DI int crow(int reg, int h) { return (reg & 3) + 8 * (reg >> 2) + 4 * h; }
DI float wave_sum(float v) {
  v += __shfl_xor(v, 32); v += __shfl_xor(v, 16); v += __shfl_xor(v, 8); v += __shfl_xor(v, 4); v += __shfl_xor(v, 2); v += __shfl_xor(v, 1);
  return v;
}
DI float half_sum(float v) {
  v += __shfl_xor(v, 16); v += __shfl_xor(v, 8); v += __shfl_xor(v, 4); v += __shfl_xor(v, 2); v += __shfl_xor(v, 1);
  return v;
}

DI void convT_tile(const float* __restrict__ src, int K, int N, u16* __restrict__ dst, int kt, int nt, int perm_half, char* smem) {
  float* t = (float*)smem;
  const int tid = otid() & 255;
  __syncthreads();
  {
    const int col = tid & 63, r0 = tid >> 6;
#pragma unroll
    for (int i = 0; i < 16; ++i) { int row = r0 + 4 * i; t[row * 65 + col] = src[(size_t)(kt * 64 + row) * N + nt * 64 + col]; }
  }
  __syncthreads();
  {
    const int nl = tid >> 2, kq = tid & 3;
    int n = nt * 64 + nl;
    if (perm_half > 0) { if (n < perm_half) n = (n >> 7) * 256 + (n & 127); else { int j = n - perm_half; n = (j >> 7) * 256 + 128 + (j & 127); } }
    u32x4 o0, o1;
#pragma unroll
    for (int i = 0; i < 4; ++i) {
      o0[i] = pack2(t[(kq * 16 + 2 * i) * 65 + nl], t[(kq * 16 + 2 * i + 1) * 65 + nl]);
      o1[i] = pack2(t[(kq * 16 + 8 + 2 * i) * 65 + nl], t[(kq * 16 + 8 + 2 * i + 1) * 65 + nl]);
    }
    u16* d = dst + (size_t)n * K + kt * 64 + kq * 16;
    *(u32x4*)d = o0; *(u32x4*)(d + 8) = o1;
  }
}

DI void filter_item(const Params& P, int layer, int L, int tb, u16* __restrict__ G, char* smem) {
  float* h1 = (float*)smem;
  float* h2 = h1 + 64 * 65;
  const int tid = otid() & 255, lane = tid & 63, w = __builtin_amdgcn_readfirstlane(tid >> 6);
  const float* w1 = P.hy_w1 + layer * 33 * 64; const float* b1 = P.hy_b1 + layer * 64;
  const float* w2 = P.hy_w2 + layer * 64 * 64; const float* b2 = P.hy_b2 + layer * 64;
  const float* w3 = P.hy_w3 + layer * 64 * 1024; const float* fr = P.hy_freq + layer * 64;
  const int t = tb * 64 + lane;
  const float tl = (float)t / (float)(L - 1);
  __syncthreads();
  {
    float a[16];
#pragma unroll
    for (int u = 0; u < 16; ++u) a[u] = b1[w * 16 + u] + tl * w1[w * 16 + u];
    const float base = (float)(2.0 * 3.14159265358979323846 / (double)L) * (float)t;
    for (int b = 0; b < 16; ++b) {
      const float band = 1e-4f + (float)b * ((15.0f - 1e-4f) / 15.0f);
      const float ang = base * band;
      const float cs = cosf(ang), sn = -sinf(ang);
#pragma unroll
      for (int u = 0; u < 16; ++u) a[u] += cs * w1[(1 + b) * 64 + w * 16 + u] + sn * w1[(17 + b) * 64 + w * 16 + u];
    }
#pragma unroll
    for (int u = 0; u < 16; ++u) h1[lane * 65 + w * 16 + u] = sinf(fr[w * 16 + u] * a[u]);
  }
  __syncthreads();
  {
    float a[16];
#pragma unroll
    for (int u = 0; u < 16; ++u) a[u] = b2[w * 16 + u];
    for (int k = 0; k < 64; ++k) {
      const float hv = h1[lane * 65 + k];
#pragma unroll
      for (int u = 0; u < 16; ++u) a[u] += hv * w2[k * 64 + w * 16 + u];
    }
#pragma unroll
    for (int u = 0; u < 16; ++u) h2[lane * 65 + w * 16 + u] = sinf(fr[w * 16 + u] * a[u]);
  }
  __syncthreads();
  const float min_decay = -3.0701134573253946f, max_decay = -15.350567286626973f;
  for (int og = 0; og < 64; ++og) {
    const int o = w * 256 + og * 4;
    float a0 = 0.f, a1 = 0.f, a2 = 0.f, a3 = 0.f;
#pragma unroll 4
    for (int k = 0; k < 64; ++k) {
      const float hv = h2[lane * 65 + k];
      const f32x4 wv = *(const f32x4*)(w3 + k * 1024 + o);
      a0 += hv * wv[0]; a1 += hv * wv[1]; a2 += hv * wv[2]; a3 += hv * wv[3];
    }
    float av[4] = {a0, a1, a2, a3};
#pragma unroll
    for (int q = 0; q < 4; ++q) {
      const int oo = o + q; const int ch = oo & 511;
      const float delta = min_decay + (float)ch * ((max_decay - min_decay) / 511.0f);
      const float val = av[q] * expf(-tl * fabsf(delta));
      u16* Gc = G + (size_t)ch * (2 * L);
      if (oo < 512) Gc[L - t] = f2bf(val);
      else { if (t >= 1) Gc[L + t] = f2bf(val); else Gc[0] = 0; }
    }
  }
}

DI void norm_row_bf16(const float* __restrict__ x, const float* __restrict__ g, u16* __restrict__ out, int lane) {
  f32x4 v[4]; float ss = 0.f;
#pragma unroll
  for (int i = 0; i < 4; ++i) { v[i] = *(const f32x4*)(x + lane * 4 + 256 * i); ss += v[i][0] * v[i][0] + v[i][1] * v[i][1] + v[i][2] * v[i][2] + v[i][3] * v[i][3]; }
  ss = wave_sum(ss);
  const float rs = rsqrtf(ss * (1.0f / 1024.0f) + 1e-6f);
#pragma unroll
  for (int i = 0; i < 4; ++i) {
    const f32x4 gg = *(const f32x4*)(g + lane * 4 + 256 * i);
    u32x2 o; o[0] = pack2(v[i][0] * rs * gg[0], v[i][1] * rs * gg[1]); o[1] = pack2(v[i][2] * rs * gg[2], v[i][3] * rs * gg[3]);
    *(u32x2*)(out + lane * 4 + 256 * i) = o;
  }
}
DI void norm_row_f32_inplace(float* __restrict__ x, const float* __restrict__ g, int lane) {
  f32x4 v[4]; float ss = 0.f;
#pragma unroll
  for (int i = 0; i < 4; ++i) { v[i] = *(const f32x4*)(x + lane * 4 + 256 * i); ss += v[i][0] * v[i][0] + v[i][1] * v[i][1] + v[i][2] * v[i][2] + v[i][3] * v[i][3]; }
  ss = wave_sum(ss);
  const float rs = rsqrtf(ss * (1.0f / 1024.0f) + 1e-6f);
#pragma unroll
  for (int i = 0; i < 4; ++i) {
    const f32x4 gg = *(const f32x4*)(g + lane * 4 + 256 * i);
    f32x4 o; o[0] = v[i][0] * rs * gg[0]; o[1] = v[i][1] * rs * gg[1]; o[2] = v[i][2] * rs * gg[2]; o[3] = v[i][3] * rs * gg[3];
    *(f32x4*)(x + lane * 4 + 256 * i) = o;
  }
}

namespace pg8 {
#define PG8_LAS __attribute__((address_space(3)))
typedef unsigned short bf16_t;
typedef short bf16x8 __attribute__((ext_vector_type(8)));
typedef float f32x4 __attribute__((ext_vector_type(4)));
typedef unsigned u32x4 __attribute__((ext_vector_type(4)));
constexpr int BM = 256, BK = 64, HALF = 128, HTB = HALF * BK * 2  , STAGE_BYTES = 8 * HTB, NXCD = 8, WGM = 8;

__host__ __device__ __forceinline__ int lds_byte(int r, int c) { const int st = (r >> 4) * 2 + (c >> 5), rr = r & 15, cc = c & 31, ob = rr * 64 + cc * 2; return st * 1024 + (ob ^ (((ob >> 9) & 1) << 5)); }
__host__ __device__ __forceinline__ void stage_rc(int b, int& R, int& C) { const int st = b / 1024, sb = b % 1024, swz = sb ^ (((sb >> 9) & 1) << 5); R = (st >> 1) * 16 + swz / 64; C = (st & 1) * 32 + (swz % 64) / 2; }
__host__ __device__ __forceinline__ int perm32(int rho) { const int n = rho >> 4, i = rho & 15; return 8 * (i >> 2) + 4 * n + (i & 3); }

struct Unit { int pm, pn; };
struct Gemm { const bf16_t* A; const bf16_t* Bt; int M, N, K; };

struct StaticOrder {
    int nM, nN, nwg, G, c;
    __host__ __device__ void init(int M, int N, int G_, int c_) { nM = M / BM; nN = N / BM; nwg = nM * nN; G = G_; c = c_; }
    __host__ __device__ bool next(int i, Unit& u) const {
        const long L = (long)i * G + c; if (L >= nwg) return false;
        int wgid = (int)L; { const int q = nwg / NXCD, r = nwg % NXCD, xcd = wgid % NXCD, off = wgid / NXCD; wgid = (xcd < r ? xcd * (q + 1) : r * (q + 1) + (xcd - r) * q) + off; }
        const int nig = WGM * nN, gid = wgid / nig, fm = gid * WGM, gsz = (nM - fm) < WGM ? (nM - fm) : WGM;
        u.pm = fm + ((wgid % nig) % gsz); u.pn = (wgid % nig) / gsz; return true;
    }
    __device__ __forceinline__ void a_ready(const Unit&) const {}
    __device__ __forceinline__ void done(const Unit&) const {}
};

template <class Epi, class Sched, bool STAMP = false>
__device__ __forceinline__ void gemm_phase(PG8_LAS unsigned char* lds, const Gemm g, const Sched& S, const Epi& E, unsigned long long* stamps) {
    const int tid = otid(), wid = __builtin_amdgcn_readfirstlane(tid >> 6), lane = tid & 63, wr = wid >> 2, wc = wid & 3, fr = lane & 15, fq = lane >> 4;
    const int K = g.K, nt = K / BK;
    int ts_lo = 0, ts_hi = 0, nts = 0; const unsigned long long rt_entry = STAMP ? (unsigned long long)wall_clock64() : 0ull;
#define PG8_STAMP() do { if (STAMP && wid == 0 && nts < 64) { const unsigned long long _c = (unsigned long long)clock64(); \
        ts_lo = (lane == nts) ? (int)(unsigned)_c : ts_lo; ts_hi = (lane == nts) ? (int)(unsigned)(_c >> 32) : ts_hi; ++nts; } } while (0)
    PG8_STAMP();
    unsigned voffA[2], voffB[2];
#pragma unroll
    for (int i = 0; i < 2; ++i) { int R, C; stage_rc(tid * 16 + i * 8192, R, C); const int Rb = E.perm ? ((R & ~31) + perm32(R & 31)) : R;
        voffA[i] = (unsigned)(R * K + C) * 2u; voffB[i] = (unsigned)(Rb * K + C) * 2u; }
    const size_t kstep = (size_t)(BK * 2);
    const size_t hstep = (size_t)HALF * K * 2;
    const size_t tstep = 2 * hstep;
    const unsigned ldsw = (unsigned)wid * 1024u;
    const int aoff = lds_byte(wr * 64 + fr, fq * 8), boff = lds_byte(wc * 32 + fr, fq * 8);
#define PG8_SA(b, h) (((b) * 2 + (h)) * HTB)
#define PG8_SB(b, h) ((4 + (b) * 2 + (h)) * HTB)
#define PG8_STAGE(bufoff, gbase, voff) do { _Pragma("unroll") for (int _i = 0; _i < 2; ++_i) \
        __builtin_amdgcn_global_load_lds((const unsigned*)((const char*)(gbase) + (voff)[_i]), (PG8_LAS unsigned*)(lds + (bufoff) + ldsw + _i * 8192), 16, 0, 0); } while (0)
#define PG8_LDA(dst, b, h) do { _Pragma("unroll") for (int m = 0; m < 4; ++m) _Pragma("unroll") for (int k = 0; k < 2; ++k) dst[m][k] = *(const PG8_LAS bf16x8*)(lds + PG8_SA(b, h) + aoff + m * 2048 + k * 1024); } while (0)
#define PG8_LDB(dst, b, h) do { _Pragma("unroll") for (int n = 0; n < 2; ++n) _Pragma("unroll") for (int k = 0; k < 2; ++k) dst[n][k] = *(const PG8_LAS bf16x8*)(lds + PG8_SB(b, h) + boff + n * 2048 + k * 1024); } while (0)
#define PG8_MMA(ai, bj, At, Bt) do { __builtin_amdgcn_s_setprio(1); _Pragma("unroll") for (int m = 0; m < 4; ++m) _Pragma("unroll") for (int n = 0; n < 2; ++n) _Pragma("unroll") for (int k = 0; k < 2; ++k) \
        acc[ai][bj][m][n] = __builtin_amdgcn_mfma_f32_16x16x32_bf16(Bt[n][k], At[m][k], acc[ai][bj][m][n], 0, 0, 0); __builtin_amdgcn_s_setprio(0); } while (0)
#define PG8_WAIT_V(n) asm volatile("s_waitcnt vmcnt(" #n ")" ::: "memory")
#define PG8_WAIT_L(n) asm volatile("s_waitcnt lgkmcnt(" #n ")" ::: "memory")
#define PG8_BAR __builtin_amdgcn_s_barrier()
#define PG8_SCHED __builtin_amdgcn_sched_barrier(0)
    Unit cur, nxt; int ui = 0;
    if (!S.next(0, cur)) return;
    f32x4 acc[2][2][4][2];
#pragma unroll
    for (int a = 0; a < 2; ++a)
#pragma unroll
        for (int b = 0; b < 2; ++b)
#pragma unroll
            for (int m = 0; m < 4; ++m)
#pragma unroll
                for (int n = 0; n < 2; ++n) acc[a][b][m][n] = (f32x4){0.f, 0.f, 0.f, 0.f};
    bf16x8 At[4][2], B0[2][2], B1[2][2];
    const char* cA = (const char*)g.A + (size_t)cur.pm * tstep; const char* cB = (const char*)g.Bt + (size_t)cur.pn * tstep;
    S.a_ready(cur);
    PG8_STAGE(PG8_SB(0, 0), cB, voffB); PG8_STAGE(PG8_SA(0, 0), cA, voffA); PG8_STAGE(PG8_SB(0, 1), cB + hstep, voffB); PG8_STAGE(PG8_SA(0, 1), cA + hstep, voffA);
    if (wr == 1) PG8_BAR;
    PG8_WAIT_V(4); PG8_BAR;
    PG8_STAGE(PG8_SB(1, 0), cB + kstep, voffB); PG8_STAGE(PG8_SA(1, 0), cA + kstep, voffA); PG8_STAGE(PG8_SB(1, 1), cB + hstep + kstep, voffB);
    PG8_WAIT_V(6); PG8_BAR;
    PG8_STAMP();
    for (;;) {
        const bool has_next = S.next(ui + 1, nxt);
        const char* nA = has_next ? (const char*)g.A + (size_t)nxt.pm * tstep : cA; const char* nB = has_next ? (const char*)g.Bt + (size_t)nxt.pn * tstep : cB;
        for (int t = 0; t < nt; t += 2) {
            const bool last = (t == nt - 2);
            const char* a1 = cA + (size_t)(t + 1) * kstep;
            const char* a2 = last ? nA : cA + (size_t)(t + 2) * kstep; const char* b2 = last ? nB : cB + (size_t)(t + 2) * kstep;
            const char* a3 = a2 + kstep; const char* b3 = b2 + kstep;
            if (last && has_next) S.a_ready(nxt);
            PG8_LDB(B0, 0, 0); PG8_SCHED; PG8_LDA(At, 0, 0); PG8_STAGE(PG8_SA(1, 1), a1 + hstep, voffA);
            PG8_WAIT_L(8); PG8_BAR; PG8_WAIT_L(0); PG8_MMA(0, 0, At, B0); PG8_BAR; PG8_SCHED;
            PG8_LDB(B1, 0, 1); PG8_STAGE(PG8_SB(0, 0), b2, voffB);
            PG8_BAR; PG8_WAIT_L(0); PG8_MMA(0, 1, At, B1); PG8_BAR;
            PG8_LDA(At, 0, 1); PG8_STAGE(PG8_SA(0, 0), a2, voffA);
            PG8_BAR; PG8_WAIT_L(0); PG8_MMA(1, 0, At, B0); PG8_BAR; PG8_SCHED;
            PG8_STAGE(PG8_SB(0, 1), b2 + hstep, voffB);
            PG8_WAIT_V(6); PG8_BAR; PG8_MMA(1, 1, At, B1); PG8_BAR;
            PG8_LDB(B0, 1, 0); PG8_SCHED; PG8_LDA(At, 1, 0); PG8_STAGE(PG8_SA(0, 1), a2 + hstep, voffA);
            PG8_WAIT_L(8); PG8_BAR; PG8_WAIT_L(0); PG8_MMA(0, 0, At, B0); PG8_BAR; PG8_SCHED;
            PG8_LDB(B1, 1, 1); PG8_STAGE(PG8_SB(1, 0), b3, voffB);
            PG8_BAR; PG8_WAIT_L(0); PG8_MMA(0, 1, At, B1); PG8_BAR;
            PG8_LDA(At, 1, 1); PG8_STAGE(PG8_SA(1, 0), a3, voffA);
            PG8_BAR; PG8_WAIT_L(0); PG8_MMA(1, 0, At, B0); PG8_BAR; PG8_SCHED;
            PG8_STAGE(PG8_SB(1, 1), b3 + hstep, voffB);
            PG8_WAIT_V(6); PG8_BAR; PG8_MMA(1, 1, At, B1); PG8_BAR;
        }
        PG8_STAMP();
        if constexpr (!Epi::AFTER_DRAIN) { E(acc, cur, wr, wc, fr, fq); S.done(cur); }
        PG8_STAMP();
        if (!has_next) break;
        if (!E.keep_acc(cur)) {
#pragma unroll
        for (int a = 0; a < 2; ++a)
#pragma unroll
            for (int b = 0; b < 2; ++b)
#pragma unroll
                for (int m = 0; m < 4; ++m)
#pragma unroll
                    for (int n = 0; n < 2; ++n) acc[a][b][m][n] = (f32x4){0.f, 0.f, 0.f, 0.f};
        }
        cur = nxt; cA = nA; cB = nB; ++ui;
    }
    PG8_WAIT_V(0);
    if (wr == 0) PG8_BAR;
    PG8_BAR;
    if constexpr (Epi::AFTER_DRAIN) { E.fused(acc, cur, wr, wc, fr, fq, lds, wid, lane); S.done(cur); }
    PG8_STAMP();
    if (STAMP && wid == 0) { stamps[lane] = lane < nts ? (((unsigned long long)(unsigned)ts_hi << 32) | (unsigned)ts_lo) : 0ull;
        if (lane == 62) stamps[62] = rt_entry; if (lane == 63) stamps[63] = (unsigned long long)wall_clock64(); }
#undef PG8_STAMP
#undef PG8_SA
#undef PG8_SB
#undef PG8_STAGE
#undef PG8_LDA
#undef PG8_LDB
#undef PG8_MMA
#undef PG8_WAIT_V
#undef PG8_WAIT_L
#undef PG8_BAR
#undef PG8_SCHED
}
}

enum { EPI_SWIGLU = 0, EPI_RESID = 1, EPI_PROJ = 2, EPI_MERGE = 3 };
struct AnyOrder : pg8::StaticOrder {
  bool merge3;
  __device__ __forceinline__ bool next(int i, pg8::Unit& u) const {
    if (!merge3) return pg8::StaticOrder::next(i, u);
    const int ti = i / 3, br = i - ti * 3; pg8::Unit t;
    if (!pg8::StaticOrder::next(ti, t)) return false;
    u.pm = t.pm + 64 * br; u.pn = t.pn + 4 * br; return true;
  }
};
struct EpiAny {
  static constexpr bool AFTER_DRAIN = false;
  int mode; bool perm;
  u16* O; int ldo; const float* xin; float* xout; float scale; const u16* gate; float* macc; int br;
  int L; u16* vtg; u16* vtd;
  DI bool keep_acc(const pg8::Unit&) const { return false; }
  DI void operator()(pg8::f32x4 (&acc)[2][2][4][2], const pg8::Unit& u, int wr, int wc, int fr, int fq) const {
    const int row0 = (u.pm & 63) * 256 + wr * 64 + fr;
    if (mode == EPI_SWIGLU) {
      const int col0 = u.pn * 128 + wc * 32 + 8 * fq;
#pragma unroll
      for (int ai = 0; ai < 2; ++ai)
#pragma unroll
        for (int m = 0; m < 4; ++m) {
          float v[8];
#pragma unroll
          for (int n = 0; n < 2; ++n)
#pragma unroll
            for (int e = 0; e < 4; ++e) { const float gv = acc[ai][0][m][n][e], uv = acc[ai][1][m][n][e]; v[4 * n + e] = gv * __builtin_amdgcn_rcpf(1.0f + __builtin_amdgcn_exp2f(-LOG2E * gv)) * uv; }
          u32x4 o; o[0] = pack2(v[0], v[1]); o[1] = pack2(v[2], v[3]); o[2] = pack2(v[4], v[5]); o[3] = pack2(v[6], v[7]);
          *(u32x4*)(O + (size_t)(row0 + ai * 128 + m * 16) * ldo + col0) = o;
        }
    } else if (mode == EPI_PROJ) {
      const int col0 = u.pn * 256 + wc * 32 + 8 * fq;
      const bool sg = (u.pn * 256 >= OFF_GATE);
#pragma unroll
      for (int ai = 0; ai < 2; ++ai)
#pragma unroll
        for (int m = 0; m < 4; ++m)
#pragma unroll
          for (int bj = 0; bj < 2; ++bj) {
            float v[8];
#pragma unroll
            for (int n = 0; n < 2; ++n)
#pragma unroll
              for (int e = 0; e < 4; ++e) { float t = acc[ai][bj][m][n][e]; if (sg) t = __builtin_amdgcn_rcpf(1.0f + __builtin_amdgcn_exp2f(-LOG2E * t)); v[4 * n + e] = t; }
            u32x4 o; o[0] = pack2(v[0], v[1]); o[1] = pack2(v[2], v[3]); o[2] = pack2(v[4], v[5]); o[3] = pack2(v[6], v[7]);
            *(u32x4*)(O + (size_t)(row0 + ai * 128 + m * 16) * INC + col0 + bj * 128) = o;
            const bool isg = (u.pn == 8 && bj == 1), isd = (u.pn == 13 || u.pn == 14);
            if (isg || isd) {
              const int row = row0 + ai * 128 + m * 16; const int seq = row / L, tl = row - seq * L;
              const int cidx = isg ? (wc * 32 + 8 * fq) : ((u.pn - 13) * 256 + bj * 128 + wc * 32 + 8 * fq);
              u16* vt = isg ? (vtg + ((size_t)seq * 128 + cidx) * L + tl) : (vtd + ((size_t)seq * 512 + cidx) * L + tl);
#pragma unroll
              for (int q = 0; q < 4; ++q) { vt[(size_t)(2 * q) * L] = (u16)(o[q] & 0xffffu); vt[(size_t)(2 * q + 1) * L] = (u16)(o[q] >> 16); }
            }
          }
    } else if (mode == EPI_RESID) {
      const int col0 = u.pn * 256 + wc * 32 + 4 * fq;
#pragma unroll
      for (int ai = 0; ai < 2; ++ai)
#pragma unroll
        for (int m = 0; m < 4; ++m)
#pragma unroll
          for (int bj = 0; bj < 2; ++bj)
#pragma unroll
            for (int n = 0; n < 2; ++n) {
              const size_t idx = (size_t)(row0 + ai * 128 + m * 16) * DM + col0 + bj * 128 + n * 16;
              f32x4 xv = *(const f32x4*)(xin + idx);
#pragma unroll
              for (int e = 0; e < 4; ++e) xv[e] += scale * acc[ai][bj][m][n][e];
              *(f32x4*)(xout + idx) = xv;
            }
    }
  }
  DI u16* outb_() const { return O; }
};

struct EpiMerge {
  static constexpr bool AFTER_DRAIN = false;
  bool perm; const u16* gate; u16* O;
  DI bool keep_acc(const pg8::Unit& u) const { return (u.pm >> 6) < 2; }
  DI void operator()(pg8::f32x4 (&acc)[2][2][4][2], const pg8::Unit& u, int wr, int wc, int fr, int fq) const {
    const int row0 = (u.pm & 63) * 256 + wr * 64 + fr;
    const int col0 = (u.pn & 3) * 256 + wc * 32 + 8 * fq; const int br = u.pm >> 6;
#pragma unroll
    for (int ai = 0; ai < 2; ++ai)
#pragma unroll
      for (int m = 0; m < 4; ++m)
#pragma unroll
        for (int bj = 0; bj < 2; ++bj) {
          const int row = row0 + ai * 128 + m * 16, col = col0 + bj * 128;
          const u16* gp = gate + (size_t)row * INC + OFF_GATE + br * DM + col;
          const u32x4 ga = *(const u32x4*)gp;
          float g0[8];
#pragma unroll
          for (int q = 0; q < 4; ++q) { g0[2 * q] = bflo(ga[q]); g0[2 * q + 1] = bfhi(ga[q]); }
          if (br < 2) {
            const u32x4 gb = *(const u32x4*)(gp + DM);
#pragma unroll
            for (int q = 0; q < 4; ++q) {
              const float r0 = g0[2 * q] * __builtin_amdgcn_rcpf(fmaxf(bflo(gb[q]), 1e-30f)), r1 = g0[2 * q + 1] * __builtin_amdgcn_rcpf(fmaxf(bfhi(gb[q]), 1e-30f));
              acc[ai][bj][m][q >> 1][2 * (q & 1)] *= r0; acc[ai][bj][m][q >> 1][2 * (q & 1) + 1] *= r1;
            }
          } else {
            u32x4 o;
#pragma unroll
            for (int q = 0; q < 4; ++q) o[q] = pack2(acc[ai][bj][m][q >> 1][2 * (q & 1)] * g0[2 * q], acc[ai][bj][m][q >> 1][2 * (q & 1) + 1] * g0[2 * q + 1]);
            *(u32x4*)(O + (size_t)row * DM + col) = o;
          }
        }
  }
};

DI void qk_prep_item4(const Params& P, int layer, u16* __restrict__ p, int L, int it0, int stride, int nitems, const float* __restrict__ rope) {
  const int tid = otid() & 255, lane = tid & 63, w = __builtin_amdgcn_readfirstlane(tid >> 6);
  const int i = lane & 31, jj = i & 15;
  unsigned* ptr[4]; unsigned v[4]; bool ok[4]; int tl[4]; const float* gn[4];
#pragma unroll
  for (int k = 0; k < 4; ++k) {
    const int it = it0 + k * stride; ok[k] = it < nitems;
    const int u = it * 8 + w * 2 + (lane >> 5);
    const int tok = u / 10, hd = u - tok * 10;
    const int col0 = (hd < 8) ? (OFF_GQ + hd * 64) : (OFF_GK + (hd - 8) * 64);
    gn[k] = (hd < 8) ? (P.gqa_q_norm + layer * 64) : (P.gqa_k_norm + layer * 64);
    ptr[k] = (unsigned*)(p + (size_t)tok * INC + col0) + i;
    tl[k] = tok % L;
    v[k] = ok[k] ? *ptr[k] : 0u;
  }
#pragma unroll
  for (int k = 0; k < 4; ++k) {
    if (ok[k]) {
      float a = bflo(v[k]), b = bfhi(v[k]);
      const float ss = half_sum(a * a + b * b);
      const float rs = rsqrtf(ss * (1.0f / 64.0f) + 1e-6f);
      a = a * rs * gn[k][2 * i]; b = b * rs * gn[k][2 * i + 1];
      const float* rt = rope + ((i < 16) ? ((tl[k] >> 6) * 16 + jj) : (4096 + (tl[k] & 63) * 16 + jj)) * 2;
      const float c = rt[0], sn = rt[1];
      *ptr[k] = pack2(a * c - b * sn, a * sn + b * c);
    }
  }
}

DI void transpose_item(const Params& P, int layer, const u16* __restrict__ p, int L, int kind, int ct, int tt, u16* __restrict__ dst, char* smem) {
  u16* tile = (u16*)smem;
  const int tid = otid() & 255;
  const int t0 = tt * 64;
  const int seq = t0 / L, tl0 = t0 - seq * L;
  const int C = (kind == 0) ? 128 : 512;
  __syncthreads();
  {
    const int col = tid & 63, r0 = tid >> 6;
    const int cidx = ct * 64 + col;
    if (kind < 2) {
      const int off = (kind == 0 ? OFF_GV : OFF_DV) + cidx;
#pragma unroll
      for (int i = 0; i < 16; ++i) { const int row = r0 + 4 * i; tile[col * 72 + row] = p[(size_t)(t0 + row) * INC + off]; }
    } else {
      const float* cw = P.hy_conv_w + layer * 3 * 1536; const float* cb = P.hy_conv_b + layer * 1536;
      const int c1 = 512 + cidx, c2 = 1024 + cidx;
      const float w10 = cw[c1], w11 = cw[1536 + c1], w12 = cw[3072 + c1], b1 = cb[c1];
      const float w20 = cw[c2], w21 = cw[1536 + c2], w22 = cw[3072 + c2], b2 = cb[c2];
#pragma unroll
      for (int i = 0; i < 16; ++i) {
        const int row = r0 + 4 * i; const int tl = tl0 + row;
        const u16* pr = p + (size_t)(t0 + row) * INC;
        const float xm1 = (tl > 0) ? bf2f(pr[c1 - INC]) : 0.f, x0 = bf2f(pr[c1]), xp1 = (tl < L - 1) ? bf2f(pr[c1 + INC]) : 0.f;
        const float vm1 = (tl > 0) ? bf2f(pr[c2 - INC]) : 0.f, v0 = bf2f(pr[c2]), vp1 = (tl < L - 1) ? bf2f(pr[c2 + INC]) : 0.f;
        const float x1c = xm1 * w10 + x0 * w11 + xp1 * w12 + b1;
        const float vc = vm1 * w20 + v0 * w21 + vp1 * w22 + b2;
        tile[col * 72 + row] = f2bf(vc * x1c);
      }
    }
  }
  __syncthreads();
  {
    const int c = tid >> 2, q = tid & 3;
    const u32x4 a = *(const u32x4*)(tile + c * 72 + q * 16), b = *(const u32x4*)(tile + c * 72 + q * 16 + 8);
    u16* d = dst + ((size_t)seq * C + ct * 64 + c) * L + tl0 + q * 16;
    *(u32x4*)d = a; *(u32x4*)(d + 8) = b;
  }
}

DI int kperm(int rho) { return (rho & ~0xC) | ((rho & 4) << 1) | ((rho & 8) >> 1); }
template <int DV, bool BIAS, bool SWAP>
DI void attn_tile(const u16* __restrict__ Qp, const u16* __restrict__ Kp, const u16* __restrict__ VTp, int L,
                  u16* __restrict__ Op, int ldo, int q0, const float* __restrict__ btab, char* smem) {
  constexpr int NDT = DV / 32;
  constexpr int VCH = DV / 64;
  constexpr int KS_SZ = 64 * 64, VS_SZ = DV * 64;
  constexpr int NL = 1 + VCH;
  u16* Ks = (u16*)smem;
  u16* Vs = Ks + 4 * KS_SZ;
  float* bt = (float*)(Vs + 3 * VS_SZ);
  const int tid = otid(), lane = tid & 63, w = __builtin_amdgcn_readfirstlane(tid >> 6), r = lane & 31, h = lane >> 5;
  const float sc = 0.125f * LOG2E;
  __syncthreads();
  if (BIAS) { for (int i = tid; i < 257; i += 512) bt[i] = btab[i]; }
  bf16x8 qf[4];
  {
    const u16* qrow = Qp + (size_t)(q0 + 32 * w + r) * INC + 8 * h;
#pragma unroll
    for (int s = 0; s < 4; ++s) qf[s] = *(const bf16x8*)(qrow + 16 * s);
  }
  const int qpos = q0 + 32 * w + r;
  f32x16 O[NDT];
#pragma unroll
  for (int d = 0; d < NDT; ++d)
#pragma unroll
    for (int q = 0; q < 16; ++q) O[d][q] = 0.f;
  float m = -INFINITY, l = 0.f;
  const int lrow = tid >> 3, lsw = (tid & 7) ^ ((tid >> 4) & 7);
  const u16* Kg0 = Kp + (size_t)kperm(lrow) * INC + lsw * 8;
  const u16* Vg = VTp + (size_t)lrow * L + lsw * 8;
  const int ksw = (r >> 1) & 7;
  const int nkb = L >> 6;
#define ATT_LOADK(tile, bufp) do { const int t__ = ((tile) < nkb) ? (tile) : nkb - 1; \
    __builtin_amdgcn_global_load_lds((const unsigned*)(Kg0 + ((size_t)t__ * 64) * INC), (unsigned*)((char*)(bufp) + tid * 16), 16, 0, 0); } while (0)
#define ATT_LOADV(tile, bufp) do { const int t__ = ((tile) < nkb) ? (tile) : nkb - 1; _Pragma("unroll") for (int i_ = 0; i_ < VCH; ++i_) \
    __builtin_amdgcn_global_load_lds((const unsigned*)(Vg + (size_t)(64 * i_) * L + (size_t)t__ * 64), (unsigned*)((char*)(bufp) + tid * 16 + i_ * 8192), 16, 0, 0); } while (0)
  f32x16 Sc[2];
  auto qk = [&](const u16* Kb) __attribute__((always_inline)) {
    bf16x8 kf[2][4];
#pragma unroll
    for (int kt = 0; kt < 2; ++kt)
#pragma unroll
      for (int s = 0; s < 4; ++s) kf[kt][s] = *(const bf16x8*)(Kb + (32 * kt + r) * 64 + (((2 * s + h) ^ ksw) << 3));
#pragma unroll
    for (int kt = 0; kt < 2; ++kt) {
#pragma unroll
      for (int q = 0; q < 16; ++q) Sc[kt][q] = 0.f;
#pragma unroll
      for (int s = 0; s < 4; ++s) Sc[kt] = MFMA(kf[kt][s], qf[s], Sc[kt]);
    }
    __builtin_amdgcn_sched_group_barrier(0x100, 8, 0);
    __builtin_amdgcn_sched_group_barrier(0x008, 8, 0);
  };
  bf16x8 pf[2][2];
  auto softmax = [&](int kb) __attribute__((always_inline)) {
    float cb = 0.f; bool near = false;
    if (BIAS) {
      const int kmin = kb * 64;
      near = !(kmin - (q0 + 255) >= 128 || q0 - (kmin + 63) >= 128);
      cb = (kmin > q0) ? bt[256] : bt[0];
      if (near) {
        const float isc = 1.0f / sc;
#pragma unroll
        for (int kt = 0; kt < 2; ++kt)
#pragma unroll
          for (int q = 0; q < 16; ++q) {
            int rel = kmin + 32 * kt + kperm(crow(q, h)) - qpos;
            rel = rel < -128 ? -128 : (rel > 128 ? 128 : rel);
            Sc[kt][q] += bt[rel + 128] * isc;
          }
        cb = 0.f;
      }
    }
    float mx = Sc[0][0];
#pragma unroll
    for (int kt = 0; kt < 2; ++kt)
#pragma unroll
      for (int q = 0; q < 16; ++q) mx = fmaxf(mx, Sc[kt][q]);
    mx = xhalf_max(mx);
    mx = __builtin_fmaf(mx, sc, cb);
    if (__any(mx > m + 6.0f)) {
      asm volatile("" ::: "memory");
      const float mn = fmaxf(m, mx);
      const float alpha = __builtin_amdgcn_exp2f(m - mn);
      m = mn; l *= alpha;
#pragma unroll
      for (int d = 0; d < NDT; ++d)
#pragma unroll
        for (int q = 0; q < 16; ++q) O[d][q] *= alpha;
    }
    const float nm = cb - m;
#pragma unroll
    for (int kt = 0; kt < 2; ++kt) {
#pragma unroll
      for (int q = 0; q < 16; ++q) {
        const float pv = __builtin_amdgcn_exp2f(__builtin_fmaf(Sc[kt][q], sc, nm));
        Sc[kt][q] = pv; l += pv;
      }
#pragma unroll
      for (int s = 0; s < 2; ++s) {
        u32x4 pk;
#pragma unroll
        for (int q = 0; q < 4; ++q) pk[q] = pack2(Sc[kt][8 * s + 2 * q], Sc[kt][8 * s + 2 * q + 1]);
        pf[kt][s] = __builtin_bit_cast(bf16x8, pk);
      }
    }
  };
  auto pv = [&](const u16* Vb) __attribute__((always_inline)) {
    bf16x8 vf[4][NDT];
#pragma unroll
    for (int ks = 0; ks < 4; ++ks)
#pragma unroll
      for (int d = 0; d < NDT; ++d) vf[ks][d] = *(const bf16x8*)(Vb + (32 * d + r) * 64 + (((2 * ks + h) ^ ksw) << 3));
#pragma unroll
    for (int ks = 0; ks < 4; ++ks)
#pragma unroll
      for (int d = 0; d < NDT; ++d) O[d] = MFMA(vf[ks][d], pf[ks >> 1][ks & 1], O[d]);
    __builtin_amdgcn_sched_group_barrier(0x100, 2 * NDT, 0);
    __builtin_amdgcn_sched_group_barrier(0x008, NDT, 0);
    __builtin_amdgcn_sched_group_barrier(0x100, NDT, 0);
    __builtin_amdgcn_sched_group_barrier(0x008, NDT, 0);
    __builtin_amdgcn_sched_group_barrier(0x100, NDT, 0);
    __builtin_amdgcn_sched_group_barrier(0x008, 2 * NDT, 0);
  };
  ATT_LOADK(0, Ks); ATT_LOADK(1, Ks + KS_SZ); ATT_LOADK(2, Ks + 2 * KS_SZ);
  ATT_LOADV(0, Vs); ATT_LOADV(1, Vs + VS_SZ);
  asm volatile("s_waitcnt vmcnt(0) lgkmcnt(0)\n\ts_barrier" ::: "memory");
  if (SWAP) qk(Ks);
  int r0 = 0, r2 = 2;
  for (int kb = 0; kb < nkb; ++kb) {
    ATT_LOADK(kb + 3, Ks + ((kb + 3) & 3) * KS_SZ);
    ATT_LOADV(kb + 2, Vs + r2 * VS_SZ);
    if (!SWAP) qk(Ks + (kb & 3) * KS_SZ);
    softmax(kb);
    pv(Vs + r0 * VS_SZ);
    if (SWAP) qk(Ks + ((kb + 1) & 3) * KS_SZ);
    asm volatile("s_waitcnt vmcnt(%0) lgkmcnt(0)\n\ts_barrier" :: "n"(NL) : "memory");
    r2 = r0; r0 = (r0 == 2) ? 0 : r0 + 1;
  }
  asm volatile("s_waitcnt vmcnt(0)" ::: "memory");
#undef ATT_LOADK
#undef ATT_LOADV
  l += __shfl_xor(l, 32);
  const float inv = __builtin_amdgcn_rcpf(l);
  int ldo2 = ldo; asm volatile("" : "+s"(ldo2));
  u16* orow = Op + (size_t)qpos * ldo2;
#pragma unroll
  for (int d = 0; d < NDT; ++d)
#pragma unroll
    for (int g4 = 0; g4 < 4; ++g4) {
      u32x2 o; o[0] = pack2(O[d][4 * g4] * inv, O[d][4 * g4 + 1] * inv); o[1] = pack2(O[d][4 * g4 + 2] * inv, O[d][4 * g4 + 3] * inv);
      *(u32x2*)(orow + 32 * d + 8 * g4 + 4 * h) = o;
    }
}

DI void attn_tile2(const u16* __restrict__ Qp, const u16* __restrict__ Kp, const u16* __restrict__ VTp, int L,
                   u16* __restrict__ Op, int ldo, int q0, char* smem) {
  constexpr int DV = 64, NDT = 2, VCH = 1, RT = 2;
  constexpr int KS_SZ = 64 * 64, VS_SZ = DV * 64;
  constexpr int NL = 1 + VCH;
  u16* Ks = (u16*)smem;
  u16* Vs = Ks + 4 * KS_SZ;
  const int tid = otid(), lane = tid & 63, w = __builtin_amdgcn_readfirstlane(tid >> 6), r = lane & 31, h = lane >> 5;
  const float sc = 0.125f * LOG2E;
  __syncthreads();
  bf16x8 qf[RT][4];
#pragma unroll
  for (int t = 0; t < RT; ++t) {
    const u16* qrow = Qp + (size_t)(q0 + 64 * w + 32 * t + r) * INC + 8 * h;
#pragma unroll
    for (int s = 0; s < 4; ++s) qf[t][s] = *(const bf16x8*)(qrow + 16 * s);
  }
  f32x16 O[RT][NDT];
#pragma unroll
  for (int t = 0; t < RT; ++t)
#pragma unroll
    for (int d = 0; d < NDT; ++d)
#pragma unroll
      for (int q = 0; q < 16; ++q) O[t][d][q] = 0.f;
  float m[RT], l[RT];
#pragma unroll
  for (int t = 0; t < RT; ++t) { m[t] = -INFINITY; l[t] = 0.f; }
  const int lrow = tid >> 3, lsw = (tid & 7) ^ ((tid >> 4) & 7);
  const u16* Kg0 = Kp + (size_t)kperm(lrow) * INC + lsw * 8;
  const u16* Vg = VTp + (size_t)lrow * L + lsw * 8;
  const int ksw = (r >> 1) & 7;
  const int nkb = L >> 6;
#define ATT_LOADK(tile, bufp) do { const int t__ = ((tile) < nkb) ? (tile) : nkb - 1; \
    __builtin_amdgcn_global_load_lds((const unsigned*)(Kg0 + ((size_t)t__ * 64) * INC), (unsigned*)((char*)(bufp) + tid * 16), 16, 0, 0); } while (0)
#define ATT_LOADV(tile, bufp) do { const int t__ = ((tile) < nkb) ? (tile) : nkb - 1; \
    __builtin_amdgcn_global_load_lds((const unsigned*)(Vg + (size_t)t__ * 64), (unsigned*)((char*)(bufp) + tid * 16), 16, 0, 0); } while (0)
  ATT_LOADK(0, Ks); ATT_LOADK(1, Ks + KS_SZ); ATT_LOADK(2, Ks + 2 * KS_SZ);
  ATT_LOADV(0, Vs); ATT_LOADV(1, Vs + VS_SZ);
  asm volatile("s_waitcnt vmcnt(0) lgkmcnt(0)\n\ts_barrier" ::: "memory");
  int r0 = 0, r2 = 2;
  for (int kb = 0; kb < nkb; ++kb) {
    ATT_LOADK(kb + 3, Ks + ((kb + 3) & 3) * KS_SZ);
    ATT_LOADV(kb + 2, Vs + r2 * VS_SZ);
    const u16* Kb = Ks + (kb & 3) * KS_SZ; const u16* Vb = Vs + r0 * VS_SZ;
    f32x16 Sc[RT][2];
    {
      bf16x8 kf[2][4];
#pragma unroll
      for (int kt = 0; kt < 2; ++kt)
#pragma unroll
        for (int s = 0; s < 4; ++s) kf[kt][s] = *(const bf16x8*)(Kb + (32 * kt + r) * 64 + (((2 * s + h) ^ ksw) << 3));
#pragma unroll
      for (int t = 0; t < RT; ++t)
#pragma unroll
        for (int kt = 0; kt < 2; ++kt) {
#pragma unroll
          for (int q = 0; q < 16; ++q) Sc[t][kt][q] = 0.f;
#pragma unroll
          for (int s = 0; s < 4; ++s) Sc[t][kt] = MFMA(kf[kt][s], qf[t][s], Sc[t][kt]);
        }
      __builtin_amdgcn_sched_group_barrier(0x100, 8, 0);
      __builtin_amdgcn_sched_group_barrier(0x008, 16, 0);
    }
    bf16x8 pf[RT][2][2];
#pragma unroll
    for (int t = 0; t < RT; ++t) {
      float mx = Sc[t][0][0];
#pragma unroll
      for (int kt = 0; kt < 2; ++kt)
#pragma unroll
        for (int q = 0; q < 16; ++q) mx = fmaxf(mx, Sc[t][kt][q]);
      mx = xhalf_max(mx);
      mx *= sc;
      if (__any(mx > m[t] + 6.0f)) {
        asm volatile("" ::: "memory");
        const float mn = fmaxf(m[t], mx);
        const float alpha = __builtin_amdgcn_exp2f(m[t] - mn);
        m[t] = mn; l[t] *= alpha;
#pragma unroll
        for (int d = 0; d < NDT; ++d)
#pragma unroll
          for (int q = 0; q < 16; ++q) O[t][d][q] *= alpha;
      }
      const float nm = -m[t];
#pragma unroll
      for (int kt = 0; kt < 2; ++kt) {
#pragma unroll
        for (int q = 0; q < 16; ++q) { const float pv = __builtin_amdgcn_exp2f(__builtin_fmaf(Sc[t][kt][q], sc, nm)); Sc[t][kt][q] = pv; l[t] += pv; }
#pragma unroll
        for (int s = 0; s < 2; ++s) {
          u32x4 pk;
#pragma unroll
          for (int q = 0; q < 4; ++q) pk[q] = pack2(Sc[t][kt][8 * s + 2 * q], Sc[t][kt][8 * s + 2 * q + 1]);
          pf[t][kt][s] = __builtin_bit_cast(bf16x8, pk);
        }
      }
    }
    {
      bf16x8 vf[4][NDT];
#pragma unroll
      for (int ks = 0; ks < 4; ++ks)
#pragma unroll
        for (int d = 0; d < NDT; ++d) vf[ks][d] = *(const bf16x8*)(Vb + (32 * d + r) * 64 + (((2 * ks + h) ^ ksw) << 3));
#pragma unroll
      for (int ks = 0; ks < 4; ++ks)
#pragma unroll
        for (int d = 0; d < NDT; ++d)
#pragma unroll
          for (int t = 0; t < RT; ++t) O[t][d] = MFMA(vf[ks][d], pf[t][ks >> 1][ks & 1], O[t][d]);
      __builtin_amdgcn_sched_group_barrier(0x100, 4, 0);
      __builtin_amdgcn_sched_group_barrier(0x008, 4, 0);
      __builtin_amdgcn_sched_group_barrier(0x100, 4, 0);
      __builtin_amdgcn_sched_group_barrier(0x008, 12, 0);
    }
    asm volatile("s_waitcnt vmcnt(%0) lgkmcnt(0)\n\ts_barrier" :: "n"(NL) : "memory");
    r2 = r0; r0 = (r0 == 2) ? 0 : r0 + 1;
  }
  asm volatile("s_waitcnt vmcnt(0)" ::: "memory");
#undef ATT_LOADK
#undef ATT_LOADV
  int ldo2 = ldo; asm volatile("" : "+s"(ldo2));
#pragma unroll
  for (int t = 0; t < RT; ++t) {
    float lt = l[t]; lt += __shfl_xor(lt, 32);
    const float inv = __builtin_amdgcn_rcpf(lt);
    u16* orow = Op + (size_t)(q0 + 64 * w + 32 * t + r) * ldo2;
#pragma unroll
    for (int d = 0; d < NDT; ++d)
#pragma unroll
      for (int g4 = 0; g4 < 4; ++g4) {
        u32x2 o; o[0] = pack2(O[t][d][4 * g4] * inv, O[t][d][4 * g4 + 1] * inv); o[1] = pack2(O[t][d][4 * g4 + 2] * inv, O[t][d][4 * g4 + 3] * inv);
        *(u32x2*)(orow + 32 * d + 8 * g4 + 4 * h) = o;
      }
  }
}

template <int ILO, int IHI>
DI void hy_seg(int lo, int hi, f32x16 (&acc)[4], const u16* fw, const u16* fw1, const u16* zs, const int (&tq)[4], const int (&tJ)[4],
               int ZLP8, int L, int wb, int r, int h) {
  if (lo > hi) return;
  const int idx0 = L - lo - r + 8 * h - wb;
  const unsigned* ap = (idx0 & 1) ? (const unsigned*)(fw1 + idx0 - 1) : (const unsigned*)(fw + idx0);
  const u16* zq[4]; int cs[4];
#pragma unroll
  for (int i = ILO; i <= IHI; ++i) { zq[i] = zs + tq[i] * ZLP8; cs[i] = (1024 + 1024 * tJ[i] + 32 * r - lo + 8 * h) >> 3; }
  const int n = ((hi - lo) >> 4) + 1;
  bf16x8 a, b[4];
  { u32x4 av; av[0] = ap[0]; av[1] = ap[1]; av[2] = ap[2]; av[3] = ap[3]; a = __builtin_bit_cast(bf16x8, av); }
#pragma unroll
  for (int i = ILO; i <= IHI; ++i) b[i] = *(const bf16x8*)(zq[i] + ((cs[i] + (cs[i] >> 2)) << 3));
  for (int k = 0; k < n; ++k) {
    ap -= 8;
    bf16x8 an, c[4];
    { u32x4 av; av[0] = ap[0]; av[1] = ap[1]; av[2] = ap[2]; av[3] = ap[3]; an = __builtin_bit_cast(bf16x8, av); }
#pragma unroll
    for (int i = ILO; i <= IHI; ++i) { cs[i] -= 2; c[i] = *(const bf16x8*)(zq[i] + ((cs[i] + (cs[i] >> 2)) << 3)); }
#pragma unroll
    for (int i = ILO; i <= IHI; ++i) acc[i] = MFMA(a, b[i], acc[i]);
    a = an;
#pragma unroll
    for (int i = ILO; i <= IHI; ++i) b[i] = c[i];
  }
}

DI void hyena_item(int c, const u16* __restrict__ G, const u16* __restrict__ zT, u16* __restrict__ yT, int nseq, int L, char* smem) {
  u16* zs = (u16*)smem;
  u16* fw = zs + 25600;
  u16* fw1 = fw + 4224;
  const int tid = otid() & 255, lane = tid & 63, w = __builtin_amdgcn_readfirstlane(tid >> 6), r = lane & 31, h = lane >> 5;
  const int ZL = L + 2048;
  const int ZLP8 = ((ZL >> 3) + (ZL >> 5)) << 3;
  __syncthreads();
  for (int q = 0; q < nseq; ++q) {
    const u16* src = zT + ((size_t)q * 512 + c) * L;
    u16* dst = zs + q * ZLP8;
    const u32x4 zero = {0u, 0u, 0u, 0u};
    for (int i = tid; i < 128; i += 256) { const int c0 = i, c1 = 128 + (L >> 3) + i; *(u32x4*)(dst + ((c0 + (c0 >> 2)) << 3)) = zero; *(u32x4*)(dst + ((c1 + (c1 >> 2)) << 3)) = zero; }
    for (int i = tid; i < (L >> 3); i += 256) { const int cc = 128 + i; *(u32x4*)(dst + ((cc + (cc >> 2)) << 3)) = *(const u32x4*)(src + i * 8); }
  }
  int tq[4], tJ[4];
#pragma unroll
  for (int i = 0; i < 4; ++i) { if (nseq == 2) { tq[i] = i & 1; tJ[i] = 2 * w + (i >> 1); } else { tq[i] = 0; tJ[i] = 4 * w + i; } }
  f32x16 acc[4];
#pragma unroll
  for (int i = 0; i < 4; ++i)
#pragma unroll
    for (int q = 0; q < 16; ++q) acc[i][q] = 0.f;
  const int E0 = -L + 16, ELAST = L - 32;
  const int npass = (2 * L - 32 + 4095) / 4096;
  const u16* Gc = G + (size_t)c * (2 * L);
  for (int ps = 0; ps < npass; ++ps) {
    const int ea = E0 + 4096 * ps, eb = ea + 4096;
    const int wb = L - eb - 16;
    __syncthreads();
    for (int i = tid; i < 520; i += 256) {
      const int gi = wb + i * 8;
      u32x4 v = {0u, 0u, 0u, 0u};
      if (gi >= 0 && gi < 2 * L) v = *(const u32x4*)(Gc + gi);
      *(u32x4*)(fw + i * 8) = v;
    }
    __syncthreads();
    for (int i = tid; i < 2079; i += 256) { const unsigned lo = ((const unsigned*)fw)[i], hi = ((const unsigned*)fw)[i + 1]; ((unsigned*)fw1)[i] = (lo >> 16) | (hi << 16); }
    __syncthreads();
    const int eend = (eb - 16 < ELAST) ? (eb - 16) : ELAST;
    int emn[4], emx[4];
#pragma unroll
    for (int i = 0; i < 4; ++i) { emn[i] = 1024 * tJ[i] - L + 16; emx[i] = 1024 * tJ[i] + 992; }
#define HY_CLIP_LO(v) ((v) < ea ? ea : (v))
#define HY_CLIP_HI(v) ((v) > eend ? eend : (v))
    hy_seg<0, 0>(HY_CLIP_LO(emn[0]), HY_CLIP_HI(emn[1] - 16), acc, fw, fw1, zs, tq, tJ, ZLP8, L, wb, r, h);
    hy_seg<0, 1>(HY_CLIP_LO(emn[1]), HY_CLIP_HI(emn[2] - 16), acc, fw, fw1, zs, tq, tJ, ZLP8, L, wb, r, h);
    hy_seg<0, 2>(HY_CLIP_LO(emn[2]), HY_CLIP_HI(emn[3] - 16), acc, fw, fw1, zs, tq, tJ, ZLP8, L, wb, r, h);
    hy_seg<0, 3>(HY_CLIP_LO(emn[3]), HY_CLIP_HI(emx[0]), acc, fw, fw1, zs, tq, tJ, ZLP8, L, wb, r, h);
    hy_seg<1, 3>(HY_CLIP_LO(emx[0] + 16), HY_CLIP_HI(emx[1]), acc, fw, fw1, zs, tq, tJ, ZLP8, L, wb, r, h);
    hy_seg<2, 3>(HY_CLIP_LO(emx[1] + 16), HY_CLIP_HI(emx[2]), acc, fw, fw1, zs, tq, tJ, ZLP8, L, wb, r, h);
    hy_seg<3, 3>(HY_CLIP_LO(emx[2] + 16), HY_CLIP_HI(emx[3]), acc, fw, fw1, zs, tq, tJ, ZLP8, L, wb, r, h);
#undef HY_CLIP_LO
#undef HY_CLIP_HI
  }
#pragma unroll
  for (int i = 0; i < 4; ++i) {
    u16* dst = yT + ((size_t)tq[i] * 512 + c) * L + 1024 * tJ[i] + 32 * r + 4 * h;
#pragma unroll
    for (int g4 = 0; g4 < 4; ++g4) {
      u32x2 o; o[0] = pack2(acc[i][4 * g4], acc[i][4 * g4 + 1]); o[1] = pack2(acc[i][4 * g4 + 2], acc[i][4 * g4 + 3]);
      *(u32x2*)(dst + 8 * g4) = o;
    }
  }
}

DI void diff_post_item(const Params& P, int layer, float lam, float lam_init, const u16* __restrict__ dO, u16* __restrict__ ydf, int it) {
  const int tid = otid() & 255, lane = tid & 63, w = __builtin_amdgcn_readfirstlane(tid >> 6);
  const int u = it * 8 + w * 2 + (lane >> 5);
  const int i = lane & 31;
  const u32x2 a = *(const u32x2*)(dO + (size_t)u * 256 + 4 * i);
  const u32x2 b = *(const u32x2*)(dO + (size_t)u * 256 + 128 + 4 * i);
  float o[4];
  o[0] = bflo(a[0]) - lam * bflo(b[0]); o[1] = bfhi(a[0]) - lam * bfhi(b[0]);
  o[2] = bflo(a[1]) - lam * bflo(b[1]); o[3] = bfhi(a[1]) - lam * bfhi(b[1]);
  const float ss = half_sum(o[0] * o[0] + o[1] * o[1] + o[2] * o[2] + o[3] * o[3]);
  const float rs = rsqrtf(ss * (1.0f / 128.0f) + 1e-5f) * (1.0f - lam_init);
  const float* g = P.diff_subln + layer * 128 + 4 * i;
  u32x2 ov; ov[0] = pack2(o[0] * rs * g[0], o[1] * rs * g[1]); ov[1] = pack2(o[2] * rs * g[2], o[3] * rs * g[3]);
  *(u32x2*)(ydf + (size_t)u * 128 + 4 * i) = ov;
}
DI void hyena_post_item(const Params& P, int layer, const u16* __restrict__ p, int L, const u16* __restrict__ yT, const u16* __restrict__ zT,
                        int ct, int tt, u16* __restrict__ yhy, char* smem) {
  float* tile = (float*)smem;
  const int tid = otid() & 255;
  const int t0 = tt * 64; const int seq = t0 / L, tl0 = t0 - seq * L;
  __syncthreads();
  {
    const int tcol = tid & 63, c0 = tid >> 6;
#pragma unroll
    for (int i = 0; i < 16; ++i) {
      const int cc = c0 + 4 * i; const int c = ct * 64 + cc;
      const size_t gi = ((size_t)seq * 512 + c) * L + tl0 + tcol;
      tile[cc * 65 + tcol] = bf2f(yT[gi]) + bf2f(zT[gi]) * P.hy_skip[layer * 512 + c];
    }
  }
  __syncthreads();
  {
    const int col = tid & 63, r0 = tid >> 6; const int c = ct * 64 + col;
    const float* cw = P.hy_conv_w + layer * 3 * 1536; const float* cb = P.hy_conv_b + layer * 1536;
    const float w0 = cw[c], w1 = cw[1536 + c], w2 = cw[3072 + c], b0 = cb[c];
#pragma unroll
    for (int i = 0; i < 16; ++i) {
      const int row = r0 + 4 * i; const int tl = tl0 + row;
      const u16* pr = p + (size_t)(t0 + row) * INC + c;
      const float xm1 = (tl > 0) ? bf2f(pr[-INC]) : 0.f, x0 = bf2f(pr[0]), xp1 = (tl < L - 1) ? bf2f(pr[INC]) : 0.f;
      const float x0c = xm1 * w0 + x0 * w1 + xp1 * w2 + b0;
      yhy[(size_t)(t0 + row) * 512 + c] = f2bf(x0c * tile[col * 65 + row]);
    }
  }
}

__global__ void __launch_bounds__(512) fwd_megakernel(Params Parg) {
  cg::grid_group grid = cg::this_grid();
  extern __shared__ __attribute__((aligned(16))) char smem_dyn[];
  char* smem = smem_dyn + 16;
  uint4& xb_words = *(uint4*)smem_dyn;
  const int nb = gridDim.x, nb2 = nb * 2;
#define KPARAMS() const Params __attribute__((address_space(4)))* pp_ = (const Params __attribute__((address_space(4)))*)__builtin_amdgcn_kernarg_segment_ptr(); \
  asm volatile("" : "+s"(pp_)); const Params& P = *(const Params*)pp_; char* ws = P.ws
  if (threadIdx.x == 0) xb_words = make_uint4(0u, 0u, 0u, blockIdx.x);
  __syncthreads();
  XcdBarrier xb;
  { KPARAMS(); xb = xcd_barrier_post((unsigned*)(ws + O_BAR), (volatile LAS unsigned*)&xb_words); }

  for (int step = 0; step < 80; ++step) {
    const int layer = step / 40, ls = step - layer * 40;
    PHASE_IDS();
    KPARAMS();
    float* misc = (float*)(ws + O_MISC);
    u16* pbuf = (u16*)(ws + O_P); u16* hid = pbuf; u16* hn = (u16*)(ws + O_HN); u16* merged = hn;
    if (ls == 0) {
      u16* filt8 = (u16*)(ws + O_FILT8); u16* filt16 = (u16*)(ws + O_FILT16);
      const int n1 = 16 * 88, n2 = 44 * 16, n3 = 16 * 108, n4 = 3 * 8 * 16, n5 = 16 * 16;
      const int nfilt = 128 + 256;
      const int total = n1 + n2 + n3 + n4 + n5 + n1 + n2 + nfilt;
      for (int it = bid2; it < total; it += nb2) {
        int t = it;
        if (t < nfilt) {
          const bool big = t < 256;
          filter_item(P, layer, big ? 16384 : 8192, big ? t : t - 256, big ? filt16 : filt8, smg);
          continue;
        }
        t -= nfilt;
        const float* src; int K, N, kt, nt, ph = 0; u16* dst;
        if (t < n1) { src = P.ffn1_w_in + (size_t)layer * 1024 * 5632; K = 1024; N = 5632; dst = (u16*)(ws + O_F1IN); kt = t / 88; nt = t % 88; ph = 2816; }
        else if ((t -= n1) < n2) { src = P.ffn1_w_out + (size_t)layer * 2816 * 1024; K = 2816; N = 1024; dst = (u16*)(ws + O_F1OUT); kt = t / 16; nt = t % 16; }
        else if ((t -= n2) < n3) { src = P.w_in + (size_t)layer * 1024 * 6912; K = 1024; N = 6912; dst = (u16*)(ws + O_WIN); kt = t / 108; nt = t % 108; }
        else if ((t -= n3) < n4) { const int br = t / 128, tt = t % 128; src = P.w_branch + ((size_t)layer * 3 + br) * 512 * 1024; K = 512; N = 1024;
                                   dst = (u16*)(ws + O_WBR) + (size_t)br * 1024 * 512; kt = tt / 16; nt = tt % 16; }
        else if ((t -= n4) < n5) { src = P.w_out + (size_t)layer * 1024 * 1024; K = 1024; N = 1024; dst = (u16*)(ws + O_WOUT); kt = t / 16; nt = t % 16; }
        else if ((t -= n5) < n1) { src = P.ffn2_w_in + (size_t)layer * 1024 * 5632; K = 1024; N = 5632; dst = (u16*)(ws + O_F2IN); kt = t / 88; nt = t % 88; ph = 2816; }
        else { t -= n1; src = P.ffn2_w_out + (size_t)layer * 2816 * 1024; K = 2816; N = 1024; dst = (u16*)(ws + O_F2OUT); kt = t / 16; nt = t % 16; }
        convT_tile(src, K, N, dst, kt, nt, ph, smg);
      }
      if (bid == 1 && grp == 0 && layer == 0) {
        float* rope = (float*)(ws + O_ROPE);
        for (int i = t_; i < 320 * 16; i += 256) {
          const int pos = (i < 4096) ? (i >> 4) : ((i - 4096) >> 4); const int jj = i & 15;
          const float inv = powf(10000.0f, -(float)(2 * jj) / 32.0f);
          const float ang = (float)pos * inv;
          rope[2 * i] = cosf(ang); rope[2 * i + 1] = sinf(ang);
        }
      }
      if (bid == 0 && grp == 0) {
        const int tid = t_;
        if (tid < 2) {
          const float* lp = P.diff_lambda + tid * 256;
          float s1 = 0.f, s2 = 0.f;
          for (int i = 0; i < 64; ++i) { s1 += lp[i] * lp[64 + i]; s2 += lp[128 + i] * lp[192 + i]; }
          const float lam_init = 0.8f - 0.6f * expf(-0.3f * (float)tid);
          misc[tid] = expf(s1) - expf(s2) + lam_init;
        }
        for (int i = tid; i < 4 * 257; i += 256) {
          const int hh = i / 257, idx = i % 257; const int rel = idx - 128; const int n = rel < 0 ? -rel : rel;
          int b;
          if (n < 8) b = n; else { int lg = 8 + (int)(logf((float)n / 8.0f) / 2.772588722239781f * 8.0f); b = lg < 15 ? lg : 15; }
          if (rel > 0) b += 16;
          misc[64 + i] = P.rel_bias[b * 4 + hh] * LOG2E;
        }
      }
      if (step == 0) {
        grid.sync();
        if (threadIdx.x == 0) {
          unsigned* bar = (unsigned*)(ws + O_BAR); bool even = ((nb & 7) == 0);
          for (int j = 0; j < 16; ++j) { const unsigned c = xb_ld(&bar[XB_XCNT(j)]); if (c != ((j < 8) ? (unsigned)(nb >> 3) : 0u)) even = false; }
          volatile LAS unsigned* st = (volatile LAS unsigned*)&xb_words;
          if (even) st[3] = st[2] * 8u + xb.x;
        }
        __syncthreads();
      } else GSYNC();
      continue;
    }
    const int cs = ls - 1; const int ch = cs / 13, st = cs - ch * 13;
    const int nseq = (ch < 2) ? 2 : 1, L = (ch < 2) ? 8192 : 16384;
    const float* xin0 = (ch < 2) ? (P.x_prompt + (size_t)ch * TCH * DM) : P.x_sample;
    float* xres = P.out + (size_t)ch * TCH * DM;
    const float* xcur = (layer == 0) ? xin0 : xres;
    for (int rp_ = 0; rp_ <= ((REPMASK >> st) & 1); ++rp_) {
    if (st == 0 || st == 3 || st == 10) {
      const float* src = (st == 0) ? xcur : xres;
      const float* gn = ((st == 0) ? P.ffn1_norm : (st == 3 ? P.mix_norm : P.ffn2_norm)) + layer * DM;
      for (int it = bid2; it < TCH / 4; it += nb2) { const int row = it * 4 + w; norm_row_bf16(src + (size_t)row * DM, gn, hn + (size_t)row * DM, lane); }
    } else if (st == 1 || st == 2 || st == 4 || st == 8 || st == 9 || st == 11 || st == 12) {
      EpiAny E{}; const u16* A; const u16* Bt; int N, K;
      if (st == 1 || st == 11) { A = hn; Bt = (u16*)(ws + (st == 1 ? O_F1IN : O_F2IN)); N = 5632; K = DM; E.mode = EPI_SWIGLU; E.perm = true; E.O = hid; E.ldo = DFF; }
      else if (st == 2 || st == 12) { A = hid; Bt = (u16*)(ws + (st == 2 ? O_F1OUT : O_F2OUT)); N = DM; K = DFF; E.mode = EPI_RESID; E.perm = false;
                                      E.xin = (st == 2) ? xcur : xres; E.xout = xres; E.scale = 0.5f; }
      else if (st == 4) { A = hn; Bt = (u16*)(ws + O_WIN); N = INC; K = DM; E.mode = EPI_PROJ; E.perm = true; E.O = pbuf; E.L = L; E.vtg = (u16*)(ws + O_VTG); E.vtd = (u16*)(ws + O_VTD); }
      else if (st == 8) { A = (u16*)(ws + O_YHY); Bt = (u16*)(ws + O_WBR); N = DM; K = 512; E.mode = EPI_MERGE; E.perm = false; E.gate = pbuf; E.macc = (float*)(ws + O_ZT); E.O = merged; }
      else { A = merged; Bt = (u16*)(ws + O_WOUT); N = DM; K = DM; E.mode = EPI_RESID; E.perm = false; E.xin = xres; E.xout = xres; E.scale = 1.0f; }
      if (st == 8) {
        pg8::Gemm gg{A, Bt, TCH, N, K};
        AnyOrder S; S.init(TCH, N, nb, bid); S.merge3 = true;
        EpiMerge EM{true, pbuf, merged};
        pg8::gemm_phase<EpiMerge, AnyOrder, false>((PG8_LAS unsigned char*)smem, gg, S, EM, nullptr);
      } else {
        pg8::Gemm gg{A, Bt, TCH, N, K};
        AnyOrder S; S.init(TCH, N, nb, bid); S.merge3 = false;
        pg8::gemm_phase<EpiAny, AnyOrder, false>((PG8_LAS unsigned char*)smem, gg, S, E, nullptr);
      }
    } else if (st == 5) {
      const int nqk = TCH * 10 / 8, ntr = 256 * 8;
      for (int it0 = bid2; it0 < nqk; it0 += nb2 * 4) qk_prep_item4(P, layer, pbuf, L, it0, nb2, nqk, (const float*)(ws + O_ROPE));
      for (int t = bid2; t < ntr; t += nb2) transpose_item(P, layer, pbuf, L, 2, t & 7, t >> 3, (u16*)(ws + O_ZT), smg);
    } else if (st == 6) {
      u16* zT = (u16*)(ws + O_ZT); u16* yT = (u16*)(ws + O_YT); u16* dO = (u16*)(ws + O_DIFFO);
      u16* vtg = (u16*)(ws + O_VTG); u16* vtd = (u16*)(ws + O_VTD); u16* ygq = (u16*)(ws + O_YGQ);
      const u16* filt = (u16*)(ws + ((ch < 2) ? O_FILT8 : O_FILT16));
      const int nqt = L / 256;
      const int xcd = bid & 7, nxu = nb >> 3, nitem = nseq * nqt;
      for (int e = bid >> 3; e < nitem; e += nxu) {
        const int seq = e / nqt, qt = e - seq * nqt;
        const int hh = xcd >> 1, cc = xcd & 1;
        const size_t tb = (size_t)seq * L;
        const u16* Qd = pbuf + tb * INC + OFF_DQ + xcd * 64; const u16* Kd = pbuf + tb * INC + OFF_DK + xcd * 64;
        const u16* Vd = vtd + ((size_t)seq * 512 + hh * 128) * L; u16* Od = dO + tb * 1024 + (hh * 2 + cc) * 128;
        attn_tile<128, true, false>(Qd, Kd, Vd, L, Od, 1024, qt * 256, misc + 64 + hh * 257, smem);
      }
      {
        const int nqt2 = L / 512, nitem2 = nseq * nqt2;
        for (int e = bid >> 3; e < nitem2; e += nxu) {
          const int seq = e / nqt2, qt = e - seq * nqt2;
          const int kvh = xcd >> 2;
          const size_t tb = (size_t)seq * L;
          const u16* Qd = pbuf + tb * INC + OFF_GQ + xcd * 64; const u16* Kd = pbuf + tb * INC + OFF_GK + kvh * 64;
          const u16* Vd = vtg + ((size_t)seq * 128 + kvh * 64) * L; u16* Od = ygq + tb * 512 + xcd * 64;
          attn_tile2(Qd, Kd, Vd, L, Od, 512, qt * 512, smem);
        }
      }
      for (int c = bid2; c < 512; c += nb2) hyena_item(c, filt, zT, yT, nseq, L, smg);
    } else {
      u16* zT = (u16*)(ws + O_ZT); u16* yT = (u16*)(ws + O_YT); u16* dO = (u16*)(ws + O_DIFFO);
      u16* yhy = (u16*)(ws + O_YHY); u16* ydf = (u16*)(ws + O_YDF);
      const float lam = misc[layer];
      const float lam_init = 0.8f - 0.6f * expf(-0.3f * (float)layer);
      const int ndp = TCH * 4 / 8, nhp = 256 * 8;
      for (int it = bid2; it < ndp + nhp; it += nb2) {
        if (it < ndp) diff_post_item(P, layer, lam, lam_init, dO, ydf, it);
        else { const int t = it - ndp; hyena_post_item(P, layer, pbuf, L, yT, zT, t % 8, t / 8, yhy, smg); }
      }
    }
    }
    GSYNC();
  }
  { PHASE_IDS(); KPARAMS(); (void)ws;
    for (int it = bid2; it < NTOK / 4; it += nb2) { const int row = it * 4 + w; norm_row_f32_inplace(P.out + (size_t)row * DM, P.final_norm, lane); }
  }
}

extern "C" void kernel_launch(void* const* d_in, const int* in_sizes, int n_in, void* d_out, int out_size, void* d_ws, size_t ws_size,
                              hipStream_t stream) {
  static int grid_blocks = 0;
  if (!grid_blocks) {
    int dev = 0, cus = 0, per_cu = 0;
    (void)hipGetDevice(&dev);
    (void)hipDeviceGetAttribute(&cus, hipDeviceAttributeMultiprocessorCount, dev);
    (void)hipFuncSetAttribute((const void*)fwd_megakernel, hipFuncAttributeMaxDynamicSharedMemorySize, SMEM_BYTES + 16);
    (void)hipOccupancyMaxActiveBlocksPerMultiprocessor(&per_cu, fwd_megakernel, 512, SMEM_BYTES + 16);
    if (per_cu < 1) per_cu = 1;
    if (per_cu > 1) per_cu = 1;
    grid_blocks = cus * per_cu;
  }
  Params p{};
  const float* const* in = (const float* const*)d_in;
  p.x_prompt = in[0]; p.x_sample = in[1]; p.ffn1_norm = in[2]; p.ffn1_w_in = in[3]; p.ffn1_w_out = in[4]; p.mix_norm = in[5]; p.w_in = in[6];
  p.hy_conv_w = in[7]; p.hy_conv_b = in[8]; p.hy_w1 = in[9]; p.hy_b1 = in[10]; p.hy_w2 = in[11]; p.hy_b2 = in[12]; p.hy_w3 = in[13];
  p.hy_freq = in[14]; p.hy_skip = in[15]; p.gqa_q_norm = in[16]; p.gqa_k_norm = in[17]; p.diff_lambda = in[18]; p.diff_subln = in[19];
  p.rel_bias = in[20]; p.w_branch = in[21]; p.w_out = in[22]; p.ffn2_norm = in[23]; p.ffn2_w_in = in[24]; p.ffn2_w_out = in[25]; p.final_norm = in[26];
  p.out = (float*)d_out; p.ws = (char*)d_ws;
  void* args[] = {&p};
  (void)hipMemsetAsync((char*)d_ws + O_BAR, 0, XCD_BAR_WORDS * 4, stream);
  hipError_t e = hipLaunchCooperativeKernel((void*)fwd_megakernel, dim3(grid_blocks), dim3(512), args, SMEM_BYTES + 16, stream);
  if (e != hipSuccess) fprintf(stderr, "cooperative launch failed: %s (grid %d)\n", hipGetErrorString(e), grid_blocks);
}
```
